# Optimizing an MI355X kernel written in HIP

```python
import jax, jax.numpy as jnp
from jax import lax
import numpy as np

D_MODEL = 2048
BATCH = 2
SEQ = 8192
DEPTH = 4
DEC_BATCH = 16
DEC_SEQ = 64
PAST_LEN = 2048

CHUNK = 64
N_MIXERS = 2
N_RWKV_LAYERS = (DEPTH + 1) // 2
N_GLA_LAYERS = DEPTH // 2
RWKV_HEAD = 64
RWKV_HEADS = D_MODEL // RWKV_HEAD
RWKV_DECAY_LORA = 96
RWKV_AAA_LORA = 96
RWKV_MV_LORA = 64
RWKV_GATE_LORA = 256
RWKV_GN_EPS = 64e-5
GLA_HEADS = 4
GLA_DK = D_MODEL // 2
GLA_DV = D_MODEL
GLA_HEAD_K = GLA_DK // GLA_HEADS
GLA_HEAD_V = GLA_DV // GLA_HEADS
GLA_GATE_RANK = 16
GLA_GATE_NORMALIZER = 16.0
GLA_NORM_EPS = 1e-5
FFN_HIDDEN = 5632
CONV_WIDTH = 3
NORM_EPS = 1e-6

kernel_name = 'rwkv7_gla_convffn_stream_step'


def rmsnorm(x, g):
    xf = x.astype(jnp.float32)
    y = xf * lax.rsqrt(jnp.mean(xf * xf, axis=-1, keepdims=True) + NORM_EPS)
    return y.astype(x.dtype) * g


def _wkv7_step(S, inp):
    r, d, k, v, kk, a = inp
    sa = jnp.einsum('bhvk,bhk->bhv', S, -kk)
    S = S * d[:, :, None, :] + sa[..., None] * (kk * a)[:, :, None, :] + v[..., None] * k[:, :, None, :]
    o = jnp.einsum('bhvk,bhk->bhv', S, r)
    return S, o


def rwkv7_time_mix(x, x_prev, wkv0, v_first, vres, mix, w0, w1, w2, a0, a1, a2,
                   g1, g2, k_k, k_a, r_k, wr, wk, wv, wo, lnx_w, lnx_b):
    B, T, D = x.shape
    H, N = RWKV_HEADS, RWKV_HEAD
    xx = jnp.concatenate([x_prev[:, None, :].astype(x.dtype), x[:, :-1, :]], axis=1) - x
    xr, xw, xk, xv, xa, xg = [x + xx * mix[m] for m in range(6)]
    r = xr @ wr
    w = -jax.nn.softplus(-(w0 + jnp.tanh(xw @ w1) @ w2)) - 0.5
    k = xk @ wk
    v = xv @ wv
    if vres is None:
        v_first = v
    else:
        v0, v1, v2 = vres
        v = v + (v_first - v) * jax.nn.sigmoid(v0 + (xv @ v1) @ v2)
    a = jax.nn.sigmoid(a0 + (xa @ a1) @ a2)
    g = jax.nn.sigmoid(xg @ g1) @ g2
    kk = (k * k_k).reshape(B, T, H, N).astype(jnp.float32)
    kk = kk / jnp.maximum(jnp.sqrt(jnp.sum(kk * kk, axis=-1, keepdims=True)), 1e-12)
    k = k * (1 + (a - 1) * k_a)
    heads = lambda t: t.reshape(B, T, H, N).astype(jnp.float32)
    rh, kh, vh, ah = heads(r), heads(k), heads(v), heads(a)
    dh = jnp.exp(-jnp.exp(heads(w)))
    tmaj = lambda t: jnp.moveaxis(t, 1, 0)
    S, o = lax.scan(_wkv7_step, wkv0.astype(jnp.float32),
                    (tmaj(rh), tmaj(dh), tmaj(kh), tmaj(vh), tmaj(kk), tmaj(ah)))
    o = jnp.moveaxis(o, 0, 1)
    mu = jnp.mean(o, axis=-1, keepdims=True)
    var = jnp.mean(jnp.square(o - mu), axis=-1, keepdims=True)
    o = ((o - mu) * lax.rsqrt(var + RWKV_GN_EPS)).reshape(B, T, D).astype(x.dtype) * lnx_w + lnx_b
    bonus = (jnp.sum(rh * kh * r_k, axis=-1, keepdims=True) * vh).reshape(B, T, D).astype(x.dtype)
    out = ((o + bonus) * g) @ wo
    return out, x[:, -1, :], S.astype(wkv0.dtype), v_first


def gla_chunked(q, k, v, g, S0):
    B, H, T, DK = q.shape
    C = min(CHUNK, T)
    n = T // C
    blk = lambda t: jnp.moveaxis(t.reshape(B, H, n, C, t.shape[-1]), 2, 0)
    causal = jnp.tril(jnp.ones((C, C), dtype=bool))

    def step(S, inp):
        qc, kc, vc, gc = inp
        cum = jnp.cumsum(gc, axis=-2)
        last = cum[:, :, -1:, :]
        qe = qc * jnp.exp(cum)
        ke = kc * jnp.exp(-cum)
        scores = jnp.where(causal, jnp.einsum('bhid,bhjd->bhij', qe, ke), 0.0)
        o = jnp.einsum('bhij,bhjv->bhiv', scores, vc) + jnp.einsum('bhid,bhdv->bhiv', qe, S)
        S = S * jnp.exp(last)[:, :, 0, :, None] + jnp.einsum('bhjd,bhjv->bhdv', kc * jnp.exp(last - cum), vc)
        return S, o

    S, o = lax.scan(step, S0, (blk(q), blk(k), blk(v), blk(g)))
    o = jnp.moveaxis(o, 0, 2).reshape(B, H, T, v.shape[-1])
    return o, S


def gla_time_mix(x, S0, w_in, gk_w2, gk_b, head_norm, wo):
    B, T, D = x.shape
    proj = x @ w_in
    q, k, v, gate, lr = jnp.split(
        proj, [GLA_DK, 2 * GLA_DK, 2 * GLA_DK + GLA_DV, 2 * GLA_DK + 2 * GLA_DV], axis=-1)
    gk = jax.nn.log_sigmoid((lr @ gk_w2 + gk_b).astype(jnp.float32)) / GLA_GATE_NORMALIZER
    hk = lambda t: t.reshape(B, T, GLA_HEADS, GLA_HEAD_K).transpose(0, 2, 1, 3).astype(jnp.float32)
    qh = hk(q) * GLA_HEAD_K ** -0.5
    kh, gh = hk(k), hk(gk)
    vh = v.reshape(B, T, GLA_HEADS, GLA_HEAD_V).transpose(0, 2, 1, 3).astype(jnp.float32)
    o, S = gla_chunked(qh, kh, vh, gh, S0.astype(jnp.float32))
    o = o * lax.rsqrt(jnp.mean(o * o, axis=-1, keepdims=True) + GLA_NORM_EPS)
    o = o.transpose(0, 2, 1, 3).astype(x.dtype) * head_norm
    o = o.reshape(B, T, GLA_DV) * jax.nn.silu(gate)
    return o @ wo, S.astype(S0.dtype)


def conv_ffn(x, conv_state, w_up, conv_w, conv_b, w_down):
    T = x.shape[1]
    u = x @ w_up
    up = jnp.concatenate([conv_state.astype(u.dtype), u], axis=1)
    c = conv_b + sum(conv_w[i] * up[:, i:i + T] for i in range(CONV_WIDTH))
    val, gate = jnp.split(c, 2, axis=-1)
    return (jax.nn.silu(gate) * val) @ w_down, up[:, T:]


def run_trunk(x, shift_st, wkv_st, gla_st, conv_st, prm):
    new_shift, new_wkv, new_gla, new_conv = [], [], [], []
    v_first = None
    for i in range(DEPTH):
        h = rmsnorm(x, prm['norm_mix'][i])
        j = i // N_MIXERS
        if i % N_MIXERS == 0:
            vres = None if j == 0 else (prm['rwkv_v0'][j - 1], prm['rwkv_v1'][j - 1], prm['rwkv_v2'][j - 1])
            out, s_shift, s_wkv, v_first = rwkv7_time_mix(
                h, shift_st[j], wkv_st[j], v_first, vres, prm['rwkv_mix'][j],
                prm['rwkv_w0'][j], prm['rwkv_w1'][j], prm['rwkv_w2'][j],
                prm['rwkv_a0'][j], prm['rwkv_a1'][j], prm['rwkv_a2'][j],
                prm['rwkv_g1'][j], prm['rwkv_g2'][j], prm['rwkv_k_k'][j], prm['rwkv_k_a'][j],
                prm['rwkv_r_k'][j], prm['rwkv_wr'][j], prm['rwkv_wk'][j], prm['rwkv_wv'][j],
                prm['rwkv_wo'][j], prm['rwkv_lnx_w'][j], prm['rwkv_lnx_b'][j])
            new_shift.append(s_shift)
            new_wkv.append(s_wkv)
        else:
            out, s_gla = gla_time_mix(h, gla_st[j], prm['gla_w_in'][j], prm['gla_gk_w2'][j],
                                      prm['gla_gk_b'][j], prm['gla_head_norm'][j], prm['gla_wo'][j])
            new_gla.append(s_gla)
        x = x + out
        h = rmsnorm(x, prm['norm_ffn'][i])
        out, s_conv = conv_ffn(h, conv_st[i], prm['ffn_w_up'][i], prm['ffn_conv_w'][i],
                               prm['ffn_conv_b'][i], prm['ffn_w_down'][i])
        new_conv.append(s_conv)
        x = x + out
    y = rmsnorm(x, prm['norm_final'])
    return y, jnp.stack(new_shift), jnp.stack(new_wkv), jnp.stack(new_gla), jnp.stack(new_conv)


def setup_inputs(seed: int = 0) -> dict:
    key = jax.random.key(seed)
    ks = jax.random.split(key, 40)
    f32 = jnp.float32
    nrm = lambda k, shape, s: jax.random.normal(k, shape, f32) * s
    LA, LB, D, H, N, F2 = N_RWKV_LAYERS, N_GLA_LAYERS, D_MODEL, RWKV_HEADS, RWKV_HEAD, 2 * FFN_HIDDEN
    w_in_cols = 2 * GLA_DK + 2 * GLA_DV + GLA_GATE_RANK
    conv_shift = jnp.zeros((CONV_WIDTH, F2), f32).at[CONV_WIDTH - 1].set(1.0)
    return {
        'x_prompt': nrm(ks[0], (BATCH, SEQ, D), 1.0),
        'x_sample': nrm(ks[1], (DEC_BATCH, DEC_SEQ, D), 1.0),
        'state_rwkv_shift': nrm(ks[2], (LA, DEC_BATCH, D), 1.0),
        'state_rwkv_wkv': nrm(ks[3], (LA, DEC_BATCH, H, N, N), 0.2),
        'state_gla': nrm(ks[4], (LB, DEC_BATCH, GLA_HEADS, GLA_HEAD_K, GLA_HEAD_V), 0.1),
        'state_ffn_conv': nrm(ks[5], (DEPTH, DEC_BATCH, CONV_WIDTH - 1, F2), 1.0),
        'norm_mix': 1.0 + nrm(ks[6], (DEPTH, D), 0.02),
        'norm_ffn': 1.0 + nrm(ks[7], (DEPTH, D), 0.02),
        'norm_final': 1.0 + nrm(ks[8], (D,), 0.02),
        'rwkv_mix': jax.random.uniform(ks[9], (LA, 6, D), f32),
        'rwkv_w0': jax.random.uniform(ks[10], (LA, D), f32, -6.0, -1.0),
        'rwkv_w1': nrm(ks[11], (LA, D, RWKV_DECAY_LORA), D ** -0.5),
        'rwkv_w2': nrm(ks[12], (LA, RWKV_DECAY_LORA, D), 0.1 * RWKV_DECAY_LORA ** -0.5),
        'rwkv_a0': nrm(ks[13], (LA, D), 0.1),
        'rwkv_a1': nrm(ks[14], (LA, D, RWKV_AAA_LORA), D ** -0.5),
        'rwkv_a2': nrm(ks[15], (LA, RWKV_AAA_LORA, D), 0.1 * RWKV_AAA_LORA ** -0.5),
        'rwkv_v0': nrm(ks[16], (LA - 1, D), 0.1),
        'rwkv_v1': nrm(ks[17], (LA - 1, D, RWKV_MV_LORA), D ** -0.5),
        'rwkv_v2': nrm(ks[18], (LA - 1, RWKV_MV_LORA, D), 0.1 * RWKV_MV_LORA ** -0.5),
        'rwkv_g1': nrm(ks[19], (LA, D, RWKV_GATE_LORA), D ** -0.5),
        'rwkv_g2': nrm(ks[20], (LA, RWKV_GATE_LORA, D), RWKV_GATE_LORA ** -0.5),
        'rwkv_k_k': 0.85 + nrm(ks[21], (LA, D), 0.05),
        'rwkv_k_a': 1.0 + nrm(ks[22], (LA, D), 0.05),
        'rwkv_r_k': nrm(ks[23], (LA, H, N), 0.1),
        'rwkv_wr': nrm(ks[24], (LA, D, D), D ** -0.5),
        'rwkv_wk': nrm(ks[25], (LA, D, D), D ** -0.5),
        'rwkv_wv': nrm(ks[26], (LA, D, D), D ** -0.5),
        'rwkv_wo': nrm(ks[27], (LA, D, D), 0.5 * D ** -0.5),
        'rwkv_lnx_w': 1.0 + nrm(ks[28], (LA, D), 0.02),
        'rwkv_lnx_b': nrm(ks[29], (LA, D), 0.01),
        'gla_w_in': nrm(ks[30], (LB, D, w_in_cols), D ** -0.5),
        'gla_gk_w2': nrm(ks[31], (LB, GLA_GATE_RANK, GLA_DK), GLA_GATE_RANK ** -0.5),
        'gla_gk_b': nrm(ks[32], (LB, GLA_DK), 0.1),
        'gla_head_norm': 1.0 + nrm(ks[33], (LB, GLA_HEAD_V), 0.02),
        'gla_wo': nrm(ks[34], (LB, GLA_DV, D), 0.5 * GLA_DV ** -0.5),
        'ffn_w_up': nrm(ks[35], (DEPTH, D, F2), D ** -0.5),
        'ffn_conv_w': conv_shift + nrm(ks[36], (DEPTH, CONV_WIDTH, F2), 0.3),
        'ffn_conv_b': nrm(ks[37], (DEPTH, F2), 0.01),
        'ffn_w_down': nrm(ks[38], (DEPTH, FFN_HIDDEN, D), 0.5 * FFN_HIDDEN ** -0.5),
    }


def reference(x_prompt, x_sample, state_rwkv_shift, state_rwkv_wkv, state_gla, state_ffn_conv,
              norm_mix, norm_ffn, norm_final, rwkv_mix, rwkv_w0, rwkv_w1, rwkv_w2,
              rwkv_a0, rwkv_a1, rwkv_a2, rwkv_v0, rwkv_v1, rwkv_v2, rwkv_g1, rwkv_g2,
              rwkv_k_k, rwkv_k_a, rwkv_r_k, rwkv_wr, rwkv_wk, rwkv_wv, rwkv_wo,
              rwkv_lnx_w, rwkv_lnx_b, gla_w_in, gla_gk_w2, gla_gk_b, gla_head_norm, gla_wo,
              ffn_w_up, ffn_conv_w, ffn_conv_b, ffn_w_down):
    prm = dict(norm_mix=norm_mix, norm_ffn=norm_ffn, norm_final=norm_final,
               rwkv_mix=rwkv_mix, rwkv_w0=rwkv_w0, rwkv_w1=rwkv_w1, rwkv_w2=rwkv_w2,
               rwkv_a0=rwkv_a0, rwkv_a1=rwkv_a1, rwkv_a2=rwkv_a2,
               rwkv_v0=rwkv_v0, rwkv_v1=rwkv_v1, rwkv_v2=rwkv_v2,
               rwkv_g1=rwkv_g1, rwkv_g2=rwkv_g2, rwkv_k_k=rwkv_k_k, rwkv_k_a=rwkv_k_a,
               rwkv_r_k=rwkv_r_k, rwkv_wr=rwkv_wr, rwkv_wk=rwkv_wk, rwkv_wv=rwkv_wv,
               rwkv_wo=rwkv_wo, rwkv_lnx_w=rwkv_lnx_w, rwkv_lnx_b=rwkv_lnx_b,
               gla_w_in=gla_w_in, gla_gk_w2=gla_gk_w2, gla_gk_b=gla_gk_b,
               gla_head_norm=gla_head_norm, gla_wo=gla_wo,
               ffn_w_up=ffn_w_up, ffn_conv_w=ffn_conv_w, ffn_conv_b=ffn_conv_b,
               ffn_w_down=ffn_w_down)
    bp, dt = x_prompt.shape[0], x_prompt.dtype
    zero_shift = jnp.zeros((N_RWKV_LAYERS, bp, D_MODEL), dt)
    zero_wkv = jnp.zeros((N_RWKV_LAYERS, bp, RWKV_HEADS, RWKV_HEAD, RWKV_HEAD), dt)
    zero_gla = jnp.zeros((N_GLA_LAYERS, bp, GLA_HEADS, GLA_HEAD_K, GLA_HEAD_V), dt)
    zero_conv = jnp.zeros((DEPTH, bp, CONV_WIDTH - 1, 2 * FFN_HIDDEN), dt)
    y_prompt, p_shift, p_wkv, p_gla, p_conv = run_trunk(
        x_prompt, zero_shift, zero_wkv, zero_gla, zero_conv, prm)
    y_sample, s_shift, s_wkv, s_gla, s_conv = run_trunk(
        x_sample, state_rwkv_shift, state_rwkv_wkv, state_gla, state_ffn_conv, prm)
    return (y_prompt, y_sample, p_shift, p_wkv, p_gla, p_conv, s_shift, s_wkv, s_gla, s_conv)
```

```cpp
#include <hip/hip_runtime.h>
#include <hip/hip_cooperative_groups.h>
#include <cstdio>
#include <cstdint>
namespace cg = cooperative_groups;

#define LAS __attribute__((address_space(3)))
typedef unsigned short bf16_t;
typedef short bf16x8 __attribute__((ext_vector_type(8)));
typedef float f32x4 __attribute__((ext_vector_type(4)));
typedef float f32x16 __attribute__((ext_vector_type(16)));
typedef unsigned u32x4 __attribute__((ext_vector_type(4)));
typedef unsigned u32x2 __attribute__((ext_vector_type(2)));

constexpr int DM = 2048, MROWS = 17408, MPROMPT = 16384;
constexpr int FH = 5632, F2 = 11264;
constexpr int LDS_BYTES = 147456;
constexpr size_t MiB = 1u << 20;
constexpr size_t WS_WT = 1 * MiB;
constexpr size_t WS_A = 411 * MiB;
constexpr size_t WS_B = 819 * MiB;
constexpr size_t WS_VF = 1227 * MiB;
constexpr size_t WS_END = 1295 * MiB;
constexpr size_t ACT = (size_t)MROWS * DM;
constexpr size_t RW_SZ = (size_t)7168 * 2048 + (size_t)8192 * 256 + (size_t)2048 * 2048;
constexpr size_t GW_SZ = (size_t)6400 * 2048 + (size_t)2048 * 2048;
constexpr size_t FW_SZ = (size_t)11264 * 2048 + (size_t)2048 * 5632;
constexpr size_t GW_OFF = 2 * RW_SZ, FW_OFF = GW_OFF + 2 * GW_SZ;
constexpr size_t O_PSHIFT = 35651584, O_PWKV = 35659776, O_PGLA = 36184064, O_PCONV = 38281216;
constexpr size_t O_SSHIFT = 38461440, O_SWKV = 38526976, O_SGLA = 42721280, O_SCONV = 59498496, O_TOTAL = 60940288;

__device__ __forceinline__ unsigned cvt_pk_bf16(float lo, float hi) { unsigned r; asm volatile("v_cvt_pk_bf16_f32 %0, %1, %2" : "=v"(r) : "v"(lo), "v"(hi)); return r; }
__device__ __forceinline__ float bf2f(bf16_t b) { return __builtin_bit_cast(float, (unsigned)b << 16); }
__device__ __forceinline__ float bflo(unsigned u) { return __builtin_bit_cast(float, u << 16); }
__device__ __forceinline__ float bfhi(unsigned u) { return __builtin_bit_cast(float, u & 0xffff0000u); }
__device__ __forceinline__ void unpack8(u32x4 w, float (&f)[8]) {
    f[0] = bflo(w.x); f[1] = bfhi(w.x); f[2] = bflo(w.y); f[3] = bfhi(w.y); f[4] = bflo(w.z); f[5] = bfhi(w.z); f[6] = bflo(w.w); f[7] = bfhi(w.w);
}
__device__ __forceinline__ u32x4 pack8(const float (&f)[8]) {
    u32x4 w; w.x = cvt_pk_bf16(f[0], f[1]); w.y = cvt_pk_bf16(f[2], f[3]); w.z = cvt_pk_bf16(f[4], f[5]); w.w = cvt_pk_bf16(f[6], f[7]); return w;
}
__device__ __forceinline__ float sigmoidf_(float x) { return 1.f / (1.f + __expf(-x)); }
__device__ __forceinline__ float shx(float v, int lane, int o) { return __builtin_bit_cast(float, __builtin_amdgcn_ds_bpermute((lane ^ o) << 2, __builtin_bit_cast(int, v))); }
__device__ __forceinline__ float wave_sum(float v, int lane) {
#pragma unroll
    for (int o = 1; o < 64; o <<= 1) v += shx(v, lane, o);
    return v;
}
__device__ __forceinline__ float sum8(float v, int lane) { v += shx(v, lane, 1); v += shx(v, lane, 2); v += shx(v, lane, 4); return v; }
__device__ __forceinline__ int crow(int reg, int h) { return (reg & 3) + 8 * (reg >> 2) + 4 * h; }

namespace pg8 {
constexpr int BM = 256, BK = 64, HALF = 128, HTB = HALF * BK * 2, STAGE_BYTES = 8 * HTB, NXCD = 8, WGM = 8;
__host__ __device__ __forceinline__ int lds_byte(int r, int c) { const int st = (r >> 4) * 2 + (c >> 5), rr = r & 15, cc = c & 31, ob = rr * 64 + cc * 2; return st * 1024 + (ob ^ (((ob >> 9) & 1) << 5)); }
__host__ __device__ __forceinline__ void stage_rc(int b, int& R, int& C) { const int st = b / 1024, sb = b % 1024, swz = sb ^ (((sb >> 9) & 1) << 5); R = (st >> 1) * 16 + swz / 64; C = (st & 1) * 32 + (swz % 64) / 2; }
__host__ __device__ __forceinline__ int perm32(int rho) { const int n = rho >> 4, i = rho & 15; return 8 * (i >> 2) + 4 * n + (i & 3); }

struct Unit { int pm, pn; };
struct Gemm { const bf16_t* A; const bf16_t* Bt; int M, N, K; int mode; size_t astride; };
__device__ __forceinline__ const char* a_of(const Gemm& g, int pn) {
    int s = 0;
    if (g.mode == 1) s = pn < 8 ? 0 : pn < 16 ? 2 : pn < 24 ? 3 : pn == 24 ? 1 : pn == 25 ? 4 : pn == 26 ? 5 : 3;
    else if (g.mode == 2) s = pn >> 3;
    return (const char*)g.A + (size_t)s * g.astride;
}
struct StaticOrder {
    int nM, nN, nwg, G, c;
    __device__ void init(int M, int N, int G_, int c_) { nM = M / BM; nN = N / BM; nwg = nM * nN; G = G_; c = c_; }
    __device__ bool next(int i, Unit& u) const {
        const long L = (long)i * G + c; if (L >= nwg) return false;
        int wgid = (int)L; { const int q = nwg / NXCD, r = nwg % NXCD, xcd = wgid % NXCD, off = wgid / NXCD; wgid = (xcd < r ? xcd * (q + 1) : r * (q + 1) + (xcd - r) * q) + off; }
        const int nig = WGM * nN, gid = wgid / nig, fm = gid * WGM, gsz = (nM - fm) < WGM ? (nM - fm) : WGM;
        u.pm = fm + ((wgid % nig) % gsz); u.pn = (wgid % nig) / gsz; return true;
    }
};

template <class F> struct Epi {
    static constexpr bool PERM = true;
    F f;
    __device__ __forceinline__ void operator()(const f32x4 (&acc)[2][2][4][2], const Unit& u, int wr, int wc, int fr, int fq) const {
        asm volatile("" : "+v"(fr), "+v"(fq));
        const int row0 = u.pm * BM + wr * 64 + fr, col0 = u.pn * BM + wc * 32 + 8 * fq;
#pragma unroll
        for (int ai = 0; ai < 2; ++ai)
#pragma unroll
            for (int m = 0; m < 4; ++m)
#pragma unroll
                for (int bj = 0; bj < 2; ++bj) f(row0 + ai * HALF + m * 16, col0 + bj * HALF, acc[ai][bj][m][0], acc[ai][bj][m][1]);
    }
};

template <class EpiT>
__device__ __forceinline__ void gemm_phase(LAS unsigned char* lds, const Gemm g, const StaticOrder& S, const EpiT& E) {
    int tid = threadIdx.x; asm volatile("" : "+v"(tid));
    const int wid = __builtin_amdgcn_readfirstlane(tid >> 6), lane = tid & 63, wr = wid >> 2, wc = wid & 3, fr = lane & 15, fq = lane >> 4;
    const int K = g.K, nt = K / BK;
    unsigned voffA[2], voffB[2];
#pragma unroll
    for (int i = 0; i < 2; ++i) { int R, C; stage_rc(tid * 16 + i * 8192, R, C); const int Rb = EpiT::PERM ? ((R & ~31) + perm32(R & 31)) : R;
        voffA[i] = (unsigned)(R * K + C) * 2u; voffB[i] = (unsigned)(Rb * K + C) * 2u; }
    const size_t kstep = (size_t)(BK * 2);
    const size_t hstep = (size_t)HALF * K * 2;
    const size_t tstep = 2 * hstep;
    const unsigned ldsw = (unsigned)wid * 1024u;
    const int aoff = lds_byte(wr * 64 + fr, fq * 8), boff = lds_byte(wc * 32 + fr, fq * 8);
#define PG8_SA(b, h) (((b) * 2 + (h)) * HTB)
#define PG8_SB(b, h) ((4 + (b) * 2 + (h)) * HTB)
#define PG8_STAGE(bufoff, gbase, voff) do { _Pragma("unroll") for (int _i = 0; _i < 2; ++_i) \
        __builtin_amdgcn_global_load_lds((const unsigned*)((const char*)(gbase) + (voff)[_i]), (LAS unsigned*)(lds + (bufoff) + ldsw + _i * 8192), 16, 0, 0); } while (0)
#define PG8_LDA(dst, b, h) do { _Pragma("unroll") for (int m = 0; m < 4; ++m) _Pragma("unroll") for (int k = 0; k < 2; ++k) dst[m][k] = *(const LAS bf16x8*)(lds + PG8_SA(b, h) + aoff + m * 2048 + k * 1024); } while (0)
#define PG8_LDB(dst, b, h) do { _Pragma("unroll") for (int n = 0; n < 2; ++n) _Pragma("unroll") for (int k = 0; k < 2; ++k) dst[n][k] = *(const LAS bf16x8*)(lds + PG8_SB(b, h) + boff + n * 2048 + k * 1024); } while (0)
#define PG8_MMA(ai, bj, At, Bt) do { __builtin_amdgcn_s_setprio(1); _Pragma("unroll") for (int m = 0; m < 4; ++m) _Pragma("unroll") for (int n = 0; n < 2; ++n) _Pragma("unroll") for (int k = 0; k < 2; ++k) \
        acc[ai][bj][m][n] = __builtin_amdgcn_mfma_f32_16x16x32_bf16(Bt[n][k], At[m][k], acc[ai][bj][m][n], 0, 0, 0); __builtin_amdgcn_s_setprio(0); } while (0)
#define PG8_WAIT_V(n) asm volatile("s_waitcnt vmcnt(" #n ")" ::: "memory")
#define PG8_WAIT_L(n) asm volatile("s_waitcnt lgkmcnt(" #n ")" ::: "memory")
#define PG8_BAR __builtin_amdgcn_s_barrier()
#define PG8_SCHED __builtin_amdgcn_sched_barrier(0)
    Unit cur, nxt; int ui = 0;
    if (!S.next(0, cur)) return;
    f32x4 acc[2][2][4][2];
#pragma unroll
    for (int a = 0; a < 2; ++a)
#pragma unroll
        for (int b = 0; b < 2; ++b)
#pragma unroll
            for (int m = 0; m < 4; ++m)
#pragma unroll
                for (int n = 0; n < 2; ++n) acc[a][b][m][n] = (f32x4){0.f, 0.f, 0.f, 0.f};
    bf16x8 At[4][2], B0[2][2], B1[2][2];
    const char* cA = a_of(g, cur.pn) + (size_t)cur.pm * tstep; const char* cB = (const char*)g.Bt + (size_t)cur.pn * tstep;
    PG8_STAGE(PG8_SB(0, 0), cB, voffB); PG8_STAGE(PG8_SB(0, 1), cB + hstep, voffB); PG8_STAGE(PG8_SA(0, 0), cA, voffA); PG8_STAGE(PG8_SA(0, 1), cA + hstep, voffA);
    if (wr == 1) PG8_BAR;
    PG8_WAIT_V(2); PG8_BAR;
    PG8_STAGE(PG8_SB(1, 0), cB + kstep, voffB); PG8_STAGE(PG8_SA(1, 0), cA + kstep, voffA); PG8_STAGE(PG8_SB(1, 1), cB + hstep + kstep, voffB);
    PG8_WAIT_V(6); PG8_BAR;
    for (;;) {
        const bool has_next = S.next(ui + 1, nxt);
        const char* nA = has_next ? a_of(g, nxt.pn) + (size_t)nxt.pm * tstep : cA; const char* nB = has_next ? (const char*)g.Bt + (size_t)nxt.pn * tstep : cB;
        for (int t = 0; t < nt; t += 2) {
            const bool last = (t == nt - 2);
            const char* a1 = cA + (size_t)(t + 1) * kstep;
            const char* a2 = last ? nA : cA + (size_t)(t + 2) * kstep; const char* b2 = last ? nB : cB + (size_t)(t + 2) * kstep;
            const char* a3 = a2 + kstep; const char* b3 = b2 + kstep;
            PG8_LDB(B0, 0, 0); PG8_LDB(B1, 0, 1); PG8_SCHED; PG8_LDA(At, 0, 0); PG8_STAGE(PG8_SA(1, 1), a1 + hstep, voffA);
            PG8_WAIT_V(8); PG8_WAIT_L(0); PG8_BAR; PG8_MMA(0, 0, At, B0); PG8_MMA(0, 1, At, B1); PG8_BAR; PG8_SCHED;
            PG8_LDA(At, 0, 1); PG8_STAGE(PG8_SB(0, 0), b2, voffB); PG8_STAGE(PG8_SB(0, 1), b2 + hstep, voffB); PG8_STAGE(PG8_SA(0, 0), a2, voffA);
            PG8_WAIT_V(8); PG8_WAIT_L(0); PG8_BAR; PG8_MMA(1, 0, At, B0); PG8_MMA(1, 1, At, B1); PG8_BAR; PG8_SCHED;
            PG8_LDB(B0, 1, 0); PG8_LDB(B1, 1, 1); PG8_SCHED; PG8_LDA(At, 1, 0); PG8_STAGE(PG8_SA(0, 1), a2 + hstep, voffA);
            PG8_WAIT_V(8); PG8_WAIT_L(0); PG8_BAR; PG8_MMA(0, 0, At, B0); PG8_MMA(0, 1, At, B1); PG8_BAR; PG8_SCHED;
            PG8_LDA(At, 1, 1); PG8_STAGE(PG8_SB(1, 0), b3, voffB); PG8_STAGE(PG8_SB(1, 1), b3 + hstep, voffB); PG8_STAGE(PG8_SA(1, 0), a3, voffA);
            PG8_WAIT_V(8); PG8_WAIT_L(0); PG8_BAR; PG8_MMA(1, 0, At, B0); PG8_MMA(1, 1, At, B1); PG8_BAR; PG8_SCHED;
        }
        if (wr == 0) PG8_BAR;
        E(acc, cur, wr, wc, fr, fq);
        if (!has_next) break;
#pragma unroll
        for (int a = 0; a < 2; ++a)
#pragma unroll
            for (int b = 0; b < 2; ++b)
#pragma unroll
                for (int m = 0; m < 4; ++m)
#pragma unroll
                    for (int n = 0; n < 2; ++n) acc[a][b][m][n] = (f32x4){0.f, 0.f, 0.f, 0.f};
        cur = nxt; cA = nA; cB = nB; ++ui;
        if (wr == 1) PG8_BAR;
    }
    PG8_WAIT_V(0);
    PG8_BAR;
#undef PG8_SA
#undef PG8_SB
#undef PG8_STAGE
#undef PG8_LDA
#undef PG8_LDB
#undef PG8_MMA
#undef PG8_WAIT_V
#undef PG8_WAIT_L
#undef PG8_BAR
#undef PG8_SCHED
}
}

__device__ __forceinline__ void store8bf(bf16_t* p, f32x4 a, f32x4 b) {
    u32x4 w; w.x = cvt_pk_bf16(a[0], a[1]); w.y = cvt_pk_bf16(a[2], a[3]); w.z = cvt_pk_bf16(b[0], b[1]); w.w = cvt_pk_bf16(b[2], b[3]);
    *(u32x4*)p = w;
}
struct FRes { float* X;
    __device__ __forceinline__ void operator()(int row, int col, f32x4 a, f32x4 b) const {
        float* p = X + (size_t)row * DM + col; f32x4 x0 = *(f32x4*)p, x1 = *(f32x4*)(p + 4); *(f32x4*)p = x0 + a; *(f32x4*)(p + 4) = x1 + b; } };
struct FR1 { bf16_t *R, *K, *V, *L;
    __device__ __forceinline__ void operator()(int row, int col, f32x4 a, f32x4 b) const {
        if (col < 6144) { const int g = col >> 11; const size_t o = (size_t)row * DM + (col & 2047); if (g == 0) store8bf(R + o, a, b); else if (g == 1) store8bf(K + o, a, b); else store8bf(V + o, a, b); }
        else { const int t = (col - 6144) >> 8, c = col & 255;
            if (t == 0) { for (int i = 0; i < 4; ++i) { a[i] = 1.f - 2.f / (1.f + __expf(2.f * a[i])); b[i] = 1.f - 2.f / (1.f + __expf(2.f * b[i])); } }
            else if (t == 2) { for (int i = 0; i < 4; ++i) { a[i] = sigmoidf_(a[i]); b[i] = sigmoidf_(b[i]); } }
            store8bf(L + (size_t)t * MROWS * 256 + (size_t)row * 256 + c, a, b); } } };
__device__ __forceinline__ float decay_of(float z) { const float e = 0.60653065971f / (1.f + __expf(-z)); return __expf(-e); }
struct FR2 { float* DD; bf16_t *AA, *GG, *VG; const float *w0, *a0, *v0;
    __device__ __forceinline__ void operator()(int row, int col, f32x4 a, f32x4 b) const {
        const int g = col >> 11, c = col & 2047; const size_t off = (size_t)row * DM + c;
        if (g == 0) { f32x4 z0 = *(const f32x4*)(w0 + c), z1 = *(const f32x4*)(w0 + c + 4); a += z0; b += z1;
            for (int i = 0; i < 4; ++i) { a[i] = decay_of(a[i]); b[i] = decay_of(b[i]); }
            *(f32x4*)(DD + off) = a; *(f32x4*)(DD + off + 4) = b; }
        else if (g == 1) { f32x4 z0 = *(const f32x4*)(a0 + c), z1 = *(const f32x4*)(a0 + c + 4); a += z0; b += z1;
            for (int i = 0; i < 4; ++i) { a[i] = sigmoidf_(a[i]); b[i] = sigmoidf_(b[i]); } store8bf(AA + off, a, b); }
        else if (g == 2) { store8bf(GG + off, a, b); }
        else { f32x4 z0 = *(const f32x4*)(v0 + c), z1 = *(const f32x4*)(v0 + c + 4); a += z0; b += z1;
            for (int i = 0; i < 4; ++i) { a[i] = sigmoidf_(a[i]); b[i] = sigmoidf_(b[i]); } store8bf(VG + off, a, b); } } };
struct FG1 { bf16_t* PROJ; float* LR;
    __device__ __forceinline__ void operator()(int row, int col, f32x4 a, f32x4 b) const {
        if (col < 6144) { if (col < 1024) { a *= 0.0625f; b *= 0.0625f; } store8bf(PROJ + (size_t)row * 6144 + col, a, b); }
        else if (col < 6160) { float* p = LR + (size_t)row * 16 + (col - 6144); *(f32x4*)p = a; *(f32x4*)(p + 4) = b; } } };
struct FUp { bf16_t* U; float* pconv; float* sconv;
    __device__ __forceinline__ void operator()(int row, int col, f32x4 a, f32x4 b) const {
        store8bf(U + (size_t)row * F2 + col, a, b);
        if (row < MPROMPT) { const int t = row & 8191; if (t >= 8190) { float* p = pconv + ((size_t)((row >> 13) * 2 + (t - 8190))) * F2 + col; *(f32x4*)p = a; *(f32x4*)(p + 4) = b; } }
        else { const int rr = row - MPROMPT, t = rr & 63; if (t >= 62) { float* p = sconv + ((size_t)((rr >> 6) * 2 + (t - 62))) * F2 + col; *(f32x4*)p = a; *(f32x4*)(p + 4) = b; } } } };

__device__ __forceinline__ void tr_item(const float* W, int K, int N, bf16_t* WT, int Kpad, int Npad, float* scr, int item, int lane) {
    const int nblk = Npad / 32, kb = item / nblk, nb = item % nblk, k0 = 64 * kb, n0 = 32 * nb;
    const int n = n0 + (lane & 31);
#pragma unroll 8
    for (int i = 0; i < 32; ++i) { const int kk = 2 * i + (lane >> 5); const int k = k0 + kk; scr[kk * 33 + (lane & 31)] = (k < K && n < N) ? W[(size_t)k * N + n] : 0.f; }
    asm volatile("s_waitcnt lgkmcnt(0)" ::: "memory");
    const int c = lane & 7;
#pragma unroll
    for (int j = 0; j < 4; ++j) { const int nn = (lane >> 3) + 8 * j; const float* s = scr + (8 * c) * 33 + nn;
        u32x4 o; o.x = cvt_pk_bf16(s[0 * 33], s[1 * 33]); o.y = cvt_pk_bf16(s[2 * 33], s[3 * 33]); o.z = cvt_pk_bf16(s[4 * 33], s[5 * 33]); o.w = cvt_pk_bf16(s[6 * 33], s[7 * 33]);
        *(u32x4*)(WT + (size_t)(n0 + nn) * Kpad + k0 + 8 * c) = o; }
    asm volatile("s_waitcnt lgkmcnt(0)" ::: "memory");
}

struct P { const float* in[39]; float* out; unsigned char* ws; };

__device__ __forceinline__ void row_info(int row, int& t, int& len, int& b, bool& prompt) {
    if (row < MPROMPT) { prompt = true; b = row >> 13; t = row & 8191; len = 8192; }
    else { prompt = false; const int rr = row - MPROMPT; b = rr >> 6; t = rr & 63; len = 64; }
}

__device__ __forceinline__ const float* ldp(const unsigned long long* tab, int i) {
    const unsigned long long v = tab[i];
    const unsigned lo = __builtin_amdgcn_readfirstlane((unsigned)v), hi = __builtin_amdgcn_readfirstlane((unsigned)(v >> 32));
    return (const float*)(((unsigned long long)hi << 32) | lo);
}
#define IN(k) ldp(tab, (k))
#define OUTP ((float*)ldp(tab, 39))
#define BASES float* X = (float*)ldp(tab, 39); unsigned char* ws_ = (unsigned char*)ldp(tab, 40); bf16_t* WT = (bf16_t*)(ws_ + WS_WT); unsigned char* RA = ws_ + WS_A; unsigned char* RB = ws_ + WS_B; \
    bf16_t* VFIRST = (bf16_t*)(ws_ + WS_VF); LAS unsigned char* ldsl = (LAS unsigned char*)lds; (void)X; (void)WT; (void)RA; (void)RB; (void)VFIRST; (void)ldsl;
#define RWKV_PTRS bf16_t* HB = (bf16_t*)RA; bf16_t* Rb = (bf16_t*)RB; bf16_t* Kb = Rb + ACT; bf16_t* Vb = (jl == 0) ? VFIRST : Kb + ACT; bf16_t* Lb = (bf16_t*)(RB + 204 * MiB); \
    float* DD = (float*)(RB + 240 * MiB); bf16_t* AA = (bf16_t*)RA; bf16_t* VG = AA + ACT; bf16_t* GG = VG + ACT; bf16_t* Y = GG + ACT; \
    bf16_t* W1 = WT + jl * RW_SZ; bf16_t* W2 = W1 + (size_t)7168 * 2048; bf16_t* WO = W2 + (size_t)8192 * 256; \
    (void)HB; (void)Rb; (void)Kb; (void)Vb; (void)Lb; (void)DD; (void)AA; (void)VG; (void)GG; (void)Y; (void)W1; (void)W2; (void)WO;
#define GLA_PTRS bf16_t* H = (bf16_t*)RB; float* LR = (float*)(RB + 68 * MiB); float* O = (float*)(RB + 70 * MiB); bf16_t* Y = (bf16_t*)(RB + 206 * MiB); \
    bf16_t* PROJ = (bf16_t*)RA; bf16_t* QE = (bf16_t*)(RA + 204 * MiB); bf16_t* KDT = (bf16_t*)(RA + 238 * MiB); bf16_t* VT = (bf16_t*)(RA + 272 * MiB); \
    bf16_t* SC = (bf16_t*)(RA + 340 * MiB); float* EL = (float*)(RA + 349 * MiB); bf16_t* GI = WT + GW_OFF + jl * GW_SZ; bf16_t* GO = GI + (size_t)6400 * 2048; \
    (void)H; (void)LR; (void)O; (void)Y; (void)PROJ; (void)QE; (void)KDT; (void)VT; (void)SC; (void)EL; (void)GI; (void)GO;
#define FFN_PTRS bf16_t* H = (bf16_t*)RB; bf16_t* HID = (bf16_t*)(RB + 68 * MiB); bf16_t* U = (bf16_t*)RA; bf16_t* WU = WT + FW_OFF + layer * FW_SZ; bf16_t* WD = WU + (size_t)F2 * 2048; \
    (void)H; (void)HID; (void)U; (void)WU; (void)WD;

__global__ void __launch_bounds__(512, 2) fwd_kernel(P p) {
    extern __shared__ __attribute__((aligned(16))) unsigned char lds[];
    cg::grid_group grid = cg::this_grid();
    const int G = gridDim.x, NGW = G * 8, NT = G * 512;
#define PHASE_IDS int tid = threadIdx.x; asm volatile("" : "+v"(tid)); const int lane = tid & 63; const int wave = __builtin_amdgcn_readfirstlane(tid >> 6); const int gw = blockIdx.x * 8 + wave; const int gtid = blockIdx.x * 512 + tid; (void)lane; (void)gw; (void)gtid;
    unsigned long long* tab = (unsigned long long*)(lds + LDS_BYTES - 512);
    if (threadIdx.x == 0) {
#pragma unroll
        for (int i = 0; i < 39; ++i) tab[i] = (unsigned long long)p.in[i];
        tab[39] = (unsigned long long)p.out; tab[40] = (unsigned long long)p.ws;
    }
    __syncthreads();

    {
        PHASE_IDS BASES
        float* scr = (float*)(lds + wave * 16384);
#define TR(src, K, N, dst, Kpad, Npad) do { const int _ni = ((Kpad) / 64) * ((Npad) / 32); for (int it = gw; it < _ni; it += NGW) tr_item((src), (K), (N), (dst), (Kpad), (Npad), scr, it, lane); } while (0)
#pragma unroll 1
        for (int j = 0; j < 2; ++j) {
            bf16_t* W1 = WT + j * RW_SZ; bf16_t* W2 = W1 + (size_t)7168 * 2048; bf16_t* WO = W2 + (size_t)8192 * 256;
            TR(IN(24) + (size_t)j * DM * DM, 2048, 2048, W1, 2048, 2048);
            TR(IN(25) + (size_t)j * DM * DM, 2048, 2048, W1 + (size_t)2048 * 2048, 2048, 2048);
            TR(IN(26) + (size_t)j * DM * DM, 2048, 2048, W1 + (size_t)4096 * 2048, 2048, 2048);
            TR(IN(11) + (size_t)j * DM * 96, 2048, 96, W1 + (size_t)6144 * 2048, 2048, 256);
            TR(IN(14) + (size_t)j * DM * 96, 2048, 96, W1 + (size_t)6400 * 2048, 2048, 256);
            TR(IN(19) + (size_t)j * DM * 256, 2048, 256, W1 + (size_t)6656 * 2048, 2048, 256);
            if (j >= 1) TR(IN(17) + (size_t)(j - 1) * DM * 64, 2048, 64, W1 + (size_t)6912 * 2048, 2048, 256);
            TR(IN(12) + (size_t)j * 96 * DM, 96, 2048, W2, 256, 2048);
            TR(IN(15) + (size_t)j * 96 * DM, 96, 2048, W2 + (size_t)2048 * 256, 256, 2048);
            TR(IN(20) + (size_t)j * 256 * DM, 256, 2048, W2 + (size_t)4096 * 256, 256, 2048);
            if (j >= 1) TR(IN(18) + (size_t)(j - 1) * 64 * DM, 64, 2048, W2 + (size_t)6144 * 256, 256, 2048);
            TR(IN(27) + (size_t)j * DM * DM, 2048, 2048, WO, 2048, 2048);
            bf16_t* GI = WT + GW_OFF + j * GW_SZ; bf16_t* GO = GI + (size_t)6400 * 2048;
            TR(IN(30) + (size_t)j * DM * 6160, 2048, 6160, GI, 2048, 6400);
            TR(IN(34) + (size_t)j * DM * DM, 2048, 2048, GO, 2048, 2048);
        }
#pragma unroll 1
        for (int i = 0; i < 4; ++i) {
            bf16_t* WU = WT + FW_OFF + i * FW_SZ; bf16_t* WD = WU + (size_t)F2 * 2048;
            TR(IN(35) + (size_t)i * DM * F2, 2048, F2, WU, 2048, F2);
            TR(IN(38) + (size_t)i * FH * DM, FH, 2048, WD, FH, 2048);
        }
#undef TR
        const f32x4* xp = (const f32x4*)IN(0); const f32x4* xs = (const f32x4*)IN(1); f32x4* xo = (f32x4*)X;
        const int NP4 = MPROMPT * DM / 4, NA4 = MROWS * DM / 4;
        for (int i = gtid; i < NA4; i += NT) xo[i] = i < NP4 ? xp[i] : xs[i - NP4];
    }
    grid.sync();

#pragma clang loop unroll(full)
    for (int layer = 0; layer < 4; ++layer) {
        const int jl = layer >> 1;
        if ((layer & 1) == 0) {
            {
                PHASE_IDS BASES RWKV_PTRS
                const float* gmix = IN(6) + (size_t)layer * DM;
                const float* mix = IN(9) + (size_t)jl * 6 * DM;
                const float* sst = IN(2) + (size_t)jl * 16 * DM;
                for (int row = gw; row < MROWS; row += NGW) {
                    int t, len, b; bool prompt; row_info(row, t, len, b, prompt);
                    const f32x4* xr = (const f32x4*)(X + (size_t)row * DM) + lane;
                    f32x4 x[8]; float ss = 0.f;
#pragma unroll
                    for (int q = 0; q < 8; ++q) { x[q] = xr[64 * q]; ss += x[q][0] * x[q][0] + x[q][1] * x[q][1] + x[q][2] * x[q][2] + x[q][3] * x[q][3]; }
                    const float rs = rsqrtf(wave_sum(ss, lane) * (1.f / DM) + 1e-6f);
                    f32x4 hp[8];
                    if (t > 0) {
                        const f32x4* xq = (const f32x4*)(X + (size_t)(row - 1) * DM) + lane; float s2 = 0.f;
#pragma unroll
                        for (int q = 0; q < 8; ++q) { hp[q] = xq[64 * q]; s2 += hp[q][0] * hp[q][0] + hp[q][1] * hp[q][1] + hp[q][2] * hp[q][2] + hp[q][3] * hp[q][3]; }
                        const float rp = rsqrtf(wave_sum(s2, lane) * (1.f / DM) + 1e-6f);
#pragma unroll
                        for (int q = 0; q < 8; ++q) { const f32x4 gg = *((const f32x4*)gmix + lane + 64 * q); hp[q] = hp[q] * rp * gg; }
                    } else if (!prompt) {
#pragma unroll
                        for (int q = 0; q < 8; ++q) hp[q] = *((const f32x4*)(sst + (size_t)b * DM) + lane + 64 * q);
                    } else {
#pragma unroll
                        for (int q = 0; q < 8; ++q) hp[q] = (f32x4){0.f, 0.f, 0.f, 0.f};
                    }
                    const bool lastrow = (t == len - 1);
                    float* shout = OUTP + (prompt ? O_PSHIFT + ((size_t)jl * 2 + b) * DM : O_SSHIFT + ((size_t)jl * 16 + b) * DM);
#pragma unroll
                    for (int q = 0; q < 8; ++q) {
                        const f32x4 gg = *((const f32x4*)gmix + lane + 64 * q);
                        const f32x4 h = x[q] * rs * gg; const f32x4 dlt = hp[q] - h;
                        if (lastrow) *((f32x4*)shout + lane + 64 * q) = h;
#pragma unroll
                        for (int m = 0; m < 6; ++m) {
                            const f32x4 mx = *((const f32x4*)(mix + (size_t)m * DM) + lane + 64 * q);
                            const f32x4 o = h + dlt * mx;
                            u32x2 w; w.x = cvt_pk_bf16(o[0], o[1]); w.y = cvt_pk_bf16(o[2], o[3]);
                            *((u32x2*)(HB + (size_t)m * ACT + (size_t)row * DM) + lane + 64 * q) = w;
                        }
                    }
                }
            }
            grid.sync();
            {
                BASES RWKV_PTRS
                pg8::Gemm g{HB, W1, MROWS, jl == 0 ? 6912 : 7168, 2048, 1, ACT * 2};
                pg8::StaticOrder S; S.init(g.M, g.N, G, (int)blockIdx.x);
                pg8::Epi<FR1> E{FR1{Rb, Kb, Vb, Lb}};
                pg8::gemm_phase(ldsl, g, S, E);
            }
            grid.sync();
            {
                BASES RWKV_PTRS
                pg8::Gemm g{Lb, W2, MROWS, jl == 0 ? 6144 : 8192, 256, 2, (size_t)MROWS * 256 * 2};
                pg8::StaticOrder S; S.init(g.M, g.N, G, (int)blockIdx.x);
                pg8::Epi<FR2> E{FR2{DD, AA, GG, VG, IN(10) + (size_t)jl * DM, IN(13) + (size_t)jl * DM, IN(16) + (size_t)(jl > 0 ? jl - 1 : 0) * DM}};
                pg8::gemm_phase(ldsl, g, S, E);
            }
            grid.sync();
            {
                PHASE_IDS BASES RWKV_PTRS
                float* sm = (float*)lds;
                float* sD = sm; float* sKK = sm + 4096; float* sKA = sm + 8192; float* sKM = sm + 12288; float* sR = sm + 16384; float* sVV = sm + 20480;
                float* sO = sm + 24576; float* sRed = sm + 28672; float* sRedO = sm + 29696; float* sRK = sm + 30720;
                const float* k_k = IN(21) + (size_t)jl * DM; const float* k_a = IN(22) + (size_t)jl * DM; const float* r_k = IN(23) + (size_t)jl * DM;
                const float* lnw = IN(28) + (size_t)jl * DM; const float* lnb = IN(29) + (size_t)jl * DM;
                for (int u = blockIdx.x; u < 576; u += G) {
                    const bool prompt = u < 64; int b, h, base, nblk;
                    if (prompt) { b = u >> 5; h = u & 31; base = b * 8192; nblk = 128; }
                    else { const int su = u - 64; b = su >> 5; h = su & 31; base = MPROMPT + b * 64; nblk = 1; }
                    float S[8];
                    if (prompt) {
#pragma unroll
                        for (int i = 0; i < 8; ++i) S[i] = 0.f;
                    } else {
                        const float* s0 = IN(3) + ((((size_t)jl * 16 + b) * 32 + h) * 64 + lane) * 64 + wave * 8;
                        const f32x4 a = *(const f32x4*)s0, c = *(const f32x4*)(s0 + 4);
                        S[0] = a[0]; S[1] = a[1]; S[2] = a[2]; S[3] = a[3]; S[4] = c[0]; S[5] = c[1]; S[6] = c[2]; S[7] = c[3];
                    }
#pragma unroll 1
                    for (int tb = 0; tb < nblk; ++tb) {
                        const int st = tid >> 3, c0 = (tid & 7) * 8; const int srow = base + tb * 64 + st; const int col = h * 64 + c0;
                        const size_t off = (size_t)srow * DM + col;
                        {
                            float r[8], k[8], v[8], a[8];
                            unpack8(*(const u32x4*)(Rb + off), r); unpack8(*(const u32x4*)(Kb + off), k); unpack8(*(const u32x4*)(Vb + off), v); unpack8(*(const u32x4*)(AA + off), a);
                            const f32x4 d0 = *(const f32x4*)(DD + off), d1 = *(const f32x4*)(DD + off + 4);
                            if (jl > 0) { float vf[8], vg[8]; unpack8(*(const u32x4*)(VFIRST + off), vf); unpack8(*(const u32x4*)(VG + off), vg);
#pragma unroll
                                for (int i = 0; i < 8; ++i) v[i] = v[i] + (vf[i] - v[i]) * vg[i]; }
                            float kkv[8]; float ss = 0.f;
#pragma unroll
                            for (int i = 0; i < 8; ++i) { kkv[i] = k[i] * k_k[col + i]; ss += kkv[i] * kkv[i]; }
                            ss = sum8(ss, lane);
                            const float inv = 1.f / fmaxf(sqrtf(ss), 1e-12f);
                            float rk = 0.f; float kk[8], ka[8], km[8];
#pragma unroll
                            for (int i = 0; i < 8; ++i) { kk[i] = kkv[i] * inv; ka[i] = kk[i] * a[i]; km[i] = k[i] * (1.f + (a[i] - 1.f) * k_a[col + i]); rk += r[i] * km[i] * r_k[col + i]; }
                            rk = sum8(rk, lane);
                            if ((tid & 7) == 0) sRK[st] = rk;
                            const int so = st * 64 + c0;
                            *(f32x4*)(sD + so) = d0; *(f32x4*)(sD + so + 4) = d1;
                            *(f32x4*)(sKK + so) = (f32x4){kk[0], kk[1], kk[2], kk[3]}; *(f32x4*)(sKK + so + 4) = (f32x4){kk[4], kk[5], kk[6], kk[7]};
                            *(f32x4*)(sKA + so) = (f32x4){ka[0], ka[1], ka[2], ka[3]}; *(f32x4*)(sKA + so + 4) = (f32x4){ka[4], ka[5], ka[6], ka[7]};
                            *(f32x4*)(sKM + so) = (f32x4){km[0], km[1], km[2], km[3]}; *(f32x4*)(sKM + so + 4) = (f32x4){km[4], km[5], km[6], km[7]};
                            *(f32x4*)(sR + so) = (f32x4){r[0], r[1], r[2], r[3]}; *(f32x4*)(sR + so + 4) = (f32x4){r[4], r[5], r[6], r[7]};
                            *(f32x4*)(sVV + so) = (f32x4){v[0], v[1], v[2], v[3]}; *(f32x4*)(sVV + so + 4) = (f32x4){v[4], v[5], v[6], v[7]};
                        }
                        __syncthreads();
#pragma unroll 1
                        for (int t = 0; t < 64; ++t) {
                            const int ko = t * 64 + wave * 8; const int par = (t & 1) * 512;
                            const f32x4 k0 = *(const f32x4*)(sKK + ko), k1 = *(const f32x4*)(sKK + ko + 4);
                            float pp = S[0] * k0[0] + S[1] * k0[1] + S[2] * k0[2] + S[3] * k0[3] + S[4] * k1[0] + S[5] * k1[1] + S[6] * k1[2] + S[7] * k1[3];
                            sRed[par + wave * 64 + lane] = pp;
                            const f32x4 d0 = *(const f32x4*)(sD + ko), d1 = *(const f32x4*)(sD + ko + 4);
                            const f32x4 a0 = *(const f32x4*)(sKA + ko), a1 = *(const f32x4*)(sKA + ko + 4);
                            const f32x4 m0 = *(const f32x4*)(sKM + ko), m1 = *(const f32x4*)(sKM + ko + 4);
                            const f32x4 r0 = *(const f32x4*)(sR + ko), r1 = *(const f32x4*)(sR + ko + 4);
                            const float vv = sVV[t * 64 + lane];
                            __syncthreads();
                            float sa = 0.f;
#pragma unroll
                            for (int w = 0; w < 8; ++w) sa += sRed[par + w * 64 + lane];
                            sa = -sa;
                            if (t > 0 && wave == ((t - 1) & 7)) { float o = 0.f; const int pq = ((t - 1) & 1) * 512;
#pragma unroll
                                for (int w = 0; w < 8; ++w) o += sRedO[pq + w * 64 + lane];
                                sO[(t - 1) * 64 + lane] = o; }
                            S[0] = S[0] * d0[0] + sa * a0[0] + vv * m0[0]; S[1] = S[1] * d0[1] + sa * a0[1] + vv * m0[1];
                            S[2] = S[2] * d0[2] + sa * a0[2] + vv * m0[2]; S[3] = S[3] * d0[3] + sa * a0[3] + vv * m0[3];
                            S[4] = S[4] * d1[0] + sa * a1[0] + vv * m1[0]; S[5] = S[5] * d1[1] + sa * a1[1] + vv * m1[1];
                            S[6] = S[6] * d1[2] + sa * a1[2] + vv * m1[2]; S[7] = S[7] * d1[3] + sa * a1[3] + vv * m1[3];
                            const float qq = S[0] * r0[0] + S[1] * r0[1] + S[2] * r0[2] + S[3] * r0[3] + S[4] * r1[0] + S[5] * r1[1] + S[6] * r1[2] + S[7] * r1[3];
                            sRedO[par + wave * 64 + lane] = qq;
                        }
                        __syncthreads();
                        if (wave == 7) { float o = 0.f;
#pragma unroll
                            for (int w = 0; w < 8; ++w) o += sRedO[512 + w * 64 + lane];
                            sO[63 * 64 + lane] = o; }
                        __syncthreads();
                        {
                            const int so = st * 64 + c0;
                            const f32x4 o0 = *(const f32x4*)(sO + so), o1 = *(const f32x4*)(sO + so + 4);
                            float o[8] = {o0[0], o0[1], o0[2], o0[3], o1[0], o1[1], o1[2], o1[3]};
                            float s = 0.f;
#pragma unroll
                            for (int i = 0; i < 8; ++i) s += o[i];
                            const float mu = sum8(s, lane) * (1.f / 64.f); float q = 0.f;
#pragma unroll
                            for (int i = 0; i < 8; ++i) { o[i] -= mu; q += o[i] * o[i]; }
                            const float rstd = rsqrtf(sum8(q, lane) * (1.f / 64.f) + 64e-5f);
                            float g8[8]; unpack8(*(const u32x4*)(GG + off), g8);
                            const float rk = sRK[st];
                            float y[8];
#pragma unroll
                            for (int i = 0; i < 8; ++i) y[i] = (o[i] * rstd * lnw[col + i] + lnb[col + i] + rk * sVV[so + i]) * g8[i];
                            *(u32x4*)(Y + off) = pack8(y);
                        }
                        __syncthreads();
                    }
                    float* so_ = OUTP + (prompt ? O_PWKV + ((((size_t)jl * 2 + b) * 32 + h) * 64 + lane) * 64 + wave * 8
                                                 : O_SWKV + ((((size_t)jl * 16 + b) * 32 + h) * 64 + lane) * 64 + wave * 8);
                    *(f32x4*)so_ = (f32x4){S[0], S[1], S[2], S[3]}; *(f32x4*)(so_ + 4) = (f32x4){S[4], S[5], S[6], S[7]};
                }
            }
            grid.sync();
            {
                BASES RWKV_PTRS
                pg8::Gemm g{Y, WO, MROWS, 2048, 2048, 0, 0};
                pg8::StaticOrder S; S.init(g.M, g.N, G, (int)blockIdx.x);
                pg8::Epi<FRes> E{FRes{X}};
                pg8::gemm_phase(ldsl, g, S, E);
            }
            grid.sync();
        } else {
            { PHASE_IDS BASES GLA_PTRS
            const float* gmix = IN(6) + (size_t)layer * DM;
            for (int row = gw; row < MROWS; row += NGW) {
                const f32x4* xr = (const f32x4*)(X + (size_t)row * DM) + lane; f32x4 x[8]; float ss = 0.f;
#pragma unroll
                for (int q = 0; q < 8; ++q) { x[q] = xr[64 * q]; ss += x[q][0] * x[q][0] + x[q][1] * x[q][1] + x[q][2] * x[q][2] + x[q][3] * x[q][3]; }
                const float rs = rsqrtf(wave_sum(ss, lane) * (1.f / DM) + 1e-6f);
#pragma unroll
                for (int q = 0; q < 8; ++q) { const f32x4 gg = *((const f32x4*)gmix + lane + 64 * q); const f32x4 h = x[q] * rs * gg;
                    u32x2 w; w.x = cvt_pk_bf16(h[0], h[1]); w.y = cvt_pk_bf16(h[2], h[3]); *((u32x2*)(H + (size_t)row * DM) + lane + 64 * q) = w; }
            } }
            grid.sync();
            {
                BASES GLA_PTRS
                pg8::Gemm g{H, GI, MROWS, 6400, 2048, 0, 0};
                pg8::StaticOrder S; S.init(g.M, g.N, G, (int)blockIdx.x);
                pg8::Epi<FG1> E{FG1{PROJ, LR}};
                pg8::gemm_phase(ldsl, g, S, E);
            }
            grid.sync();
            {
                PHASE_IDS BASES GLA_PTRS
                float* lrS = (float*)lds;
                float* w2S = (float*)(lds + 4096);
                float* totS = (float*)(lds + 20480);
                bf16_t* qeS = (bf16_t*)(lds + 22528);
                bf16_t* keS = (bf16_t*)(lds + 22528 + 33792);
                bf16_t* vS = qeS;
                const float* gw2 = IN(31) + (size_t)jl * 16 * 1024; const float* gkb = IN(32) + (size_t)jl * 1024;
#pragma unroll 1
                for (int it = blockIdx.x; it < 1088; it += G) {
                    const int c = it >> 2, h = it & 3, r0 = c * 64; const size_t base = (size_t)it;
                    if (tid < 256) *(f32x4*)(lrS + tid * 4) = *(const f32x4*)(LR + (size_t)r0 * 16 + tid * 4);
                    for (int q = tid; q < 1024; q += 512) { const int r = q >> 6, cc = (q & 63) * 4; *(f32x4*)(w2S + r * 256 + cc) = *(const f32x4*)(gw2 + (size_t)r * 1024 + h * 256 + cc); }
                    __syncthreads();
                    const int d = tid & 255, half = tid >> 8;
                    float cumv[32];
                    {
                        float w[16];
#pragma unroll
                        for (int r = 0; r < 16; ++r) w[r] = w2S[r * 256 + d];
                        const float bb = gkb[h * 256 + d]; float run = 0.f;
#pragma unroll
                        for (int tt = 0; tt < 32; ++tt) {
                            const float* lp = lrS + (half * 32 + tt) * 16; float z = bb;
#pragma unroll
                            for (int r = 0; r < 16; ++r) z += lp[r] * w[r];
                            const float g = (fminf(z, 0.f) - log1pf(__expf(-fabsf(z)))) * 0.0625f;
                            run += g; cumv[tt] = run;
                        }
                        totS[half * 256 + d] = run;
                    }
                    __syncthreads();
                    {
                        const float t0 = totS[d], t1 = totS[256 + d]; const float last = t0 + t1, offc = half ? t0 : 0.f;
                        if (half == 0) EL[base * 256 + d] = __expf(last);
                        unsigned kdp[16];
#pragma unroll
                        for (int tt = 0; tt < 32; tt += 2) {
                            float kd2[2];
#pragma unroll
                            for (int e = 0; e < 2; ++e) {
                                const int t = half * 32 + tt + e; const float cum = cumv[tt + e] + offc;
                                const size_t po = (size_t)(r0 + t) * 6144 + h * 256 + d;
                                const float q = bf2f(PROJ[po]), k = bf2f(PROJ[po + 1024]);
                                const float qe = q * __expf(cum), ke = k * __expf(-cum); kd2[e] = k * __expf(last - cum);
                                const unsigned pq = cvt_pk_bf16(qe, ke);
                                qeS[t * 264 + d] = (bf16_t)(pq & 0xffffu); keS[t * 264 + d] = (bf16_t)(pq >> 16);
                                QE[(size_t)(r0 + t) * 1024 + h * 256 + d] = (bf16_t)(pq & 0xffffu);
                            }
                            kdp[tt >> 1] = cvt_pk_bf16(kd2[0], kd2[1]);
                        }
                        u32x4* kdst = (u32x4*)(KDT + (base * 256 + d) * 64 + half * 32);
                        kdst[0] = (u32x4){kdp[0], kdp[1], kdp[2], kdp[3]}; kdst[1] = (u32x4){kdp[4], kdp[5], kdp[6], kdp[7]};
                        kdst[2] = (u32x4){kdp[8], kdp[9], kdp[10], kdp[11]}; kdst[3] = (u32x4){kdp[12], kdp[13], kdp[14], kdp[15]};
                    }
                    __syncthreads();
                    if (wave < 4) {
                        const int mi = wave >> 1, ni = wave & 1, l32 = lane & 31, hl = lane >> 5;
                        f32x16 cacc;
#pragma unroll
                        for (int i = 0; i < 16; ++i) cacc[i] = 0.f;
#pragma unroll
                        for (int kk = 0; kk < 16; ++kk) {
                            const bf16x8 a = *(const bf16x8*)(qeS + (mi * 32 + l32) * 264 + kk * 16 + hl * 8);
                            const bf16x8 b = *(const bf16x8*)(keS + (ni * 32 + l32) * 264 + kk * 16 + hl * 8);
                            cacc = __builtin_amdgcn_mfma_f32_32x32x16_bf16(a, b, cacc, 0, 0, 0);
                        }
#pragma unroll
                        for (int i = 0; i < 16; ++i) { const int ii = mi * 32 + crow(i, hl), jj = ni * 32 + l32;
                            const float v = (jj <= ii) ? cacc[i] : 0.f; SC[base * 4096 + ii * 64 + jj] = (bf16_t)(cvt_pk_bf16(v, 0.f) & 0xffffu); }
                    }
                    __syncthreads();
                    for (int q = tid; q < 4096; q += 512) { const int t = q >> 6, cc = (q & 63) * 8;
                        *(u32x4*)(vS + t * 520 + cc) = *(const u32x4*)(PROJ + (size_t)(r0 + t) * 6144 + 2048 + h * 512 + cc); }
                    __syncthreads();
                    {
                        const int dv = tid; u32x4* vdst = (u32x4*)(VT + (base * 512 + dv) * 64);
#pragma unroll
                        for (int q = 0; q < 8; ++q) {
                            unsigned w[4];
#pragma unroll
                            for (int e = 0; e < 4; ++e) { const unsigned lo = vS[(q * 8 + 2 * e) * 520 + dv], hi = vS[(q * 8 + 2 * e + 1) * 520 + dv]; w[e] = lo | (hi << 16); }
                            vdst[q] = (u32x4){w[0], w[1], w[2], w[3]};
                        }
                    }
                    __syncthreads();
                }
            }
            grid.sync();
            {
                PHASE_IDS BASES GLA_PTRS
                float* red = (float*)lds;
                const int l32 = lane & 31, hl = lane >> 5;
#pragma unroll 1
                for (int u = blockIdx.x; u < 1152; u += G) {
                    const bool prompt = u < 128; int b, h, s, cg0, nch, row0;
                    if (prompt) { b = u >> 6; h = (u >> 4) & 3; s = u & 15; cg0 = b * 128; nch = 128; row0 = b * 8192; }
                    else { const int su = u - 128; b = su >> 6; h = (su >> 4) & 3; s = su & 15; cg0 = 256 + b; nch = 1; row0 = MPROMPT + b * 64; }
                    f32x16 S;
                    if (prompt) {
#pragma unroll
                        for (int i = 0; i < 16; ++i) S[i] = 0.f;
                    } else {
                        const float* s0 = IN(4) + ((((size_t)jl * 16 + b) * 4 + h) * 256) * 512;
#pragma unroll
                        for (int i = 0; i < 16; ++i) S[i] = s0[(size_t)(32 * wave + crow(i, hl)) * 512 + 32 * s + l32];
                    }
#pragma unroll 1
                    for (int c = 0; c < nch; ++c) {
                        const size_t base = (size_t)(cg0 + c) * 4 + h; const int r0 = row0 + c * 64;
                        const bf16_t* kdt = KDT + base * 256 * 64; const bf16_t* vt = VT + base * 512 * 64; const bf16_t* sc = SC + base * 4096;
                        bf16x8 ka[4], vb[4];
#pragma unroll
                        for (int ks = 0; ks < 4; ++ks) { ka[ks] = *(const bf16x8*)(kdt + (32 * wave + l32) * 64 + 16 * ks + 8 * hl); vb[ks] = *(const bf16x8*)(vt + (32 * s + l32) * 64 + 16 * ks + 8 * hl); }
                        f32x4 el[4];
#pragma unroll
                        for (int g = 0; g < 4; ++g) el[g] = *(const f32x4*)(EL + base * 256 + 32 * wave + 8 * g + 4 * hl);
                        bf16x8 qf[2][2];
#pragma unroll
                        for (int mt = 0; mt < 2; ++mt)
#pragma unroll
                            for (int s2 = 0; s2 < 2; ++s2) { const bf16_t* pq = QE + (size_t)(r0 + mt * 32 + l32) * 1024 + h * 256 + 32 * wave + 16 * s2 + 4 * hl;
                                const u32x2 lo = *(const u32x2*)pq, hi = *(const u32x2*)(pq + 8); const u32x4 w = (u32x4){lo.x, lo.y, hi.x, hi.y}; qf[mt][s2] = __builtin_bit_cast(bf16x8, w); }
                        const int mtw = wave & 1, ksw = wave >> 1;
                        const bf16x8 scf = *(const bf16x8*)(sc + (mtw * 32 + l32) * 64 + 16 * ksw + 8 * hl);
                        u32x4 sp0, sp1;
                        sp0.x = cvt_pk_bf16(S[0], S[1]); sp0.y = cvt_pk_bf16(S[2], S[3]); sp0.z = cvt_pk_bf16(S[4], S[5]); sp0.w = cvt_pk_bf16(S[6], S[7]);
                        sp1.x = cvt_pk_bf16(S[8], S[9]); sp1.y = cvt_pk_bf16(S[10], S[11]); sp1.z = cvt_pk_bf16(S[12], S[13]); sp1.w = cvt_pk_bf16(S[14], S[15]);
                        const bf16x8 sb0 = __builtin_bit_cast(bf16x8, sp0), sb1 = __builtin_bit_cast(bf16x8, sp1);
                        f32x16 o0, o1;
#pragma unroll
                        for (int i = 0; i < 16; ++i) { o0[i] = 0.f; o1[i] = 0.f; }
                        o0 = __builtin_amdgcn_mfma_f32_32x32x16_bf16(qf[0][0], sb0, o0, 0, 0, 0); o0 = __builtin_amdgcn_mfma_f32_32x32x16_bf16(qf[0][1], sb1, o0, 0, 0, 0);
                        o1 = __builtin_amdgcn_mfma_f32_32x32x16_bf16(qf[1][0], sb0, o1, 0, 0, 0); o1 = __builtin_amdgcn_mfma_f32_32x32x16_bf16(qf[1][1], sb1, o1, 0, 0, 0);
                        bf16x8 vbw = ksw == 0 ? vb[0] : ksw == 1 ? vb[1] : ksw == 2 ? vb[2] : vb[3];
                        if (mtw == 0) o0 = __builtin_amdgcn_mfma_f32_32x32x16_bf16(scf, vbw, o0, 0, 0, 0);
                        else o1 = __builtin_amdgcn_mfma_f32_32x32x16_bf16(scf, vbw, o1, 0, 0, 0);
#pragma unroll
                        for (int i = 0; i < 16; ++i) S[i] *= el[i >> 2][i & 3];
#pragma unroll
                        for (int ks = 0; ks < 4; ++ks) S = __builtin_amdgcn_mfma_f32_32x32x16_bf16(ka[ks], vb[ks], S, 0, 0, 0);
#pragma unroll
                        for (int q = 0; q < 16; ++q) { red[(wave * 32 + q) * 64 + lane] = o0[q]; red[(wave * 32 + 16 + q) * 64 + lane] = o1[q]; }
                        __syncthreads();
                        {
                            const int q = tid >> 4, lg = tid & 15; f32x4 sum = (f32x4){0.f, 0.f, 0.f, 0.f};
#pragma unroll
                            for (int w = 0; w < 8; ++w) sum += *(const f32x4*)(red + (w * 32 + q) * 64 + 4 * lg);
                            const int mt = q >> 4, reg = q & 15, L = 4 * lg; const int i = mt * 32 + crow(reg, L >> 5), dv = L & 31;
                            *(f32x4*)(O + (size_t)(r0 + i) * DM + h * 512 + 32 * s + dv) = sum;
                        }
                        __syncthreads();
                    }
                    float* dst = OUTP + (prompt ? O_PGLA + ((((size_t)jl * 2 + b) * 4 + h) * 256) * 512 : O_SGLA + ((((size_t)jl * 16 + b) * 4 + h) * 256) * 512);
#pragma unroll
                    for (int i = 0; i < 16; ++i) dst[(size_t)(32 * wave + crow(i, hl)) * 512 + 32 * s + l32] = S[i];
                }
            }
            grid.sync();
            {
                PHASE_IDS BASES GLA_PTRS
                const float* hn = IN(33) + (size_t)jl * 512;
                for (int row = gw; row < MROWS; row += NGW) {
#pragma unroll
                    for (int h = 0; h < 4; ++h) {
                        const float* op = O + (size_t)row * DM + h * 512 + lane * 8;
                        const f32x4 a = *(const f32x4*)op, b = *(const f32x4*)(op + 4);
                        float ss = a[0] * a[0] + a[1] * a[1] + a[2] * a[2] + a[3] * a[3] + b[0] * b[0] + b[1] * b[1] + b[2] * b[2] + b[3] * b[3];
                        const float rs = rsqrtf(wave_sum(ss, lane) * (1.f / 512.f) + 1e-5f);
                        float gt[8]; unpack8(*(const u32x4*)(PROJ + (size_t)row * 6144 + 4096 + h * 512 + lane * 8), gt);
                        const f32x4 n0 = *(const f32x4*)(hn + lane * 8), n1 = *(const f32x4*)(hn + lane * 8 + 4);
                        float y[8];
#pragma unroll
                        for (int i = 0; i < 4; ++i) { y[i] = a[i] * rs * n0[i] * (gt[i] * sigmoidf_(gt[i])); y[4 + i] = b[i] * rs * n1[i] * (gt[4 + i] * sigmoidf_(gt[4 + i])); }
                        *(u32x4*)(Y + (size_t)row * DM + h * 512 + lane * 8) = pack8(y);
                    }
                }
            }
            grid.sync();
            {
                BASES GLA_PTRS
                pg8::Gemm g{Y, GO, MROWS, 2048, 2048, 0, 0};
                pg8::StaticOrder S; S.init(g.M, g.N, G, (int)blockIdx.x);
                pg8::Epi<FRes> E{FRes{X}};
                pg8::gemm_phase(ldsl, g, S, E);
            }
            grid.sync();
        }
        {
            { PHASE_IDS BASES FFN_PTRS
            const float* gf = IN(7) + (size_t)layer * DM;
            for (int row = gw; row < MROWS; row += NGW) {
                const f32x4* xr = (const f32x4*)(X + (size_t)row * DM) + lane; f32x4 x[8]; float ss = 0.f;
#pragma unroll
                for (int q = 0; q < 8; ++q) { x[q] = xr[64 * q]; ss += x[q][0] * x[q][0] + x[q][1] * x[q][1] + x[q][2] * x[q][2] + x[q][3] * x[q][3]; }
                const float rs = rsqrtf(wave_sum(ss, lane) * (1.f / DM) + 1e-6f);
#pragma unroll
                for (int q = 0; q < 8; ++q) { const f32x4 gg = *((const f32x4*)gf + lane + 64 * q); const f32x4 h = x[q] * rs * gg;
                    u32x2 w; w.x = cvt_pk_bf16(h[0], h[1]); w.y = cvt_pk_bf16(h[2], h[3]); *((u32x2*)(H + (size_t)row * DM) + lane + 64 * q) = w; }
            } }
            grid.sync();
            {
                BASES FFN_PTRS
                pg8::Gemm g{H, WU, MROWS, F2, 2048, 0, 0};
                pg8::StaticOrder S; S.init(g.M, g.N, G, (int)blockIdx.x);
                pg8::Epi<FUp> E{FUp{U, OUTP + O_PCONV + (size_t)layer * 2 * 2 * F2, OUTP + O_SCONV + (size_t)layer * 16 * 2 * F2}};
                pg8::gemm_phase(ldsl, g, S, E);
            }
            grid.sync();
            {
                PHASE_IDS BASES FFN_PTRS
                const float* cw = IN(36) + (size_t)layer * 3 * F2; const float* cb = IN(37) + (size_t)layer * F2;
                const float* cst = IN(5) + (size_t)layer * 16 * 2 * F2;
#pragma unroll 1
                for (int it = gtid; it < 544 * 704; it += NT) {
                    const int rc = it / 704, c8 = it - rc * 704, col = c8 * 8, r0 = rc * 32;
                    int t0, len, b; bool prompt; row_info(r0, t0, len, b, prompt);
                    float wv[3][8], wg[3][8], bv[8], bg[8];
#pragma unroll
                    for (int k = 0; k < 3; ++k) { const f32x4 a = *(const f32x4*)(cw + (size_t)k * F2 + col), a2 = *(const f32x4*)(cw + (size_t)k * F2 + col + 4);
                        const f32x4 g = *(const f32x4*)(cw + (size_t)k * F2 + FH + col), g2 = *(const f32x4*)(cw + (size_t)k * F2 + FH + col + 4);
#pragma unroll
                        for (int i = 0; i < 4; ++i) { wv[k][i] = a[i]; wv[k][4 + i] = a2[i]; wg[k][i] = g[i]; wg[k][4 + i] = g2[i]; } }
                    { const f32x4 a = *(const f32x4*)(cb + col), a2 = *(const f32x4*)(cb + col + 4), g = *(const f32x4*)(cb + FH + col), g2 = *(const f32x4*)(cb + FH + col + 4);
#pragma unroll
                      for (int i = 0; i < 4; ++i) { bv[i] = a[i]; bv[4 + i] = a2[i]; bg[i] = g[i]; bg[4 + i] = g2[i]; } }
                    float v2[8], v1[8], g2_[8], g1_[8];
                    if (t0 > 0) {
                        unpack8(*(const u32x4*)(U + (size_t)(r0 - 2) * F2 + col), v2); unpack8(*(const u32x4*)(U + (size_t)(r0 - 1) * F2 + col), v1);
                        unpack8(*(const u32x4*)(U + (size_t)(r0 - 2) * F2 + FH + col), g2_); unpack8(*(const u32x4*)(U + (size_t)(r0 - 1) * F2 + FH + col), g1_);
                    } else if (!prompt) {
                        const float* s0 = cst + ((size_t)b * 2) * F2 + col; const float* s1 = s0 + F2;
#pragma unroll
                        for (int i = 0; i < 8; ++i) { v2[i] = s0[i]; v1[i] = s1[i]; g2_[i] = s0[FH + i]; g1_[i] = s1[FH + i]; }
                    } else {
#pragma unroll
                        for (int i = 0; i < 8; ++i) { v2[i] = 0.f; v1[i] = 0.f; g2_[i] = 0.f; g1_[i] = 0.f; }
                    }
#pragma unroll 2
                    for (int r = 0; r < 32; ++r) {
                        float v0[8], g0[8];
                        unpack8(*(const u32x4*)(U + (size_t)(r0 + r) * F2 + col), v0); unpack8(*(const u32x4*)(U + (size_t)(r0 + r) * F2 + FH + col), g0);
                        float y[8];
#pragma unroll
                        for (int i = 0; i < 8; ++i) {
                            const float cv = bv[i] + wv[0][i] * v2[i] + wv[1][i] * v1[i] + wv[2][i] * v0[i];
                            const float cg_ = bg[i] + wg[0][i] * g2_[i] + wg[1][i] * g1_[i] + wg[2][i] * g0[i];
                            y[i] = cg_ * sigmoidf_(cg_) * cv;
                            v2[i] = v1[i]; v1[i] = v0[i]; g2_[i] = g1_[i]; g1_[i] = g0[i];
                        }
                        *(u32x4*)(HID + (size_t)(r0 + r) * FH + col) = pack8(y);
                    }
                }
            }
            grid.sync();
            {
                BASES FFN_PTRS
                pg8::Gemm g{HID, WD, MROWS, 2048, FH, 0, 0};
                pg8::StaticOrder S; S.init(g.M, g.N, G, (int)blockIdx.x);
                pg8::Epi<FRes> E{FRes{X}};
                pg8::gemm_phase(ldsl, g, S, E);
            }
            grid.sync();
        }
    }
    {
        PHASE_IDS BASES
        const float* gn = IN(8);
        for (int row = gw; row < MROWS; row += NGW) {
            f32x4* xr = (f32x4*)(X + (size_t)row * DM) + lane; f32x4 x[8]; float ss = 0.f;
#pragma unroll
            for (int q = 0; q < 8; ++q) { x[q] = xr[64 * q]; ss += x[q][0] * x[q][0] + x[q][1] * x[q][1] + x[q][2] * x[q][2] + x[q][3] * x[q][3]; }
            const float rs = rsqrtf(wave_sum(ss, lane) * (1.f / DM) + 1e-6f);
#pragma unroll
            for (int q = 0; q < 8; ++q) { const f32x4 gg = *((const f32x4*)gn + lane + 64 * q); xr[64 * q] = x[q] * rs * gg; }
        }
    }
}

extern "C" void kernel_launch(void* const* d_in, const int* in_sizes, int n_in, void* d_out, int out_size, void* d_ws, size_t ws_size, hipStream_t stream) {
    static int grid = 0;
    if (grid == 0) {
        if (n_in != 39 || (size_t)out_size != O_TOTAL || ws_size < WS_END) {
            fprintf(stderr, "kernel_launch: unexpected shapes: n_in %d out %d ws %zu (need %zu)\n", n_in, out_size, ws_size, (size_t)WS_END); grid = -1; return; }
        int dev = 0, cus = 0, per_cu = 0;
        (void)hipGetDevice(&dev);
        (void)hipDeviceGetAttribute(&cus, hipDeviceAttributeMultiprocessorCount, dev);
        if (hipFuncSetAttribute((const void*)fwd_kernel, hipFuncAttributeMaxDynamicSharedMemorySize, LDS_BYTES) != hipSuccess) { fprintf(stderr, "kernel_launch: hipFuncSetAttribute failed\n"); grid = -1; return; }
        if (hipOccupancyMaxActiveBlocksPerMultiprocessor(&per_cu, (const void*)fwd_kernel, 512, LDS_BYTES) != hipSuccess || per_cu < 1) { fprintf(stderr, "kernel_launch: occupancy query says %d\n", per_cu); per_cu = 1; }
        (void)hipGetLastError();
        grid = cus * 1;
        if (grid <= 0) grid = 256;
    }
    if (grid < 0) return;
    P prm{};
    for (int i = 0; i < 39; ++i) prm.in[i] = (const float*)d_in[i];
    prm.out = (float*)d_out; prm.ws = (unsigned char*)d_ws;
    void* args[] = {&prm};
    hipError_t e = hipLaunchCooperativeKernel((const void*)fwd_kernel, dim3(grid), dim3(512), args, LDS_BYTES, stream);
    if (e != hipSuccess) fprintf(stderr, "cooperative launch failed: %s (grid %d)\n", hipGetErrorString(e), grid);
}
```

```cpp
#include <hip/hip_runtime.h>
#include <hip/hip_cooperative_groups.h>
#include <cstdio>
#include <cstdint>
namespace cg = cooperative_groups;

#define LAS __attribute__((address_space(3)))
typedef unsigned short bf16_t;
typedef short bf16x8 __attribute__((ext_vector_type(8)));
typedef float f32x4 __attribute__((ext_vector_type(4)));
typedef float f32x16 __attribute__((ext_vector_type(16)));
typedef unsigned u32x4 __attribute__((ext_vector_type(4)));
typedef unsigned u32x2 __attribute__((ext_vector_type(2)));

constexpr int DM = 2048, MROWS = 17408, MPROMPT = 16384;
constexpr int FH = 5632, F2 = 11264;
constexpr int LDS_BYTES = 147456;
constexpr size_t MiB = 1u << 20;
constexpr size_t WS_WT = 1 * MiB;
constexpr size_t WS_A = 411 * MiB;
constexpr size_t WS_B = 819 * MiB;
constexpr size_t WS_VF = 1227 * MiB;
constexpr size_t WS_END = 1295 * MiB;
constexpr size_t ACT = (size_t)MROWS * DM;
constexpr size_t RW_SZ = (size_t)7168 * 2048 + (size_t)8192 * 256 + (size_t)2048 * 2048;
constexpr size_t GW_SZ = (size_t)6400 * 2048 + (size_t)2048 * 2048;
constexpr size_t FW_SZ = (size_t)11264 * 2048 + (size_t)2048 * 5632;
constexpr size_t GW_OFF = 2 * RW_SZ, FW_OFF = GW_OFF + 2 * GW_SZ;
constexpr size_t O_PSHIFT = 35651584, O_PWKV = 35659776, O_PGLA = 36184064, O_PCONV = 38281216;
constexpr size_t O_SSHIFT = 38461440, O_SWKV = 38526976, O_SGLA = 42721280, O_SCONV = 59498496, O_TOTAL = 60940288;

__device__ __forceinline__ unsigned cvt_pk_bf16(float lo, float hi) { unsigned r; asm volatile("v_cvt_pk_bf16_f32 %0, %1, %2" : "=v"(r) : "v"(lo), "v"(hi)); return r; }
__device__ __forceinline__ float bf2f(bf16_t b) { return __builtin_bit_cast(float, (unsigned)b << 16); }
__device__ __forceinline__ float bflo(unsigned u) { return __builtin_bit_cast(float, u << 16); }
__device__ __forceinline__ float bfhi(unsigned u) { return __builtin_bit_cast(float, u & 0xffff0000u); }
__device__ __forceinline__ void unpack8(u32x4 w, float (&f)[8]) {
    f[0] = bflo(w.x); f[1] = bfhi(w.x); f[2] = bflo(w.y); f[3] = bfhi(w.y); f[4] = bflo(w.z); f[5] = bfhi(w.z); f[6] = bflo(w.w); f[7] = bfhi(w.w);
}
__device__ __forceinline__ u32x4 pack8(const float (&f)[8]) {
    u32x4 w; w.x = cvt_pk_bf16(f[0], f[1]); w.y = cvt_pk_bf16(f[2], f[3]); w.z = cvt_pk_bf16(f[4], f[5]); w.w = cvt_pk_bf16(f[6], f[7]); return w;
}
__device__ __forceinline__ float sigmoidf_(float x) { return 1.f / (1.f + __expf(-x)); }
__device__ __forceinline__ float shx(float v, int lane, int o) { return __builtin_bit_cast(float, __builtin_amdgcn_ds_bpermute((lane ^ o) << 2, __builtin_bit_cast(int, v))); }
__device__ __forceinline__ float wave_sum(float v, int lane) {
#pragma unroll
    for (int o = 1; o < 64; o <<= 1) v += shx(v, lane, o);
    return v;
}
__device__ __forceinline__ float sum8(float v, int lane) { v += shx(v, lane, 1); v += shx(v, lane, 2); v += shx(v, lane, 4); return v; }
__device__ __forceinline__ int crow(int reg, int h) { return (reg & 3) + 8 * (reg >> 2) + 4 * h; }

namespace pg8 {
constexpr int BM = 256, BK = 64, HALF = 128, HTB = HALF * BK * 2, STAGE_BYTES = 8 * HTB, NXCD = 8, WGM = 8;
__host__ __device__ __forceinline__ int lds_byte(int r, int c) { const int st = (r >> 4) * 2 + (c >> 5), rr = r & 15, cc = c & 31, ob = rr * 64 + cc * 2; return st * 1024 + (ob ^ (((ob >> 9) & 1) << 5)); }
__host__ __device__ __forceinline__ void stage_rc(int b, int& R, int& C) { const int st = b / 1024, sb = b % 1024, swz = sb ^ (((sb >> 9) & 1) << 5); R = (st >> 1) * 16 + swz / 64; C = (st & 1) * 32 + (swz % 64) / 2; }
__host__ __device__ __forceinline__ int perm32(int rho) { const int n = rho >> 4, i = rho & 15; return 8 * (i >> 2) + 4 * n + (i & 3); }

struct Unit { int pm, pn; };
struct Gemm { const bf16_t* A; const bf16_t* Bt; int M, N, K; int mode; size_t astride; };
__device__ __forceinline__ const char* a_of(const Gemm& g, int pn) {
    int s = 0;
    if (g.mode == 1) s = pn < 8 ? 0 : pn < 16 ? 2 : pn < 24 ? 3 : pn == 24 ? 1 : pn == 25 ? 4 : pn == 26 ? 5 : 3;
    else if (g.mode == 2) s = pn >> 3;
    return (const char*)g.A + (size_t)s * g.astride;
}
struct StaticOrder {
    int nM, nN, nwg, G, c;
    __device__ void init(int M, int N, int G_, int c_) { nM = M / BM; nN = N / BM; nwg = nM * nN; G = G_; c = c_; }
    __device__ bool next(int i, Unit& u) const {
        const long L = (long)i * G + c; if (L >= nwg) return false;
        int wgid = (int)L; { const int q = nwg / NXCD, r = nwg % NXCD, xcd = wgid % NXCD, off = wgid / NXCD; wgid = (xcd < r ? xcd * (q + 1) : r * (q + 1) + (xcd - r) * q) + off; }
        const int nig = WGM * nN, gid = wgid / nig, fm = gid * WGM, gsz = (nM - fm) < WGM ? (nM - fm) : WGM;
        u.pm = fm + ((wgid % nig) % gsz); u.pn = (wgid % nig) / gsz; return true;
    }
};

template <class F> struct Epi {
    static constexpr bool PERM = true;
    F f;
    __device__ __forceinline__ void operator()(const f32x4 (&acc)[2][2][4][2], const Unit& u, int wr, int wc, int fr, int fq) const {
        asm volatile("" : "+v"(fr), "+v"(fq));
        const int row0 = u.pm * BM + wr * 64 + fr, col0 = u.pn * BM + wc * 32 + 8 * fq;
#pragma unroll
        for (int ai = 0; ai < 2; ++ai)
#pragma unroll
            for (int m = 0; m < 4; ++m)
#pragma unroll
                for (int bj = 0; bj < 2; ++bj) f(row0 + ai * HALF + m * 16, col0 + bj * HALF, acc[ai][bj][m][0], acc[ai][bj][m][1]);
    }
};

template <class EpiT>
__device__ __forceinline__ void gemm_phase(LAS unsigned char* lds, const Gemm g, const StaticOrder& S, const EpiT& E) {
    int tid = threadIdx.x; asm volatile("" : "+v"(tid));
    const int wid = __builtin_amdgcn_readfirstlane(tid >> 6), lane = tid & 63, wr = wid >> 2, wc = wid & 3, fr = lane & 15, fq = lane >> 4;
    const int K = g.K, nt = K / BK;
    unsigned voffA[2], voffB[2];
#pragma unroll
    for (int i = 0; i < 2; ++i) { int R, C; stage_rc(tid * 16 + i * 8192, R, C); const int Rb = EpiT::PERM ? ((R & ~31) + perm32(R & 31)) : R;
        voffA[i] = (unsigned)(R * K + C) * 2u; voffB[i] = (unsigned)(Rb * K + C) * 2u; }
    const size_t kstep = (size_t)(BK * 2);
    const size_t hstep = (size_t)HALF * K * 2;
    const size_t tstep = 2 * hstep;
    const unsigned ldsw = (unsigned)wid * 1024u;
    const int aoff = lds_byte(wr * 64 + fr, fq * 8), boff = lds_byte(wc * 32 + fr, fq * 8);
#define PG8_SA(b, h) (((b) * 2 + (h)) * HTB)
#define PG8_SB(b, h) ((4 + (b) * 2 + (h)) * HTB)
#define PG8_STAGE(bufoff, gbase, voff) do { _Pragma("unroll") for (int _i = 0; _i < 2; ++_i) \
        __builtin_amdgcn_global_load_lds((const unsigned*)((const char*)(gbase) + (voff)[_i]), (LAS unsigned*)(lds + (bufoff) + ldsw + _i * 8192), 16, 0, 0); } while (0)
#define PG8_LDA(dst, b, h) do { _Pragma("unroll") for (int m = 0; m < 4; ++m) _Pragma("unroll") for (int k = 0; k < 2; ++k) dst[m][k] = *(const LAS bf16x8*)(lds + PG8_SA(b, h) + aoff + m * 2048 + k * 1024); } while (0)
#define PG8_LDB(dst, b, h) do { _Pragma("unroll") for (int n = 0; n < 2; ++n) _Pragma("unroll") for (int k = 0; k < 2; ++k) dst[n][k] = *(const LAS bf16x8*)(lds + PG8_SB(b, h) + boff + n * 2048 + k * 1024); } while (0)
#define PG8_MMA(ai, bj, At, Bt) do { __builtin_amdgcn_s_setprio(1); _Pragma("unroll") for (int m = 0; m < 4; ++m) _Pragma("unroll") for (int n = 0; n < 2; ++n) _Pragma("unroll") for (int k = 0; k < 2; ++k) \
        acc[ai][bj][m][n] = __builtin_amdgcn_mfma_f32_16x16x32_bf16(Bt[n][k], At[m][k], acc[ai][bj][m][n], 0, 0, 0); __builtin_amdgcn_s_setprio(0); } while (0)
#define PG8_WAIT_V(n) asm volatile("s_waitcnt vmcnt(" #n ")" ::: "memory")
#define PG8_WAIT_L(n) asm volatile("s_waitcnt lgkmcnt(" #n ")" ::: "memory")
#define PG8_BAR __builtin_amdgcn_s_barrier()
#define PG8_SCHED __builtin_amdgcn_sched_barrier(0)
    Unit cur, nxt; int ui = 0;
    if (!S.next(0, cur)) return;
    f32x4 acc[2][2][4][2];
#pragma unroll
    for (int a = 0; a < 2; ++a)
#pragma unroll
        for (int b = 0; b < 2; ++b)
#pragma unroll
            for (int m = 0; m < 4; ++m)
#pragma unroll
                for (int n = 0; n < 2; ++n) acc[a][b][m][n] = (f32x4){0.f, 0.f, 0.f, 0.f};
    bf16x8 At[4][2], B0[2][2], B1[2][2];
    const char* cA = a_of(g, cur.pn) + (size_t)cur.pm * tstep; const char* cB = (const char*)g.Bt + (size_t)cur.pn * tstep;
    PG8_STAGE(PG8_SB(0, 0), cB, voffB); PG8_STAGE(PG8_SB(0, 1), cB + hstep, voffB); PG8_STAGE(PG8_SA(0, 0), cA, voffA); PG8_STAGE(PG8_SA(0, 1), cA + hstep, voffA);
    if (wr == 1) PG8_BAR;
    PG8_WAIT_V(2); PG8_BAR;
    PG8_STAGE(PG8_SB(1, 0), cB + kstep, voffB); PG8_STAGE(PG8_SA(1, 0), cA + kstep, voffA); PG8_STAGE(PG8_SB(1, 1), cB + hstep + kstep, voffB);
    PG8_WAIT_V(6); PG8_BAR;
    for (;;) {
        const bool has_next = S.next(ui + 1, nxt);
        const char* nA = has_next ? a_of(g, nxt.pn) + (size_t)nxt.pm * tstep : cA; const char* nB = has_next ? (const char*)g.Bt + (size_t)nxt.pn * tstep : cB;
        for (int t = 0; t < nt; t += 2) {
            const bool last = (t == nt - 2);
            const char* a1 = cA + (size_t)(t + 1) * kstep;
            const char* a2 = last ? nA : cA + (size_t)(t + 2) * kstep; const char* b2 = last ? nB : cB + (size_t)(t + 2) * kstep;
            const char* a3 = a2 + kstep; const char* b3 = b2 + kstep;
            PG8_LDB(B0, 0, 0); PG8_LDB(B1, 0, 1); PG8_SCHED; PG8_LDA(At, 0, 0); PG8_STAGE(PG8_SA(1, 1), a1 + hstep, voffA);
            PG8_WAIT_V(8); PG8_WAIT_L(0); PG8_BAR; PG8_MMA(0, 0, At, B0); PG8_MMA(0, 1, At, B1); PG8_BAR; PG8_SCHED;
            PG8_LDA(At, 0, 1); PG8_STAGE(PG8_SB(0, 0), b2, voffB); PG8_STAGE(PG8_SB(0, 1), b2 + hstep, voffB); PG8_STAGE(PG8_SA(0, 0), a2, voffA);
            PG8_WAIT_V(8); PG8_WAIT_L(0); PG8_BAR; PG8_MMA(1, 0, At, B0); PG8_MMA(1, 1, At, B1); PG8_BAR; PG8_SCHED;
            PG8_LDB(B0, 1, 0); PG8_LDB(B1, 1, 1); PG8_SCHED; PG8_LDA(At, 1, 0); PG8_STAGE(PG8_SA(0, 1), a2 + hstep, voffA);
            PG8_WAIT_V(8); PG8_WAIT_L(0); PG8_BAR; PG8_MMA(0, 0, At, B0); PG8_MMA(0, 1, At, B1); PG8_BAR; PG8_SCHED;
            PG8_LDA(At, 1, 1); PG8_STAGE(PG8_SB(1, 0), b3, voffB); PG8_STAGE(PG8_SB(1, 1), b3 + hstep, voffB); PG8_STAGE(PG8_SA(1, 0), a3, voffA);
            PG8_WAIT_V(8); PG8_WAIT_L(0); PG8_BAR; PG8_MMA(1, 0, At, B0); PG8_MMA(1, 1, At, B1); PG8_BAR; PG8_SCHED;
        }
        if (wr == 0) PG8_BAR;
        E(acc, cur, wr, wc, fr, fq);
        if (!has_next) break;
#pragma unroll
        for (int a = 0; a < 2; ++a)
#pragma unroll
            for (int b = 0; b < 2; ++b)
#pragma unroll
                for (int m = 0; m < 4; ++m)
#pragma unroll
                    for (int n = 0; n < 2; ++n) acc[a][b][m][n] = (f32x4){0.f, 0.f, 0.f, 0.f};
        cur = nxt; cA = nA; cB = nB; ++ui;
        if (wr == 1) PG8_BAR;
    }
    PG8_WAIT_V(0);
    PG8_BAR;
#undef PG8_SA
#undef PG8_SB
#undef PG8_STAGE
#undef PG8_LDA
#undef PG8_LDB
#undef PG8_MMA
#undef PG8_WAIT_V
#undef PG8_WAIT_L
#undef PG8_BAR
#undef PG8_SCHED
}
}

__device__ __forceinline__ void store8bf(bf16_t* p, f32x4 a, f32x4 b) {
    u32x4 w; w.x = cvt_pk_bf16(a[0], a[1]); w.y = cvt_pk_bf16(a[2], a[3]); w.z = cvt_pk_bf16(b[0], b[1]); w.w = cvt_pk_bf16(b[2], b[3]);
    *(u32x4*)p = w;
}
struct FRes { float* X;
    __device__ __forceinline__ void operator()(int row, int col, f32x4 a, f32x4 b) const {
        float* p = X + (size_t)row * DM + col; f32x4 x0 = *(f32x4*)p, x1 = *(f32x4*)(p + 4); *(f32x4*)p = x0 + a; *(f32x4*)(p + 4) = x1 + b; } };
struct FR1 { bf16_t *R, *K, *V, *L;
    __device__ __forceinline__ void operator()(int row, int col, f32x4 a, f32x4 b) const {
        if (col < 6144) { const int g = col >> 11; const size_t o = (size_t)row * DM + (col & 2047); if (g == 0) store8bf(R + o, a, b); else if (g == 1) store8bf(K + o, a, b); else store8bf(V + o, a, b); }
        else { const int t = (col - 6144) >> 8, c = col & 255;
            if (t == 0) { for (int i = 0; i < 4; ++i) { a[i] = 1.f - 2.f / (1.f + __expf(2.f * a[i])); b[i] = 1.f - 2.f / (1.f + __expf(2.f * b[i])); } }
            else if (t == 2) { for (int i = 0; i < 4; ++i) { a[i] = sigmoidf_(a[i]); b[i] = sigmoidf_(b[i]); } }
            store8bf(L + (size_t)t * MROWS * 256 + (size_t)row * 256 + c, a, b); } } };
__device__ __forceinline__ float decay_of(float z) { return -0.60653065971f / (1.f + __expf(-z)); }
struct FR2 { float* DD; bf16_t *AA, *GG, *VG; const float *w0, *a0, *v0;
    __device__ __forceinline__ void operator()(int row, int col, f32x4 a, f32x4 b) const {
        const int g = col >> 11, c = col & 2047; const size_t off = (size_t)row * DM + c;
        if (g == 0) { f32x4 z0 = *(const f32x4*)(w0 + c), z1 = *(const f32x4*)(w0 + c + 4); a += z0; b += z1;
            for (int i = 0; i < 4; ++i) { a[i] = decay_of(a[i]); b[i] = decay_of(b[i]); }
            *(f32x4*)(DD + off) = a; *(f32x4*)(DD + off + 4) = b; }
        else if (g == 1) { f32x4 z0 = *(const f32x4*)(a0 + c), z1 = *(const f32x4*)(a0 + c + 4); a += z0; b += z1;
            for (int i = 0; i < 4; ++i) { a[i] = sigmoidf_(a[i]); b[i] = sigmoidf_(b[i]); } store8bf(AA + off, a, b); }
        else if (g == 2) { store8bf(GG + off, a, b); }
        else { f32x4 z0 = *(const f32x4*)(v0 + c), z1 = *(const f32x4*)(v0 + c + 4); a += z0; b += z1;
            for (int i = 0; i < 4; ++i) { a[i] = sigmoidf_(a[i]); b[i] = sigmoidf_(b[i]); } store8bf(VG + off, a, b); } } };
struct FG1 { bf16_t* PROJ; float* LR;
    __device__ __forceinline__ void operator()(int row, int col, f32x4 a, f32x4 b) const {
        if (col < 6144) { if (col < 1024) { a *= 0.0625f; b *= 0.0625f; } store8bf(PROJ + (size_t)row * 6144 + col, a, b); }
        else if (col < 6160) { float* p = LR + (size_t)row * 16 + (col - 6144); *(f32x4*)p = a; *(f32x4*)(p + 4) = b; } } };
struct FUp { bf16_t* U; float* pconv; float* sconv;
    __device__ __forceinline__ void operator()(int row, int col, f32x4 a, f32x4 b) const {
        store8bf(U + (size_t)row * F2 + col, a, b);
        if (row < MPROMPT) { const int t = row & 8191; if (t >= 8190) { float* p = pconv + ((size_t)((row >> 13) * 2 + (t - 8190))) * F2 + col; *(f32x4*)p = a; *(f32x4*)(p + 4) = b; } }
        else { const int rr = row - MPROMPT, t = rr & 63; if (t >= 62) { float* p = sconv + ((size_t)((rr >> 6) * 2 + (t - 62))) * F2 + col; *(f32x4*)p = a; *(f32x4*)(p + 4) = b; } } } };

__device__ __forceinline__ void tr_item(const float* W, int K, int N, bf16_t* WT, int Kpad, int Npad, float* scr, int item, int lane) {
    const int nblk = Npad / 32, kb = item / nblk, nb = item % nblk, k0 = 64 * kb, n0 = 32 * nb;
    const int n = n0 + (lane & 31);
#pragma unroll 8
    for (int i = 0; i < 32; ++i) { const int kk = 2 * i + (lane >> 5); const int k = k0 + kk; scr[kk * 33 + (lane & 31)] = (k < K && n < N) ? W[(size_t)k * N + n] : 0.f; }
    asm volatile("s_waitcnt lgkmcnt(0)" ::: "memory");
    const int c = lane & 7;
#pragma unroll
    for (int j = 0; j < 4; ++j) { const int nn = (lane >> 3) + 8 * j; const float* s = scr + (8 * c) * 33 + nn;
        u32x4 o; o.x = cvt_pk_bf16(s[0 * 33], s[1 * 33]); o.y = cvt_pk_bf16(s[2 * 33], s[3 * 33]); o.z = cvt_pk_bf16(s[4 * 33], s[5 * 33]); o.w = cvt_pk_bf16(s[6 * 33], s[7 * 33]);
        *(u32x4*)(WT + (size_t)(n0 + nn) * Kpad + k0 + 8 * c) = o; }
    asm volatile("s_waitcnt lgkmcnt(0)" ::: "memory");
}

struct P { const float* in[39]; float* out; unsigned char* ws; };

__device__ __forceinline__ void row_info(int row, int& t, int& len, int& b, bool& prompt) {
    if (row < MPROMPT) { prompt = true; b = row >> 13; t = row & 8191; len = 8192; }
    else { prompt = false; const int rr = row - MPROMPT; b = rr >> 6; t = rr & 63; len = 64; }
}

__device__ __forceinline__ const float* ldp(const unsigned long long* tab, int i) {
    const unsigned long long v = tab[i];
    const unsigned lo = __builtin_amdgcn_readfirstlane((unsigned)v), hi = __builtin_amdgcn_readfirstlane((unsigned)(v >> 32));
    return (const float*)(((unsigned long long)hi << 32) | lo);
}
#define IN(k) ldp(tab, (k))
#define OUTP ((float*)ldp(tab, 39))
#define BASES float* X = (float*)ldp(tab, 39); unsigned char* ws_ = (unsigned char*)ldp(tab, 40); bf16_t* WT = (bf16_t*)(ws_ + WS_WT); unsigned char* RA = ws_ + WS_A; unsigned char* RB = ws_ + WS_B; \
    bf16_t* VFIRST = (bf16_t*)(ws_ + WS_VF); LAS unsigned char* ldsl = (LAS unsigned char*)lds; (void)X; (void)WT; (void)RA; (void)RB; (void)VFIRST; (void)ldsl;
#define RWKV_PTRS bf16_t* HB = (bf16_t*)RA; bf16_t* Rb = (bf16_t*)RB; bf16_t* Kb = Rb + ACT; bf16_t* Vb = (jl == 0) ? VFIRST : Kb + ACT; bf16_t* Lb = (bf16_t*)(RB + 204 * MiB); \
    float* DD = (float*)(RB + 240 * MiB); bf16_t* AA = (bf16_t*)RA; bf16_t* VG = AA + ACT; bf16_t* GG = VG + ACT; bf16_t* Y = GG + ACT; \
    bf16_t* W1 = WT + jl * RW_SZ; bf16_t* W2 = W1 + (size_t)7168 * 2048; bf16_t* WO = W2 + (size_t)8192 * 256; \
    (void)HB; (void)Rb; (void)Kb; (void)Vb; (void)Lb; (void)DD; (void)AA; (void)VG; (void)GG; (void)Y; (void)W1; (void)W2; (void)WO;
#define GLA_PTRS bf16_t* H = (bf16_t*)RB; float* LR = (float*)(RB + 68 * MiB); float* O = (float*)(RB + 70 * MiB); bf16_t* Y = (bf16_t*)(RB + 206 * MiB); \
    bf16_t* PROJ = (bf16_t*)RA; bf16_t* QE = (bf16_t*)(RA + 204 * MiB); bf16_t* KDT = (bf16_t*)(RA + 238 * MiB); bf16_t* VT = (bf16_t*)(RA + 272 * MiB); \
    bf16_t* SC = (bf16_t*)(RA + 340 * MiB); float* EL = (float*)(RA + 349 * MiB); bf16_t* GI = WT + GW_OFF + jl * GW_SZ; bf16_t* GO = GI + (size_t)6400 * 2048; \
    (void)H; (void)LR; (void)O; (void)Y; (void)PROJ; (void)QE; (void)KDT; (void)VT; (void)SC; (void)EL; (void)GI; (void)GO;
#define FFN_PTRS bf16_t* H = (bf16_t*)RB; bf16_t* HID = (bf16_t*)(RB + 68 * MiB); bf16_t* U = (bf16_t*)RA; bf16_t* WU = WT + FW_OFF + layer * FW_SZ; bf16_t* WD = WU + (size_t)F2 * 2048; \
    (void)H; (void)HID; (void)U; (void)WU; (void)WD;

__global__ void __launch_bounds__(512, 2) fwd_kernel(P p) {
    extern __shared__ __attribute__((aligned(16))) unsigned char lds[];
    cg::grid_group grid = cg::this_grid();
    const int G = gridDim.x, NGW = G * 8, NT = G * 512;
#define PHASE_IDS int tid = threadIdx.x; asm volatile("" : "+v"(tid)); const int lane = tid & 63; const int wave = __builtin_amdgcn_readfirstlane(tid >> 6); const int gw = blockIdx.x * 8 + wave; const int gtid = blockIdx.x * 512 + tid; (void)lane; (void)gw; (void)gtid;
    unsigned long long* tab = (unsigned long long*)(lds + LDS_BYTES - 512);
    if (threadIdx.x == 0) {
#pragma unroll
        for (int i = 0; i < 39; ++i) tab[i] = (unsigned long long)p.in[i];
        tab[39] = (unsigned long long)p.out; tab[40] = (unsigned long long)p.ws;
    }
    __syncthreads();

    {
        PHASE_IDS BASES
        float* scr = (float*)(lds + wave * 16384);
#define TR(src, K, N, dst, Kpad, Npad) do { const int _ni = ((Kpad) / 64) * ((Npad) / 32); for (int it = gw; it < _ni; it += NGW) tr_item((src), (K), (N), (dst), (Kpad), (Npad), scr, it, lane); } while (0)
#pragma unroll 1
        for (int j = 0; j < 2; ++j) {
            bf16_t* W1 = WT + j * RW_SZ; bf16_t* W2 = W1 + (size_t)7168 * 2048; bf16_t* WO = W2 + (size_t)8192 * 256;
            TR(IN(24) + (size_t)j * DM * DM, 2048, 2048, W1, 2048, 2048);
            TR(IN(25) + (size_t)j * DM * DM, 2048, 2048, W1 + (size_t)2048 * 2048, 2048, 2048);
            TR(IN(26) + (size_t)j * DM * DM, 2048, 2048, W1 + (size_t)4096 * 2048, 2048, 2048);
            TR(IN(11) + (size_t)j * DM * 96, 2048, 96, W1 + (size_t)6144 * 2048, 2048, 256);
            TR(IN(14) + (size_t)j * DM * 96, 2048, 96, W1 + (size_t)6400 * 2048, 2048, 256);
            TR(IN(19) + (size_t)j * DM * 256, 2048, 256, W1 + (size_t)6656 * 2048, 2048, 256);
            if (j >= 1) TR(IN(17) + (size_t)(j - 1) * DM * 64, 2048, 64, W1 + (size_t)6912 * 2048, 2048, 256);
            TR(IN(12) + (size_t)j * 96 * DM, 96, 2048, W2, 256, 2048);
            TR(IN(15) + (size_t)j * 96 * DM, 96, 2048, W2 + (size_t)2048 * 256, 256, 2048);
            TR(IN(20) + (size_t)j * 256 * DM, 256, 2048, W2 + (size_t)4096 * 256, 256, 2048);
            if (j >= 1) TR(IN(18) + (size_t)(j - 1) * 64 * DM, 64, 2048, W2 + (size_t)6144 * 256, 256, 2048);
            TR(IN(27) + (size_t)j * DM * DM, 2048, 2048, WO, 2048, 2048);
            bf16_t* GI = WT + GW_OFF + j * GW_SZ; bf16_t* GO = GI + (size_t)6400 * 2048;
            TR(IN(30) + (size_t)j * DM * 6160, 2048, 6160, GI, 2048, 6400);
            TR(IN(34) + (size_t)j * DM * DM, 2048, 2048, GO, 2048, 2048);
        }
#pragma unroll 1
        for (int i = 0; i < 4; ++i) {
            bf16_t* WU = WT + FW_OFF + i * FW_SZ; bf16_t* WD = WU + (size_t)F2 * 2048;
            TR(IN(35) + (size_t)i * DM * F2, 2048, F2, WU, 2048, F2);
            TR(IN(38) + (size_t)i * FH * DM, FH, 2048, WD, FH, 2048);
        }
#undef TR
        const f32x4* xp = (const f32x4*)IN(0); const f32x4* xs = (const f32x4*)IN(1); f32x4* xo = (f32x4*)X;
        const int NP4 = MPROMPT * DM / 4, NA4 = MROWS * DM / 4;
        for (int i = gtid; i < NA4; i += NT) xo[i] = i < NP4 ? xp[i] : xs[i - NP4];
    }
    grid.sync();

#pragma clang loop unroll(full)
    for (int layer = 0; layer < 4; ++layer) {
        const int jl = layer >> 1;
        if ((layer & 1) == 0) {
            {
                PHASE_IDS BASES RWKV_PTRS
                const float* gmix = IN(6) + (size_t)layer * DM;
                const float* mix = IN(9) + (size_t)jl * 6 * DM;
                const float* sst = IN(2) + (size_t)jl * 16 * DM;
                for (int row = gw; row < MROWS; row += NGW) {
                    int t, len, b; bool prompt; row_info(row, t, len, b, prompt);
                    const f32x4* xr = (const f32x4*)(X + (size_t)row * DM) + lane;
                    f32x4 x[8]; float ss = 0.f;
#pragma unroll
                    for (int q = 0; q < 8; ++q) { x[q] = xr[64 * q]; ss += x[q][0] * x[q][0] + x[q][1] * x[q][1] + x[q][2] * x[q][2] + x[q][3] * x[q][3]; }
                    const float rs = rsqrtf(wave_sum(ss, lane) * (1.f / DM) + 1e-6f);
                    f32x4 hp[8];
                    if (t > 0) {
                        const f32x4* xq = (const f32x4*)(X + (size_t)(row - 1) * DM) + lane; float s2 = 0.f;
#pragma unroll
                        for (int q = 0; q < 8; ++q) { hp[q] = xq[64 * q]; s2 += hp[q][0] * hp[q][0] + hp[q][1] * hp[q][1] + hp[q][2] * hp[q][2] + hp[q][3] * hp[q][3]; }
                        const float rp = rsqrtf(wave_sum(s2, lane) * (1.f / DM) + 1e-6f);
#pragma unroll
                        for (int q = 0; q < 8; ++q) { const f32x4 gg = *((const f32x4*)gmix + lane + 64 * q); hp[q] = hp[q] * rp * gg; }
                    } else if (!prompt) {
#pragma unroll
                        for (int q = 0; q < 8; ++q) hp[q] = *((const f32x4*)(sst + (size_t)b * DM) + lane + 64 * q);
                    } else {
#pragma unroll
                        for (int q = 0; q < 8; ++q) hp[q] = (f32x4){0.f, 0.f, 0.f, 0.f};
                    }
                    const bool lastrow = (t == len - 1);
                    float* shout = OUTP + (prompt ? O_PSHIFT + ((size_t)jl * 2 + b) * DM : O_SSHIFT + ((size_t)jl * 16 + b) * DM);
#pragma unroll
                    for (int q = 0; q < 8; ++q) {
                        const f32x4 gg = *((const f32x4*)gmix + lane + 64 * q);
                        const f32x4 h = x[q] * rs * gg; const f32x4 dlt = hp[q] - h;
                        if (lastrow) *((f32x4*)shout + lane + 64 * q) = h;
#pragma unroll
                        for (int m = 0; m < 6; ++m) {
                            const f32x4 mx = *((const f32x4*)(mix + (size_t)m * DM) + lane + 64 * q);
                            const f32x4 o = h + dlt * mx;
                            u32x2 w; w.x = cvt_pk_bf16(o[0], o[1]); w.y = cvt_pk_bf16(o[2], o[3]);
                            *((u32x2*)(HB + (size_t)m * ACT + (size_t)row * DM) + lane + 64 * q) = w;
                        }
                    }
                }
            }
            grid.sync();
            {
                BASES RWKV_PTRS
                pg8::Gemm g{HB, W1, MROWS, jl == 0 ? 6912 : 7168, 2048, 1, ACT * 2};
                pg8::StaticOrder S; S.init(g.M, g.N, G, (int)blockIdx.x);
                pg8::Epi<FR1> E{FR1{Rb, Kb, Vb, Lb}};
                pg8::gemm_phase(ldsl, g, S, E);
            }
            grid.sync();
            {
                BASES RWKV_PTRS
                pg8::Gemm g{Lb, W2, MROWS, jl == 0 ? 6144 : 8192, 256, 2, (size_t)MROWS * 256 * 2};
                pg8::StaticOrder S; S.init(g.M, g.N, G, (int)blockIdx.x);
                pg8::Epi<FR2> E{FR2{DD, AA, GG, VG, IN(10) + (size_t)jl * DM, IN(13) + (size_t)jl * DM, IN(16) + (size_t)(jl > 0 ? jl - 1 : 0) * DM}};
                pg8::gemm_phase(ldsl, g, S, E);
            }
            grid.sync();
            {
                PHASE_IDS BASES RWKV_PTRS
                float* Obuf = (float*)(RA + 272 * MiB); float* RK = (float*)(RB + 204 * MiB); float* DTg = (float*)(RB + 208 * MiB);
                const float* k_k = IN(21) + (size_t)jl * DM; const float* k_a = IN(22) + (size_t)jl * DM; const float* r_k = IN(23) + (size_t)jl * DM;
                const int l32 = lane & 31, hl = lane >> 5;
#pragma unroll 1
                for (int item = blockIdx.x; item < 8704; item += G) {
                    LAS unsigned char* ldsv = (LAS unsigned char*)lds; asm volatile("" : "+v"(ldsv));
                    LAS bf16_t* AH = (LAS bf16_t*)(ldsv + 0); LAS bf16_t* RH = (LAS bf16_t*)(ldsv + 9216); LAS bf16_t* BH = (LAS bf16_t*)(ldsv + 18432); LAS bf16_t* KH = (LAS bf16_t*)(ldsv + 27648);
                    LAS bf16_t* BHT = (LAS bf16_t*)(ldsv + 36864); LAS bf16_t* KHT = (LAS bf16_t*)(ldsv + 46080); LAS bf16_t* VTs = (LAS bf16_t*)(ldsv + 55296); LAS bf16_t* XT = (LAS bf16_t*)(ldsv + 64512);
                    LAS float* AAB = (LAS float*)(ldsv + 82944); LAS bf16_t* AAK = (LAS bf16_t*)(ldsv + 99328); LAS bf16_t* ARB = (LAS bf16_t*)(ldsv + 108544); LAS bf16_t* ARK = (LAS bf16_t*)(ldsv + 117760);
                    LAS float* LB = (LAS float*)(ldsv + 126976); LAS float* DTS = (LAS float*)(ldsv + 143360);
                    (void)RH; (void)KH; (void)KHT;
                    const int chunk = item >> 5, h = item & 31, r0 = chunk * 64;
                    const int st = tid >> 3, c0 = (tid & 7) * 8; const int col = h * 64 + c0; const size_t off = (size_t)(r0 + st) * DM + col;
                    float r[8], kk[8], bb[8], km[8], ld[8];
                    {
                        float k[8], v[8], a[8];
                        unpack8(*(const u32x4*)(Rb + off), r); unpack8(*(const u32x4*)(Kb + off), k); unpack8(*(const u32x4*)(Vb + off), v); unpack8(*(const u32x4*)(AA + off), a);
                        const f32x4 d0 = *(const f32x4*)(DD + off), d1 = *(const f32x4*)(DD + off + 4);
                        ld[0] = d0[0]; ld[1] = d0[1]; ld[2] = d0[2]; ld[3] = d0[3]; ld[4] = d1[0]; ld[5] = d1[1]; ld[6] = d1[2]; ld[7] = d1[3];
                        if (jl > 0) { float vf[8], vg[8]; unpack8(*(const u32x4*)(VFIRST + off), vf); unpack8(*(const u32x4*)(VG + off), vg);
#pragma unroll
                            for (int i = 0; i < 8; ++i) v[i] = v[i] + (vf[i] - v[i]) * vg[i]; }
                        float ss = 0.f;
#pragma unroll
                        for (int i = 0; i < 8; ++i) { kk[i] = k[i] * k_k[col + i]; ss += kk[i] * kk[i]; }
                        ss = sum8(ss, lane);
                        const float inv = 1.f / fmaxf(sqrtf(ss), 1e-12f);
                        float rk = 0.f;
#pragma unroll
                        for (int i = 0; i < 8; ++i) { kk[i] *= inv; bb[i] = kk[i] * a[i]; km[i] = k[i] * (1.f + (a[i] - 1.f) * k_a[col + i]); rk += r[i] * km[i] * r_k[col + i]; }
                        rk = sum8(rk, lane);
                        if ((tid & 7) == 0) RK[(size_t)(r0 + st) * 32 + h] = rk;
                        *(LAS f32x4*)(LB + st * 64 + c0) = d0; *(LAS f32x4*)(LB + st * 64 + c0 + 4) = d1;
#pragma unroll
                        for (int i = 0; i < 8; i += 2) { const unsigned pk = cvt_pk_bf16(v[i], v[i + 1]); VTs[(c0 + i) * 72 + st] = (bf16_t)(pk & 0xffffu); VTs[(c0 + i + 1) * 72 + st] = (bf16_t)(pk >> 16); }
                    }
                    __syncthreads();
                    if (tid < 64) { float run = 0.f;
#pragma unroll 8
                        for (int t = 0; t < 64; ++t) { run += LB[t * 64 + tid]; LB[t * 64 + tid] = run; } }
                    __syncthreads();
                    {
                        float ah[8], bh[8], kh[8], rh[8];
#pragma unroll
                        for (int i = 0; i < 8; ++i) { const float Lt = LB[st * 64 + c0 + i]; const float e3 = __expf(Lt), e2 = __expf(-Lt), e1 = __expf(Lt - ld[i]);
                            ah[i] = -kk[i] * e1; bh[i] = bb[i] * e2; kh[i] = km[i] * e2; rh[i] = r[i] * e3;
                            if (st == 63) { DTS[c0 + i] = e3; DTg[(size_t)item * 64 + c0 + i] = e3; } }
                        *(LAS u32x4*)(AH + st * 72 + c0) = pack8(ah); *(LAS u32x4*)(RH + st * 72 + c0) = pack8(rh);
                        *(LAS u32x4*)(BH + st * 72 + c0) = pack8(bh); *(LAS u32x4*)(KH + st * 72 + c0) = pack8(kh);
#pragma unroll
                        for (int i = 0; i < 8; i += 2) { const unsigned p1 = cvt_pk_bf16(bh[i], bh[i + 1]), p2 = cvt_pk_bf16(kh[i], kh[i + 1]);
                            BHT[(c0 + i) * 72 + st] = (bf16_t)(p1 & 0xffffu); BHT[(c0 + i + 1) * 72 + st] = (bf16_t)(p1 >> 16);
                            KHT[(c0 + i) * 72 + st] = (bf16_t)(p2 & 0xffffu); KHT[(c0 + i + 1) * 72 + st] = (bf16_t)(p2 >> 16); }
                    }
                    __syncthreads();
                    {
                        const int mi = wave & 3, rowsel = mi >> 1, tt = mi & 1;
#pragma unroll
                        for (int nn = 0; nn < 2; ++nn) {
                            const int colsel = wave >> 2, stl = nn; const int ni = 2 * colsel + nn;
                            f32x16 acc;
#pragma unroll
                            for (int i = 0; i < 16; ++i) acc[i] = 0.f;
                            if (stl <= tt) {
#pragma unroll
                                for (int ks = 0; ks < 4; ++ks) {
                                    const bf16x8 a = *(const LAS bf16x8*)(AH + (mi * 32 + l32) * 72 + ks * 16 + hl * 8);
                                    const bf16x8 b = *(const LAS bf16x8*)(BH + (ni * 32 + l32) * 72 + ks * 16 + hl * 8);
                                    acc = __builtin_amdgcn_mfma_f32_32x32x16_bf16(a, b, acc, 0, 0, 0);
                                }
                            }
#pragma unroll
                            for (int i = 0; i < 16; ++i) {
                                const int t = tt * 32 + crow(i, hl), s = stl * 32 + l32;
                                const bool keep = rowsel ? (s <= t) : (s < t);
                                const float val = keep ? acc[i] : 0.f;
                                if (rowsel == 0 && colsel == 0) AAB[t * 64 + s] = val;
                                else { LAS bf16_t* dst = (rowsel == 0) ? AAK : (colsel == 0 ? ARB : ARK); dst[t * 72 + s] = (bf16_t)(cvt_pk_bf16(val, 0.f) & 0xffffu); }
                            }
                        }
                    }
                    __syncthreads();
                    if (wave < 4) {
                        const int mt = wave >> 1, nt = wave & 1;
                        f32x16 acc;
#pragma unroll
                        for (int i = 0; i < 16; ++i) acc[i] = 0.f;
#pragma unroll
                        for (int ks = 0; ks < 4; ++ks) {
                            const bf16x8 a = *(const LAS bf16x8*)(AAK + (mt * 32 + l32) * 72 + ks * 16 + hl * 8);
                            const bf16x8 b = *(const LAS bf16x8*)(VTs + (nt * 32 + l32) * 72 + ks * 16 + hl * 8);
                            acc = __builtin_amdgcn_mfma_f32_32x32x16_bf16(a, b, acc, 0, 0, 0);
                        }
#pragma unroll
                        for (int i = 0; i < 16; ++i) LB[(mt * 32 + crow(i, hl)) * 64 + nt * 32 + l32] = acc[i];
                    }
                    __syncthreads();
                    if (tid < 128) {
                        float Xc[64];
#pragma unroll
                        for (int t = 0; t < 64; ++t) Xc[t] = 0.f;
#pragma clang loop unroll(full)
                        for (int t = 0; t < 64; ++t) {
                            const float va_ = bf2f(AH[t * 72 + (tid & 63)]), vb_ = LB[t * 64 + (tid & 63)];
                            float a0 = (tid < 64) ? va_ : vb_;
                            float a1 = 0.f, a2 = 0.f, a3 = 0.f;
#pragma clang loop unroll(full)
                            for (int s4 = 0; s4 < t; s4 += 4) { const f32x4 w = *(const LAS f32x4*)(AAB + t * 64 + s4);
                                a0 += w[0] * Xc[s4]; a1 += w[1] * Xc[s4 + 1]; a2 += w[2] * Xc[s4 + 2]; a3 += w[3] * Xc[s4 + 3]; }
                            Xc[t] = (a0 + a1) + (a2 + a3);
                            asm volatile("" : "+v"(Xc[t]) :: "memory");
                        }
#pragma unroll
                        for (int q = 0; q < 8; ++q) { float f8[8];
#pragma unroll
                            for (int i = 0; i < 8; ++i) f8[i] = Xc[q * 8 + i];
                            *(LAS u32x4*)(XT + tid * 72 + q * 8) = pack8(f8); }
                    }
                    __syncthreads();
                    {
                        const int kind = wave >> 2, mt = (wave & 3) >> 1, nt = wave & 1;
                        {
                            const LAS bf16_t* Ap = (kind == 0 ? ARB : BHT) + (mt * 32 + l32) * 72; const LAS bf16_t* Bp = XT + (nt * 32 + l32) * 72;
                            f32x16 acc;
#pragma unroll
                            for (int i = 0; i < 16; ++i) acc[i] = 0.f;
#pragma unroll
                            for (int ks = 0; ks < 4; ++ks) acc = __builtin_amdgcn_mfma_f32_32x32x16_bf16(*(const LAS bf16x8*)(Ap + ks * 16 + hl * 8), *(const LAS bf16x8*)(Bp + ks * 16 + hl * 8), acc, 0, 0, 0);
                            bf16_t* dstb = (kind == 0) ? Rb : Kb;
#pragma unroll
                            for (int i = 0; i < 16; ++i) { const int rr = mt * 32 + crow(i, hl), cc = nt * 32 + l32;
                                float val = acc[i];
                                if (kind == 0) val += bf2f(RH[rr * 72 + cc]); else val *= DTS[rr];
                                dstb[(size_t)(r0 + rr) * DM + h * 64 + cc] = (bf16_t)(cvt_pk_bf16(val, 0.f) & 0xffffu); }
                        }
                        {
                            const LAS bf16_t* A1 = (kind == 0 ? ARB : BHT) + (mt * 32 + l32) * 72; const LAS bf16_t* A2 = (kind == 0 ? ARK : KHT) + (mt * 32 + l32) * 72;
                            const LAS bf16_t* B1 = XT + (64 + nt * 32 + l32) * 72; const LAS bf16_t* B2 = VTs + (nt * 32 + l32) * 72;
                            f32x16 acc;
#pragma unroll
                            for (int i = 0; i < 16; ++i) acc[i] = 0.f;
#pragma unroll
                            for (int ks = 0; ks < 4; ++ks) acc = __builtin_amdgcn_mfma_f32_32x32x16_bf16(*(const LAS bf16x8*)(A1 + ks * 16 + hl * 8), *(const LAS bf16x8*)(B1 + ks * 16 + hl * 8), acc, 0, 0, 0);
#pragma unroll
                            for (int ks = 0; ks < 4; ++ks) acc = __builtin_amdgcn_mfma_f32_32x32x16_bf16(*(const LAS bf16x8*)(A2 + ks * 16 + hl * 8), *(const LAS bf16x8*)(B2 + ks * 16 + hl * 8), acc, 0, 0, 0);
                            float* dstf = (kind == 0) ? Obuf : DD;
#pragma unroll
                            for (int i = 0; i < 16; ++i) { const int rr = mt * 32 + crow(i, hl), cc = nt * 32 + l32;
                                float val = acc[i]; if (kind == 1) val *= DTS[rr];
                                dstf[(size_t)(r0 + rr) * DM + h * 64 + cc] = val; }
                        }
                    }
                    __syncthreads();
                }
            }
            grid.sync();
            {
                PHASE_IDS BASES RWKV_PTRS
                const float* DTg = (const float*)(RB + 208 * MiB);
                const int l32 = lane & 31, hl = lane >> 5;
                const int q = wave * G + blockIdx.x;
                if (q < 1152) {
                    const bool prompt = q < 128; int b, h, vh, chunk0, nch;
                    if (prompt) { const int chain = q >> 1; b = chain >> 5; h = chain & 31; vh = q & 1; chunk0 = b * 128; nch = 128; }
                    else { const int sq = q - 128; const int chain = sq >> 1; b = chain >> 5; h = chain & 31; vh = sq & 1; chunk0 = 256 + b; nch = 1; }
                    const int colb = h * 64, vcol = colb + 32 * vh + l32;
                    f32x16 S0, S1;
                    if (prompt) {
#pragma unroll
                        for (int i = 0; i < 16; ++i) { S0[i] = 0.f; S1[i] = 0.f; }
                    } else {
                        const float* s0 = IN(3) + ((((size_t)jl * 16 + b) * 32 + h) * 64 + (32 * vh + l32)) * 64;
#pragma unroll
                        for (int i = 0; i < 16; ++i) { S0[i] = s0[crow(i, hl)]; S1[i] = s0[32 + crow(i, hl)]; }
                    }
                    bf16x8 gf[2][2][2]; f32x16 n0, n1; f32x4 dt_[2][4];
#define S2_COMPUTE(cc) do { const int _r0 = (chunk0 + (cc)) * 64; \
                        u32x4 w00, w01, w10, w11; \
                        w00.x = cvt_pk_bf16(S0[0], S0[1]); w00.y = cvt_pk_bf16(S0[2], S0[3]); w00.z = cvt_pk_bf16(S0[4], S0[5]); w00.w = cvt_pk_bf16(S0[6], S0[7]); \
                        w01.x = cvt_pk_bf16(S0[8], S0[9]); w01.y = cvt_pk_bf16(S0[10], S0[11]); w01.z = cvt_pk_bf16(S0[12], S0[13]); w01.w = cvt_pk_bf16(S0[14], S0[15]); \
                        w10.x = cvt_pk_bf16(S1[0], S1[1]); w10.y = cvt_pk_bf16(S1[2], S1[3]); w10.z = cvt_pk_bf16(S1[4], S1[5]); w10.w = cvt_pk_bf16(S1[6], S1[7]); \
                        w11.x = cvt_pk_bf16(S1[8], S1[9]); w11.y = cvt_pk_bf16(S1[10], S1[11]); w11.z = cvt_pk_bf16(S1[12], S1[13]); w11.w = cvt_pk_bf16(S1[14], S1[15]); \
                        const bf16x8 sb00 = __builtin_bit_cast(bf16x8, w00), sb01 = __builtin_bit_cast(bf16x8, w01), sb10 = __builtin_bit_cast(bf16x8, w10), sb11 = __builtin_bit_cast(bf16x8, w11); \
                        n0 = __builtin_amdgcn_mfma_f32_32x32x16_bf16(gf[0][0][0], sb00, n0, 0, 0, 0); n1 = __builtin_amdgcn_mfma_f32_32x32x16_bf16(gf[1][0][0], sb00, n1, 0, 0, 0); \
                        n0 = __builtin_amdgcn_mfma_f32_32x32x16_bf16(gf[0][0][1], sb01, n0, 0, 0, 0); n1 = __builtin_amdgcn_mfma_f32_32x32x16_bf16(gf[1][0][1], sb01, n1, 0, 0, 0); \
                        n0 = __builtin_amdgcn_mfma_f32_32x32x16_bf16(gf[0][1][0], sb10, n0, 0, 0, 0); n1 = __builtin_amdgcn_mfma_f32_32x32x16_bf16(gf[1][1][0], sb10, n1, 0, 0, 0); \
                        n0 = __builtin_amdgcn_mfma_f32_32x32x16_bf16(gf[0][1][1], sb11, n0, 0, 0, 0); n1 = __builtin_amdgcn_mfma_f32_32x32x16_bf16(gf[1][1][1], sb11, n1, 0, 0, 0); \
                        { unsigned char* _sp = (unsigned char*)DD + ((size_t)(_r0 + l32) * DM + colb + 32 * vh) * 4 + 8 * hl; \
                          *(u32x2*)(_sp + 0) = (u32x2){w00.x, w00.y}; *(u32x2*)(_sp + 16) = (u32x2){w00.z, w00.w}; *(u32x2*)(_sp + 32) = (u32x2){w01.x, w01.y}; *(u32x2*)(_sp + 48) = (u32x2){w01.z, w01.w}; \
                          *(u32x2*)(_sp + 64) = (u32x2){w10.x, w10.y}; *(u32x2*)(_sp + 80) = (u32x2){w10.z, w10.w}; *(u32x2*)(_sp + 96) = (u32x2){w11.x, w11.y}; *(u32x2*)(_sp + 112) = (u32x2){w11.z, w11.w}; } \
                        _Pragma("unroll") for (int i = 0; i < 16; ++i) { S0[i] = S0[i] * dt_[0][i >> 2][i & 3] + n0[i]; S1[i] = S1[i] * dt_[1][i >> 2][i & 3] + n1[i]; } \
                    } while (0)
                    if (prompt) {
                        LAS float* dtl = (LAS float*)((LAS unsigned char*)lds);
                        LAS unsigned char* ring = (LAS unsigned char*)lds + 32768;
                        for (int i = lane; i < 128 * 16; i += 64) *(LAS f32x4*)(dtl + i * 4) = *(const f32x4*)(DTg + ((size_t)(chunk0 + (i >> 4)) * 32 + h) * 64 + (i & 15) * 4);
#define S2_DMA(cc) do { const int _r0 = (chunk0 + (cc)) * 64; LAS unsigned char* _s = ring + ((cc) & 3) * 16384; \
                            _Pragma("unroll") for (int j = 0; j < 8; ++j) { const int _row = 8 * j + (lane >> 3); const int _p = (lane & 7) ^ (_row & 7); \
                                __builtin_amdgcn_global_load_lds((const unsigned*)(Kb + (size_t)(_r0 + _row) * DM + colb + _p * 8), (LAS unsigned*)(_s + j * 1024), 16, 0, 0); } \
                            _Pragma("unroll") for (int j = 0; j < 8; ++j) { const int _row = 8 * j + (lane >> 3); \
                                __builtin_amdgcn_global_load_lds((const unsigned*)(DD + (size_t)(_r0 + _row) * DM + colb + 32 * vh + (lane & 7) * 4), (LAS unsigned*)(_s + 8192 + j * 1024), 16, 0, 0); } \
                        } while (0)
                        S2_DMA(0); S2_DMA(1);
#pragma unroll 1
                        for (int c = 0; c < 128; ++c) {
                            if (c + 2 < 128) { S2_DMA(c + 2); asm volatile("s_waitcnt vmcnt(32)" ::: "memory"); }
                            else if (c + 1 < 128) asm volatile("s_waitcnt vmcnt(16)" ::: "memory");
                            else asm volatile("s_waitcnt vmcnt(0)" ::: "memory");
                            LAS unsigned char* sl = ring + (c & 3) * 16384;
#pragma unroll
                            for (int mt = 0; mt < 2; ++mt)
#pragma unroll
                                for (int kt = 0; kt < 2; ++kt)
#pragma unroll
                                    for (int s2 = 0; s2 < 2; ++s2) {
                                        const int row = 32 * mt + l32, p = 4 * kt + 2 * s2;
                                        const u32x2 lo = *(const LAS u32x2*)(sl + row * 128 + ((p ^ (row & 7)) * 16) + 8 * hl);
                                        const u32x2 hi = *(const LAS u32x2*)(sl + row * 128 + (((p + 1) ^ (row & 7)) * 16) + 8 * hl);
                                        gf[mt][kt][s2] = __builtin_bit_cast(bf16x8, (u32x4){lo.x, lo.y, hi.x, hi.y});
                                    }
#pragma unroll
                            for (int i = 0; i < 16; ++i) { n0[i] = *(const LAS float*)(sl + 8192 + crow(i, hl) * 128 + l32 * 4); n1[i] = *(const LAS float*)(sl + 8192 + (32 + crow(i, hl)) * 128 + l32 * 4); }
#pragma unroll
                            for (int mt = 0; mt < 2; ++mt)
#pragma unroll
                                for (int g = 0; g < 4; ++g) dt_[mt][g] = *(const LAS f32x4*)(dtl + c * 64 + 32 * mt + 8 * g + 4 * hl);
                            S2_COMPUTE(c);
                        }
#undef S2_DMA
                    } else {
                        const int _r0 = chunk0 * 64; const size_t _item = (size_t)chunk0 * 32 + h;
#pragma unroll
                        for (int mt = 0; mt < 2; ++mt)
#pragma unroll
                            for (int kt = 0; kt < 2; ++kt)
#pragma unroll
                                for (int s2 = 0; s2 < 2; ++s2) {
                                    const size_t _o = (size_t)(_r0 + 32 * mt + l32) * DM + colb + 32 * kt + 16 * s2 + 4 * hl;
                                    const u32x2 _lo = *(const u32x2*)(Kb + _o), _hi = *(const u32x2*)(Kb + _o + 8); gf[mt][kt][s2] = __builtin_bit_cast(bf16x8, (u32x4){_lo.x, _lo.y, _hi.x, _hi.y}); }
#pragma unroll
                        for (int i = 0; i < 16; ++i) { n0[i] = DD[(size_t)(_r0 + crow(i, hl)) * DM + vcol]; n1[i] = DD[(size_t)(_r0 + 32 + crow(i, hl)) * DM + vcol]; }
#pragma unroll
                        for (int mt = 0; mt < 2; ++mt)
#pragma unroll
                            for (int g = 0; g < 4; ++g) dt_[mt][g] = *(const f32x4*)(DTg + _item * 64 + 32 * mt + 8 * g + 4 * hl);
                        S2_COMPUTE(0);
                    }
#undef S2_COMPUTE
                    float* so_ = OUTP + (prompt ? O_PWKV + ((((size_t)jl * 2 + b) * 32 + h) * 64 + (32 * vh + l32)) * 64
                                                : O_SWKV + ((((size_t)jl * 16 + b) * 32 + h) * 64 + (32 * vh + l32)) * 64);
#pragma unroll
                    for (int i = 0; i < 16; ++i) { so_[crow(i, hl)] = S0[i]; so_[32 + crow(i, hl)] = S1[i]; }
                }
            }
            grid.sync();
            {
                PHASE_IDS BASES RWKV_PTRS
                const float* Obuf = (const float*)(RA + 272 * MiB); const float* RK = (const float*)(RB + 204 * MiB);
                const float* lnw = IN(28) + (size_t)jl * DM; const float* lnb = IN(29) + (size_t)jl * DM;
                const int l32 = lane & 31, hl = lane >> 5;
#pragma unroll 1
                for (int item = blockIdx.x; item < 8704; item += G) {
                    LAS unsigned char* ldsv = (LAS unsigned char*)lds; asm volatile("" : "+v"(ldsv));
                    LAS bf16_t* R2s = (LAS bf16_t*)(ldsv + 0); LAS bf16_t* STs = (LAS bf16_t*)(ldsv + 9216); LAS float* Os = (LAS float*)(ldsv + 18432);
                    const int chunk = item >> 5, h = item & 31, r0 = chunk * 64;
                    {
                        const int rr = tid >> 3, pc = tid & 7;
                        *(LAS u32x4*)(R2s + rr * 72 + pc * 8) = *(const u32x4*)(Rb + (size_t)(r0 + rr) * DM + h * 64 + pc * 8);
                        const unsigned char* sp = (const unsigned char*)DD + ((size_t)(r0 + (rr & 31)) * DM + h * 64 + 32 * (rr >> 5)) * 4 + pc * 16;
                        *(LAS u32x4*)(STs + rr * 72 + pc * 8) = *(const u32x4*)sp;
                    }
                    __syncthreads();
                    if (wave < 4) {
                        const int tt = wave >> 1, vt = wave & 1;
                        f32x16 acc;
#pragma unroll
                        for (int i = 0; i < 16; ++i) acc[i] = Obuf[(size_t)(r0 + 32 * tt + crow(i, hl)) * DM + h * 64 + 32 * vt + l32];
#pragma unroll
                        for (int ks = 0; ks < 4; ++ks) acc = __builtin_amdgcn_mfma_f32_32x32x16_bf16(*(const LAS bf16x8*)(R2s + (32 * tt + l32) * 72 + ks * 16 + hl * 8), *(const LAS bf16x8*)(STs + (32 * vt + l32) * 72 + ks * 16 + hl * 8), acc, 0, 0, 0);
#pragma unroll
                        for (int i = 0; i < 16; ++i) Os[(32 * tt + crow(i, hl)) * 68 + 32 * vt + l32] = acc[i];
                    }
                    __syncthreads();
                    {
                        const int st = tid >> 3, c0 = (tid & 7) * 8, col = h * 64 + c0; const size_t off = (size_t)(r0 + st) * DM + col;
                        const f32x4 o0 = *(const LAS f32x4*)(Os + st * 68 + c0), o1 = *(const LAS f32x4*)(Os + st * 68 + c0 + 4);
                        float o[8] = {o0[0], o0[1], o0[2], o0[3], o1[0], o1[1], o1[2], o1[3]};
                        float s = 0.f;
#pragma unroll
                        for (int i = 0; i < 8; ++i) s += o[i];
                        const float mu = sum8(s, lane) * (1.f / 64.f); float q = 0.f;
#pragma unroll
                        for (int i = 0; i < 8; ++i) { o[i] -= mu; q += o[i] * o[i]; }
                        const float rstd = rsqrtf(sum8(q, lane) * (1.f / 64.f) + 64e-5f);
                        float v[8], g8[8]; unpack8(*(const u32x4*)(Vb + off), v); unpack8(*(const u32x4*)(GG + off), g8);
                        if (jl > 0) { float vf[8], vg[8]; unpack8(*(const u32x4*)(VFIRST + off), vf); unpack8(*(const u32x4*)(VG + off), vg);
#pragma unroll
                            for (int i = 0; i < 8; ++i) v[i] = v[i] + (vf[i] - v[i]) * vg[i]; }
                        const float rk = RK[(size_t)(r0 + st) * 32 + h];
                        float y[8];
#pragma unroll
                        for (int i = 0; i < 8; ++i) y[i] = (o[i] * rstd * lnw[col + i] + lnb[col + i] + rk * v[i]) * g8[i];
                        *(u32x4*)(Y + off) = pack8(y);
                    }
                    __syncthreads();
                }
            }
            grid.sync();
            {
                BASES RWKV_PTRS
                pg8::Gemm g{Y, WO, MROWS, 2048, 2048, 0, 0};
                pg8::StaticOrder S; S.init(g.M, g.N, G, (int)blockIdx.x);
                pg8::Epi<FRes> E{FRes{X}};
                pg8::gemm_phase(ldsl, g, S, E);
            }
            grid.sync();
        } else {
            { PHASE_IDS BASES GLA_PTRS
            const float* gmix = IN(6) + (size_t)layer * DM;
            for (int row = gw; row < MROWS; row += NGW) {
                const f32x4* xr = (const f32x4*)(X + (size_t)row * DM) + lane; f32x4 x[8]; float ss = 0.f;
#pragma unroll
                for (int q = 0; q < 8; ++q) { x[q] = xr[64 * q]; ss += x[q][0] * x[q][0] + x[q][1] * x[q][1] + x[q][2] * x[q][2] + x[q][3] * x[q][3]; }
                const float rs = rsqrtf(wave_sum(ss, lane) * (1.f / DM) + 1e-6f);
#pragma unroll
                for (int q = 0; q < 8; ++q) { const f32x4 gg = *((const f32x4*)gmix + lane + 64 * q); const f32x4 h = x[q] * rs * gg;
                    u32x2 w; w.x = cvt_pk_bf16(h[0], h[1]); w.y = cvt_pk_bf16(h[2], h[3]); *((u32x2*)(H + (size_t)row * DM) + lane + 64 * q) = w; }
            } }
            grid.sync();
            {
                BASES GLA_PTRS
                pg8::Gemm g{H, GI, MROWS, 6400, 2048, 0, 0};
                pg8::StaticOrder S; S.init(g.M, g.N, G, (int)blockIdx.x);
                pg8::Epi<FG1> E{FG1{PROJ, LR}};
                pg8::gemm_phase(ldsl, g, S, E);
            }
            grid.sync();
            {
                PHASE_IDS BASES GLA_PTRS
                float* lrS = (float*)lds;
                float* w2S = (float*)(lds + 4096);
                float* totS = (float*)(lds + 20480);
                bf16_t* qeS = (bf16_t*)(lds + 22528);
                bf16_t* keS = (bf16_t*)(lds + 22528 + 33792);
                bf16_t* vS = qeS;
                const float* gw2 = IN(31) + (size_t)jl * 16 * 1024; const float* gkb = IN(32) + (size_t)jl * 1024;
#pragma unroll 1
                for (int it = blockIdx.x; it < 1088; it += G) {
                    const int c = it >> 2, h = it & 3, r0 = c * 64; const size_t base = (size_t)it;
                    if (tid < 256) *(f32x4*)(lrS + tid * 4) = *(const f32x4*)(LR + (size_t)r0 * 16 + tid * 4);
                    for (int q = tid; q < 1024; q += 512) { const int r = q >> 6, cc = (q & 63) * 4; *(f32x4*)(w2S + r * 256 + cc) = *(const f32x4*)(gw2 + (size_t)r * 1024 + h * 256 + cc); }
                    __syncthreads();
                    const int d = tid & 255, half = tid >> 8;
                    float cumv[32];
                    {
                        float w[16];
#pragma unroll
                        for (int r = 0; r < 16; ++r) w[r] = w2S[r * 256 + d];
                        const float bb = gkb[h * 256 + d]; float run = 0.f;
#pragma unroll
                        for (int tt = 0; tt < 32; ++tt) {
                            const float* lp = lrS + (half * 32 + tt) * 16; float z = bb;
#pragma unroll
                            for (int r = 0; r < 16; ++r) z += lp[r] * w[r];
                            const float g = (fminf(z, 0.f) - log1pf(__expf(-fabsf(z)))) * 0.0625f;
                            run += g; cumv[tt] = run;
                        }
                        totS[half * 256 + d] = run;
                    }
                    __syncthreads();
                    {
                        const float t0 = totS[d], t1 = totS[256 + d]; const float last = t0 + t1, offc = half ? t0 : 0.f;
                        if (half == 0) EL[base * 256 + d] = __expf(last);
                        unsigned kdp[16];
#pragma unroll
                        for (int tt = 0; tt < 32; tt += 2) {
                            float kd2[2];
#pragma unroll
                            for (int e = 0; e < 2; ++e) {
                                const int t = half * 32 + tt + e; const float cum = cumv[tt + e] + offc;
                                const size_t po = (size_t)(r0 + t) * 6144 + h * 256 + d;
                                const float q = bf2f(PROJ[po]), k = bf2f(PROJ[po + 1024]);
                                const float qe = q * __expf(cum), ke = k * __expf(-cum); kd2[e] = k * __expf(last - cum);
                                const unsigned pq = cvt_pk_bf16(qe, ke);
                                qeS[t * 264 + d] = (bf16_t)(pq & 0xffffu); keS[t * 264 + d] = (bf16_t)(pq >> 16);
                                QE[(size_t)(r0 + t) * 1024 + h * 256 + d] = (bf16_t)(pq & 0xffffu);
                            }
                            kdp[tt >> 1] = cvt_pk_bf16(kd2[0], kd2[1]);
                        }
                        u32x4* kdst = (u32x4*)(KDT + (base * 256 + d) * 64 + half * 32);
                        kdst[0] = (u32x4){kdp[0], kdp[1], kdp[2], kdp[3]}; kdst[1] = (u32x4){kdp[4], kdp[5], kdp[6], kdp[7]};
                        kdst[2] = (u32x4){kdp[8], kdp[9], kdp[10], kdp[11]}; kdst[3] = (u32x4){kdp[12], kdp[13], kdp[14], kdp[15]};
                    }
                    __syncthreads();
                    if (wave < 4) {
                        const int mi = wave >> 1, ni = wave & 1, l32 = lane & 31, hl = lane >> 5;
                        f32x16 cacc;
#pragma unroll
                        for (int i = 0; i < 16; ++i) cacc[i] = 0.f;
#pragma unroll
                        for (int kk = 0; kk < 16; ++kk) {
                            const bf16x8 a = *(const bf16x8*)(qeS + (mi * 32 + l32) * 264 + kk * 16 + hl * 8);
                            const bf16x8 b = *(const bf16x8*)(keS + (ni * 32 + l32) * 264 + kk * 16 + hl * 8);
                            cacc = __builtin_amdgcn_mfma_f32_32x32x16_bf16(a, b, cacc, 0, 0, 0);
                        }
#pragma unroll
                        for (int i = 0; i < 16; ++i) { const int ii = mi * 32 + crow(i, hl), jj = ni * 32 + l32;
                            const float v = (jj <= ii) ? cacc[i] : 0.f; SC[base * 4096 + ii * 64 + jj] = (bf16_t)(cvt_pk_bf16(v, 0.f) & 0xffffu); }
                    }
                    __syncthreads();
                    for (int q = tid; q < 4096; q += 512) { const int t = q >> 6, cc = (q & 63) * 8;
                        *(u32x4*)(vS + t * 520 + cc) = *(const u32x4*)(PROJ + (size_t)(r0 + t) * 6144 + 2048 + h * 512 + cc); }
                    __syncthreads();
                    {
                        const int dv = tid; u32x4* vdst = (u32x4*)(VT + (base * 512 + dv) * 64);
#pragma unroll
                        for (int q = 0; q < 8; ++q) {
                            unsigned w[4];
#pragma unroll
                            for (int e = 0; e < 4; ++e) { const unsigned lo = vS[(q * 8 + 2 * e) * 520 + dv], hi = vS[(q * 8 + 2 * e + 1) * 520 + dv]; w[e] = lo | (hi << 16); }
                            vdst[q] = (u32x4){w[0], w[1], w[2], w[3]};
                        }
                    }
                    __syncthreads();
                }
            }
            grid.sync();
            {
                PHASE_IDS BASES GLA_PTRS
                float* red = (float*)lds;
                const int l32 = lane & 31, hl = lane >> 5;
#pragma unroll 1
                for (int u = blockIdx.x; u < 1152; u += G) {
                    const bool prompt = u < 128; int b, h, s, cg0, nch, row0;
                    if (prompt) { b = u >> 6; h = (u >> 4) & 3; s = u & 15; cg0 = b * 128; nch = 128; row0 = b * 8192; }
                    else { const int su = u - 128; b = su >> 6; h = (su >> 4) & 3; s = su & 15; cg0 = 256 + b; nch = 1; row0 = MPROMPT + b * 64; }
                    f32x16 S;
                    if (prompt) {
#pragma unroll
                        for (int i = 0; i < 16; ++i) S[i] = 0.f;
                    } else {
                        const float* s0 = IN(4) + ((((size_t)jl * 16 + b) * 4 + h) * 256) * 512;
#pragma unroll
                        for (int i = 0; i < 16; ++i) S[i] = s0[(size_t)(32 * wave + crow(i, hl)) * 512 + 32 * s + l32];
                    }
#pragma unroll 1
                    for (int c = 0; c < nch; ++c) {
                        const size_t base = (size_t)(cg0 + c) * 4 + h; const int r0 = row0 + c * 64;
                        const bf16_t* kdt = KDT + base * 256 * 64; const bf16_t* vt = VT + base * 512 * 64; const bf16_t* sc = SC + base * 4096;
                        bf16x8 ka[4], vb[4];
#pragma unroll
                        for (int ks = 0; ks < 4; ++ks) { ka[ks] = *(const bf16x8*)(kdt + (32 * wave + l32) * 64 + 16 * ks + 8 * hl); vb[ks] = *(const bf16x8*)(vt + (32 * s + l32) * 64 + 16 * ks + 8 * hl); }
                        f32x4 el[4];
#pragma unroll
                        for (int g = 0; g < 4; ++g) el[g] = *(const f32x4*)(EL + base * 256 + 32 * wave + 8 * g + 4 * hl);
                        bf16x8 qf[2][2];
#pragma unroll
                        for (int mt = 0; mt < 2; ++mt)
#pragma unroll
                            for (int s2 = 0; s2 < 2; ++s2) { const bf16_t* pq = QE + (size_t)(r0 + mt * 32 + l32) * 1024 + h * 256 + 32 * wave + 16 * s2 + 4 * hl;
                                const u32x2 lo = *(const u32x2*)pq, hi = *(const u32x2*)(pq + 8); const u32x4 w = (u32x4){lo.x, lo.y, hi.x, hi.y}; qf[mt][s2] = __builtin_bit_cast(bf16x8, w); }
                        const int mtw = wave & 1, ksw = wave >> 1;
                        const bf16x8 scf = *(const bf16x8*)(sc + (mtw * 32 + l32) * 64 + 16 * ksw + 8 * hl);
                        u32x4 sp0, sp1;
                        sp0.x = cvt_pk_bf16(S[0], S[1]); sp0.y = cvt_pk_bf16(S[2], S[3]); sp0.z = cvt_pk_bf16(S[4], S[5]); sp0.w = cvt_pk_bf16(S[6], S[7]);
                        sp1.x = cvt_pk_bf16(S[8], S[9]); sp1.y = cvt_pk_bf16(S[10], S[11]); sp1.z = cvt_pk_bf16(S[12], S[13]); sp1.w = cvt_pk_bf16(S[14], S[15]);
                        const bf16x8 sb0 = __builtin_bit_cast(bf16x8, sp0), sb1 = __builtin_bit_cast(bf16x8, sp1);
                        f32x16 o0, o1;
#pragma unroll
                        for (int i = 0; i < 16; ++i) { o0[i] = 0.f; o1[i] = 0.f; }
                        o0 = __builtin_amdgcn_mfma_f32_32x32x16_bf16(qf[0][0], sb0, o0, 0, 0, 0); o0 = __builtin_amdgcn_mfma_f32_32x32x16_bf16(qf[0][1], sb1, o0, 0, 0, 0);
                        o1 = __builtin_amdgcn_mfma_f32_32x32x16_bf16(qf[1][0], sb0, o1, 0, 0, 0); o1 = __builtin_amdgcn_mfma_f32_32x32x16_bf16(qf[1][1], sb1, o1, 0, 0, 0);
                        bf16x8 vbw = ksw == 0 ? vb[0] : ksw == 1 ? vb[1] : ksw == 2 ? vb[2] : vb[3];
                        if (mtw == 0) o0 = __builtin_amdgcn_mfma_f32_32x32x16_bf16(scf, vbw, o0, 0, 0, 0);
                        else o1 = __builtin_amdgcn_mfma_f32_32x32x16_bf16(scf, vbw, o1, 0, 0, 0);
#pragma unroll
                        for (int i = 0; i < 16; ++i) S[i] *= el[i >> 2][i & 3];
#pragma unroll
                        for (int ks = 0; ks < 4; ++ks) S = __builtin_amdgcn_mfma_f32_32x32x16_bf16(ka[ks], vb[ks], S, 0, 0, 0);
#pragma unroll
                        for (int q = 0; q < 16; ++q) { red[(wave * 32 + q) * 64 + lane] = o0[q]; red[(wave * 32 + 16 + q) * 64 + lane] = o1[q]; }
                        __syncthreads();
                        {
                            const int q = tid >> 4, lg = tid & 15; f32x4 sum = (f32x4){0.f, 0.f, 0.f, 0.f};
#pragma unroll
                            for (int w = 0; w < 8; ++w) sum += *(const f32x4*)(red + (w * 32 + q) * 64 + 4 * lg);
                            const int mt = q >> 4, reg = q & 15, L = 4 * lg; const int i = mt * 32 + crow(reg, L >> 5), dv = L & 31;
                            *(f32x4*)(O + (size_t)(r0 + i) * DM + h * 512 + 32 * s + dv) = sum;
                        }
                        __syncthreads();
                    }
                    float* dst = OUTP + (prompt ? O_PGLA + ((((size_t)jl * 2 + b) * 4 + h) * 256) * 512 : O_SGLA + ((((size_t)jl * 16 + b) * 4 + h) * 256) * 512);
#pragma unroll
                    for (int i = 0; i < 16; ++i) dst[(size_t)(32 * wave + crow(i, hl)) * 512 + 32 * s + l32] = S[i];
                }
            }
            grid.sync();
            {
                PHASE_IDS BASES GLA_PTRS
                const float* hn = IN(33) + (size_t)jl * 512;
                for (int row = gw; row < MROWS; row += NGW) {
#pragma unroll
                    for (int h = 0; h < 4; ++h) {
                        const float* op = O + (size_t)row * DM + h * 512 + lane * 8;
                        const f32x4 a = *(const f32x4*)op, b = *(const f32x4*)(op + 4);
                        float ss = a[0] * a[0] + a[1] * a[1] + a[2] * a[2] + a[3] * a[3] + b[0] * b[0] + b[1] * b[1] + b[2] * b[2] + b[3] * b[3];
                        const float rs = rsqrtf(wave_sum(ss, lane) * (1.f / 512.f) + 1e-5f);
                        float gt[8]; unpack8(*(const u32x4*)(PROJ + (size_t)row * 6144 + 4096 + h * 512 + lane * 8), gt);
                        const f32x4 n0 = *(const f32x4*)(hn + lane * 8), n1 = *(const f32x4*)(hn + lane * 8 + 4);
                        float y[8];
#pragma unroll
                        for (int i = 0; i < 4; ++i) { y[i] = a[i] * rs * n0[i] * (gt[i] * sigmoidf_(gt[i])); y[4 + i] = b[i] * rs * n1[i] * (gt[4 + i] * sigmoidf_(gt[4 + i])); }
                        *(u32x4*)(Y + (size_t)row * DM + h * 512 + lane * 8) = pack8(y);
                    }
                }
            }
            grid.sync();
            {
                BASES GLA_PTRS
                pg8::Gemm g{Y, GO, MROWS, 2048, 2048, 0, 0};
                pg8::StaticOrder S; S.init(g.M, g.N, G, (int)blockIdx.x);
                pg8::Epi<FRes> E{FRes{X}};
                pg8::gemm_phase(ldsl, g, S, E);
            }
            grid.sync();
        }
        {
            { PHASE_IDS BASES FFN_PTRS
            const float* gf = IN(7) + (size_t)layer * DM;
            for (int row = gw; row < MROWS; row += NGW) {
                const f32x4* xr = (const f32x4*)(X + (size_t)row * DM) + lane; f32x4 x[8]; float ss = 0.f;
#pragma unroll
                for (int q = 0; q < 8; ++q) { x[q] = xr[64 * q]; ss += x[q][0] * x[q][0] + x[q][1] * x[q][1] + x[q][2] * x[q][2] + x[q][3] * x[q][3]; }
                const float rs = rsqrtf(wave_sum(ss, lane) * (1.f / DM) + 1e-6f);
#pragma unroll
                for (int q = 0; q < 8; ++q) { const f32x4 gg = *((const f32x4*)gf + lane + 64 * q); const f32x4 h = x[q] * rs * gg;
                    u32x2 w; w.x = cvt_pk_bf16(h[0], h[1]); w.y = cvt_pk_bf16(h[2], h[3]); *((u32x2*)(H + (size_t)row * DM) + lane + 64 * q) = w; }
            } }
            grid.sync();
            {
                BASES FFN_PTRS
                pg8::Gemm g{H, WU, MROWS, F2, 2048, 0, 0};
                pg8::StaticOrder S; S.init(g.M, g.N, G, (int)blockIdx.x);
                pg8::Epi<FUp> E{FUp{U, OUTP + O_PCONV + (size_t)layer * 2 * 2 * F2, OUTP + O_SCONV + (size_t)layer * 16 * 2 * F2}};
                pg8::gemm_phase(ldsl, g, S, E);
            }
            grid.sync();
            {
                PHASE_IDS BASES FFN_PTRS
                const float* cw = IN(36) + (size_t)layer * 3 * F2; const float* cb = IN(37) + (size_t)layer * F2;
                const float* cst = IN(5) + (size_t)layer * 16 * 2 * F2;
#pragma unroll 1
                for (int it = gtid; it < 544 * 704; it += NT) {
                    const int rc = it / 704, c8 = it - rc * 704, col = c8 * 8, r0 = rc * 32;
                    int t0, len, b; bool prompt; row_info(r0, t0, len, b, prompt);
                    float wv[3][8], wg[3][8], bv[8], bg[8];
#pragma unroll
                    for (int k = 0; k < 3; ++k) { const f32x4 a = *(const f32x4*)(cw + (size_t)k * F2 + col), a2 = *(const f32x4*)(cw + (size_t)k * F2 + col + 4);
                        const f32x4 g = *(const f32x4*)(cw + (size_t)k * F2 + FH + col), g2 = *(const f32x4*)(cw + (size_t)k * F2 + FH + col + 4);
#pragma unroll
                        for (int i = 0; i < 4; ++i) { wv[k][i] = a[i]; wv[k][4 + i] = a2[i]; wg[k][i] = g[i]; wg[k][4 + i] = g2[i]; } }
                    { const f32x4 a = *(const f32x4*)(cb + col), a2 = *(const f32x4*)(cb + col + 4), g = *(const f32x4*)(cb + FH + col), g2 = *(const f32x4*)(cb + FH + col + 4);
#pragma unroll
                      for (int i = 0; i < 4; ++i) { bv[i] = a[i]; bv[4 + i] = a2[i]; bg[i] = g[i]; bg[4 + i] = g2[i]; } }
                    float v2[8], v1[8], g2_[8], g1_[8];
                    if (t0 > 0) {
                        unpack8(*(const u32x4*)(U + (size_t)(r0 - 2) * F2 + col), v2); unpack8(*(const u32x4*)(U + (size_t)(r0 - 1) * F2 + col), v1);
                        unpack8(*(const u32x4*)(U + (size_t)(r0 - 2) * F2 + FH + col), g2_); unpack8(*(const u32x4*)(U + (size_t)(r0 - 1) * F2 + FH + col), g1_);
                    } else if (!prompt) {
                        const float* s0 = cst + ((size_t)b * 2) * F2 + col; const float* s1 = s0 + F2;
#pragma unroll
                        for (int i = 0; i < 8; ++i) { v2[i] = s0[i]; v1[i] = s1[i]; g2_[i] = s0[FH + i]; g1_[i] = s1[FH + i]; }
                    } else {
#pragma unroll
                        for (int i = 0; i < 8; ++i) { v2[i] = 0.f; v1[i] = 0.f; g2_[i] = 0.f; g1_[i] = 0.f; }
                    }
#pragma unroll 2
                    for (int r = 0; r < 32; ++r) {
                        float v0[8], g0[8];
                        unpack8(*(const u32x4*)(U + (size_t)(r0 + r) * F2 + col), v0); unpack8(*(const u32x4*)(U + (size_t)(r0 + r) * F2 + FH + col), g0);
                        float y[8];
#pragma unroll
                        for (int i = 0; i < 8; ++i) {
                            const float cv = bv[i] + wv[0][i] * v2[i] + wv[1][i] * v1[i] + wv[2][i] * v0[i];
                            const float cg_ = bg[i] + wg[0][i] * g2_[i] + wg[1][i] * g1_[i] + wg[2][i] * g0[i];
                            y[i] = cg_ * sigmoidf_(cg_) * cv;
                            v2[i] = v1[i]; v1[i] = v0[i]; g2_[i] = g1_[i]; g1_[i] = g0[i];
                        }
                        *(u32x4*)(HID + (size_t)(r0 + r) * FH + col) = pack8(y);
                    }
                }
            }
            grid.sync();
            {
                BASES FFN_PTRS
                pg8::Gemm g{HID, WD, MROWS, 2048, FH, 0, 0};
                pg8::StaticOrder S; S.init(g.M, g.N, G, (int)blockIdx.x);
                pg8::Epi<FRes> E{FRes{X}};
                pg8::gemm_phase(ldsl, g, S, E);
            }
            grid.sync();
        }
    }
    {
        PHASE_IDS BASES
        const float* gn = IN(8);
        for (int row = gw; row < MROWS; row += NGW) {
            f32x4* xr = (f32x4*)(X + (size_t)row * DM) + lane; f32x4 x[8]; float ss = 0.f;
#pragma unroll
            for (int q = 0; q < 8; ++q) { x[q] = xr[64 * q]; ss += x[q][0] * x[q][0] + x[q][1] * x[q][1] + x[q][2] * x[q][2] + x[q][3] * x[q][3]; }
            const float rs = rsqrtf(wave_sum(ss, lane) * (1.f / DM) + 1e-6f);
#pragma unroll
            for (int q = 0; q < 8; ++q) { const f32x4 gg = *((const f32x4*)gn + lane + 64 * q); xr[64 * q] = x[q] * rs * gg; }
        }
    }
}

extern "C" void kernel_launch(void* const* d_in, const int* in_sizes, int n_in, void* d_out, int out_size, void* d_ws, size_t ws_size, hipStream_t stream) {
    static int grid = 0;
    if (grid == 0) {
        if (n_in != 39 || (size_t)out_size != O_TOTAL || ws_size < WS_END) {
            fprintf(stderr, "kernel_launch: unexpected shapes: n_in %d out %d ws %zu (need %zu)\n", n_in, out_size, ws_size, (size_t)WS_END); grid = -1; return; }
        int dev = 0, cus = 0, per_cu = 0;
        (void)hipGetDevice(&dev);
        (void)hipDeviceGetAttribute(&cus, hipDeviceAttributeMultiprocessorCount, dev);
        if (hipFuncSetAttribute((const void*)fwd_kernel, hipFuncAttributeMaxDynamicSharedMemorySize, LDS_BYTES) != hipSuccess) { fprintf(stderr, "kernel_launch: hipFuncSetAttribute failed\n"); grid = -1; return; }
        if (hipOccupancyMaxActiveBlocksPerMultiprocessor(&per_cu, (const void*)fwd_kernel, 512, LDS_BYTES) != hipSuccess || per_cu < 1) { fprintf(stderr, "kernel_launch: occupancy query says %d\n", per_cu); per_cu = 1; }
        (void)hipGetLastError();
        grid = cus * 1;
        if (grid <= 0) grid = 256;
    }
    if (grid < 0) return;
    P prm{};
    for (int i = 0; i < 39; ++i) prm.in[i] = (const float*)d_in[i];
    prm.out = (float*)d_out; prm.ws = (unsigned char*)d_ws;
    void* args[] = {&prm};
    hipError_t e = hipLaunchCooperativeKernel((const void*)fwd_kernel, dim3(grid), dim3(512), args, LDS_BYTES, stream);
    if (e != hipSuccess) fprintf(stderr, "cooperative launch failed: %s (grid %d)\n", hipGetErrorString(e), grid);
}
```

```cpp
#include <hip/hip_runtime.h>
#include <hip/hip_cooperative_groups.h>
#include <cstdio>
#include <cstdint>
namespace cg = cooperative_groups;

#define LAS __attribute__((address_space(3)))
typedef unsigned short bf16_t;
typedef short bf16x8 __attribute__((ext_vector_type(8)));
typedef float f32x4 __attribute__((ext_vector_type(4)));
typedef float f32x16 __attribute__((ext_vector_type(16)));
typedef unsigned u32x4 __attribute__((ext_vector_type(4)));
typedef unsigned u32x2 __attribute__((ext_vector_type(2)));

constexpr int DM = 2048, MROWS = 17408, MPROMPT = 16384;
constexpr int FH = 5632, F2 = 11264;
constexpr int LDS_BYTES = 147456;
constexpr size_t MiB = 1u << 20;
constexpr size_t WS_WT = 1 * MiB;
constexpr size_t WS_A = 411 * MiB;
constexpr size_t WS_B = 819 * MiB;
constexpr size_t WS_VF = 1227 * MiB;
constexpr size_t WS_END = 1295 * MiB;
constexpr size_t ACT = (size_t)MROWS * DM;
constexpr size_t RW_SZ = (size_t)7168 * 2048 + (size_t)8192 * 256 + (size_t)2048 * 2048;
constexpr size_t GW_SZ = (size_t)6400 * 2048 + (size_t)2048 * 2048;
constexpr size_t FW_SZ = (size_t)11264 * 2048 + (size_t)2048 * 5632;
constexpr size_t GW_OFF = 2 * RW_SZ, FW_OFF = GW_OFF + 2 * GW_SZ;
constexpr size_t O_PSHIFT = 35651584, O_PWKV = 35659776, O_PGLA = 36184064, O_PCONV = 38281216;
constexpr size_t O_SSHIFT = 38461440, O_SWKV = 38526976, O_SGLA = 42721280, O_SCONV = 59498496, O_TOTAL = 60940288;

__device__ __forceinline__ unsigned cvt_pk_bf16(float lo, float hi) { unsigned r; asm volatile("v_cvt_pk_bf16_f32 %0, %1, %2" : "=v"(r) : "v"(lo), "v"(hi)); return r; }
__device__ __forceinline__ float bf2f(bf16_t b) { return __builtin_bit_cast(float, (unsigned)b << 16); }
__device__ __forceinline__ float bflo(unsigned u) { return __builtin_bit_cast(float, u << 16); }
__device__ __forceinline__ float bfhi(unsigned u) { return __builtin_bit_cast(float, u & 0xffff0000u); }
__device__ __forceinline__ void unpack8(u32x4 w, float (&f)[8]) {
    f[0] = bflo(w.x); f[1] = bfhi(w.x); f[2] = bflo(w.y); f[3] = bfhi(w.y); f[4] = bflo(w.z); f[5] = bfhi(w.z); f[6] = bflo(w.w); f[7] = bfhi(w.w);
}
__device__ __forceinline__ u32x4 pack8(const float (&f)[8]) {
    u32x4 w; w.x = cvt_pk_bf16(f[0], f[1]); w.y = cvt_pk_bf16(f[2], f[3]); w.z = cvt_pk_bf16(f[4], f[5]); w.w = cvt_pk_bf16(f[6], f[7]); return w;
}
__device__ __forceinline__ float sigmoidf_(float x) { return 1.f / (1.f + __expf(-x)); }
__device__ __forceinline__ float shx(float v, int lane, int o) { return __builtin_bit_cast(float, __builtin_amdgcn_ds_bpermute((lane ^ o) << 2, __builtin_bit_cast(int, v))); }
__device__ __forceinline__ float wave_sum(float v, int lane) {
#pragma unroll
    for (int o = 1; o < 64; o <<= 1) v += shx(v, lane, o);
    return v;
}
__device__ __forceinline__ float sum8(float v, int lane) { v += shx(v, lane, 1); v += shx(v, lane, 2); v += shx(v, lane, 4); return v; }
__device__ __forceinline__ int crow(int reg, int h) { return (reg & 3) + 8 * (reg >> 2) + 4 * h; }

namespace pg8 {
constexpr int BM = 256, BK = 64, HALF = 128, HTB = HALF * BK * 2, STAGE_BYTES = 8 * HTB, NXCD = 8, WGM = 8;
__host__ __device__ __forceinline__ int lds_byte(int r, int c) { const int st = (r >> 4) * 2 + (c >> 5), rr = r & 15, cc = c & 31, ob = rr * 64 + cc * 2; return st * 1024 + (ob ^ (((ob >> 9) & 1) << 5)); }
__host__ __device__ __forceinline__ void stage_rc(int b, int& R, int& C) { const int st = b / 1024, sb = b % 1024, swz = sb ^ (((sb >> 9) & 1) << 5); R = (st >> 1) * 16 + swz / 64; C = (st & 1) * 32 + (swz % 64) / 2; }
__host__ __device__ __forceinline__ int perm32(int rho) { const int n = rho >> 4, i = rho & 15; return 8 * (i >> 2) + 4 * n + (i & 3); }

struct Unit { int pm, pn; };
struct Gemm { const bf16_t* A; const bf16_t* Bt; int M, N, K; int mode; size_t astride; };
__device__ __forceinline__ const char* a_of(const Gemm& g, int pn) {
    int s = 0;
    if (g.mode == 1) s = pn < 8 ? 0 : pn < 16 ? 2 : pn < 24 ? 3 : pn == 24 ? 1 : pn == 25 ? 4 : pn == 26 ? 5 : 3;
    else if (g.mode == 2) s = pn >> 3;
    return (const char*)g.A + (size_t)s * g.astride;
}
struct StaticOrder {
    int nM, nN, nwg, G, c;
    __device__ void init(int M, int N, int G_, int c_) { nM = M / BM; nN = N / BM; nwg = nM * nN; G = G_; c = c_; }
    __device__ bool next(int i, Unit& u) const {
        const long L = (long)i * G + c; if (L >= nwg) return false;
        int wgid = (int)L; { const int q = nwg / NXCD, r = nwg % NXCD, xcd = wgid % NXCD, off = wgid / NXCD; wgid = (xcd < r ? xcd * (q + 1) : r * (q + 1) + (xcd - r) * q) + off; }
        const int nig = WGM * nN, gid = wgid / nig, fm = gid * WGM, gsz = (nM - fm) < WGM ? (nM - fm) : WGM;
        u.pm = fm + ((wgid % nig) % gsz); u.pn = (wgid % nig) / gsz; return true;
    }
};

template <class F> struct Epi {
    static constexpr bool PERM = true;
    F f;
    __device__ __forceinline__ void operator()(const f32x4 (&acc)[2][2][4][2], const Unit& u, int wr, int wc, int fr, int fq) const {
        { int t_ = threadIdx.x; asm volatile("" : "+v"(t_)); const int l_ = t_ & 63, w_ = __builtin_amdgcn_readfirstlane(t_ >> 6); fr = l_ & 15; fq = l_ >> 4; wr = w_ >> 2; wc = w_ & 3; }
        const int row0 = u.pm * BM + wr * 64 + fr, col0 = u.pn * BM + wc * 32 + 8 * fq;
#pragma unroll
        for (int ai = 0; ai < 2; ++ai)
#pragma unroll
            for (int m = 0; m < 4; ++m)
#pragma unroll
                for (int bj = 0; bj < 2; ++bj) f(row0 + ai * HALF + m * 16, col0 + bj * HALF, acc[ai][bj][m][0], acc[ai][bj][m][1]);
    }
};

template <class EpiT>
__device__ __forceinline__ void gemm_phase(LAS unsigned char* lds, const Gemm g, const StaticOrder& S, const EpiT& E) {
    int tid = threadIdx.x; asm volatile("" : "+v"(tid));
    const int wid = __builtin_amdgcn_readfirstlane(tid >> 6), lane = tid & 63, wr = wid >> 2, wc = wid & 3, fr = lane & 15, fq = lane >> 4;
    const int K = g.K, nt = K / BK;
    unsigned voffA[2], voffB[2];
#pragma unroll
    for (int i = 0; i < 2; ++i) { int R, C; stage_rc(tid * 16 + i * 8192, R, C); const int Rb = EpiT::PERM ? ((R & ~31) + perm32(R & 31)) : R;
        voffA[i] = (unsigned)(R * K + C) * 2u; voffB[i] = (unsigned)(Rb * K + C) * 2u; }
    const size_t kstep = (size_t)(BK * 2);
    const size_t hstep = (size_t)HALF * K * 2;
    const size_t tstep = 2 * hstep;
    const unsigned ldsw = (unsigned)wid * 1024u;
    const int aoff = lds_byte(wr * 64 + fr, fq * 8), boff = lds_byte(wc * 32 + fr, fq * 8);
#define PG8_SA(b, h) (((b) * 2 + (h)) * HTB)
#define PG8_SB(b, h) ((4 + (b) * 2 + (h)) * HTB)
#define PG8_STAGE(bufoff, gbase, voff) do { _Pragma("unroll") for (int _i = 0; _i < 2; ++_i) \
        __builtin_amdgcn_global_load_lds((const unsigned*)((const char*)(gbase) + (voff)[_i]), (LAS unsigned*)(lds + (bufoff) + ldsw + _i * 8192), 16, 0, 0); } while (0)
#define PG8_LDA(dst, b, h) do { _Pragma("unroll") for (int m = 0; m < 4; ++m) _Pragma("unroll") for (int k = 0; k < 2; ++k) dst[m][k] = *(const LAS bf16x8*)(lds + PG8_SA(b, h) + aoff + m * 2048 + k * 1024); } while (0)
#define PG8_LDB(dst, b, h) do { _Pragma("unroll") for (int n = 0; n < 2; ++n) _Pragma("unroll") for (int k = 0; k < 2; ++k) dst[n][k] = *(const LAS bf16x8*)(lds + PG8_SB(b, h) + boff + n * 2048 + k * 1024); } while (0)
#define PG8_MMA(ai, bj, At, Bt) do { __builtin_amdgcn_s_setprio(1); _Pragma("unroll") for (int m = 0; m < 4; ++m) _Pragma("unroll") for (int n = 0; n < 2; ++n) _Pragma("unroll") for (int k = 0; k < 2; ++k) \
        acc[ai][bj][m][n] = __builtin_amdgcn_mfma_f32_16x16x32_bf16(Bt[n][k], At[m][k], acc[ai][bj][m][n], 0, 0, 0); __builtin_amdgcn_s_setprio(0); } while (0)
#define PG8_WAIT_V(n) asm volatile("s_waitcnt vmcnt(" #n ")" ::: "memory")
#define PG8_WAIT_L(n) asm volatile("s_waitcnt lgkmcnt(" #n ")" ::: "memory")
#define PG8_BAR __builtin_amdgcn_s_barrier()
#define PG8_SCHED __builtin_amdgcn_sched_barrier(0)
    Unit cur, nxt; int ui = 0;
    if (!S.next(0, cur)) return;
    f32x4 acc[2][2][4][2];
#pragma unroll
    for (int a = 0; a < 2; ++a)
#pragma unroll
        for (int b = 0; b < 2; ++b)
#pragma unroll
            for (int m = 0; m < 4; ++m)
#pragma unroll
                for (int n = 0; n < 2; ++n) acc[a][b][m][n] = (f32x4){0.f, 0.f, 0.f, 0.f};
    bf16x8 At[4][2], B0[2][2], B1[2][2];
    const char* cA = a_of(g, cur.pn) + (size_t)cur.pm * tstep; const char* cB = (const char*)g.Bt + (size_t)cur.pn * tstep;
    PG8_STAGE(PG8_SB(0, 0), cB, voffB); PG8_STAGE(PG8_SB(0, 1), cB + hstep, voffB); PG8_STAGE(PG8_SA(0, 0), cA, voffA); PG8_STAGE(PG8_SA(0, 1), cA + hstep, voffA);
    if (wr == 1) PG8_BAR;
    PG8_WAIT_V(2); PG8_BAR;
    PG8_STAGE(PG8_SB(1, 0), cB + kstep, voffB); PG8_STAGE(PG8_SA(1, 0), cA + kstep, voffA); PG8_STAGE(PG8_SB(1, 1), cB + hstep + kstep, voffB);
    PG8_WAIT_V(6); PG8_BAR;
    for (;;) {
        const bool has_next = S.next(ui + 1, nxt);
        const char* nA = has_next ? a_of(g, nxt.pn) + (size_t)nxt.pm * tstep : cA; const char* nB = has_next ? (const char*)g.Bt + (size_t)nxt.pn * tstep : cB;
        for (int t = 0; t < nt; t += 2) {
            const bool last = (t == nt - 2);
            const char* a1 = cA + (size_t)(t + 1) * kstep;
            const char* a2 = last ? nA : cA + (size_t)(t + 2) * kstep; const char* b2 = last ? nB : cB + (size_t)(t + 2) * kstep;
            const char* a3 = a2 + kstep; const char* b3 = b2 + kstep;
            PG8_LDB(B0, 0, 0); PG8_LDB(B1, 0, 1); PG8_SCHED; PG8_LDA(At, 0, 0); PG8_STAGE(PG8_SA(1, 1), a1 + hstep, voffA);
            PG8_WAIT_V(8); PG8_WAIT_L(0); PG8_BAR; PG8_MMA(0, 0, At, B0); PG8_MMA(0, 1, At, B1); PG8_BAR; PG8_SCHED;
            PG8_LDA(At, 0, 1); PG8_STAGE(PG8_SB(0, 0), b2, voffB); PG8_STAGE(PG8_SB(0, 1), b2 + hstep, voffB); PG8_STAGE(PG8_SA(0, 0), a2, voffA);
            PG8_WAIT_V(8); PG8_WAIT_L(0); PG8_BAR; PG8_MMA(1, 0, At, B0); PG8_MMA(1, 1, At, B1); PG8_BAR; PG8_SCHED;
            PG8_LDB(B0, 1, 0); PG8_LDB(B1, 1, 1); PG8_SCHED; PG8_LDA(At, 1, 0); PG8_STAGE(PG8_SA(0, 1), a2 + hstep, voffA);
            PG8_WAIT_V(8); PG8_WAIT_L(0); PG8_BAR; PG8_MMA(0, 0, At, B0); PG8_MMA(0, 1, At, B1); PG8_BAR; PG8_SCHED;
            PG8_LDA(At, 1, 1); PG8_STAGE(PG8_SB(1, 0), b3, voffB); PG8_STAGE(PG8_SB(1, 1), b3 + hstep, voffB); PG8_STAGE(PG8_SA(1, 0), a3, voffA);
            PG8_WAIT_V(8); PG8_WAIT_L(0); PG8_BAR; PG8_MMA(1, 0, At, B0); PG8_MMA(1, 1, At, B1); PG8_BAR; PG8_SCHED;
        }
        if (wr == 0) PG8_BAR;
        E(acc, cur, wr, wc, fr, fq);
        if (!has_next) break;
#pragma unroll
        for (int a = 0; a < 2; ++a)
#pragma unroll
            for (int b = 0; b < 2; ++b)
#pragma unroll
                for (int m = 0; m < 4; ++m)
#pragma unroll
                    for (int n = 0; n < 2; ++n) acc[a][b][m][n] = (f32x4){0.f, 0.f, 0.f, 0.f};
        cur = nxt; cA = nA; cB = nB; ++ui;
        if (wr == 1) PG8_BAR;
    }
    PG8_WAIT_V(0);
    PG8_BAR;
#undef PG8_SA
#undef PG8_SB
#undef PG8_STAGE
#undef PG8_LDA
#undef PG8_LDB
#undef PG8_MMA
#undef PG8_WAIT_V
#undef PG8_WAIT_L
#undef PG8_BAR
#undef PG8_SCHED
}
}

__device__ __forceinline__ void store8bf(bf16_t* p, f32x4 a, f32x4 b) {
    u32x4 w; w.x = cvt_pk_bf16(a[0], a[1]); w.y = cvt_pk_bf16(a[2], a[3]); w.z = cvt_pk_bf16(b[0], b[1]); w.w = cvt_pk_bf16(b[2], b[3]);
    *(u32x4*)p = w;
}
struct FRes { float* X;
    __device__ __forceinline__ void operator()(int row, int col, f32x4 a, f32x4 b) const {
        float* p = X + (size_t)row * DM + col; f32x4 x0 = *(f32x4*)p, x1 = *(f32x4*)(p + 4); *(f32x4*)p = x0 + a; *(f32x4*)(p + 4) = x1 + b; } };
struct FR1 { bf16_t *R, *K, *V, *L;
    __device__ __forceinline__ void operator()(int row, int col, f32x4 a, f32x4 b) const {
        if (col < 6144) { const int g = col >> 11; const size_t o = (size_t)row * DM + (col & 2047); if (g == 0) store8bf(R + o, a, b); else if (g == 1) store8bf(K + o, a, b); else store8bf(V + o, a, b); }
        else { const int t = (col - 6144) >> 8, c = col & 255;
            if (t == 0) { for (int i = 0; i < 4; ++i) { a[i] = 1.f - 2.f / (1.f + __expf(2.f * a[i])); b[i] = 1.f - 2.f / (1.f + __expf(2.f * b[i])); } }
            else if (t == 2) { for (int i = 0; i < 4; ++i) { a[i] = sigmoidf_(a[i]); b[i] = sigmoidf_(b[i]); } }
            store8bf(L + (size_t)t * MROWS * 256 + (size_t)row * 256 + c, a, b); } } };
__device__ __forceinline__ float decay_of(float z) { return -0.60653065971f / (1.f + __expf(-z)); }
struct FR2 { float* DD; bf16_t *AA, *GG, *VG; const float *w0, *a0, *v0;
    __device__ __forceinline__ void operator()(int row, int col, f32x4 a, f32x4 b) const {
        const int g = col >> 11, c = col & 2047; const size_t off = (size_t)row * DM + c;
        if (g == 0) { f32x4 z0 = *(const f32x4*)(w0 + c), z1 = *(const f32x4*)(w0 + c + 4); a += z0; b += z1;
            for (int i = 0; i < 4; ++i) { a[i] = decay_of(a[i]); b[i] = decay_of(b[i]); }
            *(f32x4*)(DD + off) = a; *(f32x4*)(DD + off + 4) = b; }
        else if (g == 1) { f32x4 z0 = *(const f32x4*)(a0 + c), z1 = *(const f32x4*)(a0 + c + 4); a += z0; b += z1;
            for (int i = 0; i < 4; ++i) { a[i] = sigmoidf_(a[i]); b[i] = sigmoidf_(b[i]); } store8bf(AA + off, a, b); }
        else if (g == 2) { store8bf(GG + off, a, b); }
        else { f32x4 z0 = *(const f32x4*)(v0 + c), z1 = *(const f32x4*)(v0 + c + 4); a += z0; b += z1;
            for (int i = 0; i < 4; ++i) { a[i] = sigmoidf_(a[i]); b[i] = sigmoidf_(b[i]); } store8bf(VG + off, a, b); } } };
struct FG1 { bf16_t* PROJ; float* LR;
    __device__ __forceinline__ void operator()(int row, int col, f32x4 a, f32x4 b) const {
        if (col < 6144) { if (col < 1024) { a *= 0.0625f; b *= 0.0625f; } store8bf(PROJ + (size_t)row * 6144 + col, a, b); }
        else if (col < 6160) { float* p = LR + (size_t)row * 16 + (col - 6144); *(f32x4*)p = a; *(f32x4*)(p + 4) = b; } } };
struct FUp { bf16_t* U; float* pconv; float* sconv;
    __device__ __forceinline__ void operator()(int row, int col, f32x4 a, f32x4 b) const {
        store8bf(U + (size_t)row * F2 + col, a, b);
        if (row < MPROMPT) { const int t = row & 8191; if (t >= 8190) { float* p = pconv + ((size_t)((row >> 13) * 2 + (t - 8190))) * F2 + col; *(f32x4*)p = a; *(f32x4*)(p + 4) = b; } }
        else { const int rr = row - MPROMPT, t = rr & 63; if (t >= 62) { float* p = sconv + ((size_t)((rr >> 6) * 2 + (t - 62))) * F2 + col; *(f32x4*)p = a; *(f32x4*)(p + 4) = b; } } } };

__device__ __forceinline__ void tr_item(const float* W, int K, int N, bf16_t* WT, int Kpad, int Npad, float* scr, int item, int lane) {
    const int nblk = Npad / 32, kb = item / nblk, nb = item % nblk, k0 = 64 * kb, n0 = 32 * nb;
    const int n = n0 + (lane & 31);
#pragma unroll
    for (int i = 0; i < 32; ++i) { const int kk = 2 * i + (lane >> 5); const int k = k0 + kk; scr[kk * 33 + (lane & 31)] = (k < K && n < N) ? W[(size_t)k * N + n] : 0.f; }
    asm volatile("s_waitcnt lgkmcnt(0)" ::: "memory");
    const int c = lane & 7;
#pragma unroll
    for (int j = 0; j < 4; ++j) { const int nn = (lane >> 3) + 8 * j; const float* s = scr + (8 * c) * 33 + nn;
        u32x4 o; o.x = cvt_pk_bf16(s[0 * 33], s[1 * 33]); o.y = cvt_pk_bf16(s[2 * 33], s[3 * 33]); o.z = cvt_pk_bf16(s[4 * 33], s[5 * 33]); o.w = cvt_pk_bf16(s[6 * 33], s[7 * 33]);
        *(u32x4*)(WT + (size_t)(n0 + nn) * Kpad + k0 + 8 * c) = o; }
    asm volatile("s_waitcnt lgkmcnt(0)" ::: "memory");
}

struct P { const float* in[39]; float* out; unsigned char* ws; };

__device__ __forceinline__ void row_info(int row, int& t, int& len, int& b, bool& prompt) {
    if (row < MPROMPT) { prompt = true; b = row >> 13; t = row & 8191; len = 8192; }
    else { prompt = false; const int rr = row - MPROMPT; b = rr >> 6; t = rr & 63; len = 64; }
}

__device__ __forceinline__ const float* ldp(const unsigned long long* tab, int i) {
    const unsigned long long v = tab[i];
    const unsigned lo = __builtin_amdgcn_readfirstlane((unsigned)v), hi = __builtin_amdgcn_readfirstlane((unsigned)(v >> 32));
    const __attribute__((address_space(1))) float* g = (const __attribute__((address_space(1))) float*)(((unsigned long long)hi << 32) | lo);
    return (const float*)g;
}
__device__ __forceinline__ void fast_grid_barrier(unsigned* bar, unsigned long long* tab) {
    asm volatile("s_waitcnt vmcnt(0)" ::: "memory");
    __syncthreads();
    if (threadIdx.x == 0) {
        const unsigned G = gridDim.x, grp = blockIdx.x & 7u;
        const unsigned epoch = (unsigned)tab[41] + 1u; tab[41] = epoch;
        const unsigned ngrp = (G - grp + 7u) >> 3, ntop = G < 8u ? G : 8u;
        __builtin_amdgcn_fence(__ATOMIC_RELEASE, "agent");
        asm volatile("s_waitcnt vmcnt(0)" ::: "memory");
        const unsigned old = __hip_atomic_fetch_add(&bar[64u * (1u + grp)], 1u, __ATOMIC_RELAXED, __HIP_MEMORY_SCOPE_AGENT);
        if (old + 1u == epoch * ngrp) (void)__hip_atomic_fetch_add(&bar[0], 1u, __ATOMIC_RELAXED, __HIP_MEMORY_SCOPE_AGENT);
        while (__hip_atomic_load(&bar[0], __ATOMIC_RELAXED, __HIP_MEMORY_SCOPE_AGENT) < epoch * ntop) __builtin_amdgcn_s_sleep(1);
        __builtin_amdgcn_fence(__ATOMIC_ACQUIRE, "agent");
        asm volatile("s_waitcnt vmcnt(0)" ::: "memory");
    }
    __syncthreads();
}
#define IN(k) ldp(tab, (k))
#define OUTP ((float*)ldp(tab, 39))
#define BASES float* X = (float*)ldp(tab, 39); unsigned char* ws_ = (unsigned char*)ldp(tab, 40); bf16_t* WT = (bf16_t*)(ws_ + WS_WT); unsigned char* RA = ws_ + WS_A; unsigned char* RB = ws_ + WS_B; \
    bf16_t* VFIRST = (bf16_t*)(ws_ + WS_VF); LAS unsigned char* ldsl = (LAS unsigned char*)lds; (void)X; (void)WT; (void)RA; (void)RB; (void)VFIRST; (void)ldsl;
#define RWKV_PTRS bf16_t* HB = (bf16_t*)RA; bf16_t* Rb = (bf16_t*)RB; bf16_t* Kb = Rb + ACT; bf16_t* Vb = (jl == 0) ? VFIRST : Kb + ACT; bf16_t* Lb = (bf16_t*)(RB + 204 * MiB); \
    float* DD = (float*)(RB + 240 * MiB); bf16_t* AA = (bf16_t*)RA; bf16_t* VG = AA + ACT; bf16_t* GG = VG + ACT; bf16_t* Y = GG + ACT; \
    bf16_t* W1 = WT + jl * RW_SZ; bf16_t* W2 = W1 + (size_t)7168 * 2048; bf16_t* WO = W2 + (size_t)8192 * 256; \
    (void)HB; (void)Rb; (void)Kb; (void)Vb; (void)Lb; (void)DD; (void)AA; (void)VG; (void)GG; (void)Y; (void)W1; (void)W2; (void)WO;
#define GLA_PTRS bf16_t* H = (bf16_t*)RB; float* LR = (float*)(RB + 68 * MiB); float* O = (float*)(RB + 70 * MiB); bf16_t* Y = (bf16_t*)(RB + 206 * MiB); \
    bf16_t* PROJ = (bf16_t*)RA; bf16_t* QE = (bf16_t*)(RA + 204 * MiB); bf16_t* KDT = (bf16_t*)(RA + 238 * MiB); bf16_t* VT = (bf16_t*)(RA + 272 * MiB); \
    bf16_t* SC = (bf16_t*)(RA + 340 * MiB); float* EL = (float*)(RA + 349 * MiB); bf16_t* GI = WT + GW_OFF + jl * GW_SZ; bf16_t* GO = GI + (size_t)6400 * 2048; \
    (void)H; (void)LR; (void)O; (void)Y; (void)PROJ; (void)QE; (void)KDT; (void)VT; (void)SC; (void)EL; (void)GI; (void)GO;
#define FFN_PTRS bf16_t* H = (bf16_t*)RB; bf16_t* HID = (bf16_t*)(RB + 68 * MiB); bf16_t* U = (bf16_t*)RA; bf16_t* WU = WT + FW_OFF + layer * FW_SZ; bf16_t* WD = WU + (size_t)F2 * 2048; \
    (void)H; (void)HID; (void)U; (void)WU; (void)WD;

__global__ void __launch_bounds__(512, 2) fwd_kernel(P p) {
    extern __shared__ __attribute__((aligned(16))) unsigned char lds[];
    cg::grid_group grid = cg::this_grid();
    const int G = gridDim.x, NGW = G * 8, NT = G * 512;
#define PHASE_IDS int tid = threadIdx.x; asm volatile("" : "+v"(tid)); const int lane = tid & 63; const int wave = __builtin_amdgcn_readfirstlane(tid >> 6); const int gw = blockIdx.x * 8 + wave; const int gtid = blockIdx.x * 512 + tid; (void)lane; (void)gw; (void)gtid;
    unsigned long long* tab = (unsigned long long*)(lds + LDS_BYTES - 512);
    if (threadIdx.x == 0) {
#pragma unroll
        for (int i = 0; i < 39; ++i) tab[i] = (unsigned long long)p.in[i];
        tab[39] = (unsigned long long)p.out; tab[40] = (unsigned long long)p.ws; tab[41] = 0ull;
    }
    __syncthreads();

    {
        PHASE_IDS BASES
        float* scr = (float*)(lds + wave * 16384);
#define TR(src, K, N, dst, Kpad, Npad) do { const int _ni = ((Kpad) / 64) * ((Npad) / 32); for (int it = gw; it < _ni; it += NGW) tr_item((src), (K), (N), (dst), (Kpad), (Npad), scr, it, lane); } while (0)
#pragma unroll 1
        for (int j = 0; j < 2; ++j) {
            bf16_t* W1 = WT + j * RW_SZ; bf16_t* W2 = W1 + (size_t)7168 * 2048; bf16_t* WO = W2 + (size_t)8192 * 256;
            TR(IN(24) + (size_t)j * DM * DM, 2048, 2048, W1, 2048, 2048);
            TR(IN(25) + (size_t)j * DM * DM, 2048, 2048, W1 + (size_t)2048 * 2048, 2048, 2048);
            TR(IN(26) + (size_t)j * DM * DM, 2048, 2048, W1 + (size_t)4096 * 2048, 2048, 2048);
            TR(IN(11) + (size_t)j * DM * 96, 2048, 96, W1 + (size_t)6144 * 2048, 2048, 256);
            TR(IN(14) + (size_t)j * DM * 96, 2048, 96, W1 + (size_t)6400 * 2048, 2048, 256);
            TR(IN(19) + (size_t)j * DM * 256, 2048, 256, W1 + (size_t)6656 * 2048, 2048, 256);
            if (j >= 1) TR(IN(17) + (size_t)(j - 1) * DM * 64, 2048, 64, W1 + (size_t)6912 * 2048, 2048, 256);
            TR(IN(12) + (size_t)j * 96 * DM, 96, 2048, W2, 256, 2048);
            TR(IN(15) + (size_t)j * 96 * DM, 96, 2048, W2 + (size_t)2048 * 256, 256, 2048);
            TR(IN(20) + (size_t)j * 256 * DM, 256, 2048, W2 + (size_t)4096 * 256, 256, 2048);
            if (j >= 1) TR(IN(18) + (size_t)(j - 1) * 64 * DM, 64, 2048, W2 + (size_t)6144 * 256, 256, 2048);
            TR(IN(27) + (size_t)j * DM * DM, 2048, 2048, WO, 2048, 2048);
            bf16_t* GI = WT + GW_OFF + j * GW_SZ; bf16_t* GO = GI + (size_t)6400 * 2048;
            TR(IN(30) + (size_t)j * DM * 6160, 2048, 6160, GI, 2048, 6400);
            TR(IN(34) + (size_t)j * DM * DM, 2048, 2048, GO, 2048, 2048);
        }
#pragma unroll 1
        for (int i = 0; i < 4; ++i) {
            bf16_t* WU = WT + FW_OFF + i * FW_SZ; bf16_t* WD = WU + (size_t)F2 * 2048;
            TR(IN(35) + (size_t)i * DM * F2, 2048, F2, WU, 2048, F2);
            TR(IN(38) + (size_t)i * FH * DM, FH, 2048, WD, FH, 2048);
        }
#undef TR
        const f32x4* xp = (const f32x4*)IN(0); const f32x4* xs = (const f32x4*)IN(1); f32x4* xo = (f32x4*)X;
        const int NP4 = MPROMPT * DM / 4, NA4 = MROWS * DM / 4;
#pragma unroll 4
        for (int i = gtid; i < NA4; i += NT) xo[i] = i < NP4 ? xp[i] : xs[i - NP4];
    }
    grid.sync();

#pragma clang loop unroll(full)
    for (int layer = 0; layer < 4; ++layer) {
        const int jl = layer >> 1;
        if ((layer & 1) == 0) {
            {
                PHASE_IDS BASES RWKV_PTRS
                const float* gmix = IN(6) + (size_t)layer * DM;
                const float* mix = IN(9) + (size_t)jl * 6 * DM;
                const float* sst = IN(2) + (size_t)jl * 16 * DM;
                for (int row = gw; row < MROWS; row += NGW) {
                    int t, len, b; bool prompt; row_info(row, t, len, b, prompt);
                    const f32x4* xr = (const f32x4*)(X + (size_t)row * DM) + lane;
                    f32x4 x[8]; float ss = 0.f;
#pragma unroll
                    for (int q = 0; q < 8; ++q) { x[q] = xr[64 * q]; ss += x[q][0] * x[q][0] + x[q][1] * x[q][1] + x[q][2] * x[q][2] + x[q][3] * x[q][3]; }
                    const float rs = rsqrtf(wave_sum(ss, lane) * (1.f / DM) + 1e-6f);
                    f32x4 hp[8];
                    if (t > 0) {
                        const f32x4* xq = (const f32x4*)(X + (size_t)(row - 1) * DM) + lane; float s2 = 0.f;
#pragma unroll
                        for (int q = 0; q < 8; ++q) { hp[q] = xq[64 * q]; s2 += hp[q][0] * hp[q][0] + hp[q][1] * hp[q][1] + hp[q][2] * hp[q][2] + hp[q][3] * hp[q][3]; }
                        const float rp = rsqrtf(wave_sum(s2, lane) * (1.f / DM) + 1e-6f);
#pragma unroll
                        for (int q = 0; q < 8; ++q) { const f32x4 gg = *((const f32x4*)gmix + lane + 64 * q); hp[q] = hp[q] * rp * gg; }
                    } else if (!prompt) {
#pragma unroll
                        for (int q = 0; q < 8; ++q) hp[q] = *((const f32x4*)(sst + (size_t)b * DM) + lane + 64 * q);
                    } else {
#pragma unroll
                        for (int q = 0; q < 8; ++q) hp[q] = (f32x4){0.f, 0.f, 0.f, 0.f};
                    }
                    const bool lastrow = (t == len - 1);
                    float* shout = OUTP + (prompt ? O_PSHIFT + ((size_t)jl * 2 + b) * DM : O_SSHIFT + ((size_t)jl * 16 + b) * DM);
#pragma unroll
                    for (int q = 0; q < 8; ++q) {
                        const f32x4 gg = *((const f32x4*)gmix + lane + 64 * q);
                        const f32x4 h = x[q] * rs * gg; const f32x4 dlt = hp[q] - h;
                        if (lastrow) *((f32x4*)shout + lane + 64 * q) = h;
#pragma unroll
                        for (int m = 0; m < 6; ++m) {
                            const f32x4 mx = *((const f32x4*)(mix + (size_t)m * DM) + lane + 64 * q);
                            const f32x4 o = h + dlt * mx;
                            u32x2 w; w.x = cvt_pk_bf16(o[0], o[1]); w.y = cvt_pk_bf16(o[2], o[3]);
                            *((u32x2*)(HB + (size_t)m * ACT + (size_t)row * DM) + lane + 64 * q) = w;
                        }
                    }
                }
            }
            fast_grid_barrier((unsigned*)ldp(tab, 40), tab);
            {
                BASES RWKV_PTRS
                pg8::Gemm g{HB, W1, MROWS, jl == 0 ? 6912 : 7168, 2048, 1, ACT * 2};
                pg8::StaticOrder S; S.init(g.M, g.N, G, (int)blockIdx.x);
                pg8::Epi<FR1> E{FR1{Rb, Kb, Vb, Lb}};
                pg8::gemm_phase(ldsl, g, S, E);
            }
            fast_grid_barrier((unsigned*)ldp(tab, 40), tab);
            {
                BASES RWKV_PTRS
                pg8::Gemm g{Lb, W2, MROWS, jl == 0 ? 6144 : 8192, 256, 2, (size_t)MROWS * 256 * 2};
                pg8::StaticOrder S; S.init(g.M, g.N, G, (int)blockIdx.x);
                pg8::Epi<FR2> E{FR2{DD, AA, GG, VG, IN(10) + (size_t)jl * DM, IN(13) + (size_t)jl * DM, IN(16) + (size_t)(jl > 0 ? jl - 1 : 0) * DM}};
                pg8::gemm_phase(ldsl, g, S, E);
            }
            fast_grid_barrier((unsigned*)ldp(tab, 40), tab);
            {
                PHASE_IDS BASES RWKV_PTRS
                float* Obuf = (float*)(RA + 272 * MiB); float* RK = (float*)(RB + 204 * MiB); float* DTg = (float*)(RB + 208 * MiB);
                const float* k_k = IN(21) + (size_t)jl * DM; const float* k_a = IN(22) + (size_t)jl * DM; const float* r_k = IN(23) + (size_t)jl * DM;
                const int l32 = lane & 31, hl = lane >> 5;
#define S1_BAR do { asm volatile("s_waitcnt lgkmcnt(0)" ::: "memory"); __builtin_amdgcn_s_barrier(); asm volatile("" ::: "memory"); } while (0)
                const int st = tid >> 3, c0 = (tid & 7) * 8;
                u32x4 pr_, pk_, pv_, pa_, pvf_ = (u32x4){0u, 0u, 0u, 0u}, pvg_ = (u32x4){0u, 0u, 0u, 0u}; f32x4 pd0_, pd1_;
#define S1_FETCH(it) do { const size_t _off = (size_t)(((it) >> 5) * 64 + st) * DM + ((it) & 31) * 64 + c0; \
                    pr_ = *(const u32x4*)(Rb + _off); pk_ = *(const u32x4*)(Kb + _off); pv_ = *(const u32x4*)(Vb + _off); pa_ = *(const u32x4*)(AA + _off); \
                    pd0_ = *(const f32x4*)(DD + _off); pd1_ = *(const f32x4*)(DD + _off + 4); \
                    if (jl > 0) { pvf_ = *(const u32x4*)(VFIRST + _off); pvg_ = *(const u32x4*)(VG + _off); } } while (0)
#pragma unroll 1
                for (int item = blockIdx.x; item < 8704; item += G) {
                    LAS unsigned char* ldsv = (LAS unsigned char*)lds; asm volatile("" : "+v"(ldsv));
                    LAS bf16_t* AH = (LAS bf16_t*)(ldsv + 0); LAS bf16_t* RH = (LAS bf16_t*)(ldsv + 9216); LAS bf16_t* BH = (LAS bf16_t*)(ldsv + 18432); LAS bf16_t* KH = (LAS bf16_t*)(ldsv + 27648);
                    LAS bf16_t* BHT = (LAS bf16_t*)(ldsv + 36864); LAS bf16_t* KHT = (LAS bf16_t*)(ldsv + 46080); LAS bf16_t* VTs = (LAS bf16_t*)(ldsv + 55296); LAS bf16_t* XT = (LAS bf16_t*)(ldsv + 64512);
                    LAS float* AAB = (LAS float*)(ldsv + 82944); LAS bf16_t* AAK = (LAS bf16_t*)(ldsv + 99328); LAS bf16_t* ARB = (LAS bf16_t*)(ldsv + 108544); LAS bf16_t* ARK = (LAS bf16_t*)(ldsv + 117760);
                    LAS float* LB = (LAS float*)(ldsv + 126976); LAS float* DTS = (LAS float*)(ldsv + 143360);
                    (void)RH; (void)KH; (void)KHT;
                    const int chunk = item >> 5, h = item & 31, r0 = chunk * 64;
                    const int col = h * 64 + c0;
                    S1_FETCH(item);
                    float r[8], kk[8], bb[8], km[8], ld[8];
                    {
                        float k[8], v[8], a[8];
                        unpack8(pr_, r); unpack8(pk_, k); unpack8(pv_, v); unpack8(pa_, a);
                        const f32x4 d0 = pd0_, d1 = pd1_;
                        ld[0] = d0[0]; ld[1] = d0[1]; ld[2] = d0[2]; ld[3] = d0[3]; ld[4] = d1[0]; ld[5] = d1[1]; ld[6] = d1[2]; ld[7] = d1[3];
                        if (jl > 0) { float vf[8], vg[8]; unpack8(pvf_, vf); unpack8(pvg_, vg);
#pragma unroll
                            for (int i = 0; i < 8; ++i) v[i] = v[i] + (vf[i] - v[i]) * vg[i]; }
                        float ss = 0.f;
#pragma unroll
                        for (int i = 0; i < 8; ++i) { kk[i] = k[i] * k_k[col + i]; ss += kk[i] * kk[i]; }
                        ss = sum8(ss, lane);
                        const float inv = 1.f / fmaxf(sqrtf(ss), 1e-12f);
                        float rk = 0.f;
#pragma unroll
                        for (int i = 0; i < 8; ++i) { kk[i] *= inv; bb[i] = kk[i] * a[i]; km[i] = k[i] * (1.f + (a[i] - 1.f) * k_a[col + i]); rk += r[i] * km[i] * r_k[col + i]; }
                        rk = sum8(rk, lane);
                        if ((tid & 7) == 0) RK[(size_t)(r0 + st) * 32 + h] = rk;
                        *(LAS f32x4*)(LB + st * 64 + c0) = d0; *(LAS f32x4*)(LB + st * 64 + c0 + 4) = d1;
#pragma unroll
                        for (int i = 0; i < 8; i += 2) { const unsigned pk = cvt_pk_bf16(v[i], v[i + 1]); VTs[(c0 + i) * 72 + st] = (bf16_t)(pk & 0xffffu); VTs[(c0 + i + 1) * 72 + st] = (bf16_t)(pk >> 16); }
                    }
                    S1_BAR;
                    {
                        const int cc_ = tid & 63, tq_ = tid >> 6; float pf[8]; float run = 0.f;
#pragma unroll
                        for (int j = 0; j < 8; ++j) { run += LB[(8 * tq_ + j) * 64 + cc_]; pf[j] = run; }
                        AAB[tq_ * 64 + cc_] = run;
                        S1_BAR;
                        float ofs = 0.f;
#pragma unroll
                        for (int g = 0; g < 7; ++g) ofs += (g < tq_) ? AAB[g * 64 + cc_] : 0.f;
#pragma unroll
                        for (int j = 0; j < 8; ++j) LB[(8 * tq_ + j) * 64 + cc_] = pf[j] + ofs;
                    }
                    S1_BAR;
                    {
                        float ah[8], bh[8], kh[8], rh[8];
#pragma unroll
                        for (int i = 0; i < 8; ++i) { const float Lt = LB[st * 64 + c0 + i]; const float e3 = __expf(Lt), e2 = __expf(-Lt), e1 = __expf(Lt - ld[i]);
                            ah[i] = -kk[i] * e1; bh[i] = bb[i] * e2; kh[i] = km[i] * e2; rh[i] = r[i] * e3;
                            if (st == 63) { DTS[c0 + i] = e3; DTg[(size_t)item * 64 + c0 + i] = e3; } }
                        *(LAS u32x4*)(AH + st * 72 + c0) = pack8(ah); *(LAS u32x4*)(RH + st * 72 + c0) = pack8(rh);
                        *(LAS u32x4*)(BH + st * 72 + c0) = pack8(bh); *(LAS u32x4*)(KH + st * 72 + c0) = pack8(kh);
#pragma unroll
                        for (int i = 0; i < 8; i += 2) { const unsigned p1 = cvt_pk_bf16(bh[i], bh[i + 1]), p2 = cvt_pk_bf16(kh[i], kh[i + 1]);
                            BHT[(c0 + i) * 72 + st] = (bf16_t)(p1 & 0xffffu); BHT[(c0 + i + 1) * 72 + st] = (bf16_t)(p1 >> 16);
                            KHT[(c0 + i) * 72 + st] = (bf16_t)(p2 & 0xffffu); KHT[(c0 + i + 1) * 72 + st] = (bf16_t)(p2 >> 16); }
                    }
                    S1_BAR;
                    {
                        const int mi = wave & 3, rowsel = mi >> 1, tt = mi & 1;
#pragma unroll
                        for (int nn = 0; nn < 2; ++nn) {
                            const int colsel = wave >> 2, stl = nn; const int ni = 2 * colsel + nn;
                            f32x16 acc;
#pragma unroll
                            for (int i = 0; i < 16; ++i) acc[i] = 0.f;
                            if (stl <= tt) {
#pragma unroll
                                for (int ks = 0; ks < 4; ++ks) {
                                    const bf16x8 a = *(const LAS bf16x8*)(AH + (mi * 32 + l32) * 72 + ks * 16 + hl * 8);
                                    const bf16x8 b = *(const LAS bf16x8*)(BH + (ni * 32 + l32) * 72 + ks * 16 + hl * 8);
                                    acc = __builtin_amdgcn_mfma_f32_32x32x16_bf16(a, b, acc, 0, 0, 0);
                                }
                            }
#pragma unroll
                            for (int i = 0; i < 16; ++i) {
                                const int t = tt * 32 + crow(i, hl), s = stl * 32 + l32;
                                const bool keep = rowsel ? (s <= t) : (s < t);
                                const float val = keep ? acc[i] : 0.f;
                                if (rowsel == 0 && colsel == 0) AAB[t * 64 + s] = val;
                                else { LAS bf16_t* dst = (rowsel == 0) ? AAK : (colsel == 0 ? ARB : ARK); dst[t * 72 + s] = (bf16_t)(cvt_pk_bf16(val, 0.f) & 0xffffu); }
                            }
                        }
                    }
                    S1_BAR;
                    if (wave < 4) {
                        const int mt = wave >> 1, nt = wave & 1;
                        f32x16 acc;
#pragma unroll
                        for (int i = 0; i < 16; ++i) acc[i] = 0.f;
#pragma unroll
                        for (int ks = 0; ks < 4; ++ks) {
                            const bf16x8 a = *(const LAS bf16x8*)(AAK + (mt * 32 + l32) * 72 + ks * 16 + hl * 8);
                            const bf16x8 b = *(const LAS bf16x8*)(VTs + (nt * 32 + l32) * 72 + ks * 16 + hl * 8);
                            acc = __builtin_amdgcn_mfma_f32_32x32x16_bf16(a, b, acc, 0, 0, 0);
                        }
#pragma unroll
                        for (int i = 0; i < 16; ++i) LB[(mt * 32 + crow(i, hl)) * 64 + nt * 32 + l32] = acc[i];
                    }
                    S1_BAR;
                    if (tid < 128) {
                        float Xc[64];
#pragma unroll
                        for (int t = 0; t < 64; ++t) Xc[t] = 0.f;
#pragma clang loop unroll(full)
                        for (int t = 0; t < 64; ++t) {
                            const float va_ = bf2f(AH[t * 72 + (tid & 63)]), vb_ = LB[t * 64 + (tid & 63)];
                            float a0 = (tid < 64) ? va_ : vb_;
                            float a1 = 0.f, a2 = 0.f, a3 = 0.f;
#pragma clang loop unroll(full)
                            for (int s4 = 0; s4 < t; s4 += 4) { const f32x4 w = *(const LAS f32x4*)(AAB + t * 64 + s4);
                                a0 += w[0] * Xc[s4]; a1 += w[1] * Xc[s4 + 1]; a2 += w[2] * Xc[s4 + 2]; a3 += w[3] * Xc[s4 + 3]; }
                            Xc[t] = (a0 + a1) + (a2 + a3);
                            asm volatile("" : "+v"(Xc[t]) :: "memory");
                        }
#pragma unroll
                        for (int q = 0; q < 8; ++q) { float f8[8];
#pragma unroll
                            for (int i = 0; i < 8; ++i) f8[i] = Xc[q * 8 + i];
                            *(LAS u32x4*)(XT + tid * 72 + q * 8) = pack8(f8); }
                    }
                    S1_BAR;
                    {
                        const int kind = wave >> 2, mt = (wave & 3) >> 1, nt = wave & 1;
                        {
                            const LAS bf16_t* Ap = (kind == 0 ? ARB : BHT) + (mt * 32 + l32) * 72; const LAS bf16_t* Bp = XT + (nt * 32 + l32) * 72;
                            f32x16 acc;
#pragma unroll
                            for (int i = 0; i < 16; ++i) acc[i] = 0.f;
#pragma unroll
                            for (int ks = 0; ks < 4; ++ks) acc = __builtin_amdgcn_mfma_f32_32x32x16_bf16(*(const LAS bf16x8*)(Ap + ks * 16 + hl * 8), *(const LAS bf16x8*)(Bp + ks * 16 + hl * 8), acc, 0, 0, 0);
                            bf16_t* dstb = (kind == 0) ? Rb : Kb;
#pragma unroll
                            for (int i = 0; i < 16; ++i) { const int rr = mt * 32 + crow(i, hl), cc = nt * 32 + l32;
                                float val = acc[i];
                                if (kind == 0) val += bf2f(RH[rr * 72 + cc]); else val *= DTS[rr];
                                dstb[(size_t)(r0 + rr) * DM + h * 64 + cc] = (bf16_t)(cvt_pk_bf16(val, 0.f) & 0xffffu); }
                        }
                        {
                            const LAS bf16_t* A1 = (kind == 0 ? ARB : BHT) + (mt * 32 + l32) * 72; const LAS bf16_t* A2 = (kind == 0 ? ARK : KHT) + (mt * 32 + l32) * 72;
                            const LAS bf16_t* B1 = XT + (64 + nt * 32 + l32) * 72; const LAS bf16_t* B2 = VTs + (nt * 32 + l32) * 72;
                            f32x16 acc;
#pragma unroll
                            for (int i = 0; i < 16; ++i) acc[i] = 0.f;
#pragma unroll
                            for (int ks = 0; ks < 4; ++ks) acc = __builtin_amdgcn_mfma_f32_32x32x16_bf16(*(const LAS bf16x8*)(A1 + ks * 16 + hl * 8), *(const LAS bf16x8*)(B1 + ks * 16 + hl * 8), acc, 0, 0, 0);
#pragma unroll
                            for (int ks = 0; ks < 4; ++ks) acc = __builtin_amdgcn_mfma_f32_32x32x16_bf16(*(const LAS bf16x8*)(A2 + ks * 16 + hl * 8), *(const LAS bf16x8*)(B2 + ks * 16 + hl * 8), acc, 0, 0, 0);
                            float* dstf = (kind == 0) ? Obuf : DD;
#pragma unroll
                            for (int i = 0; i < 16; ++i) { const int rr = mt * 32 + crow(i, hl), cc = nt * 32 + l32;
                                float val = acc[i]; if (kind == 1) val *= DTS[rr];
                                dstf[(size_t)(r0 + rr) * DM + h * 64 + cc] = val; }
                        }
                    }
                    S1_BAR;
                }
            }
            fast_grid_barrier((unsigned*)ldp(tab, 40), tab);
#undef S1_BAR
#undef S1_FETCH
            {
                PHASE_IDS BASES RWKV_PTRS
                const float* DTg = (const float*)(RB + 208 * MiB);
                const int l32 = lane & 31, hl = lane >> 5;
                const int q = wave * G + blockIdx.x;
                if (q < 1152) {
                    const bool prompt = q < 128; int b, h, vh, chunk0, nch;
                    if (prompt) { const int chain = q >> 1; b = chain >> 5; h = chain & 31; vh = q & 1; chunk0 = b * 128; nch = 128; }
                    else { const int sq = q - 128; const int chain = sq >> 1; b = chain >> 5; h = chain & 31; vh = sq & 1; chunk0 = 256 + b; nch = 1; }
                    const int colb = h * 64, vcol = colb + 32 * vh + l32;
                    f32x16 S0, S1;
                    if (prompt) {
#pragma unroll
                        for (int i = 0; i < 16; ++i) { S0[i] = 0.f; S1[i] = 0.f; }
                    } else {
                        const float* s0 = IN(3) + ((((size_t)jl * 16 + b) * 32 + h) * 64 + (32 * vh + l32)) * 64;
#pragma unroll
                        for (int i = 0; i < 16; ++i) { S0[i] = s0[crow(i, hl)]; S1[i] = s0[32 + crow(i, hl)]; }
                    }
                    bf16x8 gf[2][2][2]; f32x16 n0, n1; f32x4 dt_[2][4];
#define S2_COMPUTE(cc) do { const int _r0 = (chunk0 + (cc)) * 64; \
                        u32x4 w00, w01, w10, w11; \
                        w00.x = cvt_pk_bf16(S0[0], S0[1]); w00.y = cvt_pk_bf16(S0[2], S0[3]); w00.z = cvt_pk_bf16(S0[4], S0[5]); w00.w = cvt_pk_bf16(S0[6], S0[7]); \
                        w01.x = cvt_pk_bf16(S0[8], S0[9]); w01.y = cvt_pk_bf16(S0[10], S0[11]); w01.z = cvt_pk_bf16(S0[12], S0[13]); w01.w = cvt_pk_bf16(S0[14], S0[15]); \
                        w10.x = cvt_pk_bf16(S1[0], S1[1]); w10.y = cvt_pk_bf16(S1[2], S1[3]); w10.z = cvt_pk_bf16(S1[4], S1[5]); w10.w = cvt_pk_bf16(S1[6], S1[7]); \
                        w11.x = cvt_pk_bf16(S1[8], S1[9]); w11.y = cvt_pk_bf16(S1[10], S1[11]); w11.z = cvt_pk_bf16(S1[12], S1[13]); w11.w = cvt_pk_bf16(S1[14], S1[15]); \
                        const bf16x8 sb00 = __builtin_bit_cast(bf16x8, w00), sb01 = __builtin_bit_cast(bf16x8, w01), sb10 = __builtin_bit_cast(bf16x8, w10), sb11 = __builtin_bit_cast(bf16x8, w11); \
                        n0 = __builtin_amdgcn_mfma_f32_32x32x16_bf16(gf[0][0][0], sb00, n0, 0, 0, 0); n1 = __builtin_amdgcn_mfma_f32_32x32x16_bf16(gf[1][0][0], sb00, n1, 0, 0, 0); \
                        n0 = __builtin_amdgcn_mfma_f32_32x32x16_bf16(gf[0][0][1], sb01, n0, 0, 0, 0); n1 = __builtin_amdgcn_mfma_f32_32x32x16_bf16(gf[1][0][1], sb01, n1, 0, 0, 0); \
                        n0 = __builtin_amdgcn_mfma_f32_32x32x16_bf16(gf[0][1][0], sb10, n0, 0, 0, 0); n1 = __builtin_amdgcn_mfma_f32_32x32x16_bf16(gf[1][1][0], sb10, n1, 0, 0, 0); \
                        n0 = __builtin_amdgcn_mfma_f32_32x32x16_bf16(gf[0][1][1], sb11, n0, 0, 0, 0); n1 = __builtin_amdgcn_mfma_f32_32x32x16_bf16(gf[1][1][1], sb11, n1, 0, 0, 0); \
                        { unsigned char* _sp = (unsigned char*)DD + ((size_t)(_r0 + l32) * DM + colb + 32 * vh) * 4 + 8 * hl; \
                          *(u32x2*)(_sp + 0) = (u32x2){w00.x, w00.y}; *(u32x2*)(_sp + 16) = (u32x2){w00.z, w00.w}; *(u32x2*)(_sp + 32) = (u32x2){w01.x, w01.y}; *(u32x2*)(_sp + 48) = (u32x2){w01.z, w01.w}; \
                          *(u32x2*)(_sp + 64) = (u32x2){w10.x, w10.y}; *(u32x2*)(_sp + 80) = (u32x2){w10.z, w10.w}; *(u32x2*)(_sp + 96) = (u32x2){w11.x, w11.y}; *(u32x2*)(_sp + 112) = (u32x2){w11.z, w11.w}; } \
                        _Pragma("unroll") for (int i = 0; i < 16; ++i) { S0[i] = S0[i] * dt_[0][i >> 2][i & 3] + n0[i]; S1[i] = S1[i] * dt_[1][i >> 2][i & 3] + n1[i]; } \
                    } while (0)
                    if (prompt) {
                        LAS float* dtl = (LAS float*)((LAS unsigned char*)lds);
                        LAS unsigned char* ring = (LAS unsigned char*)lds + 32768;
                        for (int i = lane; i < 128 * 16; i += 64) *(LAS f32x4*)(dtl + i * 4) = *(const f32x4*)(DTg + ((size_t)(chunk0 + (i >> 4)) * 32 + h) * 64 + (i & 15) * 4);
#define S2_DMA(cc) do { const int _r0 = (chunk0 + (cc)) * 64; LAS unsigned char* _s = ring + ((cc) & 3) * 16384; \
                            _Pragma("unroll") for (int j = 0; j < 8; ++j) { const int _row = 8 * j + (lane >> 3); const int _p = (lane & 7) ^ (_row & 7); \
                                __builtin_amdgcn_global_load_lds((const unsigned*)(Kb + (size_t)(_r0 + _row) * DM + colb + _p * 8), (LAS unsigned*)(_s + j * 1024), 16, 0, 0); } \
                            _Pragma("unroll") for (int j = 0; j < 8; ++j) { const int _row = 8 * j + (lane >> 3); \
                                __builtin_amdgcn_global_load_lds((const unsigned*)(DD + (size_t)(_r0 + _row) * DM + colb + 32 * vh + (lane & 7) * 4), (LAS unsigned*)(_s + 8192 + j * 1024), 16, 0, 0); } \
                        } while (0)
                        S2_DMA(0); S2_DMA(1);
#pragma unroll 1
                        for (int c = 0; c < 128; ++c) {
                            if (c + 2 < 128) { S2_DMA(c + 2); asm volatile("s_waitcnt vmcnt(32)" ::: "memory"); }
                            else if (c + 1 < 128) asm volatile("s_waitcnt vmcnt(16)" ::: "memory");
                            else asm volatile("s_waitcnt vmcnt(0)" ::: "memory");
                            LAS unsigned char* sl = ring + (c & 3) * 16384;
#pragma unroll
                            for (int mt = 0; mt < 2; ++mt)
#pragma unroll
                                for (int kt = 0; kt < 2; ++kt)
#pragma unroll
                                    for (int s2 = 0; s2 < 2; ++s2) {
                                        const int row = 32 * mt + l32, p = 4 * kt + 2 * s2;
                                        const u32x2 lo = *(const LAS u32x2*)(sl + row * 128 + ((p ^ (row & 7)) * 16) + 8 * hl);
                                        const u32x2 hi = *(const LAS u32x2*)(sl + row * 128 + (((p + 1) ^ (row & 7)) * 16) + 8 * hl);
                                        gf[mt][kt][s2] = __builtin_bit_cast(bf16x8, (u32x4){lo.x, lo.y, hi.x, hi.y});
                                    }
#pragma unroll
                            for (int i = 0; i < 16; ++i) { n0[i] = *(const LAS float*)(sl + 8192 + crow(i, hl) * 128 + l32 * 4); n1[i] = *(const LAS float*)(sl + 8192 + (32 + crow(i, hl)) * 128 + l32 * 4); }
#pragma unroll
                            for (int mt = 0; mt < 2; ++mt)
#pragma unroll
                                for (int g = 0; g < 4; ++g) dt_[mt][g] = *(const LAS f32x4*)(dtl + c * 64 + 32 * mt + 8 * g + 4 * hl);
                            S2_COMPUTE(c);
                        }
#undef S2_DMA
                    } else {
                        const int _r0 = chunk0 * 64; const size_t _item = (size_t)chunk0 * 32 + h;
#pragma unroll
                        for (int mt = 0; mt < 2; ++mt)
#pragma unroll
                            for (int kt = 0; kt < 2; ++kt)
#pragma unroll
                                for (int s2 = 0; s2 < 2; ++s2) {
                                    const size_t _o = (size_t)(_r0 + 32 * mt + l32) * DM + colb + 32 * kt + 16 * s2 + 4 * hl;
                                    const u32x2 _lo = *(const u32x2*)(Kb + _o), _hi = *(const u32x2*)(Kb + _o + 8); gf[mt][kt][s2] = __builtin_bit_cast(bf16x8, (u32x4){_lo.x, _lo.y, _hi.x, _hi.y}); }
#pragma unroll
                        for (int i = 0; i < 16; ++i) { n0[i] = DD[(size_t)(_r0 + crow(i, hl)) * DM + vcol]; n1[i] = DD[(size_t)(_r0 + 32 + crow(i, hl)) * DM + vcol]; }
#pragma unroll
                        for (int mt = 0; mt < 2; ++mt)
#pragma unroll
                            for (int g = 0; g < 4; ++g) dt_[mt][g] = *(const f32x4*)(DTg + _item * 64 + 32 * mt + 8 * g + 4 * hl);
                        S2_COMPUTE(0);
                    }
#undef S2_COMPUTE
                    float* so_ = OUTP + (prompt ? O_PWKV + ((((size_t)jl * 2 + b) * 32 + h) * 64 + (32 * vh + l32)) * 64
                                                : O_SWKV + ((((size_t)jl * 16 + b) * 32 + h) * 64 + (32 * vh + l32)) * 64);
#pragma unroll
                    for (int i = 0; i < 16; ++i) { so_[crow(i, hl)] = S0[i]; so_[32 + crow(i, hl)] = S1[i]; }
                }
            }
            fast_grid_barrier((unsigned*)ldp(tab, 40), tab);
            {
                PHASE_IDS BASES RWKV_PTRS
                const float* Obuf = (const float*)(RA + 272 * MiB); const float* RK = (const float*)(RB + 204 * MiB);
                const float* lnw = IN(28) + (size_t)jl * DM; const float* lnb = IN(29) + (size_t)jl * DM;
                const int l32 = lane & 31, hl = lane >> 5;
#pragma unroll 1
                for (int item = blockIdx.x; item < 8704; item += G) {
                    LAS unsigned char* ldsv = (LAS unsigned char*)lds; asm volatile("" : "+v"(ldsv));
                    LAS bf16_t* R2s = (LAS bf16_t*)(ldsv + 0); LAS bf16_t* STs = (LAS bf16_t*)(ldsv + 9216); LAS float* Os = (LAS float*)(ldsv + 18432);
                    const int chunk = item >> 5, h = item & 31, r0 = chunk * 64;
                    {
                        const int rr = tid >> 3, pc = tid & 7;
                        *(LAS u32x4*)(R2s + rr * 72 + pc * 8) = *(const u32x4*)(Rb + (size_t)(r0 + rr) * DM + h * 64 + pc * 8);
                        const unsigned char* sp = (const unsigned char*)DD + ((size_t)(r0 + (rr & 31)) * DM + h * 64 + 32 * (rr >> 5)) * 4 + pc * 16;
                        *(LAS u32x4*)(STs + rr * 72 + pc * 8) = *(const u32x4*)sp;
                    }
                    __syncthreads();
                    if (wave < 4) {
                        const int tt = wave >> 1, vt = wave & 1;
                        f32x16 acc;
#pragma unroll
                        for (int i = 0; i < 16; ++i) acc[i] = Obuf[(size_t)(r0 + 32 * tt + crow(i, hl)) * DM + h * 64 + 32 * vt + l32];
#pragma unroll
                        for (int ks = 0; ks < 4; ++ks) acc = __builtin_amdgcn_mfma_f32_32x32x16_bf16(*(const LAS bf16x8*)(R2s + (32 * tt + l32) * 72 + ks * 16 + hl * 8), *(const LAS bf16x8*)(STs + (32 * vt + l32) * 72 + ks * 16 + hl * 8), acc, 0, 0, 0);
#pragma unroll
                        for (int i = 0; i < 16; ++i) Os[(32 * tt + crow(i, hl)) * 68 + 32 * vt + l32] = acc[i];
                    }
                    __syncthreads();
                    {
                        const int st = tid >> 3, c0 = (tid & 7) * 8, col = h * 64 + c0; const size_t off = (size_t)(r0 + st) * DM + col;
                        const f32x4 o0 = *(const LAS f32x4*)(Os + st * 68 + c0), o1 = *(const LAS f32x4*)(Os + st * 68 + c0 + 4);
                        float o[8] = {o0[0], o0[1], o0[2], o0[3], o1[0], o1[1], o1[2], o1[3]};
                        float s = 0.f;
#pragma unroll
                        for (int i = 0; i < 8; ++i) s += o[i];
                        const float mu = sum8(s, lane) * (1.f / 64.f); float q = 0.f;
#pragma unroll
                        for (int i = 0; i < 8; ++i) { o[i] -= mu; q += o[i] * o[i]; }
                        const float rstd = rsqrtf(sum8(q, lane) * (1.f / 64.f) + 64e-5f);
                        float v[8], g8[8]; unpack8(*(const u32x4*)(Vb + off), v); unpack8(*(const u32x4*)(GG + off), g8);
                        if (jl > 0) { float vf[8], vg[8]; unpack8(*(const u32x4*)(VFIRST + off), vf); unpack8(*(const u32x4*)(VG + off), vg);
#pragma unroll
                            for (int i = 0; i < 8; ++i) v[i] = v[i] + (vf[i] - v[i]) * vg[i]; }
                        const float rk = RK[(size_t)(r0 + st) * 32 + h];
                        float y[8];
#pragma unroll
                        for (int i = 0; i < 8; ++i) y[i] = (o[i] * rstd * lnw[col + i] + lnb[col + i] + rk * v[i]) * g8[i];
                        *(u32x4*)(Y + off) = pack8(y);
                    }
                    __syncthreads();
                }
            }
            fast_grid_barrier((unsigned*)ldp(tab, 40), tab);
            {
                BASES RWKV_PTRS
                pg8::Gemm g{Y, WO, MROWS, 2048, 2048, 0, 0};
                pg8::StaticOrder S; S.init(g.M, g.N, G, (int)blockIdx.x);
                pg8::Epi<FRes> E{FRes{X}};
                pg8::gemm_phase(ldsl, g, S, E);
            }
            fast_grid_barrier((unsigned*)ldp(tab, 40), tab);
        } else {
            { PHASE_IDS BASES GLA_PTRS
            const float* gmix = IN(6) + (size_t)layer * DM;
            for (int row = gw; row < MROWS; row += NGW) {
                const f32x4* xr = (const f32x4*)(X + (size_t)row * DM) + lane; f32x4 x[8]; float ss = 0.f;
#pragma unroll
                for (int q = 0; q < 8; ++q) { x[q] = xr[64 * q]; ss += x[q][0] * x[q][0] + x[q][1] * x[q][1] + x[q][2] * x[q][2] + x[q][3] * x[q][3]; }
                const float rs = rsqrtf(wave_sum(ss, lane) * (1.f / DM) + 1e-6f);
#pragma unroll
                for (int q = 0; q < 8; ++q) { const f32x4 gg = *((const f32x4*)gmix + lane + 64 * q); const f32x4 h = x[q] * rs * gg;
                    u32x2 w; w.x = cvt_pk_bf16(h[0], h[1]); w.y = cvt_pk_bf16(h[2], h[3]); *((u32x2*)(H + (size_t)row * DM) + lane + 64 * q) = w; }
            } }
            fast_grid_barrier((unsigned*)ldp(tab, 40), tab);
            {
                BASES GLA_PTRS
                pg8::Gemm g{H, GI, MROWS, 6400, 2048, 0, 0};
                pg8::StaticOrder S; S.init(g.M, g.N, G, (int)blockIdx.x);
                pg8::Epi<FG1> E{FG1{PROJ, LR}};
                pg8::gemm_phase(ldsl, g, S, E);
            }
            fast_grid_barrier((unsigned*)ldp(tab, 40), tab);
            {
                PHASE_IDS BASES GLA_PTRS
                float* lrS = (float*)lds;
                float* w2S = (float*)(lds + 4096);
                float* totS = (float*)(lds + 20480);
                bf16_t* qeS = (bf16_t*)(lds + 22528);
                bf16_t* keS = (bf16_t*)(lds + 22528 + 33792);
                bf16_t* vS = qeS;
                const float* gw2 = IN(31) + (size_t)jl * 16 * 1024; const float* gkb = IN(32) + (size_t)jl * 1024;
#pragma unroll 1
                for (int it = blockIdx.x; it < 1088; it += G) {
                    const int c = it >> 2, h = it & 3, r0 = c * 64; const size_t base = (size_t)it;
                    if (tid < 256) *(f32x4*)(lrS + tid * 4) = *(const f32x4*)(LR + (size_t)r0 * 16 + tid * 4);
                    for (int q = tid; q < 1024; q += 512) { const int r = q >> 6, cc = (q & 63) * 4; *(f32x4*)(w2S + r * 256 + cc) = *(const f32x4*)(gw2 + (size_t)r * 1024 + h * 256 + cc); }
                    __syncthreads();
                    const int d = tid & 255, half = tid >> 8;
                    float cumv[32];
                    {
                        float w[16];
#pragma unroll
                        for (int r = 0; r < 16; ++r) w[r] = w2S[r * 256 + d];
                        const float bb = gkb[h * 256 + d]; float run = 0.f;
#pragma unroll
                        for (int tt = 0; tt < 32; ++tt) {
                            const float* lp = lrS + (half * 32 + tt) * 16; float z = bb;
#pragma unroll
                            for (int r = 0; r < 16; ++r) z += lp[r] * w[r];
                            const float g = (fminf(z, 0.f) - log1pf(__expf(-fabsf(z)))) * 0.0625f;
                            run += g; cumv[tt] = run;
                        }
                        totS[half * 256 + d] = run;
                    }
                    __syncthreads();
                    {
                        const float t0 = totS[d], t1 = totS[256 + d]; const float last = t0 + t1, offc = half ? t0 : 0.f;
                        if (half == 0) EL[base * 256 + d] = __expf(last);
                        unsigned kdp[16];
#pragma unroll
                        for (int tt = 0; tt < 32; tt += 2) {
                            float kd2[2];
#pragma unroll
                            for (int e = 0; e < 2; ++e) {
                                const int t = half * 32 + tt + e; const float cum = cumv[tt + e] + offc;
                                const size_t po = (size_t)(r0 + t) * 6144 + h * 256 + d;
                                const float q = bf2f(PROJ[po]), k = bf2f(PROJ[po + 1024]);
                                const float qe = q * __expf(cum), ke = k * __expf(-cum); kd2[e] = k * __expf(last - cum);
                                const unsigned pq = cvt_pk_bf16(qe, ke);
                                qeS[t * 264 + d] = (bf16_t)(pq & 0xffffu); keS[t * 264 + d] = (bf16_t)(pq >> 16);
                                QE[(size_t)(r0 + t) * 1024 + h * 256 + d] = (bf16_t)(pq & 0xffffu);
                            }
                            kdp[tt >> 1] = cvt_pk_bf16(kd2[0], kd2[1]);
                        }
                        u32x4* kdst = (u32x4*)(KDT + (base * 256 + d) * 64 + half * 32);
                        kdst[0] = (u32x4){kdp[0], kdp[1], kdp[2], kdp[3]}; kdst[1] = (u32x4){kdp[4], kdp[5], kdp[6], kdp[7]};
                        kdst[2] = (u32x4){kdp[8], kdp[9], kdp[10], kdp[11]}; kdst[3] = (u32x4){kdp[12], kdp[13], kdp[14], kdp[15]};
                    }
                    __syncthreads();
                    if (wave < 4) {
                        const int mi = wave >> 1, ni = wave & 1, l32 = lane & 31, hl = lane >> 5;
                        f32x16 cacc;
#pragma unroll
                        for (int i = 0; i < 16; ++i) cacc[i] = 0.f;
#pragma unroll
                        for (int kk = 0; kk < 16; ++kk) {
                            const bf16x8 a = *(const bf16x8*)(qeS + (mi * 32 + l32) * 264 + kk * 16 + hl * 8);
                            const bf16x8 b = *(const bf16x8*)(keS + (ni * 32 + l32) * 264 + kk * 16 + hl * 8);
                            cacc = __builtin_amdgcn_mfma_f32_32x32x16_bf16(a, b, cacc, 0, 0, 0);
                        }
#pragma unroll
                        for (int i = 0; i < 16; ++i) { const int ii = mi * 32 + crow(i, hl), jj = ni * 32 + l32;
                            const float v = (jj <= ii) ? cacc[i] : 0.f; SC[base * 4096 + ii * 64 + jj] = (bf16_t)(cvt_pk_bf16(v, 0.f) & 0xffffu); }
                    }
                    __syncthreads();
                    for (int q = tid; q < 4096; q += 512) { const int t = q >> 6, cc = (q & 63) * 8;
                        *(u32x4*)(vS + t * 520 + cc) = *(const u32x4*)(PROJ + (size_t)(r0 + t) * 6144 + 2048 + h * 512 + cc); }
                    __syncthreads();
                    {
                        const int dv = tid; u32x4* vdst = (u32x4*)(VT + (base * 512 + dv) * 64);
#pragma unroll
                        for (int q = 0; q < 8; ++q) {
                            unsigned w[4];
#pragma unroll
                            for (int e = 0; e < 4; ++e) { const unsigned lo = vS[(q * 8 + 2 * e) * 520 + dv], hi = vS[(q * 8 + 2 * e + 1) * 520 + dv]; w[e] = lo | (hi << 16); }
                            vdst[q] = (u32x4){w[0], w[1], w[2], w[3]};
                        }
                    }
                    __syncthreads();
                }
            }
            fast_grid_barrier((unsigned*)ldp(tab, 40), tab);
            {
                PHASE_IDS BASES GLA_PTRS
                float* red = (float*)lds;
                const int l32 = lane & 31, hl = lane >> 5;
#pragma unroll 1
                for (int u = blockIdx.x; u < 1152; u += G) {
                    const bool prompt = u < 128; int b, h, s, cg0, nch, row0;
                    if (prompt) { b = u >> 6; h = (u >> 4) & 3; s = u & 15; cg0 = b * 128; nch = 128; row0 = b * 8192; }
                    else { const int su = u - 128; b = su >> 6; h = (su >> 4) & 3; s = su & 15; cg0 = 256 + b; nch = 1; row0 = MPROMPT + b * 64; }
                    f32x16 S;
                    if (prompt) {
#pragma unroll
                        for (int i = 0; i < 16; ++i) S[i] = 0.f;
                    } else {
                        const float* s0 = IN(4) + ((((size_t)jl * 16 + b) * 4 + h) * 256) * 512;
#pragma unroll
                        for (int i = 0; i < 16; ++i) S[i] = s0[(size_t)(32 * wave + crow(i, hl)) * 512 + 32 * s + l32];
                    }
                    const int mtw = wave & 1, ksw = wave >> 1;
                    bf16x8 ka[4], vb[4], qf[2][2], scf; f32x4 el[4];
#define GL_LD_Q(cc) do { const size_t _base = (size_t)(cg0 + (cc)) * 4 + h; const int _r0 = row0 + (cc) * 64; const bf16_t* _sc = SC + _base * 4096; \
                        _Pragma("unroll") for (int mt = 0; mt < 2; ++mt) _Pragma("unroll") for (int s2 = 0; s2 < 2; ++s2) { const bf16_t* _pq = QE + (size_t)(_r0 + mt * 32 + l32) * 1024 + h * 256 + 32 * wave + 16 * s2 + 4 * hl; \
                            const u32x2 _lo = *(const u32x2*)_pq, _hi = *(const u32x2*)(_pq + 8); qf[mt][s2] = __builtin_bit_cast(bf16x8, (u32x4){_lo.x, _lo.y, _hi.x, _hi.y}); } \
                        scf = *(const bf16x8*)(_sc + (mtw * 32 + l32) * 64 + 16 * ksw + 8 * hl); } while (0)
#define GL_LD_E(cc) do { const size_t _base = (size_t)(cg0 + (cc)) * 4 + h; \
                        _Pragma("unroll") for (int g = 0; g < 4; ++g) el[g] = *(const f32x4*)(EL + _base * 256 + 32 * wave + 8 * g + 4 * hl); } while (0)
#define GL_LD_K(cc) do { const size_t _base = (size_t)(cg0 + (cc)) * 4 + h; const bf16_t* _kdt = KDT + _base * 256 * 64; const bf16_t* _vt = VT + _base * 512 * 64; \
                        _Pragma("unroll") for (int ks = 0; ks < 4; ++ks) { ka[ks] = *(const bf16x8*)(_kdt + (32 * wave + l32) * 64 + 16 * ks + 8 * hl); vb[ks] = *(const bf16x8*)(_vt + (32 * s + l32) * 64 + 16 * ks + 8 * hl); } } while (0)
                    GL_LD_Q(0); GL_LD_E(0); GL_LD_K(0);
#pragma unroll 1
                    for (int c = 0; c < nch; ++c) {
                        const int r0 = row0 + c * 64; const int cn = (c + 1 < nch) ? c + 1 : c;
                        u32x4 sp0, sp1;
                        sp0.x = cvt_pk_bf16(S[0], S[1]); sp0.y = cvt_pk_bf16(S[2], S[3]); sp0.z = cvt_pk_bf16(S[4], S[5]); sp0.w = cvt_pk_bf16(S[6], S[7]);
                        sp1.x = cvt_pk_bf16(S[8], S[9]); sp1.y = cvt_pk_bf16(S[10], S[11]); sp1.z = cvt_pk_bf16(S[12], S[13]); sp1.w = cvt_pk_bf16(S[14], S[15]);
                        const bf16x8 sb0 = __builtin_bit_cast(bf16x8, sp0), sb1 = __builtin_bit_cast(bf16x8, sp1);
                        const bf16x8 vbw = ksw == 0 ? vb[0] : ksw == 1 ? vb[1] : ksw == 2 ? vb[2] : vb[3];
#pragma unroll
                        for (int mt = 0; mt < 2; ++mt) { f32x16 oo;
#pragma unroll
                            for (int i = 0; i < 16; ++i) oo[i] = 0.f;
                            oo = __builtin_amdgcn_mfma_f32_32x32x16_bf16(qf[mt][0], sb0, oo, 0, 0, 0); oo = __builtin_amdgcn_mfma_f32_32x32x16_bf16(qf[mt][1], sb1, oo, 0, 0, 0);
                            if (mtw == mt) oo = __builtin_amdgcn_mfma_f32_32x32x16_bf16(scf, vbw, oo, 0, 0, 0);
#pragma unroll
                            for (int q = 0; q < 16; ++q) red[(wave * 32 + mt * 16 + q) * 64 + lane] = oo[q]; }
                        GL_LD_Q(cn);
#pragma unroll
                        for (int i = 0; i < 16; ++i) S[i] *= el[i >> 2][i & 3];
                        GL_LD_E(cn);
#pragma unroll
                        for (int ks = 0; ks < 4; ++ks) S = __builtin_amdgcn_mfma_f32_32x32x16_bf16(ka[ks], vb[ks], S, 0, 0, 0);
                        GL_LD_K(cn);
                        asm volatile("s_waitcnt lgkmcnt(0)" ::: "memory"); __builtin_amdgcn_s_barrier(); asm volatile("" ::: "memory");
                        { const int q = tid >> 4, lg = tid & 15; f32x4 sum = (f32x4){0.f, 0.f, 0.f, 0.f};
#pragma unroll
                          for (int w = 0; w < 8; ++w) sum += *(const f32x4*)(red + (w * 32 + q) * 64 + 4 * lg);
                          const int mt = q >> 4, reg = q & 15, L = 4 * lg; const int i = mt * 32 + crow(reg, L >> 5), dv = L & 31;
                          *(f32x4*)(O + (size_t)(r0 + i) * DM + h * 512 + 32 * s + dv) = sum; }
                        asm volatile("s_waitcnt lgkmcnt(0)" ::: "memory"); __builtin_amdgcn_s_barrier(); asm volatile("" ::: "memory");
                    }
#undef GL_LD_Q
#undef GL_LD_E
#undef GL_LD_K
                    float* dst = OUTP + (prompt ? O_PGLA + ((((size_t)jl * 2 + b) * 4 + h) * 256) * 512 : O_SGLA + ((((size_t)jl * 16 + b) * 4 + h) * 256) * 512);
#pragma unroll
                    for (int i = 0; i < 16; ++i) dst[(size_t)(32 * wave + crow(i, hl)) * 512 + 32 * s + l32] = S[i];
                }
            }
            fast_grid_barrier((unsigned*)ldp(tab, 40), tab);
            {
                PHASE_IDS BASES GLA_PTRS
                const float* hn = IN(33) + (size_t)jl * 512;
                for (int row = gw; row < MROWS; row += NGW) {
#pragma unroll
                    for (int h = 0; h < 4; ++h) {
                        const float* op = O + (size_t)row * DM + h * 512 + lane * 8;
                        const f32x4 a = *(const f32x4*)op, b = *(const f32x4*)(op + 4);
                        float ss = a[0] * a[0] + a[1] * a[1] + a[2] * a[2] + a[3] * a[3] + b[0] * b[0] + b[1] * b[1] + b[2] * b[2] + b[3] * b[3];
                        const float rs = rsqrtf(wave_sum(ss, lane) * (1.f / 512.f) + 1e-5f);
                        float gt[8]; unpack8(*(const u32x4*)(PROJ + (size_t)row * 6144 + 4096 + h * 512 + lane * 8), gt);
                        const f32x4 n0 = *(const f32x4*)(hn + lane * 8), n1 = *(const f32x4*)(hn + lane * 8 + 4);
                        float y[8];
#pragma unroll
                        for (int i = 0; i < 4; ++i) { y[i] = a[i] * rs * n0[i] * (gt[i] * sigmoidf_(gt[i])); y[4 + i] = b[i] * rs * n1[i] * (gt[4 + i] * sigmoidf_(gt[4 + i])); }
                        *(u32x4*)(Y + (size_t)row * DM + h * 512 + lane * 8) = pack8(y);
                    }
                }
            }
            fast_grid_barrier((unsigned*)ldp(tab, 40), tab);
            {
                BASES GLA_PTRS
                pg8::Gemm g{Y, GO, MROWS, 2048, 2048, 0, 0};
                pg8::StaticOrder S; S.init(g.M, g.N, G, (int)blockIdx.x);
                pg8::Epi<FRes> E{FRes{X}};
                pg8::gemm_phase(ldsl, g, S, E);
            }
            fast_grid_barrier((unsigned*)ldp(tab, 40), tab);
        }
        {
            { PHASE_IDS BASES FFN_PTRS
            const float* gf = IN(7) + (size_t)layer * DM;
            for (int row = gw; row < MROWS; row += NGW) {
                const f32x4* xr = (const f32x4*)(X + (size_t)row * DM) + lane; f32x4 x[8]; float ss = 0.f;
#pragma unroll
                for (int q = 0; q < 8; ++q) { x[q] = xr[64 * q]; ss += x[q][0] * x[q][0] + x[q][1] * x[q][1] + x[q][2] * x[q][2] + x[q][3] * x[q][3]; }
                const float rs = rsqrtf(wave_sum(ss, lane) * (1.f / DM) + 1e-6f);
#pragma unroll
                for (int q = 0; q < 8; ++q) { const f32x4 gg = *((const f32x4*)gf + lane + 64 * q); const f32x4 h = x[q] * rs * gg;
                    u32x2 w; w.x = cvt_pk_bf16(h[0], h[1]); w.y = cvt_pk_bf16(h[2], h[3]); *((u32x2*)(H + (size_t)row * DM) + lane + 64 * q) = w; }
            } }
            fast_grid_barrier((unsigned*)ldp(tab, 40), tab);
            {
                BASES FFN_PTRS
                pg8::Gemm g{H, WU, MROWS, F2, 2048, 0, 0};
                pg8::StaticOrder S; S.init(g.M, g.N, G, (int)blockIdx.x);
                pg8::Epi<FUp> E{FUp{U, OUTP + O_PCONV + (size_t)layer * 2 * 2 * F2, OUTP + O_SCONV + (size_t)layer * 16 * 2 * F2}};
                pg8::gemm_phase(ldsl, g, S, E);
            }
            fast_grid_barrier((unsigned*)ldp(tab, 40), tab);
            {
                PHASE_IDS BASES FFN_PTRS
                const float* cw = IN(36) + (size_t)layer * 3 * F2; const float* cb = IN(37) + (size_t)layer * F2;
                const float* cst = IN(5) + (size_t)layer * 16 * 2 * F2;
#pragma unroll 1
                for (int it = gtid; it < 544 * 704; it += NT) {
                    const int rc = it / 704, c8 = it - rc * 704, col = c8 * 8, r0 = rc * 32;
                    int t0, len, b; bool prompt; row_info(r0, t0, len, b, prompt);
                    float wv[3][8], wg[3][8], bv[8], bg[8];
#pragma unroll
                    for (int k = 0; k < 3; ++k) { const f32x4 a = *(const f32x4*)(cw + (size_t)k * F2 + col), a2 = *(const f32x4*)(cw + (size_t)k * F2 + col + 4);
                        const f32x4 g = *(const f32x4*)(cw + (size_t)k * F2 + FH + col), g2 = *(const f32x4*)(cw + (size_t)k * F2 + FH + col + 4);
#pragma unroll
                        for (int i = 0; i < 4; ++i) { wv[k][i] = a[i]; wv[k][4 + i] = a2[i]; wg[k][i] = g[i]; wg[k][4 + i] = g2[i]; } }
                    { const f32x4 a = *(const f32x4*)(cb + col), a2 = *(const f32x4*)(cb + col + 4), g = *(const f32x4*)(cb + FH + col), g2 = *(const f32x4*)(cb + FH + col + 4);
#pragma unroll
                      for (int i = 0; i < 4; ++i) { bv[i] = a[i]; bv[4 + i] = a2[i]; bg[i] = g[i]; bg[4 + i] = g2[i]; } }
                    float v2[8], v1[8], g2_[8], g1_[8];
                    if (t0 > 0) {
                        unpack8(*(const u32x4*)(U + (size_t)(r0 - 2) * F2 + col), v2); unpack8(*(const u32x4*)(U + (size_t)(r0 - 1) * F2 + col), v1);
                        unpack8(*(const u32x4*)(U + (size_t)(r0 - 2) * F2 + FH + col), g2_); unpack8(*(const u32x4*)(U + (size_t)(r0 - 1) * F2 + FH + col), g1_);
                    } else if (!prompt) {
                        const float* s0 = cst + ((size_t)b * 2) * F2 + col; const float* s1 = s0 + F2;
#pragma unroll
                        for (int i = 0; i < 8; ++i) { v2[i] = s0[i]; v1[i] = s1[i]; g2_[i] = s0[FH + i]; g1_[i] = s1[FH + i]; }
                    } else {
#pragma unroll
                        for (int i = 0; i < 8; ++i) { v2[i] = 0.f; v1[i] = 0.f; g2_[i] = 0.f; g1_[i] = 0.f; }
                    }
#pragma unroll 1
                    for (int rb = 0; rb < 32; rb += 8) {
                      u32x4 uv_[8], ug_[8];
#pragma unroll
                      for (int j = 0; j < 8; ++j) { uv_[j] = *(const u32x4*)(U + (size_t)(r0 + rb + j) * F2 + col); ug_[j] = *(const u32x4*)(U + (size_t)(r0 + rb + j) * F2 + FH + col); }
#pragma unroll
                      for (int j = 0; j < 8; ++j) {
                        const int r = rb + j;
                        float v0[8], g0[8];
                        unpack8(uv_[j], v0); unpack8(ug_[j], g0);
                        float y[8];
#pragma unroll
                        for (int i = 0; i < 8; ++i) {
                            const float cv = bv[i] + wv[0][i] * v2[i] + wv[1][i] * v1[i] + wv[2][i] * v0[i];
                            const float cg_ = bg[i] + wg[0][i] * g2_[i] + wg[1][i] * g1_[i] + wg[2][i] * g0[i];
                            y[i] = cg_ * sigmoidf_(cg_) * cv;
                            v2[i] = v1[i]; v1[i] = v0[i]; g2_[i] = g1_[i]; g1_[i] = g0[i];
                        }
                        *(u32x4*)(HID + (size_t)(r0 + r) * FH + col) = pack8(y);
                      }
                    }
                }
            }
            fast_grid_barrier((unsigned*)ldp(tab, 40), tab);
            {
                BASES FFN_PTRS
                pg8::Gemm g{HID, WD, MROWS, 2048, FH, 0, 0};
                pg8::StaticOrder S; S.init(g.M, g.N, G, (int)blockIdx.x);
                pg8::Epi<FRes> E{FRes{X}};
                pg8::gemm_phase(ldsl, g, S, E);
            }
            fast_grid_barrier((unsigned*)ldp(tab, 40), tab);
        }
    }
    {
        PHASE_IDS BASES
        const float* gn = IN(8);
        for (int row = gw; row < MROWS; row += NGW) {
            f32x4* xr = (f32x4*)(X + (size_t)row * DM) + lane; f32x4 x[8]; float ss = 0.f;
#pragma unroll
            for (int q = 0; q < 8; ++q) { x[q] = xr[64 * q]; ss += x[q][0] * x[q][0] + x[q][1] * x[q][1] + x[q][2] * x[q][2] + x[q][3] * x[q][3]; }
            const float rs = rsqrtf(wave_sum(ss, lane) * (1.f / DM) + 1e-6f);
#pragma unroll
            for (int q = 0; q < 8; ++q) { const f32x4 gg = *((const f32x4*)gn + lane + 64 * q); xr[64 * q] = x[q] * rs * gg; }
        }
    }
}

extern "C" void kernel_launch(void* const* d_in, const int* in_sizes, int n_in, void* d_out, int out_size, void* d_ws, size_t ws_size, hipStream_t stream) {
    static int grid = 0;
    if (grid == 0) {
        if (n_in != 39 || (size_t)out_size != O_TOTAL || ws_size < WS_END) {
            fprintf(stderr, "kernel_launch: unexpected shapes: n_in %d out %d ws %zu (need %zu)\n", n_in, out_size, ws_size, (size_t)WS_END); grid = -1; return; }
        int dev = 0, cus = 0, per_cu = 0;
        (void)hipGetDevice(&dev);
        (void)hipDeviceGetAttribute(&cus, hipDeviceAttributeMultiprocessorCount, dev);
        if (hipFuncSetAttribute((const void*)fwd_kernel, hipFuncAttributeMaxDynamicSharedMemorySize, LDS_BYTES) != hipSuccess) { fprintf(stderr, "kernel_launch: hipFuncSetAttribute failed\n"); grid = -1; return; }
        if (hipOccupancyMaxActiveBlocksPerMultiprocessor(&per_cu, (const void*)fwd_kernel, 512, LDS_BYTES) != hipSuccess || per_cu < 1) { fprintf(stderr, "kernel_launch: occupancy query says %d\n", per_cu); per_cu = 1; }
        (void)hipGetLastError();
        grid = cus * 1;
        if (grid <= 0) grid = 256;
    }
    if (grid < 0) return;
    P prm{};
    for (int i = 0; i < 39; ++i) prm.in[i] = (const float*)d_in[i];
    prm.out = (float*)d_out; prm.ws = (unsigned char*)d_ws;
    (void)hipMemsetAsync(d_ws, 0, 4096, stream);
    void* args[] = {&prm};
    hipError_t e = hipLaunchCooperativeKernel((const void*)fwd_kernel, dim3(grid), dim3(512), args, LDS_BYTES, stream);
    if (e != hipSuccess) fprintf(stderr, "cooperative launch failed: %s (grid %d)\n", hipGetErrorString(e), grid);
}
```

```cpp
#include <hip/hip_runtime.h>
#include <hip/hip_cooperative_groups.h>
#include <cstdio>
#include <cstdint>
namespace cg = cooperative_groups;

#define LAS __attribute__((address_space(3)))
typedef unsigned short bf16_t;
typedef short bf16x8 __attribute__((ext_vector_type(8)));
typedef float f32x4 __attribute__((ext_vector_type(4)));
typedef float f32x16 __attribute__((ext_vector_type(16)));
typedef unsigned u32x4 __attribute__((ext_vector_type(4)));
typedef unsigned u32x2 __attribute__((ext_vector_type(2)));

constexpr int DM = 2048, MROWS = 17408, MPROMPT = 16384;
constexpr int FH = 5632, F2 = 11264;
constexpr int LDS_BYTES = 147456;
constexpr size_t MiB = 1u << 20;
constexpr size_t WS_WT = 1 * MiB;
constexpr size_t WS_A = 411 * MiB;
constexpr size_t WS_B = 819 * MiB;
constexpr size_t WS_VF = 1227 * MiB;
constexpr size_t WS_END = 1295 * MiB;
constexpr size_t ACT = (size_t)MROWS * DM;
constexpr size_t RW_SZ = (size_t)7168 * 2048 + (size_t)8192 * 256 + (size_t)2048 * 2048;
constexpr size_t GW_SZ = (size_t)6400 * 2048 + (size_t)2048 * 2048;
constexpr size_t FW_SZ = (size_t)11264 * 2048 + (size_t)2048 * 5632;
constexpr size_t GW_OFF = 2 * RW_SZ, FW_OFF = GW_OFF + 2 * GW_SZ;
constexpr size_t O_PSHIFT = 35651584, O_PWKV = 35659776, O_PGLA = 36184064, O_PCONV = 38281216;
constexpr size_t O_SSHIFT = 38461440, O_SWKV = 38526976, O_SGLA = 42721280, O_SCONV = 59498496, O_TOTAL = 60940288;

__device__ __forceinline__ unsigned cvt_pk_bf16(float lo, float hi) { unsigned r; asm volatile("v_cvt_pk_bf16_f32 %0, %1, %2" : "=v"(r) : "v"(lo), "v"(hi)); return r; }
__device__ __forceinline__ float bf2f(bf16_t b) { return __builtin_bit_cast(float, (unsigned)b << 16); }
__device__ __forceinline__ float bflo(unsigned u) { return __builtin_bit_cast(float, u << 16); }
__device__ __forceinline__ float bfhi(unsigned u) { return __builtin_bit_cast(float, u & 0xffff0000u); }
__device__ __forceinline__ void unpack8(u32x4 w, float (&f)[8]) {
    f[0] = bflo(w.x); f[1] = bfhi(w.x); f[2] = bflo(w.y); f[3] = bfhi(w.y); f[4] = bflo(w.z); f[5] = bfhi(w.z); f[6] = bflo(w.w); f[7] = bfhi(w.w);
}
__device__ __forceinline__ u32x4 pack8(const float (&f)[8]) {
    u32x4 w; w.x = cvt_pk_bf16(f[0], f[1]); w.y = cvt_pk_bf16(f[2], f[3]); w.z = cvt_pk_bf16(f[4], f[5]); w.w = cvt_pk_bf16(f[6], f[7]); return w;
}
__device__ __forceinline__ float sigmoidf_(float x) { return 1.f / (1.f + __expf(-x)); }
__device__ __forceinline__ float shx(float v, int lane, int o) { return __builtin_bit_cast(float, __builtin_amdgcn_ds_bpermute((lane ^ o) << 2, __builtin_bit_cast(int, v))); }
__device__ __forceinline__ float wave_sum(float v, int lane) {
#pragma unroll
    for (int o = 1; o < 64; o <<= 1) v += shx(v, lane, o);
    return v;
}
__device__ __forceinline__ float sum8(float v, int lane) { v += shx(v, lane, 1); v += shx(v, lane, 2); v += shx(v, lane, 4); return v; }
__device__ __forceinline__ int crow(int reg, int h) { return (reg & 3) + 8 * (reg >> 2) + 4 * h; }

namespace pg8 {
constexpr int BM = 256, BK = 64, HALF = 128, HTB = HALF * BK * 2, STAGE_BYTES = 8 * HTB, NXCD = 8, WGM = 8;
__host__ __device__ __forceinline__ int lds_byte(int r, int c) { const int st = (r >> 4) * 2 + (c >> 5), rr = r & 15, cc = c & 31, ob = rr * 64 + cc * 2; return st * 1024 + (ob ^ (((ob >> 9) & 1) << 5)); }
__host__ __device__ __forceinline__ void stage_rc(int b, int& R, int& C) { const int st = b / 1024, sb = b % 1024, swz = sb ^ (((sb >> 9) & 1) << 5); R = (st >> 1) * 16 + swz / 64; C = (st & 1) * 32 + (swz % 64) / 2; }
__host__ __device__ __forceinline__ int perm32(int rho) { const int n = rho >> 4, i = rho & 15; return 8 * (i >> 2) + 4 * n + (i & 3); }

struct Unit { int pm, pn, kofs, knt, split; };
struct Gemm { const bf16_t* A; const bf16_t* Bt; int M, N, K; int mode; size_t astride; };
__device__ __forceinline__ const char* a_of(const Gemm& g, int pn) {
    int s = 0;
    if (g.mode == 1) s = pn < 8 ? 0 : pn < 16 ? 2 : pn < 24 ? 3 : pn == 24 ? 1 : pn == 25 ? 4 : pn == 26 ? 5 : 3;
    else if (g.mode == 2) s = pn >> 3;
    return (const char*)g.A + (size_t)s * g.astride;
}
struct StaticOrder {
    int nM, nN, nwg, G, c, nFull, S, ntK, total;
    __device__ __forceinline__ void init(int M, int N, int G_, int c_, int K = 0, int S_ = 1) { nM = M / BM; nN = N / BM; nwg = nM * nN; G = G_; c = c_; ntK = K / BK;
        nFull = (nwg / G) * G; S = S_; if (S_ <= 1 || nFull == nwg) { S = 1; nFull = nwg; } total = nFull + (nwg - nFull) * S; }
    __device__ __forceinline__ bool next(int i, Unit& u) const {
        const long L = (long)i * G + c; if (L >= total) return false;
        int wgid;
        if (L < nFull) { wgid = (int)L; u.kofs = 0; u.knt = ntK; u.split = 0; }
        else { const int j = (int)L - nFull; wgid = nFull + j / S; const int part = j % S; u.knt = ntK / S; u.kofs = part * u.knt * BK; u.split = 1 + part * 32 + j / S; }
        tile_pmpn(wgid, u.pm, u.pn); return true;
    }
    __device__ __forceinline__ void tile_pmpn(int wgid, int& pm, int& pn) const {
        { const int q = nwg / NXCD, r = nwg % NXCD, xcd = wgid % NXCD, off = wgid / NXCD; wgid = (xcd < r ? xcd * (q + 1) : r * (q + 1) + (xcd - r) * q) + off; }
        const int nig = WGM * nN, gid = wgid / nig, fm = gid * WGM, gsz = (nM - fm) < WGM ? (nM - fm) : WGM;
        pm = fm + ((wgid % nig) % gsz); pn = (wgid % nig) / gsz;
    }
};

template <class F> struct Epi {
    static constexpr bool PERM = true;
    F f;
    __device__ __forceinline__ void operator()(const f32x4 (&acc)[2][2][4][2], const Unit& u, int wr, int wc, int fr, int fq) const {
        { int t_ = threadIdx.x; asm volatile("" : "+v"(t_)); const int l_ = t_ & 63, w_ = __builtin_amdgcn_readfirstlane(t_ >> 6); fr = l_ & 15; fq = l_ >> 4; wr = w_ >> 2; wc = w_ & 3; }
        const int row0 = u.pm * BM + wr * 64 + fr, col0 = u.pn * BM + wc * 32 + 8 * fq;
#pragma unroll
        for (int ai = 0; ai < 2; ++ai)
#pragma unroll
            for (int m = 0; m < 4; ++m)
#pragma unroll
                for (int bj = 0; bj < 2; ++bj) f(row0 + ai * HALF + m * 16, col0 + bj * HALF, acc[ai][bj][m][0], acc[ai][bj][m][1], u.split);
    }
};

template <class EpiT>
__device__ __forceinline__ void gemm_phase(LAS unsigned char* lds, const Gemm g, const StaticOrder& S, const EpiT& E) {
    int tid = threadIdx.x; asm volatile("" : "+v"(tid));
    const int wid = __builtin_amdgcn_readfirstlane(tid >> 6), lane = tid & 63, wr = wid >> 2, wc = wid & 3, fr = lane & 15, fq = lane >> 4;
    const int K = g.K;
    unsigned voffA[2], voffB[2];
#pragma unroll
    for (int i = 0; i < 2; ++i) { int R, C; stage_rc(tid * 16 + i * 8192, R, C); const int Rb = EpiT::PERM ? ((R & ~31) + perm32(R & 31)) : R;
        voffA[i] = (unsigned)(R * K + C) * 2u; voffB[i] = (unsigned)(Rb * K + C) * 2u; }
    const size_t kstep = (size_t)(BK * 2);
    const size_t hstep = (size_t)HALF * K * 2;
    const size_t tstep = 2 * hstep;
    const unsigned ldsw = (unsigned)wid * 1024u;
    const int aoff = lds_byte(wr * 64 + fr, fq * 8), boff = lds_byte(wc * 32 + fr, fq * 8);
#define PG8_SA(b, h) (((b) * 2 + (h)) * HTB)
#define PG8_SB(b, h) ((4 + (b) * 2 + (h)) * HTB)
#define PG8_STAGE(bufoff, gbase, voff) do { _Pragma("unroll") for (int _i = 0; _i < 2; ++_i) \
        __builtin_amdgcn_global_load_lds((const unsigned*)((const char*)(gbase) + (voff)[_i]), (LAS unsigned*)(lds + (bufoff) + ldsw + _i * 8192), 16, 0, 0); } while (0)
#define PG8_LDA(dst, b, h) do { _Pragma("unroll") for (int m = 0; m < 4; ++m) _Pragma("unroll") for (int k = 0; k < 2; ++k) dst[m][k] = *(const LAS bf16x8*)(lds + PG8_SA(b, h) + aoff + m * 2048 + k * 1024); } while (0)
#define PG8_LDB(dst, b, h) do { _Pragma("unroll") for (int n = 0; n < 2; ++n) _Pragma("unroll") for (int k = 0; k < 2; ++k) dst[n][k] = *(const LAS bf16x8*)(lds + PG8_SB(b, h) + boff + n * 2048 + k * 1024); } while (0)
#define PG8_MMA(ai, bj, At, Bt) do { __builtin_amdgcn_s_setprio(1); _Pragma("unroll") for (int m = 0; m < 4; ++m) _Pragma("unroll") for (int n = 0; n < 2; ++n) _Pragma("unroll") for (int k = 0; k < 2; ++k) \
        acc[ai][bj][m][n] = __builtin_amdgcn_mfma_f32_16x16x32_bf16(Bt[n][k], At[m][k], acc[ai][bj][m][n], 0, 0, 0); __builtin_amdgcn_s_setprio(0); } while (0)
#define PG8_WAIT_V(n) asm volatile("s_waitcnt vmcnt(" #n ")" ::: "memory")
#define PG8_WAIT_L(n) asm volatile("s_waitcnt lgkmcnt(" #n ")" ::: "memory")
#define PG8_BAR __builtin_amdgcn_s_barrier()
#define PG8_SCHED __builtin_amdgcn_sched_barrier(0)
    Unit cur, nxt; int ui = 0;
    if (!S.next(0, cur)) return;
    f32x4 acc[2][2][4][2];
#pragma unroll
    for (int a = 0; a < 2; ++a)
#pragma unroll
        for (int b = 0; b < 2; ++b)
#pragma unroll
            for (int m = 0; m < 4; ++m)
#pragma unroll
                for (int n = 0; n < 2; ++n) acc[a][b][m][n] = (f32x4){0.f, 0.f, 0.f, 0.f};
    bf16x8 At[4][2], B0[2][2], B1[2][2];
    const char* cA = a_of(g, cur.pn) + (size_t)cur.pm * tstep + (size_t)cur.kofs * 2; const char* cB = (const char*)g.Bt + (size_t)cur.pn * tstep + (size_t)cur.kofs * 2;
    PG8_STAGE(PG8_SB(0, 0), cB, voffB); PG8_STAGE(PG8_SB(0, 1), cB + hstep, voffB); PG8_STAGE(PG8_SA(0, 0), cA, voffA); PG8_STAGE(PG8_SA(0, 1), cA + hstep, voffA);
    if (wr == 1) PG8_BAR;
    PG8_WAIT_V(2); PG8_BAR;
    PG8_STAGE(PG8_SB(1, 0), cB + kstep, voffB); PG8_STAGE(PG8_SA(1, 0), cA + kstep, voffA); PG8_STAGE(PG8_SB(1, 1), cB + hstep + kstep, voffB);
    PG8_WAIT_V(6); PG8_BAR;
    for (;;) {
        const bool has_next = S.next(ui + 1, nxt);
        const char* nA = has_next ? a_of(g, nxt.pn) + (size_t)nxt.pm * tstep + (size_t)nxt.kofs * 2 : cA; const char* nB = has_next ? (const char*)g.Bt + (size_t)nxt.pn * tstep + (size_t)nxt.kofs * 2 : cB;
        const int nt = cur.knt;
        for (int t = 0; t < nt; t += 2) {
            const bool last = (t == nt - 2);
            const char* a1 = cA + (size_t)(t + 1) * kstep;
            const char* a2 = last ? nA : cA + (size_t)(t + 2) * kstep; const char* b2 = last ? nB : cB + (size_t)(t + 2) * kstep;
            const char* a3 = a2 + kstep; const char* b3 = b2 + kstep;
            PG8_LDB(B0, 0, 0); PG8_LDB(B1, 0, 1); PG8_SCHED; PG8_LDA(At, 0, 0); PG8_STAGE(PG8_SA(1, 1), a1 + hstep, voffA);
            PG8_WAIT_V(8); PG8_WAIT_L(0); PG8_BAR; PG8_MMA(0, 0, At, B0); PG8_MMA(0, 1, At, B1); PG8_BAR; PG8_SCHED;
            PG8_LDA(At, 0, 1); PG8_STAGE(PG8_SB(0, 0), b2, voffB); PG8_STAGE(PG8_SB(0, 1), b2 + hstep, voffB); PG8_STAGE(PG8_SA(0, 0), a2, voffA);
            PG8_WAIT_V(8); PG8_WAIT_L(0); PG8_BAR; PG8_MMA(1, 0, At, B0); PG8_MMA(1, 1, At, B1); PG8_BAR; PG8_SCHED;
            PG8_LDB(B0, 1, 0); PG8_LDB(B1, 1, 1); PG8_SCHED; PG8_LDA(At, 1, 0); PG8_STAGE(PG8_SA(0, 1), a2 + hstep, voffA);
            PG8_WAIT_V(8); PG8_WAIT_L(0); PG8_BAR; PG8_MMA(0, 0, At, B0); PG8_MMA(0, 1, At, B1); PG8_BAR; PG8_SCHED;
            PG8_LDA(At, 1, 1); PG8_STAGE(PG8_SB(1, 0), b3, voffB); PG8_STAGE(PG8_SB(1, 1), b3 + hstep, voffB); PG8_STAGE(PG8_SA(1, 0), a3, voffA);
            PG8_WAIT_V(8); PG8_WAIT_L(0); PG8_BAR; PG8_MMA(1, 0, At, B0); PG8_MMA(1, 1, At, B1); PG8_BAR; PG8_SCHED;
        }
        if (wr == 0) PG8_BAR;
        E(acc, cur, wr, wc, fr, fq);
        if (!has_next) break;
#pragma unroll
        for (int a = 0; a < 2; ++a)
#pragma unroll
            for (int b = 0; b < 2; ++b)
#pragma unroll
                for (int m = 0; m < 4; ++m)
#pragma unroll
                    for (int n = 0; n < 2; ++n) acc[a][b][m][n] = (f32x4){0.f, 0.f, 0.f, 0.f};
        cur = nxt; cA = nA; cB = nB; ++ui;
        if (wr == 1) PG8_BAR;
    }
    PG8_WAIT_V(0);
    PG8_BAR;
#undef PG8_SA
#undef PG8_SB
#undef PG8_STAGE
#undef PG8_LDA
#undef PG8_LDB
#undef PG8_MMA
#undef PG8_WAIT_V
#undef PG8_WAIT_L
#undef PG8_BAR
#undef PG8_SCHED
}
}

__device__ __forceinline__ void store8bf(bf16_t* p, f32x4 a, f32x4 b) {
    u32x4 w; w.x = cvt_pk_bf16(a[0], a[1]); w.y = cvt_pk_bf16(a[2], a[3]); w.z = cvt_pk_bf16(b[0], b[1]); w.w = cvt_pk_bf16(b[2], b[3]);
    *(u32x4*)p = w;
}
struct FRes { float* X; float* PART;
    __device__ __forceinline__ void operator()(int row, int col, f32x4 a, f32x4 b, int split) const {
        float* p = X + (size_t)row * DM + col;
        if (split) { float* q = PART + (size_t)(split - 1) * 65536 + (row & 255) * 256 + (col & 255); *(f32x4*)q = a; *(f32x4*)(q + 4) = b; }
        else { f32x4 x0 = *(f32x4*)p, x1 = *(f32x4*)(p + 4); *(f32x4*)p = x0 + a; *(f32x4*)(p + 4) = x1 + b; } } };
struct FR1 { bf16_t *R, *K, *V, *L;
    __device__ __forceinline__ void operator()(int row, int col, f32x4 a, f32x4 b, int) const {
        if (col < 6144) { const int g = col >> 11; const size_t o = (size_t)row * DM + (col & 2047); if (g == 0) store8bf(R + o, a, b); else if (g == 1) store8bf(K + o, a, b); else store8bf(V + o, a, b); }
        else { const int t = (col - 6144) >> 8, c = col & 255;
            if (t == 0) { for (int i = 0; i < 4; ++i) { a[i] = 1.f - 2.f / (1.f + __expf(2.f * a[i])); b[i] = 1.f - 2.f / (1.f + __expf(2.f * b[i])); } }
            else if (t == 2) { for (int i = 0; i < 4; ++i) { a[i] = sigmoidf_(a[i]); b[i] = sigmoidf_(b[i]); } }
            store8bf(L + (size_t)t * MROWS * 256 + (size_t)row * 256 + c, a, b); } } };
__device__ __forceinline__ float decay_of(float z) { return -0.60653065971f / (1.f + __expf(-z)); }
struct FR2 { float* DD; bf16_t *AA, *GG, *VG; const float *w0, *a0, *v0;
    __device__ __forceinline__ void operator()(int row, int col, f32x4 a, f32x4 b, int) const {
        const int g = col >> 11, c = col & 2047; const size_t off = (size_t)row * DM + c;
        if (g == 0) { f32x4 z0 = *(const f32x4*)(w0 + c), z1 = *(const f32x4*)(w0 + c + 4); a += z0; b += z1;
            for (int i = 0; i < 4; ++i) { a[i] = decay_of(a[i]); b[i] = decay_of(b[i]); }
            *(f32x4*)(DD + off) = a; *(f32x4*)(DD + off + 4) = b; }
        else if (g == 1) { f32x4 z0 = *(const f32x4*)(a0 + c), z1 = *(const f32x4*)(a0 + c + 4); a += z0; b += z1;
            for (int i = 0; i < 4; ++i) { a[i] = sigmoidf_(a[i]); b[i] = sigmoidf_(b[i]); } store8bf(AA + off, a, b); }
        else if (g == 2) { store8bf(GG + off, a, b); }
        else { f32x4 z0 = *(const f32x4*)(v0 + c), z1 = *(const f32x4*)(v0 + c + 4); a += z0; b += z1;
            for (int i = 0; i < 4; ++i) { a[i] = sigmoidf_(a[i]); b[i] = sigmoidf_(b[i]); } store8bf(VG + off, a, b); } } };
struct FG1 { bf16_t* PROJ; float* LR;
    __device__ __forceinline__ void operator()(int row, int col, f32x4 a, f32x4 b, int) const {
        if (col < 6144) { if (col < 1024) { a *= 0.0625f; b *= 0.0625f; } store8bf(PROJ + (size_t)row * 6144 + col, a, b); }
        else if (col < 6160) { float* p = LR + (size_t)row * 16 + (col - 6144); *(f32x4*)p = a; *(f32x4*)(p + 4) = b; } } };
struct FUp { bf16_t* U; float* pconv; float* sconv;
    __device__ __forceinline__ void operator()(int row, int col, f32x4 a, f32x4 b, int) const {
        store8bf(U + (size_t)row * F2 + col, a, b);
        if (row < MPROMPT) { const int t = row & 8191; if (t >= 8190) { float* p = pconv + ((size_t)((row >> 13) * 2 + (t - 8190))) * F2 + col; *(f32x4*)p = a; *(f32x4*)(p + 4) = b; } }
        else { const int rr = row - MPROMPT, t = rr & 63; if (t >= 62) { float* p = sconv + ((size_t)((rr >> 6) * 2 + (t - 62))) * F2 + col; *(f32x4*)p = a; *(f32x4*)(p + 4) = b; } } } };

__device__ __forceinline__ void tr_item(const float* W, int K, int N, bf16_t* WT, int Kpad, int Npad, float* scr, int item, int lane) {
    const int nblk = Npad / 32, kb = item / nblk, nb = item % nblk, k0 = 64 * kb, n0 = 32 * nb;
    const int n = n0 + (lane & 31);
#pragma unroll
    for (int i = 0; i < 32; ++i) { const int kk = 2 * i + (lane >> 5); const int k = k0 + kk; scr[kk * 33 + (lane & 31)] = (k < K && n < N) ? W[(size_t)k * N + n] : 0.f; }
    asm volatile("s_waitcnt lgkmcnt(0)" ::: "memory");
    const int c = lane & 7;
#pragma unroll
    for (int j = 0; j < 4; ++j) { const int nn = (lane >> 3) + 8 * j; const float* s = scr + (8 * c) * 33 + nn;
        u32x4 o; o.x = cvt_pk_bf16(s[0 * 33], s[1 * 33]); o.y = cvt_pk_bf16(s[2 * 33], s[3 * 33]); o.z = cvt_pk_bf16(s[4 * 33], s[5 * 33]); o.w = cvt_pk_bf16(s[6 * 33], s[7 * 33]);
        *(u32x4*)(WT + (size_t)(n0 + nn) * Kpad + k0 + 8 * c) = o; }
    asm volatile("s_waitcnt lgkmcnt(0)" ::: "memory");
}

struct P { const float* in[39]; float* out; unsigned char* ws; };

__device__ __forceinline__ void row_info(int row, int& t, int& len, int& b, bool& prompt) {
    if (row < MPROMPT) { prompt = true; b = row >> 13; t = row & 8191; len = 8192; }
    else { prompt = false; const int rr = row - MPROMPT; b = rr >> 6; t = rr & 63; len = 64; }
}

__device__ __forceinline__ const float* ldp(const unsigned long long* tab, int i) {
    const unsigned long long v = tab[i];
    const unsigned lo = __builtin_amdgcn_readfirstlane((unsigned)v), hi = __builtin_amdgcn_readfirstlane((unsigned)(v >> 32));
    const __attribute__((address_space(1))) float* g = (const __attribute__((address_space(1))) float*)(((unsigned long long)hi << 32) | lo);
    return (const float*)g;
}
__device__ __forceinline__ void fast_grid_barrier(unsigned* bar, unsigned long long* tab) {
    asm volatile("s_waitcnt vmcnt(0)" ::: "memory");
    __syncthreads();
    if (threadIdx.x == 0) {
        const unsigned G = gridDim.x, grp = blockIdx.x & 7u;
        const unsigned epoch = (unsigned)tab[41] + 1u; tab[41] = epoch;
        const unsigned ngrp = (G - grp + 7u) >> 3, ntop = G < 8u ? G : 8u;
        __builtin_amdgcn_fence(__ATOMIC_RELEASE, "agent");
        asm volatile("s_waitcnt vmcnt(0)" ::: "memory");
        const unsigned old = __hip_atomic_fetch_add(&bar[64u * (1u + grp)], 1u, __ATOMIC_RELAXED, __HIP_MEMORY_SCOPE_AGENT);
        if (old + 1u == epoch * ngrp) (void)__hip_atomic_fetch_add(&bar[0], 1u, __ATOMIC_RELAXED, __HIP_MEMORY_SCOPE_AGENT);
        while (__hip_atomic_load(&bar[0], __ATOMIC_RELAXED, __HIP_MEMORY_SCOPE_AGENT) < epoch * ntop) __builtin_amdgcn_s_sleep(1);
        __builtin_amdgcn_fence(__ATOMIC_ACQUIRE, "agent");
        asm volatile("s_waitcnt vmcnt(0)" ::: "memory");
    }
    __syncthreads();
}
#define IN(k) ldp(tab, (k))
#define OUTP ((float*)ldp(tab, 39))
#define BASES float* X = (float*)ldp(tab, 39); unsigned char* ws_ = (unsigned char*)ldp(tab, 40); bf16_t* WT = (bf16_t*)(ws_ + WS_WT); unsigned char* RA = ws_ + WS_A; unsigned char* RB = ws_ + WS_B; \
    bf16_t* VFIRST = (bf16_t*)(ws_ + WS_VF); LAS unsigned char* ldsl = (LAS unsigned char*)lds; (void)X; (void)WT; (void)RA; (void)RB; (void)VFIRST; (void)ldsl;
#define RWKV_PTRS bf16_t* HB = (bf16_t*)RA; bf16_t* Rb = (bf16_t*)RB; bf16_t* Kb = Rb + ACT; bf16_t* Vb = (jl == 0) ? VFIRST : Kb + ACT; bf16_t* Lb = (bf16_t*)(RB + 204 * MiB); \
    float* DD = (float*)(RB + 240 * MiB); bf16_t* AA = (bf16_t*)RA; bf16_t* VG = AA + ACT; bf16_t* GG = VG + ACT; bf16_t* Y = GG + ACT; \
    bf16_t* W1 = WT + jl * RW_SZ; bf16_t* W2 = W1 + (size_t)7168 * 2048; bf16_t* WO = W2 + (size_t)8192 * 256; \
    (void)HB; (void)Rb; (void)Kb; (void)Vb; (void)Lb; (void)DD; (void)AA; (void)VG; (void)GG; (void)Y; (void)W1; (void)W2; (void)WO;
#define GLA_PTRS bf16_t* H = (bf16_t*)RB; float* LR = (float*)(RB + 68 * MiB); float* O = (float*)(RB + 70 * MiB); bf16_t* Y = (bf16_t*)(RB + 206 * MiB); \
    bf16_t* PROJ = (bf16_t*)RA; bf16_t* QE = (bf16_t*)(RA + 204 * MiB); bf16_t* KDT = (bf16_t*)(RA + 238 * MiB); bf16_t* VT = (bf16_t*)(RA + 272 * MiB); \
    bf16_t* SC = (bf16_t*)(RA + 340 * MiB); float* EL = (float*)(RA + 349 * MiB); bf16_t* GI = WT + GW_OFF + jl * GW_SZ; bf16_t* GO = GI + (size_t)6400 * 2048; \
    (void)H; (void)LR; (void)O; (void)Y; (void)PROJ; (void)QE; (void)KDT; (void)VT; (void)SC; (void)EL; (void)GI; (void)GO;
#define FFN_PTRS bf16_t* H = (bf16_t*)RB; bf16_t* HID = (bf16_t*)(RB + 68 * MiB); bf16_t* U = (bf16_t*)RA; bf16_t* WU = WT + FW_OFF + layer * FW_SZ; bf16_t* WD = WU + (size_t)F2 * 2048; \
    (void)H; (void)HID; (void)U; (void)WU; (void)WD;

__global__ void __launch_bounds__(512, 2) fwd_kernel(P p) {
    extern __shared__ __attribute__((aligned(16))) unsigned char lds[];
    cg::grid_group grid = cg::this_grid();
    const int G = gridDim.x, NGW = G * 8, NT = G * 512;
#define PHASE_IDS int tid = threadIdx.x; asm volatile("" : "+v"(tid)); const int lane = tid & 63; const int wave = __builtin_amdgcn_readfirstlane(tid >> 6); const int gw = blockIdx.x * 8 + wave; const int gtid = blockIdx.x * 512 + tid; (void)lane; (void)gw; (void)gtid;
    unsigned long long* tab = (unsigned long long*)(lds + LDS_BYTES - 512);
    if (threadIdx.x == 0) {
#pragma unroll
        for (int i = 0; i < 39; ++i) tab[i] = (unsigned long long)p.in[i];
        tab[39] = (unsigned long long)p.out; tab[40] = (unsigned long long)p.ws; tab[41] = 0ull;
    }
    __syncthreads();

    {
        PHASE_IDS BASES
        float* scr = (float*)(lds + wave * 16384);
#define TR(src, K, N, dst, Kpad, Npad) do { const int _ni = ((Kpad) / 64) * ((Npad) / 32); for (int it = gw; it < _ni; it += NGW) tr_item((src), (K), (N), (dst), (Kpad), (Npad), scr, it, lane); } while (0)
#pragma unroll 1
        for (int j = 0; j < 2; ++j) {
            bf16_t* W1 = WT + j * RW_SZ; bf16_t* W2 = W1 + (size_t)7168 * 2048; bf16_t* WO = W2 + (size_t)8192 * 256;
            TR(IN(24) + (size_t)j * DM * DM, 2048, 2048, W1, 2048, 2048);
            TR(IN(25) + (size_t)j * DM * DM, 2048, 2048, W1 + (size_t)2048 * 2048, 2048, 2048);
            TR(IN(26) + (size_t)j * DM * DM, 2048, 2048, W1 + (size_t)4096 * 2048, 2048, 2048);
            TR(IN(11) + (size_t)j * DM * 96, 2048, 96, W1 + (size_t)6144 * 2048, 2048, 256);
            TR(IN(14) + (size_t)j * DM * 96, 2048, 96, W1 + (size_t)6400 * 2048, 2048, 256);
            TR(IN(19) + (size_t)j * DM * 256, 2048, 256, W1 + (size_t)6656 * 2048, 2048, 256);
            if (j >= 1) TR(IN(17) + (size_t)(j - 1) * DM * 64, 2048, 64, W1 + (size_t)6912 * 2048, 2048, 256);
            TR(IN(12) + (size_t)j * 96 * DM, 96, 2048, W2, 256, 2048);
            TR(IN(15) + (size_t)j * 96 * DM, 96, 2048, W2 + (size_t)2048 * 256, 256, 2048);
            TR(IN(20) + (size_t)j * 256 * DM, 256, 2048, W2 + (size_t)4096 * 256, 256, 2048);
            if (j >= 1) TR(IN(18) + (size_t)(j - 1) * 64 * DM, 64, 2048, W2 + (size_t)6144 * 256, 256, 2048);
            TR(IN(27) + (size_t)j * DM * DM, 2048, 2048, WO, 2048, 2048);
            bf16_t* GI = WT + GW_OFF + j * GW_SZ; bf16_t* GO = GI + (size_t)6400 * 2048;
            TR(IN(30) + (size_t)j * DM * 6160, 2048, 6160, GI, 2048, 6400);
            TR(IN(34) + (size_t)j * DM * DM, 2048, 2048, GO, 2048, 2048);
        }
#pragma unroll 1
        for (int i = 0; i < 4; ++i) {
            bf16_t* WU = WT + FW_OFF + i * FW_SZ; bf16_t* WD = WU + (size_t)F2 * 2048;
            TR(IN(35) + (size_t)i * DM * F2, 2048, F2, WU, 2048, F2);
            TR(IN(38) + (size_t)i * FH * DM, FH, 2048, WD, FH, 2048);
        }
#undef TR
        const f32x4* xp = (const f32x4*)IN(0); const f32x4* xs = (const f32x4*)IN(1); f32x4* xo = (f32x4*)X;
        const int NP4 = MPROMPT * DM / 4, NA4 = MROWS * DM / 4;
#pragma unroll 4
        for (int i = gtid; i < NA4; i += NT) xo[i] = i < NP4 ? xp[i] : xs[i - NP4];
    }
    grid.sync();

#pragma clang loop unroll(full)
    for (int layer = 0; layer < 4; ++layer) {
        const int jl = layer >> 1;
        if ((layer & 1) == 0) {
            {
                PHASE_IDS BASES RWKV_PTRS
                const float* gmix = IN(6) + (size_t)layer * DM;
                const float* mix = IN(9) + (size_t)jl * 6 * DM;
                const float* sst = IN(2) + (size_t)jl * 16 * DM;
                for (int row = gw; row < MROWS; row += NGW) {
                    int t, len, b; bool prompt; row_info(row, t, len, b, prompt);
                    const f32x4* xr = (const f32x4*)(X + (size_t)row * DM) + lane;
                    f32x4 x[8]; float ss = 0.f;
#pragma unroll
                    for (int q = 0; q < 8; ++q) { x[q] = xr[64 * q]; ss += x[q][0] * x[q][0] + x[q][1] * x[q][1] + x[q][2] * x[q][2] + x[q][3] * x[q][3]; }
                    const float rs = rsqrtf(wave_sum(ss, lane) * (1.f / DM) + 1e-6f);
                    f32x4 hp[8];
                    if (t > 0) {
                        const f32x4* xq = (const f32x4*)(X + (size_t)(row - 1) * DM) + lane; float s2 = 0.f;
#pragma unroll
                        for (int q = 0; q < 8; ++q) { hp[q] = xq[64 * q]; s2 += hp[q][0] * hp[q][0] + hp[q][1] * hp[q][1] + hp[q][2] * hp[q][2] + hp[q][3] * hp[q][3]; }
                        const float rp = rsqrtf(wave_sum(s2, lane) * (1.f / DM) + 1e-6f);
#pragma unroll
                        for (int q = 0; q < 8; ++q) { const f32x4 gg = *((const f32x4*)gmix + lane + 64 * q); hp[q] = hp[q] * rp * gg; }
                    } else if (!prompt) {
#pragma unroll
                        for (int q = 0; q < 8; ++q) hp[q] = *((const f32x4*)(sst + (size_t)b * DM) + lane + 64 * q);
                    } else {
#pragma unroll
                        for (int q = 0; q < 8; ++q) hp[q] = (f32x4){0.f, 0.f, 0.f, 0.f};
                    }
                    const bool lastrow = (t == len - 1);
                    float* shout = OUTP + (prompt ? O_PSHIFT + ((size_t)jl * 2 + b) * DM : O_SSHIFT + ((size_t)jl * 16 + b) * DM);
#pragma unroll
                    for (int q = 0; q < 8; ++q) {
                        const f32x4 gg = *((const f32x4*)gmix + lane + 64 * q);
                        const f32x4 h = x[q] * rs * gg; const f32x4 dlt = hp[q] - h;
                        if (lastrow) *((f32x4*)shout + lane + 64 * q) = h;
#pragma unroll
                        for (int m = 0; m < 6; ++m) {
                            const f32x4 mx = *((const f32x4*)(mix + (size_t)m * DM) + lane + 64 * q);
                            const f32x4 o = h + dlt * mx;
                            u32x2 w; w.x = cvt_pk_bf16(o[0], o[1]); w.y = cvt_pk_bf16(o[2], o[3]);
                            *((u32x2*)(HB + (size_t)m * ACT + (size_t)row * DM) + lane + 64 * q) = w;
                        }
                    }
                }
            }
            fast_grid_barrier((unsigned*)ldp(tab, 40), tab);
            {
                BASES RWKV_PTRS
                pg8::Gemm g{HB, W1, MROWS, jl == 0 ? 6912 : 7168, 2048, 1, ACT * 2};
                pg8::StaticOrder S; S.init(g.M, g.N, G, (int)blockIdx.x, g.K, 1);
                pg8::Epi<FR1> E{FR1{Rb, Kb, Vb, Lb}};
                pg8::gemm_phase(ldsl, g, S, E);
            }
            fast_grid_barrier((unsigned*)ldp(tab, 40), tab);
            {
                BASES RWKV_PTRS
                pg8::Gemm g{Lb, W2, MROWS, jl == 0 ? 6144 : 8192, 256, 2, (size_t)MROWS * 256 * 2};
                pg8::StaticOrder S; S.init(g.M, g.N, G, (int)blockIdx.x, g.K, 1);
                pg8::Epi<FR2> E{FR2{DD, AA, GG, VG, IN(10) + (size_t)jl * DM, IN(13) + (size_t)jl * DM, IN(16) + (size_t)(jl > 0 ? jl - 1 : 0) * DM}};
                pg8::gemm_phase(ldsl, g, S, E);
            }
            fast_grid_barrier((unsigned*)ldp(tab, 40), tab);
            {
                PHASE_IDS BASES RWKV_PTRS
                float* Obuf = (float*)(RA + 272 * MiB); float* RK = (float*)(RB + 204 * MiB); float* DTg = (float*)(RB + 208 * MiB);
                const float* k_k = IN(21) + (size_t)jl * DM; const float* k_a = IN(22) + (size_t)jl * DM; const float* r_k = IN(23) + (size_t)jl * DM;
                const int l32 = lane & 31, hl = lane >> 5;
#define S1_BAR do { asm volatile("s_waitcnt lgkmcnt(0)" ::: "memory"); __builtin_amdgcn_s_barrier(); asm volatile("" ::: "memory"); } while (0)
                const int st = tid >> 3, c0 = (tid & 7) * 8;
                u32x4 pr_, pk_, pv_, pa_, pvf_ = (u32x4){0u, 0u, 0u, 0u}, pvg_ = (u32x4){0u, 0u, 0u, 0u}; f32x4 pd0_, pd1_;
#define S1_FETCH(it) do { const size_t _off = (size_t)(((it) >> 5) * 64 + st) * DM + ((it) & 31) * 64 + c0; \
                    pr_ = *(const u32x4*)(Rb + _off); pk_ = *(const u32x4*)(Kb + _off); pv_ = *(const u32x4*)(Vb + _off); pa_ = *(const u32x4*)(AA + _off); \
                    pd0_ = *(const f32x4*)(DD + _off); pd1_ = *(const f32x4*)(DD + _off + 4); \
                    if (jl > 0) { pvf_ = *(const u32x4*)(VFIRST + _off); pvg_ = *(const u32x4*)(VG + _off); } } while (0)
#pragma unroll 1
                for (int item = blockIdx.x; item < 8704; item += G) {
                    LAS unsigned char* ldsv = (LAS unsigned char*)lds; asm volatile("" : "+v"(ldsv));
                    LAS bf16_t* AH = (LAS bf16_t*)(ldsv + 0); LAS bf16_t* RH = (LAS bf16_t*)(ldsv + 9216); LAS bf16_t* BH = (LAS bf16_t*)(ldsv + 18432); LAS bf16_t* KH = (LAS bf16_t*)(ldsv + 27648);
                    LAS bf16_t* BHT = (LAS bf16_t*)(ldsv + 36864); LAS bf16_t* KHT = (LAS bf16_t*)(ldsv + 46080); LAS bf16_t* VTs = (LAS bf16_t*)(ldsv + 55296); LAS bf16_t* XT = (LAS bf16_t*)(ldsv + 64512);
                    LAS float* AAB = (LAS float*)(ldsv + 82944); LAS bf16_t* AAK = (LAS bf16_t*)(ldsv + 99328); LAS bf16_t* ARB = (LAS bf16_t*)(ldsv + 108544); LAS bf16_t* ARK = (LAS bf16_t*)(ldsv + 117760);
                    LAS float* LB = (LAS float*)(ldsv + 126976); LAS float* DTS = (LAS float*)(ldsv + 143360);
                    (void)RH; (void)KH; (void)KHT;
                    const int chunk = item >> 5, h = item & 31, r0 = chunk * 64;
                    const int col = h * 64 + c0;
                    S1_FETCH(item);
                    float r[8], kk[8], bb[8], km[8], ld[8];
                    {
                        float k[8], v[8], a[8];
                        unpack8(pr_, r); unpack8(pk_, k); unpack8(pv_, v); unpack8(pa_, a);
                        const f32x4 d0 = pd0_, d1 = pd1_;
                        ld[0] = d0[0]; ld[1] = d0[1]; ld[2] = d0[2]; ld[3] = d0[3]; ld[4] = d1[0]; ld[5] = d1[1]; ld[6] = d1[2]; ld[7] = d1[3];
                        if (jl > 0) { float vf[8], vg[8]; unpack8(pvf_, vf); unpack8(pvg_, vg);
#pragma unroll
                            for (int i = 0; i < 8; ++i) v[i] = v[i] + (vf[i] - v[i]) * vg[i]; }
                        float ss = 0.f;
#pragma unroll
                        for (int i = 0; i < 8; ++i) { kk[i] = k[i] * k_k[col + i]; ss += kk[i] * kk[i]; }
                        ss = sum8(ss, lane);
                        const float inv = 1.f / fmaxf(sqrtf(ss), 1e-12f);
                        float rk = 0.f;
#pragma unroll
                        for (int i = 0; i < 8; ++i) { kk[i] *= inv; bb[i] = kk[i] * a[i]; km[i] = k[i] * (1.f + (a[i] - 1.f) * k_a[col + i]); rk += r[i] * km[i] * r_k[col + i]; }
                        rk = sum8(rk, lane);
                        if ((tid & 7) == 0) RK[(size_t)(r0 + st) * 32 + h] = rk;
                        *(LAS f32x4*)(LB + st * 64 + c0) = d0; *(LAS f32x4*)(LB + st * 64 + c0 + 4) = d1;
#pragma unroll
                        for (int i = 0; i < 8; i += 2) { const unsigned pk = cvt_pk_bf16(v[i], v[i + 1]); VTs[(c0 + i) * 72 + st] = (bf16_t)(pk & 0xffffu); VTs[(c0 + i + 1) * 72 + st] = (bf16_t)(pk >> 16); }
                    }
                    S1_BAR;
                    {
                        const int cc_ = tid & 63, tq_ = tid >> 6; float pf[8]; float run = 0.f;
#pragma unroll
                        for (int j = 0; j < 8; ++j) { run += LB[(8 * tq_ + j) * 64 + cc_]; pf[j] = run; }
                        AAB[tq_ * 64 + cc_] = run;
                        S1_BAR;
                        float ofs = 0.f;
#pragma unroll
                        for (int g = 0; g < 7; ++g) ofs += (g < tq_) ? AAB[g * 64 + cc_] : 0.f;
#pragma unroll
                        for (int j = 0; j < 8; ++j) LB[(8 * tq_ + j) * 64 + cc_] = pf[j] + ofs;
                    }
                    S1_BAR;
                    {
                        float ah[8], bh[8], kh[8], rh[8];
#pragma unroll
                        for (int i = 0; i < 8; ++i) { const float Lt = LB[st * 64 + c0 + i]; const float e3 = __expf(Lt), e2 = __expf(-Lt), e1 = __expf(Lt - ld[i]);
                            ah[i] = -kk[i] * e1; bh[i] = bb[i] * e2; kh[i] = km[i] * e2; rh[i] = r[i] * e3;
                            if (st == 63) { DTS[c0 + i] = e3; DTg[(size_t)item * 64 + c0 + i] = e3; } }
                        *(LAS u32x4*)(AH + st * 72 + c0) = pack8(ah); *(LAS u32x4*)(RH + st * 72 + c0) = pack8(rh);
                        *(LAS u32x4*)(BH + st * 72 + c0) = pack8(bh); *(LAS u32x4*)(KH + st * 72 + c0) = pack8(kh);
#pragma unroll
                        for (int i = 0; i < 8; i += 2) { const unsigned p1 = cvt_pk_bf16(bh[i], bh[i + 1]), p2 = cvt_pk_bf16(kh[i], kh[i + 1]);
                            BHT[(c0 + i) * 72 + st] = (bf16_t)(p1 & 0xffffu); BHT[(c0 + i + 1) * 72 + st] = (bf16_t)(p1 >> 16);
                            KHT[(c0 + i) * 72 + st] = (bf16_t)(p2 & 0xffffu); KHT[(c0 + i + 1) * 72 + st] = (bf16_t)(p2 >> 16); }
                    }
                    S1_BAR;
                    {
                        const int mi = wave & 3, rowsel = mi >> 1, tt = mi & 1;
#pragma unroll
                        for (int nn = 0; nn < 2; ++nn) {
                            const int colsel = wave >> 2, stl = nn; const int ni = 2 * colsel + nn;
                            f32x16 acc;
#pragma unroll
                            for (int i = 0; i < 16; ++i) acc[i] = 0.f;
                            if (stl <= tt) {
#pragma unroll
                                for (int ks = 0; ks < 4; ++ks) {
                                    const bf16x8 a = *(const LAS bf16x8*)(AH + (mi * 32 + l32) * 72 + ks * 16 + hl * 8);
                                    const bf16x8 b = *(const LAS bf16x8*)(BH + (ni * 32 + l32) * 72 + ks * 16 + hl * 8);
                                    acc = __builtin_amdgcn_mfma_f32_32x32x16_bf16(a, b, acc, 0, 0, 0);
                                }
                            }
#pragma unroll
                            for (int i = 0; i < 16; ++i) {
                                const int t = tt * 32 + crow(i, hl), s = stl * 32 + l32;
                                const bool keep = rowsel ? (s <= t) : (s < t);
                                const float val = keep ? acc[i] : 0.f;
                                if (rowsel == 0 && colsel == 0) AAB[t * 64 + s] = val;
                                else { LAS bf16_t* dst = (rowsel == 0) ? AAK : (colsel == 0 ? ARB : ARK); dst[t * 72 + s] = (bf16_t)(cvt_pk_bf16(val, 0.f) & 0xffffu); }
                            }
                        }
                    }
                    S1_BAR;
                    if (wave < 4) {
                        const int mt = wave >> 1, nt = wave & 1;
                        f32x16 acc;
#pragma unroll
                        for (int i = 0; i < 16; ++i) acc[i] = 0.f;
#pragma unroll
                        for (int ks = 0; ks < 4; ++ks) {
                            const bf16x8 a = *(const LAS bf16x8*)(AAK + (mt * 32 + l32) * 72 + ks * 16 + hl * 8);
                            const bf16x8 b = *(const LAS bf16x8*)(VTs + (nt * 32 + l32) * 72 + ks * 16 + hl * 8);
                            acc = __builtin_amdgcn_mfma_f32_32x32x16_bf16(a, b, acc, 0, 0, 0);
                        }
#pragma unroll
                        for (int i = 0; i < 16; ++i) LB[(mt * 32 + crow(i, hl)) * 64 + nt * 32 + l32] = acc[i];
                    }
                    S1_BAR;
                    if (tid < 128) {
                        float Xc[64];
#pragma unroll
                        for (int t = 0; t < 64; ++t) Xc[t] = 0.f;
#pragma clang loop unroll(full)
                        for (int t = 0; t < 64; ++t) {
                            const float va_ = bf2f(AH[t * 72 + (tid & 63)]), vb_ = LB[t * 64 + (tid & 63)];
                            float a0 = (tid < 64) ? va_ : vb_;
                            float a1 = 0.f, a2 = 0.f, a3 = 0.f;
#pragma clang loop unroll(full)
                            for (int s4 = 0; s4 < t; s4 += 4) { const f32x4 w = *(const LAS f32x4*)(AAB + t * 64 + s4);
                                a0 += w[0] * Xc[s4]; a1 += w[1] * Xc[s4 + 1]; a2 += w[2] * Xc[s4 + 2]; a3 += w[3] * Xc[s4 + 3]; }
                            Xc[t] = (a0 + a1) + (a2 + a3);
                            asm volatile("" : "+v"(Xc[t]) :: "memory");
                        }
#pragma unroll
                        for (int q = 0; q < 8; ++q) { float f8[8];
#pragma unroll
                            for (int i = 0; i < 8; ++i) f8[i] = Xc[q * 8 + i];
                            *(LAS u32x4*)(XT + tid * 72 + q * 8) = pack8(f8); }
                    }
                    S1_BAR;
                    {
                        const int kind = wave >> 2, mt = (wave & 3) >> 1, nt = wave & 1;
                        {
                            const LAS bf16_t* Ap = (kind == 0 ? ARB : BHT) + (mt * 32 + l32) * 72; const LAS bf16_t* Bp = XT + (nt * 32 + l32) * 72;
                            f32x16 acc;
#pragma unroll
                            for (int i = 0; i < 16; ++i) acc[i] = 0.f;
#pragma unroll
                            for (int ks = 0; ks < 4; ++ks) acc = __builtin_amdgcn_mfma_f32_32x32x16_bf16(*(const LAS bf16x8*)(Ap + ks * 16 + hl * 8), *(const LAS bf16x8*)(Bp + ks * 16 + hl * 8), acc, 0, 0, 0);
                            bf16_t* dstb = (kind == 0) ? Rb : Kb;
#pragma unroll
                            for (int i = 0; i < 16; ++i) { const int rr = mt * 32 + crow(i, hl), cc = nt * 32 + l32;
                                float val = acc[i];
                                if (kind == 0) val += bf2f(RH[rr * 72 + cc]); else val *= DTS[rr];
                                dstb[(size_t)(r0 + rr) * DM + h * 64 + cc] = (bf16_t)(cvt_pk_bf16(val, 0.f) & 0xffffu); }
                        }
                        {
                            const LAS bf16_t* A1 = (kind == 0 ? ARB : BHT) + (mt * 32 + l32) * 72; const LAS bf16_t* A2 = (kind == 0 ? ARK : KHT) + (mt * 32 + l32) * 72;
                            const LAS bf16_t* B1 = XT + (64 + nt * 32 + l32) * 72; const LAS bf16_t* B2 = VTs + (nt * 32 + l32) * 72;
                            f32x16 acc;
#pragma unroll
                            for (int i = 0; i < 16; ++i) acc[i] = 0.f;
#pragma unroll
                            for (int ks = 0; ks < 4; ++ks) acc = __builtin_amdgcn_mfma_f32_32x32x16_bf16(*(const LAS bf16x8*)(A1 + ks * 16 + hl * 8), *(const LAS bf16x8*)(B1 + ks * 16 + hl * 8), acc, 0, 0, 0);
#pragma unroll
                            for (int ks = 0; ks < 4; ++ks) acc = __builtin_amdgcn_mfma_f32_32x32x16_bf16(*(const LAS bf16x8*)(A2 + ks * 16 + hl * 8), *(const LAS bf16x8*)(B2 + ks * 16 + hl * 8), acc, 0, 0, 0);
                            float* dstf = (kind == 0) ? Obuf : DD;
#pragma unroll
                            for (int i = 0; i < 16; ++i) { const int rr = mt * 32 + crow(i, hl), cc = nt * 32 + l32;
                                float val = acc[i]; if (kind == 1) val *= DTS[rr];
                                dstf[(size_t)(r0 + rr) * DM + h * 64 + cc] = val; }
                        }
                    }
                    S1_BAR;
                }
            }
            fast_grid_barrier((unsigned*)ldp(tab, 40), tab);
#undef S1_BAR
#undef S1_FETCH
            {
                PHASE_IDS BASES RWKV_PTRS
                const float* DTg = (const float*)(RB + 208 * MiB);
                const int l32 = lane & 31, hl = lane >> 5;
                const int q = wave * G + blockIdx.x;
                if (q < 1152) {
                    const bool prompt = q < 128; int b, h, vh, chunk0, nch;
                    if (prompt) { const int chain = q >> 1; b = chain >> 5; h = chain & 31; vh = q & 1; chunk0 = b * 128; nch = 128; }
                    else { const int sq = q - 128; const int chain = sq >> 1; b = chain >> 5; h = chain & 31; vh = sq & 1; chunk0 = 256 + b; nch = 1; }
                    const int colb = h * 64, vcol = colb + 32 * vh + l32;
                    f32x16 S0, S1;
                    if (prompt) {
#pragma unroll
                        for (int i = 0; i < 16; ++i) { S0[i] = 0.f; S1[i] = 0.f; }
                    } else {
                        const float* s0 = IN(3) + ((((size_t)jl * 16 + b) * 32 + h) * 64 + (32 * vh + l32)) * 64;
#pragma unroll
                        for (int i = 0; i < 16; ++i) { S0[i] = s0[crow(i, hl)]; S1[i] = s0[32 + crow(i, hl)]; }
                    }
                    bf16x8 gf[2][2][2]; f32x16 n0, n1; f32x4 dt_[2][4];
#define S2_COMPUTE(cc) do { const int _r0 = (chunk0 + (cc)) * 64; \
                        u32x4 w00, w01, w10, w11; \
                        w00.x = cvt_pk_bf16(S0[0], S0[1]); w00.y = cvt_pk_bf16(S0[2], S0[3]); w00.z = cvt_pk_bf16(S0[4], S0[5]); w00.w = cvt_pk_bf16(S0[6], S0[7]); \
                        w01.x = cvt_pk_bf16(S0[8], S0[9]); w01.y = cvt_pk_bf16(S0[10], S0[11]); w01.z = cvt_pk_bf16(S0[12], S0[13]); w01.w = cvt_pk_bf16(S0[14], S0[15]); \
                        w10.x = cvt_pk_bf16(S1[0], S1[1]); w10.y = cvt_pk_bf16(S1[2], S1[3]); w10.z = cvt_pk_bf16(S1[4], S1[5]); w10.w = cvt_pk_bf16(S1[6], S1[7]); \
                        w11.x = cvt_pk_bf16(S1[8], S1[9]); w11.y = cvt_pk_bf16(S1[10], S1[11]); w11.z = cvt_pk_bf16(S1[12], S1[13]); w11.w = cvt_pk_bf16(S1[14], S1[15]); \
                        const bf16x8 sb00 = __builtin_bit_cast(bf16x8, w00), sb01 = __builtin_bit_cast(bf16x8, w01), sb10 = __builtin_bit_cast(bf16x8, w10), sb11 = __builtin_bit_cast(bf16x8, w11); \
                        n0 = __builtin_amdgcn_mfma_f32_32x32x16_bf16(gf[0][0][0], sb00, n0, 0, 0, 0); n1 = __builtin_amdgcn_mfma_f32_32x32x16_bf16(gf[1][0][0], sb00, n1, 0, 0, 0); \
                        n0 = __builtin_amdgcn_mfma_f32_32x32x16_bf16(gf[0][0][1], sb01, n0, 0, 0, 0); n1 = __builtin_amdgcn_mfma_f32_32x32x16_bf16(gf[1][0][1], sb01, n1, 0, 0, 0); \
                        n0 = __builtin_amdgcn_mfma_f32_32x32x16_bf16(gf[0][1][0], sb10, n0, 0, 0, 0); n1 = __builtin_amdgcn_mfma_f32_32x32x16_bf16(gf[1][1][0], sb10, n1, 0, 0, 0); \
                        n0 = __builtin_amdgcn_mfma_f32_32x32x16_bf16(gf[0][1][1], sb11, n0, 0, 0, 0); n1 = __builtin_amdgcn_mfma_f32_32x32x16_bf16(gf[1][1][1], sb11, n1, 0, 0, 0); \
                        { unsigned char* _sp = (unsigned char*)DD + ((size_t)(_r0 + l32) * DM + colb + 32 * vh) * 4 + 8 * hl; \
                          *(u32x2*)(_sp + 0) = (u32x2){w00.x, w00.y}; *(u32x2*)(_sp + 16) = (u32x2){w00.z, w00.w}; *(u32x2*)(_sp + 32) = (u32x2){w01.x, w01.y}; *(u32x2*)(_sp + 48) = (u32x2){w01.z, w01.w}; \
                          *(u32x2*)(_sp + 64) = (u32x2){w10.x, w10.y}; *(u32x2*)(_sp + 80) = (u32x2){w10.z, w10.w}; *(u32x2*)(_sp + 96) = (u32x2){w11.x, w11.y}; *(u32x2*)(_sp + 112) = (u32x2){w11.z, w11.w}; } \
                        _Pragma("unroll") for (int i = 0; i < 16; ++i) { S0[i] = S0[i] * dt_[0][i >> 2][i & 3] + n0[i]; S1[i] = S1[i] * dt_[1][i >> 2][i & 3] + n1[i]; } \
                    } while (0)
                    if (prompt) {
                        LAS float* dtl = (LAS float*)((LAS unsigned char*)lds);
                        LAS unsigned char* ring = (LAS unsigned char*)lds + 32768;
                        for (int i = lane; i < 128 * 16; i += 64) *(LAS f32x4*)(dtl + i * 4) = *(const f32x4*)(DTg + ((size_t)(chunk0 + (i >> 4)) * 32 + h) * 64 + (i & 15) * 4);
#define S2_DMA(cc) do { const int _r0 = (chunk0 + (cc)) * 64; LAS unsigned char* _s = ring + ((cc) & 3) * 16384; \
                            _Pragma("unroll") for (int j = 0; j < 8; ++j) { const int _row = 8 * j + (lane >> 3); const int _p = (lane & 7) ^ (_row & 7); \
                                __builtin_amdgcn_global_load_lds((const unsigned*)(Kb + (size_t)(_r0 + _row) * DM + colb + _p * 8), (LAS unsigned*)(_s + j * 1024), 16, 0, 0); } \
                            _Pragma("unroll") for (int j = 0; j < 8; ++j) { const int _row = 8 * j + (lane >> 3); \
                                __builtin_amdgcn_global_load_lds((const unsigned*)(DD + (size_t)(_r0 + _row) * DM + colb + 32 * vh + (lane & 7) * 4), (LAS unsigned*)(_s + 8192 + j * 1024), 16, 0, 0); } \
                        } while (0)
                        S2_DMA(0); S2_DMA(1);
#pragma unroll 1
                        for (int c = 0; c < 128; ++c) {
                            if (c + 2 < 128) { S2_DMA(c + 2); asm volatile("s_waitcnt vmcnt(32)" ::: "memory"); }
                            else if (c + 1 < 128) asm volatile("s_waitcnt vmcnt(16)" ::: "memory");
                            else asm volatile("s_waitcnt vmcnt(0)" ::: "memory");
                            LAS unsigned char* sl = ring + (c & 3) * 16384;
#pragma unroll
                            for (int mt = 0; mt < 2; ++mt)
#pragma unroll
                                for (int kt = 0; kt < 2; ++kt)
#pragma unroll
                                    for (int s2 = 0; s2 < 2; ++s2) {
                                        const int row = 32 * mt + l32, p = 4 * kt + 2 * s2;
                                        const u32x2 lo = *(const LAS u32x2*)(sl + row * 128 + ((p ^ (row & 7)) * 16) + 8 * hl);
                                        const u32x2 hi = *(const LAS u32x2*)(sl + row * 128 + (((p + 1) ^ (row & 7)) * 16) + 8 * hl);
                                        gf[mt][kt][s2] = __builtin_bit_cast(bf16x8, (u32x4){lo.x, lo.y, hi.x, hi.y});
                                    }
#pragma unroll
                            for (int i = 0; i < 16; ++i) { n0[i] = *(const LAS float*)(sl + 8192 + crow(i, hl) * 128 + l32 * 4); n1[i] = *(const LAS float*)(sl + 8192 + (32 + crow(i, hl)) * 128 + l32 * 4); }
#pragma unroll
                            for (int mt = 0; mt < 2; ++mt)
#pragma unroll
                                for (int g = 0; g < 4; ++g) dt_[mt][g] = *(const LAS f32x4*)(dtl + c * 64 + 32 * mt + 8 * g + 4 * hl);
                            S2_COMPUTE(c);
                        }
#undef S2_DMA
                    } else {
                        const int _r0 = chunk0 * 64; const size_t _item = (size_t)chunk0 * 32 + h;
#pragma unroll
                        for (int mt = 0; mt < 2; ++mt)
#pragma unroll
                            for (int kt = 0; kt < 2; ++kt)
#pragma unroll
                                for (int s2 = 0; s2 < 2; ++s2) {
                                    const size_t _o = (size_t)(_r0 + 32 * mt + l32) * DM + colb + 32 * kt + 16 * s2 + 4 * hl;
                                    const u32x2 _lo = *(const u32x2*)(Kb + _o), _hi = *(const u32x2*)(Kb + _o + 8); gf[mt][kt][s2] = __builtin_bit_cast(bf16x8, (u32x4){_lo.x, _lo.y, _hi.x, _hi.y}); }
#pragma unroll
                        for (int i = 0; i < 16; ++i) { n0[i] = DD[(size_t)(_r0 + crow(i, hl)) * DM + vcol]; n1[i] = DD[(size_t)(_r0 + 32 + crow(i, hl)) * DM + vcol]; }
#pragma unroll
                        for (int mt = 0; mt < 2; ++mt)
#pragma unroll
                            for (int g = 0; g < 4; ++g) dt_[mt][g] = *(const f32x4*)(DTg + _item * 64 + 32 * mt + 8 * g + 4 * hl);
                        S2_COMPUTE(0);
                    }
#undef S2_COMPUTE
                    float* so_ = OUTP + (prompt ? O_PWKV + ((((size_t)jl * 2 + b) * 32 + h) * 64 + (32 * vh + l32)) * 64
                                                : O_SWKV + ((((size_t)jl * 16 + b) * 32 + h) * 64 + (32 * vh + l32)) * 64);
#pragma unroll
                    for (int i = 0; i < 16; ++i) { so_[crow(i, hl)] = S0[i]; so_[32 + crow(i, hl)] = S1[i]; }
                }
            }
            fast_grid_barrier((unsigned*)ldp(tab, 40), tab);
            {
                PHASE_IDS BASES RWKV_PTRS
                const float* Obuf = (const float*)(RA + 272 * MiB); const float* RK = (const float*)(RB + 204 * MiB);
                const float* lnw = IN(28) + (size_t)jl * DM; const float* lnb = IN(29) + (size_t)jl * DM;
                const int l32 = lane & 31, hl = lane >> 5;
#pragma unroll 1
                for (int item = blockIdx.x; item < 8704; item += G) {
                    LAS unsigned char* ldsv = (LAS unsigned char*)lds; asm volatile("" : "+v"(ldsv));
                    LAS bf16_t* R2s = (LAS bf16_t*)(ldsv + 0); LAS bf16_t* STs = (LAS bf16_t*)(ldsv + 9216); LAS float* Os = (LAS float*)(ldsv + 18432);
                    const int chunk = item >> 5, h = item & 31, r0 = chunk * 64;
                    {
                        const int rr = tid >> 3, pc = tid & 7;
                        *(LAS u32x4*)(R2s + rr * 72 + pc * 8) = *(const u32x4*)(Rb + (size_t)(r0 + rr) * DM + h * 64 + pc * 8);
                        const unsigned char* sp = (const unsigned char*)DD + ((size_t)(r0 + (rr & 31)) * DM + h * 64 + 32 * (rr >> 5)) * 4 + pc * 16;
                        *(LAS u32x4*)(STs + rr * 72 + pc * 8) = *(const u32x4*)sp;
                    }
                    __syncthreads();
                    if (wave < 4) {
                        const int tt = wave >> 1, vt = wave & 1;
                        f32x16 acc;
#pragma unroll
                        for (int i = 0; i < 16; ++i) acc[i] = Obuf[(size_t)(r0 + 32 * tt + crow(i, hl)) * DM + h * 64 + 32 * vt + l32];
#pragma unroll
                        for (int ks = 0; ks < 4; ++ks) acc = __builtin_amdgcn_mfma_f32_32x32x16_bf16(*(const LAS bf16x8*)(R2s + (32 * tt + l32) * 72 + ks * 16 + hl * 8), *(const LAS bf16x8*)(STs + (32 * vt + l32) * 72 + ks * 16 + hl * 8), acc, 0, 0, 0);
#pragma unroll
                        for (int i = 0; i < 16; ++i) Os[(32 * tt + crow(i, hl)) * 68 + 32 * vt + l32] = acc[i];
                    }
                    __syncthreads();
                    {
                        const int st = tid >> 3, c0 = (tid & 7) * 8, col = h * 64 + c0; const size_t off = (size_t)(r0 + st) * DM + col;
                        const f32x4 o0 = *(const LAS f32x4*)(Os + st * 68 + c0), o1 = *(const LAS f32x4*)(Os + st * 68 + c0 + 4);
                        float o[8] = {o0[0], o0[1], o0[2], o0[3], o1[0], o1[1], o1[2], o1[3]};
                        float s = 0.f;
#pragma unroll
                        for (int i = 0; i < 8; ++i) s += o[i];
                        const float mu = sum8(s, lane) * (1.f / 64.f); float q = 0.f;
#pragma unroll
                        for (int i = 0; i < 8; ++i) { o[i] -= mu; q += o[i] * o[i]; }
                        const float rstd = rsqrtf(sum8(q, lane) * (1.f / 64.f) + 64e-5f);
                        float v[8], g8[8]; unpack8(*(const u32x4*)(Vb + off), v); unpack8(*(const u32x4*)(GG + off), g8);
                        if (jl > 0) { float vf[8], vg[8]; unpack8(*(const u32x4*)(VFIRST + off), vf); unpack8(*(const u32x4*)(VG + off), vg);
#pragma unroll
                            for (int i = 0; i < 8; ++i) v[i] = v[i] + (vf[i] - v[i]) * vg[i]; }
                        const float rk = RK[(size_t)(r0 + st) * 32 + h];
                        float y[8];
#pragma unroll
                        for (int i = 0; i < 8; ++i) y[i] = (o[i] * rstd * lnw[col + i] + lnb[col + i] + rk * v[i]) * g8[i];
                        *(u32x4*)(Y + off) = pack8(y);
                    }
                    __syncthreads();
                }
            }
            fast_grid_barrier((unsigned*)ldp(tab, 40), tab);
            {
                BASES RWKV_PTRS
                pg8::Gemm g{Y, WO, MROWS, 2048, 2048, 0, 0};
                pg8::StaticOrder S; S.init(g.M, g.N, G, (int)blockIdx.x, g.K, 4);
                pg8::Epi<FRes> E{FRes{X, (float*)(RA + 272 * MiB)}};
                pg8::gemm_phase(ldsl, g, S, E);
                fast_grid_barrier((unsigned*)ldp(tab, 40), tab);
                {
                    PHASE_IDS
                    const float* PART = (const float*)(RA + 272 * MiB); const int ntail = S.nwg - S.nFull;
                    if (S.S > 1) for (int idx = gtid; idx < ntail * 16384; idx += NT) {
                        const int tl = idx >> 14, r = (idx >> 6) & 255, c4 = idx & 63; int pm, pn; S.tile_pmpn(S.nFull + tl, pm, pn);
                        f32x4* xp = (f32x4*)(X + (size_t)(pm * 256 + r) * DM + pn * 256 + c4 * 4); f32x4 acc = *xp;
#pragma unroll
                        for (int part = 0; part < 4; ++part) acc += *(const f32x4*)(PART + (size_t)(part * 32 + tl) * 65536 + r * 256 + c4 * 4);
                        *xp = acc; }
                }
            }
            fast_grid_barrier((unsigned*)ldp(tab, 40), tab);
        } else {
            { PHASE_IDS BASES GLA_PTRS
            const float* gmix = IN(6) + (size_t)layer * DM;
            for (int row = gw; row < MROWS; row += NGW) {
                const f32x4* xr = (const f32x4*)(X + (size_t)row * DM) + lane; f32x4 x[8]; float ss = 0.f;
#pragma unroll
                for (int q = 0; q < 8; ++q) { x[q] = xr[64 * q]; ss += x[q][0] * x[q][0] + x[q][1] * x[q][1] + x[q][2] * x[q][2] + x[q][3] * x[q][3]; }
                const float rs = rsqrtf(wave_sum(ss, lane) * (1.f / DM) + 1e-6f);
#pragma unroll
                for (int q = 0; q < 8; ++q) { const f32x4 gg = *((const f32x4*)gmix + lane + 64 * q); const f32x4 h = x[q] * rs * gg;
                    u32x2 w; w.x = cvt_pk_bf16(h[0], h[1]); w.y = cvt_pk_bf16(h[2], h[3]); *((u32x2*)(H + (size_t)row * DM) + lane + 64 * q) = w; }
            } }
            fast_grid_barrier((unsigned*)ldp(tab, 40), tab);
            {
                BASES GLA_PTRS
                pg8::Gemm g{H, GI, MROWS, 6400, 2048, 0, 0};
                pg8::StaticOrder S; S.init(g.M, g.N, G, (int)blockIdx.x, g.K, 1);
                pg8::Epi<FG1> E{FG1{PROJ, LR}};
                pg8::gemm_phase(ldsl, g, S, E);
            }
            fast_grid_barrier((unsigned*)ldp(tab, 40), tab);
            {
                PHASE_IDS BASES GLA_PTRS
                float* lrS = (float*)lds;
                float* w2S = (float*)(lds + 4096);
                float* totS = (float*)(lds + 20480);
                bf16_t* qeS = (bf16_t*)(lds + 22528);
                bf16_t* keS = (bf16_t*)(lds + 22528 + 33792);
                bf16_t* vS = qeS;
                const float* gw2 = IN(31) + (size_t)jl * 16 * 1024; const float* gkb = IN(32) + (size_t)jl * 1024;
#pragma unroll 1
                for (int it = blockIdx.x; it < 1088; it += G) {
                    const int c = it >> 2, h = it & 3, r0 = c * 64; const size_t base = (size_t)it;
                    if (tid < 256) *(f32x4*)(lrS + tid * 4) = *(const f32x4*)(LR + (size_t)r0 * 16 + tid * 4);
                    for (int q = tid; q < 1024; q += 512) { const int r = q >> 6, cc = (q & 63) * 4; *(f32x4*)(w2S + r * 256 + cc) = *(const f32x4*)(gw2 + (size_t)r * 1024 + h * 256 + cc); }
                    __syncthreads();
                    const int d = tid & 255, half = tid >> 8;
                    float cumv[32];
                    {
                        float w[16];
#pragma unroll
                        for (int r = 0; r < 16; ++r) w[r] = w2S[r * 256 + d];
                        const float bb = gkb[h * 256 + d]; float run = 0.f;
#pragma unroll
                        for (int tt = 0; tt < 32; ++tt) {
                            const float* lp = lrS + (half * 32 + tt) * 16; float z = bb;
#pragma unroll
                            for (int r = 0; r < 16; ++r) z += lp[r] * w[r];
                            const float g = (fminf(z, 0.f) - log1pf(__expf(-fabsf(z)))) * 0.0625f;
                            run += g; cumv[tt] = run;
                        }
                        totS[half * 256 + d] = run;
                    }
                    __syncthreads();
                    {
                        const float t0 = totS[d], t1 = totS[256 + d]; const float last = t0 + t1, offc = half ? t0 : 0.f;
                        if (half == 0) EL[base * 256 + d] = __expf(last);
                        unsigned kdp[16];
#pragma unroll
                        for (int tt = 0; tt < 32; tt += 2) {
                            float kd2[2];
#pragma unroll
                            for (int e = 0; e < 2; ++e) {
                                const int t = half * 32 + tt + e; const float cum = cumv[tt + e] + offc;
                                const size_t po = (size_t)(r0 + t) * 6144 + h * 256 + d;
                                const float q = bf2f(PROJ[po]), k = bf2f(PROJ[po + 1024]);
                                const float qe = q * __expf(cum), ke = k * __expf(-cum); kd2[e] = k * __expf(last - cum);
                                const unsigned pq = cvt_pk_bf16(qe, ke);
                                qeS[t * 264 + d] = (bf16_t)(pq & 0xffffu); keS[t * 264 + d] = (bf16_t)(pq >> 16);
                                QE[((base * 8 + (d >> 5)) * 64 + t) * 32 + (d & 31)] = (bf16_t)(pq & 0xffffu);
                            }
                            kdp[tt >> 1] = cvt_pk_bf16(kd2[0], kd2[1]);
                        }
                        u32x4* kdst = (u32x4*)(KDT + (base * 256 + d) * 64 + half * 32);
                        kdst[0] = (u32x4){kdp[0], kdp[1], kdp[2], kdp[3]}; kdst[1] = (u32x4){kdp[4], kdp[5], kdp[6], kdp[7]};
                        kdst[2] = (u32x4){kdp[8], kdp[9], kdp[10], kdp[11]}; kdst[3] = (u32x4){kdp[12], kdp[13], kdp[14], kdp[15]};
                    }
                    __syncthreads();
                    if (wave < 4) {
                        const int mi = wave >> 1, ni = wave & 1, l32 = lane & 31, hl = lane >> 5;
                        f32x16 cacc;
#pragma unroll
                        for (int i = 0; i < 16; ++i) cacc[i] = 0.f;
#pragma unroll
                        for (int kk = 0; kk < 16; ++kk) {
                            const bf16x8 a = *(const bf16x8*)(qeS + (mi * 32 + l32) * 264 + kk * 16 + hl * 8);
                            const bf16x8 b = *(const bf16x8*)(keS + (ni * 32 + l32) * 264 + kk * 16 + hl * 8);
                            cacc = __builtin_amdgcn_mfma_f32_32x32x16_bf16(a, b, cacc, 0, 0, 0);
                        }
#pragma unroll
                        for (int i = 0; i < 16; ++i) { const int ii = mi * 32 + crow(i, hl), jj = ni * 32 + l32;
                            const float v = (jj <= ii) ? cacc[i] : 0.f; SC[base * 4096 + ii * 64 + jj] = (bf16_t)(cvt_pk_bf16(v, 0.f) & 0xffffu); }
                    }
                    __syncthreads();
                    for (int q = tid; q < 4096; q += 512) { const int t = q >> 6, cc = (q & 63) * 8;
                        *(u32x4*)(vS + t * 520 + cc) = *(const u32x4*)(PROJ + (size_t)(r0 + t) * 6144 + 2048 + h * 512 + cc); }
                    __syncthreads();
                    {
                        const int dv = tid; u32x4* vdst = (u32x4*)(VT + (base * 512 + dv) * 64);
#pragma unroll
                        for (int q = 0; q < 8; ++q) {
                            unsigned w[4];
#pragma unroll
                            for (int e = 0; e < 4; ++e) { const unsigned lo = vS[(q * 8 + 2 * e) * 520 + dv], hi = vS[(q * 8 + 2 * e + 1) * 520 + dv]; w[e] = lo | (hi << 16); }
                            vdst[q] = (u32x4){w[0], w[1], w[2], w[3]};
                        }
                    }
                    __syncthreads();
                }
            }
            fast_grid_barrier((unsigned*)ldp(tab, 40), tab);
            {
                PHASE_IDS BASES GLA_PTRS
                float* red = (float*)lds;
                const int l32 = lane & 31, hl = lane >> 5;
#pragma unroll 1
                for (int u = blockIdx.x; u < 1152; u += G) {
                    const bool prompt = u < 128; int b, h, s, cg0, nch, row0;
                    if (prompt) { b = u >> 6; h = (u >> 4) & 3; s = u & 15; cg0 = b * 128; nch = 128; row0 = b * 8192; }
                    else { const int su = u - 128; b = su >> 6; h = (su >> 4) & 3; s = su & 15; cg0 = 256 + b; nch = 1; row0 = MPROMPT + b * 64; }
                    f32x16 S;
                    if (prompt) {
#pragma unroll
                        for (int i = 0; i < 16; ++i) S[i] = 0.f;
                    } else {
                        const float* s0 = IN(4) + ((((size_t)jl * 16 + b) * 4 + h) * 256) * 512;
#pragma unroll
                        for (int i = 0; i < 16; ++i) S[i] = s0[(size_t)(32 * wave + crow(i, hl)) * 512 + 32 * s + l32];
                    }
                    const int mtw = wave & 1, ksw = wave >> 1;
                    bf16x8 ka[4], vb[4], qf[2][2], scf; f32x4 el[4];
#define GL_LD_Q(cc) do { const size_t _base = (size_t)(cg0 + (cc)) * 4 + h; const int _r0 = row0 + (cc) * 64; const bf16_t* _sc = SC + _base * 4096; \
                        _Pragma("unroll") for (int mt = 0; mt < 2; ++mt) _Pragma("unroll") for (int s2 = 0; s2 < 2; ++s2) { const bf16_t* _pq = QE + ((_base * 8 + wave) * 64 + mt * 32 + l32) * 32 + 16 * s2 + 4 * hl; \
                            const u32x2 _lo = *(const u32x2*)_pq, _hi = *(const u32x2*)(_pq + 8); qf[mt][s2] = __builtin_bit_cast(bf16x8, (u32x4){_lo.x, _lo.y, _hi.x, _hi.y}); } \
                        scf = *(const bf16x8*)(_sc + (mtw * 32 + l32) * 64 + 16 * ksw + 8 * hl); } while (0)
#define GL_LD_E(cc) do { const size_t _base = (size_t)(cg0 + (cc)) * 4 + h; \
                        _Pragma("unroll") for (int g = 0; g < 4; ++g) el[g] = *(const f32x4*)(EL + _base * 256 + 32 * wave + 8 * g + 4 * hl); } while (0)
#define GL_LD_K(cc) do { const size_t _base = (size_t)(cg0 + (cc)) * 4 + h; const bf16_t* _kdt = KDT + _base * 256 * 64; const bf16_t* _vt = VT + _base * 512 * 64; \
                        _Pragma("unroll") for (int ks = 0; ks < 4; ++ks) { ka[ks] = *(const bf16x8*)(_kdt + (32 * wave + l32) * 64 + 16 * ks + 8 * hl); vb[ks] = *(const bf16x8*)(_vt + (32 * s + l32) * 64 + 16 * ks + 8 * hl); } } while (0)
                    GL_LD_Q(0); GL_LD_E(0); GL_LD_K(0);
#pragma unroll 1
                    for (int c = 0; c < nch; ++c) {
                        const int r0 = row0 + c * 64; const int cn = (c + 1 < nch) ? c + 1 : c;
                        u32x4 sp0, sp1;
                        sp0.x = cvt_pk_bf16(S[0], S[1]); sp0.y = cvt_pk_bf16(S[2], S[3]); sp0.z = cvt_pk_bf16(S[4], S[5]); sp0.w = cvt_pk_bf16(S[6], S[7]);
                        sp1.x = cvt_pk_bf16(S[8], S[9]); sp1.y = cvt_pk_bf16(S[10], S[11]); sp1.z = cvt_pk_bf16(S[12], S[13]); sp1.w = cvt_pk_bf16(S[14], S[15]);
                        const bf16x8 sb0 = __builtin_bit_cast(bf16x8, sp0), sb1 = __builtin_bit_cast(bf16x8, sp1);
                        const bf16x8 vbw = ksw == 0 ? vb[0] : ksw == 1 ? vb[1] : ksw == 2 ? vb[2] : vb[3];
#pragma unroll
                        for (int mt = 0; mt < 2; ++mt) { f32x16 oo;
#pragma unroll
                            for (int i = 0; i < 16; ++i) oo[i] = 0.f;
                            oo = __builtin_amdgcn_mfma_f32_32x32x16_bf16(qf[mt][0], sb0, oo, 0, 0, 0); oo = __builtin_amdgcn_mfma_f32_32x32x16_bf16(qf[mt][1], sb1, oo, 0, 0, 0);
                            if (mtw == mt) oo = __builtin_amdgcn_mfma_f32_32x32x16_bf16(scf, vbw, oo, 0, 0, 0);
#pragma unroll
                            for (int q = 0; q < 16; ++q) red[(wave * 32 + mt * 16 + q) * 64 + lane] = oo[q]; }
                        GL_LD_Q(cn);
#pragma unroll
                        for (int i = 0; i < 16; ++i) S[i] *= el[i >> 2][i & 3];
                        GL_LD_E(cn);
#pragma unroll
                        for (int ks = 0; ks < 4; ++ks) S = __builtin_amdgcn_mfma_f32_32x32x16_bf16(ka[ks], vb[ks], S, 0, 0, 0);
                        GL_LD_K(cn);
                        asm volatile("s_waitcnt lgkmcnt(0)" ::: "memory"); __builtin_amdgcn_s_barrier(); asm volatile("" ::: "memory");
                        { const int q = tid >> 4, lg = tid & 15; f32x4 sum = (f32x4){0.f, 0.f, 0.f, 0.f};
#pragma unroll
                          for (int w = 0; w < 8; ++w) sum += *(const f32x4*)(red + (w * 32 + q) * 64 + 4 * lg);
                          const int mt = q >> 4, reg = q & 15, L = 4 * lg; const int i = mt * 32 + crow(reg, L >> 5), dv = L & 31;
                          *(f32x4*)(O + (size_t)(r0 + i) * DM + h * 512 + 32 * s + dv) = sum; }
                        asm volatile("s_waitcnt lgkmcnt(0)" ::: "memory"); __builtin_amdgcn_s_barrier(); asm volatile("" ::: "memory");
                    }
#undef GL_LD_Q
#undef GL_LD_E
#undef GL_LD_K
                    float* dst = OUTP + (prompt ? O_PGLA + ((((size_t)jl * 2 + b) * 4 + h) * 256) * 512 : O_SGLA + ((((size_t)jl * 16 + b) * 4 + h) * 256) * 512);
#pragma unroll
                    for (int i = 0; i < 16; ++i) dst[(size_t)(32 * wave + crow(i, hl)) * 512 + 32 * s + l32] = S[i];
                }
            }
            fast_grid_barrier((unsigned*)ldp(tab, 40), tab);
            {
                PHASE_IDS BASES GLA_PTRS
                const float* hn = IN(33) + (size_t)jl * 512;
                for (int row = gw; row < MROWS; row += NGW) {
#pragma unroll
                    for (int h = 0; h < 4; ++h) {
                        const float* op = O + (size_t)row * DM + h * 512 + lane * 8;
                        const f32x4 a = *(const f32x4*)op, b = *(const f32x4*)(op + 4);
                        float ss = a[0] * a[0] + a[1] * a[1] + a[2] * a[2] + a[3] * a[3] + b[0] * b[0] + b[1] * b[1] + b[2] * b[2] + b[3] * b[3];
                        const float rs = rsqrtf(wave_sum(ss, lane) * (1.f / 512.f) + 1e-5f);
                        float gt[8]; unpack8(*(const u32x4*)(PROJ + (size_t)row * 6144 + 4096 + h * 512 + lane * 8), gt);
                        const f32x4 n0 = *(const f32x4*)(hn + lane * 8), n1 = *(const f32x4*)(hn + lane * 8 + 4);
                        float y[8];
#pragma unroll
                        for (int i = 0; i < 4; ++i) { y[i] = a[i] * rs * n0[i] * (gt[i] * sigmoidf_(gt[i])); y[4 + i] = b[i] * rs * n1[i] * (gt[4 + i] * sigmoidf_(gt[4 + i])); }
                        *(u32x4*)(Y + (size_t)row * DM + h * 512 + lane * 8) = pack8(y);
                    }
                }
            }
            fast_grid_barrier((unsigned*)ldp(tab, 40), tab);
            {
                BASES GLA_PTRS
                pg8::Gemm g{Y, GO, MROWS, 2048, 2048, 0, 0};
                pg8::StaticOrder S; S.init(g.M, g.N, G, (int)blockIdx.x, g.K, 4);
                pg8::Epi<FRes> E{FRes{X, (float*)(RA + 272 * MiB)}};
                pg8::gemm_phase(ldsl, g, S, E);
                fast_grid_barrier((unsigned*)ldp(tab, 40), tab);
                {
                    PHASE_IDS
                    const float* PART = (const float*)(RA + 272 * MiB); const int ntail = S.nwg - S.nFull;
                    if (S.S > 1) for (int idx = gtid; idx < ntail * 16384; idx += NT) {
                        const int tl = idx >> 14, r = (idx >> 6) & 255, c4 = idx & 63; int pm, pn; S.tile_pmpn(S.nFull + tl, pm, pn);
                        f32x4* xp = (f32x4*)(X + (size_t)(pm * 256 + r) * DM + pn * 256 + c4 * 4); f32x4 acc = *xp;
#pragma unroll
                        for (int part = 0; part < 4; ++part) acc += *(const f32x4*)(PART + (size_t)(part * 32 + tl) * 65536 + r * 256 + c4 * 4);
                        *xp = acc; }
                }
            }
            fast_grid_barrier((unsigned*)ldp(tab, 40), tab);
        }
        {
            { PHASE_IDS BASES FFN_PTRS
            const float* gf = IN(7) + (size_t)layer * DM;
            for (int row = gw; row < MROWS; row += NGW) {
                const f32x4* xr = (const f32x4*)(X + (size_t)row * DM) + lane; f32x4 x[8]; float ss = 0.f;
#pragma unroll
                for (int q = 0; q < 8; ++q) { x[q] = xr[64 * q]; ss += x[q][0] * x[q][0] + x[q][1] * x[q][1] + x[q][2] * x[q][2] + x[q][3] * x[q][3]; }
                const float rs = rsqrtf(wave_sum(ss, lane) * (1.f / DM) + 1e-6f);
#pragma unroll
                for (int q = 0; q < 8; ++q) { const f32x4 gg = *((const f32x4*)gf + lane + 64 * q); const f32x4 h = x[q] * rs * gg;
                    u32x2 w; w.x = cvt_pk_bf16(h[0], h[1]); w.y = cvt_pk_bf16(h[2], h[3]); *((u32x2*)(H + (size_t)row * DM) + lane + 64 * q) = w; }
            } }
            fast_grid_barrier((unsigned*)ldp(tab, 40), tab);
            {
                BASES FFN_PTRS
                pg8::Gemm g{H, WU, MROWS, F2, 2048, 0, 0};
                pg8::StaticOrder S; S.init(g.M, g.N, G, (int)blockIdx.x, g.K, 1);
                pg8::Epi<FUp> E{FUp{U, OUTP + O_PCONV + (size_t)layer * 2 * 2 * F2, OUTP + O_SCONV + (size_t)layer * 16 * 2 * F2}};
                pg8::gemm_phase(ldsl, g, S, E);
            }
            fast_grid_barrier((unsigned*)ldp(tab, 40), tab);
            {
                PHASE_IDS BASES FFN_PTRS
                const float* cw = IN(36) + (size_t)layer * 3 * F2; const float* cb = IN(37) + (size_t)layer * F2;
                const float* cst = IN(5) + (size_t)layer * 16 * 2 * F2;
#pragma unroll 1
                for (int it = gtid; it < 544 * 704; it += NT) {
                    const int rc = it / 704, c8 = it - rc * 704, col = c8 * 8, r0 = rc * 32;
                    int t0, len, b; bool prompt; row_info(r0, t0, len, b, prompt);
                    float wv[3][8], wg[3][8], bv[8], bg[8];
#pragma unroll
                    for (int k = 0; k < 3; ++k) { const f32x4 a = *(const f32x4*)(cw + (size_t)k * F2 + col), a2 = *(const f32x4*)(cw + (size_t)k * F2 + col + 4);
                        const f32x4 g = *(const f32x4*)(cw + (size_t)k * F2 + FH + col), g2 = *(const f32x4*)(cw + (size_t)k * F2 + FH + col + 4);
#pragma unroll
                        for (int i = 0; i < 4; ++i) { wv[k][i] = a[i]; wv[k][4 + i] = a2[i]; wg[k][i] = g[i]; wg[k][4 + i] = g2[i]; } }
                    { const f32x4 a = *(const f32x4*)(cb + col), a2 = *(const f32x4*)(cb + col + 4), g = *(const f32x4*)(cb + FH + col), g2 = *(const f32x4*)(cb + FH + col + 4);
#pragma unroll
                      for (int i = 0; i < 4; ++i) { bv[i] = a[i]; bv[4 + i] = a2[i]; bg[i] = g[i]; bg[4 + i] = g2[i]; } }
                    float v2[8], v1[8], g2_[8], g1_[8];
                    if (t0 > 0) {
                        unpack8(*(const u32x4*)(U + (size_t)(r0 - 2) * F2 + col), v2); unpack8(*(const u32x4*)(U + (size_t)(r0 - 1) * F2 + col), v1);
                        unpack8(*(const u32x4*)(U + (size_t)(r0 - 2) * F2 + FH + col), g2_); unpack8(*(const u32x4*)(U + (size_t)(r0 - 1) * F2 + FH + col), g1_);
                    } else if (!prompt) {
                        const float* s0 = cst + ((size_t)b * 2) * F2 + col; const float* s1 = s0 + F2;
#pragma unroll
                        for (int i = 0; i < 8; ++i) { v2[i] = s0[i]; v1[i] = s1[i]; g2_[i] = s0[FH + i]; g1_[i] = s1[FH + i]; }
                    } else {
#pragma unroll
                        for (int i = 0; i < 8; ++i) { v2[i] = 0.f; v1[i] = 0.f; g2_[i] = 0.f; g1_[i] = 0.f; }
                    }
#pragma unroll 1
                    for (int rb = 0; rb < 32; rb += 8) {
                      u32x4 uv_[8], ug_[8];
#pragma unroll
                      for (int j = 0; j < 8; ++j) { uv_[j] = *(const u32x4*)(U + (size_t)(r0 + rb + j) * F2 + col); ug_[j] = *(const u32x4*)(U + (size_t)(r0 + rb + j) * F2 + FH + col); }
#pragma unroll
                      for (int j = 0; j < 8; ++j) {
                        const int r = rb + j;
                        float v0[8], g0[8];
                        unpack8(uv_[j], v0); unpack8(ug_[j], g0);
                        float y[8];
#pragma unroll
                        for (int i = 0; i < 8; ++i) {
                            const float cv = bv[i] + wv[0][i] * v2[i] + wv[1][i] * v1[i] + wv[2][i] * v0[i];
                            const float cg_ = bg[i] + wg[0][i] * g2_[i] + wg[1][i] * g1_[i] + wg[2][i] * g0[i];
                            y[i] = cg_ * sigmoidf_(cg_) * cv;
                            v2[i] = v1[i]; v1[i] = v0[i]; g2_[i] = g1_[i]; g1_[i] = g0[i];
                        }
                        *(u32x4*)(HID + (size_t)(r0 + r) * FH + col) = pack8(y);
                      }
                    }
                }
            }
            fast_grid_barrier((unsigned*)ldp(tab, 40), tab);
            {
                BASES FFN_PTRS
                pg8::Gemm g{HID, WD, MROWS, 2048, FH, 0, 0};
                pg8::StaticOrder S; S.init(g.M, g.N, G, (int)blockIdx.x, g.K, 4);
                pg8::Epi<FRes> E{FRes{X, (float*)(RA + 272 * MiB)}};
                pg8::gemm_phase(ldsl, g, S, E);
                fast_grid_barrier((unsigned*)ldp(tab, 40), tab);
                {
                    PHASE_IDS
                    const float* PART = (const float*)(RA + 272 * MiB); const int ntail = S.nwg - S.nFull;
                    if (S.S > 1) for (int idx = gtid; idx < ntail * 16384; idx += NT) {
                        const int tl = idx >> 14, r = (idx >> 6) & 255, c4 = idx & 63; int pm, pn; S.tile_pmpn(S.nFull + tl, pm, pn);
                        f32x4* xp = (f32x4*)(X + (size_t)(pm * 256 + r) * DM + pn * 256 + c4 * 4); f32x4 acc = *xp;
#pragma unroll
                        for (int part = 0; part < 4; ++part) acc += *(const f32x4*)(PART + (size_t)(part * 32 + tl) * 65536 + r * 256 + c4 * 4);
                        *xp = acc; }
                }
            }
            fast_grid_barrier((unsigned*)ldp(tab, 40), tab);
        }
    }
    {
        PHASE_IDS BASES
        const float* gn = IN(8);
        for (int row = gw; row < MROWS; row += NGW) {
            f32x4* xr = (f32x4*)(X + (size_t)row * DM) + lane; f32x4 x[8]; float ss = 0.f;
#pragma unroll
            for (int q = 0; q < 8; ++q) { x[q] = xr[64 * q]; ss += x[q][0] * x[q][0] + x[q][1] * x[q][1] + x[q][2] * x[q][2] + x[q][3] * x[q][3]; }
            const float rs = rsqrtf(wave_sum(ss, lane) * (1.f / DM) + 1e-6f);
#pragma unroll
            for (int q = 0; q < 8; ++q) { const f32x4 gg = *((const f32x4*)gn + lane + 64 * q); xr[64 * q] = x[q] * rs * gg; }
        }
    }
}

extern "C" void kernel_launch(void* const* d_in, const int* in_sizes, int n_in, void* d_out, int out_size, void* d_ws, size_t ws_size, hipStream_t stream) {
    static int grid = 0;
    if (grid == 0) {
        if (n_in != 39 || (size_t)out_size != O_TOTAL || ws_size < WS_END) {
            fprintf(stderr, "kernel_launch: unexpected shapes: n_in %d out %d ws %zu (need %zu)\n", n_in, out_size, ws_size, (size_t)WS_END); grid = -1; return; }
        int dev = 0, cus = 0, per_cu = 0;
        (void)hipGetDevice(&dev);
        (void)hipDeviceGetAttribute(&cus, hipDeviceAttributeMultiprocessorCount, dev);
        if (hipFuncSetAttribute((const void*)fwd_kernel, hipFuncAttributeMaxDynamicSharedMemorySize, LDS_BYTES) != hipSuccess) { fprintf(stderr, "kernel_launch: hipFuncSetAttribute failed\n"); grid = -1; return; }
        if (hipOccupancyMaxActiveBlocksPerMultiprocessor(&per_cu, (const void*)fwd_kernel, 512, LDS_BYTES) != hipSuccess || per_cu < 1) { fprintf(stderr, "kernel_launch: occupancy query says %d\n", per_cu); per_cu = 1; }
        (void)hipGetLastError();
        grid = cus * 1;
        if (grid <= 0) grid = 256;
    }
    if (grid < 0) return;
    P prm{};
    for (int i = 0; i < 39; ++i) prm.in[i] = (const float*)d_in[i];
    prm.out = (float*)d_out; prm.ws = (unsigned char*)d_ws;
    (void)hipMemsetAsync(d_ws, 0, 4096, stream);
    void* args[] = {&prm};
    hipError_t e = hipLaunchCooperativeKernel((const void*)fwd_kernel, dim3(grid), dim3(512), args, LDS_BYTES, stream);
    if (e != hipSuccess) fprintf(stderr, "cooperative launch failed: %s (grid %d)\n", hipGetErrorString(e), grid);
}
```

```cpp
#include <hip/hip_runtime.h>
#include <hip/hip_cooperative_groups.h>
#include <cstdio>
#include <cstdint>
namespace cg = cooperative_groups;

#define LAS __attribute__((address_space(3)))
typedef unsigned short bf16_t;
typedef short bf16x8 __attribute__((ext_vector_type(8)));
typedef float f32x4 __attribute__((ext_vector_type(4)));
typedef float f32x16 __attribute__((ext_vector_type(16)));
typedef unsigned u32x4 __attribute__((ext_vector_type(4)));
typedef unsigned u32x2 __attribute__((ext_vector_type(2)));

constexpr int DM = 2048, MROWS = 17408, MPROMPT = 16384;
constexpr int FH = 5632, F2 = 11264;
constexpr int LDS_BYTES = 147456;
constexpr size_t MiB = 1u << 20;
constexpr size_t WS_WT = 1 * MiB;
constexpr size_t WS_A = 411 * MiB;
constexpr size_t WS_B = 819 * MiB;
constexpr size_t WS_VF = 1227 * MiB;
constexpr size_t WS_END = 1295 * MiB;
constexpr size_t ACT = (size_t)MROWS * DM;
constexpr size_t RW_SZ = (size_t)7168 * 2048 + (size_t)8192 * 256 + (size_t)2048 * 2048;
constexpr size_t GW_SZ = (size_t)6400 * 2048 + (size_t)2048 * 2048;
constexpr size_t FW_SZ = (size_t)11264 * 2048 + (size_t)2048 * 5632;
constexpr size_t GW_OFF = 2 * RW_SZ, FW_OFF = GW_OFF + 2 * GW_SZ;
constexpr size_t O_PSHIFT = 35651584, O_PWKV = 35659776, O_PGLA = 36184064, O_PCONV = 38281216;
constexpr size_t O_SSHIFT = 38461440, O_SWKV = 38526976, O_SGLA = 42721280, O_SCONV = 59498496, O_TOTAL = 60940288;

__device__ __forceinline__ unsigned cvt_pk_bf16(float lo, float hi) { unsigned r; asm volatile("v_cvt_pk_bf16_f32 %0, %1, %2" : "=v"(r) : "v"(lo), "v"(hi)); return r; }
__device__ __forceinline__ float bf2f(bf16_t b) { return __builtin_bit_cast(float, (unsigned)b << 16); }
__device__ __forceinline__ float bflo(unsigned u) { return __builtin_bit_cast(float, u << 16); }
__device__ __forceinline__ float bfhi(unsigned u) { return __builtin_bit_cast(float, u & 0xffff0000u); }
__device__ __forceinline__ void unpack8(u32x4 w, float (&f)[8]) {
    f[0] = bflo(w.x); f[1] = bfhi(w.x); f[2] = bflo(w.y); f[3] = bfhi(w.y); f[4] = bflo(w.z); f[5] = bfhi(w.z); f[6] = bflo(w.w); f[7] = bfhi(w.w);
}
__device__ __forceinline__ u32x4 pack8(const float (&f)[8]) {
    u32x4 w; w.x = cvt_pk_bf16(f[0], f[1]); w.y = cvt_pk_bf16(f[2], f[3]); w.z = cvt_pk_bf16(f[4], f[5]); w.w = cvt_pk_bf16(f[6], f[7]); return w;
}
__device__ __forceinline__ float sigmoidf_(float x) { return 1.f / (1.f + __expf(-x)); }
__device__ __forceinline__ float shx(float v, int lane, int o) { return __builtin_bit_cast(float, __builtin_amdgcn_ds_bpermute((lane ^ o) << 2, __builtin_bit_cast(int, v))); }
__device__ __forceinline__ float wave_sum(float v, int lane) {
#pragma unroll
    for (int o = 1; o < 64; o <<= 1) v += shx(v, lane, o);
    return v;
}
__device__ __forceinline__ float sum8(float v, int lane) { v += shx(v, lane, 1); v += shx(v, lane, 2); v += shx(v, lane, 4); return v; }
__device__ __forceinline__ int crow(int reg, int h) { return (reg & 3) + 8 * (reg >> 2) + 4 * h; }

namespace pg8 {
constexpr int BM = 256, BK = 64, HALF = 128, HTB = HALF * BK * 2, STAGE_BYTES = 8 * HTB, NXCD = 8, WGM = 8;
__host__ __device__ __forceinline__ int lds_byte(int r, int c) { const int st = (r >> 4) * 2 + (c >> 5), rr = r & 15, cc = c & 31, ob = rr * 64 + cc * 2; return st * 1024 + (ob ^ (((ob >> 9) & 1) << 5)); }
__host__ __device__ __forceinline__ void stage_rc(int b, int& R, int& C) { const int st = b / 1024, sb = b % 1024, swz = sb ^ (((sb >> 9) & 1) << 5); R = (st >> 1) * 16 + swz / 64; C = (st & 1) * 32 + (swz % 64) / 2; }
__host__ __device__ __forceinline__ int perm32(int rho) { const int n = rho >> 4, i = rho & 15; return 8 * (i >> 2) + 4 * n + (i & 3); }

struct Unit { int pm, pn, kofs, knt, split; };
struct Gemm { const bf16_t* A; const bf16_t* Bt; int M, N, K; int mode; size_t astride; };
__device__ __forceinline__ const char* a_of(const Gemm& g, int pn) {
    int s = 0;
    if (g.mode == 1) s = pn < 8 ? 0 : pn < 16 ? 2 : pn < 24 ? 3 : pn == 24 ? 1 : pn == 25 ? 4 : pn == 26 ? 5 : 3;
    else if (g.mode == 2) s = pn >> 3;
    return (const char*)g.A + (size_t)s * g.astride;
}
struct StaticOrder {
    int nM, nN, nwg, G, c, nFull, S, ntK, total;
    __device__ __forceinline__ void init(int M, int N, int G_, int c_, int K = 0, int S_ = 1) { nM = M / BM; nN = N / BM; nwg = nM * nN; G = G_; c = c_; ntK = K / BK;
        nFull = (nwg / G) * G; S = S_; if (S_ <= 1 || nFull == nwg) { S = 1; nFull = nwg; } total = nFull + (nwg - nFull) * S; }
    __device__ __forceinline__ bool next(int i, Unit& u) const {
        const long L = (long)i * G + c; if (L >= total) return false;
        int wgid;
        if (L < nFull) { wgid = (int)L; u.kofs = 0; u.knt = ntK; u.split = 0; }
        else { const int j = (int)L - nFull; wgid = nFull + j / S; const int part = j % S; u.knt = ntK / S; u.kofs = part * u.knt * BK; u.split = 1 + part * 32 + j / S; }
        tile_pmpn(wgid, u.pm, u.pn); return true;
    }
    __device__ __forceinline__ void tile_pmpn(int wgid, int& pm, int& pn) const {
        { const int q = nwg / NXCD, r = nwg % NXCD, xcd = wgid % NXCD, off = wgid / NXCD; wgid = (xcd < r ? xcd * (q + 1) : r * (q + 1) + (xcd - r) * q) + off; }
        const int nig = WGM * nN, gid = wgid / nig, fm = gid * WGM, gsz = (nM - fm) < WGM ? (nM - fm) : WGM;
        pm = fm + ((wgid % nig) % gsz); pn = (wgid % nig) / gsz;
    }
};

template <class F> struct Epi {
    static constexpr bool PERM = true;
    F f;
    __device__ __forceinline__ void operator()(const f32x4 (&acc)[2][2][4][2], const Unit& u, int wr, int wc, int fr, int fq) const {
        { int t_ = threadIdx.x; asm volatile("" : "+v"(t_)); const int l_ = t_ & 63, w_ = __builtin_amdgcn_readfirstlane(t_ >> 6); fr = l_ & 15; fq = l_ >> 4; wr = w_ >> 2; wc = w_ & 3; }
        const int row0 = u.pm * BM + wr * 64 + fr, col0 = u.pn * BM + wc * 32 + 8 * fq;
#pragma unroll
        for (int ai = 0; ai < 2; ++ai)
#pragma unroll
            for (int m = 0; m < 4; ++m)
#pragma unroll
                for (int bj = 0; bj < 2; ++bj) f(row0 + ai * HALF + m * 16, col0 + bj * HALF, acc[ai][bj][m][0], acc[ai][bj][m][1], u.split);
    }
};

template <class EpiT>
__device__ __forceinline__ void gemm_phase(LAS unsigned char* lds, const Gemm g, const StaticOrder& S, const EpiT& E) {
    int tid = threadIdx.x; asm volatile("" : "+v"(tid));
    const int wid = __builtin_amdgcn_readfirstlane(tid >> 6), lane = tid & 63, wr = wid >> 2, wc = wid & 3, fr = lane & 15, fq = lane >> 4;
    const int K = g.K;
    unsigned voffA[2], voffB[2];
#pragma unroll
    for (int i = 0; i < 2; ++i) { int R, C; stage_rc(tid * 16 + i * 8192, R, C); const int Rb = EpiT::PERM ? ((R & ~31) + perm32(R & 31)) : R;
        voffA[i] = (unsigned)(R * K + C) * 2u; voffB[i] = (unsigned)(Rb * K + C) * 2u; }
    const size_t kstep = (size_t)(BK * 2);
    const size_t hstep = (size_t)HALF * K * 2;
    const size_t tstep = 2 * hstep;
    const unsigned ldsw = (unsigned)wid * 1024u;
    const int aoff = lds_byte(wr * 64 + fr, fq * 8), boff = lds_byte(wc * 32 + fr, fq * 8);
#define PG8_SA(b, h) (((b) * 2 + (h)) * HTB)
#define PG8_SB(b, h) ((4 + (b) * 2 + (h)) * HTB)
#define PG8_STAGE(bufoff, gbase, voff) do { _Pragma("unroll") for (int _i = 0; _i < 2; ++_i) \
        __builtin_amdgcn_global_load_lds((const unsigned*)((const char*)(gbase) + (voff)[_i]), (LAS unsigned*)(lds + (bufoff) + ldsw + _i * 8192), 16, 0, 0); } while (0)
#define PG8_LDA(dst, b, h) do { _Pragma("unroll") for (int m = 0; m < 4; ++m) _Pragma("unroll") for (int k = 0; k < 2; ++k) dst[m][k] = *(const LAS bf16x8*)(lds + PG8_SA(b, h) + aoff + m * 2048 + k * 1024); } while (0)
#define PG8_LDB(dst, b, h) do { _Pragma("unroll") for (int n = 0; n < 2; ++n) _Pragma("unroll") for (int k = 0; k < 2; ++k) dst[n][k] = *(const LAS bf16x8*)(lds + PG8_SB(b, h) + boff + n * 2048 + k * 1024); } while (0)
#define PG8_MMA(ai, bj, At, Bt) do { __builtin_amdgcn_s_setprio(1); _Pragma("unroll") for (int m = 0; m < 4; ++m) _Pragma("unroll") for (int n = 0; n < 2; ++n) _Pragma("unroll") for (int k = 0; k < 2; ++k) \
        acc[ai][bj][m][n] = __builtin_amdgcn_mfma_f32_16x16x32_bf16(Bt[n][k], At[m][k], acc[ai][bj][m][n], 0, 0, 0); __builtin_amdgcn_s_setprio(0); } while (0)
#define PG8_WAIT_V(n) asm volatile("s_waitcnt vmcnt(" #n ")" ::: "memory")
#define PG8_WAIT_L(n) asm volatile("s_waitcnt lgkmcnt(" #n ")" ::: "memory")
#define PG8_BAR __builtin_amdgcn_s_barrier()
#define PG8_SCHED __builtin_amdgcn_sched_barrier(0)
    Unit cur, nxt; int ui = 0;
    if (!S.next(0, cur)) return;
    f32x4 acc[2][2][4][2];
#pragma unroll
    for (int a = 0; a < 2; ++a)
#pragma unroll
        for (int b = 0; b < 2; ++b)
#pragma unroll
            for (int m = 0; m < 4; ++m)
#pragma unroll
                for (int n = 0; n < 2; ++n) acc[a][b][m][n] = (f32x4){0.f, 0.f, 0.f, 0.f};
    bf16x8 At[4][2], B0[2][2], B1[2][2];
    const char* cA = a_of(g, cur.pn) + (size_t)cur.pm * tstep + (size_t)cur.kofs * 2; const char* cB = (const char*)g.Bt + (size_t)cur.pn * tstep + (size_t)cur.kofs * 2;
    PG8_STAGE(PG8_SB(0, 0), cB, voffB); PG8_STAGE(PG8_SB(0, 1), cB + hstep, voffB); PG8_STAGE(PG8_SA(0, 0), cA, voffA); PG8_STAGE(PG8_SA(0, 1), cA + hstep, voffA);
    if (wr == 1) PG8_BAR;
    PG8_WAIT_V(2); PG8_BAR;
    PG8_STAGE(PG8_SB(1, 0), cB + kstep, voffB); PG8_STAGE(PG8_SA(1, 0), cA + kstep, voffA); PG8_STAGE(PG8_SB(1, 1), cB + hstep + kstep, voffB);
    PG8_WAIT_V(6); PG8_BAR;
    for (;;) {
        const bool has_next = S.next(ui + 1, nxt);
        const char* nA = has_next ? a_of(g, nxt.pn) + (size_t)nxt.pm * tstep + (size_t)nxt.kofs * 2 : cA; const char* nB = has_next ? (const char*)g.Bt + (size_t)nxt.pn * tstep + (size_t)nxt.kofs * 2 : cB;
        const int nt = cur.knt;
        for (int t = 0; t < nt; t += 2) {
            const bool last = (t == nt - 2);
            const char* a1 = cA + (size_t)(t + 1) * kstep;
            const char* a2 = last ? nA : cA + (size_t)(t + 2) * kstep; const char* b2 = last ? nB : cB + (size_t)(t + 2) * kstep;
            const char* a3 = a2 + kstep; const char* b3 = b2 + kstep;
            PG8_LDB(B0, 0, 0); PG8_LDB(B1, 0, 1); PG8_SCHED; PG8_LDA(At, 0, 0); PG8_STAGE(PG8_SA(1, 1), a1 + hstep, voffA);
            PG8_WAIT_V(8); PG8_WAIT_L(0); PG8_BAR; PG8_MMA(0, 0, At, B0); PG8_MMA(0, 1, At, B1); PG8_BAR; PG8_SCHED;
            PG8_LDA(At, 0, 1); PG8_STAGE(PG8_SB(0, 0), b2, voffB); PG8_STAGE(PG8_SB(0, 1), b2 + hstep, voffB); PG8_STAGE(PG8_SA(0, 0), a2, voffA);
            PG8_WAIT_V(8); PG8_WAIT_L(0); PG8_BAR; PG8_MMA(1, 0, At, B0); PG8_MMA(1, 1, At, B1); PG8_BAR; PG8_SCHED;
            PG8_LDB(B0, 1, 0); PG8_LDB(B1, 1, 1); PG8_SCHED; PG8_LDA(At, 1, 0); PG8_STAGE(PG8_SA(0, 1), a2 + hstep, voffA);
            PG8_WAIT_V(8); PG8_WAIT_L(0); PG8_BAR; PG8_MMA(0, 0, At, B0); PG8_MMA(0, 1, At, B1); PG8_BAR; PG8_SCHED;
            PG8_LDA(At, 1, 1); PG8_STAGE(PG8_SB(1, 0), b3, voffB); PG8_STAGE(PG8_SB(1, 1), b3 + hstep, voffB); PG8_STAGE(PG8_SA(1, 0), a3, voffA);
            PG8_WAIT_V(8); PG8_WAIT_L(0); PG8_BAR; PG8_MMA(1, 0, At, B0); PG8_MMA(1, 1, At, B1); PG8_BAR; PG8_SCHED;
        }
        if (wr == 0) PG8_BAR;
        E(acc, cur, wr, wc, fr, fq);
        if (!has_next) break;
#pragma unroll
        for (int a = 0; a < 2; ++a)
#pragma unroll
            for (int b = 0; b < 2; ++b)
#pragma unroll
                for (int m = 0; m < 4; ++m)
#pragma unroll
                    for (int n = 0; n < 2; ++n) acc[a][b][m][n] = (f32x4){0.f, 0.f, 0.f, 0.f};
        cur = nxt; cA = nA; cB = nB; ++ui;
        if (wr == 1) PG8_BAR;
    }
    PG8_WAIT_V(0);
    PG8_BAR;
#undef PG8_SA
#undef PG8_SB
#undef PG8_STAGE
#undef PG8_LDA
#undef PG8_LDB
#undef PG8_MMA
#undef PG8_WAIT_V
#undef PG8_WAIT_L
#undef PG8_BAR
#undef PG8_SCHED
}
}

__device__ __forceinline__ void store8bf(bf16_t* p, f32x4 a, f32x4 b) {
    u32x4 w; w.x = cvt_pk_bf16(a[0], a[1]); w.y = cvt_pk_bf16(a[2], a[3]); w.z = cvt_pk_bf16(b[0], b[1]); w.w = cvt_pk_bf16(b[2], b[3]);
    *(u32x4*)p = w;
}
struct FRes { float* X; float* PART;
    __device__ __forceinline__ void operator()(int row, int col, f32x4 a, f32x4 b, int split) const {
        float* p = X + (size_t)row * DM + col;
        if (split) { float* q = PART + (size_t)(split - 1) * 65536 + (row & 255) * 256 + (col & 255); *(f32x4*)q = a; *(f32x4*)(q + 4) = b; }
        else { f32x4 x0 = *(f32x4*)p, x1 = *(f32x4*)(p + 4); *(f32x4*)p = x0 + a; *(f32x4*)(p + 4) = x1 + b; } } };
struct FR1 { bf16_t *R, *K, *V, *L;
    __device__ __forceinline__ void operator()(int row, int col, f32x4 a, f32x4 b, int) const {
        if (col < 6144) { const int g = col >> 11; const size_t o = (size_t)row * DM + (col & 2047); if (g == 0) store8bf(R + o, a, b); else if (g == 1) store8bf(K + o, a, b); else store8bf(V + o, a, b); }
        else { const int t = (col - 6144) >> 8, c = col & 255;
            if (t == 0) { for (int i = 0; i < 4; ++i) { a[i] = 1.f - 2.f / (1.f + __expf(2.f * a[i])); b[i] = 1.f - 2.f / (1.f + __expf(2.f * b[i])); } }
            else if (t == 2) { for (int i = 0; i < 4; ++i) { a[i] = sigmoidf_(a[i]); b[i] = sigmoidf_(b[i]); } }
            store8bf(L + (size_t)t * MROWS * 256 + (size_t)row * 256 + c, a, b); } } };
__device__ __forceinline__ float decay_of(float z) { return -0.60653065971f / (1.f + __expf(-z)); }
struct FR2 { float* DD; bf16_t *AA, *GG, *VG; const float *w0, *a0, *v0;
    __device__ __forceinline__ void operator()(int row, int col, f32x4 a, f32x4 b, int) const {
        const int g = col >> 11, c = col & 2047; const size_t off = (size_t)row * DM + c;
        if (g == 0) { f32x4 z0 = *(const f32x4*)(w0 + c), z1 = *(const f32x4*)(w0 + c + 4); a += z0; b += z1;
            for (int i = 0; i < 4; ++i) { a[i] = decay_of(a[i]); b[i] = decay_of(b[i]); }
            *(f32x4*)(DD + off) = a; *(f32x4*)(DD + off + 4) = b; }
        else if (g == 1) { f32x4 z0 = *(const f32x4*)(a0 + c), z1 = *(const f32x4*)(a0 + c + 4); a += z0; b += z1;
            for (int i = 0; i < 4; ++i) { a[i] = sigmoidf_(a[i]); b[i] = sigmoidf_(b[i]); } store8bf(AA + off, a, b); }
        else if (g == 2) { store8bf(GG + off, a, b); }
        else { f32x4 z0 = *(const f32x4*)(v0 + c), z1 = *(const f32x4*)(v0 + c + 4); a += z0; b += z1;
            for (int i = 0; i < 4; ++i) { a[i] = sigmoidf_(a[i]); b[i] = sigmoidf_(b[i]); } store8bf(VG + off, a, b); } } };
struct FG1 { bf16_t* PROJ; float* LR;
    __device__ __forceinline__ void operator()(int row, int col, f32x4 a, f32x4 b, int) const {
        if (col < 6144) { if (col < 1024) { a *= 0.0625f; b *= 0.0625f; } store8bf(PROJ + (size_t)row * 6144 + col, a, b); }
        else if (col < 6160) { float* p = LR + (size_t)row * 16 + (col - 6144); *(f32x4*)p = a; *(f32x4*)(p + 4) = b; } } };
struct FUp { bf16_t* U; float* pconv; float* sconv;
    __device__ __forceinline__ void operator()(int row, int col, f32x4 a, f32x4 b, int) const {
        store8bf(U + (size_t)row * F2 + col, a, b);
        if (row < MPROMPT) { const int t = row & 8191; if (t >= 8190) { float* p = pconv + ((size_t)((row >> 13) * 2 + (t - 8190))) * F2 + col; *(f32x4*)p = a; *(f32x4*)(p + 4) = b; } }
        else { const int rr = row - MPROMPT, t = rr & 63; if (t >= 62) { float* p = sconv + ((size_t)((rr >> 6) * 2 + (t - 62))) * F2 + col; *(f32x4*)p = a; *(f32x4*)(p + 4) = b; } } } };

__device__ __forceinline__ void tr_item(const float* W, int K, int N, bf16_t* WT, int Kpad, int Npad, float* scr, int item, int lane) {
    const int nblk = Npad / 64, kb = item / nblk, nb = item % nblk, k0 = 64 * kb, n0 = 64 * nb;
    const int n4 = n0 + (lane & 15) * 4;
    f32x4 v[16];
#pragma unroll
    for (int i = 0; i < 16; ++i) { const int k = k0 + 4 * i + (lane >> 4); v[i] = (k < K && n4 < N) ? *(const f32x4*)(W + (size_t)k * N + n4) : (f32x4){0.f, 0.f, 0.f, 0.f}; }
#pragma unroll
    for (int i = 0; i < 16; ++i) { float* d = scr + (4 * i + (lane >> 4)) * 65 + (lane & 15) * 4; d[0] = v[i][0]; d[1] = v[i][1]; d[2] = v[i][2]; d[3] = v[i][3]; }
    asm volatile("s_waitcnt lgkmcnt(0)" ::: "memory");
    const int c = lane & 7;
#pragma unroll
    for (int j = 0; j < 8; ++j) { const int nn = (lane >> 3) + 8 * j; const float* s = scr + (8 * c) * 65 + nn;
        u32x4 o; o.x = cvt_pk_bf16(s[0 * 65], s[1 * 65]); o.y = cvt_pk_bf16(s[2 * 65], s[3 * 65]); o.z = cvt_pk_bf16(s[4 * 65], s[5 * 65]); o.w = cvt_pk_bf16(s[6 * 65], s[7 * 65]);
        *(u32x4*)(WT + (size_t)(n0 + nn) * Kpad + k0 + 8 * c) = o; }
    asm volatile("s_waitcnt lgkmcnt(0)" ::: "memory");
}

struct P { const float* in[39]; float* out; unsigned char* ws; };

__device__ __forceinline__ void row_info(int row, int& t, int& len, int& b, bool& prompt) {
    if (row < MPROMPT) { prompt = true; b = row >> 13; t = row & 8191; len = 8192; }
    else { prompt = false; const int rr = row - MPROMPT; b = rr >> 6; t = rr & 63; len = 64; }
}

__device__ __forceinline__ const float* ldp(const unsigned long long* tab, int i) {
    const unsigned long long v = tab[i];
    const unsigned lo = __builtin_amdgcn_readfirstlane((unsigned)v), hi = __builtin_amdgcn_readfirstlane((unsigned)(v >> 32));
    const __attribute__((address_space(1))) float* g = (const __attribute__((address_space(1))) float*)(((unsigned long long)hi << 32) | lo);
    return (const float*)g;
}
__device__ __forceinline__ void fast_grid_barrier(unsigned* bar, unsigned long long* tab) {
    asm volatile("s_waitcnt vmcnt(0)" ::: "memory");
    __syncthreads();
    if (threadIdx.x == 0) {
        const unsigned G = gridDim.x, grp = blockIdx.x & 7u;
        const unsigned epoch = (unsigned)tab[41] + 1u; tab[41] = epoch;
        const unsigned ngrp = (G - grp + 7u) >> 3, ntop = G < 8u ? G : 8u;
        __builtin_amdgcn_fence(__ATOMIC_RELEASE, "agent");
        asm volatile("s_waitcnt vmcnt(0)" ::: "memory");
        const unsigned old = __hip_atomic_fetch_add(&bar[64u * (1u + grp)], 1u, __ATOMIC_RELAXED, __HIP_MEMORY_SCOPE_AGENT);
        if (old + 1u == epoch * ngrp) (void)__hip_atomic_fetch_add(&bar[0], 1u, __ATOMIC_RELAXED, __HIP_MEMORY_SCOPE_AGENT);
        while (__hip_atomic_load(&bar[0], __ATOMIC_RELAXED, __HIP_MEMORY_SCOPE_AGENT) < epoch * ntop) __builtin_amdgcn_s_sleep(1);
        __builtin_amdgcn_fence(__ATOMIC_ACQUIRE, "agent");
        asm volatile("s_waitcnt vmcnt(0)" ::: "memory");
    }
    __syncthreads();
}
#define IN(k) ldp(tab, (k))
#define OUTP ((float*)ldp(tab, 39))
#define BASES float* X = (float*)ldp(tab, 39); unsigned char* ws_ = (unsigned char*)ldp(tab, 40); bf16_t* WT = (bf16_t*)(ws_ + WS_WT); unsigned char* RA = ws_ + WS_A; unsigned char* RB = ws_ + WS_B; \
    bf16_t* VFIRST = (bf16_t*)(ws_ + WS_VF); LAS unsigned char* ldsl = (LAS unsigned char*)lds; (void)X; (void)WT; (void)RA; (void)RB; (void)VFIRST; (void)ldsl;
#define RWKV_PTRS bf16_t* HB = (bf16_t*)RA; bf16_t* Rb = (bf16_t*)RB; bf16_t* Kb = Rb + ACT; bf16_t* Vb = (jl == 0) ? VFIRST : Kb + ACT; bf16_t* Lb = (bf16_t*)(RB + 204 * MiB); \
    float* DD = (float*)(RB + 240 * MiB); bf16_t* AA = (bf16_t*)RA; bf16_t* VG = AA + ACT; bf16_t* GG = VG + ACT; bf16_t* Y = GG + ACT; \
    bf16_t* W1 = WT + jl * RW_SZ; bf16_t* W2 = W1 + (size_t)7168 * 2048; bf16_t* WO = W2 + (size_t)8192 * 256; \
    (void)HB; (void)Rb; (void)Kb; (void)Vb; (void)Lb; (void)DD; (void)AA; (void)VG; (void)GG; (void)Y; (void)W1; (void)W2; (void)WO;
#define GLA_PTRS bf16_t* H = (bf16_t*)RB; float* LR = (float*)(RB + 68 * MiB); float* O = (float*)(RB + 70 * MiB); bf16_t* Y = (bf16_t*)(RB + 206 * MiB); \
    bf16_t* PROJ = (bf16_t*)RA; bf16_t* QE = (bf16_t*)(RA + 204 * MiB); bf16_t* KDT = (bf16_t*)(RA + 238 * MiB); bf16_t* VT = (bf16_t*)(RA + 272 * MiB); \
    bf16_t* SC = (bf16_t*)(RA + 340 * MiB); float* EL = (float*)(RA + 349 * MiB); bf16_t* GI = WT + GW_OFF + jl * GW_SZ; bf16_t* GO = GI + (size_t)6400 * 2048; \
    (void)H; (void)LR; (void)O; (void)Y; (void)PROJ; (void)QE; (void)KDT; (void)VT; (void)SC; (void)EL; (void)GI; (void)GO;
#define FFN_PTRS bf16_t* H = (bf16_t*)RB; bf16_t* HID = (bf16_t*)(RB + 68 * MiB); bf16_t* U = (bf16_t*)RA; bf16_t* WU = WT + FW_OFF + layer * FW_SZ; bf16_t* WD = WU + (size_t)F2 * 2048; \
    (void)H; (void)HID; (void)U; (void)WU; (void)WD;

__global__ void __launch_bounds__(512, 2) fwd_kernel(P p) {
    extern __shared__ __attribute__((aligned(16))) unsigned char lds[];
    cg::grid_group grid = cg::this_grid();
    const int G = gridDim.x, NGW = G * 8, NT = G * 512;
#define PHASE_IDS int tid = threadIdx.x; asm volatile("" : "+v"(tid)); const int lane = tid & 63; const int wave = __builtin_amdgcn_readfirstlane(tid >> 6); const int gw = blockIdx.x * 8 + wave; const int gtid = blockIdx.x * 512 + tid; (void)lane; (void)gw; (void)gtid;
    unsigned long long* tab = (unsigned long long*)(lds + LDS_BYTES - 512);
    if (threadIdx.x == 0) {
#pragma unroll
        for (int i = 0; i < 39; ++i) tab[i] = (unsigned long long)p.in[i];
        tab[39] = (unsigned long long)p.out; tab[40] = (unsigned long long)p.ws; tab[41] = 0ull;
    }
    __syncthreads();

    {
        PHASE_IDS BASES
        float* scr = (float*)(lds + wave * 16896);
#define TR(src, K, N, dst, Kpad, Npad) do { const int _ni = ((Kpad) / 64) * ((Npad) / 64); for (int it = gw; it < _ni; it += NGW) tr_item((src), (K), (N), (dst), (Kpad), (Npad), scr, it, lane); } while (0)
#pragma unroll 1
        for (int j = 0; j < 2; ++j) {
            bf16_t* W1 = WT + j * RW_SZ; bf16_t* W2 = W1 + (size_t)7168 * 2048; bf16_t* WO = W2 + (size_t)8192 * 256;
            TR(IN(24) + (size_t)j * DM * DM, 2048, 2048, W1, 2048, 2048);
            TR(IN(25) + (size_t)j * DM * DM, 2048, 2048, W1 + (size_t)2048 * 2048, 2048, 2048);
            TR(IN(26) + (size_t)j * DM * DM, 2048, 2048, W1 + (size_t)4096 * 2048, 2048, 2048);
            TR(IN(11) + (size_t)j * DM * 96, 2048, 96, W1 + (size_t)6144 * 2048, 2048, 256);
            TR(IN(14) + (size_t)j * DM * 96, 2048, 96, W1 + (size_t)6400 * 2048, 2048, 256);
            TR(IN(19) + (size_t)j * DM * 256, 2048, 256, W1 + (size_t)6656 * 2048, 2048, 256);
            if (j >= 1) TR(IN(17) + (size_t)(j - 1) * DM * 64, 2048, 64, W1 + (size_t)6912 * 2048, 2048, 256);
            TR(IN(12) + (size_t)j * 96 * DM, 96, 2048, W2, 256, 2048);
            TR(IN(15) + (size_t)j * 96 * DM, 96, 2048, W2 + (size_t)2048 * 256, 256, 2048);
            TR(IN(20) + (size_t)j * 256 * DM, 256, 2048, W2 + (size_t)4096 * 256, 256, 2048);
            if (j >= 1) TR(IN(18) + (size_t)(j - 1) * 64 * DM, 64, 2048, W2 + (size_t)6144 * 256, 256, 2048);
            TR(IN(27) + (size_t)j * DM * DM, 2048, 2048, WO, 2048, 2048);
            bf16_t* GI = WT + GW_OFF + j * GW_SZ; bf16_t* GO = GI + (size_t)6400 * 2048;
            TR(IN(30) + (size_t)j * DM * 6160, 2048, 6160, GI, 2048, 6400);
            TR(IN(34) + (size_t)j * DM * DM, 2048, 2048, GO, 2048, 2048);
        }
#pragma unroll 1
        for (int i = 0; i < 4; ++i) {
            bf16_t* WU = WT + FW_OFF + i * FW_SZ; bf16_t* WD = WU + (size_t)F2 * 2048;
            TR(IN(35) + (size_t)i * DM * F2, 2048, F2, WU, 2048, F2);
            TR(IN(38) + (size_t)i * FH * DM, FH, 2048, WD, FH, 2048);
        }
#undef TR
        const f32x4* xp = (const f32x4*)IN(0); const f32x4* xs = (const f32x4*)IN(1); f32x4* xo = (f32x4*)X;
        const int NP4 = MPROMPT * DM / 4, NA4 = MROWS * DM / 4;
#pragma unroll 4
        for (int i = gtid; i < NA4; i += NT) xo[i] = i < NP4 ? xp[i] : xs[i - NP4];
    }
    grid.sync();

#pragma clang loop unroll(full)
    for (int layer = 0; layer < 4; ++layer) {
        const int jl = layer >> 1;
        if ((layer & 1) == 0) {
            {
                PHASE_IDS BASES RWKV_PTRS
                const float* gmix = IN(6) + (size_t)layer * DM;
                const float* mix = IN(9) + (size_t)jl * 6 * DM;
                const float* sst = IN(2) + (size_t)jl * 16 * DM;
                for (int row = gw; row < MROWS; row += NGW) {
                    int t, len, b; bool prompt; row_info(row, t, len, b, prompt);
                    const f32x4* xr = (const f32x4*)(X + (size_t)row * DM) + lane;
                    f32x4 x[8]; float ss = 0.f;
#pragma unroll
                    for (int q = 0; q < 8; ++q) { x[q] = xr[64 * q]; ss += x[q][0] * x[q][0] + x[q][1] * x[q][1] + x[q][2] * x[q][2] + x[q][3] * x[q][3]; }
                    const float rs = rsqrtf(wave_sum(ss, lane) * (1.f / DM) + 1e-6f);
                    f32x4 hp[8];
                    if (t > 0) {
                        const f32x4* xq = (const f32x4*)(X + (size_t)(row - 1) * DM) + lane; float s2 = 0.f;
#pragma unroll
                        for (int q = 0; q < 8; ++q) { hp[q] = xq[64 * q]; s2 += hp[q][0] * hp[q][0] + hp[q][1] * hp[q][1] + hp[q][2] * hp[q][2] + hp[q][3] * hp[q][3]; }
                        const float rp = rsqrtf(wave_sum(s2, lane) * (1.f / DM) + 1e-6f);
#pragma unroll
                        for (int q = 0; q < 8; ++q) { const f32x4 gg = *((const f32x4*)gmix + lane + 64 * q); hp[q] = hp[q] * rp * gg; }
                    } else if (!prompt) {
#pragma unroll
                        for (int q = 0; q < 8; ++q) hp[q] = *((const f32x4*)(sst + (size_t)b * DM) + lane + 64 * q);
                    } else {
#pragma unroll
                        for (int q = 0; q < 8; ++q) hp[q] = (f32x4){0.f, 0.f, 0.f, 0.f};
                    }
                    const bool lastrow = (t == len - 1);
                    float* shout = OUTP + (prompt ? O_PSHIFT + ((size_t)jl * 2 + b) * DM : O_SSHIFT + ((size_t)jl * 16 + b) * DM);
#pragma unroll
                    for (int q = 0; q < 8; ++q) {
                        const f32x4 gg = *((const f32x4*)gmix + lane + 64 * q);
                        const f32x4 h = x[q] * rs * gg; const f32x4 dlt = hp[q] - h;
                        if (lastrow) *((f32x4*)shout + lane + 64 * q) = h;
#pragma unroll
                        for (int m = 0; m < 6; ++m) {
                            const f32x4 mx = *((const f32x4*)(mix + (size_t)m * DM) + lane + 64 * q);
                            const f32x4 o = h + dlt * mx;
                            u32x2 w; w.x = cvt_pk_bf16(o[0], o[1]); w.y = cvt_pk_bf16(o[2], o[3]);
                            *((u32x2*)(HB + (size_t)m * ACT + (size_t)row * DM) + lane + 64 * q) = w;
                        }
                    }
                }
            }
            fast_grid_barrier((unsigned*)ldp(tab, 40), tab);
            {
                BASES RWKV_PTRS
                pg8::Gemm g{HB, W1, MROWS, jl == 0 ? 6912 : 7168, 2048, 1, ACT * 2};
                pg8::StaticOrder S; S.init(g.M, g.N, G, (int)blockIdx.x, g.K, 1);
                pg8::Epi<FR1> E{FR1{Rb, Kb, Vb, Lb}};
                pg8::gemm_phase(ldsl, g, S, E);
            }
            fast_grid_barrier((unsigned*)ldp(tab, 40), tab);
            {
                BASES RWKV_PTRS
                pg8::Gemm g{Lb, W2, MROWS, jl == 0 ? 6144 : 8192, 256, 2, (size_t)MROWS * 256 * 2};
                pg8::StaticOrder S; S.init(g.M, g.N, G, (int)blockIdx.x, g.K, 1);
                pg8::Epi<FR2> E{FR2{DD, AA, GG, VG, IN(10) + (size_t)jl * DM, IN(13) + (size_t)jl * DM, IN(16) + (size_t)(jl > 0 ? jl - 1 : 0) * DM}};
                pg8::gemm_phase(ldsl, g, S, E);
            }
            fast_grid_barrier((unsigned*)ldp(tab, 40), tab);
            {
                PHASE_IDS BASES RWKV_PTRS
                float* Obuf = (float*)(RA + 272 * MiB); float* RK = (float*)(RB + 204 * MiB); float* DTg = (float*)(RB + 208 * MiB);
                const float* k_k = IN(21) + (size_t)jl * DM; const float* k_a = IN(22) + (size_t)jl * DM; const float* r_k = IN(23) + (size_t)jl * DM;
                const int l32 = lane & 31, hl = lane >> 5;
#define S1_BAR do { asm volatile("s_waitcnt lgkmcnt(0)" ::: "memory"); __builtin_amdgcn_s_barrier(); asm volatile("" ::: "memory"); } while (0)
                const int st = tid >> 3, c0 = (tid & 7) * 8;
                u32x4 pr_, pk_, pv_, pa_, pvf_ = (u32x4){0u, 0u, 0u, 0u}, pvg_ = (u32x4){0u, 0u, 0u, 0u}; f32x4 pd0_, pd1_;
#define S1_FETCH(it) do { const size_t _off = (size_t)(((it) >> 5) * 64 + st) * DM + ((it) & 31) * 64 + c0; \
                    pr_ = *(const u32x4*)(Rb + _off); pk_ = *(const u32x4*)(Kb + _off); pv_ = *(const u32x4*)(Vb + _off); pa_ = *(const u32x4*)(AA + _off); \
                    pd0_ = *(const f32x4*)(DD + _off); pd1_ = *(const f32x4*)(DD + _off + 4); \
                    if (jl > 0) { pvf_ = *(const u32x4*)(VFIRST + _off); pvg_ = *(const u32x4*)(VG + _off); } } while (0)
#pragma unroll 1
                for (int item = blockIdx.x; item < 8704; item += G) {
                    LAS unsigned char* ldsv = (LAS unsigned char*)lds; asm volatile("" : "+v"(ldsv));
                    LAS bf16_t* AH = (LAS bf16_t*)(ldsv + 0); LAS bf16_t* RH = (LAS bf16_t*)(ldsv + 9216); LAS bf16_t* BH = (LAS bf16_t*)(ldsv + 18432); LAS bf16_t* KH = (LAS bf16_t*)(ldsv + 27648);
                    LAS bf16_t* BHT = (LAS bf16_t*)(ldsv + 36864); LAS bf16_t* KHT = (LAS bf16_t*)(ldsv + 46080); LAS bf16_t* VTs = (LAS bf16_t*)(ldsv + 55296); LAS bf16_t* XT = (LAS bf16_t*)(ldsv + 64512);
                    LAS float* AAB = (LAS float*)(ldsv + 82944); LAS bf16_t* AAK = (LAS bf16_t*)(ldsv + 99328); LAS bf16_t* ARB = (LAS bf16_t*)(ldsv + 108544); LAS bf16_t* ARK = (LAS bf16_t*)(ldsv + 117760);
                    LAS float* LB = (LAS float*)(ldsv + 126976); LAS float* DTS = (LAS float*)(ldsv + 143360);
                    (void)RH; (void)KH; (void)KHT;
                    const int chunk = item >> 5, h = item & 31, r0 = chunk * 64;
                    const int col = h * 64 + c0;
                    S1_FETCH(item);
                    float r[8], kk[8], bb[8], km[8], ld[8];
                    {
                        float k[8], v[8], a[8];
                        unpack8(pr_, r); unpack8(pk_, k); unpack8(pv_, v); unpack8(pa_, a);
                        const f32x4 d0 = pd0_, d1 = pd1_;
                        ld[0] = d0[0]; ld[1] = d0[1]; ld[2] = d0[2]; ld[3] = d0[3]; ld[4] = d1[0]; ld[5] = d1[1]; ld[6] = d1[2]; ld[7] = d1[3];
                        if (jl > 0) { float vf[8], vg[8]; unpack8(pvf_, vf); unpack8(pvg_, vg);
#pragma unroll
                            for (int i = 0; i < 8; ++i) v[i] = v[i] + (vf[i] - v[i]) * vg[i]; }
                        float ss = 0.f;
#pragma unroll
                        for (int i = 0; i < 8; ++i) { kk[i] = k[i] * k_k[col + i]; ss += kk[i] * kk[i]; }
                        ss = sum8(ss, lane);
                        const float inv = 1.f / fmaxf(sqrtf(ss), 1e-12f);
                        float rk = 0.f;
#pragma unroll
                        for (int i = 0; i < 8; ++i) { kk[i] *= inv; bb[i] = kk[i] * a[i]; km[i] = k[i] * (1.f + (a[i] - 1.f) * k_a[col + i]); rk += r[i] * km[i] * r_k[col + i]; }
                        rk = sum8(rk, lane);
                        if ((tid & 7) == 0) RK[(size_t)(r0 + st) * 32 + h] = rk;
                        *(LAS f32x4*)(LB + st * 64 + c0) = d0; *(LAS f32x4*)(LB + st * 64 + c0 + 4) = d1;
#pragma unroll
                        for (int i = 0; i < 8; i += 2) { const unsigned pk = cvt_pk_bf16(v[i], v[i + 1]); VTs[(c0 + i) * 72 + st] = (bf16_t)(pk & 0xffffu); VTs[(c0 + i + 1) * 72 + st] = (bf16_t)(pk >> 16); }
                    }
                    S1_BAR;
                    {
                        const int cc_ = tid & 63, tq_ = tid >> 6; float pf[8]; float run = 0.f;
#pragma unroll
                        for (int j = 0; j < 8; ++j) { run += LB[(8 * tq_ + j) * 64 + cc_]; pf[j] = run; }
                        AAB[tq_ * 64 + cc_] = run;
                        S1_BAR;
                        float ofs = 0.f;
#pragma unroll
                        for (int g = 0; g < 7; ++g) ofs += (g < tq_) ? AAB[g * 64 + cc_] : 0.f;
#pragma unroll
                        for (int j = 0; j < 8; ++j) LB[(8 * tq_ + j) * 64 + cc_] = pf[j] + ofs;
                    }
                    S1_BAR;
                    {
                        float ah[8], bh[8], kh[8], rh[8];
#pragma unroll
                        for (int i = 0; i < 8; ++i) { const float Lt = LB[st * 64 + c0 + i]; const float e3 = __expf(Lt), e2 = __expf(-Lt), e1 = __expf(Lt - ld[i]);
                            ah[i] = -kk[i] * e1; bh[i] = bb[i] * e2; kh[i] = km[i] * e2; rh[i] = r[i] * e3;
                            if (st == 63) { DTS[c0 + i] = e3; DTg[(size_t)item * 64 + c0 + i] = e3; } }
                        *(LAS u32x4*)(AH + st * 72 + c0) = pack8(ah); *(LAS u32x4*)(RH + st * 72 + c0) = pack8(rh);
                        *(LAS u32x4*)(BH + st * 72 + c0) = pack8(bh); *(LAS u32x4*)(KH + st * 72 + c0) = pack8(kh);
#pragma unroll
                        for (int i = 0; i < 8; i += 2) { const unsigned p1 = cvt_pk_bf16(bh[i], bh[i + 1]), p2 = cvt_pk_bf16(kh[i], kh[i + 1]);
                            BHT[(c0 + i) * 72 + st] = (bf16_t)(p1 & 0xffffu); BHT[(c0 + i + 1) * 72 + st] = (bf16_t)(p1 >> 16);
                            KHT[(c0 + i) * 72 + st] = (bf16_t)(p2 & 0xffffu); KHT[(c0 + i + 1) * 72 + st] = (bf16_t)(p2 >> 16); }
                    }
                    S1_BAR;
                    {
                        const int mi = wave & 3, rowsel = mi >> 1, tt = mi & 1;
#pragma unroll
                        for (int nn = 0; nn < 2; ++nn) {
                            const int colsel = wave >> 2, stl = nn; const int ni = 2 * colsel + nn;
                            f32x16 acc;
#pragma unroll
                            for (int i = 0; i < 16; ++i) acc[i] = 0.f;
                            if (stl <= tt) {
#pragma unroll
                                for (int ks = 0; ks < 4; ++ks) {
                                    const bf16x8 a = *(const LAS bf16x8*)(AH + (mi * 32 + l32) * 72 + ks * 16 + hl * 8);
                                    const bf16x8 b = *(const LAS bf16x8*)(BH + (ni * 32 + l32) * 72 + ks * 16 + hl * 8);
                                    acc = __builtin_amdgcn_mfma_f32_32x32x16_bf16(a, b, acc, 0, 0, 0);
                                }
                            }
#pragma unroll
                            for (int i = 0; i < 16; ++i) {
                                const int t = tt * 32 + crow(i, hl), s = stl * 32 + l32;
                                const bool keep = rowsel ? (s <= t) : (s < t);
                                const float val = keep ? acc[i] : 0.f;
                                if (rowsel == 0 && colsel == 0) AAB[t * 64 + s] = val;
                                else { LAS bf16_t* dst = (rowsel == 0) ? AAK : (colsel == 0 ? ARB : ARK); dst[t * 72 + s] = (bf16_t)(cvt_pk_bf16(val, 0.f) & 0xffffu); }
                            }
                        }
                    }
                    S1_BAR;
                    if (wave < 4) {
                        const int mt = wave >> 1, nt = wave & 1;
                        f32x16 acc;
#pragma unroll
                        for (int i = 0; i < 16; ++i) acc[i] = 0.f;
#pragma unroll
                        for (int ks = 0; ks < 4; ++ks) {
                            const bf16x8 a = *(const LAS bf16x8*)(AAK + (mt * 32 + l32) * 72 + ks * 16 + hl * 8);
                            const bf16x8 b = *(const LAS bf16x8*)(VTs + (nt * 32 + l32) * 72 + ks * 16 + hl * 8);
                            acc = __builtin_amdgcn_mfma_f32_32x32x16_bf16(a, b, acc, 0, 0, 0);
                        }
#pragma unroll
                        for (int i = 0; i < 16; ++i) LB[(mt * 32 + crow(i, hl)) * 64 + nt * 32 + l32] = acc[i];
                    }
                    S1_BAR;
                    if (tid < 128) {
                        float Xc[64];
#pragma unroll
                        for (int t = 0; t < 64; ++t) Xc[t] = 0.f;
#pragma clang loop unroll(full)
                        for (int t = 0; t < 64; ++t) {
                            const float va_ = bf2f(AH[t * 72 + (tid & 63)]), vb_ = LB[t * 64 + (tid & 63)];
                            float a0 = (tid < 64) ? va_ : vb_;
                            float a1 = 0.f, a2 = 0.f, a3 = 0.f;
#pragma clang loop unroll(full)
                            for (int s4 = 0; s4 < t; s4 += 4) { const f32x4 w = *(const LAS f32x4*)(AAB + t * 64 + s4);
                                a0 += w[0] * Xc[s4]; a1 += w[1] * Xc[s4 + 1]; a2 += w[2] * Xc[s4 + 2]; a3 += w[3] * Xc[s4 + 3]; }
                            Xc[t] = (a0 + a1) + (a2 + a3);
                            asm volatile("" : "+v"(Xc[t]));
                        }
#pragma unroll
                        for (int q = 0; q < 8; ++q) { float f8[8];
#pragma unroll
                            for (int i = 0; i < 8; ++i) f8[i] = Xc[q * 8 + i];
                            *(LAS u32x4*)(XT + tid * 72 + q * 8) = pack8(f8); }
                    }
                    S1_BAR;
                    {
                        const int kind = wave >> 2, mt = (wave & 3) >> 1, nt = wave & 1;
                        {
                            const LAS bf16_t* Ap = (kind == 0 ? ARB : BHT) + (mt * 32 + l32) * 72; const LAS bf16_t* Bp = XT + (nt * 32 + l32) * 72;
                            f32x16 acc;
#pragma unroll
                            for (int i = 0; i < 16; ++i) acc[i] = 0.f;
#pragma unroll
                            for (int ks = 0; ks < 4; ++ks) acc = __builtin_amdgcn_mfma_f32_32x32x16_bf16(*(const LAS bf16x8*)(Ap + ks * 16 + hl * 8), *(const LAS bf16x8*)(Bp + ks * 16 + hl * 8), acc, 0, 0, 0);
                            bf16_t* dstb = (kind == 0) ? Rb : Kb;
#pragma unroll
                            for (int i = 0; i < 16; ++i) { const int rr = mt * 32 + crow(i, hl), cc = nt * 32 + l32;
                                float val = acc[i];
                                if (kind == 0) val += bf2f(RH[rr * 72 + cc]); else val *= DTS[rr];
                                dstb[(size_t)(r0 + rr) * DM + h * 64 + cc] = (bf16_t)(cvt_pk_bf16(val, 0.f) & 0xffffu); }
                        }
                        {
                            const LAS bf16_t* A1 = (kind == 0 ? ARB : BHT) + (mt * 32 + l32) * 72; const LAS bf16_t* A2 = (kind == 0 ? ARK : KHT) + (mt * 32 + l32) * 72;
                            const LAS bf16_t* B1 = XT + (64 + nt * 32 + l32) * 72; const LAS bf16_t* B2 = VTs + (nt * 32 + l32) * 72;
                            f32x16 acc;
#pragma unroll
                            for (int i = 0; i < 16; ++i) acc[i] = 0.f;
#pragma unroll
                            for (int ks = 0; ks < 4; ++ks) acc = __builtin_amdgcn_mfma_f32_32x32x16_bf16(*(const LAS bf16x8*)(A1 + ks * 16 + hl * 8), *(const LAS bf16x8*)(B1 + ks * 16 + hl * 8), acc, 0, 0, 0);
#pragma unroll
                            for (int ks = 0; ks < 4; ++ks) acc = __builtin_amdgcn_mfma_f32_32x32x16_bf16(*(const LAS bf16x8*)(A2 + ks * 16 + hl * 8), *(const LAS bf16x8*)(B2 + ks * 16 + hl * 8), acc, 0, 0, 0);
                            float* dstf = (kind == 0) ? Obuf : DD;
#pragma unroll
                            for (int i = 0; i < 16; ++i) { const int rr = mt * 32 + crow(i, hl), cc = nt * 32 + l32;
                                float val = acc[i]; if (kind == 1) val *= DTS[rr];
                                dstf[(size_t)(r0 + rr) * DM + h * 64 + cc] = val; }
                        }
                    }
                    S1_BAR;
                }
            }
            fast_grid_barrier((unsigned*)ldp(tab, 40), tab);
#undef S1_BAR
#undef S1_FETCH
            {
                PHASE_IDS BASES RWKV_PTRS
                const float* DTg = (const float*)(RB + 208 * MiB);
                const int l32 = lane & 31, hl = lane >> 5;
                const int q = wave * G + blockIdx.x;
                if (q < 1152) {
                    const bool prompt = q < 128; int b, h, vh, chunk0, nch;
                    if (prompt) { const int chain = q & 63; b = chain >> 5; h = chain & 31; vh = q >> 6; chunk0 = b * 128; nch = 128; }
                    else { const int sq = q - 128; const int chain = sq >> 1; b = chain >> 5; h = chain & 31; vh = sq & 1; chunk0 = 256 + b; nch = 1; }
                    const int colb = h * 64, vcol = colb + 32 * vh + l32;
                    f32x16 S0, S1;
                    if (prompt) {
#pragma unroll
                        for (int i = 0; i < 16; ++i) { S0[i] = 0.f; S1[i] = 0.f; }
                    } else {
                        const float* s0 = IN(3) + ((((size_t)jl * 16 + b) * 32 + h) * 64 + (32 * vh + l32)) * 64;
#pragma unroll
                        for (int i = 0; i < 16; ++i) { S0[i] = s0[crow(i, hl)]; S1[i] = s0[32 + crow(i, hl)]; }
                    }
                    bf16x8 gf[2][2][2]; f32x16 n0, n1; f32x4 dt_[2][4];
#define S2_COMPUTE(cc) do { const int _r0 = (chunk0 + (cc)) * 64; \
                        u32x4 w00, w01, w10, w11; \
                        w00.x = cvt_pk_bf16(S0[0], S0[1]); w00.y = cvt_pk_bf16(S0[2], S0[3]); w00.z = cvt_pk_bf16(S0[4], S0[5]); w00.w = cvt_pk_bf16(S0[6], S0[7]); \
                        w01.x = cvt_pk_bf16(S0[8], S0[9]); w01.y = cvt_pk_bf16(S0[10], S0[11]); w01.z = cvt_pk_bf16(S0[12], S0[13]); w01.w = cvt_pk_bf16(S0[14], S0[15]); \
                        w10.x = cvt_pk_bf16(S1[0], S1[1]); w10.y = cvt_pk_bf16(S1[2], S1[3]); w10.z = cvt_pk_bf16(S1[4], S1[5]); w10.w = cvt_pk_bf16(S1[6], S1[7]); \
                        w11.x = cvt_pk_bf16(S1[8], S1[9]); w11.y = cvt_pk_bf16(S1[10], S1[11]); w11.z = cvt_pk_bf16(S1[12], S1[13]); w11.w = cvt_pk_bf16(S1[14], S1[15]); \
                        const bf16x8 sb00 = __builtin_bit_cast(bf16x8, w00), sb01 = __builtin_bit_cast(bf16x8, w01), sb10 = __builtin_bit_cast(bf16x8, w10), sb11 = __builtin_bit_cast(bf16x8, w11); \
                        n0 = __builtin_amdgcn_mfma_f32_32x32x16_bf16(gf[0][0][0], sb00, n0, 0, 0, 0); n1 = __builtin_amdgcn_mfma_f32_32x32x16_bf16(gf[1][0][0], sb00, n1, 0, 0, 0); \
                        n0 = __builtin_amdgcn_mfma_f32_32x32x16_bf16(gf[0][0][1], sb01, n0, 0, 0, 0); n1 = __builtin_amdgcn_mfma_f32_32x32x16_bf16(gf[1][0][1], sb01, n1, 0, 0, 0); \
                        n0 = __builtin_amdgcn_mfma_f32_32x32x16_bf16(gf[0][1][0], sb10, n0, 0, 0, 0); n1 = __builtin_amdgcn_mfma_f32_32x32x16_bf16(gf[1][1][0], sb10, n1, 0, 0, 0); \
                        n0 = __builtin_amdgcn_mfma_f32_32x32x16_bf16(gf[0][1][1], sb11, n0, 0, 0, 0); n1 = __builtin_amdgcn_mfma_f32_32x32x16_bf16(gf[1][1][1], sb11, n1, 0, 0, 0); \
                        { unsigned char* _sp = (unsigned char*)DD + ((size_t)(_r0 + l32) * DM + colb + 32 * vh) * 4 + 8 * hl; \
                          *(u32x2*)(_sp + 0) = (u32x2){w00.x, w00.y}; *(u32x2*)(_sp + 16) = (u32x2){w00.z, w00.w}; *(u32x2*)(_sp + 32) = (u32x2){w01.x, w01.y}; *(u32x2*)(_sp + 48) = (u32x2){w01.z, w01.w}; \
                          *(u32x2*)(_sp + 64) = (u32x2){w10.x, w10.y}; *(u32x2*)(_sp + 80) = (u32x2){w10.z, w10.w}; *(u32x2*)(_sp + 96) = (u32x2){w11.x, w11.y}; *(u32x2*)(_sp + 112) = (u32x2){w11.z, w11.w}; } \
                        _Pragma("unroll") for (int i = 0; i < 16; ++i) { S0[i] = S0[i] * dt_[0][i >> 2][i & 3] + n0[i]; S1[i] = S1[i] * dt_[1][i >> 2][i & 3] + n1[i]; } \
                    } while (0)
                    if (prompt) {
                        LAS float* dtl = (LAS float*)((LAS unsigned char*)lds);
                        LAS unsigned char* ring = (LAS unsigned char*)lds + 32768;
                        for (int i = lane; i < 128 * 16; i += 64) *(LAS f32x4*)(dtl + i * 4) = *(const f32x4*)(DTg + ((size_t)(chunk0 + (i >> 4)) * 32 + h) * 64 + (i & 15) * 4);
#define S2_DMA(cc) do { const int _r0 = (chunk0 + (cc)) * 64; LAS unsigned char* _s = ring + ((cc) & 3) * 16384; \
                            _Pragma("unroll") for (int j = 0; j < 8; ++j) { const int _row = 8 * j + (lane >> 3); const int _p = (lane & 7) ^ (_row & 7); \
                                __builtin_amdgcn_global_load_lds((const unsigned*)(Kb + (size_t)(_r0 + _row) * DM + colb + _p * 8), (LAS unsigned*)(_s + j * 1024), 16, 0, 0); } \
                            _Pragma("unroll") for (int j = 0; j < 8; ++j) { const int _row = 8 * j + (lane >> 3); \
                                __builtin_amdgcn_global_load_lds((const unsigned*)(DD + (size_t)(_r0 + _row) * DM + colb + 32 * vh + (lane & 7) * 4), (LAS unsigned*)(_s + 8192 + j * 1024), 16, 0, 0); } \
                        } while (0)
                        S2_DMA(0); S2_DMA(1);
#pragma unroll 1
                        for (int c = 0; c < 128; ++c) {
                            if (c + 2 < 128) { S2_DMA(c + 2); asm volatile("s_waitcnt vmcnt(32)" ::: "memory"); }
                            else if (c + 1 < 128) asm volatile("s_waitcnt vmcnt(16)" ::: "memory");
                            else asm volatile("s_waitcnt vmcnt(0)" ::: "memory");
                            LAS unsigned char* sl = ring + (c & 3) * 16384;
#pragma unroll
                            for (int mt = 0; mt < 2; ++mt)
#pragma unroll
                                for (int kt = 0; kt < 2; ++kt)
#pragma unroll
                                    for (int s2 = 0; s2 < 2; ++s2) {
                                        const int row = 32 * mt + l32, p = 4 * kt + 2 * s2;
                                        const u32x2 lo = *(const LAS u32x2*)(sl + row * 128 + ((p ^ (row & 7)) * 16) + 8 * hl);
                                        const u32x2 hi = *(const LAS u32x2*)(sl + row * 128 + (((p + 1) ^ (row & 7)) * 16) + 8 * hl);
                                        gf[mt][kt][s2] = __builtin_bit_cast(bf16x8, (u32x4){lo.x, lo.y, hi.x, hi.y});
                                    }
#pragma unroll
                            for (int i = 0; i < 16; ++i) { n0[i] = *(const LAS float*)(sl + 8192 + crow(i, hl) * 128 + l32 * 4); n1[i] = *(const LAS float*)(sl + 8192 + (32 + crow(i, hl)) * 128 + l32 * 4); }
#pragma unroll
                            for (int mt = 0; mt < 2; ++mt)
#pragma unroll
                                for (int g = 0; g < 4; ++g) dt_[mt][g] = *(const LAS f32x4*)(dtl + c * 64 + 32 * mt + 8 * g + 4 * hl);
                            S2_COMPUTE(c);
                        }
#undef S2_DMA
                    } else {
                        const int _r0 = chunk0 * 64; const size_t _item = (size_t)chunk0 * 32 + h;
#pragma unroll
                        for (int mt = 0; mt < 2; ++mt)
#pragma unroll
                            for (int kt = 0; kt < 2; ++kt)
#pragma unroll
                                for (int s2 = 0; s2 < 2; ++s2) {
                                    const size_t _o = (size_t)(_r0 + 32 * mt + l32) * DM + colb + 32 * kt + 16 * s2 + 4 * hl;
                                    const u32x2 _lo = *(const u32x2*)(Kb + _o), _hi = *(const u32x2*)(Kb + _o + 8); gf[mt][kt][s2] = __builtin_bit_cast(bf16x8, (u32x4){_lo.x, _lo.y, _hi.x, _hi.y}); }
#pragma unroll
                        for (int i = 0; i < 16; ++i) { n0[i] = DD[(size_t)(_r0 + crow(i, hl)) * DM + vcol]; n1[i] = DD[(size_t)(_r0 + 32 + crow(i, hl)) * DM + vcol]; }
#pragma unroll
                        for (int mt = 0; mt < 2; ++mt)
#pragma unroll
                            for (int g = 0; g < 4; ++g) dt_[mt][g] = *(const f32x4*)(DTg + _item * 64 + 32 * mt + 8 * g + 4 * hl);
                        S2_COMPUTE(0);
                    }
#undef S2_COMPUTE
                    float* so_ = OUTP + (prompt ? O_PWKV + ((((size_t)jl * 2 + b) * 32 + h) * 64 + (32 * vh + l32)) * 64
                                                : O_SWKV + ((((size_t)jl * 16 + b) * 32 + h) * 64 + (32 * vh + l32)) * 64);
#pragma unroll
                    for (int i = 0; i < 16; ++i) { so_[crow(i, hl)] = S0[i]; so_[32 + crow(i, hl)] = S1[i]; }
                }
            }
            fast_grid_barrier((unsigned*)ldp(tab, 40), tab);
            {
                PHASE_IDS BASES RWKV_PTRS
                const float* Obuf = (const float*)(RA + 272 * MiB); const float* RK = (const float*)(RB + 204 * MiB);
                const float* lnw = IN(28) + (size_t)jl * DM; const float* lnb = IN(29) + (size_t)jl * DM;
                const int l32 = lane & 31, hl = lane >> 5;
#pragma unroll 1
                for (int item = blockIdx.x; item < 8704; item += G) {
                    LAS unsigned char* ldsv = (LAS unsigned char*)lds; asm volatile("" : "+v"(ldsv));
                    LAS bf16_t* R2s = (LAS bf16_t*)(ldsv + 0); LAS bf16_t* STs = (LAS bf16_t*)(ldsv + 9216); LAS float* Os = (LAS float*)(ldsv + 18432);
                    const int chunk = item >> 5, h = item & 31, r0 = chunk * 64;
                    {
                        const int rr = tid >> 3, pc = tid & 7;
                        *(LAS u32x4*)(R2s + rr * 72 + pc * 8) = *(const u32x4*)(Rb + (size_t)(r0 + rr) * DM + h * 64 + pc * 8);
                        const unsigned char* sp = (const unsigned char*)DD + ((size_t)(r0 + (rr & 31)) * DM + h * 64 + 32 * (rr >> 5)) * 4 + pc * 16;
                        *(LAS u32x4*)(STs + rr * 72 + pc * 8) = *(const u32x4*)sp;
                    }
                    __syncthreads();
                    if (wave < 4) {
                        const int tt = wave >> 1, vt = wave & 1;
                        f32x16 acc;
#pragma unroll
                        for (int i = 0; i < 16; ++i) acc[i] = Obuf[(size_t)(r0 + 32 * tt + crow(i, hl)) * DM + h * 64 + 32 * vt + l32];
#pragma unroll
                        for (int ks = 0; ks < 4; ++ks) acc = __builtin_amdgcn_mfma_f32_32x32x16_bf16(*(const LAS bf16x8*)(R2s + (32 * tt + l32) * 72 + ks * 16 + hl * 8), *(const LAS bf16x8*)(STs + (32 * vt + l32) * 72 + ks * 16 + hl * 8), acc, 0, 0, 0);
#pragma unroll
                        for (int i = 0; i < 16; ++i) Os[(32 * tt + crow(i, hl)) * 68 + 32 * vt + l32] = acc[i];
                    }
                    __syncthreads();
                    {
                        const int st = tid >> 3, c0 = (tid & 7) * 8, col = h * 64 + c0; const size_t off = (size_t)(r0 + st) * DM + col;
                        const f32x4 o0 = *(const LAS f32x4*)(Os + st * 68 + c0), o1 = *(const LAS f32x4*)(Os + st * 68 + c0 + 4);
                        float o[8] = {o0[0], o0[1], o0[2], o0[3], o1[0], o1[1], o1[2], o1[3]};
                        float s = 0.f;
#pragma unroll
                        for (int i = 0; i < 8; ++i) s += o[i];
                        const float mu = sum8(s, lane) * (1.f / 64.f); float q = 0.f;
#pragma unroll
                        for (int i = 0; i < 8; ++i) { o[i] -= mu; q += o[i] * o[i]; }
                        const float rstd = rsqrtf(sum8(q, lane) * (1.f / 64.f) + 64e-5f);
                        float v[8], g8[8]; unpack8(*(const u32x4*)(Vb + off), v); unpack8(*(const u32x4*)(GG + off), g8);
                        if (jl > 0) { float vf[8], vg[8]; unpack8(*(const u32x4*)(VFIRST + off), vf); unpack8(*(const u32x4*)(VG + off), vg);
#pragma unroll
                            for (int i = 0; i < 8; ++i) v[i] = v[i] + (vf[i] - v[i]) * vg[i]; }
                        const float rk = RK[(size_t)(r0 + st) * 32 + h];
                        float y[8];
#pragma unroll
                        for (int i = 0; i < 8; ++i) y[i] = (o[i] * rstd * lnw[col + i] + lnb[col + i] + rk * v[i]) * g8[i];
                        *(u32x4*)(Y + off) = pack8(y);
                    }
                    __syncthreads();
                }
            }
            fast_grid_barrier((unsigned*)ldp(tab, 40), tab);
            {
                BASES RWKV_PTRS
                pg8::Gemm g{Y, WO, MROWS, 2048, 2048, 0, 0};
                pg8::StaticOrder S; S.init(g.M, g.N, G, (int)blockIdx.x, g.K, 4);
                pg8::Epi<FRes> E{FRes{X, (float*)(RA + 272 * MiB)}};
                pg8::gemm_phase(ldsl, g, S, E);
                fast_grid_barrier((unsigned*)ldp(tab, 40), tab);
                {
                    PHASE_IDS
                    const float* PART = (const float*)(RA + 272 * MiB); const int ntail = S.nwg - S.nFull;
                    if (S.S > 1) for (int idx = gtid; idx < ntail * 16384; idx += NT) {
                        const int tl = idx >> 14, r = (idx >> 6) & 255, c4 = idx & 63; int pm, pn; S.tile_pmpn(S.nFull + tl, pm, pn);
                        f32x4* xp = (f32x4*)(X + (size_t)(pm * 256 + r) * DM + pn * 256 + c4 * 4); f32x4 acc = *xp;
#pragma unroll
                        for (int part = 0; part < 4; ++part) acc += *(const f32x4*)(PART + (size_t)(part * 32 + tl) * 65536 + r * 256 + c4 * 4);
                        *xp = acc; }
                }
            }
            fast_grid_barrier((unsigned*)ldp(tab, 40), tab);
        } else {
            { PHASE_IDS BASES GLA_PTRS
            const float* gmix = IN(6) + (size_t)layer * DM;
            for (int row = gw; row < MROWS; row += NGW) {
                const f32x4* xr = (const f32x4*)(X + (size_t)row * DM) + lane; f32x4 x[8]; float ss = 0.f;
#pragma unroll
                for (int q = 0; q < 8; ++q) { x[q] = xr[64 * q]; ss += x[q][0] * x[q][0] + x[q][1] * x[q][1] + x[q][2] * x[q][2] + x[q][3] * x[q][3]; }
                const float rs = rsqrtf(wave_sum(ss, lane) * (1.f / DM) + 1e-6f);
#pragma unroll
                for (int q = 0; q < 8; ++q) { const f32x4 gg = *((const f32x4*)gmix + lane + 64 * q); const f32x4 h = x[q] * rs * gg;
                    u32x2 w; w.x = cvt_pk_bf16(h[0], h[1]); w.y = cvt_pk_bf16(h[2], h[3]); *((u32x2*)(H + (size_t)row * DM) + lane + 64 * q) = w; }
            } }
            fast_grid_barrier((unsigned*)ldp(tab, 40), tab);
            {
                BASES GLA_PTRS
                pg8::Gemm g{H, GI, MROWS, 6400, 2048, 0, 0};
                pg8::StaticOrder S; S.init(g.M, g.N, G, (int)blockIdx.x, g.K, 1);
                pg8::Epi<FG1> E{FG1{PROJ, LR}};
                pg8::gemm_phase(ldsl, g, S, E);
            }
            fast_grid_barrier((unsigned*)ldp(tab, 40), tab);
            {
                PHASE_IDS BASES GLA_PTRS
                float* lrS = (float*)lds;
                float* w2S = (float*)(lds + 4096);
                float* totS = (float*)(lds + 20480);
                bf16_t* qeS = (bf16_t*)(lds + 22528);
                bf16_t* keS = (bf16_t*)(lds + 22528 + 33792);
                bf16_t* vS = qeS;
                const float* gw2 = IN(31) + (size_t)jl * 16 * 1024; const float* gkb = IN(32) + (size_t)jl * 1024;
#pragma unroll 1
                for (int it = blockIdx.x; it < 1088; it += G) {
                    const int c = it >> 2, h = it & 3, r0 = c * 64; const size_t base = (size_t)it;
                    if (tid < 256) *(f32x4*)(lrS + tid * 4) = *(const f32x4*)(LR + (size_t)r0 * 16 + tid * 4);
                    for (int q = tid; q < 1024; q += 512) { const int r = q >> 6, cc = (q & 63) * 4; *(f32x4*)(w2S + r * 256 + cc) = *(const f32x4*)(gw2 + (size_t)r * 1024 + h * 256 + cc); }
                    __syncthreads();
                    const int d = tid & 255, half = tid >> 8;
                    float cumv[32];
                    {
                        float w[16];
#pragma unroll
                        for (int r = 0; r < 16; ++r) w[r] = w2S[r * 256 + d];
                        const float bb = gkb[h * 256 + d]; float run = 0.f;
#pragma unroll
                        for (int tt = 0; tt < 32; ++tt) {
                            const float* lp = lrS + (half * 32 + tt) * 16; float z = bb;
#pragma unroll
                            for (int r = 0; r < 16; ++r) z += lp[r] * w[r];
                            const float g = (fminf(z, 0.f) - log1pf(__expf(-fabsf(z)))) * 0.0625f;
                            run += g; cumv[tt] = run;
                        }
                        totS[half * 256 + d] = run;
                    }
                    __syncthreads();
                    {
                        const float t0 = totS[d], t1 = totS[256 + d]; const float last = t0 + t1, offc = half ? t0 : 0.f;
                        if (half == 0) EL[base * 256 + d] = __expf(last);
                        unsigned kdp[16];
#pragma unroll
                        for (int tt = 0; tt < 32; tt += 2) {
                            float kd2[2];
#pragma unroll
                            for (int e = 0; e < 2; ++e) {
                                const int t = half * 32 + tt + e; const float cum = cumv[tt + e] + offc;
                                const size_t po = (size_t)(r0 + t) * 6144 + h * 256 + d;
                                const float q = bf2f(PROJ[po]), k = bf2f(PROJ[po + 1024]);
                                const float qe = q * __expf(cum), ke = k * __expf(-cum); kd2[e] = k * __expf(last - cum);
                                const unsigned pq = cvt_pk_bf16(qe, ke);
                                qeS[t * 264 + d] = (bf16_t)(pq & 0xffffu); keS[t * 264 + d] = (bf16_t)(pq >> 16);
                                QE[((base * 8 + (d >> 5)) * 64 + t) * 32 + (d & 31)] = (bf16_t)(pq & 0xffffu);
                            }
                            kdp[tt >> 1] = cvt_pk_bf16(kd2[0], kd2[1]);
                        }
                        u32x4* kdst = (u32x4*)(KDT + (base * 256 + d) * 64 + half * 32);
                        kdst[0] = (u32x4){kdp[0], kdp[1], kdp[2], kdp[3]}; kdst[1] = (u32x4){kdp[4], kdp[5], kdp[6], kdp[7]};
                        kdst[2] = (u32x4){kdp[8], kdp[9], kdp[10], kdp[11]}; kdst[3] = (u32x4){kdp[12], kdp[13], kdp[14], kdp[15]};
                    }
                    __syncthreads();
                    if (wave < 4) {
                        const int mi = wave >> 1, ni = wave & 1, l32 = lane & 31, hl = lane >> 5;
                        f32x16 cacc;
#pragma unroll
                        for (int i = 0; i < 16; ++i) cacc[i] = 0.f;
#pragma unroll
                        for (int kk = 0; kk < 16; ++kk) {
                            const bf16x8 a = *(const bf16x8*)(qeS + (mi * 32 + l32) * 264 + kk * 16 + hl * 8);
                            const bf16x8 b = *(const bf16x8*)(keS + (ni * 32 + l32) * 264 + kk * 16 + hl * 8);
                            cacc = __builtin_amdgcn_mfma_f32_32x32x16_bf16(a, b, cacc, 0, 0, 0);
                        }
#pragma unroll
                        for (int i = 0; i < 16; ++i) { const int ii = mi * 32 + crow(i, hl), jj = ni * 32 + l32;
                            const float v = (jj <= ii) ? cacc[i] : 0.f; SC[base * 4096 + ii * 64 + jj] = (bf16_t)(cvt_pk_bf16(v, 0.f) & 0xffffu); }
                    }
                    __syncthreads();
                    for (int q = tid; q < 4096; q += 512) { const int t = q >> 6, cc = (q & 63) * 8;
                        *(u32x4*)(vS + t * 520 + cc) = *(const u32x4*)(PROJ + (size_t)(r0 + t) * 6144 + 2048 + h * 512 + cc); }
                    __syncthreads();
                    {
                        const int dv = tid; u32x4* vdst = (u32x4*)(VT + (base * 512 + dv) * 64);
#pragma unroll
                        for (int q = 0; q < 8; ++q) {
                            unsigned w[4];
#pragma unroll
                            for (int e = 0; e < 4; ++e) { const unsigned lo = vS[(q * 8 + 2 * e) * 520 + dv], hi = vS[(q * 8 + 2 * e + 1) * 520 + dv]; w[e] = lo | (hi << 16); }
                            vdst[q] = (u32x4){w[0], w[1], w[2], w[3]};
                        }
                    }
                    __syncthreads();
                }
            }
            fast_grid_barrier((unsigned*)ldp(tab, 40), tab);
            {
                PHASE_IDS BASES GLA_PTRS
                float* red = (float*)lds;
                const int l32 = lane & 31, hl = lane >> 5;
#pragma unroll 1
                for (int u = blockIdx.x; u < 1152; u += G) {
                    const bool prompt = u < 128; int b, h, s, cg0, nch, row0;
                    if (prompt) { const int pair = u & 7; b = pair >> 2; h = pair & 3; s = u >> 3; cg0 = b * 128; nch = 128; row0 = b * 8192; }
                    else { const int su = u - 128; b = su >> 6; h = (su >> 4) & 3; s = su & 15; cg0 = 256 + b; nch = 1; row0 = MPROMPT + b * 64; }
                    f32x16 S;
                    if (prompt) {
#pragma unroll
                        for (int i = 0; i < 16; ++i) S[i] = 0.f;
                    } else {
                        const float* s0 = IN(4) + ((((size_t)jl * 16 + b) * 4 + h) * 256) * 512;
#pragma unroll
                        for (int i = 0; i < 16; ++i) S[i] = s0[(size_t)(32 * wave + crow(i, hl)) * 512 + 32 * s + l32];
                    }
                    const int mtw = wave & 1, ksw = wave >> 1;
                    bf16x8 ka[4], vb[4], qf[2][2], scf; f32x4 el[4];
#define GL_LD_Q(cc) do { const size_t _base = (size_t)(cg0 + (cc)) * 4 + h; const int _r0 = row0 + (cc) * 64; const bf16_t* _sc = SC + _base * 4096; \
                        _Pragma("unroll") for (int mt = 0; mt < 2; ++mt) _Pragma("unroll") for (int s2 = 0; s2 < 2; ++s2) { const bf16_t* _pq = QE + ((_base * 8 + wave) * 64 + mt * 32 + l32) * 32 + 16 * s2 + 4 * hl; \
                            const u32x2 _lo = *(const u32x2*)_pq, _hi = *(const u32x2*)(_pq + 8); qf[mt][s2] = __builtin_bit_cast(bf16x8, (u32x4){_lo.x, _lo.y, _hi.x, _hi.y}); } \
                        scf = *(const bf16x8*)(_sc + (mtw * 32 + l32) * 64 + 16 * ksw + 8 * hl); } while (0)
#define GL_LD_E(cc) do { const size_t _base = (size_t)(cg0 + (cc)) * 4 + h; \
                        _Pragma("unroll") for (int g = 0; g < 4; ++g) el[g] = *(const f32x4*)(EL + _base * 256 + 32 * wave + 8 * g + 4 * hl); } while (0)
#define GL_LD_K(cc) do { const size_t _base = (size_t)(cg0 + (cc)) * 4 + h; const bf16_t* _kdt = KDT + _base * 256 * 64; const bf16_t* _vt = VT + _base * 512 * 64; \
                        _Pragma("unroll") for (int ks = 0; ks < 4; ++ks) { ka[ks] = *(const bf16x8*)(_kdt + (32 * wave + l32) * 64 + 16 * ks + 8 * hl); vb[ks] = *(const bf16x8*)(_vt + (32 * s + l32) * 64 + 16 * ks + 8 * hl); } } while (0)
                    GL_LD_Q(0); GL_LD_E(0); GL_LD_K(0);
                    f32x4 osum = (f32x4){0.f, 0.f, 0.f, 0.f}; float* optr = nullptr;
#pragma unroll 1
                    for (int c = 0; c < nch; ++c) {
                        const int r0 = row0 + c * 64; const int cn = (c + 1 < nch) ? c + 1 : c;
                        asm volatile("" : "+v"(vb[3]), "+v"(ka[3]));
                        if (c > 0) *(f32x4*)optr = osum;
                        u32x4 sp0, sp1;
                        sp0.x = cvt_pk_bf16(S[0], S[1]); sp0.y = cvt_pk_bf16(S[2], S[3]); sp0.z = cvt_pk_bf16(S[4], S[5]); sp0.w = cvt_pk_bf16(S[6], S[7]);
                        sp1.x = cvt_pk_bf16(S[8], S[9]); sp1.y = cvt_pk_bf16(S[10], S[11]); sp1.z = cvt_pk_bf16(S[12], S[13]); sp1.w = cvt_pk_bf16(S[14], S[15]);
                        const bf16x8 sb0 = __builtin_bit_cast(bf16x8, sp0), sb1 = __builtin_bit_cast(bf16x8, sp1);
                        const bf16x8 vbw = ksw == 0 ? vb[0] : ksw == 1 ? vb[1] : ksw == 2 ? vb[2] : vb[3];
#pragma unroll
                        for (int mt = 0; mt < 2; ++mt) { f32x16 oo;
#pragma unroll
                            for (int i = 0; i < 16; ++i) oo[i] = 0.f;
                            oo = __builtin_amdgcn_mfma_f32_32x32x16_bf16(qf[mt][0], sb0, oo, 0, 0, 0); oo = __builtin_amdgcn_mfma_f32_32x32x16_bf16(qf[mt][1], sb1, oo, 0, 0, 0);
                            if (mtw == mt) oo = __builtin_amdgcn_mfma_f32_32x32x16_bf16(scf, vbw, oo, 0, 0, 0);
#pragma unroll
                            for (int q = 0; q < 16; ++q) red[(wave * 32 + mt * 16 + q) * 64 + lane] = oo[q]; }
                        GL_LD_Q(cn);
#pragma unroll
                        for (int i = 0; i < 16; ++i) S[i] *= el[i >> 2][i & 3];
                        GL_LD_E(cn);
#pragma unroll
                        for (int ks = 0; ks < 4; ++ks) S = __builtin_amdgcn_mfma_f32_32x32x16_bf16(ka[ks], vb[ks], S, 0, 0, 0);
                        GL_LD_K(cn);
                        asm volatile("s_waitcnt lgkmcnt(0)" ::: "memory"); __builtin_amdgcn_s_barrier(); asm volatile("" ::: "memory");
                        { const int q = tid >> 4, lg = tid & 15; f32x4 sum = (f32x4){0.f, 0.f, 0.f, 0.f};
#pragma unroll
                          for (int w = 0; w < 8; ++w) sum += *(const f32x4*)(red + (w * 32 + q) * 64 + 4 * lg);
                          const int mt = q >> 4, reg = q & 15, L = 4 * lg; const int i = mt * 32 + crow(reg, L >> 5), dv = L & 31;
                          osum = sum; optr = O + (size_t)(r0 + i) * DM + h * 512 + 32 * s + dv; }
                        asm volatile("s_waitcnt lgkmcnt(0)" ::: "memory"); __builtin_amdgcn_s_barrier(); asm volatile("" ::: "memory");
                    }
                    *(f32x4*)optr = osum;
#undef GL_LD_Q
#undef GL_LD_E
#undef GL_LD_K
                    float* dst = OUTP + (prompt ? O_PGLA + ((((size_t)jl * 2 + b) * 4 + h) * 256) * 512 : O_SGLA + ((((size_t)jl * 16 + b) * 4 + h) * 256) * 512);
#pragma unroll
                    for (int i = 0; i < 16; ++i) dst[(size_t)(32 * wave + crow(i, hl)) * 512 + 32 * s + l32] = S[i];
                }
            }
            fast_grid_barrier((unsigned*)ldp(tab, 40), tab);
            {
                PHASE_IDS BASES GLA_PTRS
                const float* hn = IN(33) + (size_t)jl * 512;
                for (int row = gw; row < MROWS; row += NGW) {
#pragma unroll
                    for (int h = 0; h < 4; ++h) {
                        const float* op = O + (size_t)row * DM + h * 512 + lane * 8;
                        const f32x4 a = *(const f32x4*)op, b = *(const f32x4*)(op + 4);
                        float ss = a[0] * a[0] + a[1] * a[1] + a[2] * a[2] + a[3] * a[3] + b[0] * b[0] + b[1] * b[1] + b[2] * b[2] + b[3] * b[3];
                        const float rs = rsqrtf(wave_sum(ss, lane) * (1.f / 512.f) + 1e-5f);
                        float gt[8]; unpack8(*(const u32x4*)(PROJ + (size_t)row * 6144 + 4096 + h * 512 + lane * 8), gt);
                        const f32x4 n0 = *(const f32x4*)(hn + lane * 8), n1 = *(const f32x4*)(hn + lane * 8 + 4);
                        float y[8];
#pragma unroll
                        for (int i = 0; i < 4; ++i) { y[i] = a[i] * rs * n0[i] * (gt[i] * sigmoidf_(gt[i])); y[4 + i] = b[i] * rs * n1[i] * (gt[4 + i] * sigmoidf_(gt[4 + i])); }
                        *(u32x4*)(Y + (size_t)row * DM + h * 512 + lane * 8) = pack8(y);
                    }
                }
            }
            fast_grid_barrier((unsigned*)ldp(tab, 40), tab);
            {
                BASES GLA_PTRS
                pg8::Gemm g{Y, GO, MROWS, 2048, 2048, 0, 0};
                pg8::StaticOrder S; S.init(g.M, g.N, G, (int)blockIdx.x, g.K, 4);
                pg8::Epi<FRes> E{FRes{X, (float*)(RA + 272 * MiB)}};
                pg8::gemm_phase(ldsl, g, S, E);
                fast_grid_barrier((unsigned*)ldp(tab, 40), tab);
                {
                    PHASE_IDS
                    const float* PART = (const float*)(RA + 272 * MiB); const int ntail = S.nwg - S.nFull;
                    if (S.S > 1) for (int idx = gtid; idx < ntail * 16384; idx += NT) {
                        const int tl = idx >> 14, r = (idx >> 6) & 255, c4 = idx & 63; int pm, pn; S.tile_pmpn(S.nFull + tl, pm, pn);
                        f32x4* xp = (f32x4*)(X + (size_t)(pm * 256 + r) * DM + pn * 256 + c4 * 4); f32x4 acc = *xp;
#pragma unroll
                        for (int part = 0; part < 4; ++part) acc += *(const f32x4*)(PART + (size_t)(part * 32 + tl) * 65536 + r * 256 + c4 * 4);
                        *xp = acc; }
                }
            }
            fast_grid_barrier((unsigned*)ldp(tab, 40), tab);
        }
        {
            { PHASE_IDS BASES FFN_PTRS
            const float* gf = IN(7) + (size_t)layer * DM;
            for (int row = gw; row < MROWS; row += NGW) {
                const f32x4* xr = (const f32x4*)(X + (size_t)row * DM) + lane; f32x4 x[8]; float ss = 0.f;
#pragma unroll
                for (int q = 0; q < 8; ++q) { x[q] = xr[64 * q]; ss += x[q][0] * x[q][0] + x[q][1] * x[q][1] + x[q][2] * x[q][2] + x[q][3] * x[q][3]; }
                const float rs = rsqrtf(wave_sum(ss, lane) * (1.f / DM) + 1e-6f);
#pragma unroll
                for (int q = 0; q < 8; ++q) { const f32x4 gg = *((const f32x4*)gf + lane + 64 * q); const f32x4 h = x[q] * rs * gg;
                    u32x2 w; w.x = cvt_pk_bf16(h[0], h[1]); w.y = cvt_pk_bf16(h[2], h[3]); *((u32x2*)(H + (size_t)row * DM) + lane + 64 * q) = w; }
            } }
            fast_grid_barrier((unsigned*)ldp(tab, 40), tab);
            {
                BASES FFN_PTRS
                pg8::Gemm g{H, WU, MROWS, F2, 2048, 0, 0};
                pg8::StaticOrder S; S.init(g.M, g.N, G, (int)blockIdx.x, g.K, 1);
                pg8::Epi<FUp> E{FUp{U, OUTP + O_PCONV + (size_t)layer * 2 * 2 * F2, OUTP + O_SCONV + (size_t)layer * 16 * 2 * F2}};
                pg8::gemm_phase(ldsl, g, S, E);
            }
            fast_grid_barrier((unsigned*)ldp(tab, 40), tab);
            {
                PHASE_IDS BASES FFN_PTRS
                const float* cw = IN(36) + (size_t)layer * 3 * F2; const float* cb = IN(37) + (size_t)layer * F2;
                const float* cst = IN(5) + (size_t)layer * 16 * 2 * F2;
#pragma unroll 1
                for (int it = gtid; it < 544 * 704; it += NT) {
                    const int rc = it / 704, c8 = it - rc * 704, col = c8 * 8, r0 = rc * 32;
                    int t0, len, b; bool prompt; row_info(r0, t0, len, b, prompt);
                    float wv[3][8], wg[3][8], bv[8], bg[8];
#pragma unroll
                    for (int k = 0; k < 3; ++k) { const f32x4 a = *(const f32x4*)(cw + (size_t)k * F2 + col), a2 = *(const f32x4*)(cw + (size_t)k * F2 + col + 4);
                        const f32x4 g = *(const f32x4*)(cw + (size_t)k * F2 + FH + col), g2 = *(const f32x4*)(cw + (size_t)k * F2 + FH + col + 4);
#pragma unroll
                        for (int i = 0; i < 4; ++i) { wv[k][i] = a[i]; wv[k][4 + i] = a2[i]; wg[k][i] = g[i]; wg[k][4 + i] = g2[i]; } }
                    { const f32x4 a = *(const f32x4*)(cb + col), a2 = *(const f32x4*)(cb + col + 4), g = *(const f32x4*)(cb + FH + col), g2 = *(const f32x4*)(cb + FH + col + 4);
#pragma unroll
                      for (int i = 0; i < 4; ++i) { bv[i] = a[i]; bv[4 + i] = a2[i]; bg[i] = g[i]; bg[4 + i] = g2[i]; } }
                    float v2[8], v1[8], g2_[8], g1_[8];
                    if (t0 > 0) {
                        unpack8(*(const u32x4*)(U + (size_t)(r0 - 2) * F2 + col), v2); unpack8(*(const u32x4*)(U + (size_t)(r0 - 1) * F2 + col), v1);
                        unpack8(*(const u32x4*)(U + (size_t)(r0 - 2) * F2 + FH + col), g2_); unpack8(*(const u32x4*)(U + (size_t)(r0 - 1) * F2 + FH + col), g1_);
                    } else if (!prompt) {
                        const float* s0 = cst + ((size_t)b * 2) * F2 + col; const float* s1 = s0 + F2;
#pragma unroll
                        for (int i = 0; i < 8; ++i) { v2[i] = s0[i]; v1[i] = s1[i]; g2_[i] = s0[FH + i]; g1_[i] = s1[FH + i]; }
                    } else {
#pragma unroll
                        for (int i = 0; i < 8; ++i) { v2[i] = 0.f; v1[i] = 0.f; g2_[i] = 0.f; g1_[i] = 0.f; }
                    }
#pragma unroll 1
                    for (int rb = 0; rb < 32; rb += 8) {
                      u32x4 uv_[8], ug_[8];
#pragma unroll
                      for (int j = 0; j < 8; ++j) { uv_[j] = *(const u32x4*)(U + (size_t)(r0 + rb + j) * F2 + col); ug_[j] = *(const u32x4*)(U + (size_t)(r0 + rb + j) * F2 + FH + col); }
#pragma unroll
                      for (int j = 0; j < 8; ++j) {
                        const int r = rb + j;
                        float v0[8], g0[8];
                        unpack8(uv_[j], v0); unpack8(ug_[j], g0);
                        float y[8];
#pragma unroll
                        for (int i = 0; i < 8; ++i) {
                            const float cv = bv[i] + wv[0][i] * v2[i] + wv[1][i] * v1[i] + wv[2][i] * v0[i];
                            const float cg_ = bg[i] + wg[0][i] * g2_[i] + wg[1][i] * g1_[i] + wg[2][i] * g0[i];
                            y[i] = cg_ * sigmoidf_(cg_) * cv;
                            v2[i] = v1[i]; v1[i] = v0[i]; g2_[i] = g1_[i]; g1_[i] = g0[i];
                        }
                        *(u32x4*)(HID + (size_t)(r0 + r) * FH + col) = pack8(y);
                      }
                    }
                }
            }
            fast_grid_barrier((unsigned*)ldp(tab, 40), tab);
            {
                BASES FFN_PTRS
                pg8::Gemm g{HID, WD, MROWS, 2048, FH, 0, 0};
                pg8::StaticOrder S; S.init(g.M, g.N, G, (int)blockIdx.x, g.K, 4);
                pg8::Epi<FRes> E{FRes{X, (float*)(RA + 272 * MiB)}};
                pg8::gemm_phase(ldsl, g, S, E);
                fast_grid_barrier((unsigned*)ldp(tab, 40), tab);
                {
                    PHASE_IDS
                    const float* PART = (const float*)(RA + 272 * MiB); const int ntail = S.nwg - S.nFull;
                    if (S.S > 1) for (int idx = gtid; idx < ntail * 16384; idx += NT) {
                        const int tl = idx >> 14, r = (idx >> 6) & 255, c4 = idx & 63; int pm, pn; S.tile_pmpn(S.nFull + tl, pm, pn);
                        f32x4* xp = (f32x4*)(X + (size_t)(pm * 256 + r) * DM + pn * 256 + c4 * 4); f32x4 acc = *xp;
#pragma unroll
                        for (int part = 0; part < 4; ++part) acc += *(const f32x4*)(PART + (size_t)(part * 32 + tl) * 65536 + r * 256 + c4 * 4);
                        *xp = acc; }
                }
            }
            fast_grid_barrier((unsigned*)ldp(tab, 40), tab);
        }
    }
    {
        PHASE_IDS BASES
        const float* gn = IN(8);
        for (int row = gw; row < MROWS; row += NGW) {
            f32x4* xr = (f32x4*)(X + (size_t)row * DM) + lane; f32x4 x[8]; float ss = 0.f;
#pragma unroll
            for (int q = 0; q < 8; ++q) { x[q] = xr[64 * q]; ss += x[q][0] * x[q][0] + x[q][1] * x[q][1] + x[q][2] * x[q][2] + x[q][3] * x[q][3]; }
            const float rs = rsqrtf(wave_sum(ss, lane) * (1.f / DM) + 1e-6f);
#pragma unroll
            for (int q = 0; q < 8; ++q) { const f32x4 gg = *((const f32x4*)gn + lane + 64 * q); xr[64 * q] = x[q] * rs * gg; }
        }
    }
}

extern "C" void kernel_launch(void* const* d_in, const int* in_sizes, int n_in, void* d_out, int out_size, void* d_ws, size_t ws_size, hipStream_t stream) {
    static int grid = 0;
    if (grid == 0) {
        if (n_in != 39 || (size_t)out_size != O_TOTAL || ws_size < WS_END) {
            fprintf(stderr, "kernel_launch: unexpected shapes: n_in %d out %d ws %zu (need %zu)\n", n_in, out_size, ws_size, (size_t)WS_END); grid = -1; return; }
        int dev = 0, cus = 0, per_cu = 0;
        (void)hipGetDevice(&dev);
        (void)hipDeviceGetAttribute(&cus, hipDeviceAttributeMultiprocessorCount, dev);
        if (hipFuncSetAttribute((const void*)fwd_kernel, hipFuncAttributeMaxDynamicSharedMemorySize, LDS_BYTES) != hipSuccess) { fprintf(stderr, "kernel_launch: hipFuncSetAttribute failed\n"); grid = -1; return; }
        if (hipOccupancyMaxActiveBlocksPerMultiprocessor(&per_cu, (const void*)fwd_kernel, 512, LDS_BYTES) != hipSuccess || per_cu < 1) { fprintf(stderr, "kernel_launch: occupancy query says %d\n", per_cu); per_cu = 1; }
        (void)hipGetLastError();
        grid = cus * 1;
        if (grid <= 0) grid = 256;
    }
    if (grid < 0) return;
    P prm{};
    for (int i = 0; i < 39; ++i) prm.in[i] = (const float*)d_in[i];
    prm.out = (float*)d_out; prm.ws = (unsigned char*)d_ws;
    (void)hipMemsetAsync(d_ws, 0, 4096, stream);
    void* args[] = {&prm};
    hipError_t e = hipLaunchCooperativeKernel((const void*)fwd_kernel, dim3(grid), dim3(512), args, LDS_BYTES, stream);
    if (e != hipSuccess) fprintf(stderr, "cooperative launch failed: %s (grid %d)\n", hipGetErrorString(e), grid);
}
```

```cpp
#include <hip/hip_runtime.h>
#include <hip/hip_cooperative_groups.h>
#include <cstdio>
#include <cstdint>
namespace cg = cooperative_groups;

#define LAS __attribute__((address_space(3)))
typedef unsigned short bf16_t;
typedef short bf16x8 __attribute__((ext_vector_type(8)));
typedef float f32x4 __attribute__((ext_vector_type(4)));
typedef float f32x16 __attribute__((ext_vector_type(16)));
typedef unsigned u32x4 __attribute__((ext_vector_type(4)));
typedef unsigned u32x2 __attribute__((ext_vector_type(2)));

constexpr int DM = 2048, MROWS = 17408, MPROMPT = 16384;
constexpr int FH = 5632, F2 = 11264;
constexpr int LDS_BYTES = 147456;
constexpr size_t MiB = 1u << 20;
constexpr size_t WS_WT = 1 * MiB;
constexpr size_t WS_A = 411 * MiB;
constexpr size_t WS_B = 819 * MiB;
constexpr size_t WS_VF = 1227 * MiB;
constexpr size_t WS_END = 1295 * MiB;
constexpr size_t ACT = (size_t)MROWS * DM;
constexpr size_t RW_SZ = (size_t)7168 * 2048 + (size_t)8192 * 256 + (size_t)2048 * 2048;
constexpr size_t GW_SZ = (size_t)6400 * 2048 + (size_t)2048 * 2048;
constexpr size_t FW_SZ = (size_t)11264 * 2048 + (size_t)2048 * 5632;
constexpr size_t GW_OFF = 2 * RW_SZ, FW_OFF = GW_OFF + 2 * GW_SZ;
constexpr size_t O_PSHIFT = 35651584, O_PWKV = 35659776, O_PGLA = 36184064, O_PCONV = 38281216;
constexpr size_t O_SSHIFT = 38461440, O_SWKV = 38526976, O_SGLA = 42721280, O_SCONV = 59498496, O_TOTAL = 60940288;

__device__ __forceinline__ unsigned cvt_pk_bf16(float lo, float hi) { unsigned r; asm volatile("v_cvt_pk_bf16_f32 %0, %1, %2" : "=v"(r) : "v"(lo), "v"(hi)); return r; }
__device__ __forceinline__ float bf2f(bf16_t b) { return __builtin_bit_cast(float, (unsigned)b << 16); }
__device__ __forceinline__ float bflo(unsigned u) { return __builtin_bit_cast(float, u << 16); }
__device__ __forceinline__ float bfhi(unsigned u) { return __builtin_bit_cast(float, u & 0xffff0000u); }
__device__ __forceinline__ void unpack8(u32x4 w, float (&f)[8]) {
    f[0] = bflo(w.x); f[1] = bfhi(w.x); f[2] = bflo(w.y); f[3] = bfhi(w.y); f[4] = bflo(w.z); f[5] = bfhi(w.z); f[6] = bflo(w.w); f[7] = bfhi(w.w);
}
__device__ __forceinline__ u32x4 pack8(const float (&f)[8]) {
    u32x4 w; w.x = cvt_pk_bf16(f[0], f[1]); w.y = cvt_pk_bf16(f[2], f[3]); w.z = cvt_pk_bf16(f[4], f[5]); w.w = cvt_pk_bf16(f[6], f[7]); return w;
}
__device__ __forceinline__ float sigmoidf_(float x) { return 1.f / (1.f + __expf(-x)); }
__device__ __forceinline__ float shx(float v, int lane, int o) { return __builtin_bit_cast(float, __builtin_amdgcn_ds_bpermute((lane ^ o) << 2, __builtin_bit_cast(int, v))); }
__device__ __forceinline__ float wave_sum(float v, int lane) {
#pragma unroll
    for (int o = 1; o < 64; o <<= 1) v += shx(v, lane, o);
    return v;
}
__device__ __forceinline__ float sum8(float v, int lane) { v += shx(v, lane, 1); v += shx(v, lane, 2); v += shx(v, lane, 4); return v; }
__device__ __forceinline__ int crow(int reg, int h) { return (reg & 3) + 8 * (reg >> 2) + 4 * h; }

namespace pg8 {
constexpr int BM = 256, BK = 64, HALF = 128, HTB = HALF * BK * 2, STAGE_BYTES = 8 * HTB, NXCD = 8, WGM = 8;
__host__ __device__ __forceinline__ int lds_byte(int r, int c) { const int st = (r >> 4) * 2 + (c >> 5), rr = r & 15, cc = c & 31, ob = rr * 64 + cc * 2; return st * 1024 + (ob ^ (((ob >> 9) & 1) << 5)); }
__host__ __device__ __forceinline__ void stage_rc(int b, int& R, int& C) { const int st = b / 1024, sb = b % 1024, swz = sb ^ (((sb >> 9) & 1) << 5); R = (st >> 1) * 16 + swz / 64; C = (st & 1) * 32 + (swz % 64) / 2; }
__host__ __device__ __forceinline__ int perm32(int rho) { const int n = rho >> 4, i = rho & 15; return 8 * (i >> 2) + 4 * n + (i & 3); }

struct Unit { int pm, pn, kofs, knt, split; };
struct Gemm { const bf16_t* A; const bf16_t* Bt; int M, N, K; int mode; size_t astride; };
__device__ __forceinline__ const char* a_of(const Gemm& g, int pn) {
    int s = 0;
    if (g.mode == 1) s = pn < 8 ? 0 : pn < 16 ? 2 : pn < 24 ? 3 : pn == 24 ? 1 : pn == 25 ? 4 : pn == 26 ? 5 : 3;
    else if (g.mode == 2) s = pn >> 3;
    return (const char*)g.A + (size_t)s * g.astride;
}
struct StaticOrder {
    int nM, nN, nwg, G, c, nFull, S, ntK, total;
    __device__ __forceinline__ void init(int M, int N, int G_, int c_, int K = 0, int S_ = 1) { nM = M / BM; nN = N / BM; nwg = nM * nN; G = G_; c = c_; ntK = K / BK;
        nFull = (nwg / G) * G; S = S_; if (S_ <= 1 || nFull == nwg) { S = 1; nFull = nwg; } total = nFull + (nwg - nFull) * S; }
    __device__ __forceinline__ bool next(int i, Unit& u) const {
        const long L = (long)i * G + c; if (L >= total) return false;
        int wgid;
        if (L < nFull) { wgid = (int)L; u.kofs = 0; u.knt = ntK; u.split = 0; }
        else { const int j = (int)L - nFull; wgid = nFull + j / S; const int part = j % S; u.knt = ntK / S; u.kofs = part * u.knt * BK; u.split = 1 + part * 32 + j / S; }
        tile_pmpn(wgid, u.pm, u.pn); return true;
    }
    __device__ __forceinline__ void tile_pmpn(int wgid, int& pm, int& pn) const {
        { const int q = nwg / NXCD, r = nwg % NXCD, xcd = wgid % NXCD, off = wgid / NXCD; wgid = (xcd < r ? xcd * (q + 1) : r * (q + 1) + (xcd - r) * q) + off; }
        const int nig = WGM * nN, gid = wgid / nig, fm = gid * WGM, gsz = (nM - fm) < WGM ? (nM - fm) : WGM;
        pm = fm + ((wgid % nig) % gsz); pn = (wgid % nig) / gsz;
    }
};

template <class F> struct Epi {
    static constexpr bool PERM = true;
    F f;
    __device__ __forceinline__ void operator()(const f32x4 (&acc)[2][2][4][2], const Unit& u, int wr, int wc, int fr, int fq) const {
        { int t_ = threadIdx.x; asm volatile("" : "+v"(t_)); const int l_ = t_ & 63, w_ = __builtin_amdgcn_readfirstlane(t_ >> 6); fr = l_ & 15; fq = l_ >> 4; wr = w_ >> 2; wc = w_ & 3; }
        const int row0 = u.pm * BM + wr * 64 + fr, col0 = u.pn * BM + wc * 32 + 8 * fq;
#pragma unroll
        for (int ai = 0; ai < 2; ++ai)
#pragma unroll
            for (int m = 0; m < 4; ++m)
#pragma unroll
                for (int bj = 0; bj < 2; ++bj) f(row0 + ai * HALF + m * 16, col0 + bj * HALF, acc[ai][bj][m][0], acc[ai][bj][m][1], u.split);
    }
};

template <class EpiT>
__device__ __forceinline__ void gemm_phase(LAS unsigned char* lds, const Gemm g, const StaticOrder& S, const EpiT& E) {
    int tid = threadIdx.x; asm volatile("" : "+v"(tid));
    const int wid = __builtin_amdgcn_readfirstlane(tid >> 6), lane = tid & 63, wr = wid >> 2, wc = wid & 3, fr = lane & 15, fq = lane >> 4;
    const int K = g.K;
    unsigned voffA[2], voffB[2];
#pragma unroll
    for (int i = 0; i < 2; ++i) { int R, C; stage_rc(tid * 16 + i * 8192, R, C); const int Rb = EpiT::PERM ? ((R & ~31) + perm32(R & 31)) : R;
        voffA[i] = (unsigned)(R * K + C) * 2u; voffB[i] = (unsigned)(Rb * K + C) * 2u; }
    const size_t kstep = (size_t)(BK * 2);
    const size_t hstep = (size_t)HALF * K * 2;
    const size_t tstep = 2 * hstep;
    const unsigned ldsw = (unsigned)wid * 1024u;
    const int aoff = lds_byte(wr * 64 + fr, fq * 8), boff = lds_byte(wc * 32 + fr, fq * 8);
#define PG8_SA(b, h) (((b) * 2 + (h)) * HTB)
#define PG8_SB(b, h) ((4 + (b) * 2 + (h)) * HTB)
#define PG8_STAGE(bufoff, gbase, voff) do { _Pragma("unroll") for (int _i = 0; _i < 2; ++_i) \
        __builtin_amdgcn_global_load_lds((const unsigned*)((const char*)(gbase) + (voff)[_i]), (LAS unsigned*)(lds + (bufoff) + ldsw + _i * 8192), 16, 0, 0); } while (0)
#define PG8_LDA(dst, b, h) do { _Pragma("unroll") for (int m = 0; m < 4; ++m) _Pragma("unroll") for (int k = 0; k < 2; ++k) dst[m][k] = *(const LAS bf16x8*)(lds + PG8_SA(b, h) + aoff + m * 2048 + k * 1024); } while (0)
#define PG8_LDB(dst, b, h) do { _Pragma("unroll") for (int n = 0; n < 2; ++n) _Pragma("unroll") for (int k = 0; k < 2; ++k) dst[n][k] = *(const LAS bf16x8*)(lds + PG8_SB(b, h) + boff + n * 2048 + k * 1024); } while (0)
#define PG8_MMA(ai, bj, At, Bt) do { __builtin_amdgcn_s_setprio(1); _Pragma("unroll") for (int m = 0; m < 4; ++m) _Pragma("unroll") for (int n = 0; n < 2; ++n) _Pragma("unroll") for (int k = 0; k < 2; ++k) \
        acc[ai][bj][m][n] = __builtin_amdgcn_mfma_f32_16x16x32_bf16(Bt[n][k], At[m][k], acc[ai][bj][m][n], 0, 0, 0); __builtin_amdgcn_s_setprio(0); } while (0)
#define PG8_WAIT_V(n) asm volatile("s_waitcnt vmcnt(" #n ")" ::: "memory")
#define PG8_WAIT_L(n) asm volatile("s_waitcnt lgkmcnt(" #n ")" ::: "memory")
#define PG8_BAR __builtin_amdgcn_s_barrier()
#define PG8_SCHED __builtin_amdgcn_sched_barrier(0)
    Unit cur, nxt; int ui = 0;
    if (!S.next(0, cur)) return;
    f32x4 acc[2][2][4][2];
#pragma unroll
    for (int a = 0; a < 2; ++a)
#pragma unroll
        for (int b = 0; b < 2; ++b)
#pragma unroll
            for (int m = 0; m < 4; ++m)
#pragma unroll
                for (int n = 0; n < 2; ++n) acc[a][b][m][n] = (f32x4){0.f, 0.f, 0.f, 0.f};
    bf16x8 At[4][2], B0[2][2], B1[2][2];
    const char* cA = a_of(g, cur.pn) + (size_t)cur.pm * tstep + (size_t)cur.kofs * 2; const char* cB = (const char*)g.Bt + (size_t)cur.pn * tstep + (size_t)cur.kofs * 2;
    PG8_STAGE(PG8_SB(0, 0), cB, voffB); PG8_STAGE(PG8_SB(0, 1), cB + hstep, voffB); PG8_STAGE(PG8_SA(0, 0), cA, voffA); PG8_STAGE(PG8_SA(0, 1), cA + hstep, voffA);
    if (wr == 1) PG8_BAR;
    PG8_WAIT_V(2); PG8_BAR;
    PG8_STAGE(PG8_SB(1, 0), cB + kstep, voffB); PG8_STAGE(PG8_SA(1, 0), cA + kstep, voffA); PG8_STAGE(PG8_SB(1, 1), cB + hstep + kstep, voffB);
    PG8_WAIT_V(6); PG8_BAR;
    for (;;) {
        const bool has_next = S.next(ui + 1, nxt);
        const char* nA = has_next ? a_of(g, nxt.pn) + (size_t)nxt.pm * tstep + (size_t)nxt.kofs * 2 : cA; const char* nB = has_next ? (const char*)g.Bt + (size_t)nxt.pn * tstep + (size_t)nxt.kofs * 2 : cB;
        const int nt = cur.knt;
        for (int t = 0; t < nt; t += 2) {
            const bool last = (t == nt - 2);
            const char* a1 = cA + (size_t)(t + 1) * kstep;
            const char* a2 = last ? nA : cA + (size_t)(t + 2) * kstep; const char* b2 = last ? nB : cB + (size_t)(t + 2) * kstep;
            const char* a3 = a2 + kstep; const char* b3 = b2 + kstep;
            PG8_LDB(B0, 0, 0); PG8_LDB(B1, 0, 1); PG8_SCHED; PG8_LDA(At, 0, 0); PG8_STAGE(PG8_SA(1, 1), a1 + hstep, voffA);
            PG8_WAIT_V(8); PG8_WAIT_L(0); PG8_BAR; PG8_MMA(0, 0, At, B0); PG8_MMA(0, 1, At, B1); PG8_BAR; PG8_SCHED;
            PG8_LDA(At, 0, 1); PG8_STAGE(PG8_SB(0, 0), b2, voffB); PG8_STAGE(PG8_SB(0, 1), b2 + hstep, voffB); PG8_STAGE(PG8_SA(0, 0), a2, voffA);
            PG8_WAIT_V(8); PG8_WAIT_L(0); PG8_BAR; PG8_MMA(1, 0, At, B0); PG8_MMA(1, 1, At, B1); PG8_BAR; PG8_SCHED;
            PG8_LDB(B0, 1, 0); PG8_LDB(B1, 1, 1); PG8_SCHED; PG8_LDA(At, 1, 0); PG8_STAGE(PG8_SA(0, 1), a2 + hstep, voffA);
            PG8_WAIT_V(8); PG8_WAIT_L(0); PG8_BAR; PG8_MMA(0, 0, At, B0); PG8_MMA(0, 1, At, B1); PG8_BAR; PG8_SCHED;
            PG8_LDA(At, 1, 1); PG8_STAGE(PG8_SB(1, 0), b3, voffB); PG8_STAGE(PG8_SB(1, 1), b3 + hstep, voffB); PG8_STAGE(PG8_SA(1, 0), a3, voffA);
            PG8_WAIT_V(8); PG8_WAIT_L(0); PG8_BAR; PG8_MMA(1, 0, At, B0); PG8_MMA(1, 1, At, B1); PG8_BAR; PG8_SCHED;
        }
        if (wr == 0) PG8_BAR;
        E(acc, cur, wr, wc, fr, fq);
        if (!has_next) break;
#pragma unroll
        for (int a = 0; a < 2; ++a)
#pragma unroll
            for (int b = 0; b < 2; ++b)
#pragma unroll
                for (int m = 0; m < 4; ++m)
#pragma unroll
                    for (int n = 0; n < 2; ++n) acc[a][b][m][n] = (f32x4){0.f, 0.f, 0.f, 0.f};
        cur = nxt; cA = nA; cB = nB; ++ui;
        if (wr == 1) PG8_BAR;
    }
    PG8_WAIT_V(0);
    PG8_BAR;
#undef PG8_SA
#undef PG8_SB
#undef PG8_STAGE
#undef PG8_LDA
#undef PG8_LDB
#undef PG8_MMA
#undef PG8_WAIT_V
#undef PG8_WAIT_L
#undef PG8_BAR
#undef PG8_SCHED
}
}

__device__ __forceinline__ void store8bf(bf16_t* p, f32x4 a, f32x4 b) {
    u32x4 w; w.x = cvt_pk_bf16(a[0], a[1]); w.y = cvt_pk_bf16(a[2], a[3]); w.z = cvt_pk_bf16(b[0], b[1]); w.w = cvt_pk_bf16(b[2], b[3]);
    *(u32x4*)p = w;
}
struct FRes { float* X; float* PART;
    __device__ __forceinline__ void operator()(int row, int col, f32x4 a, f32x4 b, int split) const {
        float* p = X + (size_t)row * DM + col;
        if (split) { float* q = PART + (size_t)(split - 1) * 65536 + (row & 255) * 256 + (col & 255); *(f32x4*)q = a; *(f32x4*)(q + 4) = b; }
        else { f32x4 x0 = *(f32x4*)p, x1 = *(f32x4*)(p + 4); *(f32x4*)p = x0 + a; *(f32x4*)(p + 4) = x1 + b; } } };
struct FR1 { bf16_t *R, *K, *V, *L;
    __device__ __forceinline__ void operator()(int row, int col, f32x4 a, f32x4 b, int) const {
        if (col < 6144) { const int g = col >> 11; const size_t o = (size_t)row * DM + (col & 2047); if (g == 0) store8bf(R + o, a, b); else if (g == 1) store8bf(K + o, a, b); else store8bf(V + o, a, b); }
        else { const int t = (col - 6144) >> 8, c = col & 255;
            if (t == 0) { for (int i = 0; i < 4; ++i) { a[i] = 1.f - 2.f / (1.f + __expf(2.f * a[i])); b[i] = 1.f - 2.f / (1.f + __expf(2.f * b[i])); } }
            else if (t == 2) { for (int i = 0; i < 4; ++i) { a[i] = sigmoidf_(a[i]); b[i] = sigmoidf_(b[i]); } }
            store8bf(L + (size_t)t * MROWS * 256 + (size_t)row * 256 + c, a, b); } } };
__device__ __forceinline__ float decay_of(float z) { return -0.60653065971f / (1.f + __expf(-z)); }
struct FR2 { float* DD; bf16_t *AA, *GG, *VG; const float *w0, *a0, *v0;
    __device__ __forceinline__ void operator()(int row, int col, f32x4 a, f32x4 b, int) const {
        const int g = col >> 11, c = col & 2047; const size_t off = (size_t)row * DM + c;
        if (g == 0) { f32x4 z0 = *(const f32x4*)(w0 + c), z1 = *(const f32x4*)(w0 + c + 4); a += z0; b += z1;
            for (int i = 0; i < 4; ++i) { a[i] = decay_of(a[i]); b[i] = decay_of(b[i]); }
            *(f32x4*)(DD + off) = a; *(f32x4*)(DD + off + 4) = b; }
        else if (g == 1) { f32x4 z0 = *(const f32x4*)(a0 + c), z1 = *(const f32x4*)(a0 + c + 4); a += z0; b += z1;
            for (int i = 0; i < 4; ++i) { a[i] = sigmoidf_(a[i]); b[i] = sigmoidf_(b[i]); } store8bf(AA + off, a, b); }
        else if (g == 2) { store8bf(GG + off, a, b); }
        else { f32x4 z0 = *(const f32x4*)(v0 + c), z1 = *(const f32x4*)(v0 + c + 4); a += z0; b += z1;
            for (int i = 0; i < 4; ++i) { a[i] = sigmoidf_(a[i]); b[i] = sigmoidf_(b[i]); } store8bf(VG + off, a, b); } } };
struct FG1 { bf16_t* PROJ; float* LR;
    __device__ __forceinline__ void operator()(int row, int col, f32x4 a, f32x4 b, int) const {
        if (col < 6144) { if (col < 1024) { a *= 0.0625f; b *= 0.0625f; } store8bf(PROJ + (size_t)row * 6144 + col, a, b); }
        else if (col < 6160) { float* p = LR + (size_t)row * 16 + (col - 6144); *(f32x4*)p = a; *(f32x4*)(p + 4) = b; } } };
struct FUp { bf16_t* U; float* pconv; float* sconv;
    __device__ __forceinline__ void operator()(int row, int col, f32x4 a, f32x4 b, int) const {
        store8bf(U + (size_t)row * F2 + col, a, b);
        if (row < MPROMPT) { const int t = row & 8191; if (t >= 8190) { float* p = pconv + ((size_t)((row >> 13) * 2 + (t - 8190))) * F2 + col; *(f32x4*)p = a; *(f32x4*)(p + 4) = b; } }
        else { const int rr = row - MPROMPT, t = rr & 63; if (t >= 62) { float* p = sconv + ((size_t)((rr >> 6) * 2 + (t - 62))) * F2 + col; *(f32x4*)p = a; *(f32x4*)(p + 4) = b; } } } };

__device__ __forceinline__ void tr_item(const float* W, int K, int N, bf16_t* WT, int Kpad, int Npad, float* scr, int item, int lane) {
    const int nblk = Npad / 64, kb = item / nblk, nb = item % nblk, k0 = 64 * kb, n0 = 64 * nb;
    const int n4 = n0 + (lane & 15) * 4;
    f32x4 v[16];
#pragma unroll
    for (int i = 0; i < 16; ++i) { const int k = k0 + 4 * i + (lane >> 4); v[i] = (k < K && n4 < N) ? *(const f32x4*)(W + (size_t)k * N + n4) : (f32x4){0.f, 0.f, 0.f, 0.f}; }
#pragma unroll
    for (int i = 0; i < 16; ++i) { float* d = scr + (4 * i + (lane >> 4)) * 65 + (lane & 15) * 4; d[0] = v[i][0]; d[1] = v[i][1]; d[2] = v[i][2]; d[3] = v[i][3]; }
    asm volatile("s_waitcnt lgkmcnt(0)" ::: "memory");
    const int c = lane & 7;
#pragma unroll
    for (int j = 0; j < 8; ++j) { const int nn = (lane >> 3) + 8 * j; const float* s = scr + (8 * c) * 65 + nn;
        u32x4 o; o.x = cvt_pk_bf16(s[0 * 65], s[1 * 65]); o.y = cvt_pk_bf16(s[2 * 65], s[3 * 65]); o.z = cvt_pk_bf16(s[4 * 65], s[5 * 65]); o.w = cvt_pk_bf16(s[6 * 65], s[7 * 65]);
        *(u32x4*)(WT + (size_t)(n0 + nn) * Kpad + k0 + 8 * c) = o; }
    asm volatile("s_waitcnt lgkmcnt(0)" ::: "memory");
}

struct P { const float* in[39]; float* out; unsigned char* ws; };

__device__ __forceinline__ void row_info(int row, int& t, int& len, int& b, bool& prompt) {
    if (row < MPROMPT) { prompt = true; b = row >> 13; t = row & 8191; len = 8192; }
    else { prompt = false; const int rr = row - MPROMPT; b = rr >> 6; t = rr & 63; len = 64; }
}

__device__ __forceinline__ const float* ldp(const unsigned long long* tab, int i) {
    const unsigned long long v = tab[i];
    const unsigned lo = __builtin_amdgcn_readfirstlane((unsigned)v), hi = __builtin_amdgcn_readfirstlane((unsigned)(v >> 32));
    const __attribute__((address_space(1))) float* g = (const __attribute__((address_space(1))) float*)(((unsigned long long)hi << 32) | lo);
    return (const float*)g;
}
__device__ __forceinline__ void fast_grid_barrier(unsigned* bar, unsigned long long* tab) {
    asm volatile("s_waitcnt vmcnt(0)" ::: "memory");
    __syncthreads();
    if (threadIdx.x == 0) {
        const unsigned G = gridDim.x, grp = blockIdx.x & 7u;
        const unsigned epoch = (unsigned)tab[41] + 1u; tab[41] = epoch;
        const unsigned ngrp = (G - grp + 7u) >> 3, ntop = G < 8u ? G : 8u;
        __builtin_amdgcn_fence(__ATOMIC_RELEASE, "agent");
        asm volatile("s_waitcnt vmcnt(0)" ::: "memory");
        const unsigned old = __hip_atomic_fetch_add(&bar[64u * (1u + grp)], 1u, __ATOMIC_RELAXED, __HIP_MEMORY_SCOPE_AGENT);
        if (old + 1u == epoch * ngrp) (void)__hip_atomic_fetch_add(&bar[0], 1u, __ATOMIC_RELAXED, __HIP_MEMORY_SCOPE_AGENT);
        while (__hip_atomic_load(&bar[0], __ATOMIC_RELAXED, __HIP_MEMORY_SCOPE_AGENT) < epoch * ntop) __builtin_amdgcn_s_sleep(1);
        __builtin_amdgcn_fence(__ATOMIC_ACQUIRE, "agent");
        asm volatile("s_waitcnt vmcnt(0)" ::: "memory");
    }
    __syncthreads();
}
#define IN(k) ldp(tab, (k))
#define OUTP ((float*)ldp(tab, 39))
#define BASES float* X = (float*)ldp(tab, 39); unsigned char* ws_ = (unsigned char*)ldp(tab, 40); bf16_t* WT = (bf16_t*)(ws_ + WS_WT); unsigned char* RA = ws_ + WS_A; unsigned char* RB = ws_ + WS_B; \
    bf16_t* VFIRST = (bf16_t*)(ws_ + WS_VF); LAS unsigned char* ldsl = (LAS unsigned char*)lds; (void)X; (void)WT; (void)RA; (void)RB; (void)VFIRST; (void)ldsl;
#define RWKV_PTRS bf16_t* HB = (bf16_t*)RA; bf16_t* Rb = (bf16_t*)RB; bf16_t* Kb = Rb + ACT; bf16_t* Vb = (jl == 0) ? VFIRST : Kb + ACT; bf16_t* Lb = (bf16_t*)(RB + 204 * MiB); \
    float* DD = (float*)(RB + 240 * MiB); bf16_t* AA = (bf16_t*)RA; bf16_t* VG = AA + ACT; bf16_t* GG = VG + ACT; bf16_t* Y = GG + ACT; \
    bf16_t* W1 = WT + jl * RW_SZ; bf16_t* W2 = W1 + (size_t)7168 * 2048; bf16_t* WO = W2 + (size_t)8192 * 256; \
    (void)HB; (void)Rb; (void)Kb; (void)Vb; (void)Lb; (void)DD; (void)AA; (void)VG; (void)GG; (void)Y; (void)W1; (void)W2; (void)WO;
#define GLA_PTRS bf16_t* H = (bf16_t*)RB; float* LR = (float*)(RB + 68 * MiB); float* O = (float*)(RB + 70 * MiB); bf16_t* Y = (bf16_t*)(RB + 206 * MiB); \
    bf16_t* PROJ = (bf16_t*)RA; bf16_t* QE = (bf16_t*)(RA + 204 * MiB); bf16_t* KDT = (bf16_t*)(RA + 238 * MiB); bf16_t* VT = (bf16_t*)(RA + 272 * MiB); \
    bf16_t* SC = (bf16_t*)(RA + 340 * MiB); float* EL = (float*)(RA + 349 * MiB); bf16_t* GI = WT + GW_OFF + jl * GW_SZ; bf16_t* GO = GI + (size_t)6400 * 2048; \
    (void)H; (void)LR; (void)O; (void)Y; (void)PROJ; (void)QE; (void)KDT; (void)VT; (void)SC; (void)EL; (void)GI; (void)GO;
#define FFN_PTRS bf16_t* H = (bf16_t*)RB; bf16_t* HID = (bf16_t*)(RB + 68 * MiB); bf16_t* U = (bf16_t*)RA; bf16_t* WU = WT + FW_OFF + layer * FW_SZ; bf16_t* WD = WU + (size_t)F2 * 2048; \
    (void)H; (void)HID; (void)U; (void)WU; (void)WD;

__global__ void __launch_bounds__(512, 2) fwd_kernel(P p) {
    extern __shared__ __attribute__((aligned(16))) unsigned char lds[];
    cg::grid_group grid = cg::this_grid();
    const int G = gridDim.x, NGW = G * 8, NT = G * 512;
#define PHASE_IDS int tid = threadIdx.x; asm volatile("" : "+v"(tid)); const int lane = tid & 63; const int wave = __builtin_amdgcn_readfirstlane(tid >> 6); const int gw = blockIdx.x * 8 + wave; const int gtid = blockIdx.x * 512 + tid; (void)lane; (void)gw; (void)gtid;
    unsigned long long* tab = (unsigned long long*)(lds + LDS_BYTES - 512);
    if (threadIdx.x == 0) {
#pragma unroll
        for (int i = 0; i < 39; ++i) tab[i] = (unsigned long long)p.in[i];
        tab[39] = (unsigned long long)p.out; tab[40] = (unsigned long long)p.ws; tab[41] = 0ull;
    }
    __syncthreads();

    {
        PHASE_IDS BASES
        float* scr = (float*)(lds + wave * 16896);
#define TR(src, K, N, dst, Kpad, Npad) do { const int _ni = ((Kpad) / 64) * ((Npad) / 64); for (int it = gw; it < _ni; it += NGW) tr_item((src), (K), (N), (dst), (Kpad), (Npad), scr, it, lane); } while (0)
#pragma unroll 1
        for (int j = 0; j < 2; ++j) {
            bf16_t* W1 = WT + j * RW_SZ; bf16_t* W2 = W1 + (size_t)7168 * 2048; bf16_t* WO = W2 + (size_t)8192 * 256;
            TR(IN(24) + (size_t)j * DM * DM, 2048, 2048, W1, 2048, 2048);
            TR(IN(25) + (size_t)j * DM * DM, 2048, 2048, W1 + (size_t)2048 * 2048, 2048, 2048);
            TR(IN(26) + (size_t)j * DM * DM, 2048, 2048, W1 + (size_t)4096 * 2048, 2048, 2048);
            TR(IN(11) + (size_t)j * DM * 96, 2048, 96, W1 + (size_t)6144 * 2048, 2048, 256);
            TR(IN(14) + (size_t)j * DM * 96, 2048, 96, W1 + (size_t)6400 * 2048, 2048, 256);
            TR(IN(19) + (size_t)j * DM * 256, 2048, 256, W1 + (size_t)6656 * 2048, 2048, 256);
            if (j >= 1) TR(IN(17) + (size_t)(j - 1) * DM * 64, 2048, 64, W1 + (size_t)6912 * 2048, 2048, 256);
            TR(IN(12) + (size_t)j * 96 * DM, 96, 2048, W2, 256, 2048);
            TR(IN(15) + (size_t)j * 96 * DM, 96, 2048, W2 + (size_t)2048 * 256, 256, 2048);
            TR(IN(20) + (size_t)j * 256 * DM, 256, 2048, W2 + (size_t)4096 * 256, 256, 2048);
            if (j >= 1) TR(IN(18) + (size_t)(j - 1) * 64 * DM, 64, 2048, W2 + (size_t)6144 * 256, 256, 2048);
            TR(IN(27) + (size_t)j * DM * DM, 2048, 2048, WO, 2048, 2048);
            bf16_t* GI = WT + GW_OFF + j * GW_SZ; bf16_t* GO = GI + (size_t)6400 * 2048;
            TR(IN(30) + (size_t)j * DM * 6160, 2048, 6160, GI, 2048, 6400);
            TR(IN(34) + (size_t)j * DM * DM, 2048, 2048, GO, 2048, 2048);
        }
#pragma unroll 1
        for (int i = 0; i < 4; ++i) {
            bf16_t* WU = WT + FW_OFF + i * FW_SZ; bf16_t* WD = WU + (size_t)F2 * 2048;
            TR(IN(35) + (size_t)i * DM * F2, 2048, F2, WU, 2048, F2);
            TR(IN(38) + (size_t)i * FH * DM, FH, 2048, WD, FH, 2048);
        }
#undef TR
        const f32x4* xp = (const f32x4*)IN(0); const f32x4* xs = (const f32x4*)IN(1); f32x4* xo = (f32x4*)X;
        const int NP4 = MPROMPT * DM / 4, NA4 = MROWS * DM / 4;
#pragma unroll 4
        for (int i = gtid; i < NA4; i += NT) xo[i] = i < NP4 ? xp[i] : xs[i - NP4];
    }
    grid.sync();

#pragma clang loop unroll(full)
    for (int layer = 0; layer < 4; ++layer) {
        const int jl = layer >> 1;
        if ((layer & 1) == 0) {
            {
                PHASE_IDS BASES RWKV_PTRS
                const float* gmix = IN(6) + (size_t)layer * DM;
                const float* mix = IN(9) + (size_t)jl * 6 * DM;
                const float* sst = IN(2) + (size_t)jl * 16 * DM;
                for (int row = gw; row < MROWS; row += NGW) {
                    int t, len, b; bool prompt; row_info(row, t, len, b, prompt);
                    const f32x4* xr = (const f32x4*)(X + (size_t)row * DM) + lane;
                    f32x4 x[8]; float ss = 0.f;
#pragma unroll
                    for (int q = 0; q < 8; ++q) { x[q] = xr[64 * q]; ss += x[q][0] * x[q][0] + x[q][1] * x[q][1] + x[q][2] * x[q][2] + x[q][3] * x[q][3]; }
                    const float rs = rsqrtf(wave_sum(ss, lane) * (1.f / DM) + 1e-6f);
                    f32x4 hp[8];
                    if (t > 0) {
                        const f32x4* xq = (const f32x4*)(X + (size_t)(row - 1) * DM) + lane; float s2 = 0.f;
#pragma unroll
                        for (int q = 0; q < 8; ++q) { hp[q] = xq[64 * q]; s2 += hp[q][0] * hp[q][0] + hp[q][1] * hp[q][1] + hp[q][2] * hp[q][2] + hp[q][3] * hp[q][3]; }
                        const float rp = rsqrtf(wave_sum(s2, lane) * (1.f / DM) + 1e-6f);
#pragma unroll
                        for (int q = 0; q < 8; ++q) { const f32x4 gg = *((const f32x4*)gmix + lane + 64 * q); hp[q] = hp[q] * rp * gg; }
                    } else if (!prompt) {
#pragma unroll
                        for (int q = 0; q < 8; ++q) hp[q] = *((const f32x4*)(sst + (size_t)b * DM) + lane + 64 * q);
                    } else {
#pragma unroll
                        for (int q = 0; q < 8; ++q) hp[q] = (f32x4){0.f, 0.f, 0.f, 0.f};
                    }
                    const bool lastrow = (t == len - 1);
                    float* shout = OUTP + (prompt ? O_PSHIFT + ((size_t)jl * 2 + b) * DM : O_SSHIFT + ((size_t)jl * 16 + b) * DM);
#pragma unroll
                    for (int q = 0; q < 8; ++q) {
                        const f32x4 gg = *((const f32x4*)gmix + lane + 64 * q);
                        const f32x4 h = x[q] * rs * gg; const f32x4 dlt = hp[q] - h;
                        if (lastrow) *((f32x4*)shout + lane + 64 * q) = h;
#pragma unroll
                        for (int m = 0; m < 6; ++m) {
                            const f32x4 mx = *((const f32x4*)(mix + (size_t)m * DM) + lane + 64 * q);
                            const f32x4 o = h + dlt * mx;
                            u32x2 w; w.x = cvt_pk_bf16(o[0], o[1]); w.y = cvt_pk_bf16(o[2], o[3]);
                            *((u32x2*)(HB + (size_t)m * ACT + (size_t)row * DM) + lane + 64 * q) = w;
                        }
                    }
                }
            }
            fast_grid_barrier((unsigned*)ldp(tab, 40), tab);
            {
                BASES RWKV_PTRS
                pg8::Gemm g{HB, W1, MROWS, jl == 0 ? 6912 : 7168, 2048, 1, ACT * 2};
                pg8::StaticOrder S; S.init(g.M, g.N, G, (int)blockIdx.x, g.K, 1);
                pg8::Epi<FR1> E{FR1{Rb, Kb, Vb, Lb}};
                pg8::gemm_phase(ldsl, g, S, E);
            }
            fast_grid_barrier((unsigned*)ldp(tab, 40), tab);
            {
                BASES RWKV_PTRS
                pg8::Gemm g{Lb, W2, MROWS, jl == 0 ? 6144 : 8192, 256, 2, (size_t)MROWS * 256 * 2};
                pg8::StaticOrder S; S.init(g.M, g.N, G, (int)blockIdx.x, g.K, 1);
                pg8::Epi<FR2> E{FR2{DD, AA, GG, VG, IN(10) + (size_t)jl * DM, IN(13) + (size_t)jl * DM, IN(16) + (size_t)(jl > 0 ? jl - 1 : 0) * DM}};
                pg8::gemm_phase(ldsl, g, S, E);
            }
            fast_grid_barrier((unsigned*)ldp(tab, 40), tab);
            {
                PHASE_IDS BASES RWKV_PTRS
                float* Obuf = (float*)(RA + 272 * MiB); float* RK = (float*)(RB + 204 * MiB); float* DTg = (float*)(RB + 208 * MiB);
                const float* k_k = IN(21) + (size_t)jl * DM; const float* k_a = IN(22) + (size_t)jl * DM; const float* r_k = IN(23) + (size_t)jl * DM;
                const int l32 = lane & 31, hl = lane >> 5;
#define S1_BAR do { asm volatile("s_waitcnt lgkmcnt(0)" ::: "memory"); __builtin_amdgcn_s_barrier(); asm volatile("" ::: "memory"); } while (0)
                const int st = tid >> 3, c0 = (tid & 7) * 8;
                u32x4 pr_, pk_, pv_, pa_, pvf_ = (u32x4){0u, 0u, 0u, 0u}, pvg_ = (u32x4){0u, 0u, 0u, 0u}; f32x4 pd0_, pd1_;
#define S1_FETCH(it) do { const size_t _off = (size_t)(((it) >> 5) * 64 + st) * DM + ((it) & 31) * 64 + c0; \
                    pr_ = *(const u32x4*)(Rb + _off); pk_ = *(const u32x4*)(Kb + _off); pv_ = *(const u32x4*)(Vb + _off); pa_ = *(const u32x4*)(AA + _off); \
                    pd0_ = *(const f32x4*)(DD + _off); pd1_ = *(const f32x4*)(DD + _off + 4); \
                    if (jl > 0) { pvf_ = *(const u32x4*)(VFIRST + _off); pvg_ = *(const u32x4*)(VG + _off); } } while (0)
#pragma unroll 1
                for (int item = blockIdx.x; item < 8704; item += G) {
                    LAS unsigned char* ldsv = (LAS unsigned char*)lds; asm volatile("" : "+v"(ldsv));
                    LAS bf16_t* AH = (LAS bf16_t*)(ldsv + 0); LAS bf16_t* RH = (LAS bf16_t*)(ldsv + 9216); LAS bf16_t* BH = (LAS bf16_t*)(ldsv + 18432); LAS bf16_t* KH = (LAS bf16_t*)(ldsv + 27648);
                    LAS bf16_t* BHT = (LAS bf16_t*)(ldsv + 36864); LAS bf16_t* KHT = (LAS bf16_t*)(ldsv + 46080); LAS bf16_t* VTs = (LAS bf16_t*)(ldsv + 55296); LAS bf16_t* XT = (LAS bf16_t*)(ldsv + 64512);
                    LAS float* AAB = (LAS float*)(ldsv + 82944); LAS bf16_t* AAK = (LAS bf16_t*)(ldsv + 99328); LAS bf16_t* ARB = (LAS bf16_t*)(ldsv + 108544); LAS bf16_t* ARK = (LAS bf16_t*)(ldsv + 117760);
                    LAS float* LB = (LAS float*)(ldsv + 126976); LAS float* DTS = (LAS float*)(ldsv + 143360);
                    (void)RH; (void)KH; (void)KHT;
                    const int chunk = item >> 5, h = item & 31, r0 = chunk * 64;
                    const int col = h * 64 + c0;
                    S1_FETCH(item);
                    float r[8], kk[8], bb[8], km[8], ld[8];
                    {
                        float k[8], v[8], a[8];
                        unpack8(pr_, r); unpack8(pk_, k); unpack8(pv_, v); unpack8(pa_, a);
                        const f32x4 d0 = pd0_, d1 = pd1_;
                        ld[0] = d0[0]; ld[1] = d0[1]; ld[2] = d0[2]; ld[3] = d0[3]; ld[4] = d1[0]; ld[5] = d1[1]; ld[6] = d1[2]; ld[7] = d1[3];
                        if (jl > 0) { float vf[8], vg[8]; unpack8(pvf_, vf); unpack8(pvg_, vg);
#pragma unroll
                            for (int i = 0; i < 8; ++i) v[i] = v[i] + (vf[i] - v[i]) * vg[i]; }
                        float ss = 0.f;
#pragma unroll
                        for (int i = 0; i < 8; ++i) { kk[i] = k[i] * k_k[col + i]; ss += kk[i] * kk[i]; }
                        ss = sum8(ss, lane);
                        const float inv = 1.f / fmaxf(sqrtf(ss), 1e-12f);
                        float rk = 0.f;
#pragma unroll
                        for (int i = 0; i < 8; ++i) { kk[i] *= inv; bb[i] = kk[i] * a[i]; km[i] = k[i] * (1.f + (a[i] - 1.f) * k_a[col + i]); rk += r[i] * km[i] * r_k[col + i]; }
                        rk = sum8(rk, lane);
                        if ((tid & 7) == 0) RK[(size_t)(r0 + st) * 32 + h] = rk;
                        *(LAS f32x4*)(LB + st * 64 + c0) = d0; *(LAS f32x4*)(LB + st * 64 + c0 + 4) = d1;
#pragma unroll
                        for (int i = 0; i < 8; i += 2) { const unsigned pk = cvt_pk_bf16(v[i], v[i + 1]); VTs[(c0 + i) * 72 + st] = (bf16_t)(pk & 0xffffu); VTs[(c0 + i + 1) * 72 + st] = (bf16_t)(pk >> 16); }
                    }
                    S1_BAR;
                    {
                        const int cc_ = tid & 63, tq_ = tid >> 6; float pf[8]; float run = 0.f;
#pragma unroll
                        for (int j = 0; j < 8; ++j) { run += LB[(8 * tq_ + j) * 64 + cc_]; pf[j] = run; }
                        AAB[tq_ * 64 + cc_] = run;
                        S1_BAR;
                        float ofs = 0.f;
#pragma unroll
                        for (int g = 0; g < 7; ++g) ofs += (g < tq_) ? AAB[g * 64 + cc_] : 0.f;
#pragma unroll
                        for (int j = 0; j < 8; ++j) LB[(8 * tq_ + j) * 64 + cc_] = pf[j] + ofs;
                    }
                    S1_BAR;
                    {
                        float ah[8], bh[8], kh[8], rh[8];
#pragma unroll
                        for (int i = 0; i < 8; ++i) { const float Lt = LB[st * 64 + c0 + i]; const float e3 = __expf(Lt), e2 = __expf(-Lt), e1 = __expf(Lt - ld[i]);
                            ah[i] = -kk[i] * e1; bh[i] = bb[i] * e2; kh[i] = km[i] * e2; rh[i] = r[i] * e3;
                            if (st == 63) { DTS[c0 + i] = e3; DTg[(size_t)item * 64 + c0 + i] = e3; } }
                        *(LAS u32x4*)(AH + st * 72 + c0) = pack8(ah); *(LAS u32x4*)(RH + st * 72 + c0) = pack8(rh);
                        *(LAS u32x4*)(BH + st * 72 + c0) = pack8(bh); *(LAS u32x4*)(KH + st * 72 + c0) = pack8(kh);
#pragma unroll
                        for (int i = 0; i < 8; i += 2) { const unsigned p1 = cvt_pk_bf16(bh[i], bh[i + 1]), p2 = cvt_pk_bf16(kh[i], kh[i + 1]);
                            BHT[(c0 + i) * 72 + st] = (bf16_t)(p1 & 0xffffu); BHT[(c0 + i + 1) * 72 + st] = (bf16_t)(p1 >> 16);
                            KHT[(c0 + i) * 72 + st] = (bf16_t)(p2 & 0xffffu); KHT[(c0 + i + 1) * 72 + st] = (bf16_t)(p2 >> 16); }
                    }
                    S1_BAR;
                    {
                        const int mi = wave & 3, rowsel = mi >> 1, tt = mi & 1;
#pragma unroll
                        for (int nn = 0; nn < 2; ++nn) {
                            const int colsel = wave >> 2, stl = nn; const int ni = 2 * colsel + nn;
                            f32x16 acc;
#pragma unroll
                            for (int i = 0; i < 16; ++i) acc[i] = 0.f;
                            if (stl <= tt) {
#pragma unroll
                                for (int ks = 0; ks < 4; ++ks) {
                                    const bf16x8 a = *(const LAS bf16x8*)(AH + (mi * 32 + l32) * 72 + ks * 16 + hl * 8);
                                    const bf16x8 b = *(const LAS bf16x8*)(BH + (ni * 32 + l32) * 72 + ks * 16 + hl * 8);
                                    acc = __builtin_amdgcn_mfma_f32_32x32x16_bf16(a, b, acc, 0, 0, 0);
                                }
                            }
#pragma unroll
                            for (int i = 0; i < 16; ++i) {
                                const int t = tt * 32 + crow(i, hl), s = stl * 32 + l32;
                                const bool keep = rowsel ? (s <= t) : (s < t);
                                const float val = keep ? acc[i] : 0.f;
                                if (rowsel == 0 && colsel == 0) AAB[t * 64 + s] = val;
                                else { LAS bf16_t* dst = (rowsel == 0) ? AAK : (colsel == 0 ? ARB : ARK); dst[t * 72 + s] = (bf16_t)(cvt_pk_bf16(val, 0.f) & 0xffffu); }
                            }
                        }
                    }
                    S1_BAR;
                    if (wave < 4) {
                        const int mt = wave >> 1, nt = wave & 1;
                        f32x16 acc;
#pragma unroll
                        for (int i = 0; i < 16; ++i) acc[i] = 0.f;
#pragma unroll
                        for (int ks = 0; ks < 4; ++ks) {
                            const bf16x8 a = *(const LAS bf16x8*)(AAK + (mt * 32 + l32) * 72 + ks * 16 + hl * 8);
                            const bf16x8 b = *(const LAS bf16x8*)(VTs + (nt * 32 + l32) * 72 + ks * 16 + hl * 8);
                            acc = __builtin_amdgcn_mfma_f32_32x32x16_bf16(a, b, acc, 0, 0, 0);
                        }
#pragma unroll
                        for (int i = 0; i < 16; ++i) LB[(mt * 32 + crow(i, hl)) * 64 + nt * 32 + l32] = acc[i];
                    }
                    S1_BAR;
                    {
                        const int colx = tid >> 2, par = tid & 3;
                        float Xp[4][4];
#pragma unroll
                        for (int i = 0; i < 4; ++i) { Xp[i][0] = 0.f; Xp[i][1] = 0.f; Xp[i][2] = 0.f; Xp[i][3] = 0.f; }
#pragma clang loop unroll(full)
                        for (int t = 0; t < 64; ++t) {
                            const float va_ = bf2f(AH[t * 72 + (colx & 63)]), vb_ = LB[t * 64 + (colx & 63)];
                            float a0 = par ? 0.f : ((colx < 64) ? va_ : vb_);
                            float a1 = 0.f, a2 = 0.f, a3 = 0.f;
#pragma clang loop unroll(full)
                            for (int i = 0; 16 * i < t; ++i) { const f32x4 w = *(const LAS f32x4*)(AAB + t * 64 + 16 * i + 4 * par);
                                a0 += w[0] * Xp[i][0]; a1 += w[1] * Xp[i][1]; a2 += w[2] * Xp[i][2]; a3 += w[3] * Xp[i][3]; }
                            float val = (a0 + a1) + (a2 + a3);
                            val += __builtin_bit_cast(float, __builtin_amdgcn_update_dpp(0, __builtin_bit_cast(int, val), 0xB1, 0xf, 0xf, false));
                            val += __builtin_bit_cast(float, __builtin_amdgcn_update_dpp(0, __builtin_bit_cast(int, val), 0x4E, 0xf, 0xf, false));
                            Xp[t >> 4][t & 3] = (par == ((t >> 2) & 3)) ? val : Xp[t >> 4][t & 3];
                            asm volatile("" : "+v"(Xp[t >> 4][t & 3]));
                        }
#pragma unroll
                        for (int i = 0; i < 4; ++i) { u32x2 w; w.x = cvt_pk_bf16(Xp[i][0], Xp[i][1]); w.y = cvt_pk_bf16(Xp[i][2], Xp[i][3]);
                            *(LAS u32x2*)(XT + colx * 72 + 16 * i + 4 * par) = w; }
                    }
                    S1_BAR;
                    {
                        const int kind = wave >> 2, mt = (wave & 3) >> 1, nt = wave & 1;
                        {
                            const LAS bf16_t* Ap = (kind == 0 ? ARB : BHT) + (mt * 32 + l32) * 72; const LAS bf16_t* Bp = XT + (nt * 32 + l32) * 72;
                            f32x16 acc;
#pragma unroll
                            for (int i = 0; i < 16; ++i) acc[i] = 0.f;
#pragma unroll
                            for (int ks = 0; ks < 4; ++ks) acc = __builtin_amdgcn_mfma_f32_32x32x16_bf16(*(const LAS bf16x8*)(Ap + ks * 16 + hl * 8), *(const LAS bf16x8*)(Bp + ks * 16 + hl * 8), acc, 0, 0, 0);
                            bf16_t* dstb = (kind == 0) ? Rb : Kb;
#pragma unroll
                            for (int i = 0; i < 16; ++i) { const int rr = mt * 32 + crow(i, hl), cc = nt * 32 + l32;
                                float val = acc[i];
                                if (kind == 0) val += bf2f(RH[rr * 72 + cc]); else val *= DTS[rr];
                                dstb[(size_t)(r0 + rr) * DM + h * 64 + cc] = (bf16_t)(cvt_pk_bf16(val, 0.f) & 0xffffu); }
                        }
                        {
                            const LAS bf16_t* A1 = (kind == 0 ? ARB : BHT) + (mt * 32 + l32) * 72; const LAS bf16_t* A2 = (kind == 0 ? ARK : KHT) + (mt * 32 + l32) * 72;
                            const LAS bf16_t* B1 = XT + (64 + nt * 32 + l32) * 72; const LAS bf16_t* B2 = VTs + (nt * 32 + l32) * 72;
                            f32x16 acc;
#pragma unroll
                            for (int i = 0; i < 16; ++i) acc[i] = 0.f;
#pragma unroll
                            for (int ks = 0; ks < 4; ++ks) acc = __builtin_amdgcn_mfma_f32_32x32x16_bf16(*(const LAS bf16x8*)(A1 + ks * 16 + hl * 8), *(const LAS bf16x8*)(B1 + ks * 16 + hl * 8), acc, 0, 0, 0);
#pragma unroll
                            for (int ks = 0; ks < 4; ++ks) acc = __builtin_amdgcn_mfma_f32_32x32x16_bf16(*(const LAS bf16x8*)(A2 + ks * 16 + hl * 8), *(const LAS bf16x8*)(B2 + ks * 16 + hl * 8), acc, 0, 0, 0);
                            float* dstf = (kind == 0) ? Obuf : DD;
#pragma unroll
                            for (int i = 0; i < 16; ++i) { const int rr = mt * 32 + crow(i, hl), cc = nt * 32 + l32;
                                float val = acc[i]; if (kind == 1) val *= DTS[rr];
                                dstf[(size_t)(r0 + rr) * DM + h * 64 + cc] = val; }
                        }
                    }
                    S1_BAR;
                }
            }
            fast_grid_barrier((unsigned*)ldp(tab, 40), tab);
#undef S1_BAR
#undef S1_FETCH
            {
                PHASE_IDS BASES RWKV_PTRS
                const float* DTg = (const float*)(RB + 208 * MiB);
                const int l32 = lane & 31, hl = lane >> 5;
                const int q = wave * G + blockIdx.x;
                if (q < 1152) {
                    const bool prompt = q < 128; int b, h, vh, chunk0, nch;
                    if (prompt) { const int chain = q & 63; b = chain >> 5; h = chain & 31; vh = q >> 6; chunk0 = b * 128; nch = 128; }
                    else { const int sq = q - 128; const int chain = sq >> 1; b = chain >> 5; h = chain & 31; vh = sq & 1; chunk0 = 256 + b; nch = 1; }
                    const int colb = h * 64, vcol = colb + 32 * vh + l32;
                    f32x16 S0, S1;
                    if (prompt) {
#pragma unroll
                        for (int i = 0; i < 16; ++i) { S0[i] = 0.f; S1[i] = 0.f; }
                    } else {
                        const float* s0 = IN(3) + ((((size_t)jl * 16 + b) * 32 + h) * 64 + (32 * vh + l32)) * 64;
#pragma unroll
                        for (int i = 0; i < 16; ++i) { S0[i] = s0[crow(i, hl)]; S1[i] = s0[32 + crow(i, hl)]; }
                    }
                    bf16x8 gf[2][2][2]; f32x16 n0, n1; f32x4 dt_[2][4];
#define S2_COMPUTE(cc) do { const int _r0 = (chunk0 + (cc)) * 64; \
                        u32x4 w00, w01, w10, w11; \
                        w00.x = cvt_pk_bf16(S0[0], S0[1]); w00.y = cvt_pk_bf16(S0[2], S0[3]); w00.z = cvt_pk_bf16(S0[4], S0[5]); w00.w = cvt_pk_bf16(S0[6], S0[7]); \
                        w01.x = cvt_pk_bf16(S0[8], S0[9]); w01.y = cvt_pk_bf16(S0[10], S0[11]); w01.z = cvt_pk_bf16(S0[12], S0[13]); w01.w = cvt_pk_bf16(S0[14], S0[15]); \
                        w10.x = cvt_pk_bf16(S1[0], S1[1]); w10.y = cvt_pk_bf16(S1[2], S1[3]); w10.z = cvt_pk_bf16(S1[4], S1[5]); w10.w = cvt_pk_bf16(S1[6], S1[7]); \
                        w11.x = cvt_pk_bf16(S1[8], S1[9]); w11.y = cvt_pk_bf16(S1[10], S1[11]); w11.z = cvt_pk_bf16(S1[12], S1[13]); w11.w = cvt_pk_bf16(S1[14], S1[15]); \
                        const bf16x8 sb00 = __builtin_bit_cast(bf16x8, w00), sb01 = __builtin_bit_cast(bf16x8, w01), sb10 = __builtin_bit_cast(bf16x8, w10), sb11 = __builtin_bit_cast(bf16x8, w11); \
                        n0 = __builtin_amdgcn_mfma_f32_32x32x16_bf16(gf[0][0][0], sb00, n0, 0, 0, 0); n1 = __builtin_amdgcn_mfma_f32_32x32x16_bf16(gf[1][0][0], sb00, n1, 0, 0, 0); \
                        n0 = __builtin_amdgcn_mfma_f32_32x32x16_bf16(gf[0][0][1], sb01, n0, 0, 0, 0); n1 = __builtin_amdgcn_mfma_f32_32x32x16_bf16(gf[1][0][1], sb01, n1, 0, 0, 0); \
                        n0 = __builtin_amdgcn_mfma_f32_32x32x16_bf16(gf[0][1][0], sb10, n0, 0, 0, 0); n1 = __builtin_amdgcn_mfma_f32_32x32x16_bf16(gf[1][1][0], sb10, n1, 0, 0, 0); \
                        n0 = __builtin_amdgcn_mfma_f32_32x32x16_bf16(gf[0][1][1], sb11, n0, 0, 0, 0); n1 = __builtin_amdgcn_mfma_f32_32x32x16_bf16(gf[1][1][1], sb11, n1, 0, 0, 0); \
                        { unsigned char* _sp = (unsigned char*)DD + ((size_t)(_r0 + l32) * DM + colb + 32 * vh) * 4 + 8 * hl; \
                          *(u32x2*)(_sp + 0) = (u32x2){w00.x, w00.y}; *(u32x2*)(_sp + 16) = (u32x2){w00.z, w00.w}; *(u32x2*)(_sp + 32) = (u32x2){w01.x, w01.y}; *(u32x2*)(_sp + 48) = (u32x2){w01.z, w01.w}; \
                          *(u32x2*)(_sp + 64) = (u32x2){w10.x, w10.y}; *(u32x2*)(_sp + 80) = (u32x2){w10.z, w10.w}; *(u32x2*)(_sp + 96) = (u32x2){w11.x, w11.y}; *(u32x2*)(_sp + 112) = (u32x2){w11.z, w11.w}; } \
                        _Pragma("unroll") for (int i = 0; i < 16; ++i) { S0[i] = S0[i] * dt_[0][i >> 2][i & 3] + n0[i]; S1[i] = S1[i] * dt_[1][i >> 2][i & 3] + n1[i]; } \
                    } while (0)
                    if (prompt) {
                        LAS float* dtl = (LAS float*)((LAS unsigned char*)lds);
                        LAS unsigned char* ring = (LAS unsigned char*)lds + 32768;
                        for (int i = lane; i < 128 * 16; i += 64) *(LAS f32x4*)(dtl + i * 4) = *(const f32x4*)(DTg + ((size_t)(chunk0 + (i >> 4)) * 32 + h) * 64 + (i & 15) * 4);
#define S2_DMA(cc) do { const int _r0 = (chunk0 + (cc)) * 64; LAS unsigned char* _s = ring + ((cc) & 3) * 16384; \
                            _Pragma("unroll") for (int j = 0; j < 8; ++j) { const int _row = 8 * j + (lane >> 3); const int _p = (lane & 7) ^ (_row & 7); \
                                __builtin_amdgcn_global_load_lds((const unsigned*)(Kb + (size_t)(_r0 + _row) * DM + colb + _p * 8), (LAS unsigned*)(_s + j * 1024), 16, 0, 0); } \
                            _Pragma("unroll") for (int j = 0; j < 8; ++j) { const int _row = 8 * j + (lane >> 3); \
                                __builtin_amdgcn_global_load_lds((const unsigned*)(DD + (size_t)(_r0 + _row) * DM + colb + 32 * vh + (lane & 7) * 4), (LAS unsigned*)(_s + 8192 + j * 1024), 16, 0, 0); } \
                        } while (0)
                        S2_DMA(0); S2_DMA(1);
#pragma unroll 1
                        for (int c = 0; c < 128; ++c) {
                            if (c + 2 < 128) { S2_DMA(c + 2); asm volatile("s_waitcnt vmcnt(32)" ::: "memory"); }
                            else if (c + 1 < 128) asm volatile("s_waitcnt vmcnt(16)" ::: "memory");
                            else asm volatile("s_waitcnt vmcnt(0)" ::: "memory");
                            LAS unsigned char* sl = ring + (c & 3) * 16384;
#pragma unroll
                            for (int mt = 0; mt < 2; ++mt)
#pragma unroll
                                for (int kt = 0; kt < 2; ++kt)
#pragma unroll
                                    for (int s2 = 0; s2 < 2; ++s2) {
                                        const int row = 32 * mt + l32, p = 4 * kt + 2 * s2;
                                        const u32x2 lo = *(const LAS u32x2*)(sl + row * 128 + ((p ^ (row & 7)) * 16) + 8 * hl);
                                        const u32x2 hi = *(const LAS u32x2*)(sl + row * 128 + (((p + 1) ^ (row & 7)) * 16) + 8 * hl);
                                        gf[mt][kt][s2] = __builtin_bit_cast(bf16x8, (u32x4){lo.x, lo.y, hi.x, hi.y});
                                    }
#pragma unroll
                            for (int i = 0; i < 16; ++i) { n0[i] = *(const LAS float*)(sl + 8192 + crow(i, hl) * 128 + l32 * 4); n1[i] = *(const LAS float*)(sl + 8192 + (32 + crow(i, hl)) * 128 + l32 * 4); }
#pragma unroll
                            for (int mt = 0; mt < 2; ++mt)
#pragma unroll
                                for (int g = 0; g < 4; ++g) dt_[mt][g] = *(const LAS f32x4*)(dtl + c * 64 + 32 * mt + 8 * g + 4 * hl);
                            S2_COMPUTE(c);
                        }
#undef S2_DMA
                    } else {
                        const int _r0 = chunk0 * 64; const size_t _item = (size_t)chunk0 * 32 + h;
#pragma unroll
                        for (int mt = 0; mt < 2; ++mt)
#pragma unroll
                            for (int kt = 0; kt < 2; ++kt)
#pragma unroll
                                for (int s2 = 0; s2 < 2; ++s2) {
                                    const size_t _o = (size_t)(_r0 + 32 * mt + l32) * DM + colb + 32 * kt + 16 * s2 + 4 * hl;
                                    const u32x2 _lo = *(const u32x2*)(Kb + _o), _hi = *(const u32x2*)(Kb + _o + 8); gf[mt][kt][s2] = __builtin_bit_cast(bf16x8, (u32x4){_lo.x, _lo.y, _hi.x, _hi.y}); }
#pragma unroll
                        for (int i = 0; i < 16; ++i) { n0[i] = DD[(size_t)(_r0 + crow(i, hl)) * DM + vcol]; n1[i] = DD[(size_t)(_r0 + 32 + crow(i, hl)) * DM + vcol]; }
#pragma unroll
                        for (int mt = 0; mt < 2; ++mt)
#pragma unroll
                            for (int g = 0; g < 4; ++g) dt_[mt][g] = *(const f32x4*)(DTg + _item * 64 + 32 * mt + 8 * g + 4 * hl);
                        S2_COMPUTE(0);
                    }
#undef S2_COMPUTE
                    float* so_ = OUTP + (prompt ? O_PWKV + ((((size_t)jl * 2 + b) * 32 + h) * 64 + (32 * vh + l32)) * 64
                                                : O_SWKV + ((((size_t)jl * 16 + b) * 32 + h) * 64 + (32 * vh + l32)) * 64);
#pragma unroll
                    for (int i = 0; i < 16; ++i) { so_[crow(i, hl)] = S0[i]; so_[32 + crow(i, hl)] = S1[i]; }
                }
            }
            fast_grid_barrier((unsigned*)ldp(tab, 40), tab);
            {
                PHASE_IDS BASES RWKV_PTRS
                const float* Obuf = (const float*)(RA + 272 * MiB); const float* RK = (const float*)(RB + 204 * MiB);
                const float* lnw = IN(28) + (size_t)jl * DM; const float* lnb = IN(29) + (size_t)jl * DM;
                const int l32 = lane & 31, hl = lane >> 5;
#pragma unroll 1
                for (int item = blockIdx.x; item < 8704; item += G) {
                    LAS unsigned char* ldsv = (LAS unsigned char*)lds; asm volatile("" : "+v"(ldsv));
                    LAS bf16_t* R2s = (LAS bf16_t*)(ldsv + 0); LAS bf16_t* STs = (LAS bf16_t*)(ldsv + 9216); LAS float* Os = (LAS float*)(ldsv + 18432);
                    const int chunk = item >> 5, h = item & 31, r0 = chunk * 64;
                    {
                        const int rr = tid >> 3, pc = tid & 7;
                        *(LAS u32x4*)(R2s + rr * 72 + pc * 8) = *(const u32x4*)(Rb + (size_t)(r0 + rr) * DM + h * 64 + pc * 8);
                        const unsigned char* sp = (const unsigned char*)DD + ((size_t)(r0 + (rr & 31)) * DM + h * 64 + 32 * (rr >> 5)) * 4 + pc * 16;
                        *(LAS u32x4*)(STs + rr * 72 + pc * 8) = *(const u32x4*)sp;
                    }
                    __syncthreads();
                    if (wave < 4) {
                        const int tt = wave >> 1, vt = wave & 1;
                        f32x16 acc;
#pragma unroll
                        for (int i = 0; i < 16; ++i) acc[i] = Obuf[(size_t)(r0 + 32 * tt + crow(i, hl)) * DM + h * 64 + 32 * vt + l32];
#pragma unroll
                        for (int ks = 0; ks < 4; ++ks) acc = __builtin_amdgcn_mfma_f32_32x32x16_bf16(*(const LAS bf16x8*)(R2s + (32 * tt + l32) * 72 + ks * 16 + hl * 8), *(const LAS bf16x8*)(STs + (32 * vt + l32) * 72 + ks * 16 + hl * 8), acc, 0, 0, 0);
#pragma unroll
                        for (int i = 0; i < 16; ++i) Os[(32 * tt + crow(i, hl)) * 68 + 32 * vt + l32] = acc[i];
                    }
                    __syncthreads();
                    {
                        const int st = tid >> 3, c0 = (tid & 7) * 8, col = h * 64 + c0; const size_t off = (size_t)(r0 + st) * DM + col;
                        const f32x4 o0 = *(const LAS f32x4*)(Os + st * 68 + c0), o1 = *(const LAS f32x4*)(Os + st * 68 + c0 + 4);
                        float o[8] = {o0[0], o0[1], o0[2], o0[3], o1[0], o1[1], o1[2], o1[3]};
                        float s = 0.f;
#pragma unroll
                        for (int i = 0; i < 8; ++i) s += o[i];
                        const float mu = sum8(s, lane) * (1.f / 64.f); float q = 0.f;
#pragma unroll
                        for (int i = 0; i < 8; ++i) { o[i] -= mu; q += o[i] * o[i]; }
                        const float rstd = rsqrtf(sum8(q, lane) * (1.f / 64.f) + 64e-5f);
                        float v[8], g8[8]; unpack8(*(const u32x4*)(Vb + off), v); unpack8(*(const u32x4*)(GG + off), g8);
                        if (jl > 0) { float vf[8], vg[8]; unpack8(*(const u32x4*)(VFIRST + off), vf); unpack8(*(const u32x4*)(VG + off), vg);
#pragma unroll
                            for (int i = 0; i < 8; ++i) v[i] = v[i] + (vf[i] - v[i]) * vg[i]; }
                        const float rk = RK[(size_t)(r0 + st) * 32 + h];
                        float y[8];
#pragma unroll
                        for (int i = 0; i < 8; ++i) y[i] = (o[i] * rstd * lnw[col + i] + lnb[col + i] + rk * v[i]) * g8[i];
                        *(u32x4*)(Y + off) = pack8(y);
                    }
                    __syncthreads();
                }
            }
            fast_grid_barrier((unsigned*)ldp(tab, 40), tab);
            {
                BASES RWKV_PTRS
                pg8::Gemm g{Y, WO, MROWS, 2048, 2048, 0, 0};
                pg8::StaticOrder S; S.init(g.M, g.N, G, (int)blockIdx.x, g.K, 4);
                pg8::Epi<FRes> E{FRes{X, (float*)(RA + 272 * MiB)}};
                pg8::gemm_phase(ldsl, g, S, E);
                fast_grid_barrier((unsigned*)ldp(tab, 40), tab);
                {
                    PHASE_IDS
                    const float* PART = (const float*)(RA + 272 * MiB); const int ntail = S.nwg - S.nFull;
                    if (S.S > 1) for (int idx = gtid; idx < ntail * 16384; idx += NT) {
                        const int tl = idx >> 14, r = (idx >> 6) & 255, c4 = idx & 63; int pm, pn; S.tile_pmpn(S.nFull + tl, pm, pn);
                        f32x4* xp = (f32x4*)(X + (size_t)(pm * 256 + r) * DM + pn * 256 + c4 * 4); f32x4 acc = *xp;
#pragma unroll
                        for (int part = 0; part < 4; ++part) acc += *(const f32x4*)(PART + (size_t)(part * 32 + tl) * 65536 + r * 256 + c4 * 4);
                        *xp = acc; }
                }
            }
            fast_grid_barrier((unsigned*)ldp(tab, 40), tab);
        } else {
            { PHASE_IDS BASES GLA_PTRS
            const float* gmix = IN(6) + (size_t)layer * DM;
            for (int row = gw; row < MROWS; row += NGW) {
                const f32x4* xr = (const f32x4*)(X + (size_t)row * DM) + lane; f32x4 x[8]; float ss = 0.f;
#pragma unroll
                for (int q = 0; q < 8; ++q) { x[q] = xr[64 * q]; ss += x[q][0] * x[q][0] + x[q][1] * x[q][1] + x[q][2] * x[q][2] + x[q][3] * x[q][3]; }
                const float rs = rsqrtf(wave_sum(ss, lane) * (1.f / DM) + 1e-6f);
#pragma unroll
                for (int q = 0; q < 8; ++q) { const f32x4 gg = *((const f32x4*)gmix + lane + 64 * q); const f32x4 h = x[q] * rs * gg;
                    u32x2 w; w.x = cvt_pk_bf16(h[0], h[1]); w.y = cvt_pk_bf16(h[2], h[3]); *((u32x2*)(H + (size_t)row * DM) + lane + 64 * q) = w; }
            } }
            fast_grid_barrier((unsigned*)ldp(tab, 40), tab);
            {
                BASES GLA_PTRS
                pg8::Gemm g{H, GI, MROWS, 6400, 2048, 0, 0};
                pg8::StaticOrder S; S.init(g.M, g.N, G, (int)blockIdx.x, g.K, 1);
                pg8::Epi<FG1> E{FG1{PROJ, LR}};
                pg8::gemm_phase(ldsl, g, S, E);
            }
            fast_grid_barrier((unsigned*)ldp(tab, 40), tab);
            {
                PHASE_IDS BASES GLA_PTRS
                float* lrS = (float*)lds;
                float* w2S = (float*)(lds + 4096);
                float* totS = (float*)(lds + 20480);
                bf16_t* qeS = (bf16_t*)(lds + 22528);
                bf16_t* keS = (bf16_t*)(lds + 22528 + 33792);
                bf16_t* vS = qeS;
                const float* gw2 = IN(31) + (size_t)jl * 16 * 1024; const float* gkb = IN(32) + (size_t)jl * 1024;
#pragma unroll 1
                for (int it = blockIdx.x; it < 1088; it += G) {
                    const int c = it >> 2, h = it & 3, r0 = c * 64; const size_t base = (size_t)it;
                    if (tid < 256) *(f32x4*)(lrS + tid * 4) = *(const f32x4*)(LR + (size_t)r0 * 16 + tid * 4);
                    for (int q = tid; q < 1024; q += 512) { const int r = q >> 6, cc = (q & 63) * 4; *(f32x4*)(w2S + r * 256 + cc) = *(const f32x4*)(gw2 + (size_t)r * 1024 + h * 256 + cc); }
                    __syncthreads();
                    const int d = tid & 255, half = tid >> 8;
                    float cumv[32];
                    {
                        float w[16];
#pragma unroll
                        for (int r = 0; r < 16; ++r) w[r] = w2S[r * 256 + d];
                        const float bb = gkb[h * 256 + d]; float run = 0.f;
#pragma unroll
                        for (int tt = 0; tt < 32; ++tt) {
                            const float* lp = lrS + (half * 32 + tt) * 16; float z = bb;
#pragma unroll
                            for (int r = 0; r < 16; ++r) z += lp[r] * w[r];
                            const float g = (fminf(z, 0.f) - log1pf(__expf(-fabsf(z)))) * 0.0625f;
                            run += g; cumv[tt] = run;
                        }
                        totS[half * 256 + d] = run;
                    }
                    __syncthreads();
                    {
                        const float t0 = totS[d], t1 = totS[256 + d]; const float last = t0 + t1, offc = half ? t0 : 0.f;
                        if (half == 0) EL[base * 256 + d] = __expf(last);
                        unsigned kdp[16];
#pragma unroll
                        for (int tt = 0; tt < 32; tt += 2) {
                            float kd2[2];
#pragma unroll
                            for (int e = 0; e < 2; ++e) {
                                const int t = half * 32 + tt + e; const float cum = cumv[tt + e] + offc;
                                const size_t po = (size_t)(r0 + t) * 6144 + h * 256 + d;
                                const float q = bf2f(PROJ[po]), k = bf2f(PROJ[po + 1024]);
                                const float qe = q * __expf(cum), ke = k * __expf(-cum); kd2[e] = k * __expf(last - cum);
                                const unsigned pq = cvt_pk_bf16(qe, ke);
                                qeS[t * 264 + d] = (bf16_t)(pq & 0xffffu); keS[t * 264 + d] = (bf16_t)(pq >> 16);
                                QE[((base * 8 + (d >> 5)) * 64 + t) * 32 + (d & 31)] = (bf16_t)(pq & 0xffffu);
                            }
                            kdp[tt >> 1] = cvt_pk_bf16(kd2[0], kd2[1]);
                        }
                        u32x4* kdst = (u32x4*)(KDT + (base * 256 + d) * 64 + half * 32);
                        kdst[0] = (u32x4){kdp[0], kdp[1], kdp[2], kdp[3]}; kdst[1] = (u32x4){kdp[4], kdp[5], kdp[6], kdp[7]};
                        kdst[2] = (u32x4){kdp[8], kdp[9], kdp[10], kdp[11]}; kdst[3] = (u32x4){kdp[12], kdp[13], kdp[14], kdp[15]};
                    }
                    __syncthreads();
                    if (wave < 4) {
                        const int mi = wave >> 1, ni = wave & 1, l32 = lane & 31, hl = lane >> 5;
                        f32x16 cacc;
#pragma unroll
                        for (int i = 0; i < 16; ++i) cacc[i] = 0.f;
#pragma unroll
                        for (int kk = 0; kk < 16; ++kk) {
                            const bf16x8 a = *(const bf16x8*)(qeS + (mi * 32 + l32) * 264 + kk * 16 + hl * 8);
                            const bf16x8 b = *(const bf16x8*)(keS + (ni * 32 + l32) * 264 + kk * 16 + hl * 8);
                            cacc = __builtin_amdgcn_mfma_f32_32x32x16_bf16(a, b, cacc, 0, 0, 0);
                        }
#pragma unroll
                        for (int i = 0; i < 16; ++i) { const int ii = mi * 32 + crow(i, hl), jj = ni * 32 + l32;
                            const float v = (jj <= ii) ? cacc[i] : 0.f; SC[base * 4096 + ii * 64 + jj] = (bf16_t)(cvt_pk_bf16(v, 0.f) & 0xffffu); }
                    }
                    __syncthreads();
                    for (int q = tid; q < 4096; q += 512) { const int t = q >> 6, cc = (q & 63) * 8;
                        *(u32x4*)(vS + t * 520 + cc) = *(const u32x4*)(PROJ + (size_t)(r0 + t) * 6144 + 2048 + h * 512 + cc); }
                    __syncthreads();
                    {
                        const int dv = tid; u32x4* vdst = (u32x4*)(VT + (base * 512 + dv) * 64);
#pragma unroll
                        for (int q = 0; q < 8; ++q) {
                            unsigned w[4];
#pragma unroll
                            for (int e = 0; e < 4; ++e) { const unsigned lo = vS[(q * 8 + 2 * e) * 520 + dv], hi = vS[(q * 8 + 2 * e + 1) * 520 + dv]; w[e] = lo | (hi << 16); }
                            vdst[q] = (u32x4){w[0], w[1], w[2], w[3]};
                        }
                    }
                    __syncthreads();
                }
            }
            fast_grid_barrier((unsigned*)ldp(tab, 40), tab);
            {
                PHASE_IDS BASES GLA_PTRS
                float* red = (float*)lds;
                const int l32 = lane & 31, hl = lane >> 5;
#pragma unroll 1
                for (int u = blockIdx.x; u < 1152; u += G) {
                    const bool prompt = u < 128; int b, h, s, cg0, nch, row0;
                    if (prompt) { const int pair = u & 7; b = pair >> 2; h = pair & 3; s = u >> 3; cg0 = b * 128; nch = 128; row0 = b * 8192; }
                    else { const int su = u - 128; b = su >> 6; h = (su >> 4) & 3; s = su & 15; cg0 = 256 + b; nch = 1; row0 = MPROMPT + b * 64; }
                    f32x16 S;
                    if (prompt) {
#pragma unroll
                        for (int i = 0; i < 16; ++i) S[i] = 0.f;
                    } else {
                        const float* s0 = IN(4) + ((((size_t)jl * 16 + b) * 4 + h) * 256) * 512;
#pragma unroll
                        for (int i = 0; i < 16; ++i) S[i] = s0[(size_t)(32 * wave + crow(i, hl)) * 512 + 32 * s + l32];
                    }
                    const int mtw = wave & 1, ksw = wave >> 1;
                    bf16x8 ka[4], vb[4], qf[2][2], scf; f32x4 el[4];
#define GL_LD_Q(cc) do { const size_t _base = (size_t)(cg0 + (cc)) * 4 + h; const int _r0 = row0 + (cc) * 64; const bf16_t* _sc = SC + _base * 4096; \
                        _Pragma("unroll") for (int mt = 0; mt < 2; ++mt) _Pragma("unroll") for (int s2 = 0; s2 < 2; ++s2) { const bf16_t* _pq = QE + ((_base * 8 + wave) * 64 + mt * 32 + l32) * 32 + 16 * s2 + 4 * hl; \
                            const u32x2 _lo = *(const u32x2*)_pq, _hi = *(const u32x2*)(_pq + 8); qf[mt][s2] = __builtin_bit_cast(bf16x8, (u32x4){_lo.x, _lo.y, _hi.x, _hi.y}); } \
                        scf = *(const bf16x8*)(_sc + (mtw * 32 + l32) * 64 + 16 * ksw + 8 * hl); } while (0)
#define GL_LD_E(cc) do { const size_t _base = (size_t)(cg0 + (cc)) * 4 + h; \
                        _Pragma("unroll") for (int g = 0; g < 4; ++g) el[g] = *(const f32x4*)(EL + _base * 256 + 32 * wave + 8 * g + 4 * hl); } while (0)
#define GL_LD_K(cc) do { const size_t _base = (size_t)(cg0 + (cc)) * 4 + h; const bf16_t* _kdt = KDT + _base * 256 * 64; const bf16_t* _vt = VT + _base * 512 * 64; \
                        _Pragma("unroll") for (int ks = 0; ks < 4; ++ks) { ka[ks] = *(const bf16x8*)(_kdt + (32 * wave + l32) * 64 + 16 * ks + 8 * hl); vb[ks] = *(const bf16x8*)(_vt + (32 * s + l32) * 64 + 16 * ks + 8 * hl); } } while (0)
                    GL_LD_Q(0); GL_LD_E(0); GL_LD_K(0);
                    f32x4 osum = (f32x4){0.f, 0.f, 0.f, 0.f}; float* optr = nullptr;
#pragma unroll 1
                    for (int c = 0; c < nch; ++c) {
                        const int r0 = row0 + c * 64; const int cn = (c + 1 < nch) ? c + 1 : c;
                        asm volatile("" : "+v"(scf), "+v"(vb[3]));
                        if (c > 0) *(f32x4*)optr = osum;
                        u32x4 sp0, sp1;
                        sp0.x = cvt_pk_bf16(S[0], S[1]); sp0.y = cvt_pk_bf16(S[2], S[3]); sp0.z = cvt_pk_bf16(S[4], S[5]); sp0.w = cvt_pk_bf16(S[6], S[7]);
                        sp1.x = cvt_pk_bf16(S[8], S[9]); sp1.y = cvt_pk_bf16(S[10], S[11]); sp1.z = cvt_pk_bf16(S[12], S[13]); sp1.w = cvt_pk_bf16(S[14], S[15]);
                        const bf16x8 sb0 = __builtin_bit_cast(bf16x8, sp0), sb1 = __builtin_bit_cast(bf16x8, sp1);
                        const bf16x8 vbw = ksw == 0 ? vb[0] : ksw == 1 ? vb[1] : ksw == 2 ? vb[2] : vb[3];
#pragma unroll
                        for (int i = 0; i < 16; ++i) S[i] *= el[i >> 2][i & 3];
#pragma unroll
                        for (int ks = 0; ks < 4; ++ks) S = __builtin_amdgcn_mfma_f32_32x32x16_bf16(ka[ks], vb[ks], S, 0, 0, 0);
                        GL_LD_E(cn); GL_LD_K(cn);
                        f32x16 oo0, oo1;
#pragma unroll
                        for (int i = 0; i < 16; ++i) { oo0[i] = 0.f; oo1[i] = 0.f; }
                        oo0 = __builtin_amdgcn_mfma_f32_32x32x16_bf16(qf[0][0], sb0, oo0, 0, 0, 0); oo0 = __builtin_amdgcn_mfma_f32_32x32x16_bf16(qf[0][1], sb1, oo0, 0, 0, 0);
                        oo1 = __builtin_amdgcn_mfma_f32_32x32x16_bf16(qf[1][0], sb0, oo1, 0, 0, 0); oo1 = __builtin_amdgcn_mfma_f32_32x32x16_bf16(qf[1][1], sb1, oo1, 0, 0, 0);
                        if (mtw == 0) oo0 = __builtin_amdgcn_mfma_f32_32x32x16_bf16(scf, vbw, oo0, 0, 0, 0); else oo1 = __builtin_amdgcn_mfma_f32_32x32x16_bf16(scf, vbw, oo1, 0, 0, 0);
                        GL_LD_Q(cn);
#pragma unroll
                        for (int q = 0; q < 16; ++q) { red[(wave * 32 + q) * 64 + lane] = oo0[q]; red[(wave * 32 + 16 + q) * 64 + lane] = oo1[q]; }
                        asm volatile("s_waitcnt lgkmcnt(0)" ::: "memory"); __builtin_amdgcn_s_barrier(); asm volatile("" ::: "memory");
                        { const int q = tid >> 4, lg = tid & 15; f32x4 sum = (f32x4){0.f, 0.f, 0.f, 0.f};
#pragma unroll
                          for (int w = 0; w < 8; ++w) sum += *(const f32x4*)(red + (w * 32 + q) * 64 + 4 * lg);
                          const int mt = q >> 4, reg = q & 15, L = 4 * lg; const int i = mt * 32 + crow(reg, L >> 5), dv = L & 31;
                          osum = sum; optr = O + (size_t)(r0 + i) * DM + h * 512 + 32 * s + dv; }
                        asm volatile("s_waitcnt lgkmcnt(0)" ::: "memory"); __builtin_amdgcn_s_barrier(); asm volatile("" ::: "memory");
                    }
                    *(f32x4*)optr = osum;
#undef GL_LD_Q
#undef GL_LD_E
#undef GL_LD_K
                    float* dst = OUTP + (prompt ? O_PGLA + ((((size_t)jl * 2 + b) * 4 + h) * 256) * 512 : O_SGLA + ((((size_t)jl * 16 + b) * 4 + h) * 256) * 512);
#pragma unroll
                    for (int i = 0; i < 16; ++i) dst[(size_t)(32 * wave + crow(i, hl)) * 512 + 32 * s + l32] = S[i];
                }
            }
            fast_grid_barrier((unsigned*)ldp(tab, 40), tab);
            {
                PHASE_IDS BASES GLA_PTRS
                const float* hn = IN(33) + (size_t)jl * 512;
                for (int row = gw; row < MROWS; row += NGW) {
#pragma unroll
                    for (int h = 0; h < 4; ++h) {
                        const float* op = O + (size_t)row * DM + h * 512 + lane * 8;
                        const f32x4 a = *(const f32x4*)op, b = *(const f32x4*)(op + 4);
                        float ss = a[0] * a[0] + a[1] * a[1] + a[2] * a[2] + a[3] * a[3] + b[0] * b[0] + b[1] * b[1] + b[2] * b[2] + b[3] * b[3];
                        const float rs = rsqrtf(wave_sum(ss, lane) * (1.f / 512.f) + 1e-5f);
                        float gt[8]; unpack8(*(const u32x4*)(PROJ + (size_t)row * 6144 + 4096 + h * 512 + lane * 8), gt);
                        const f32x4 n0 = *(const f32x4*)(hn + lane * 8), n1 = *(const f32x4*)(hn + lane * 8 + 4);
                        float y[8];
#pragma unroll
                        for (int i = 0; i < 4; ++i) { y[i] = a[i] * rs * n0[i] * (gt[i] * sigmoidf_(gt[i])); y[4 + i] = b[i] * rs * n1[i] * (gt[4 + i] * sigmoidf_(gt[4 + i])); }
                        *(u32x4*)(Y + (size_t)row * DM + h * 512 + lane * 8) = pack8(y);
                    }
                }
            }
            fast_grid_barrier((unsigned*)ldp(tab, 40), tab);
            {
                BASES GLA_PTRS
                pg8::Gemm g{Y, GO, MROWS, 2048, 2048, 0, 0};
                pg8::StaticOrder S; S.init(g.M, g.N, G, (int)blockIdx.x, g.K, 4);
                pg8::Epi<FRes> E{FRes{X, (float*)(RA + 272 * MiB)}};
                pg8::gemm_phase(ldsl, g, S, E);
                fast_grid_barrier((unsigned*)ldp(tab, 40), tab);
                {
                    PHASE_IDS
                    const float* PART = (const float*)(RA + 272 * MiB); const int ntail = S.nwg - S.nFull;
                    if (S.S > 1) for (int idx = gtid; idx < ntail * 16384; idx += NT) {
                        const int tl = idx >> 14, r = (idx >> 6) & 255, c4 = idx & 63; int pm, pn; S.tile_pmpn(S.nFull + tl, pm, pn);
                        f32x4* xp = (f32x4*)(X + (size_t)(pm * 256 + r) * DM + pn * 256 + c4 * 4); f32x4 acc = *xp;
#pragma unroll
                        for (int part = 0; part < 4; ++part) acc += *(const f32x4*)(PART + (size_t)(part * 32 + tl) * 65536 + r * 256 + c4 * 4);
                        *xp = acc; }
                }
            }
            fast_grid_barrier((unsigned*)ldp(tab, 40), tab);
        }
        {
            { PHASE_IDS BASES FFN_PTRS
            const float* gf = IN(7) + (size_t)layer * DM;
            for (int row = gw; row < MROWS; row += NGW) {
                const f32x4* xr = (const f32x4*)(X + (size_t)row * DM) + lane; f32x4 x[8]; float ss = 0.f;
#pragma unroll
                for (int q = 0; q < 8; ++q) { x[q] = xr[64 * q]; ss += x[q][0] * x[q][0] + x[q][1] * x[q][1] + x[q][2] * x[q][2] + x[q][3] * x[q][3]; }
                const float rs = rsqrtf(wave_sum(ss, lane) * (1.f / DM) + 1e-6f);
#pragma unroll
                for (int q = 0; q < 8; ++q) { const f32x4 gg = *((const f32x4*)gf + lane + 64 * q); const f32x4 h = x[q] * rs * gg;
                    u32x2 w; w.x = cvt_pk_bf16(h[0], h[1]); w.y = cvt_pk_bf16(h[2], h[3]); *((u32x2*)(H + (size_t)row * DM) + lane + 64 * q) = w; }
            } }
            fast_grid_barrier((unsigned*)ldp(tab, 40), tab);
            {
                BASES FFN_PTRS
                pg8::Gemm g{H, WU, MROWS, F2, 2048, 0, 0};
                pg8::StaticOrder S; S.init(g.M, g.N, G, (int)blockIdx.x, g.K, 1);
                pg8::Epi<FUp> E{FUp{U, OUTP + O_PCONV + (size_t)layer * 2 * 2 * F2, OUTP + O_SCONV + (size_t)layer * 16 * 2 * F2}};
                pg8::gemm_phase(ldsl, g, S, E);
            }
            fast_grid_barrier((unsigned*)ldp(tab, 40), tab);
            {
                PHASE_IDS BASES FFN_PTRS
                const float* cw = IN(36) + (size_t)layer * 3 * F2; const float* cb = IN(37) + (size_t)layer * F2;
                const float* cst = IN(5) + (size_t)layer * 16 * 2 * F2;
#pragma unroll 1
                for (int it = gtid; it < 544 * 704; it += NT) {
                    const int rc = it / 704, c8 = it - rc * 704, col = c8 * 8, r0 = rc * 32;
                    int t0, len, b; bool prompt; row_info(r0, t0, len, b, prompt);
                    float wv[3][8], wg[3][8], bv[8], bg[8];
#pragma unroll
                    for (int k = 0; k < 3; ++k) { const f32x4 a = *(const f32x4*)(cw + (size_t)k * F2 + col), a2 = *(const f32x4*)(cw + (size_t)k * F2 + col + 4);
                        const f32x4 g = *(const f32x4*)(cw + (size_t)k * F2 + FH + col), g2 = *(const f32x4*)(cw + (size_t)k * F2 + FH + col + 4);
#pragma unroll
                        for (int i = 0; i < 4; ++i) { wv[k][i] = a[i]; wv[k][4 + i] = a2[i]; wg[k][i] = g[i]; wg[k][4 + i] = g2[i]; } }
                    { const f32x4 a = *(const f32x4*)(cb + col), a2 = *(const f32x4*)(cb + col + 4), g = *(const f32x4*)(cb + FH + col), g2 = *(const f32x4*)(cb + FH + col + 4);
#pragma unroll
                      for (int i = 0; i < 4; ++i) { bv[i] = a[i]; bv[4 + i] = a2[i]; bg[i] = g[i]; bg[4 + i] = g2[i]; } }
                    float v2[8], v1[8], g2_[8], g1_[8];
                    if (t0 > 0) {
                        unpack8(*(const u32x4*)(U + (size_t)(r0 - 2) * F2 + col), v2); unpack8(*(const u32x4*)(U + (size_t)(r0 - 1) * F2 + col), v1);
                        unpack8(*(const u32x4*)(U + (size_t)(r0 - 2) * F2 + FH + col), g2_); unpack8(*(const u32x4*)(U + (size_t)(r0 - 1) * F2 + FH + col), g1_);
                    } else if (!prompt) {
                        const float* s0 = cst + ((size_t)b * 2) * F2 + col; const float* s1 = s0 + F2;
#pragma unroll
                        for (int i = 0; i < 8; ++i) { v2[i] = s0[i]; v1[i] = s1[i]; g2_[i] = s0[FH + i]; g1_[i] = s1[FH + i]; }
                    } else {
#pragma unroll
                        for (int i = 0; i < 8; ++i) { v2[i] = 0.f; v1[i] = 0.f; g2_[i] = 0.f; g1_[i] = 0.f; }
                    }
#pragma unroll 1
                    for (int rb = 0; rb < 32; rb += 8) {
                      u32x4 uv_[8], ug_[8];
#pragma unroll
                      for (int j = 0; j < 8; ++j) { uv_[j] = *(const u32x4*)(U + (size_t)(r0 + rb + j) * F2 + col); ug_[j] = *(const u32x4*)(U + (size_t)(r0 + rb + j) * F2 + FH + col); }
#pragma unroll
                      for (int j = 0; j < 8; ++j) {
                        const int r = rb + j;
                        float v0[8], g0[8];
                        unpack8(uv_[j], v0); unpack8(ug_[j], g0);
                        float y[8];
#pragma unroll
                        for (int i = 0; i < 8; ++i) {
                            const float cv = bv[i] + wv[0][i] * v2[i] + wv[1][i] * v1[i] + wv[2][i] * v0[i];
                            const float cg_ = bg[i] + wg[0][i] * g2_[i] + wg[1][i] * g1_[i] + wg[2][i] * g0[i];
                            y[i] = cg_ * sigmoidf_(cg_) * cv;
                            v2[i] = v1[i]; v1[i] = v0[i]; g2_[i] = g1_[i]; g1_[i] = g0[i];
                        }
                        *(u32x4*)(HID + (size_t)(r0 + r) * FH + col) = pack8(y);
                      }
                    }
                }
            }
            fast_grid_barrier((unsigned*)ldp(tab, 40), tab);
            {
                BASES FFN_PTRS
                pg8::Gemm g{HID, WD, MROWS, 2048, FH, 0, 0};
                pg8::StaticOrder S; S.init(g.M, g.N, G, (int)blockIdx.x, g.K, 4);
                pg8::Epi<FRes> E{FRes{X, (float*)(RA + 272 * MiB)}};
                pg8::gemm_phase(ldsl, g, S, E);
                fast_grid_barrier((unsigned*)ldp(tab, 40), tab);
                {
                    PHASE_IDS
                    const float* PART = (const float*)(RA + 272 * MiB); const int ntail = S.nwg - S.nFull;
                    if (S.S > 1) for (int idx = gtid; idx < ntail * 16384; idx += NT) {
                        const int tl = idx >> 14, r = (idx >> 6) & 255, c4 = idx & 63; int pm, pn; S.tile_pmpn(S.nFull + tl, pm, pn);
                        f32x4* xp = (f32x4*)(X + (size_t)(pm * 256 + r) * DM + pn * 256 + c4 * 4); f32x4 acc = *xp;
#pragma unroll
                        for (int part = 0; part < 4; ++part) acc += *(const f32x4*)(PART + (size_t)(part * 32 + tl) * 65536 + r * 256 + c4 * 4);
                        *xp = acc; }
                }
            }
            fast_grid_barrier((unsigned*)ldp(tab, 40), tab);
        }
    }
    {
        PHASE_IDS BASES
        const float* gn = IN(8);
        for (int row = gw; row < MROWS; row += NGW) {
            f32x4* xr = (f32x4*)(X + (size_t)row * DM) + lane; f32x4 x[8]; float ss = 0.f;
#pragma unroll
            for (int q = 0; q < 8; ++q) { x[q] = xr[64 * q]; ss += x[q][0] * x[q][0] + x[q][1] * x[q][1] + x[q][2] * x[q][2] + x[q][3] * x[q][3]; }
            const float rs = rsqrtf(wave_sum(ss, lane) * (1.f / DM) + 1e-6f);
#pragma unroll
            for (int q = 0; q < 8; ++q) { const f32x4 gg = *((const f32x4*)gn + lane + 64 * q); xr[64 * q] = x[q] * rs * gg; }
        }
    }
}

extern "C" void kernel_launch(void* const* d_in, const int* in_sizes, int n_in, void* d_out, int out_size, void* d_ws, size_t ws_size, hipStream_t stream) {
    static int grid = 0;
    if (grid == 0) {
        if (n_in != 39 || (size_t)out_size != O_TOTAL || ws_size < WS_END) {
            fprintf(stderr, "kernel_launch: unexpected shapes: n_in %d out %d ws %zu (need %zu)\n", n_in, out_size, ws_size, (size_t)WS_END); grid = -1; return; }
        int dev = 0, cus = 0, per_cu = 0;
        (void)hipGetDevice(&dev);
        (void)hipDeviceGetAttribute(&cus, hipDeviceAttributeMultiprocessorCount, dev);
        if (hipFuncSetAttribute((const void*)fwd_kernel, hipFuncAttributeMaxDynamicSharedMemorySize, LDS_BYTES) != hipSuccess) { fprintf(stderr, "kernel_launch: hipFuncSetAttribute failed\n"); grid = -1; return; }
        if (hipOccupancyMaxActiveBlocksPerMultiprocessor(&per_cu, (const void*)fwd_kernel, 512, LDS_BYTES) != hipSuccess || per_cu < 1) { fprintf(stderr, "kernel_launch: occupancy query says %d\n", per_cu); per_cu = 1; }
        (void)hipGetLastError();
        grid = cus * 1;
        if (grid <= 0) grid = 256;
    }
    if (grid < 0) return;
    P prm{};
    for (int i = 0; i < 39; ++i) prm.in[i] = (const float*)d_in[i];
    prm.out = (float*)d_out; prm.ws = (unsigned char*)d_ws;
    (void)hipMemsetAsync(d_ws, 0, 4096, stream);
    void* args[] = {&prm};
    hipError_t e = hipLaunchCooperativeKernel((const void*)fwd_kernel, dim3(grid), dim3(512), args, LDS_BYTES, stream);
    if (e != hipSuccess) fprintf(stderr, "cooperative launch failed: %s (grid %d)\n", hipGetErrorString(e), grid);
}
```

```cpp
#include <hip/hip_runtime.h>
#include <hip/hip_cooperative_groups.h>
#include <cstdio>
#include <cstdint>
namespace cg = cooperative_groups;

#define LAS __attribute__((address_space(3)))
typedef unsigned short bf16_t;
typedef short bf16x8 __attribute__((ext_vector_type(8)));
typedef float f32x4 __attribute__((ext_vector_type(4)));
typedef float f32x16 __attribute__((ext_vector_type(16)));
typedef unsigned u32x4 __attribute__((ext_vector_type(4)));
typedef unsigned u32x2 __attribute__((ext_vector_type(2)));

constexpr int DM = 2048, MROWS = 17408, MPROMPT = 16384;
constexpr int FH = 5632, F2 = 11264;
constexpr int LDS_BYTES = 147456;
constexpr size_t MiB = 1u << 20;
constexpr size_t WS_WT = 1 * MiB;
constexpr size_t WS_A = 411 * MiB;
constexpr size_t WS_B = 819 * MiB;
constexpr size_t WS_VF = 1227 * MiB;
constexpr size_t WS_END = 1295 * MiB;
constexpr size_t ACT = (size_t)MROWS * DM;
constexpr size_t RW_SZ = (size_t)7168 * 2048 + (size_t)8192 * 256 + (size_t)2048 * 2048;
constexpr size_t GW_SZ = (size_t)6400 * 2048 + (size_t)2048 * 2048;
constexpr size_t FW_SZ = (size_t)11264 * 2048 + (size_t)2048 * 5632;
constexpr size_t GW_OFF = 2 * RW_SZ, FW_OFF = GW_OFF + 2 * GW_SZ;
constexpr size_t O_PSHIFT = 35651584, O_PWKV = 35659776, O_PGLA = 36184064, O_PCONV = 38281216;
constexpr size_t O_SSHIFT = 38461440, O_SWKV = 38526976, O_SGLA = 42721280, O_SCONV = 59498496, O_TOTAL = 60940288;

__device__ __forceinline__ unsigned cvt_pk_bf16(float lo, float hi) { unsigned r; asm volatile("v_cvt_pk_bf16_f32 %0, %1, %2" : "=v"(r) : "v"(lo), "v"(hi)); return r; }
__device__ __forceinline__ float bf2f(bf16_t b) { return __builtin_bit_cast(float, (unsigned)b << 16); }
__device__ __forceinline__ float bflo(unsigned u) { return __builtin_bit_cast(float, u << 16); }
__device__ __forceinline__ float bfhi(unsigned u) { return __builtin_bit_cast(float, u & 0xffff0000u); }
__device__ __forceinline__ void unpack8(u32x4 w, float (&f)[8]) {
    f[0] = bflo(w.x); f[1] = bfhi(w.x); f[2] = bflo(w.y); f[3] = bfhi(w.y); f[4] = bflo(w.z); f[5] = bfhi(w.z); f[6] = bflo(w.w); f[7] = bfhi(w.w);
}
__device__ __forceinline__ u32x4 pack8(const float (&f)[8]) {
    u32x4 w; w.x = cvt_pk_bf16(f[0], f[1]); w.y = cvt_pk_bf16(f[2], f[3]); w.z = cvt_pk_bf16(f[4], f[5]); w.w = cvt_pk_bf16(f[6], f[7]); return w;
}
__device__ __forceinline__ float sigmoidf_(float x) { return 1.f / (1.f + __expf(-x)); }
__device__ __forceinline__ float shx(float v, int lane, int o) { return __builtin_bit_cast(float, __builtin_amdgcn_ds_bpermute((lane ^ o) << 2, __builtin_bit_cast(int, v))); }
__device__ __forceinline__ float wave_sum(float v, int lane) {
#pragma unroll
    for (int o = 1; o < 64; o <<= 1) v += shx(v, lane, o);
    return v;
}
__device__ __forceinline__ float sum8(float v, int lane) { v += shx(v, lane, 1); v += shx(v, lane, 2); v += shx(v, lane, 4); return v; }
__device__ __forceinline__ int crow(int reg, int h) { return (reg & 3) + 8 * (reg >> 2) + 4 * h; }

namespace pg8 {
constexpr int BM = 256, BK = 64, HALF = 128, HTB = HALF * BK * 2, STAGE_BYTES = 8 * HTB, NXCD = 8, WGM = 8;
__host__ __device__ __forceinline__ int lds_byte(int r, int c) { const int st = (r >> 4) * 2 + (c >> 5), rr = r & 15, cc = c & 31, ob = rr * 64 + cc * 2; return st * 1024 + (ob ^ (((ob >> 9) & 1) << 5)); }
__host__ __device__ __forceinline__ void stage_rc(int b, int& R, int& C) { const int st = b / 1024, sb = b % 1024, swz = sb ^ (((sb >> 9) & 1) << 5); R = (st >> 1) * 16 + swz / 64; C = (st & 1) * 32 + (swz % 64) / 2; }
__host__ __device__ __forceinline__ int perm32(int rho) { const int n = rho >> 4, i = rho & 15; return 8 * (i >> 2) + 4 * n + (i & 3); }

struct Unit { int pm, pn, kofs, knt, split; };
struct Gemm { const bf16_t* A; const bf16_t* Bt; int M, N, K; int mode; size_t astride; };
__device__ __forceinline__ const char* a_of(const Gemm& g, int pn) {
    int s = 0;
    if (g.mode == 1) s = pn < 8 ? 0 : pn < 16 ? 2 : pn < 24 ? 3 : pn == 24 ? 1 : pn == 25 ? 4 : pn == 26 ? 5 : 3;
    else if (g.mode == 2) s = pn >> 3;
    return (const char*)g.A + (size_t)s * g.astride;
}
struct StaticOrder {
    int nM, nN, nwg, G, c, nFull, S, ntK, total;
    __device__ __forceinline__ void init(int M, int N, int G_, int c_, int K = 0, int S_ = 1) { nM = M / BM; nN = N / BM; nwg = nM * nN; G = G_; c = c_; ntK = K / BK;
        nFull = (nwg / G) * G; S = S_; if (S_ <= 1 || nFull == nwg) { S = 1; nFull = nwg; } total = nFull + (nwg - nFull) * S; }
    __device__ __forceinline__ bool next(int i, Unit& u) const {
        const long L = (long)i * G + c; if (L >= total) return false;
        int wgid;
        if (L < nFull) { wgid = (int)L; u.kofs = 0; u.knt = ntK; u.split = 0; }
        else { const int j = (int)L - nFull; wgid = nFull + j / S; const int part = j % S; u.knt = ntK / S; u.kofs = part * u.knt * BK; u.split = 1 + part * 32 + j / S; }
        tile_pmpn(wgid, u.pm, u.pn); return true;
    }
    __device__ __forceinline__ void tile_pmpn(int wgid, int& pm, int& pn) const {
        { const int q = nwg / NXCD, r = nwg % NXCD, xcd = wgid % NXCD, off = wgid / NXCD; wgid = (xcd < r ? xcd * (q + 1) : r * (q + 1) + (xcd - r) * q) + off; }
        const int nig = WGM * nN, gid = wgid / nig, fm = gid * WGM, gsz = (nM - fm) < WGM ? (nM - fm) : WGM;
        pm = fm + ((wgid % nig) % gsz); pn = (wgid % nig) / gsz;
    }
};

template <class F> struct Epi {
    static constexpr bool PERM = true;
    F f;
    __device__ __forceinline__ void operator()(const f32x4 (&acc)[2][2][4][2], const Unit& u, int wr, int wc, int fr, int fq) const {
        { int t_ = threadIdx.x; asm volatile("" : "+v"(t_)); const int l_ = t_ & 63, w_ = __builtin_amdgcn_readfirstlane(t_ >> 6); fr = l_ & 15; fq = l_ >> 4; wr = w_ >> 2; wc = w_ & 3; }
        const int row0 = u.pm * BM + wr * 64 + fr, col0 = u.pn * BM + wc * 32 + 8 * fq;
#pragma unroll
        for (int ai = 0; ai < 2; ++ai)
#pragma unroll
            for (int m = 0; m < 4; ++m)
#pragma unroll
                for (int bj = 0; bj < 2; ++bj) f(row0 + ai * HALF + m * 16, col0 + bj * HALF, acc[ai][bj][m][0], acc[ai][bj][m][1], u.split);
    }
};

template <class EpiT>
__device__ __forceinline__ void gemm_phase(LAS unsigned char* lds, const Gemm g, const StaticOrder& S, const EpiT& E) {
    int tid = threadIdx.x; asm volatile("" : "+v"(tid));
    const int wid = __builtin_amdgcn_readfirstlane(tid >> 6), lane = tid & 63, wr = wid >> 2, wc = wid & 3, fr = lane & 15, fq = lane >> 4;
    const int K = g.K;
    unsigned voffA[2], voffB[2];
#pragma unroll
    for (int i = 0; i < 2; ++i) { int R, C; stage_rc(tid * 16 + i * 8192, R, C); const int Rb = EpiT::PERM ? ((R & ~31) + perm32(R & 31)) : R;
        voffA[i] = (unsigned)(R * K + C) * 2u; voffB[i] = (unsigned)(Rb * K + C) * 2u; }
    const size_t kstep = (size_t)(BK * 2);
    const size_t hstep = (size_t)HALF * K * 2;
    const size_t tstep = 2 * hstep;
    const unsigned ldsw = (unsigned)wid * 1024u;
    const int aoff = lds_byte(wr * 64 + fr, fq * 8), boff = lds_byte(wc * 32 + fr, fq * 8);
#define PG8_SA(b, h) (((b) * 2 + (h)) * HTB)
#define PG8_SB(b, h) ((4 + (b) * 2 + (h)) * HTB)
#define PG8_STAGE(bufoff, gbase, voff) do { _Pragma("unroll") for (int _i = 0; _i < 2; ++_i) \
        __builtin_amdgcn_global_load_lds((const unsigned*)((const char*)(gbase) + (voff)[_i]), (LAS unsigned*)(lds + (bufoff) + ldsw + _i * 8192), 16, 0, 0); } while (0)
#define PG8_LDA(dst, b, h) do { _Pragma("unroll") for (int m = 0; m < 4; ++m) _Pragma("unroll") for (int k = 0; k < 2; ++k) dst[m][k] = *(const LAS bf16x8*)(lds + PG8_SA(b, h) + aoff + m * 2048 + k * 1024); } while (0)
#define PG8_LDB(dst, b, h) do { _Pragma("unroll") for (int n = 0; n < 2; ++n) _Pragma("unroll") for (int k = 0; k < 2; ++k) dst[n][k] = *(const LAS bf16x8*)(lds + PG8_SB(b, h) + boff + n * 2048 + k * 1024); } while (0)
#define PG8_MMA(ai, bj, At, Bt) do { __builtin_amdgcn_s_setprio(1); _Pragma("unroll") for (int m = 0; m < 4; ++m) _Pragma("unroll") for (int n = 0; n < 2; ++n) _Pragma("unroll") for (int k = 0; k < 2; ++k) \
        acc[ai][bj][m][n] = __builtin_amdgcn_mfma_f32_16x16x32_bf16(Bt[n][k], At[m][k], acc[ai][bj][m][n], 0, 0, 0); __builtin_amdgcn_s_setprio(0); } while (0)
#define PG8_WAIT_V(n) asm volatile("s_waitcnt vmcnt(" #n ")" ::: "memory")
#define PG8_WAIT_L(n) asm volatile("s_waitcnt lgkmcnt(" #n ")" ::: "memory")
#define PG8_BAR __builtin_amdgcn_s_barrier()
#define PG8_SCHED __builtin_amdgcn_sched_barrier(0)
    Unit cur, nxt; int ui = 0;
    if (!S.next(0, cur)) return;
    f32x4 acc[2][2][4][2];
#pragma unroll
    for (int a = 0; a < 2; ++a)
#pragma unroll
        for (int b = 0; b < 2; ++b)
#pragma unroll
            for (int m = 0; m < 4; ++m)
#pragma unroll
                for (int n = 0; n < 2; ++n) acc[a][b][m][n] = (f32x4){0.f, 0.f, 0.f, 0.f};
    bf16x8 At[4][2], B0[2][2], B1[2][2];
    const char* cA = a_of(g, cur.pn) + (size_t)cur.pm * tstep + (size_t)cur.kofs * 2; const char* cB = (const char*)g.Bt + (size_t)cur.pn * tstep + (size_t)cur.kofs * 2;
    PG8_STAGE(PG8_SB(0, 0), cB, voffB); PG8_STAGE(PG8_SB(0, 1), cB + hstep, voffB); PG8_STAGE(PG8_SA(0, 0), cA, voffA); PG8_STAGE(PG8_SA(0, 1), cA + hstep, voffA);
    if (wr == 1) PG8_BAR;
    PG8_WAIT_V(2); PG8_BAR;
    PG8_STAGE(PG8_SB(1, 0), cB + kstep, voffB); PG8_STAGE(PG8_SA(1, 0), cA + kstep, voffA); PG8_STAGE(PG8_SB(1, 1), cB + hstep + kstep, voffB);
    PG8_WAIT_V(6); PG8_BAR;
    for (;;) {
        const bool has_next = S.next(ui + 1, nxt);
        const char* nA = has_next ? a_of(g, nxt.pn) + (size_t)nxt.pm * tstep + (size_t)nxt.kofs * 2 : cA; const char* nB = has_next ? (const char*)g.Bt + (size_t)nxt.pn * tstep + (size_t)nxt.kofs * 2 : cB;
        const int nt = cur.knt;
        for (int t = 0; t < nt; t += 2) {
            const bool last = (t == nt - 2);
            const char* a1 = cA + (size_t)(t + 1) * kstep;
            const char* a2 = last ? nA : cA + (size_t)(t + 2) * kstep; const char* b2 = last ? nB : cB + (size_t)(t + 2) * kstep;
            const char* a3 = a2 + kstep; const char* b3 = b2 + kstep;
            PG8_LDB(B0, 0, 0); PG8_LDB(B1, 0, 1); PG8_SCHED; PG8_LDA(At, 0, 0); PG8_STAGE(PG8_SA(1, 1), a1 + hstep, voffA);
            PG8_WAIT_V(8); PG8_WAIT_L(0); PG8_BAR; PG8_MMA(0, 0, At, B0); PG8_MMA(0, 1, At, B1); PG8_BAR; PG8_SCHED;
            PG8_LDA(At, 0, 1); PG8_STAGE(PG8_SB(0, 0), b2, voffB); PG8_STAGE(PG8_SB(0, 1), b2 + hstep, voffB); PG8_STAGE(PG8_SA(0, 0), a2, voffA);
            PG8_WAIT_V(8); PG8_WAIT_L(0); PG8_BAR; PG8_MMA(1, 0, At, B0); PG8_MMA(1, 1, At, B1); PG8_BAR; PG8_SCHED;
            PG8_LDB(B0, 1, 0); PG8_LDB(B1, 1, 1); PG8_SCHED; PG8_LDA(At, 1, 0); PG8_STAGE(PG8_SA(0, 1), a2 + hstep, voffA);
            PG8_WAIT_V(8); PG8_WAIT_L(0); PG8_BAR; PG8_MMA(0, 0, At, B0); PG8_MMA(0, 1, At, B1); PG8_BAR; PG8_SCHED;
            PG8_LDA(At, 1, 1); PG8_STAGE(PG8_SB(1, 0), b3, voffB); PG8_STAGE(PG8_SB(1, 1), b3 + hstep, voffB); PG8_STAGE(PG8_SA(1, 0), a3, voffA);
            PG8_WAIT_V(8); PG8_WAIT_L(0); PG8_BAR; PG8_MMA(1, 0, At, B0); PG8_MMA(1, 1, At, B1); PG8_BAR; PG8_SCHED;
        }
        if (wr == 0) PG8_BAR;
        E(acc, cur, wr, wc, fr, fq);
        if (!has_next) break;
#pragma unroll
        for (int a = 0; a < 2; ++a)
#pragma unroll
            for (int b = 0; b < 2; ++b)
#pragma unroll
                for (int m = 0; m < 4; ++m)
#pragma unroll
                    for (int n = 0; n < 2; ++n) acc[a][b][m][n] = (f32x4){0.f, 0.f, 0.f, 0.f};
        cur = nxt; cA = nA; cB = nB; ++ui;
        if (wr == 1) PG8_BAR;
    }
    PG8_WAIT_V(0);
    PG8_BAR;
#undef PG8_SA
#undef PG8_SB
#undef PG8_STAGE
#undef PG8_LDA
#undef PG8_LDB
#undef PG8_MMA
#undef PG8_WAIT_V
#undef PG8_WAIT_L
#undef PG8_BAR
#undef PG8_SCHED
}
}

__device__ __forceinline__ void store8bf(bf16_t* p, f32x4 a, f32x4 b) {
    u32x4 w; w.x = cvt_pk_bf16(a[0], a[1]); w.y = cvt_pk_bf16(a[2], a[3]); w.z = cvt_pk_bf16(b[0], b[1]); w.w = cvt_pk_bf16(b[2], b[3]);
    *(u32x4*)p = w;
}
struct FRes { float* X; float* PART;
    __device__ __forceinline__ void operator()(int row, int col, f32x4 a, f32x4 b, int split) const {
        float* p = X + (size_t)row * DM + col;
        if (split) { float* q = PART + (size_t)(split - 1) * 65536 + (row & 255) * 256 + (col & 255); *(f32x4*)q = a; *(f32x4*)(q + 4) = b; }
        else { f32x4 x0 = *(f32x4*)p, x1 = *(f32x4*)(p + 4); *(f32x4*)p = x0 + a; *(f32x4*)(p + 4) = x1 + b; } } };
struct FR1 { bf16_t *R, *K, *V, *L;
    __device__ __forceinline__ void operator()(int row, int col, f32x4 a, f32x4 b, int) const {
        if (col < 6144) { const int g = col >> 11; const size_t o = (size_t)row * DM + (col & 2047); if (g == 0) store8bf(R + o, a, b); else if (g == 1) store8bf(K + o, a, b); else store8bf(V + o, a, b); }
        else { const int t = (col - 6144) >> 8, c = col & 255;
            if (t == 0) { for (int i = 0; i < 4; ++i) { a[i] = 1.f - 2.f / (1.f + __expf(2.f * a[i])); b[i] = 1.f - 2.f / (1.f + __expf(2.f * b[i])); } }
            else if (t == 2) { for (int i = 0; i < 4; ++i) { a[i] = sigmoidf_(a[i]); b[i] = sigmoidf_(b[i]); } }
            store8bf(L + (size_t)t * MROWS * 256 + (size_t)row * 256 + c, a, b); } } };
__device__ __forceinline__ float decay_of(float z) { return -0.60653065971f / (1.f + __expf(-z)); }
struct FR2 { float* DD; bf16_t *AA, *GG, *VG; const float *w0, *a0, *v0;
    __device__ __forceinline__ void operator()(int row, int col, f32x4 a, f32x4 b, int) const {
        const int g = col >> 11, c = col & 2047; const size_t off = (size_t)row * DM + c;
        if (g == 0) { f32x4 z0 = *(const f32x4*)(w0 + c), z1 = *(const f32x4*)(w0 + c + 4); a += z0; b += z1;
            for (int i = 0; i < 4; ++i) { a[i] = decay_of(a[i]); b[i] = decay_of(b[i]); }
            *(f32x4*)(DD + off) = a; *(f32x4*)(DD + off + 4) = b; }
        else if (g == 1) { f32x4 z0 = *(const f32x4*)(a0 + c), z1 = *(const f32x4*)(a0 + c + 4); a += z0; b += z1;
            for (int i = 0; i < 4; ++i) { a[i] = sigmoidf_(a[i]); b[i] = sigmoidf_(b[i]); } store8bf(AA + off, a, b); }
        else if (g == 2) { store8bf(GG + off, a, b); }
        else { f32x4 z0 = *(const f32x4*)(v0 + c), z1 = *(const f32x4*)(v0 + c + 4); a += z0; b += z1;
            for (int i = 0; i < 4; ++i) { a[i] = sigmoidf_(a[i]); b[i] = sigmoidf_(b[i]); } store8bf(VG + off, a, b); } } };
struct FG1 { bf16_t* PROJ; float* LR;
    __device__ __forceinline__ void operator()(int row, int col, f32x4 a, f32x4 b, int) const {
        if (col < 6144) { if (col < 1024) { a *= 0.0625f; b *= 0.0625f; } store8bf(PROJ + (size_t)row * 6144 + col, a, b); }
        else if (col < 6160) { float* p = LR + (size_t)row * 16 + (col - 6144); *(f32x4*)p = a; *(f32x4*)(p + 4) = b; } } };
struct FUp { bf16_t* U; float* pconv; float* sconv;
    __device__ __forceinline__ void operator()(int row, int col, f32x4 a, f32x4 b, int) const {
        store8bf(U + (size_t)row * F2 + col, a, b);
        if (row < MPROMPT) { const int t = row & 8191; if (t >= 8190) { float* p = pconv + ((size_t)((row >> 13) * 2 + (t - 8190))) * F2 + col; *(f32x4*)p = a; *(f32x4*)(p + 4) = b; } }
        else { const int rr = row - MPROMPT, t = rr & 63; if (t >= 62) { float* p = sconv + ((size_t)((rr >> 6) * 2 + (t - 62))) * F2 + col; *(f32x4*)p = a; *(f32x4*)(p + 4) = b; } } } };

__device__ __forceinline__ void tr_item(const float* W, int K, int N, bf16_t* WT, int Kpad, int Npad, float* scr, int item, int lane) {
    const int nblk = Npad / 64, kb = item / nblk, nb = item % nblk, k0 = 64 * kb, n0 = 64 * nb;
    const int n4 = n0 + (lane & 15) * 4;
    f32x4 v[16];
#pragma unroll
    for (int i = 0; i < 16; ++i) { const int k = k0 + 4 * i + (lane >> 4); v[i] = (k < K && n4 < N) ? *(const f32x4*)(W + (size_t)k * N + n4) : (f32x4){0.f, 0.f, 0.f, 0.f}; }
#pragma unroll
    for (int i = 0; i < 16; ++i) { float* d = scr + (4 * i + (lane >> 4)) * 65 + (lane & 15) * 4; d[0] = v[i][0]; d[1] = v[i][1]; d[2] = v[i][2]; d[3] = v[i][3]; }
    asm volatile("s_waitcnt lgkmcnt(0)" ::: "memory");
    const int c = lane & 7;
#pragma unroll
    for (int j = 0; j < 8; ++j) { const int nn = (lane >> 3) + 8 * j; const float* s = scr + (8 * c) * 65 + nn;
        u32x4 o; o.x = cvt_pk_bf16(s[0 * 65], s[1 * 65]); o.y = cvt_pk_bf16(s[2 * 65], s[3 * 65]); o.z = cvt_pk_bf16(s[4 * 65], s[5 * 65]); o.w = cvt_pk_bf16(s[6 * 65], s[7 * 65]);
        *(u32x4*)(WT + (size_t)(n0 + nn) * Kpad + k0 + 8 * c) = o; }
    asm volatile("s_waitcnt lgkmcnt(0)" ::: "memory");
}

struct P { const float* in[39]; float* out; unsigned char* ws; };

__device__ __forceinline__ void row_info(int row, int& t, int& len, int& b, bool& prompt) {
    if (row < MPROMPT) { prompt = true; b = row >> 13; t = row & 8191; len = 8192; }
    else { prompt = false; const int rr = row - MPROMPT; b = rr >> 6; t = rr & 63; len = 64; }
}

__device__ __forceinline__ const float* ldp(const unsigned long long* tab, int i) {
    const unsigned long long v = tab[i];
    const unsigned lo = __builtin_amdgcn_readfirstlane((unsigned)v), hi = __builtin_amdgcn_readfirstlane((unsigned)(v >> 32));
    const __attribute__((address_space(1))) float* g = (const __attribute__((address_space(1))) float*)(((unsigned long long)hi << 32) | lo);
    return (const float*)g;
}
__device__ __forceinline__ void fast_grid_barrier(unsigned* bar, unsigned long long* tab) {
    asm volatile("s_waitcnt vmcnt(0)" ::: "memory");
    __syncthreads();
    if (threadIdx.x == 0) {
        const unsigned G = gridDim.x, grp = blockIdx.x & 7u;
        const unsigned epoch = (unsigned)tab[41] + 1u; tab[41] = epoch;
        const unsigned ngrp = (G - grp + 7u) >> 3, ntop = G < 8u ? G : 8u;
        __builtin_amdgcn_fence(__ATOMIC_RELEASE, "agent");
        asm volatile("s_waitcnt vmcnt(0)" ::: "memory");
        const unsigned old = __hip_atomic_fetch_add(&bar[64u * (1u + grp)], 1u, __ATOMIC_RELAXED, __HIP_MEMORY_SCOPE_AGENT);
        if (old + 1u == epoch * ngrp) (void)__hip_atomic_fetch_add(&bar[0], 1u, __ATOMIC_RELAXED, __HIP_MEMORY_SCOPE_AGENT);
        while (__hip_atomic_load(&bar[0], __ATOMIC_RELAXED, __HIP_MEMORY_SCOPE_AGENT) < epoch * ntop) __builtin_amdgcn_s_sleep(1);
        __builtin_amdgcn_fence(__ATOMIC_ACQUIRE, "agent");
        asm volatile("s_waitcnt vmcnt(0)" ::: "memory");
    }
    __syncthreads();
}
#define IN(k) ldp(tab, (k))
#define OUTP ((float*)ldp(tab, 39))
#define BASES float* X = (float*)ldp(tab, 39); unsigned char* ws_ = (unsigned char*)ldp(tab, 40); bf16_t* WT = (bf16_t*)(ws_ + WS_WT); unsigned char* RA = ws_ + WS_A; unsigned char* RB = ws_ + WS_B; \
    bf16_t* VFIRST = (bf16_t*)(ws_ + WS_VF); LAS unsigned char* ldsl = (LAS unsigned char*)lds; (void)X; (void)WT; (void)RA; (void)RB; (void)VFIRST; (void)ldsl;
#define RWKV_PTRS bf16_t* HB = (bf16_t*)RA; bf16_t* Rb = (bf16_t*)RB; bf16_t* Kb = Rb + ACT; bf16_t* Vb = (jl == 0) ? VFIRST : Kb + ACT; bf16_t* Lb = (bf16_t*)(RB + 204 * MiB); \
    float* DD = (float*)(RB + 240 * MiB); bf16_t* AA = (bf16_t*)RA; bf16_t* VG = AA + ACT; bf16_t* GG = VG + ACT; bf16_t* Y = GG + ACT; \
    bf16_t* W1 = WT + jl * RW_SZ; bf16_t* W2 = W1 + (size_t)7168 * 2048; bf16_t* WO = W2 + (size_t)8192 * 256; \
    (void)HB; (void)Rb; (void)Kb; (void)Vb; (void)Lb; (void)DD; (void)AA; (void)VG; (void)GG; (void)Y; (void)W1; (void)W2; (void)WO;
#define GLA_PTRS bf16_t* H = (bf16_t*)RB; float* LR = (float*)(RB + 68 * MiB); float* O = (float*)(RB + 70 * MiB); bf16_t* Y = (bf16_t*)(RB + 206 * MiB); \
    bf16_t* PROJ = (bf16_t*)RA; bf16_t* QE = (bf16_t*)(RA + 204 * MiB); bf16_t* KDT = (bf16_t*)(RA + 238 * MiB); bf16_t* VT = (bf16_t*)(RA + 272 * MiB); \
    bf16_t* SC = (bf16_t*)(RA + 340 * MiB); float* EL = (float*)(RA + 349 * MiB); bf16_t* GI = WT + GW_OFF + jl * GW_SZ; bf16_t* GO = GI + (size_t)6400 * 2048; \
    (void)H; (void)LR; (void)O; (void)Y; (void)PROJ; (void)QE; (void)KDT; (void)VT; (void)SC; (void)EL; (void)GI; (void)GO;
#define FFN_PTRS bf16_t* H = (bf16_t*)RB; bf16_t* HID = (bf16_t*)(RB + 68 * MiB); bf16_t* U = (bf16_t*)RA; bf16_t* WU = WT + FW_OFF + layer * FW_SZ; bf16_t* WD = WU + (size_t)F2 * 2048; \
    (void)H; (void)HID; (void)U; (void)WU; (void)WD;

__global__ void __launch_bounds__(512, 2) fwd_kernel(P p) {
    extern __shared__ __attribute__((aligned(16))) unsigned char lds[];
    cg::grid_group grid = cg::this_grid();
    const int G = gridDim.x, NGW = G * 8, NT = G * 512;
#define PHASE_IDS int tid = threadIdx.x; asm volatile("" : "+v"(tid)); const int lane = tid & 63; const int wave = __builtin_amdgcn_readfirstlane(tid >> 6); const int gw = blockIdx.x * 8 + wave; const int gtid = blockIdx.x * 512 + tid; (void)lane; (void)gw; (void)gtid;
    unsigned long long* tab = (unsigned long long*)(lds + LDS_BYTES - 512);
    if (threadIdx.x == 0) {
#pragma unroll
        for (int i = 0; i < 39; ++i) tab[i] = (unsigned long long)p.in[i];
        tab[39] = (unsigned long long)p.out; tab[40] = (unsigned long long)p.ws; tab[41] = 0ull;
    }
    __syncthreads();

    {
        PHASE_IDS BASES
        float* scr = (float*)(lds + wave * 16896);
#define TR(src, K, N, dst, Kpad, Npad) do { const int _ni = ((Kpad) / 64) * ((Npad) / 64); for (int it = cgw_; it < _ni; it += cngw_) tr_item((src), (K), (N), (dst), (Kpad), (Npad), scr, it, lane); } while (0)
#define CONVERT_WEIGHTS(JLO, JHI, ILO, IHI, GWV, NGWV) do { const int cgw_ = (GWV), cngw_ = (NGWV); \
        _Pragma("unroll 1") for (int j = (JLO); j < (JHI); ++j) { \
            bf16_t* W1 = WT + j * RW_SZ; bf16_t* W2 = W1 + (size_t)7168 * 2048; bf16_t* WO = W2 + (size_t)8192 * 256; \
            TR(IN(24) + (size_t)j * DM * DM, 2048, 2048, W1, 2048, 2048); \
            TR(IN(25) + (size_t)j * DM * DM, 2048, 2048, W1 + (size_t)2048 * 2048, 2048, 2048); \
            TR(IN(26) + (size_t)j * DM * DM, 2048, 2048, W1 + (size_t)4096 * 2048, 2048, 2048); \
            TR(IN(11) + (size_t)j * DM * 96, 2048, 96, W1 + (size_t)6144 * 2048, 2048, 256); \
            TR(IN(14) + (size_t)j * DM * 96, 2048, 96, W1 + (size_t)6400 * 2048, 2048, 256); \
            TR(IN(19) + (size_t)j * DM * 256, 2048, 256, W1 + (size_t)6656 * 2048, 2048, 256); \
            if (j >= 1) TR(IN(17) + (size_t)(j - 1) * DM * 64, 2048, 64, W1 + (size_t)6912 * 2048, 2048, 256); \
            TR(IN(12) + (size_t)j * 96 * DM, 96, 2048, W2, 256, 2048); \
            TR(IN(15) + (size_t)j * 96 * DM, 96, 2048, W2 + (size_t)2048 * 256, 256, 2048); \
            TR(IN(20) + (size_t)j * 256 * DM, 256, 2048, W2 + (size_t)4096 * 256, 256, 2048); \
            if (j >= 1) TR(IN(18) + (size_t)(j - 1) * 64 * DM, 64, 2048, W2 + (size_t)6144 * 256, 256, 2048); \
            TR(IN(27) + (size_t)j * DM * DM, 2048, 2048, WO, 2048, 2048); \
            bf16_t* GI = WT + GW_OFF + j * GW_SZ; bf16_t* GO = GI + (size_t)6400 * 2048; \
            TR(IN(30) + (size_t)j * DM * 6160, 2048, 6160, GI, 2048, 6400); \
            TR(IN(34) + (size_t)j * DM * DM, 2048, 2048, GO, 2048, 2048); \
        } \
        _Pragma("unroll 1") for (int i = (ILO); i < (IHI); ++i) { \
            bf16_t* WU = WT + FW_OFF + i * FW_SZ; bf16_t* WD = WU + (size_t)F2 * 2048; \
            TR(IN(35) + (size_t)i * DM * F2, 2048, F2, WU, 2048, F2); \
            TR(IN(38) + (size_t)i * FH * DM, FH, 2048, WD, FH, 2048); \
        } } while (0)
        if (G >= 256) CONVERT_WEIGHTS(0, 1, 0, 2, gw, NGW); else CONVERT_WEIGHTS(0, 2, 0, 4, gw, NGW);
        const f32x4* xp = (const f32x4*)IN(0); const f32x4* xs = (const f32x4*)IN(1); f32x4* xo = (f32x4*)X;
        const int NP4 = MPROMPT * DM / 4, NA4 = MROWS * DM / 4;
#pragma unroll 4
        for (int i = gtid; i < NA4; i += NT) xo[i] = i < NP4 ? xp[i] : xs[i - NP4];
    }
    grid.sync();

#pragma clang loop unroll(full)
    for (int layer = 0; layer < 4; ++layer) {
        const int jl = layer >> 1;
        if ((layer & 1) == 0) {
            {
                PHASE_IDS BASES RWKV_PTRS
                const float* gmix = IN(6) + (size_t)layer * DM;
                const float* mix = IN(9) + (size_t)jl * 6 * DM;
                const float* sst = IN(2) + (size_t)jl * 16 * DM;
                for (int row = gw; row < MROWS; row += NGW) {
                    int t, len, b; bool prompt; row_info(row, t, len, b, prompt);
                    const f32x4* xr = (const f32x4*)(X + (size_t)row * DM) + lane;
                    f32x4 x[8]; float ss = 0.f;
#pragma unroll
                    for (int q = 0; q < 8; ++q) { x[q] = xr[64 * q]; ss += x[q][0] * x[q][0] + x[q][1] * x[q][1] + x[q][2] * x[q][2] + x[q][3] * x[q][3]; }
                    const float rs = rsqrtf(wave_sum(ss, lane) * (1.f / DM) + 1e-6f);
                    f32x4 hp[8];
                    if (t > 0) {
                        const f32x4* xq = (const f32x4*)(X + (size_t)(row - 1) * DM) + lane; float s2 = 0.f;
#pragma unroll
                        for (int q = 0; q < 8; ++q) { hp[q] = xq[64 * q]; s2 += hp[q][0] * hp[q][0] + hp[q][1] * hp[q][1] + hp[q][2] * hp[q][2] + hp[q][3] * hp[q][3]; }
                        const float rp = rsqrtf(wave_sum(s2, lane) * (1.f / DM) + 1e-6f);
#pragma unroll
                        for (int q = 0; q < 8; ++q) { const f32x4 gg = *((const f32x4*)gmix + lane + 64 * q); hp[q] = hp[q] * rp * gg; }
                    } else if (!prompt) {
#pragma unroll
                        for (int q = 0; q < 8; ++q) hp[q] = *((const f32x4*)(sst + (size_t)b * DM) + lane + 64 * q);
                    } else {
#pragma unroll
                        for (int q = 0; q < 8; ++q) hp[q] = (f32x4){0.f, 0.f, 0.f, 0.f};
                    }
                    const bool lastrow = (t == len - 1);
                    float* shout = OUTP + (prompt ? O_PSHIFT + ((size_t)jl * 2 + b) * DM : O_SSHIFT + ((size_t)jl * 16 + b) * DM);
#pragma unroll
                    for (int q = 0; q < 8; ++q) {
                        const f32x4 gg = *((const f32x4*)gmix + lane + 64 * q);
                        const f32x4 h = x[q] * rs * gg; const f32x4 dlt = hp[q] - h;
                        if (lastrow) *((f32x4*)shout + lane + 64 * q) = h;
#pragma unroll
                        for (int m = 0; m < 6; ++m) {
                            const f32x4 mx = *((const f32x4*)(mix + (size_t)m * DM) + lane + 64 * q);
                            const f32x4 o = h + dlt * mx;
                            u32x2 w; w.x = cvt_pk_bf16(o[0], o[1]); w.y = cvt_pk_bf16(o[2], o[3]);
                            *((u32x2*)(HB + (size_t)m * ACT + (size_t)row * DM) + lane + 64 * q) = w;
                        }
                    }
                }
            }
            fast_grid_barrier((unsigned*)ldp(tab, 40), tab);
            {
                BASES RWKV_PTRS
                pg8::Gemm g{HB, W1, MROWS, jl == 0 ? 6912 : 7168, 2048, 1, ACT * 2};
                pg8::StaticOrder S; S.init(g.M, g.N, G, (int)blockIdx.x, g.K, 1);
                pg8::Epi<FR1> E{FR1{Rb, Kb, Vb, Lb}};
                pg8::gemm_phase(ldsl, g, S, E);
            }
            fast_grid_barrier((unsigned*)ldp(tab, 40), tab);
            {
                BASES RWKV_PTRS
                pg8::Gemm g{Lb, W2, MROWS, jl == 0 ? 6144 : 8192, 256, 2, (size_t)MROWS * 256 * 2};
                pg8::StaticOrder S; S.init(g.M, g.N, G, (int)blockIdx.x, g.K, 1);
                pg8::Epi<FR2> E{FR2{DD, AA, GG, VG, IN(10) + (size_t)jl * DM, IN(13) + (size_t)jl * DM, IN(16) + (size_t)(jl > 0 ? jl - 1 : 0) * DM}};
                pg8::gemm_phase(ldsl, g, S, E);
            }
            fast_grid_barrier((unsigned*)ldp(tab, 40), tab);
            {
                PHASE_IDS BASES RWKV_PTRS
                float* Obuf = (float*)(RA + 272 * MiB); float* RK = (float*)(RB + 204 * MiB); float* DTg = (float*)(RB + 208 * MiB);
                const float* k_k = IN(21) + (size_t)jl * DM; const float* k_a = IN(22) + (size_t)jl * DM; const float* r_k = IN(23) + (size_t)jl * DM;
                const int l32 = lane & 31, hl = lane >> 5;
#define S1_BAR do { asm volatile("s_waitcnt lgkmcnt(0)" ::: "memory"); __builtin_amdgcn_s_barrier(); asm volatile("" ::: "memory"); } while (0)
                const int st = tid >> 3, c0 = (tid & 7) * 8;
                u32x4 pr_, pk_, pv_, pa_, pvf_ = (u32x4){0u, 0u, 0u, 0u}, pvg_ = (u32x4){0u, 0u, 0u, 0u}; f32x4 pd0_, pd1_;
#define S1_FETCH(it) do { const size_t _off = (size_t)(((it) >> 5) * 64 + st) * DM + ((it) & 31) * 64 + c0; \
                    pr_ = *(const u32x4*)(Rb + _off); pk_ = *(const u32x4*)(Kb + _off); pv_ = *(const u32x4*)(Vb + _off); pa_ = *(const u32x4*)(AA + _off); \
                    pd0_ = *(const f32x4*)(DD + _off); pd1_ = *(const f32x4*)(DD + _off + 4); \
                    if (jl > 0) { pvf_ = *(const u32x4*)(VFIRST + _off); pvg_ = *(const u32x4*)(VG + _off); } } while (0)
#pragma unroll 1
                for (int item = blockIdx.x; item < 8704; item += G) {
                    LAS unsigned char* ldsv = (LAS unsigned char*)lds; asm volatile("" : "+v"(ldsv));
                    LAS bf16_t* AH = (LAS bf16_t*)(ldsv + 0); LAS bf16_t* RH = (LAS bf16_t*)(ldsv + 9216); LAS bf16_t* BH = (LAS bf16_t*)(ldsv + 18432); LAS bf16_t* KH = (LAS bf16_t*)(ldsv + 27648);
                    LAS bf16_t* BHT = (LAS bf16_t*)(ldsv + 36864); LAS bf16_t* KHT = (LAS bf16_t*)(ldsv + 46080); LAS bf16_t* VTs = (LAS bf16_t*)(ldsv + 55296); LAS bf16_t* XT = (LAS bf16_t*)(ldsv + 64512);
                    LAS float* AAB = (LAS float*)(ldsv + 82944); LAS bf16_t* AAK = (LAS bf16_t*)(ldsv + 99328); LAS bf16_t* ARB = (LAS bf16_t*)(ldsv + 108544); LAS bf16_t* ARK = (LAS bf16_t*)(ldsv + 117760);
                    LAS float* LB = (LAS float*)(ldsv + 126976); LAS float* DTS = (LAS float*)(ldsv + 143360);
                    (void)RH; (void)KH; (void)KHT;
                    const int chunk = item >> 5, h = item & 31, r0 = chunk * 64;
                    const int col = h * 64 + c0;
                    S1_FETCH(item);
                    float r[8], kk[8], bb[8], km[8], ld[8];
                    {
                        float k[8], v[8], a[8];
                        unpack8(pr_, r); unpack8(pk_, k); unpack8(pv_, v); unpack8(pa_, a);
                        const f32x4 d0 = pd0_, d1 = pd1_;
                        ld[0] = d0[0]; ld[1] = d0[1]; ld[2] = d0[2]; ld[3] = d0[3]; ld[4] = d1[0]; ld[5] = d1[1]; ld[6] = d1[2]; ld[7] = d1[3];
                        if (jl > 0) { float vf[8], vg[8]; unpack8(pvf_, vf); unpack8(pvg_, vg);
#pragma unroll
                            for (int i = 0; i < 8; ++i) v[i] = v[i] + (vf[i] - v[i]) * vg[i]; }
                        float ss = 0.f;
#pragma unroll
                        for (int i = 0; i < 8; ++i) { kk[i] = k[i] * k_k[col + i]; ss += kk[i] * kk[i]; }
                        ss = sum8(ss, lane);
                        const float inv = 1.f / fmaxf(sqrtf(ss), 1e-12f);
                        float rk = 0.f;
#pragma unroll
                        for (int i = 0; i < 8; ++i) { kk[i] *= inv; bb[i] = kk[i] * a[i]; km[i] = k[i] * (1.f + (a[i] - 1.f) * k_a[col + i]); rk += r[i] * km[i] * r_k[col + i]; }
                        rk = sum8(rk, lane);
                        if ((tid & 7) == 0) RK[(size_t)(r0 + st) * 32 + h] = rk;
                        *(LAS f32x4*)(LB + st * 64 + c0) = d0; *(LAS f32x4*)(LB + st * 64 + c0 + 4) = d1;
#pragma unroll
                        for (int i = 0; i < 8; i += 2) { const unsigned pk = cvt_pk_bf16(v[i], v[i + 1]); VTs[(c0 + i) * 72 + st] = (bf16_t)(pk & 0xffffu); VTs[(c0 + i + 1) * 72 + st] = (bf16_t)(pk >> 16); }
                    }
                    S1_BAR;
                    {
                        const int cc_ = tid & 63, tq_ = tid >> 6; float pf[8]; float run = 0.f;
#pragma unroll
                        for (int j = 0; j < 8; ++j) { run += LB[(8 * tq_ + j) * 64 + cc_]; pf[j] = run; }
                        AAB[tq_ * 64 + cc_] = run;
                        S1_BAR;
                        float ofs = 0.f;
#pragma unroll
                        for (int g = 0; g < 7; ++g) ofs += (g < tq_) ? AAB[g * 64 + cc_] : 0.f;
#pragma unroll
                        for (int j = 0; j < 8; ++j) LB[(8 * tq_ + j) * 64 + cc_] = pf[j] + ofs;
                    }
                    S1_BAR;
                    {
                        float ah[8], bh[8], kh[8], rh[8];
#pragma unroll
                        for (int i = 0; i < 8; ++i) { const float Lt = LB[st * 64 + c0 + i]; const float e3 = __expf(Lt), e2 = __expf(-Lt), e1 = __expf(Lt - ld[i]);
                            ah[i] = -kk[i] * e1; bh[i] = bb[i] * e2; kh[i] = km[i] * e2; rh[i] = r[i] * e3;
                            if (st == 63) { DTS[c0 + i] = e3; DTg[(size_t)item * 64 + c0 + i] = e3; } }
                        *(LAS u32x4*)(AH + st * 72 + c0) = pack8(ah); *(LAS u32x4*)(RH + st * 72 + c0) = pack8(rh);
                        *(LAS u32x4*)(BH + st * 72 + c0) = pack8(bh); *(LAS u32x4*)(KH + st * 72 + c0) = pack8(kh);
#pragma unroll
                        for (int i = 0; i < 8; i += 2) { const unsigned p1 = cvt_pk_bf16(bh[i], bh[i + 1]), p2 = cvt_pk_bf16(kh[i], kh[i + 1]);
                            BHT[(c0 + i) * 72 + st] = (bf16_t)(p1 & 0xffffu); BHT[(c0 + i + 1) * 72 + st] = (bf16_t)(p1 >> 16);
                            KHT[(c0 + i) * 72 + st] = (bf16_t)(p2 & 0xffffu); KHT[(c0 + i + 1) * 72 + st] = (bf16_t)(p2 >> 16); }
                    }
                    S1_BAR;
                    {
                        const int mi = wave & 3, rowsel = mi >> 1, tt = mi & 1;
#pragma unroll
                        for (int nn = 0; nn < 2; ++nn) {
                            const int colsel = wave >> 2, stl = nn; const int ni = 2 * colsel + nn;
                            f32x16 acc;
#pragma unroll
                            for (int i = 0; i < 16; ++i) acc[i] = 0.f;
                            if (stl <= tt) {
#pragma unroll
                                for (int ks = 0; ks < 4; ++ks) {
                                    const bf16x8 a = *(const LAS bf16x8*)(AH + (mi * 32 + l32) * 72 + ks * 16 + hl * 8);
                                    const bf16x8 b = *(const LAS bf16x8*)(BH + (ni * 32 + l32) * 72 + ks * 16 + hl * 8);
                                    acc = __builtin_amdgcn_mfma_f32_32x32x16_bf16(a, b, acc, 0, 0, 0);
                                }
                            }
#pragma unroll
                            for (int i = 0; i < 16; ++i) {
                                const int t = tt * 32 + crow(i, hl), s = stl * 32 + l32;
                                const bool keep = rowsel ? (s <= t) : (s < t);
                                const float val = keep ? acc[i] : 0.f;
                                if (rowsel == 0 && colsel == 0) AAB[t * 64 + s] = val;
                                else { LAS bf16_t* dst = (rowsel == 0) ? AAK : (colsel == 0 ? ARB : ARK); dst[t * 72 + s] = (bf16_t)(cvt_pk_bf16(val, 0.f) & 0xffffu); }
                            }
                        }
                    }
                    S1_BAR;
                    if (wave < 4) {
                        const int mt = wave >> 1, nt = wave & 1;
                        f32x16 acc;
#pragma unroll
                        for (int i = 0; i < 16; ++i) acc[i] = 0.f;
#pragma unroll
                        for (int ks = 0; ks < 4; ++ks) {
                            const bf16x8 a = *(const LAS bf16x8*)(AAK + (mt * 32 + l32) * 72 + ks * 16 + hl * 8);
                            const bf16x8 b = *(const LAS bf16x8*)(VTs + (nt * 32 + l32) * 72 + ks * 16 + hl * 8);
                            acc = __builtin_amdgcn_mfma_f32_32x32x16_bf16(a, b, acc, 0, 0, 0);
                        }
#pragma unroll
                        for (int i = 0; i < 16; ++i) LB[(mt * 32 + crow(i, hl)) * 64 + nt * 32 + l32] = acc[i];
                    }
                    S1_BAR;
                    {
                        const int colx = tid >> 2, par = tid & 3;
                        float Xp[4][4];
#pragma unroll
                        for (int i = 0; i < 4; ++i) { Xp[i][0] = 0.f; Xp[i][1] = 0.f; Xp[i][2] = 0.f; Xp[i][3] = 0.f; }
#pragma clang loop unroll(full)
                        for (int t = 0; t < 64; ++t) {
                            const float va_ = bf2f(AH[t * 72 + (colx & 63)]), vb_ = LB[t * 64 + (colx & 63)];
                            float a0 = par ? 0.f : ((colx < 64) ? va_ : vb_);
                            float a1 = 0.f, a2 = 0.f, a3 = 0.f;
#pragma clang loop unroll(full)
                            for (int i = 0; 16 * i < t; ++i) { const f32x4 w = *(const LAS f32x4*)(AAB + t * 64 + 16 * i + 4 * par);
                                a0 += w[0] * Xp[i][0]; a1 += w[1] * Xp[i][1]; a2 += w[2] * Xp[i][2]; a3 += w[3] * Xp[i][3]; }
                            float val = (a0 + a1) + (a2 + a3);
                            val += __builtin_bit_cast(float, __builtin_amdgcn_update_dpp(0, __builtin_bit_cast(int, val), 0xB1, 0xf, 0xf, false));
                            val += __builtin_bit_cast(float, __builtin_amdgcn_update_dpp(0, __builtin_bit_cast(int, val), 0x4E, 0xf, 0xf, false));
                            Xp[t >> 4][t & 3] = (par == ((t >> 2) & 3)) ? val : Xp[t >> 4][t & 3];
                            asm volatile("" : "+v"(Xp[t >> 4][t & 3]));
                        }
#pragma unroll
                        for (int i = 0; i < 4; ++i) { u32x2 w; w.x = cvt_pk_bf16(Xp[i][0], Xp[i][1]); w.y = cvt_pk_bf16(Xp[i][2], Xp[i][3]);
                            *(LAS u32x2*)(XT + colx * 72 + 16 * i + 4 * par) = w; }
                    }
                    S1_BAR;
                    {
                        const int kind = wave >> 2, mt = (wave & 3) >> 1, nt = wave & 1;
                        {
                            const LAS bf16_t* Ap = (kind == 0 ? ARB : BHT) + (mt * 32 + l32) * 72; const LAS bf16_t* Bp = XT + (nt * 32 + l32) * 72;
                            f32x16 acc;
#pragma unroll
                            for (int i = 0; i < 16; ++i) acc[i] = 0.f;
#pragma unroll
                            for (int ks = 0; ks < 4; ++ks) acc = __builtin_amdgcn_mfma_f32_32x32x16_bf16(*(const LAS bf16x8*)(Ap + ks * 16 + hl * 8), *(const LAS bf16x8*)(Bp + ks * 16 + hl * 8), acc, 0, 0, 0);
                            bf16_t* dstb = (kind == 0) ? Rb : Kb;
#pragma unroll
                            for (int i = 0; i < 16; ++i) { const int rr = mt * 32 + crow(i, hl), cc = nt * 32 + l32;
                                float val = acc[i];
                                if (kind == 0) val += bf2f(RH[rr * 72 + cc]); else val *= DTS[rr];
                                dstb[(size_t)(r0 + rr) * DM + h * 64 + cc] = (bf16_t)(cvt_pk_bf16(val, 0.f) & 0xffffu); }
                        }
                        {
                            const LAS bf16_t* A1 = (kind == 0 ? ARB : BHT) + (mt * 32 + l32) * 72; const LAS bf16_t* A2 = (kind == 0 ? ARK : KHT) + (mt * 32 + l32) * 72;
                            const LAS bf16_t* B1 = XT + (64 + nt * 32 + l32) * 72; const LAS bf16_t* B2 = VTs + (nt * 32 + l32) * 72;
                            f32x16 acc;
#pragma unroll
                            for (int i = 0; i < 16; ++i) acc[i] = 0.f;
#pragma unroll
                            for (int ks = 0; ks < 4; ++ks) acc = __builtin_amdgcn_mfma_f32_32x32x16_bf16(*(const LAS bf16x8*)(A1 + ks * 16 + hl * 8), *(const LAS bf16x8*)(B1 + ks * 16 + hl * 8), acc, 0, 0, 0);
#pragma unroll
                            for (int ks = 0; ks < 4; ++ks) acc = __builtin_amdgcn_mfma_f32_32x32x16_bf16(*(const LAS bf16x8*)(A2 + ks * 16 + hl * 8), *(const LAS bf16x8*)(B2 + ks * 16 + hl * 8), acc, 0, 0, 0);
                            float* dstf = (kind == 0) ? Obuf : DD;
#pragma unroll
                            for (int i = 0; i < 16; ++i) { const int rr = mt * 32 + crow(i, hl), cc = nt * 32 + l32;
                                float val = acc[i]; if (kind == 1) val *= DTS[rr];
                                dstf[(size_t)(r0 + rr) * DM + h * 64 + cc] = val; }
                        }
                    }
                    S1_BAR;
                }
            }
            fast_grid_barrier((unsigned*)ldp(tab, 40), tab);
#undef S1_BAR
#undef S1_FETCH
            {
                PHASE_IDS BASES RWKV_PTRS
                const float* DTg = (const float*)(RB + 208 * MiB);
                const int l32 = lane & 31, hl = lane >> 5;
                const int q = wave * G + blockIdx.x;
                if (q < 1152) {
                    const bool prompt = q < 128; int b, h, vh, chunk0, nch;
                    if (prompt) { const int chain = q & 63; b = chain >> 5; h = chain & 31; vh = q >> 6; chunk0 = b * 128; nch = 128; }
                    else { const int sq = q - 128; const int chain = sq >> 1; b = chain >> 5; h = chain & 31; vh = sq & 1; chunk0 = 256 + b; nch = 1; }
                    const int colb = h * 64, vcol = colb + 32 * vh + l32;
                    f32x16 S0, S1;
                    if (prompt) {
#pragma unroll
                        for (int i = 0; i < 16; ++i) { S0[i] = 0.f; S1[i] = 0.f; }
                    } else {
                        const float* s0 = IN(3) + ((((size_t)jl * 16 + b) * 32 + h) * 64 + (32 * vh + l32)) * 64;
#pragma unroll
                        for (int i = 0; i < 16; ++i) { S0[i] = s0[crow(i, hl)]; S1[i] = s0[32 + crow(i, hl)]; }
                    }
                    bf16x8 gf[2][2][2]; f32x16 n0, n1; f32x4 dt_[2][4];
#define S2_COMPUTE(cc) do { const int _r0 = (chunk0 + (cc)) * 64; \
                        u32x4 w00, w01, w10, w11; \
                        w00.x = cvt_pk_bf16(S0[0], S0[1]); w00.y = cvt_pk_bf16(S0[2], S0[3]); w00.z = cvt_pk_bf16(S0[4], S0[5]); w00.w = cvt_pk_bf16(S0[6], S0[7]); \
                        w01.x = cvt_pk_bf16(S0[8], S0[9]); w01.y = cvt_pk_bf16(S0[10], S0[11]); w01.z = cvt_pk_bf16(S0[12], S0[13]); w01.w = cvt_pk_bf16(S0[14], S0[15]); \
                        w10.x = cvt_pk_bf16(S1[0], S1[1]); w10.y = cvt_pk_bf16(S1[2], S1[3]); w10.z = cvt_pk_bf16(S1[4], S1[5]); w10.w = cvt_pk_bf16(S1[6], S1[7]); \
                        w11.x = cvt_pk_bf16(S1[8], S1[9]); w11.y = cvt_pk_bf16(S1[10], S1[11]); w11.z = cvt_pk_bf16(S1[12], S1[13]); w11.w = cvt_pk_bf16(S1[14], S1[15]); \
                        const bf16x8 sb00 = __builtin_bit_cast(bf16x8, w00), sb01 = __builtin_bit_cast(bf16x8, w01), sb10 = __builtin_bit_cast(bf16x8, w10), sb11 = __builtin_bit_cast(bf16x8, w11); \
                        n0 = __builtin_amdgcn_mfma_f32_32x32x16_bf16(gf[0][0][0], sb00, n0, 0, 0, 0); n1 = __builtin_amdgcn_mfma_f32_32x32x16_bf16(gf[1][0][0], sb00, n1, 0, 0, 0); \
                        n0 = __builtin_amdgcn_mfma_f32_32x32x16_bf16(gf[0][0][1], sb01, n0, 0, 0, 0); n1 = __builtin_amdgcn_mfma_f32_32x32x16_bf16(gf[1][0][1], sb01, n1, 0, 0, 0); \
                        n0 = __builtin_amdgcn_mfma_f32_32x32x16_bf16(gf[0][1][0], sb10, n0, 0, 0, 0); n1 = __builtin_amdgcn_mfma_f32_32x32x16_bf16(gf[1][1][0], sb10, n1, 0, 0, 0); \
                        n0 = __builtin_amdgcn_mfma_f32_32x32x16_bf16(gf[0][1][1], sb11, n0, 0, 0, 0); n1 = __builtin_amdgcn_mfma_f32_32x32x16_bf16(gf[1][1][1], sb11, n1, 0, 0, 0); \
                        { unsigned char* _sp = (unsigned char*)DD + ((size_t)(_r0 + l32) * DM + colb + 32 * vh) * 4 + 8 * hl; \
                          *(u32x2*)(_sp + 0) = (u32x2){w00.x, w00.y}; *(u32x2*)(_sp + 16) = (u32x2){w00.z, w00.w}; *(u32x2*)(_sp + 32) = (u32x2){w01.x, w01.y}; *(u32x2*)(_sp + 48) = (u32x2){w01.z, w01.w}; \
                          *(u32x2*)(_sp + 64) = (u32x2){w10.x, w10.y}; *(u32x2*)(_sp + 80) = (u32x2){w10.z, w10.w}; *(u32x2*)(_sp + 96) = (u32x2){w11.x, w11.y}; *(u32x2*)(_sp + 112) = (u32x2){w11.z, w11.w}; } \
                        _Pragma("unroll") for (int i = 0; i < 16; ++i) { S0[i] = S0[i] * dt_[0][i >> 2][i & 3] + n0[i]; S1[i] = S1[i] * dt_[1][i >> 2][i & 3] + n1[i]; } \
                    } while (0)
                    if (prompt) {
                        LAS float* dtl = (LAS float*)((LAS unsigned char*)lds);
                        LAS unsigned char* ring = (LAS unsigned char*)lds + 32768;
                        for (int i = lane; i < 128 * 16; i += 64) *(LAS f32x4*)(dtl + i * 4) = *(const f32x4*)(DTg + ((size_t)(chunk0 + (i >> 4)) * 32 + h) * 64 + (i & 15) * 4);
#define S2_DMA(cc) do { const int _r0 = (chunk0 + (cc)) * 64; LAS unsigned char* _s = ring + ((cc) & 3) * 16384; \
                            _Pragma("unroll") for (int j = 0; j < 8; ++j) { const int _row = 8 * j + (lane >> 3); const int _p = (lane & 7) ^ (_row & 7); \
                                __builtin_amdgcn_global_load_lds((const unsigned*)(Kb + (size_t)(_r0 + _row) * DM + colb + _p * 8), (LAS unsigned*)(_s + j * 1024), 16, 0, 0); } \
                            _Pragma("unroll") for (int j = 0; j < 8; ++j) { const int _row = 8 * j + (lane >> 3); \
                                __builtin_amdgcn_global_load_lds((const unsigned*)(DD + (size_t)(_r0 + _row) * DM + colb + 32 * vh + (lane & 7) * 4), (LAS unsigned*)(_s + 8192 + j * 1024), 16, 0, 0); } \
                        } while (0)
                        S2_DMA(0); S2_DMA(1);
#pragma unroll 1
                        for (int c = 0; c < 128; ++c) {
                            if (c + 2 < 128) { S2_DMA(c + 2); asm volatile("s_waitcnt vmcnt(32)" ::: "memory"); }
                            else if (c + 1 < 128) asm volatile("s_waitcnt vmcnt(16)" ::: "memory");
                            else asm volatile("s_waitcnt vmcnt(0)" ::: "memory");
                            LAS unsigned char* sl = ring + (c & 3) * 16384;
#pragma unroll
                            for (int mt = 0; mt < 2; ++mt)
#pragma unroll
                                for (int kt = 0; kt < 2; ++kt)
#pragma unroll
                                    for (int s2 = 0; s2 < 2; ++s2) {
                                        const int row = 32 * mt + l32, p = 4 * kt + 2 * s2;
                                        const u32x2 lo = *(const LAS u32x2*)(sl + row * 128 + ((p ^ (row & 7)) * 16) + 8 * hl);
                                        const u32x2 hi = *(const LAS u32x2*)(sl + row * 128 + (((p + 1) ^ (row & 7)) * 16) + 8 * hl);
                                        gf[mt][kt][s2] = __builtin_bit_cast(bf16x8, (u32x4){lo.x, lo.y, hi.x, hi.y});
                                    }
#pragma unroll
                            for (int i = 0; i < 16; ++i) { n0[i] = *(const LAS float*)(sl + 8192 + crow(i, hl) * 128 + l32 * 4); n1[i] = *(const LAS float*)(sl + 8192 + (32 + crow(i, hl)) * 128 + l32 * 4); }
#pragma unroll
                            for (int mt = 0; mt < 2; ++mt)
#pragma unroll
                                for (int g = 0; g < 4; ++g) dt_[mt][g] = *(const LAS f32x4*)(dtl + c * 64 + 32 * mt + 8 * g + 4 * hl);
                            S2_COMPUTE(c);
                        }
#undef S2_DMA
                    } else {
                        const int _r0 = chunk0 * 64; const size_t _item = (size_t)chunk0 * 32 + h;
#pragma unroll
                        for (int mt = 0; mt < 2; ++mt)
#pragma unroll
                            for (int kt = 0; kt < 2; ++kt)
#pragma unroll
                                for (int s2 = 0; s2 < 2; ++s2) {
                                    const size_t _o = (size_t)(_r0 + 32 * mt + l32) * DM + colb + 32 * kt + 16 * s2 + 4 * hl;
                                    const u32x2 _lo = *(const u32x2*)(Kb + _o), _hi = *(const u32x2*)(Kb + _o + 8); gf[mt][kt][s2] = __builtin_bit_cast(bf16x8, (u32x4){_lo.x, _lo.y, _hi.x, _hi.y}); }
#pragma unroll
                        for (int i = 0; i < 16; ++i) { n0[i] = DD[(size_t)(_r0 + crow(i, hl)) * DM + vcol]; n1[i] = DD[(size_t)(_r0 + 32 + crow(i, hl)) * DM + vcol]; }
#pragma unroll
                        for (int mt = 0; mt < 2; ++mt)
#pragma unroll
                            for (int g = 0; g < 4; ++g) dt_[mt][g] = *(const f32x4*)(DTg + _item * 64 + 32 * mt + 8 * g + 4 * hl);
                        S2_COMPUTE(0);
                    }
#undef S2_COMPUTE
                    float* so_ = OUTP + (prompt ? O_PWKV + ((((size_t)jl * 2 + b) * 32 + h) * 64 + (32 * vh + l32)) * 64
                                                : O_SWKV + ((((size_t)jl * 16 + b) * 32 + h) * 64 + (32 * vh + l32)) * 64);
#pragma unroll
                    for (int i = 0; i < 16; ++i) { so_[crow(i, hl)] = S0[i]; so_[32 + crow(i, hl)] = S1[i]; }
                }
            }
            fast_grid_barrier((unsigned*)ldp(tab, 40), tab);
            {
                PHASE_IDS BASES RWKV_PTRS
                const float* Obuf = (const float*)(RA + 272 * MiB); const float* RK = (const float*)(RB + 204 * MiB);
                const float* lnw = IN(28) + (size_t)jl * DM; const float* lnb = IN(29) + (size_t)jl * DM;
                const int l32 = lane & 31, hl = lane >> 5;
#pragma unroll 1
                for (int item = blockIdx.x; item < 8704; item += G) {
                    LAS unsigned char* ldsv = (LAS unsigned char*)lds; asm volatile("" : "+v"(ldsv));
                    LAS bf16_t* R2s = (LAS bf16_t*)(ldsv + 0); LAS bf16_t* STs = (LAS bf16_t*)(ldsv + 9216); LAS float* Os = (LAS float*)(ldsv + 18432);
                    const int chunk = item >> 5, h = item & 31, r0 = chunk * 64;
                    {
                        const int rr = tid >> 3, pc = tid & 7;
                        *(LAS u32x4*)(R2s + rr * 72 + pc * 8) = *(const u32x4*)(Rb + (size_t)(r0 + rr) * DM + h * 64 + pc * 8);
                        const unsigned char* sp = (const unsigned char*)DD + ((size_t)(r0 + (rr & 31)) * DM + h * 64 + 32 * (rr >> 5)) * 4 + pc * 16;
                        *(LAS u32x4*)(STs + rr * 72 + pc * 8) = *(const u32x4*)sp;
                    }
                    __syncthreads();
                    if (wave < 4) {
                        const int tt = wave >> 1, vt = wave & 1;
                        f32x16 acc;
#pragma unroll
                        for (int i = 0; i < 16; ++i) acc[i] = Obuf[(size_t)(r0 + 32 * tt + crow(i, hl)) * DM + h * 64 + 32 * vt + l32];
#pragma unroll
                        for (int ks = 0; ks < 4; ++ks) acc = __builtin_amdgcn_mfma_f32_32x32x16_bf16(*(const LAS bf16x8*)(R2s + (32 * tt + l32) * 72 + ks * 16 + hl * 8), *(const LAS bf16x8*)(STs + (32 * vt + l32) * 72 + ks * 16 + hl * 8), acc, 0, 0, 0);
#pragma unroll
                        for (int i = 0; i < 16; ++i) Os[(32 * tt + crow(i, hl)) * 68 + 32 * vt + l32] = acc[i];
                    }
                    __syncthreads();
                    {
                        const int st = tid >> 3, c0 = (tid & 7) * 8, col = h * 64 + c0; const size_t off = (size_t)(r0 + st) * DM + col;
                        const f32x4 o0 = *(const LAS f32x4*)(Os + st * 68 + c0), o1 = *(const LAS f32x4*)(Os + st * 68 + c0 + 4);
                        float o[8] = {o0[0], o0[1], o0[2], o0[3], o1[0], o1[1], o1[2], o1[3]};
                        float s = 0.f;
#pragma unroll
                        for (int i = 0; i < 8; ++i) s += o[i];
                        const float mu = sum8(s, lane) * (1.f / 64.f); float q = 0.f;
#pragma unroll
                        for (int i = 0; i < 8; ++i) { o[i] -= mu; q += o[i] * o[i]; }
                        const float rstd = rsqrtf(sum8(q, lane) * (1.f / 64.f) + 64e-5f);
                        float v[8], g8[8]; unpack8(*(const u32x4*)(Vb + off), v); unpack8(*(const u32x4*)(GG + off), g8);
                        if (jl > 0) { float vf[8], vg[8]; unpack8(*(const u32x4*)(VFIRST + off), vf); unpack8(*(const u32x4*)(VG + off), vg);
#pragma unroll
                            for (int i = 0; i < 8; ++i) v[i] = v[i] + (vf[i] - v[i]) * vg[i]; }
                        const float rk = RK[(size_t)(r0 + st) * 32 + h];
                        float y[8];
#pragma unroll
                        for (int i = 0; i < 8; ++i) y[i] = (o[i] * rstd * lnw[col + i] + lnb[col + i] + rk * v[i]) * g8[i];
                        *(u32x4*)(Y + off) = pack8(y);
                    }
                    __syncthreads();
                }
            }
            fast_grid_barrier((unsigned*)ldp(tab, 40), tab);
            {
                BASES RWKV_PTRS
                pg8::Gemm g{Y, WO, MROWS, 2048, 2048, 0, 0};
                pg8::StaticOrder S; S.init(g.M, g.N, G, (int)blockIdx.x, g.K, 4);
                pg8::Epi<FRes> E{FRes{X, (float*)(RA + 272 * MiB)}};
                pg8::gemm_phase(ldsl, g, S, E);
                fast_grid_barrier((unsigned*)ldp(tab, 40), tab);
                {
                    PHASE_IDS
                    const float* PART = (const float*)(RA + 272 * MiB); const int ntail = S.nwg - S.nFull;
                    if (S.S > 1) for (int idx = gtid; idx < ntail * 16384; idx += NT) {
                        const int tl = idx >> 14, r = (idx >> 6) & 255, c4 = idx & 63; int pm, pn; S.tile_pmpn(S.nFull + tl, pm, pn);
                        f32x4* xp = (f32x4*)(X + (size_t)(pm * 256 + r) * DM + pn * 256 + c4 * 4); f32x4 acc = *xp;
#pragma unroll
                        for (int part = 0; part < 4; ++part) acc += *(const f32x4*)(PART + (size_t)(part * 32 + tl) * 65536 + r * 256 + c4 * 4);
                        *xp = acc; }
                }
            }
            fast_grid_barrier((unsigned*)ldp(tab, 40), tab);
        } else {
            { PHASE_IDS BASES GLA_PTRS
            const float* gmix = IN(6) + (size_t)layer * DM;
            for (int row = gw; row < MROWS; row += NGW) {
                const f32x4* xr = (const f32x4*)(X + (size_t)row * DM) + lane; f32x4 x[8]; float ss = 0.f;
#pragma unroll
                for (int q = 0; q < 8; ++q) { x[q] = xr[64 * q]; ss += x[q][0] * x[q][0] + x[q][1] * x[q][1] + x[q][2] * x[q][2] + x[q][3] * x[q][3]; }
                const float rs = rsqrtf(wave_sum(ss, lane) * (1.f / DM) + 1e-6f);
#pragma unroll
                for (int q = 0; q < 8; ++q) { const f32x4 gg = *((const f32x4*)gmix + lane + 64 * q); const f32x4 h = x[q] * rs * gg;
                    u32x2 w; w.x = cvt_pk_bf16(h[0], h[1]); w.y = cvt_pk_bf16(h[2], h[3]); *((u32x2*)(H + (size_t)row * DM) + lane + 64 * q) = w; }
            } }
            fast_grid_barrier((unsigned*)ldp(tab, 40), tab);
            {
                BASES GLA_PTRS
                pg8::Gemm g{H, GI, MROWS, 6400, 2048, 0, 0};
                pg8::StaticOrder S; S.init(g.M, g.N, G, (int)blockIdx.x, g.K, 1);
                pg8::Epi<FG1> E{FG1{PROJ, LR}};
                pg8::gemm_phase(ldsl, g, S, E);
            }
            fast_grid_barrier((unsigned*)ldp(tab, 40), tab);
            {
                PHASE_IDS BASES GLA_PTRS
                float* lrS = (float*)lds;
                float* w2S = (float*)(lds + 4096);
                float* totS = (float*)(lds + 20480);
                bf16_t* qeS = (bf16_t*)(lds + 22528);
                bf16_t* keS = (bf16_t*)(lds + 22528 + 33792);
                bf16_t* vS = qeS;
                const float* gw2 = IN(31) + (size_t)jl * 16 * 1024; const float* gkb = IN(32) + (size_t)jl * 1024;
#pragma unroll 1
                for (int it = blockIdx.x; it < 1088; it += G) {
                    const int c = it >> 2, h = it & 3, r0 = c * 64; const size_t base = (size_t)it;
                    if (tid < 256) *(f32x4*)(lrS + tid * 4) = *(const f32x4*)(LR + (size_t)r0 * 16 + tid * 4);
                    for (int q = tid; q < 1024; q += 512) { const int r = q >> 6, cc = (q & 63) * 4; *(f32x4*)(w2S + r * 256 + cc) = *(const f32x4*)(gw2 + (size_t)r * 1024 + h * 256 + cc); }
                    __syncthreads();
                    const int d = tid & 255, half = tid >> 8;
                    float cumv[32];
                    {
                        float w[16];
#pragma unroll
                        for (int r = 0; r < 16; ++r) w[r] = w2S[r * 256 + d];
                        const float bb = gkb[h * 256 + d]; float run = 0.f;
#pragma unroll
                        for (int tt = 0; tt < 32; ++tt) {
                            const float* lp = lrS + (half * 32 + tt) * 16; float z = bb;
#pragma unroll
                            for (int r = 0; r < 16; ++r) z += lp[r] * w[r];
                            const float g = (fminf(z, 0.f) - log1pf(__expf(-fabsf(z)))) * 0.0625f;
                            run += g; cumv[tt] = run;
                        }
                        totS[half * 256 + d] = run;
                    }
                    __syncthreads();
                    {
                        const float t0 = totS[d], t1 = totS[256 + d]; const float last = t0 + t1, offc = half ? t0 : 0.f;
                        if (half == 0) EL[base * 256 + d] = __expf(last);
                        unsigned kdp[16];
#pragma unroll
                        for (int tt = 0; tt < 32; tt += 2) {
                            float kd2[2];
#pragma unroll
                            for (int e = 0; e < 2; ++e) {
                                const int t = half * 32 + tt + e; const float cum = cumv[tt + e] + offc;
                                const size_t po = (size_t)(r0 + t) * 6144 + h * 256 + d;
                                const float q = bf2f(PROJ[po]), k = bf2f(PROJ[po + 1024]);
                                const float qe = q * __expf(cum), ke = k * __expf(-cum); kd2[e] = k * __expf(last - cum);
                                const unsigned pq = cvt_pk_bf16(qe, ke);
                                qeS[t * 264 + d] = (bf16_t)(pq & 0xffffu); keS[t * 264 + d] = (bf16_t)(pq >> 16);
                                QE[((base * 8 + (d >> 5)) * 64 + t) * 32 + (d & 31)] = (bf16_t)(pq & 0xffffu);
                            }
                            kdp[tt >> 1] = cvt_pk_bf16(kd2[0], kd2[1]);
                        }
                        u32x4* kdst = (u32x4*)(KDT + (base * 256 + d) * 64 + half * 32);
                        kdst[0] = (u32x4){kdp[0], kdp[1], kdp[2], kdp[3]}; kdst[1] = (u32x4){kdp[4], kdp[5], kdp[6], kdp[7]};
                        kdst[2] = (u32x4){kdp[8], kdp[9], kdp[10], kdp[11]}; kdst[3] = (u32x4){kdp[12], kdp[13], kdp[14], kdp[15]};
                    }
                    __syncthreads();
                    if (wave < 4) {
                        const int mi = wave >> 1, ni = wave & 1, l32 = lane & 31, hl = lane >> 5;
                        f32x16 cacc;
#pragma unroll
                        for (int i = 0; i < 16; ++i) cacc[i] = 0.f;
#pragma unroll
                        for (int kk = 0; kk < 16; ++kk) {
                            const bf16x8 a = *(const bf16x8*)(qeS + (mi * 32 + l32) * 264 + kk * 16 + hl * 8);
                            const bf16x8 b = *(const bf16x8*)(keS + (ni * 32 + l32) * 264 + kk * 16 + hl * 8);
                            cacc = __builtin_amdgcn_mfma_f32_32x32x16_bf16(a, b, cacc, 0, 0, 0);
                        }
#pragma unroll
                        for (int i = 0; i < 16; ++i) { const int ii = mi * 32 + crow(i, hl), jj = ni * 32 + l32;
                            const float v = (jj <= ii) ? cacc[i] : 0.f; SC[base * 4096 + ii * 64 + jj] = (bf16_t)(cvt_pk_bf16(v, 0.f) & 0xffffu); }
                    }
                    __syncthreads();
                    for (int q = tid; q < 4096; q += 512) { const int t = q >> 6, cc = (q & 63) * 8;
                        *(u32x4*)(vS + t * 520 + cc) = *(const u32x4*)(PROJ + (size_t)(r0 + t) * 6144 + 2048 + h * 512 + cc); }
                    __syncthreads();
                    {
                        const int dv = tid; u32x4* vdst = (u32x4*)(VT + (base * 512 + dv) * 64);
#pragma unroll
                        for (int q = 0; q < 8; ++q) {
                            unsigned w[4];
#pragma unroll
                            for (int e = 0; e < 4; ++e) { const unsigned lo = vS[(q * 8 + 2 * e) * 520 + dv], hi = vS[(q * 8 + 2 * e + 1) * 520 + dv]; w[e] = lo | (hi << 16); }
                            vdst[q] = (u32x4){w[0], w[1], w[2], w[3]};
                        }
                    }
                    __syncthreads();
                }
            }
            fast_grid_barrier((unsigned*)ldp(tab, 40), tab);
            {
                PHASE_IDS BASES GLA_PTRS
                float* red = (float*)lds;
                const int l32 = lane & 31, hl = lane >> 5;
#pragma unroll 1
                for (int u = blockIdx.x; u < 1152; u += G) {
                    const bool prompt = u < 128; int b, h, s, cg0, nch, row0;
                    if (prompt) { const int pair = u & 7; b = pair >> 2; h = pair & 3; s = u >> 3; cg0 = b * 128; nch = 128; row0 = b * 8192; }
                    else { const int su = u - 128; b = su >> 6; h = (su >> 4) & 3; s = su & 15; cg0 = 256 + b; nch = 1; row0 = MPROMPT + b * 64; }
                    f32x16 S;
                    if (prompt) {
#pragma unroll
                        for (int i = 0; i < 16; ++i) S[i] = 0.f;
                    } else {
                        const float* s0 = IN(4) + ((((size_t)jl * 16 + b) * 4 + h) * 256) * 512;
#pragma unroll
                        for (int i = 0; i < 16; ++i) S[i] = s0[(size_t)(32 * wave + crow(i, hl)) * 512 + 32 * s + l32];
                    }
                    const int mtw = wave & 1, ksw = wave >> 1;
                    bf16x8 ka[4], vb[4], qf[2][2], scf; f32x4 el[4];
#define GL_LD_Q(cc) do { const size_t _base = (size_t)(cg0 + (cc)) * 4 + h; const int _r0 = row0 + (cc) * 64; const bf16_t* _sc = SC + _base * 4096; \
                        _Pragma("unroll") for (int mt = 0; mt < 2; ++mt) _Pragma("unroll") for (int s2 = 0; s2 < 2; ++s2) { const bf16_t* _pq = QE + ((_base * 8 + wave) * 64 + mt * 32 + l32) * 32 + 16 * s2 + 4 * hl; \
                            const u32x2 _lo = *(const u32x2*)_pq, _hi = *(const u32x2*)(_pq + 8); qf[mt][s2] = __builtin_bit_cast(bf16x8, (u32x4){_lo.x, _lo.y, _hi.x, _hi.y}); } \
                        scf = *(const bf16x8*)(_sc + (mtw * 32 + l32) * 64 + 16 * ksw + 8 * hl); } while (0)
#define GL_LD_E(cc) do { const size_t _base = (size_t)(cg0 + (cc)) * 4 + h; \
                        _Pragma("unroll") for (int g = 0; g < 4; ++g) el[g] = *(const f32x4*)(EL + _base * 256 + 32 * wave + 8 * g + 4 * hl); } while (0)
#define GL_LD_K(cc) do { const size_t _base = (size_t)(cg0 + (cc)) * 4 + h; const bf16_t* _kdt = KDT + _base * 256 * 64; const bf16_t* _vt = VT + _base * 512 * 64; \
                        _Pragma("unroll") for (int ks = 0; ks < 4; ++ks) { ka[ks] = *(const bf16x8*)(_kdt + (32 * wave + l32) * 64 + 16 * ks + 8 * hl); vb[ks] = *(const bf16x8*)(_vt + (32 * s + l32) * 64 + 16 * ks + 8 * hl); } } while (0)
                    GL_LD_Q(0); GL_LD_E(0); GL_LD_K(0);
                    f32x4 osum = (f32x4){0.f, 0.f, 0.f, 0.f}; float* optr = nullptr;
#pragma unroll 1
                    for (int c = 0; c < nch; ++c) {
                        const int r0 = row0 + c * 64; const int cn = (c + 1 < nch) ? c + 1 : c;
                        asm volatile("" : "+v"(scf), "+v"(vb[3]));
                        if (c > 0) *(f32x4*)optr = osum;
                        u32x4 sp0, sp1;
                        sp0.x = cvt_pk_bf16(S[0], S[1]); sp0.y = cvt_pk_bf16(S[2], S[3]); sp0.z = cvt_pk_bf16(S[4], S[5]); sp0.w = cvt_pk_bf16(S[6], S[7]);
                        sp1.x = cvt_pk_bf16(S[8], S[9]); sp1.y = cvt_pk_bf16(S[10], S[11]); sp1.z = cvt_pk_bf16(S[12], S[13]); sp1.w = cvt_pk_bf16(S[14], S[15]);
                        const bf16x8 sb0 = __builtin_bit_cast(bf16x8, sp0), sb1 = __builtin_bit_cast(bf16x8, sp1);
                        const bf16x8 vbw = ksw == 0 ? vb[0] : ksw == 1 ? vb[1] : ksw == 2 ? vb[2] : vb[3];
#pragma unroll
                        for (int i = 0; i < 16; ++i) S[i] *= el[i >> 2][i & 3];
#pragma unroll
                        for (int ks = 0; ks < 4; ++ks) S = __builtin_amdgcn_mfma_f32_32x32x16_bf16(ka[ks], vb[ks], S, 0, 0, 0);
                        GL_LD_E(cn); GL_LD_K(cn);
                        f32x16 oo0, oo1;
#pragma unroll
                        for (int i = 0; i < 16; ++i) { oo0[i] = 0.f; oo1[i] = 0.f; }
                        oo0 = __builtin_amdgcn_mfma_f32_32x32x16_bf16(qf[0][0], sb0, oo0, 0, 0, 0); oo0 = __builtin_amdgcn_mfma_f32_32x32x16_bf16(qf[0][1], sb1, oo0, 0, 0, 0);
                        oo1 = __builtin_amdgcn_mfma_f32_32x32x16_bf16(qf[1][0], sb0, oo1, 0, 0, 0); oo1 = __builtin_amdgcn_mfma_f32_32x32x16_bf16(qf[1][1], sb1, oo1, 0, 0, 0);
                        if (mtw == 0) oo0 = __builtin_amdgcn_mfma_f32_32x32x16_bf16(scf, vbw, oo0, 0, 0, 0); else oo1 = __builtin_amdgcn_mfma_f32_32x32x16_bf16(scf, vbw, oo1, 0, 0, 0);
                        GL_LD_Q(cn);
#pragma unroll
                        for (int q = 0; q < 16; ++q) { red[(wave * 32 + q) * 64 + lane] = oo0[q]; red[(wave * 32 + 16 + q) * 64 + lane] = oo1[q]; }
                        asm volatile("s_waitcnt lgkmcnt(0)" ::: "memory"); __builtin_amdgcn_s_barrier(); asm volatile("" ::: "memory");
                        { const int q = tid >> 4, lg = tid & 15; f32x4 sum = (f32x4){0.f, 0.f, 0.f, 0.f};
#pragma unroll
                          for (int w = 0; w < 8; ++w) sum += *(const f32x4*)(red + (w * 32 + q) * 64 + 4 * lg);
                          const int mt = q >> 4, reg = q & 15, L = 4 * lg; const int i = mt * 32 + crow(reg, L >> 5), dv = L & 31;
                          osum = sum; optr = O + (size_t)(r0 + i) * DM + h * 512 + 32 * s + dv; }
                        asm volatile("s_waitcnt lgkmcnt(0)" ::: "memory"); __builtin_amdgcn_s_barrier(); asm volatile("" ::: "memory");
                    }
                    *(f32x4*)optr = osum;
#undef GL_LD_Q
#undef GL_LD_E
#undef GL_LD_K
                    float* dst = OUTP + (prompt ? O_PGLA + ((((size_t)jl * 2 + b) * 4 + h) * 256) * 512 : O_SGLA + ((((size_t)jl * 16 + b) * 4 + h) * 256) * 512);
#pragma unroll
                    for (int i = 0; i < 16; ++i) dst[(size_t)(32 * wave + crow(i, hl)) * 512 + 32 * s + l32] = S[i];
                }
                if (layer == 1 && G >= 256 && (int)blockIdx.x >= 128) {
                    float* scr = (float*)(lds + wave * 16896);
                    CONVERT_WEIGHTS(1, 2, 2, 4, ((int)blockIdx.x - 128) * 8 + wave, (G - 128) * 8);
                }
            }
            fast_grid_barrier((unsigned*)ldp(tab, 40), tab);
            {
                PHASE_IDS BASES GLA_PTRS
                const float* hn = IN(33) + (size_t)jl * 512;
                for (int row = gw; row < MROWS; row += NGW) {
#pragma unroll
                    for (int h = 0; h < 4; ++h) {
                        const float* op = O + (size_t)row * DM + h * 512 + lane * 8;
                        const f32x4 a = *(const f32x4*)op, b = *(const f32x4*)(op + 4);
                        float ss = a[0] * a[0] + a[1] * a[1] + a[2] * a[2] + a[3] * a[3] + b[0] * b[0] + b[1] * b[1] + b[2] * b[2] + b[3] * b[3];
                        const float rs = rsqrtf(wave_sum(ss, lane) * (1.f / 512.f) + 1e-5f);
                        float gt[8]; unpack8(*(const u32x4*)(PROJ + (size_t)row * 6144 + 4096 + h * 512 + lane * 8), gt);
                        const f32x4 n0 = *(const f32x4*)(hn + lane * 8), n1 = *(const f32x4*)(hn + lane * 8 + 4);
                        float y[8];
#pragma unroll
                        for (int i = 0; i < 4; ++i) { y[i] = a[i] * rs * n0[i] * (gt[i] * sigmoidf_(gt[i])); y[4 + i] = b[i] * rs * n1[i] * (gt[4 + i] * sigmoidf_(gt[4 + i])); }
                        *(u32x4*)(Y + (size_t)row * DM + h * 512 + lane * 8) = pack8(y);
                    }
                }
            }
            fast_grid_barrier((unsigned*)ldp(tab, 40), tab);
            {
                BASES GLA_PTRS
                pg8::Gemm g{Y, GO, MROWS, 2048, 2048, 0, 0};
                pg8::StaticOrder S; S.init(g.M, g.N, G, (int)blockIdx.x, g.K, 4);
                pg8::Epi<FRes> E{FRes{X, (float*)(RA + 272 * MiB)}};
                pg8::gemm_phase(ldsl, g, S, E);
                fast_grid_barrier((unsigned*)ldp(tab, 40), tab);
                {
                    PHASE_IDS
                    const float* PART = (const float*)(RA + 272 * MiB); const int ntail = S.nwg - S.nFull;
                    if (S.S > 1) for (int idx = gtid; idx < ntail * 16384; idx += NT) {
                        const int tl = idx >> 14, r = (idx >> 6) & 255, c4 = idx & 63; int pm, pn; S.tile_pmpn(S.nFull + tl, pm, pn);
                        f32x4* xp = (f32x4*)(X + (size_t)(pm * 256 + r) * DM + pn * 256 + c4 * 4); f32x4 acc = *xp;
#pragma unroll
                        for (int part = 0; part < 4; ++part) acc += *(const f32x4*)(PART + (size_t)(part * 32 + tl) * 65536 + r * 256 + c4 * 4);
                        *xp = acc; }
                }
            }
            fast_grid_barrier((unsigned*)ldp(tab, 40), tab);
        }
        {
            { PHASE_IDS BASES FFN_PTRS
            const float* gf = IN(7) + (size_t)layer * DM;
            for (int row = gw; row < MROWS; row += NGW) {
                const f32x4* xr = (const f32x4*)(X + (size_t)row * DM) + lane; f32x4 x[8]; float ss = 0.f;
#pragma unroll
                for (int q = 0; q < 8; ++q) { x[q] = xr[64 * q]; ss += x[q][0] * x[q][0] + x[q][1] * x[q][1] + x[q][2] * x[q][2] + x[q][3] * x[q][3]; }
                const float rs = rsqrtf(wave_sum(ss, lane) * (1.f / DM) + 1e-6f);
#pragma unroll
                for (int q = 0; q < 8; ++q) { const f32x4 gg = *((const f32x4*)gf + lane + 64 * q); const f32x4 h = x[q] * rs * gg;
                    u32x2 w; w.x = cvt_pk_bf16(h[0], h[1]); w.y = cvt_pk_bf16(h[2], h[3]); *((u32x2*)(H + (size_t)row * DM) + lane + 64 * q) = w; }
            } }
            fast_grid_barrier((unsigned*)ldp(tab, 40), tab);
            {
                BASES FFN_PTRS
                pg8::Gemm g{H, WU, MROWS, F2, 2048, 0, 0};
                pg8::StaticOrder S; S.init(g.M, g.N, G, (int)blockIdx.x, g.K, 1);
                pg8::Epi<FUp> E{FUp{U, OUTP + O_PCONV + (size_t)layer * 2 * 2 * F2, OUTP + O_SCONV + (size_t)layer * 16 * 2 * F2}};
                pg8::gemm_phase(ldsl, g, S, E);
            }
            fast_grid_barrier((unsigned*)ldp(tab, 40), tab);
            {
                PHASE_IDS BASES FFN_PTRS
                const float* cw = IN(36) + (size_t)layer * 3 * F2; const float* cb = IN(37) + (size_t)layer * F2;
                const float* cst = IN(5) + (size_t)layer * 16 * 2 * F2;
#pragma unroll 1
                for (int it = gtid; it < 544 * 704; it += NT) {
                    const int rc = it / 704, c8 = it - rc * 704, col = c8 * 8, r0 = rc * 32;
                    int t0, len, b; bool prompt; row_info(r0, t0, len, b, prompt);
                    float wv[3][8], wg[3][8], bv[8], bg[8];
#pragma unroll
                    for (int k = 0; k < 3; ++k) { const f32x4 a = *(const f32x4*)(cw + (size_t)k * F2 + col), a2 = *(const f32x4*)(cw + (size_t)k * F2 + col + 4);
                        const f32x4 g = *(const f32x4*)(cw + (size_t)k * F2 + FH + col), g2 = *(const f32x4*)(cw + (size_t)k * F2 + FH + col + 4);
#pragma unroll
                        for (int i = 0; i < 4; ++i) { wv[k][i] = a[i]; wv[k][4 + i] = a2[i]; wg[k][i] = g[i]; wg[k][4 + i] = g2[i]; } }
                    { const f32x4 a = *(const f32x4*)(cb + col), a2 = *(const f32x4*)(cb + col + 4), g = *(const f32x4*)(cb + FH + col), g2 = *(const f32x4*)(cb + FH + col + 4);
#pragma unroll
                      for (int i = 0; i < 4; ++i) { bv[i] = a[i]; bv[4 + i] = a2[i]; bg[i] = g[i]; bg[4 + i] = g2[i]; } }
                    float v2[8], v1[8], g2_[8], g1_[8];
                    if (t0 > 0) {
                        unpack8(*(const u32x4*)(U + (size_t)(r0 - 2) * F2 + col), v2); unpack8(*(const u32x4*)(U + (size_t)(r0 - 1) * F2 + col), v1);
                        unpack8(*(const u32x4*)(U + (size_t)(r0 - 2) * F2 + FH + col), g2_); unpack8(*(const u32x4*)(U + (size_t)(r0 - 1) * F2 + FH + col), g1_);
                    } else if (!prompt) {
                        const float* s0 = cst + ((size_t)b * 2) * F2 + col; const float* s1 = s0 + F2;
#pragma unroll
                        for (int i = 0; i < 8; ++i) { v2[i] = s0[i]; v1[i] = s1[i]; g2_[i] = s0[FH + i]; g1_[i] = s1[FH + i]; }
                    } else {
#pragma unroll
                        for (int i = 0; i < 8; ++i) { v2[i] = 0.f; v1[i] = 0.f; g2_[i] = 0.f; g1_[i] = 0.f; }
                    }
#pragma unroll 1
                    for (int rb = 0; rb < 32; rb += 8) {
                      u32x4 uv_[8], ug_[8];
#pragma unroll
                      for (int j = 0; j < 8; ++j) { uv_[j] = *(const u32x4*)(U + (size_t)(r0 + rb + j) * F2 + col); ug_[j] = *(const u32x4*)(U + (size_t)(r0 + rb + j) * F2 + FH + col); }
#pragma unroll
                      for (int j = 0; j < 8; ++j) {
                        const int r = rb + j;
                        float v0[8], g0[8];
                        unpack8(uv_[j], v0); unpack8(ug_[j], g0);
                        float y[8];
#pragma unroll
                        for (int i = 0; i < 8; ++i) {
                            const float cv = bv[i] + wv[0][i] * v2[i] + wv[1][i] * v1[i] + wv[2][i] * v0[i];
                            const float cg_ = bg[i] + wg[0][i] * g2_[i] + wg[1][i] * g1_[i] + wg[2][i] * g0[i];
                            y[i] = cg_ * sigmoidf_(cg_) * cv;
                            v2[i] = v1[i]; v1[i] = v0[i]; g2_[i] = g1_[i]; g1_[i] = g0[i];
                        }
                        *(u32x4*)(HID + (size_t)(r0 + r) * FH + col) = pack8(y);
                      }
                    }
                }
            }
            fast_grid_barrier((unsigned*)ldp(tab, 40), tab);
            {
                BASES FFN_PTRS
                pg8::Gemm g{HID, WD, MROWS, 2048, FH, 0, 0};
                pg8::StaticOrder S; S.init(g.M, g.N, G, (int)blockIdx.x, g.K, 4);
                pg8::Epi<FRes> E{FRes{X, (float*)(RA + 272 * MiB)}};
                pg8::gemm_phase(ldsl, g, S, E);
                fast_grid_barrier((unsigned*)ldp(tab, 40), tab);
                {
                    PHASE_IDS
                    const float* PART = (const float*)(RA + 272 * MiB); const int ntail = S.nwg - S.nFull;
                    if (S.S > 1) for (int idx = gtid; idx < ntail * 16384; idx += NT) {
                        const int tl = idx >> 14, r = (idx >> 6) & 255, c4 = idx & 63; int pm, pn; S.tile_pmpn(S.nFull + tl, pm, pn);
                        f32x4* xp = (f32x4*)(X + (size_t)(pm * 256 + r) * DM + pn * 256 + c4 * 4); f32x4 acc = *xp;
#pragma unroll
                        for (int part = 0; part < 4; ++part) acc += *(const f32x4*)(PART + (size_t)(part * 32 + tl) * 65536 + r * 256 + c4 * 4);
                        *xp = acc; }
                }
            }
            fast_grid_barrier((unsigned*)ldp(tab, 40), tab);
        }
    }
    {
        PHASE_IDS BASES
        const float* gn = IN(8);
        for (int row = gw; row < MROWS; row += NGW) {
            f32x4* xr = (f32x4*)(X + (size_t)row * DM) + lane; f32x4 x[8]; float ss = 0.f;
#pragma unroll
            for (int q = 0; q < 8; ++q) { x[q] = xr[64 * q]; ss += x[q][0] * x[q][0] + x[q][1] * x[q][1] + x[q][2] * x[q][2] + x[q][3] * x[q][3]; }
            const float rs = rsqrtf(wave_sum(ss, lane) * (1.f / DM) + 1e-6f);
#pragma unroll
            for (int q = 0; q < 8; ++q) { const f32x4 gg = *((const f32x4*)gn + lane + 64 * q); xr[64 * q] = x[q] * rs * gg; }
        }
    }
}

#undef TR
#undef CONVERT_WEIGHTS
extern "C" void kernel_launch(void* const* d_in, const int* in_sizes, int n_in, void* d_out, int out_size, void* d_ws, size_t ws_size, hipStream_t stream) {
    static int grid = 0;
    if (grid == 0) {
        if (n_in != 39 || (size_t)out_size != O_TOTAL || ws_size < WS_END) {
            fprintf(stderr, "kernel_launch: unexpected shapes: n_in %d out %d ws %zu (need %zu)\n", n_in, out_size, ws_size, (size_t)WS_END); grid = -1; return; }
        int dev = 0, cus = 0, per_cu = 0;
        (void)hipGetDevice(&dev);
        (void)hipDeviceGetAttribute(&cus, hipDeviceAttributeMultiprocessorCount, dev);
        if (hipFuncSetAttribute((const void*)fwd_kernel, hipFuncAttributeMaxDynamicSharedMemorySize, LDS_BYTES) != hipSuccess) { fprintf(stderr, "kernel_launch: hipFuncSetAttribute failed\n"); grid = -1; return; }
        if (hipOccupancyMaxActiveBlocksPerMultiprocessor(&per_cu, (const void*)fwd_kernel, 512, LDS_BYTES) != hipSuccess || per_cu < 1) { fprintf(stderr, "kernel_launch: occupancy query says %d\n", per_cu); per_cu = 1; }
        (void)hipGetLastError();
        grid = cus * 1;
        if (grid <= 0) grid = 256;
    }
    if (grid < 0) return;
    P prm{};
    for (int i = 0; i < 39; ++i) prm.in[i] = (const float*)d_in[i];
    prm.out = (float*)d_out; prm.ws = (unsigned char*)d_ws;
    (void)hipMemsetAsync(d_ws, 0, 4096, stream);
    void* args[] = {&prm};
    hipError_t e = hipLaunchCooperativeKernel((const void*)fwd_kernel, dim3(grid), dim3(512), args, LDS_BYTES, stream);
    if (e != hipSuccess) fprintf(stderr, "cooperative launch failed: %s (grid %d)\n", hipGetErrorString(e), grid);
}
```

```cpp
#include <hip/hip_runtime.h>
#include <hip/hip_cooperative_groups.h>
#include <cstdio>
#include <cstdint>
namespace cg = cooperative_groups;

#define LAS __attribute__((address_space(3)))
typedef unsigned short bf16_t;
typedef short bf16x8 __attribute__((ext_vector_type(8)));
typedef float f32x4 __attribute__((ext_vector_type(4)));
typedef float f32x16 __attribute__((ext_vector_type(16)));
typedef unsigned u32x4 __attribute__((ext_vector_type(4)));
typedef unsigned u32x2 __attribute__((ext_vector_type(2)));

constexpr int DM = 2048, MROWS = 17408, MPROMPT = 16384;
constexpr int FH = 5632, F2 = 11264;
constexpr int LDS_BYTES = 147456;
constexpr size_t MiB = 1u << 20;
constexpr size_t WS_WT = 1 * MiB;
constexpr size_t WS_A = 411 * MiB;
constexpr size_t WS_B = 819 * MiB;
constexpr size_t WS_VF = 1227 * MiB;
constexpr size_t WS_END = 1295 * MiB;
constexpr size_t ACT = (size_t)MROWS * DM;
constexpr size_t RW_SZ = (size_t)7168 * 2048 + (size_t)8192 * 256 + (size_t)2048 * 2048;
constexpr size_t GW_SZ = (size_t)6400 * 2048 + (size_t)2048 * 2048;
constexpr size_t FW_SZ = (size_t)11264 * 2048 + (size_t)2048 * 5632;
constexpr size_t GW_OFF = 2 * RW_SZ, FW_OFF = GW_OFF + 2 * GW_SZ;
constexpr size_t O_PSHIFT = 35651584, O_PWKV = 35659776, O_PGLA = 36184064, O_PCONV = 38281216;
constexpr size_t O_SSHIFT = 38461440, O_SWKV = 38526976, O_SGLA = 42721280, O_SCONV = 59498496, O_TOTAL = 60940288;

__device__ __forceinline__ unsigned cvt_pk_bf16(float lo, float hi) { unsigned r; asm volatile("v_cvt_pk_bf16_f32 %0, %1, %2" : "=v"(r) : "v"(lo), "v"(hi)); return r; }
__device__ __forceinline__ float bf2f(bf16_t b) { return __builtin_bit_cast(float, (unsigned)b << 16); }
__device__ __forceinline__ float bflo(unsigned u) { return __builtin_bit_cast(float, u << 16); }
__device__ __forceinline__ float bfhi(unsigned u) { return __builtin_bit_cast(float, u & 0xffff0000u); }
__device__ __forceinline__ void unpack8(u32x4 w, float (&f)[8]) {
    f[0] = bflo(w.x); f[1] = bfhi(w.x); f[2] = bflo(w.y); f[3] = bfhi(w.y); f[4] = bflo(w.z); f[5] = bfhi(w.z); f[6] = bflo(w.w); f[7] = bfhi(w.w);
}
__device__ __forceinline__ u32x4 pack8(const float (&f)[8]) {
    u32x4 w; w.x = cvt_pk_bf16(f[0], f[1]); w.y = cvt_pk_bf16(f[2], f[3]); w.z = cvt_pk_bf16(f[4], f[5]); w.w = cvt_pk_bf16(f[6], f[7]); return w;
}
__device__ __forceinline__ float sigmoidf_(float x) { return 1.f / (1.f + __expf(-x)); }
__device__ __forceinline__ float shx(float v, int lane, int o) { return __builtin_bit_cast(float, __builtin_amdgcn_ds_bpermute((lane ^ o) << 2, __builtin_bit_cast(int, v))); }
__device__ __forceinline__ float wave_sum(float v, int lane) {
#pragma unroll
    for (int o = 1; o < 64; o <<= 1) v += shx(v, lane, o);
    return v;
}
__device__ __forceinline__ float sum8(float v, int lane) { v += shx(v, lane, 1); v += shx(v, lane, 2); v += shx(v, lane, 4); return v; }
__device__ __forceinline__ int crow(int reg, int h) { return (reg & 3) + 8 * (reg >> 2) + 4 * h; }

namespace pg8 {
constexpr int BM = 256, BK = 64, HALF = 128, HTB = HALF * BK * 2, STAGE_BYTES = 8 * HTB, NXCD = 8, WGM = 8;
__host__ __device__ __forceinline__ int lds_byte(int r, int c) { const int st = (r >> 4) * 2 + (c >> 5), rr = r & 15, cc = c & 31, ob = rr * 64 + cc * 2; return st * 1024 + (ob ^ (((ob >> 9) & 1) << 5)); }
__host__ __device__ __forceinline__ void stage_rc(int b, int& R, int& C) { const int st = b / 1024, sb = b % 1024, swz = sb ^ (((sb >> 9) & 1) << 5); R = (st >> 1) * 16 + swz / 64; C = (st & 1) * 32 + (swz % 64) / 2; }
__host__ __device__ __forceinline__ int perm32(int rho) { const int n = rho >> 4, i = rho & 15; return 8 * (i >> 2) + 4 * n + (i & 3); }

struct Unit { int pm, pn, kofs, knt, split; };
struct Gemm { const bf16_t* A; const bf16_t* Bt; int M, N, K; int mode; size_t astride; };
__device__ __forceinline__ const char* a_of(const Gemm& g, int pn) {
    int s = 0;
    if (g.mode == 1) s = pn < 8 ? 0 : pn < 16 ? 2 : pn < 24 ? 3 : pn == 24 ? 1 : pn == 25 ? 4 : pn == 26 ? 5 : 3;
    else if (g.mode == 2) s = pn >> 3;
    return (const char*)g.A + (size_t)s * g.astride;
}
struct StaticOrder {
    int nM, nN, nwg, G, c, nFull, S, ntK, total;
    __device__ __forceinline__ void init(int M, int N, int G_, int c_, int K = 0, int S_ = 1) { nM = M / BM; nN = N / BM; nwg = nM * nN; G = G_; c = c_; ntK = K / BK;
        nFull = (nwg / G) * G; S = S_; if (S_ <= 1 || nFull == nwg) { S = 1; nFull = nwg; } total = nFull + (nwg - nFull) * S; }
    __device__ __forceinline__ bool next(int i, Unit& u) const {
        const long L = (long)i * G + c; if (L >= total) return false;
        int wgid;
        if (L < nFull) { wgid = (int)L; u.kofs = 0; u.knt = ntK; u.split = 0; }
        else { const int j = (int)L - nFull; wgid = nFull + j / S; const int part = j % S; u.knt = ntK / S; u.kofs = part * u.knt * BK; u.split = 1 + part * 32 + j / S; }
        tile_pmpn(wgid, u.pm, u.pn); return true;
    }
    __device__ __forceinline__ void tile_pmpn(int wgid, int& pm, int& pn) const {
        { const int q = nwg / NXCD, r = nwg % NXCD, xcd = wgid % NXCD, off = wgid / NXCD; wgid = (xcd < r ? xcd * (q + 1) : r * (q + 1) + (xcd - r) * q) + off; }
        const int nig = WGM * nN, gid = wgid / nig, fm = gid * WGM, gsz = (nM - fm) < WGM ? (nM - fm) : WGM;
        pm = fm + ((wgid % nig) % gsz); pn = (wgid % nig) / gsz;
    }
};

template <class F> struct Epi {
    static constexpr bool PERM = true;
    F f;
    __device__ __forceinline__ void operator()(const f32x4 (&acc)[2][2][4][2], const Unit& u, int wr, int wc, int fr, int fq) const {
        { int t_ = threadIdx.x; asm volatile("" : "+v"(t_)); const int l_ = t_ & 63, w_ = __builtin_amdgcn_readfirstlane(t_ >> 6); fr = l_ & 15; fq = l_ >> 4; wr = w_ >> 2; wc = w_ & 3; }
        const int row0 = u.pm * BM + wr * 64 + fr, col0 = u.pn * BM + wc * 32 + 8 * fq;
#pragma unroll
        for (int ai = 0; ai < 2; ++ai)
#pragma unroll
            for (int m = 0; m < 4; ++m)
#pragma unroll
                for (int bj = 0; bj < 2; ++bj) f(row0 + ai * HALF + m * 16, col0 + bj * HALF, acc[ai][bj][m][0], acc[ai][bj][m][1], u.split);
    }
};

template <class EpiT>
__device__ __forceinline__ void gemm_phase(LAS unsigned char* lds, const Gemm g, const StaticOrder& S, const EpiT& E) {
    int tid = threadIdx.x; asm volatile("" : "+v"(tid));
    const int wid = __builtin_amdgcn_readfirstlane(tid >> 6), lane = tid & 63, wr = wid >> 2, wc = wid & 3, fr = lane & 15, fq = lane >> 4;
    const int K = g.K;
    unsigned voffA[2], voffB[2];
#pragma unroll
    for (int i = 0; i < 2; ++i) { int R, C; stage_rc(tid * 16 + i * 8192, R, C); const int Rb = EpiT::PERM ? ((R & ~31) + perm32(R & 31)) : R;
        voffA[i] = (unsigned)(R * K + C) * 2u; voffB[i] = (unsigned)(Rb * K + C) * 2u; }
    const size_t kstep = (size_t)(BK * 2);
    const size_t hstep = (size_t)HALF * K * 2;
    const size_t tstep = 2 * hstep;
    const unsigned ldsw = (unsigned)wid * 1024u;
    const int aoff = lds_byte(wr * 64 + fr, fq * 8), boff = lds_byte(wc * 32 + fr, fq * 8);
#define PG8_SA(b, h) (((b) * 2 + (h)) * HTB)
#define PG8_SB(b, h) ((4 + (b) * 2 + (h)) * HTB)
#define PG8_STAGE(bufoff, gbase, voff) do { _Pragma("unroll") for (int _i = 0; _i < 2; ++_i) \
        __builtin_amdgcn_global_load_lds((const unsigned*)((const char*)(gbase) + (voff)[_i]), (LAS unsigned*)(lds + (bufoff) + ldsw + _i * 8192), 16, 0, 0); } while (0)
#define PG8_LDA(dst, b, h) do { _Pragma("unroll") for (int m = 0; m < 4; ++m) _Pragma("unroll") for (int k = 0; k < 2; ++k) dst[m][k] = *(const LAS bf16x8*)(lds + PG8_SA(b, h) + aoff + m * 2048 + k * 1024); } while (0)
#define PG8_LDB(dst, b, h) do { _Pragma("unroll") for (int n = 0; n < 2; ++n) _Pragma("unroll") for (int k = 0; k < 2; ++k) dst[n][k] = *(const LAS bf16x8*)(lds + PG8_SB(b, h) + boff + n * 2048 + k * 1024); } while (0)
#define PG8_MMA(ai, bj, At, Bt) do { __builtin_amdgcn_s_setprio(1); _Pragma("unroll") for (int m = 0; m < 4; ++m) _Pragma("unroll") for (int n = 0; n < 2; ++n) _Pragma("unroll") for (int k = 0; k < 2; ++k) \
        acc[ai][bj][m][n] = __builtin_amdgcn_mfma_f32_16x16x32_bf16(Bt[n][k], At[m][k], acc[ai][bj][m][n], 0, 0, 0); __builtin_amdgcn_s_setprio(0); } while (0)
#define PG8_WAIT_V(n) asm volatile("s_waitcnt vmcnt(" #n ")" ::: "memory")
#define PG8_WAIT_L(n) asm volatile("s_waitcnt lgkmcnt(" #n ")" ::: "memory")
#define PG8_BAR __builtin_amdgcn_s_barrier()
#define PG8_SCHED __builtin_amdgcn_sched_barrier(0)
    Unit cur, nxt; int ui = 0;
    if (!S.next(0, cur)) return;
    f32x4 acc[2][2][4][2];
#pragma unroll
    for (int a = 0; a < 2; ++a)
#pragma unroll
        for (int b = 0; b < 2; ++b)
#pragma unroll
            for (int m = 0; m < 4; ++m)
#pragma unroll
                for (int n = 0; n < 2; ++n) acc[a][b][m][n] = (f32x4){0.f, 0.f, 0.f, 0.f};
    bf16x8 At[4][2], B0[2][2], B1[2][2];
    const char* cA = a_of(g, cur.pn) + (size_t)cur.pm * tstep + (size_t)cur.kofs * 2; const char* cB = (const char*)g.Bt + (size_t)cur.pn * tstep + (size_t)cur.kofs * 2;
    PG8_STAGE(PG8_SB(0, 0), cB, voffB); PG8_STAGE(PG8_SB(0, 1), cB + hstep, voffB); PG8_STAGE(PG8_SA(0, 0), cA, voffA); PG8_STAGE(PG8_SA(0, 1), cA + hstep, voffA);
    if (wr == 1) PG8_BAR;
    PG8_WAIT_V(2); PG8_BAR;
    PG8_STAGE(PG8_SB(1, 0), cB + kstep, voffB); PG8_STAGE(PG8_SA(1, 0), cA + kstep, voffA); PG8_STAGE(PG8_SB(1, 1), cB + hstep + kstep, voffB);
    PG8_WAIT_V(6); PG8_BAR;
    for (;;) {
        const bool has_next = S.next(ui + 1, nxt);
        const char* nA = has_next ? a_of(g, nxt.pn) + (size_t)nxt.pm * tstep + (size_t)nxt.kofs * 2 : cA; const char* nB = has_next ? (const char*)g.Bt + (size_t)nxt.pn * tstep + (size_t)nxt.kofs * 2 : cB;
        const int nt = cur.knt;
        for (int t = 0; t < nt; t += 2) {
            const bool last = (t == nt - 2);
            const char* a1 = cA + (size_t)(t + 1) * kstep;
            const char* a2 = last ? nA : cA + (size_t)(t + 2) * kstep; const char* b2 = last ? nB : cB + (size_t)(t + 2) * kstep;
            const char* a3 = a2 + kstep; const char* b3 = b2 + kstep;
            PG8_LDB(B0, 0, 0); PG8_LDB(B1, 0, 1); PG8_SCHED; PG8_LDA(At, 0, 0); PG8_STAGE(PG8_SA(1, 1), a1 + hstep, voffA);
            PG8_WAIT_V(8); PG8_WAIT_L(0); PG8_BAR; PG8_MMA(0, 0, At, B0); PG8_MMA(0, 1, At, B1); PG8_BAR; PG8_SCHED;
            PG8_LDA(At, 0, 1); PG8_STAGE(PG8_SB(0, 0), b2, voffB); PG8_STAGE(PG8_SB(0, 1), b2 + hstep, voffB); PG8_STAGE(PG8_SA(0, 0), a2, voffA);
            PG8_WAIT_V(8); PG8_WAIT_L(0); PG8_BAR; PG8_MMA(1, 0, At, B0); PG8_MMA(1, 1, At, B1); PG8_BAR; PG8_SCHED;
            PG8_LDB(B0, 1, 0); PG8_LDB(B1, 1, 1); PG8_SCHED; PG8_LDA(At, 1, 0); PG8_STAGE(PG8_SA(0, 1), a2 + hstep, voffA);
            PG8_WAIT_V(8); PG8_WAIT_L(0); PG8_BAR; PG8_MMA(0, 0, At, B0); PG8_MMA(0, 1, At, B1); PG8_BAR; PG8_SCHED;
            PG8_LDA(At, 1, 1); PG8_STAGE(PG8_SB(1, 0), b3, voffB); PG8_STAGE(PG8_SB(1, 1), b3 + hstep, voffB); PG8_STAGE(PG8_SA(1, 0), a3, voffA);
            PG8_WAIT_V(8); PG8_WAIT_L(0); PG8_BAR; PG8_MMA(1, 0, At, B0); PG8_MMA(1, 1, At, B1); PG8_BAR; PG8_SCHED;
        }
        if (wr == 0) PG8_BAR;
        E(acc, cur, wr, wc, fr, fq);
        if (!has_next) break;
#pragma unroll
        for (int a = 0; a < 2; ++a)
#pragma unroll
            for (int b = 0; b < 2; ++b)
#pragma unroll
                for (int m = 0; m < 4; ++m)
#pragma unroll
                    for (int n = 0; n < 2; ++n) acc[a][b][m][n] = (f32x4){0.f, 0.f, 0.f, 0.f};
        cur = nxt; cA = nA; cB = nB; ++ui;
        if (wr == 1) PG8_BAR;
    }
    PG8_WAIT_V(0);
    PG8_BAR;
#undef PG8_SA
#undef PG8_SB
#undef PG8_STAGE
#undef PG8_LDA
#undef PG8_LDB
#undef PG8_MMA
#undef PG8_WAIT_V
#undef PG8_WAIT_L
#undef PG8_BAR
#undef PG8_SCHED
}
}

__device__ __forceinline__ void store8bf(bf16_t* p, f32x4 a, f32x4 b) {
    u32x4 w; w.x = cvt_pk_bf16(a[0], a[1]); w.y = cvt_pk_bf16(a[2], a[3]); w.z = cvt_pk_bf16(b[0], b[1]); w.w = cvt_pk_bf16(b[2], b[3]);
    *(u32x4*)p = w;
}
struct FRes { float* X; float* PART;
    __device__ __forceinline__ void operator()(int row, int col, f32x4 a, f32x4 b, int split) const {
        float* p = X + (size_t)row * DM + col;
        if (split) { float* q = PART + (size_t)(split - 1) * 65536 + (row & 255) * 256 + (col & 255); *(f32x4*)q = a; *(f32x4*)(q + 4) = b; }
        else { f32x4 x0 = *(f32x4*)p, x1 = *(f32x4*)(p + 4); *(f32x4*)p = x0 + a; *(f32x4*)(p + 4) = x1 + b; } } };
struct FR1 { bf16_t *R, *K, *V, *L;
    __device__ __forceinline__ void operator()(int row, int col, f32x4 a, f32x4 b, int) const {
        if (col < 6144) { const int g = col >> 11; const size_t o = (size_t)row * DM + (col & 2047); if (g == 0) store8bf(R + o, a, b); else if (g == 1) store8bf(K + o, a, b); else store8bf(V + o, a, b); }
        else { const int t = (col - 6144) >> 8, c = col & 255;
            if (t == 0) { for (int i = 0; i < 4; ++i) { a[i] = 1.f - 2.f / (1.f + __expf(2.f * a[i])); b[i] = 1.f - 2.f / (1.f + __expf(2.f * b[i])); } }
            else if (t == 2) { for (int i = 0; i < 4; ++i) { a[i] = sigmoidf_(a[i]); b[i] = sigmoidf_(b[i]); } }
            store8bf(L + (size_t)t * MROWS * 256 + (size_t)row * 256 + c, a, b); } } };
__device__ __forceinline__ float decay_of(float z) { return -0.60653065971f / (1.f + __expf(-z)); }
struct FR2 { float* DD; bf16_t *AA, *GG, *VG; const float *w0, *a0, *v0;
    __device__ __forceinline__ void operator()(int row, int col, f32x4 a, f32x4 b, int) const {
        const int g = col >> 11, c = col & 2047; const size_t off = (size_t)row * DM + c;
        if (g == 0) { f32x4 z0 = *(const f32x4*)(w0 + c), z1 = *(const f32x4*)(w0 + c + 4); a += z0; b += z1;
            for (int i = 0; i < 4; ++i) { a[i] = decay_of(a[i]); b[i] = decay_of(b[i]); }
            *(f32x4*)(DD + off) = a; *(f32x4*)(DD + off + 4) = b; }
        else if (g == 1) { f32x4 z0 = *(const f32x4*)(a0 + c), z1 = *(const f32x4*)(a0 + c + 4); a += z0; b += z1;
            for (int i = 0; i < 4; ++i) { a[i] = sigmoidf_(a[i]); b[i] = sigmoidf_(b[i]); } store8bf(AA + off, a, b); }
        else if (g == 2) { store8bf(GG + off, a, b); }
        else { f32x4 z0 = *(const f32x4*)(v0 + c), z1 = *(const f32x4*)(v0 + c + 4); a += z0; b += z1;
            for (int i = 0; i < 4; ++i) { a[i] = sigmoidf_(a[i]); b[i] = sigmoidf_(b[i]); } store8bf(VG + off, a, b); } } };
struct FG1 { bf16_t* PROJ; float* LR;
    __device__ __forceinline__ void operator()(int row, int col, f32x4 a, f32x4 b, int) const {
        if (col < 6144) { if (col < 1024) { a *= 0.0625f; b *= 0.0625f; } store8bf(PROJ + (size_t)row * 6144 + col, a, b); }
        else if (col < 6160) { float* p = LR + (size_t)row * 16 + (col - 6144); *(f32x4*)p = a; *(f32x4*)(p + 4) = b; } } };
struct FUp { bf16_t* U; float* pconv; float* sconv;
    __device__ __forceinline__ void operator()(int row, int col, f32x4 a, f32x4 b, int) const {
        store8bf(U + (size_t)row * F2 + col, a, b);
        if (row < MPROMPT) { const int t = row & 8191; if (t >= 8190) { float* p = pconv + ((size_t)((row >> 13) * 2 + (t - 8190))) * F2 + col; *(f32x4*)p = a; *(f32x4*)(p + 4) = b; } }
        else { const int rr = row - MPROMPT, t = rr & 63; if (t >= 62) { float* p = sconv + ((size_t)((rr >> 6) * 2 + (t - 62))) * F2 + col; *(f32x4*)p = a; *(f32x4*)(p + 4) = b; } } } };

__device__ __forceinline__ void tr_item(const float* W, int K, int N, bf16_t* WT, int Kpad, int Npad, float* scr, int item, int lane) {
    const int nblk = Npad / 64, kb = item / nblk, nb = item % nblk, k0 = 64 * kb, n0 = 64 * nb;
    const int n4 = n0 + (lane & 15) * 4;
    f32x4 v[16];
#pragma unroll
    for (int i = 0; i < 16; ++i) { const int k = k0 + 4 * i + (lane >> 4); v[i] = (k < K && n4 < N) ? *(const f32x4*)(W + (size_t)k * N + n4) : (f32x4){0.f, 0.f, 0.f, 0.f}; }
#pragma unroll
    for (int i = 0; i < 16; ++i) { float* d = scr + (4 * i + (lane >> 4)) * 65 + (lane & 15) * 4; d[0] = v[i][0]; d[1] = v[i][1]; d[2] = v[i][2]; d[3] = v[i][3]; }
    asm volatile("s_waitcnt lgkmcnt(0)" ::: "memory");
    const int c = lane & 7;
#pragma unroll
    for (int j = 0; j < 8; ++j) { const int nn = (lane >> 3) + 8 * j; const float* s = scr + (8 * c) * 65 + nn;
        u32x4 o; o.x = cvt_pk_bf16(s[0 * 65], s[1 * 65]); o.y = cvt_pk_bf16(s[2 * 65], s[3 * 65]); o.z = cvt_pk_bf16(s[4 * 65], s[5 * 65]); o.w = cvt_pk_bf16(s[6 * 65], s[7 * 65]);
        *(u32x4*)(WT + (size_t)(n0 + nn) * Kpad + k0 + 8 * c) = o; }
    asm volatile("s_waitcnt lgkmcnt(0)" ::: "memory");
}

struct P { const float* in[39]; float* out; unsigned char* ws; };

__device__ __forceinline__ void row_info(int row, int& t, int& len, int& b, bool& prompt) {
    if (row < MPROMPT) { prompt = true; b = row >> 13; t = row & 8191; len = 8192; }
    else { prompt = false; const int rr = row - MPROMPT; b = rr >> 6; t = rr & 63; len = 64; }
}

__device__ __forceinline__ const float* ldp(const unsigned long long* tab, int i) {
    const unsigned long long v = tab[i];
    const unsigned lo = __builtin_amdgcn_readfirstlane((unsigned)v), hi = __builtin_amdgcn_readfirstlane((unsigned)(v >> 32));
    const __attribute__((address_space(1))) float* g = (const __attribute__((address_space(1))) float*)(((unsigned long long)hi << 32) | lo);
    return (const float*)g;
}
__device__ __forceinline__ void fast_grid_barrier(unsigned* bar, unsigned long long* tab) {
    asm volatile("s_waitcnt vmcnt(0)" ::: "memory");
    __syncthreads();
    if (threadIdx.x == 0) {
        const unsigned G = gridDim.x, grp = blockIdx.x & 7u;
        const unsigned epoch = (unsigned)tab[41] + 1u; tab[41] = epoch;
        const unsigned ngrp = (G - grp + 7u) >> 3, ntop = G < 8u ? G : 8u;
        __builtin_amdgcn_fence(__ATOMIC_RELEASE, "agent");
        asm volatile("s_waitcnt vmcnt(0)" ::: "memory");
        const unsigned old = __hip_atomic_fetch_add(&bar[64u * (1u + grp)], 1u, __ATOMIC_RELAXED, __HIP_MEMORY_SCOPE_AGENT);
        if (old + 1u == epoch * ngrp) (void)__hip_atomic_fetch_add(&bar[0], 1u, __ATOMIC_RELAXED, __HIP_MEMORY_SCOPE_AGENT);
        while (__hip_atomic_load(&bar[0], __ATOMIC_RELAXED, __HIP_MEMORY_SCOPE_AGENT) < epoch * ntop) __builtin_amdgcn_s_sleep(1);
        __builtin_amdgcn_fence(__ATOMIC_ACQUIRE, "agent");
        asm volatile("s_waitcnt vmcnt(0)" ::: "memory");
    }
    __syncthreads();
}
#define IN(k) ldp(tab, (k))
#define OUTP ((float*)ldp(tab, 39))
#define BASES float* X = (float*)ldp(tab, 39); unsigned char* ws_ = (unsigned char*)ldp(tab, 40); bf16_t* WT = (bf16_t*)(ws_ + WS_WT); unsigned char* RA = ws_ + WS_A; unsigned char* RB = ws_ + WS_B; \
    bf16_t* VFIRST = (bf16_t*)(ws_ + WS_VF); LAS unsigned char* ldsl = (LAS unsigned char*)lds; (void)X; (void)WT; (void)RA; (void)RB; (void)VFIRST; (void)ldsl;
#define RWKV_PTRS bf16_t* HB = (bf16_t*)RA; bf16_t* Rb = (bf16_t*)RB; bf16_t* Kb = Rb + ACT; bf16_t* Vb = (jl == 0) ? VFIRST : Kb + ACT; bf16_t* Lb = (bf16_t*)(RB + 204 * MiB); \
    float* DD = (float*)(RB + 240 * MiB); bf16_t* AA = (bf16_t*)RA; bf16_t* VG = AA + ACT; bf16_t* GG = VG + ACT; bf16_t* Y = GG + ACT; \
    bf16_t* W1 = WT + jl * RW_SZ; bf16_t* W2 = W1 + (size_t)7168 * 2048; bf16_t* WO = W2 + (size_t)8192 * 256; \
    (void)HB; (void)Rb; (void)Kb; (void)Vb; (void)Lb; (void)DD; (void)AA; (void)VG; (void)GG; (void)Y; (void)W1; (void)W2; (void)WO;
#define GLA_PTRS bf16_t* H = (bf16_t*)RB; float* LR = (float*)(RB + 68 * MiB); float* O = (float*)(RB + 70 * MiB); bf16_t* Y = (bf16_t*)(RB + 206 * MiB); \
    bf16_t* PROJ = (bf16_t*)RA; bf16_t* QE = (bf16_t*)(RA + 204 * MiB); bf16_t* KDT = (bf16_t*)(RA + 238 * MiB); bf16_t* VT = (bf16_t*)(RA + 272 * MiB); \
    bf16_t* SC = (bf16_t*)(RA + 340 * MiB); float* EL = (float*)(RA + 349 * MiB); bf16_t* GI = WT + GW_OFF + jl * GW_SZ; bf16_t* GO = GI + (size_t)6400 * 2048; \
    (void)H; (void)LR; (void)O; (void)Y; (void)PROJ; (void)QE; (void)KDT; (void)VT; (void)SC; (void)EL; (void)GI; (void)GO;
#define FFN_PTRS bf16_t* H = (bf16_t*)RB; bf16_t* HID = (bf16_t*)(RB + 68 * MiB); bf16_t* U = (bf16_t*)RA; bf16_t* WU = WT + FW_OFF + layer * FW_SZ; bf16_t* WD = WU + (size_t)F2 * 2048; \
    (void)H; (void)HID; (void)U; (void)WU; (void)WD;

__global__ void __launch_bounds__(512, 2) fwd_kernel(P p) {
    extern __shared__ __attribute__((aligned(16))) unsigned char lds[];
    cg::grid_group grid = cg::this_grid();
    const int G = gridDim.x, NGW = G * 8, NT = G * 512;
#define PHASE_IDS int tid = threadIdx.x; asm volatile("" : "+v"(tid)); const int lane = tid & 63; const int wave = __builtin_amdgcn_readfirstlane(tid >> 6); const int gw = blockIdx.x * 8 + wave; const int gtid = blockIdx.x * 512 + tid; (void)lane; (void)gw; (void)gtid;
    unsigned long long* tab = (unsigned long long*)(lds + LDS_BYTES - 512);
    if (threadIdx.x == 0) {
#pragma unroll
        for (int i = 0; i < 39; ++i) tab[i] = (unsigned long long)p.in[i];
        tab[39] = (unsigned long long)p.out; tab[40] = (unsigned long long)p.ws; tab[41] = 0ull;
    }
    __syncthreads();

    {
        PHASE_IDS BASES
        float* scr = (float*)(lds + wave * 16896);
#define TR(src, K, N, dst, Kpad, Npad) do { const int _ni = ((Kpad) / 64) * ((Npad) / 64); for (int it = cgw_; it < _ni; it += cngw_) tr_item((src), (K), (N), (dst), (Kpad), (Npad), scr, it, lane); } while (0)
#define CONVERT_WEIGHTS(JLO, JHI, ILO, IHI, GWV, NGWV) do { const int cgw_ = (GWV), cngw_ = (NGWV); \
        _Pragma("unroll 1") for (int j = (JLO); j < (JHI); ++j) { \
            bf16_t* W1 = WT + j * RW_SZ; bf16_t* W2 = W1 + (size_t)7168 * 2048; bf16_t* WO = W2 + (size_t)8192 * 256; \
            TR(IN(24) + (size_t)j * DM * DM, 2048, 2048, W1, 2048, 2048); \
            TR(IN(25) + (size_t)j * DM * DM, 2048, 2048, W1 + (size_t)2048 * 2048, 2048, 2048); \
            TR(IN(26) + (size_t)j * DM * DM, 2048, 2048, W1 + (size_t)4096 * 2048, 2048, 2048); \
            TR(IN(11) + (size_t)j * DM * 96, 2048, 96, W1 + (size_t)6144 * 2048, 2048, 256); \
            TR(IN(14) + (size_t)j * DM * 96, 2048, 96, W1 + (size_t)6400 * 2048, 2048, 256); \
            TR(IN(19) + (size_t)j * DM * 256, 2048, 256, W1 + (size_t)6656 * 2048, 2048, 256); \
            if (j >= 1) TR(IN(17) + (size_t)(j - 1) * DM * 64, 2048, 64, W1 + (size_t)6912 * 2048, 2048, 256); \
            TR(IN(12) + (size_t)j * 96 * DM, 96, 2048, W2, 256, 2048); \
            TR(IN(15) + (size_t)j * 96 * DM, 96, 2048, W2 + (size_t)2048 * 256, 256, 2048); \
            TR(IN(20) + (size_t)j * 256 * DM, 256, 2048, W2 + (size_t)4096 * 256, 256, 2048); \
            if (j >= 1) TR(IN(18) + (size_t)(j - 1) * 64 * DM, 64, 2048, W2 + (size_t)6144 * 256, 256, 2048); \
            TR(IN(27) + (size_t)j * DM * DM, 2048, 2048, WO, 2048, 2048); \
            bf16_t* GI = WT + GW_OFF + j * GW_SZ; bf16_t* GO = GI + (size_t)6400 * 2048; \
            TR(IN(30) + (size_t)j * DM * 6160, 2048, 6160, GI, 2048, 6400); \
            TR(IN(34) + (size_t)j * DM * DM, 2048, 2048, GO, 2048, 2048); \
        } \
        _Pragma("unroll 1") for (int i = (ILO); i < (IHI); ++i) { \
            bf16_t* WU = WT + FW_OFF + i * FW_SZ; bf16_t* WD = WU + (size_t)F2 * 2048; \
            TR(IN(35) + (size_t)i * DM * F2, 2048, F2, WU, 2048, F2); \
            TR(IN(38) + (size_t)i * FH * DM, FH, 2048, WD, FH, 2048); \
        } } while (0)
        if (G >= 256) CONVERT_WEIGHTS(0, 1, 0, 2, gw, NGW); else CONVERT_WEIGHTS(0, 2, 0, 4, gw, NGW);
        const f32x4* xp = (const f32x4*)IN(0); const f32x4* xs = (const f32x4*)IN(1); f32x4* xo = (f32x4*)X;
        const int NP4 = MPROMPT * DM / 4, NA4 = MROWS * DM / 4;
#pragma unroll 4
        for (int i = gtid; i < NA4; i += NT) xo[i] = i < NP4 ? xp[i] : xs[i - NP4];
    }
    grid.sync();

#pragma clang loop unroll(full)
    for (int layer = 0; layer < 4; ++layer) {
        const int jl = layer >> 1;
        if ((layer & 1) == 0) {
            {
                PHASE_IDS BASES RWKV_PTRS
                const float* gmix = IN(6) + (size_t)layer * DM;
                const float* mix = IN(9) + (size_t)jl * 6 * DM;
                const float* sst = IN(2) + (size_t)jl * 16 * DM;
                float* mixS = (float*)lds; float* gS = mixS + 6 * DM;
                for (int i = tid; i < 6 * DM / 4; i += 512) *(f32x4*)(mixS + i * 4) = *(const f32x4*)(mix + i * 4);
                for (int i = tid; i < DM / 4; i += 512) *(f32x4*)(gS + i * 4) = *(const f32x4*)(gmix + i * 4);
                __syncthreads();
                for (int row = gw; row < MROWS; row += NGW) {
                    int t, len, b; bool prompt; row_info(row, t, len, b, prompt);
                    const f32x4* xr = (const f32x4*)(X + (size_t)row * DM) + lane;
                    f32x4 x[8]; float ss = 0.f;
#pragma unroll
                    for (int q = 0; q < 8; ++q) { x[q] = xr[64 * q]; ss += x[q][0] * x[q][0] + x[q][1] * x[q][1] + x[q][2] * x[q][2] + x[q][3] * x[q][3]; }
                    const float rs = rsqrtf(wave_sum(ss, lane) * (1.f / DM) + 1e-6f);
                    f32x4 hp[8];
                    if (t > 0) {
                        const f32x4* xq = (const f32x4*)(X + (size_t)(row - 1) * DM) + lane; float s2 = 0.f;
#pragma unroll
                        for (int q = 0; q < 8; ++q) { hp[q] = xq[64 * q]; s2 += hp[q][0] * hp[q][0] + hp[q][1] * hp[q][1] + hp[q][2] * hp[q][2] + hp[q][3] * hp[q][3]; }
                        const float rp = rsqrtf(wave_sum(s2, lane) * (1.f / DM) + 1e-6f);
#pragma unroll
                        for (int q = 0; q < 8; ++q) { const f32x4 gg = *((const f32x4*)gS + lane + 64 * q); hp[q] = hp[q] * rp * gg; }
                    } else if (!prompt) {
#pragma unroll
                        for (int q = 0; q < 8; ++q) hp[q] = *((const f32x4*)(sst + (size_t)b * DM) + lane + 64 * q);
                    } else {
#pragma unroll
                        for (int q = 0; q < 8; ++q) hp[q] = (f32x4){0.f, 0.f, 0.f, 0.f};
                    }
                    const bool lastrow = (t == len - 1);
                    float* shout = OUTP + (prompt ? O_PSHIFT + ((size_t)jl * 2 + b) * DM : O_SSHIFT + ((size_t)jl * 16 + b) * DM);
#pragma unroll
                    for (int q = 0; q < 8; ++q) {
                        const f32x4 gg = *((const f32x4*)gS + lane + 64 * q);
                        const f32x4 h = x[q] * rs * gg; const f32x4 dlt = hp[q] - h;
                        if (lastrow) *((f32x4*)shout + lane + 64 * q) = h;
#pragma unroll
                        for (int m = 0; m < 6; ++m) {
                            const f32x4 mx = *((const f32x4*)(mixS + m * DM) + lane + 64 * q);
                            const f32x4 o = h + dlt * mx;
                            u32x2 w; w.x = cvt_pk_bf16(o[0], o[1]); w.y = cvt_pk_bf16(o[2], o[3]);
                            *((u32x2*)(HB + (size_t)m * ACT + (size_t)row * DM) + lane + 64 * q) = w;
                        }
                    }
                }
            }
            fast_grid_barrier((unsigned*)ldp(tab, 40), tab);
            {
                BASES RWKV_PTRS
                pg8::Gemm g{HB, W1, MROWS, jl == 0 ? 6912 : 7168, 2048, 1, ACT * 2};
                pg8::StaticOrder S; S.init(g.M, g.N, G, (int)blockIdx.x, g.K, 1);
                pg8::Epi<FR1> E{FR1{Rb, Kb, Vb, Lb}};
                pg8::gemm_phase(ldsl, g, S, E);
            }
            fast_grid_barrier((unsigned*)ldp(tab, 40), tab);
            {
                BASES RWKV_PTRS
                pg8::Gemm g{Lb, W2, MROWS, jl == 0 ? 6144 : 8192, 256, 2, (size_t)MROWS * 256 * 2};
                pg8::StaticOrder S; S.init(g.M, g.N, G, (int)blockIdx.x, g.K, 1);
                pg8::Epi<FR2> E{FR2{DD, AA, GG, VG, IN(10) + (size_t)jl * DM, IN(13) + (size_t)jl * DM, IN(16) + (size_t)(jl > 0 ? jl - 1 : 0) * DM}};
                pg8::gemm_phase(ldsl, g, S, E);
            }
            fast_grid_barrier((unsigned*)ldp(tab, 40), tab);
            {
                PHASE_IDS BASES RWKV_PTRS
                float* Obuf = (float*)(RA + 272 * MiB); float* RK = (float*)(RB + 204 * MiB); float* DTg = (float*)(RB + 208 * MiB);
                const float* k_k = IN(21) + (size_t)jl * DM; const float* k_a = IN(22) + (size_t)jl * DM; const float* r_k = IN(23) + (size_t)jl * DM;
                const int l32 = lane & 31, hl = lane >> 5;
#define S1_BAR do { asm volatile("s_waitcnt lgkmcnt(0)" ::: "memory"); __builtin_amdgcn_s_barrier(); asm volatile("" ::: "memory"); } while (0)
                const int st = tid >> 3, c0 = (tid & 7) * 8;
                u32x4 pr_, pk_, pv_, pa_, pvf_ = (u32x4){0u, 0u, 0u, 0u}, pvg_ = (u32x4){0u, 0u, 0u, 0u}; f32x4 pd0_, pd1_;
#define S1_FETCH(it) do { const size_t _off = (size_t)(((it) >> 5) * 64 + st) * DM + ((it) & 31) * 64 + c0; \
                    pr_ = *(const u32x4*)(Rb + _off); pk_ = *(const u32x4*)(Kb + _off); pv_ = *(const u32x4*)(Vb + _off); pa_ = *(const u32x4*)(AA + _off); \
                    pd0_ = *(const f32x4*)(DD + _off); pd1_ = *(const f32x4*)(DD + _off + 4); \
                    if (jl > 0) { pvf_ = *(const u32x4*)(VFIRST + _off); pvg_ = *(const u32x4*)(VG + _off); } } while (0)
#pragma unroll 1
                for (int item = blockIdx.x; item < 8704; item += G) {
                    LAS unsigned char* ldsv = (LAS unsigned char*)lds; asm volatile("" : "+v"(ldsv));
                    LAS bf16_t* AH = (LAS bf16_t*)(ldsv + 0); LAS bf16_t* RH = (LAS bf16_t*)(ldsv + 9216); LAS bf16_t* BH = (LAS bf16_t*)(ldsv + 18432); LAS bf16_t* KH = (LAS bf16_t*)(ldsv + 27648);
                    LAS bf16_t* BHT = (LAS bf16_t*)(ldsv + 36864); LAS bf16_t* KHT = (LAS bf16_t*)(ldsv + 46080); LAS bf16_t* VTs = (LAS bf16_t*)(ldsv + 55296); LAS bf16_t* XT = (LAS bf16_t*)(ldsv + 64512);
                    LAS float* AAB = (LAS float*)(ldsv + 82944); LAS bf16_t* AAK = (LAS bf16_t*)(ldsv + 99328); LAS bf16_t* ARB = (LAS bf16_t*)(ldsv + 108544); LAS bf16_t* ARK = (LAS bf16_t*)(ldsv + 117760);
                    LAS float* LB = (LAS float*)(ldsv + 126976); LAS float* DTS = (LAS float*)(ldsv + 143360);
                    (void)RH; (void)KH; (void)KHT;
                    const int chunk = item >> 5, h = item & 31, r0 = chunk * 64;
                    const int col = h * 64 + c0;
                    S1_FETCH(item);
                    float r[8], kk[8], bb[8], km[8], ld[8];
                    {
                        float k[8], v[8], a[8];
                        unpack8(pr_, r); unpack8(pk_, k); unpack8(pv_, v); unpack8(pa_, a);
                        const f32x4 d0 = pd0_, d1 = pd1_;
                        ld[0] = d0[0]; ld[1] = d0[1]; ld[2] = d0[2]; ld[3] = d0[3]; ld[4] = d1[0]; ld[5] = d1[1]; ld[6] = d1[2]; ld[7] = d1[3];
                        if (jl > 0) { float vf[8], vg[8]; unpack8(pvf_, vf); unpack8(pvg_, vg);
#pragma unroll
                            for (int i = 0; i < 8; ++i) v[i] = v[i] + (vf[i] - v[i]) * vg[i]; }
                        float ss = 0.f;
#pragma unroll
                        for (int i = 0; i < 8; ++i) { kk[i] = k[i] * k_k[col + i]; ss += kk[i] * kk[i]; }
                        ss = sum8(ss, lane);
                        const float inv = 1.f / fmaxf(sqrtf(ss), 1e-12f);
                        float rk = 0.f;
#pragma unroll
                        for (int i = 0; i < 8; ++i) { kk[i] *= inv; bb[i] = kk[i] * a[i]; km[i] = k[i] * (1.f + (a[i] - 1.f) * k_a[col + i]); rk += r[i] * km[i] * r_k[col + i]; }
                        rk = sum8(rk, lane);
                        if ((tid & 7) == 0) RK[(size_t)(r0 + st) * 32 + h] = rk;
                        *(LAS f32x4*)(LB + st * 64 + c0) = d0; *(LAS f32x4*)(LB + st * 64 + c0 + 4) = d1;
#pragma unroll
                        for (int i = 0; i < 8; i += 2) { const unsigned pk = cvt_pk_bf16(v[i], v[i + 1]); VTs[(c0 + i) * 72 + st] = (bf16_t)(pk & 0xffffu); VTs[(c0 + i + 1) * 72 + st] = (bf16_t)(pk >> 16); }
                    }
                    S1_BAR;
                    {
                        const int cc_ = tid & 63, tq_ = tid >> 6; float pf[8]; float run = 0.f;
#pragma unroll
                        for (int j = 0; j < 8; ++j) { run += LB[(8 * tq_ + j) * 64 + cc_]; pf[j] = run; }
                        AAB[tq_ * 64 + cc_] = run;
                        S1_BAR;
                        float ofs = 0.f;
#pragma unroll
                        for (int g = 0; g < 7; ++g) ofs += (g < tq_) ? AAB[g * 64 + cc_] : 0.f;
#pragma unroll
                        for (int j = 0; j < 8; ++j) LB[(8 * tq_ + j) * 64 + cc_] = pf[j] + ofs;
                    }
                    S1_BAR;
                    {
                        float ah[8], bh[8], kh[8], rh[8];
#pragma unroll
                        for (int i = 0; i < 8; ++i) { const float Lt = LB[st * 64 + c0 + i]; const float e3 = __expf(Lt), e2 = __expf(-Lt), e1 = __expf(Lt - ld[i]);
                            ah[i] = -kk[i] * e1; bh[i] = bb[i] * e2; kh[i] = km[i] * e2; rh[i] = r[i] * e3;
                            if (st == 63) { DTS[c0 + i] = e3; DTg[(size_t)item * 64 + c0 + i] = e3; } }
                        *(LAS u32x4*)(AH + st * 72 + c0) = pack8(ah); *(LAS u32x4*)(RH + st * 72 + c0) = pack8(rh);
                        *(LAS u32x4*)(BH + st * 72 + c0) = pack8(bh); *(LAS u32x4*)(KH + st * 72 + c0) = pack8(kh);
#pragma unroll
                        for (int i = 0; i < 8; i += 2) { const unsigned p1 = cvt_pk_bf16(bh[i], bh[i + 1]), p2 = cvt_pk_bf16(kh[i], kh[i + 1]);
                            BHT[(c0 + i) * 72 + st] = (bf16_t)(p1 & 0xffffu); BHT[(c0 + i + 1) * 72 + st] = (bf16_t)(p1 >> 16);
                            KHT[(c0 + i) * 72 + st] = (bf16_t)(p2 & 0xffffu); KHT[(c0 + i + 1) * 72 + st] = (bf16_t)(p2 >> 16); }
                    }
                    S1_BAR;
                    {
                        const int mi = wave & 3, rowsel = mi >> 1, tt = mi & 1;
#pragma unroll
                        for (int nn = 0; nn < 2; ++nn) {
                            const int colsel = wave >> 2, stl = nn; const int ni = 2 * colsel + nn;
                            f32x16 acc;
#pragma unroll
                            for (int i = 0; i < 16; ++i) acc[i] = 0.f;
                            if (stl <= tt) {
#pragma unroll
                                for (int ks = 0; ks < 4; ++ks) {
                                    const bf16x8 a = *(const LAS bf16x8*)(AH + (mi * 32 + l32) * 72 + ks * 16 + hl * 8);
                                    const bf16x8 b = *(const LAS bf16x8*)(BH + (ni * 32 + l32) * 72 + ks * 16 + hl * 8);
                                    acc = __builtin_amdgcn_mfma_f32_32x32x16_bf16(a, b, acc, 0, 0, 0);
                                }
                            }
#pragma unroll
                            for (int i = 0; i < 16; ++i) {
                                const int t = tt * 32 + crow(i, hl), s = stl * 32 + l32;
                                const bool keep = rowsel ? (s <= t) : (s < t);
                                const float val = keep ? acc[i] : 0.f;
                                if (rowsel == 0 && colsel == 0) AAB[t * 64 + s] = val;
                                else { LAS bf16_t* dst = (rowsel == 0) ? AAK : (colsel == 0 ? ARB : ARK); dst[t * 72 + s] = (bf16_t)(cvt_pk_bf16(val, 0.f) & 0xffffu); }
                            }
                        }
                    }
                    S1_BAR;
                    if (wave < 4) {
                        const int mt = wave >> 1, nt = wave & 1;
                        f32x16 acc;
#pragma unroll
                        for (int i = 0; i < 16; ++i) acc[i] = 0.f;
#pragma unroll
                        for (int ks = 0; ks < 4; ++ks) {
                            const bf16x8 a = *(const LAS bf16x8*)(AAK + (mt * 32 + l32) * 72 + ks * 16 + hl * 8);
                            const bf16x8 b = *(const LAS bf16x8*)(VTs + (nt * 32 + l32) * 72 + ks * 16 + hl * 8);
                            acc = __builtin_amdgcn_mfma_f32_32x32x16_bf16(a, b, acc, 0, 0, 0);
                        }
#pragma unroll
                        for (int i = 0; i < 16; ++i) LB[(mt * 32 + crow(i, hl)) * 64 + nt * 32 + l32] = acc[i];
                    }
                    S1_BAR;
                    {
                        const int colx = tid >> 2, par = tid & 3;
                        float Xp[4][4];
#pragma unroll
                        for (int i = 0; i < 4; ++i) { Xp[i][0] = 0.f; Xp[i][1] = 0.f; Xp[i][2] = 0.f; Xp[i][3] = 0.f; }
#pragma clang loop unroll(full)
                        for (int t = 0; t < 64; ++t) {
                            const float va_ = bf2f(AH[t * 72 + (colx & 63)]), vb_ = LB[t * 64 + (colx & 63)];
                            float a0 = par ? 0.f : ((colx < 64) ? va_ : vb_);
                            float a1 = 0.f, a2 = 0.f, a3 = 0.f;
#pragma clang loop unroll(full)
                            for (int i = 0; 16 * i < t; ++i) { const f32x4 w = *(const LAS f32x4*)(AAB + t * 64 + 16 * i + 4 * par);
                                a0 += w[0] * Xp[i][0]; a1 += w[1] * Xp[i][1]; a2 += w[2] * Xp[i][2]; a3 += w[3] * Xp[i][3]; }
                            float val = (a0 + a1) + (a2 + a3);
                            val += __builtin_bit_cast(float, __builtin_amdgcn_update_dpp(0, __builtin_bit_cast(int, val), 0xB1, 0xf, 0xf, false));
                            val += __builtin_bit_cast(float, __builtin_amdgcn_update_dpp(0, __builtin_bit_cast(int, val), 0x4E, 0xf, 0xf, false));
                            Xp[t >> 4][t & 3] = (par == ((t >> 2) & 3)) ? val : Xp[t >> 4][t & 3];
                            asm volatile("" : "+v"(Xp[t >> 4][t & 3]));
                        }
#pragma unroll
                        for (int i = 0; i < 4; ++i) { u32x2 w; w.x = cvt_pk_bf16(Xp[i][0], Xp[i][1]); w.y = cvt_pk_bf16(Xp[i][2], Xp[i][3]);
                            *(LAS u32x2*)(XT + colx * 72 + 16 * i + 4 * par) = w; }
                    }
                    S1_BAR;
                    {
                        const int kind = wave >> 2, mt = (wave & 3) >> 1, nt = wave & 1;
                        {
                            const LAS bf16_t* Ap = (kind == 0 ? ARB : BHT) + (mt * 32 + l32) * 72; const LAS bf16_t* Bp = XT + (nt * 32 + l32) * 72;
                            f32x16 acc;
#pragma unroll
                            for (int i = 0; i < 16; ++i) acc[i] = 0.f;
#pragma unroll
                            for (int ks = 0; ks < 4; ++ks) acc = __builtin_amdgcn_mfma_f32_32x32x16_bf16(*(const LAS bf16x8*)(Ap + ks * 16 + hl * 8), *(const LAS bf16x8*)(Bp + ks * 16 + hl * 8), acc, 0, 0, 0);
                            bf16_t* dstb = (kind == 0) ? Rb : Kb;
#pragma unroll
                            for (int i = 0; i < 16; ++i) { const int rr = mt * 32 + crow(i, hl), cc = nt * 32 + l32;
                                float val = acc[i];
                                if (kind == 0) val += bf2f(RH[rr * 72 + cc]); else val *= DTS[rr];
                                dstb[(size_t)(r0 + rr) * DM + h * 64 + cc] = (bf16_t)(cvt_pk_bf16(val, 0.f) & 0xffffu); }
                        }
                        {
                            const LAS bf16_t* A1 = (kind == 0 ? ARB : BHT) + (mt * 32 + l32) * 72; const LAS bf16_t* A2 = (kind == 0 ? ARK : KHT) + (mt * 32 + l32) * 72;
                            const LAS bf16_t* B1 = XT + (64 + nt * 32 + l32) * 72; const LAS bf16_t* B2 = VTs + (nt * 32 + l32) * 72;
                            f32x16 acc;
#pragma unroll
                            for (int i = 0; i < 16; ++i) acc[i] = 0.f;
#pragma unroll
                            for (int ks = 0; ks < 4; ++ks) acc = __builtin_amdgcn_mfma_f32_32x32x16_bf16(*(const LAS bf16x8*)(A1 + ks * 16 + hl * 8), *(const LAS bf16x8*)(B1 + ks * 16 + hl * 8), acc, 0, 0, 0);
#pragma unroll
                            for (int ks = 0; ks < 4; ++ks) acc = __builtin_amdgcn_mfma_f32_32x32x16_bf16(*(const LAS bf16x8*)(A2 + ks * 16 + hl * 8), *(const LAS bf16x8*)(B2 + ks * 16 + hl * 8), acc, 0, 0, 0);
                            float* dstf = (kind == 0) ? Obuf : DD;
#pragma unroll
                            for (int i = 0; i < 16; ++i) { const int rr = mt * 32 + crow(i, hl), cc = nt * 32 + l32;
                                float val = acc[i]; if (kind == 1) val *= DTS[rr];
                                dstf[(size_t)(r0 + rr) * DM + h * 64 + cc] = val; }
                        }
                    }
                    S1_BAR;
                }
            }
            fast_grid_barrier((unsigned*)ldp(tab, 40), tab);
#undef S1_BAR
#undef S1_FETCH
            {
                PHASE_IDS BASES RWKV_PTRS
                const float* DTg = (const float*)(RB + 208 * MiB);
                const int l32 = lane & 31, hl = lane >> 5;
                const int q = wave * G + blockIdx.x;
                if (q < 1152) {
                    const bool prompt = q < 128; int b, h, vh, chunk0, nch;
                    if (prompt) { const int chain = q & 63; b = chain >> 5; h = chain & 31; vh = q >> 6; chunk0 = b * 128; nch = 128; }
                    else { const int sq = q - 128; const int chain = sq >> 1; b = chain >> 5; h = chain & 31; vh = sq & 1; chunk0 = 256 + b; nch = 1; }
                    const int colb = h * 64, vcol = colb + 32 * vh + l32;
                    f32x16 S0, S1;
                    if (prompt) {
#pragma unroll
                        for (int i = 0; i < 16; ++i) { S0[i] = 0.f; S1[i] = 0.f; }
                    } else {
                        const float* s0 = IN(3) + ((((size_t)jl * 16 + b) * 32 + h) * 64 + (32 * vh + l32)) * 64;
#pragma unroll
                        for (int i = 0; i < 16; ++i) { S0[i] = s0[crow(i, hl)]; S1[i] = s0[32 + crow(i, hl)]; }
                    }
                    bf16x8 gf[2][2][2]; f32x16 n0, n1; f32x4 dt_[2][4];
#define S2_COMPUTE(cc) do { const int _r0 = (chunk0 + (cc)) * 64; \
                        u32x4 w00, w01, w10, w11; \
                        w00.x = cvt_pk_bf16(S0[0], S0[1]); w00.y = cvt_pk_bf16(S0[2], S0[3]); w00.z = cvt_pk_bf16(S0[4], S0[5]); w00.w = cvt_pk_bf16(S0[6], S0[7]); \
                        w01.x = cvt_pk_bf16(S0[8], S0[9]); w01.y = cvt_pk_bf16(S0[10], S0[11]); w01.z = cvt_pk_bf16(S0[12], S0[13]); w01.w = cvt_pk_bf16(S0[14], S0[15]); \
                        w10.x = cvt_pk_bf16(S1[0], S1[1]); w10.y = cvt_pk_bf16(S1[2], S1[3]); w10.z = cvt_pk_bf16(S1[4], S1[5]); w10.w = cvt_pk_bf16(S1[6], S1[7]); \
                        w11.x = cvt_pk_bf16(S1[8], S1[9]); w11.y = cvt_pk_bf16(S1[10], S1[11]); w11.z = cvt_pk_bf16(S1[12], S1[13]); w11.w = cvt_pk_bf16(S1[14], S1[15]); \
                        const bf16x8 sb00 = __builtin_bit_cast(bf16x8, w00), sb01 = __builtin_bit_cast(bf16x8, w01), sb10 = __builtin_bit_cast(bf16x8, w10), sb11 = __builtin_bit_cast(bf16x8, w11); \
                        n0 = __builtin_amdgcn_mfma_f32_32x32x16_bf16(gf[0][0][0], sb00, n0, 0, 0, 0); n1 = __builtin_amdgcn_mfma_f32_32x32x16_bf16(gf[1][0][0], sb00, n1, 0, 0, 0); \
                        n0 = __builtin_amdgcn_mfma_f32_32x32x16_bf16(gf[0][0][1], sb01, n0, 0, 0, 0); n1 = __builtin_amdgcn_mfma_f32_32x32x16_bf16(gf[1][0][1], sb01, n1, 0, 0, 0); \
                        n0 = __builtin_amdgcn_mfma_f32_32x32x16_bf16(gf[0][1][0], sb10, n0, 0, 0, 0); n1 = __builtin_amdgcn_mfma_f32_32x32x16_bf16(gf[1][1][0], sb10, n1, 0, 0, 0); \
                        n0 = __builtin_amdgcn_mfma_f32_32x32x16_bf16(gf[0][1][1], sb11, n0, 0, 0, 0); n1 = __builtin_amdgcn_mfma_f32_32x32x16_bf16(gf[1][1][1], sb11, n1, 0, 0, 0); \
                        { unsigned char* _sp = (unsigned char*)DD + ((size_t)(_r0 + l32) * DM + colb + 32 * vh) * 4 + 8 * hl; \
                          *(u32x2*)(_sp + 0) = (u32x2){w00.x, w00.y}; *(u32x2*)(_sp + 16) = (u32x2){w00.z, w00.w}; *(u32x2*)(_sp + 32) = (u32x2){w01.x, w01.y}; *(u32x2*)(_sp + 48) = (u32x2){w01.z, w01.w}; \
                          *(u32x2*)(_sp + 64) = (u32x2){w10.x, w10.y}; *(u32x2*)(_sp + 80) = (u32x2){w10.z, w10.w}; *(u32x2*)(_sp + 96) = (u32x2){w11.x, w11.y}; *(u32x2*)(_sp + 112) = (u32x2){w11.z, w11.w}; } \
                        _Pragma("unroll") for (int i = 0; i < 16; ++i) { S0[i] = S0[i] * dt_[0][i >> 2][i & 3] + n0[i]; S1[i] = S1[i] * dt_[1][i >> 2][i & 3] + n1[i]; } \
                    } while (0)
                    if (prompt) {
                        LAS float* dtl = (LAS float*)((LAS unsigned char*)lds);
                        LAS unsigned char* ring = (LAS unsigned char*)lds + 32768;
                        for (int i = lane; i < 128 * 16; i += 64) *(LAS f32x4*)(dtl + i * 4) = *(const f32x4*)(DTg + ((size_t)(chunk0 + (i >> 4)) * 32 + h) * 64 + (i & 15) * 4);
#define S2_DMA(cc) do { const int _r0 = (chunk0 + (cc)) * 64; LAS unsigned char* _s = ring + ((cc) & 3) * 16384; \
                            _Pragma("unroll") for (int j = 0; j < 8; ++j) { const int _row = 8 * j + (lane >> 3); const int _p = (lane & 7) ^ (_row & 7); \
                                __builtin_amdgcn_global_load_lds((const unsigned*)(Kb + (size_t)(_r0 + _row) * DM + colb + _p * 8), (LAS unsigned*)(_s + j * 1024), 16, 0, 0); } \
                            _Pragma("unroll") for (int j = 0; j < 8; ++j) { const int _row = 8 * j + (lane >> 3); \
                                __builtin_amdgcn_global_load_lds((const unsigned*)(DD + (size_t)(_r0 + _row) * DM + colb + 32 * vh + (lane & 7) * 4), (LAS unsigned*)(_s + 8192 + j * 1024), 16, 0, 0); } \
                        } while (0)
                        S2_DMA(0); S2_DMA(1);
#pragma unroll 1
                        for (int c = 0; c < 128; ++c) {
                            if (c + 2 < 128) { S2_DMA(c + 2); asm volatile("s_waitcnt vmcnt(32)" ::: "memory"); }
                            else if (c + 1 < 128) asm volatile("s_waitcnt vmcnt(16)" ::: "memory");
                            else asm volatile("s_waitcnt vmcnt(0)" ::: "memory");
                            LAS unsigned char* sl = ring + (c & 3) * 16384;
#pragma unroll
                            for (int mt = 0; mt < 2; ++mt)
#pragma unroll
                                for (int kt = 0; kt < 2; ++kt)
#pragma unroll
                                    for (int s2 = 0; s2 < 2; ++s2) {
                                        const int row = 32 * mt + l32, p = 4 * kt + 2 * s2;
                                        const u32x2 lo = *(const LAS u32x2*)(sl + row * 128 + ((p ^ (row & 7)) * 16) + 8 * hl);
                                        const u32x2 hi = *(const LAS u32x2*)(sl + row * 128 + (((p + 1) ^ (row & 7)) * 16) + 8 * hl);
                                        gf[mt][kt][s2] = __builtin_bit_cast(bf16x8, (u32x4){lo.x, lo.y, hi.x, hi.y});
                                    }
#pragma unroll
                            for (int i = 0; i < 16; ++i) { n0[i] = *(const LAS float*)(sl + 8192 + crow(i, hl) * 128 + l32 * 4); n1[i] = *(const LAS float*)(sl + 8192 + (32 + crow(i, hl)) * 128 + l32 * 4); }
#pragma unroll
                            for (int mt = 0; mt < 2; ++mt)
#pragma unroll
                                for (int g = 0; g < 4; ++g) dt_[mt][g] = *(const LAS f32x4*)(dtl + c * 64 + 32 * mt + 8 * g + 4 * hl);
                            S2_COMPUTE(c);
                        }
#undef S2_DMA
                    } else {
                        const int _r0 = chunk0 * 64; const size_t _item = (size_t)chunk0 * 32 + h;
#pragma unroll
                        for (int mt = 0; mt < 2; ++mt)
#pragma unroll
                            for (int kt = 0; kt < 2; ++kt)
#pragma unroll
                                for (int s2 = 0; s2 < 2; ++s2) {
                                    const size_t _o = (size_t)(_r0 + 32 * mt + l32) * DM + colb + 32 * kt + 16 * s2 + 4 * hl;
                                    const u32x2 _lo = *(const u32x2*)(Kb + _o), _hi = *(const u32x2*)(Kb + _o + 8); gf[mt][kt][s2] = __builtin_bit_cast(bf16x8, (u32x4){_lo.x, _lo.y, _hi.x, _hi.y}); }
#pragma unroll
                        for (int i = 0; i < 16; ++i) { n0[i] = DD[(size_t)(_r0 + crow(i, hl)) * DM + vcol]; n1[i] = DD[(size_t)(_r0 + 32 + crow(i, hl)) * DM + vcol]; }
#pragma unroll
                        for (int mt = 0; mt < 2; ++mt)
#pragma unroll
                            for (int g = 0; g < 4; ++g) dt_[mt][g] = *(const f32x4*)(DTg + _item * 64 + 32 * mt + 8 * g + 4 * hl);
                        S2_COMPUTE(0);
                    }
#undef S2_COMPUTE
                    float* so_ = OUTP + (prompt ? O_PWKV + ((((size_t)jl * 2 + b) * 32 + h) * 64 + (32 * vh + l32)) * 64
                                                : O_SWKV + ((((size_t)jl * 16 + b) * 32 + h) * 64 + (32 * vh + l32)) * 64);
#pragma unroll
                    for (int i = 0; i < 16; ++i) { so_[crow(i, hl)] = S0[i]; so_[32 + crow(i, hl)] = S1[i]; }
                }
            }
            fast_grid_barrier((unsigned*)ldp(tab, 40), tab);
            {
                PHASE_IDS BASES RWKV_PTRS
                const float* Obuf = (const float*)(RA + 272 * MiB); const float* RK = (const float*)(RB + 204 * MiB);
                const float* lnw = IN(28) + (size_t)jl * DM; const float* lnb = IN(29) + (size_t)jl * DM;
                const int l32 = lane & 31, hl = lane >> 5;
#pragma unroll 1
                for (int item = blockIdx.x; item < 8704; item += G) {
                    LAS unsigned char* ldsv = (LAS unsigned char*)lds; asm volatile("" : "+v"(ldsv));
                    LAS bf16_t* R2s = (LAS bf16_t*)(ldsv + 0); LAS bf16_t* STs = (LAS bf16_t*)(ldsv + 9216); LAS float* Os = (LAS float*)(ldsv + 18432);
                    const int chunk = item >> 5, h = item & 31, r0 = chunk * 64;
                    {
                        const int rr = tid >> 3, pc = tid & 7;
                        *(LAS u32x4*)(R2s + rr * 72 + pc * 8) = *(const u32x4*)(Rb + (size_t)(r0 + rr) * DM + h * 64 + pc * 8);
                        const unsigned char* sp = (const unsigned char*)DD + ((size_t)(r0 + (rr & 31)) * DM + h * 64 + 32 * (rr >> 5)) * 4 + pc * 16;
                        *(LAS u32x4*)(STs + rr * 72 + pc * 8) = *(const u32x4*)sp;
                    }
                    __syncthreads();
                    if (wave < 4) {
                        const int tt = wave >> 1, vt = wave & 1;
                        f32x16 acc;
#pragma unroll
                        for (int i = 0; i < 16; ++i) acc[i] = Obuf[(size_t)(r0 + 32 * tt + crow(i, hl)) * DM + h * 64 + 32 * vt + l32];
#pragma unroll
                        for (int ks = 0; ks < 4; ++ks) acc = __builtin_amdgcn_mfma_f32_32x32x16_bf16(*(const LAS bf16x8*)(R2s + (32 * tt + l32) * 72 + ks * 16 + hl * 8), *(const LAS bf16x8*)(STs + (32 * vt + l32) * 72 + ks * 16 + hl * 8), acc, 0, 0, 0);
#pragma unroll
                        for (int i = 0; i < 16; ++i) Os[(32 * tt + crow(i, hl)) * 68 + 32 * vt + l32] = acc[i];
                    }
                    __syncthreads();
                    {
                        const int st = tid >> 3, c0 = (tid & 7) * 8, col = h * 64 + c0; const size_t off = (size_t)(r0 + st) * DM + col;
                        const f32x4 o0 = *(const LAS f32x4*)(Os + st * 68 + c0), o1 = *(const LAS f32x4*)(Os + st * 68 + c0 + 4);
                        float o[8] = {o0[0], o0[1], o0[2], o0[3], o1[0], o1[1], o1[2], o1[3]};
                        float s = 0.f;
#pragma unroll
                        for (int i = 0; i < 8; ++i) s += o[i];
                        const float mu = sum8(s, lane) * (1.f / 64.f); float q = 0.f;
#pragma unroll
                        for (int i = 0; i < 8; ++i) { o[i] -= mu; q += o[i] * o[i]; }
                        const float rstd = rsqrtf(sum8(q, lane) * (1.f / 64.f) + 64e-5f);
                        float v[8], g8[8]; unpack8(*(const u32x4*)(Vb + off), v); unpack8(*(const u32x4*)(GG + off), g8);
                        if (jl > 0) { float vf[8], vg[8]; unpack8(*(const u32x4*)(VFIRST + off), vf); unpack8(*(const u32x4*)(VG + off), vg);
#pragma unroll
                            for (int i = 0; i < 8; ++i) v[i] = v[i] + (vf[i] - v[i]) * vg[i]; }
                        const float rk = RK[(size_t)(r0 + st) * 32 + h];
                        float y[8];
#pragma unroll
                        for (int i = 0; i < 8; ++i) y[i] = (o[i] * rstd * lnw[col + i] + lnb[col + i] + rk * v[i]) * g8[i];
                        *(u32x4*)(Y + off) = pack8(y);
                    }
                    __syncthreads();
                }
            }
            fast_grid_barrier((unsigned*)ldp(tab, 40), tab);
            {
                BASES RWKV_PTRS
                pg8::Gemm g{Y, WO, MROWS, 2048, 2048, 0, 0};
                pg8::StaticOrder S; S.init(g.M, g.N, G, (int)blockIdx.x, g.K, 4);
                pg8::Epi<FRes> E{FRes{X, (float*)(RA + 272 * MiB)}};
                pg8::gemm_phase(ldsl, g, S, E);
                fast_grid_barrier((unsigned*)ldp(tab, 40), tab);
                {
                    PHASE_IDS
                    const float* PART = (const float*)(RA + 272 * MiB); const int ntail = S.nwg - S.nFull;
                    if (S.S > 1) for (int idx = gtid; idx < ntail * 16384; idx += NT) {
                        const int tl = idx >> 14, r = (idx >> 6) & 255, c4 = idx & 63; int pm, pn; S.tile_pmpn(S.nFull + tl, pm, pn);
                        f32x4* xp = (f32x4*)(X + (size_t)(pm * 256 + r) * DM + pn * 256 + c4 * 4); f32x4 acc = *xp;
#pragma unroll
                        for (int part = 0; part < 4; ++part) acc += *(const f32x4*)(PART + (size_t)(part * 32 + tl) * 65536 + r * 256 + c4 * 4);
                        *xp = acc; }
                }
            }
            fast_grid_barrier((unsigned*)ldp(tab, 40), tab);
        } else {
            { PHASE_IDS BASES GLA_PTRS
            const float* gmix = IN(6) + (size_t)layer * DM;
            for (int row = gw; row < MROWS; row += NGW) {
                const f32x4* xr = (const f32x4*)(X + (size_t)row * DM) + lane; f32x4 x[8]; float ss = 0.f;
#pragma unroll
                for (int q = 0; q < 8; ++q) { x[q] = xr[64 * q]; ss += x[q][0] * x[q][0] + x[q][1] * x[q][1] + x[q][2] * x[q][2] + x[q][3] * x[q][3]; }
                const float rs = rsqrtf(wave_sum(ss, lane) * (1.f / DM) + 1e-6f);
#pragma unroll
                for (int q = 0; q < 8; ++q) { const f32x4 gg = *((const f32x4*)gmix + lane + 64 * q); const f32x4 h = x[q] * rs * gg;
                    u32x2 w; w.x = cvt_pk_bf16(h[0], h[1]); w.y = cvt_pk_bf16(h[2], h[3]); *((u32x2*)(H + (size_t)row * DM) + lane + 64 * q) = w; }
            } }
            fast_grid_barrier((unsigned*)ldp(tab, 40), tab);
            {
                BASES GLA_PTRS
                pg8::Gemm g{H, GI, MROWS, 6400, 2048, 0, 0};
                pg8::StaticOrder S; S.init(g.M, g.N, G, (int)blockIdx.x, g.K, 1);
                pg8::Epi<FG1> E{FG1{PROJ, LR}};
                pg8::gemm_phase(ldsl, g, S, E);
            }
            fast_grid_barrier((unsigned*)ldp(tab, 40), tab);
            {
                PHASE_IDS BASES GLA_PTRS
                float* lrS = (float*)lds;
                float* w2S = (float*)(lds + 4096);
                float* totS = (float*)(lds + 20480);
                bf16_t* qeS = (bf16_t*)(lds + 22528);
                bf16_t* keS = (bf16_t*)(lds + 22528 + 33792);
                bf16_t* vS = qeS;
                const float* gw2 = IN(31) + (size_t)jl * 16 * 1024; const float* gkb = IN(32) + (size_t)jl * 1024;
#pragma unroll 1
                for (int it = blockIdx.x; it < 1088; it += G) {
                    const int c = it >> 2, h = it & 3, r0 = c * 64; const size_t base = (size_t)it;
                    if (tid < 256) *(f32x4*)(lrS + tid * 4) = *(const f32x4*)(LR + (size_t)r0 * 16 + tid * 4);
                    for (int q = tid; q < 1024; q += 512) { const int r = q >> 6, cc = (q & 63) * 4; *(f32x4*)(w2S + r * 256 + cc) = *(const f32x4*)(gw2 + (size_t)r * 1024 + h * 256 + cc); }
                    for (int q = tid; q < 2048; q += 512) { const int t = q >> 5, cc = (q & 31) * 8; const bf16_t* src = PROJ + (size_t)(r0 + t) * 6144 + h * 256 + cc;
                        *(u32x4*)(qeS + t * 264 + cc) = *(const u32x4*)src; *(u32x4*)(keS + t * 264 + cc) = *(const u32x4*)(src + 1024); }
                    __syncthreads();
                    const int d = tid & 255, half = tid >> 8;
                    float cumv[32];
                    {
                        float w[16];
#pragma unroll
                        for (int r = 0; r < 16; ++r) w[r] = w2S[r * 256 + d];
                        const float bb = gkb[h * 256 + d]; float run = 0.f;
#pragma unroll
                        for (int tt = 0; tt < 32; ++tt) {
                            const float* lp = lrS + (half * 32 + tt) * 16; float z = bb;
#pragma unroll
                            for (int r = 0; r < 16; ++r) z += lp[r] * w[r];
                            const float g = (fminf(z, 0.f) - log1pf(__expf(-fabsf(z)))) * 0.0625f;
                            run += g; cumv[tt] = run;
                        }
                        totS[half * 256 + d] = run;
                    }
                    __syncthreads();
                    {
                        const float t0 = totS[d], t1 = totS[256 + d]; const float last = t0 + t1, offc = half ? t0 : 0.f;
                        if (half == 0) EL[base * 256 + d] = __expf(last);
                        unsigned kdp[16];
#pragma unroll
                        for (int tt = 0; tt < 32; tt += 2) {
                            float kd2[2];
#pragma unroll
                            for (int e = 0; e < 2; ++e) {
                                const int t = half * 32 + tt + e; const float cum = cumv[tt + e] + offc;
                                const float q = bf2f(qeS[t * 264 + d]), k = bf2f(keS[t * 264 + d]);
                                const float qe = q * __expf(cum), ke = k * __expf(-cum); kd2[e] = k * __expf(last - cum);
                                const unsigned pq = cvt_pk_bf16(qe, ke);
                                qeS[t * 264 + d] = (bf16_t)(pq & 0xffffu); keS[t * 264 + d] = (bf16_t)(pq >> 16);
                                QE[((base * 8 + (d >> 5)) * 64 + t) * 32 + (d & 31)] = (bf16_t)(pq & 0xffffu);
                            }
                            kdp[tt >> 1] = cvt_pk_bf16(kd2[0], kd2[1]);
                        }
                        u32x4* kdst = (u32x4*)(KDT + (base * 256 + d) * 64 + half * 32);
                        kdst[0] = (u32x4){kdp[0], kdp[1], kdp[2], kdp[3]}; kdst[1] = (u32x4){kdp[4], kdp[5], kdp[6], kdp[7]};
                        kdst[2] = (u32x4){kdp[8], kdp[9], kdp[10], kdp[11]}; kdst[3] = (u32x4){kdp[12], kdp[13], kdp[14], kdp[15]};
                    }
                    __syncthreads();
                    if (wave < 4) {
                        const int mi = wave >> 1, ni = wave & 1, l32 = lane & 31, hl = lane >> 5;
                        f32x16 cacc;
#pragma unroll
                        for (int i = 0; i < 16; ++i) cacc[i] = 0.f;
#pragma unroll
                        for (int kk = 0; kk < 16; ++kk) {
                            const bf16x8 a = *(const bf16x8*)(qeS + (mi * 32 + l32) * 264 + kk * 16 + hl * 8);
                            const bf16x8 b = *(const bf16x8*)(keS + (ni * 32 + l32) * 264 + kk * 16 + hl * 8);
                            cacc = __builtin_amdgcn_mfma_f32_32x32x16_bf16(a, b, cacc, 0, 0, 0);
                        }
#pragma unroll
                        for (int i = 0; i < 16; ++i) { const int ii = mi * 32 + crow(i, hl), jj = ni * 32 + l32;
                            const float v = (jj <= ii) ? cacc[i] : 0.f; SC[base * 4096 + ii * 64 + jj] = (bf16_t)(cvt_pk_bf16(v, 0.f) & 0xffffu); }
                    }
                    __syncthreads();
                    for (int q = tid; q < 4096; q += 512) { const int t = q >> 6, cc = (q & 63) * 8;
                        *(u32x4*)(vS + t * 520 + cc) = *(const u32x4*)(PROJ + (size_t)(r0 + t) * 6144 + 2048 + h * 512 + cc); }
                    __syncthreads();
                    {
                        const int dv = tid; u32x4* vdst = (u32x4*)(VT + (base * 512 + dv) * 64);
#pragma unroll
                        for (int q = 0; q < 8; ++q) {
                            unsigned w[4];
#pragma unroll
                            for (int e = 0; e < 4; ++e) { const unsigned lo = vS[(q * 8 + 2 * e) * 520 + dv], hi = vS[(q * 8 + 2 * e + 1) * 520 + dv]; w[e] = lo | (hi << 16); }
                            vdst[q] = (u32x4){w[0], w[1], w[2], w[3]};
                        }
                    }
                    __syncthreads();
                }
            }
            fast_grid_barrier((unsigned*)ldp(tab, 40), tab);
            {
                PHASE_IDS BASES GLA_PTRS
                float* red = (float*)lds;
                const int l32 = lane & 31, hl = lane >> 5;
#pragma unroll 1
                for (int u = blockIdx.x; u < 1152; u += G) {
                    const bool prompt = u < 128; int b, h, s, cg0, nch, row0;
                    if (prompt) { const int pair = u & 7; b = pair >> 2; h = pair & 3; s = u >> 3; cg0 = b * 128; nch = 128; row0 = b * 8192; }
                    else { const int su = u - 128; b = su >> 6; h = (su >> 4) & 3; s = su & 15; cg0 = 256 + b; nch = 1; row0 = MPROMPT + b * 64; }
                    f32x16 S;
                    if (prompt) {
#pragma unroll
                        for (int i = 0; i < 16; ++i) S[i] = 0.f;
                    } else {
                        const float* s0 = IN(4) + ((((size_t)jl * 16 + b) * 4 + h) * 256) * 512;
#pragma unroll
                        for (int i = 0; i < 16; ++i) S[i] = s0[(size_t)(32 * wave + crow(i, hl)) * 512 + 32 * s + l32];
                    }
                    const int mtw = wave & 1, ksw = wave >> 1;
                    bf16x8 ka[4], vb[4], qf[2][2], scf; f32x4 el[4];
#define GL_LD_Q(cc) do { const size_t _base = (size_t)(cg0 + (cc)) * 4 + h; const int _r0 = row0 + (cc) * 64; const bf16_t* _sc = SC + _base * 4096; \
                        _Pragma("unroll") for (int mt = 0; mt < 2; ++mt) _Pragma("unroll") for (int s2 = 0; s2 < 2; ++s2) { const bf16_t* _pq = QE + ((_base * 8 + wave) * 64 + mt * 32 + l32) * 32 + 16 * s2 + 4 * hl; \
                            const u32x2 _lo = *(const u32x2*)_pq, _hi = *(const u32x2*)(_pq + 8); qf[mt][s2] = __builtin_bit_cast(bf16x8, (u32x4){_lo.x, _lo.y, _hi.x, _hi.y}); } \
                        scf = *(const bf16x8*)(_sc + (mtw * 32 + l32) * 64 + 16 * ksw + 8 * hl); } while (0)
#define GL_LD_E(cc) do { const size_t _base = (size_t)(cg0 + (cc)) * 4 + h; \
                        _Pragma("unroll") for (int g = 0; g < 4; ++g) el[g] = *(const f32x4*)(EL + _base * 256 + 32 * wave + 8 * g + 4 * hl); } while (0)
#define GL_LD_K(cc) do { const size_t _base = (size_t)(cg0 + (cc)) * 4 + h; const bf16_t* _kdt = KDT + _base * 256 * 64; const bf16_t* _vt = VT + _base * 512 * 64; \
                        _Pragma("unroll") for (int ks = 0; ks < 4; ++ks) { ka[ks] = *(const bf16x8*)(_kdt + (32 * wave + l32) * 64 + 16 * ks + 8 * hl); vb[ks] = *(const bf16x8*)(_vt + (32 * s + l32) * 64 + 16 * ks + 8 * hl); } } while (0)
                    GL_LD_Q(0); GL_LD_E(0); GL_LD_K(0);
                    f32x4 osum = (f32x4){0.f, 0.f, 0.f, 0.f}; float* optr = nullptr;
#pragma unroll 1
                    for (int c = 0; c < nch; ++c) {
                        const int r0 = row0 + c * 64; const int cn = (c + 1 < nch) ? c + 1 : c;
                        asm volatile("" : "+v"(scf), "+v"(vb[3]));
                        if (c > 0) *(f32x4*)optr = osum;
                        u32x4 sp0, sp1;
                        sp0.x = cvt_pk_bf16(S[0], S[1]); sp0.y = cvt_pk_bf16(S[2], S[3]); sp0.z = cvt_pk_bf16(S[4], S[5]); sp0.w = cvt_pk_bf16(S[6], S[7]);
                        sp1.x = cvt_pk_bf16(S[8], S[9]); sp1.y = cvt_pk_bf16(S[10], S[11]); sp1.z = cvt_pk_bf16(S[12], S[13]); sp1.w = cvt_pk_bf16(S[14], S[15]);
                        const bf16x8 sb0 = __builtin_bit_cast(bf16x8, sp0), sb1 = __builtin_bit_cast(bf16x8, sp1);
                        const bf16x8 vbw = ksw == 0 ? vb[0] : ksw == 1 ? vb[1] : ksw == 2 ? vb[2] : vb[3];
#pragma unroll
                        for (int i = 0; i < 16; ++i) S[i] *= el[i >> 2][i & 3];
#pragma unroll
                        for (int ks = 0; ks < 4; ++ks) S = __builtin_amdgcn_mfma_f32_32x32x16_bf16(ka[ks], vb[ks], S, 0, 0, 0);
                        GL_LD_E(cn); GL_LD_K(cn);
                        f32x16 oo0, oo1;
#pragma unroll
                        for (int i = 0; i < 16; ++i) { oo0[i] = 0.f; oo1[i] = 0.f; }
                        oo0 = __builtin_amdgcn_mfma_f32_32x32x16_bf16(qf[0][0], sb0, oo0, 0, 0, 0); oo0 = __builtin_amdgcn_mfma_f32_32x32x16_bf16(qf[0][1], sb1, oo0, 0, 0, 0);
                        oo1 = __builtin_amdgcn_mfma_f32_32x32x16_bf16(qf[1][0], sb0, oo1, 0, 0, 0); oo1 = __builtin_amdgcn_mfma_f32_32x32x16_bf16(qf[1][1], sb1, oo1, 0, 0, 0);
                        if (mtw == 0) oo0 = __builtin_amdgcn_mfma_f32_32x32x16_bf16(scf, vbw, oo0, 0, 0, 0); else oo1 = __builtin_amdgcn_mfma_f32_32x32x16_bf16(scf, vbw, oo1, 0, 0, 0);
                        GL_LD_Q(cn);
#pragma unroll
                        for (int q = 0; q < 16; ++q) { red[(wave * 32 + q) * 64 + lane] = oo0[q]; red[(wave * 32 + 16 + q) * 64 + lane] = oo1[q]; }
                        asm volatile("s_waitcnt lgkmcnt(0)" ::: "memory"); __builtin_amdgcn_s_barrier(); asm volatile("" ::: "memory");
                        { const int q = tid >> 4, lg = tid & 15; f32x4 sum = (f32x4){0.f, 0.f, 0.f, 0.f};
#pragma unroll
                          for (int w = 0; w < 8; ++w) sum += *(const f32x4*)(red + (w * 32 + q) * 64 + 4 * lg);
                          const int mt = q >> 4, reg = q & 15, L = 4 * lg; const int i = mt * 32 + crow(reg, L >> 5), dv = L & 31;
                          osum = sum; optr = O + (size_t)(r0 + i) * DM + h * 512 + 32 * s + dv; }
                        asm volatile("s_waitcnt lgkmcnt(0)" ::: "memory"); __builtin_amdgcn_s_barrier(); asm volatile("" ::: "memory");
                    }
                    *(f32x4*)optr = osum;
#undef GL_LD_Q
#undef GL_LD_E
#undef GL_LD_K
                    float* dst = OUTP + (prompt ? O_PGLA + ((((size_t)jl * 2 + b) * 4 + h) * 256) * 512 : O_SGLA + ((((size_t)jl * 16 + b) * 4 + h) * 256) * 512);
#pragma unroll
                    for (int i = 0; i < 16; ++i) dst[(size_t)(32 * wave + crow(i, hl)) * 512 + 32 * s + l32] = S[i];
                }
                if (layer == 1 && G >= 256 && (int)blockIdx.x >= 128) {
                    float* scr = (float*)(lds + wave * 16896);
                    CONVERT_WEIGHTS(1, 2, 2, 4, ((int)blockIdx.x - 128) * 8 + wave, (G - 128) * 8);
                }
            }
            fast_grid_barrier((unsigned*)ldp(tab, 40), tab);
            {
                PHASE_IDS BASES GLA_PTRS
                const float* hn = IN(33) + (size_t)jl * 512;
                for (int row = gw; row < MROWS; row += NGW) {
#pragma unroll
                    for (int h = 0; h < 4; ++h) {
                        const float* op = O + (size_t)row * DM + h * 512 + lane * 8;
                        const f32x4 a = *(const f32x4*)op, b = *(const f32x4*)(op + 4);
                        float ss = a[0] * a[0] + a[1] * a[1] + a[2] * a[2] + a[3] * a[3] + b[0] * b[0] + b[1] * b[1] + b[2] * b[2] + b[3] * b[3];
                        const float rs = rsqrtf(wave_sum(ss, lane) * (1.f / 512.f) + 1e-5f);
                        float gt[8]; unpack8(*(const u32x4*)(PROJ + (size_t)row * 6144 + 4096 + h * 512 + lane * 8), gt);
                        const f32x4 n0 = *(const f32x4*)(hn + lane * 8), n1 = *(const f32x4*)(hn + lane * 8 + 4);
                        float y[8];
#pragma unroll
                        for (int i = 0; i < 4; ++i) { y[i] = a[i] * rs * n0[i] * (gt[i] * sigmoidf_(gt[i])); y[4 + i] = b[i] * rs * n1[i] * (gt[4 + i] * sigmoidf_(gt[4 + i])); }
                        *(u32x4*)(Y + (size_t)row * DM + h * 512 + lane * 8) = pack8(y);
                    }
                }
            }
            fast_grid_barrier((unsigned*)ldp(tab, 40), tab);
            {
                BASES GLA_PTRS
                pg8::Gemm g{Y, GO, MROWS, 2048, 2048, 0, 0};
                pg8::StaticOrder S; S.init(g.M, g.N, G, (int)blockIdx.x, g.K, 4);
                pg8::Epi<FRes> E{FRes{X, (float*)(RA + 272 * MiB)}};
                pg8::gemm_phase(ldsl, g, S, E);
                fast_grid_barrier((unsigned*)ldp(tab, 40), tab);
                {
                    PHASE_IDS
                    const float* PART = (const float*)(RA + 272 * MiB); const int ntail = S.nwg - S.nFull;
                    if (S.S > 1) for (int idx = gtid; idx < ntail * 16384; idx += NT) {
                        const int tl = idx >> 14, r = (idx >> 6) & 255, c4 = idx & 63; int pm, pn; S.tile_pmpn(S.nFull + tl, pm, pn);
                        f32x4* xp = (f32x4*)(X + (size_t)(pm * 256 + r) * DM + pn * 256 + c4 * 4); f32x4 acc = *xp;
#pragma unroll
                        for (int part = 0; part < 4; ++part) acc += *(const f32x4*)(PART + (size_t)(part * 32 + tl) * 65536 + r * 256 + c4 * 4);
                        *xp = acc; }
                }
            }
            fast_grid_barrier((unsigned*)ldp(tab, 40), tab);
        }
        {
            { PHASE_IDS BASES FFN_PTRS
            const float* gf = IN(7) + (size_t)layer * DM;
            for (int row = gw; row < MROWS; row += NGW) {
                const f32x4* xr = (const f32x4*)(X + (size_t)row * DM) + lane; f32x4 x[8]; float ss = 0.f;
#pragma unroll
                for (int q = 0; q < 8; ++q) { x[q] = xr[64 * q]; ss += x[q][0] * x[q][0] + x[q][1] * x[q][1] + x[q][2] * x[q][2] + x[q][3] * x[q][3]; }
                const float rs = rsqrtf(wave_sum(ss, lane) * (1.f / DM) + 1e-6f);
#pragma unroll
                for (int q = 0; q < 8; ++q) { const f32x4 gg = *((const f32x4*)gf + lane + 64 * q); const f32x4 h = x[q] * rs * gg;
                    u32x2 w; w.x = cvt_pk_bf16(h[0], h[1]); w.y = cvt_pk_bf16(h[2], h[3]); *((u32x2*)(H + (size_t)row * DM) + lane + 64 * q) = w; }
            } }
            fast_grid_barrier((unsigned*)ldp(tab, 40), tab);
            {
                BASES FFN_PTRS
                pg8::Gemm g{H, WU, MROWS, F2, 2048, 0, 0};
                pg8::StaticOrder S; S.init(g.M, g.N, G, (int)blockIdx.x, g.K, 1);
                pg8::Epi<FUp> E{FUp{U, OUTP + O_PCONV + (size_t)layer * 2 * 2 * F2, OUTP + O_SCONV + (size_t)layer * 16 * 2 * F2}};
                pg8::gemm_phase(ldsl, g, S, E);
            }
            fast_grid_barrier((unsigned*)ldp(tab, 40), tab);
            {
                PHASE_IDS BASES FFN_PTRS
                const float* cw = IN(36) + (size_t)layer * 3 * F2; const float* cb = IN(37) + (size_t)layer * F2;
                const float* cst = IN(5) + (size_t)layer * 16 * 2 * F2;
#pragma unroll 1
                for (int it = gtid; it < 544 * 704; it += NT) {
                    const int rc = it / 704, c8 = it - rc * 704, col = c8 * 8, r0 = rc * 32;
                    int t0, len, b; bool prompt; row_info(r0, t0, len, b, prompt);
                    float wv[3][8], wg[3][8], bv[8], bg[8];
#pragma unroll
                    for (int k = 0; k < 3; ++k) { const f32x4 a = *(const f32x4*)(cw + (size_t)k * F2 + col), a2 = *(const f32x4*)(cw + (size_t)k * F2 + col + 4);
                        const f32x4 g = *(const f32x4*)(cw + (size_t)k * F2 + FH + col), g2 = *(const f32x4*)(cw + (size_t)k * F2 + FH + col + 4);
#pragma unroll
                        for (int i = 0; i < 4; ++i) { wv[k][i] = a[i]; wv[k][4 + i] = a2[i]; wg[k][i] = g[i]; wg[k][4 + i] = g2[i]; } }
                    { const f32x4 a = *(const f32x4*)(cb + col), a2 = *(const f32x4*)(cb + col + 4), g = *(const f32x4*)(cb + FH + col), g2 = *(const f32x4*)(cb + FH + col + 4);
#pragma unroll
                      for (int i = 0; i < 4; ++i) { bv[i] = a[i]; bv[4 + i] = a2[i]; bg[i] = g[i]; bg[4 + i] = g2[i]; } }
                    float v2[8], v1[8], g2_[8], g1_[8];
                    if (t0 > 0) {
                        unpack8(*(const u32x4*)(U + (size_t)(r0 - 2) * F2 + col), v2); unpack8(*(const u32x4*)(U + (size_t)(r0 - 1) * F2 + col), v1);
                        unpack8(*(const u32x4*)(U + (size_t)(r0 - 2) * F2 + FH + col), g2_); unpack8(*(const u32x4*)(U + (size_t)(r0 - 1) * F2 + FH + col), g1_);
                    } else if (!prompt) {
                        const float* s0 = cst + ((size_t)b * 2) * F2 + col; const float* s1 = s0 + F2;
#pragma unroll
                        for (int i = 0; i < 8; ++i) { v2[i] = s0[i]; v1[i] = s1[i]; g2_[i] = s0[FH + i]; g1_[i] = s1[FH + i]; }
                    } else {
#pragma unroll
                        for (int i = 0; i < 8; ++i) { v2[i] = 0.f; v1[i] = 0.f; g2_[i] = 0.f; g1_[i] = 0.f; }
                    }
#pragma unroll 1
                    for (int rb = 0; rb < 32; rb += 8) {
                      u32x4 uv_[8], ug_[8];
#pragma unroll
                      for (int j = 0; j < 8; ++j) { uv_[j] = *(const u32x4*)(U + (size_t)(r0 + rb + j) * F2 + col); ug_[j] = *(const u32x4*)(U + (size_t)(r0 + rb + j) * F2 + FH + col); }
#pragma unroll
                      for (int j = 0; j < 8; ++j) {
                        const int r = rb + j;
                        float v0[8], g0[8];
                        unpack8(uv_[j], v0); unpack8(ug_[j], g0);
                        float y[8];
#pragma unroll
                        for (int i = 0; i < 8; ++i) {
                            const float cv = bv[i] + wv[0][i] * v2[i] + wv[1][i] * v1[i] + wv[2][i] * v0[i];
                            const float cg_ = bg[i] + wg[0][i] * g2_[i] + wg[1][i] * g1_[i] + wg[2][i] * g0[i];
                            y[i] = cg_ * sigmoidf_(cg_) * cv;
                            v2[i] = v1[i]; v1[i] = v0[i]; g2_[i] = g1_[i]; g1_[i] = g0[i];
                        }
                        *(u32x4*)(HID + (size_t)(r0 + r) * FH + col) = pack8(y);
                      }
                    }
                }
            }
            fast_grid_barrier((unsigned*)ldp(tab, 40), tab);
            {
                BASES FFN_PTRS
                pg8::Gemm g{HID, WD, MROWS, 2048, FH, 0, 0};
                pg8::StaticOrder S; S.init(g.M, g.N, G, (int)blockIdx.x, g.K, 4);
                pg8::Epi<FRes> E{FRes{X, (float*)(RA + 272 * MiB)}};
                pg8::gemm_phase(ldsl, g, S, E);
                fast_grid_barrier((unsigned*)ldp(tab, 40), tab);
                {
                    PHASE_IDS
                    const float* PART = (const float*)(RA + 272 * MiB); const int ntail = S.nwg - S.nFull;
                    if (S.S > 1) for (int idx = gtid; idx < ntail * 16384; idx += NT) {
                        const int tl = idx >> 14, r = (idx >> 6) & 255, c4 = idx & 63; int pm, pn; S.tile_pmpn(S.nFull + tl, pm, pn);
                        f32x4* xp = (f32x4*)(X + (size_t)(pm * 256 + r) * DM + pn * 256 + c4 * 4); f32x4 acc = *xp;
#pragma unroll
                        for (int part = 0; part < 4; ++part) acc += *(const f32x4*)(PART + (size_t)(part * 32 + tl) * 65536 + r * 256 + c4 * 4);
                        *xp = acc; }
                }
            }
            fast_grid_barrier((unsigned*)ldp(tab, 40), tab);
        }
    }
    {
        PHASE_IDS BASES
        const float* gn = IN(8);
        for (int row = gw; row < MROWS; row += NGW) {
            f32x4* xr = (f32x4*)(X + (size_t)row * DM) + lane; f32x4 x[8]; float ss = 0.f;
#pragma unroll
            for (int q = 0; q < 8; ++q) { x[q] = xr[64 * q]; ss += x[q][0] * x[q][0] + x[q][1] * x[q][1] + x[q][2] * x[q][2] + x[q][3] * x[q][3]; }
            const float rs = rsqrtf(wave_sum(ss, lane) * (1.f / DM) + 1e-6f);
#pragma unroll
            for (int q = 0; q < 8; ++q) { const f32x4 gg = *((const f32x4*)gn + lane + 64 * q); xr[64 * q] = x[q] * rs * gg; }
        }
    }
}

#undef TR
#undef CONVERT_WEIGHTS
extern "C" void kernel_launch(void* const* d_in, const int* in_sizes, int n_in, void* d_out, int out_size, void* d_ws, size_t ws_size, hipStream_t stream) {
    static int grid = 0;
    if (grid == 0) {
        if (n_in != 39 || (size_t)out_size != O_TOTAL || ws_size < WS_END) {
            fprintf(stderr, "kernel_launch: unexpected shapes: n_in %d out %d ws %zu (need %zu)\n", n_in, out_size, ws_size, (size_t)WS_END); grid = -1; return; }
        int dev = 0, cus = 0, per_cu = 0;
        (void)hipGetDevice(&dev);
        (void)hipDeviceGetAttribute(&cus, hipDeviceAttributeMultiprocessorCount, dev);
        if (hipFuncSetAttribute((const void*)fwd_kernel, hipFuncAttributeMaxDynamicSharedMemorySize, LDS_BYTES) != hipSuccess) { fprintf(stderr, "kernel_launch: hipFuncSetAttribute failed\n"); grid = -1; return; }
        if (hipOccupancyMaxActiveBlocksPerMultiprocessor(&per_cu, (const void*)fwd_kernel, 512, LDS_BYTES) != hipSuccess || per_cu < 1) { fprintf(stderr, "kernel_launch: occupancy query says %d\n", per_cu); per_cu = 1; }
        (void)hipGetLastError();
        grid = cus * 1;
        if (grid <= 0) grid = 256;
    }
    if (grid < 0) return;
    P prm{};
    for (int i = 0; i < 39; ++i) prm.in[i] = (const float*)d_in[i];
    prm.out = (float*)d_out; prm.ws = (unsigned char*)d_ws;
    (void)hipMemsetAsync(d_ws, 0, 4096, stream);
    void* args[] = {&prm};
    hipError_t e = hipLaunchCooperativeKernel((const void*)fwd_kernel, dim3(grid), dim3(512), args, LDS_BYTES, stream);
    if (e != hipSuccess) fprintf(stderr, "cooperative launch failed: %s (grid %d)\n", hipGetErrorString(e), grid);
}
```

```cpp
#include <hip/hip_runtime.h>
#include <hip/hip_cooperative_groups.h>
#include <cstdio>
#include <cstdint>
namespace cg = cooperative_groups;

#define LAS __attribute__((address_space(3)))
typedef unsigned short bf16_t;
typedef short bf16x8 __attribute__((ext_vector_type(8)));
typedef float f32x4 __attribute__((ext_vector_type(4)));
typedef float f32x16 __attribute__((ext_vector_type(16)));
typedef unsigned u32x4 __attribute__((ext_vector_type(4)));
typedef unsigned u32x2 __attribute__((ext_vector_type(2)));

constexpr int DM = 2048, MROWS = 17408, MPROMPT = 16384;
constexpr int FH = 5632, F2 = 11264;
constexpr int LDS_BYTES = 147456;
constexpr size_t MiB = 1u << 20;
constexpr size_t WS_WT = 1 * MiB;
constexpr size_t WS_A = 411 * MiB;
constexpr size_t WS_B = 819 * MiB;
constexpr size_t WS_VF = 1227 * MiB;
constexpr size_t WS_END = 1295 * MiB;
constexpr size_t ACT = (size_t)MROWS * DM;
constexpr size_t RW_SZ = (size_t)7168 * 2048 + (size_t)8192 * 256 + (size_t)2048 * 2048;
constexpr size_t GW_SZ = (size_t)6400 * 2048 + (size_t)2048 * 2048;
constexpr size_t FW_SZ = (size_t)11264 * 2048 + (size_t)2048 * 5632;
constexpr size_t GW_OFF = 2 * RW_SZ, FW_OFF = GW_OFF + 2 * GW_SZ;
constexpr size_t O_PSHIFT = 35651584, O_PWKV = 35659776, O_PGLA = 36184064, O_PCONV = 38281216;
constexpr size_t O_SSHIFT = 38461440, O_SWKV = 38526976, O_SGLA = 42721280, O_SCONV = 59498496, O_TOTAL = 60940288;

__device__ __forceinline__ unsigned cvt_pk_bf16(float lo, float hi) { unsigned r; asm volatile("v_cvt_pk_bf16_f32 %0, %1, %2" : "=v"(r) : "v"(lo), "v"(hi)); return r; }
__device__ __forceinline__ float bf2f(bf16_t b) { return __builtin_bit_cast(float, (unsigned)b << 16); }
__device__ __forceinline__ float bflo(unsigned u) { return __builtin_bit_cast(float, u << 16); }
__device__ __forceinline__ float bfhi(unsigned u) { return __builtin_bit_cast(float, u & 0xffff0000u); }
__device__ __forceinline__ void unpack8(u32x4 w, float (&f)[8]) {
    f[0] = bflo(w.x); f[1] = bfhi(w.x); f[2] = bflo(w.y); f[3] = bfhi(w.y); f[4] = bflo(w.z); f[5] = bfhi(w.z); f[6] = bflo(w.w); f[7] = bfhi(w.w);
}
__device__ __forceinline__ u32x4 pack8(const float (&f)[8]) {
    u32x4 w; w.x = cvt_pk_bf16(f[0], f[1]); w.y = cvt_pk_bf16(f[2], f[3]); w.z = cvt_pk_bf16(f[4], f[5]); w.w = cvt_pk_bf16(f[6], f[7]); return w;
}
__device__ __forceinline__ float sigmoidf_(float x) { return 1.f / (1.f + __expf(-x)); }
__device__ __forceinline__ float shx(float v, int lane, int o) { return __builtin_bit_cast(float, __builtin_amdgcn_ds_bpermute((lane ^ o) << 2, __builtin_bit_cast(int, v))); }
__device__ __forceinline__ float wave_sum(float v, int lane) {
#pragma unroll
    for (int o = 1; o < 64; o <<= 1) v += shx(v, lane, o);
    return v;
}
__device__ __forceinline__ float sum8(float v, int lane) { v += shx(v, lane, 1); v += shx(v, lane, 2); v += shx(v, lane, 4); return v; }
__device__ __forceinline__ int crow(int reg, int h) { return (reg & 3) + 8 * (reg >> 2) + 4 * h; }

namespace pg8 {
constexpr int BM = 256, BK = 64, HALF = 128, HTB = HALF * BK * 2, STAGE_BYTES = 8 * HTB, NXCD = 8, WGM = 8;
__host__ __device__ __forceinline__ int lds_byte(int r, int c) { const int st = (r >> 4) * 2 + (c >> 5), rr = r & 15, cc = c & 31, ob = rr * 64 + cc * 2; return st * 1024 + (ob ^ (((ob >> 9) & 1) << 5)); }
__host__ __device__ __forceinline__ void stage_rc(int b, int& R, int& C) { const int st = b / 1024, sb = b % 1024, swz = sb ^ (((sb >> 9) & 1) << 5); R = (st >> 1) * 16 + swz / 64; C = (st & 1) * 32 + (swz % 64) / 2; }
__host__ __device__ __forceinline__ int perm32(int rho) { const int n = rho >> 4, i = rho & 15; return 8 * (i >> 2) + 4 * n + (i & 3); }

struct Unit { int pm, pn, kofs, knt, split; };
struct Gemm { const bf16_t* A; const bf16_t* Bt; int M, N, K; int mode; size_t astride; };
__device__ __forceinline__ const char* a_of(const Gemm& g, int pn) {
    int s = 0;
    if (g.mode == 1) s = pn < 8 ? 0 : pn < 16 ? 2 : pn < 24 ? 3 : pn == 24 ? 1 : pn == 25 ? 4 : pn == 26 ? 5 : 3;
    else if (g.mode == 2) s = pn >> 3;
    return (const char*)g.A + (size_t)s * g.astride;
}
struct StaticOrder {
    int nM, nN, nwg, G, c, nFull, S, ntK, total;
    __device__ __forceinline__ void init(int M, int N, int G_, int c_, int K = 0, int S_ = 1) { nM = M / BM; nN = N / BM; nwg = nM * nN; G = G_; c = c_; ntK = K / BK;
        nFull = (nwg / G) * G; S = S_; if (S_ <= 1 || nFull == nwg) { S = 1; nFull = nwg; } total = nFull + (nwg - nFull) * S; }
    __device__ __forceinline__ bool next(int i, Unit& u) const {
        const long L = (long)i * G + c; if (L >= total) return false;
        int wgid;
        if (L < nFull) { wgid = (int)L; u.kofs = 0; u.knt = ntK; u.split = 0; }
        else { const int j = (int)L - nFull; wgid = nFull + j / S; const int part = j % S; u.knt = ntK / S; u.kofs = part * u.knt * BK; u.split = 1 + part * 32 + j / S; }
        tile_pmpn(wgid, u.pm, u.pn); return true;
    }
    __device__ __forceinline__ void tile_pmpn(int wgid, int& pm, int& pn) const {
        { const int q = nwg / NXCD, r = nwg % NXCD, xcd = wgid % NXCD, off = wgid / NXCD; wgid = (xcd < r ? xcd * (q + 1) : r * (q + 1) + (xcd - r) * q) + off; }
        const int nig = WGM * nN, gid = wgid / nig, fm = gid * WGM, gsz = (nM - fm) < WGM ? (nM - fm) : WGM;
        pm = fm + ((wgid % nig) % gsz); pn = (wgid % nig) / gsz;
    }
};

template <class F> struct Epi {
    static constexpr bool PERM = true;
    F f;
    __device__ __forceinline__ void operator()(const f32x4 (&acc)[2][2][4][2], const Unit& u, int wr, int wc, int fr, int fq) const {
        { int t_ = threadIdx.x; asm volatile("" : "+v"(t_)); const int l_ = t_ & 63, w_ = __builtin_amdgcn_readfirstlane(t_ >> 6); fr = l_ & 15; fq = l_ >> 4; wr = w_ >> 2; wc = w_ & 3; }
        const int row0 = u.pm * BM + wr * 64 + fr, col0 = u.pn * BM + wc * 32 + 8 * fq;
#pragma unroll
        for (int ai = 0; ai < 2; ++ai)
#pragma unroll
            for (int m = 0; m < 4; ++m)
#pragma unroll
                for (int bj = 0; bj < 2; ++bj) f(row0 + ai * HALF + m * 16, col0 + bj * HALF, acc[ai][bj][m][0], acc[ai][bj][m][1], u.split);
    }
};

template <class EpiT>
__device__ __forceinline__ void gemm_phase(LAS unsigned char* lds, const Gemm g, const StaticOrder& S, const EpiT& E) {
    int tid = threadIdx.x; asm volatile("" : "+v"(tid));
    const int wid = __builtin_amdgcn_readfirstlane(tid >> 6), lane = tid & 63, wr = wid >> 2, wc = wid & 3, fr = lane & 15, fq = lane >> 4;
    const int K = g.K;
    unsigned voffA[2], voffB[2];
#pragma unroll
    for (int i = 0; i < 2; ++i) { int R, C; stage_rc(tid * 16 + i * 8192, R, C); const int Rb = EpiT::PERM ? ((R & ~31) + perm32(R & 31)) : R;
        voffA[i] = (unsigned)(R * K + C) * 2u; voffB[i] = (unsigned)(Rb * K + C) * 2u; }
    const size_t kstep = (size_t)(BK * 2);
    const size_t hstep = (size_t)HALF * K * 2;
    const size_t tstep = 2 * hstep;
    const unsigned ldsw = (unsigned)wid * 1024u;
    const int aoff = lds_byte(wr * 64 + fr, fq * 8), boff = lds_byte(wc * 32 + fr, fq * 8);
#define PG8_SA(b, h) (((b) * 2 + (h)) * HTB)
#define PG8_SB(b, h) ((4 + (b) * 2 + (h)) * HTB)
#define PG8_STAGE(bufoff, gbase, voff) do { _Pragma("unroll") for (int _i = 0; _i < 2; ++_i) \
        __builtin_amdgcn_global_load_lds((const unsigned*)((const char*)(gbase) + (voff)[_i]), (LAS unsigned*)(lds + (bufoff) + ldsw + _i * 8192), 16, 0, 0); } while (0)
#define PG8_LDA(dst, b, h) do { _Pragma("unroll") for (int m = 0; m < 4; ++m) _Pragma("unroll") for (int k = 0; k < 2; ++k) dst[m][k] = *(const LAS bf16x8*)(lds + PG8_SA(b, h) + aoff + m * 2048 + k * 1024); } while (0)
#define PG8_LDB(dst, b, h) do { _Pragma("unroll") for (int n = 0; n < 2; ++n) _Pragma("unroll") for (int k = 0; k < 2; ++k) dst[n][k] = *(const LAS bf16x8*)(lds + PG8_SB(b, h) + boff + n * 2048 + k * 1024); } while (0)
#define PG8_MMA(ai, bj, At, Bt) do { __builtin_amdgcn_s_setprio(1); _Pragma("unroll") for (int m = 0; m < 4; ++m) _Pragma("unroll") for (int n = 0; n < 2; ++n) _Pragma("unroll") for (int k = 0; k < 2; ++k) \
        acc[ai][bj][m][n] = __builtin_amdgcn_mfma_f32_16x16x32_bf16(Bt[n][k], At[m][k], acc[ai][bj][m][n], 0, 0, 0); __builtin_amdgcn_s_setprio(0); } while (0)
#define PG8_WAIT_V(n) asm volatile("s_waitcnt vmcnt(" #n ")" ::: "memory")
#define PG8_WAIT_L(n) asm volatile("s_waitcnt lgkmcnt(" #n ")" ::: "memory")
#define PG8_BAR __builtin_amdgcn_s_barrier()
#define PG8_SCHED __builtin_amdgcn_sched_barrier(0)
    Unit cur, nxt; int ui = 0;
    if (!S.next(0, cur)) return;
    f32x4 acc[2][2][4][2];
#pragma unroll
    for (int a = 0; a < 2; ++a)
#pragma unroll
        for (int b = 0; b < 2; ++b)
#pragma unroll
            for (int m = 0; m < 4; ++m)
#pragma unroll
                for (int n = 0; n < 2; ++n) acc[a][b][m][n] = (f32x4){0.f, 0.f, 0.f, 0.f};
    bf16x8 At[4][2], B0[2][2], B1[2][2];
    const char* cA = a_of(g, cur.pn) + (size_t)cur.pm * tstep + (size_t)cur.kofs * 2; const char* cB = (const char*)g.Bt + (size_t)cur.pn * tstep + (size_t)cur.kofs * 2;
    PG8_STAGE(PG8_SB(0, 0), cB, voffB); PG8_STAGE(PG8_SB(0, 1), cB + hstep, voffB); PG8_STAGE(PG8_SA(0, 0), cA, voffA); PG8_STAGE(PG8_SA(0, 1), cA + hstep, voffA);
    if (wr == 1) PG8_BAR;
    PG8_WAIT_V(2); PG8_BAR;
    PG8_STAGE(PG8_SB(1, 0), cB + kstep, voffB); PG8_STAGE(PG8_SA(1, 0), cA + kstep, voffA); PG8_STAGE(PG8_SB(1, 1), cB + hstep + kstep, voffB);
    PG8_WAIT_V(6); PG8_BAR;
    for (;;) {
        const bool has_next = S.next(ui + 1, nxt);
        const char* nA = has_next ? a_of(g, nxt.pn) + (size_t)nxt.pm * tstep + (size_t)nxt.kofs * 2 : cA; const char* nB = has_next ? (const char*)g.Bt + (size_t)nxt.pn * tstep + (size_t)nxt.kofs * 2 : cB;
        const int nt = cur.knt;
        for (int t = 0; t < nt; t += 2) {
            const bool last = (t == nt - 2);
            const char* a1 = cA + (size_t)(t + 1) * kstep;
            const char* a2 = last ? nA : cA + (size_t)(t + 2) * kstep; const char* b2 = last ? nB : cB + (size_t)(t + 2) * kstep;
            const char* a3 = a2 + kstep; const char* b3 = b2 + kstep;
            PG8_LDB(B0, 0, 0); PG8_LDB(B1, 0, 1); PG8_SCHED; PG8_LDA(At, 0, 0); PG8_STAGE(PG8_SA(1, 1), a1 + hstep, voffA);
            PG8_WAIT_V(8); PG8_WAIT_L(0); PG8_BAR; PG8_MMA(0, 0, At, B0); PG8_MMA(0, 1, At, B1); PG8_BAR; PG8_SCHED;
            PG8_LDA(At, 0, 1); PG8_STAGE(PG8_SB(0, 0), b2, voffB); PG8_STAGE(PG8_SB(0, 1), b2 + hstep, voffB); PG8_STAGE(PG8_SA(0, 0), a2, voffA);
            PG8_WAIT_V(8); PG8_WAIT_L(0); PG8_BAR; PG8_MMA(1, 0, At, B0); PG8_MMA(1, 1, At, B1); PG8_BAR; PG8_SCHED;
            PG8_LDB(B0, 1, 0); PG8_LDB(B1, 1, 1); PG8_SCHED; PG8_LDA(At, 1, 0); PG8_STAGE(PG8_SA(0, 1), a2 + hstep, voffA);
            PG8_WAIT_V(8); PG8_WAIT_L(0); PG8_BAR; PG8_MMA(0, 0, At, B0); PG8_MMA(0, 1, At, B1); PG8_BAR; PG8_SCHED;
            PG8_LDA(At, 1, 1); PG8_STAGE(PG8_SB(1, 0), b3, voffB); PG8_STAGE(PG8_SB(1, 1), b3 + hstep, voffB); PG8_STAGE(PG8_SA(1, 0), a3, voffA);
            PG8_WAIT_V(8); PG8_WAIT_L(0); PG8_BAR; PG8_MMA(1, 0, At, B0); PG8_MMA(1, 1, At, B1); PG8_BAR; PG8_SCHED;
        }
        if (wr == 0) PG8_BAR;
        E(acc, cur, wr, wc, fr, fq);
        if (!has_next) break;
#pragma unroll
        for (int a = 0; a < 2; ++a)
#pragma unroll
            for (int b = 0; b < 2; ++b)
#pragma unroll
                for (int m = 0; m < 4; ++m)
#pragma unroll
                    for (int n = 0; n < 2; ++n) acc[a][b][m][n] = (f32x4){0.f, 0.f, 0.f, 0.f};
        cur = nxt; cA = nA; cB = nB; ++ui;
        if (wr == 1) PG8_BAR;
    }
    PG8_WAIT_V(0);
    PG8_BAR;
#undef PG8_SA
#undef PG8_SB
#undef PG8_STAGE
#undef PG8_LDA
#undef PG8_LDB
#undef PG8_MMA
#undef PG8_WAIT_V
#undef PG8_WAIT_L
#undef PG8_BAR
#undef PG8_SCHED
}
}

__device__ __forceinline__ void store8bf(bf16_t* p, f32x4 a, f32x4 b) {
    u32x4 w; w.x = cvt_pk_bf16(a[0], a[1]); w.y = cvt_pk_bf16(a[2], a[3]); w.z = cvt_pk_bf16(b[0], b[1]); w.w = cvt_pk_bf16(b[2], b[3]);
    *(u32x4*)p = w;
}
struct FRes { float* X; float* PART;
    __device__ __forceinline__ void operator()(int row, int col, f32x4 a, f32x4 b, int split) const {
        float* p = X + (size_t)row * DM + col;
        if (split) { float* q = PART + (size_t)(split - 1) * 65536 + (row & 255) * 256 + (col & 255); *(f32x4*)q = a; *(f32x4*)(q + 4) = b; }
        else { f32x4 x0 = *(f32x4*)p, x1 = *(f32x4*)(p + 4); *(f32x4*)p = x0 + a; *(f32x4*)(p + 4) = x1 + b; } } };
struct FR1 { bf16_t *R, *K, *V, *L;
    __device__ __forceinline__ void operator()(int row, int col, f32x4 a, f32x4 b, int) const {
        if (col < 6144) { const int g = col >> 11; const size_t o = (size_t)row * DM + (col & 2047); if (g == 0) store8bf(R + o, a, b); else if (g == 1) store8bf(K + o, a, b); else store8bf(V + o, a, b); }
        else { const int t = (col - 6144) >> 8, c = col & 255;
            if (t == 0) { for (int i = 0; i < 4; ++i) { a[i] = 1.f - 2.f / (1.f + __expf(2.f * a[i])); b[i] = 1.f - 2.f / (1.f + __expf(2.f * b[i])); } }
            else if (t == 2) { for (int i = 0; i < 4; ++i) { a[i] = sigmoidf_(a[i]); b[i] = sigmoidf_(b[i]); } }
            store8bf(L + (size_t)t * MROWS * 256 + (size_t)row * 256 + c, a, b); } } };
__device__ __forceinline__ float decay_of(float z) { return -0.60653065971f / (1.f + __expf(-z)); }
struct FR2 { float* DD; bf16_t *AA, *GG, *VG; const float *w0, *a0, *v0;
    __device__ __forceinline__ void operator()(int row, int col, f32x4 a, f32x4 b, int) const {
        const int g = col >> 11, c = col & 2047; const size_t off = (size_t)row * DM + c;
        if (g == 0) { f32x4 z0 = *(const f32x4*)(w0 + c), z1 = *(const f32x4*)(w0 + c + 4); a += z0; b += z1;
            for (int i = 0; i < 4; ++i) { a[i] = decay_of(a[i]); b[i] = decay_of(b[i]); }
            *(f32x4*)(DD + off) = a; *(f32x4*)(DD + off + 4) = b; }
        else if (g == 1) { f32x4 z0 = *(const f32x4*)(a0 + c), z1 = *(const f32x4*)(a0 + c + 4); a += z0; b += z1;
            for (int i = 0; i < 4; ++i) { a[i] = sigmoidf_(a[i]); b[i] = sigmoidf_(b[i]); } store8bf(AA + off, a, b); }
        else if (g == 2) { store8bf(GG + off, a, b); }
        else { f32x4 z0 = *(const f32x4*)(v0 + c), z1 = *(const f32x4*)(v0 + c + 4); a += z0; b += z1;
            for (int i = 0; i < 4; ++i) { a[i] = sigmoidf_(a[i]); b[i] = sigmoidf_(b[i]); } store8bf(VG + off, a, b); } } };
struct FG1 { bf16_t* PROJ; float* LR;
    __device__ __forceinline__ void operator()(int row, int col, f32x4 a, f32x4 b, int) const {
        if (col < 6144) { if (col < 1024) { a *= 0.0625f; b *= 0.0625f; } store8bf(PROJ + (size_t)row * 6144 + col, a, b); }
        else if (col < 6160) { float* p = LR + (size_t)row * 16 + (col - 6144); *(f32x4*)p = a; *(f32x4*)(p + 4) = b; } } };
struct FUp { bf16_t* U; float* pconv; float* sconv;
    __device__ __forceinline__ void operator()(int row, int col, f32x4 a, f32x4 b, int) const {
        store8bf(U + (size_t)row * F2 + col, a, b);
        if (row < MPROMPT) { const int t = row & 8191; if (t >= 8190) { float* p = pconv + ((size_t)((row >> 13) * 2 + (t - 8190))) * F2 + col; *(f32x4*)p = a; *(f32x4*)(p + 4) = b; } }
        else { const int rr = row - MPROMPT, t = rr & 63; if (t >= 62) { float* p = sconv + ((size_t)((rr >> 6) * 2 + (t - 62))) * F2 + col; *(f32x4*)p = a; *(f32x4*)(p + 4) = b; } } } };

__device__ __forceinline__ void tr_item(const float* W, int K, int N, bf16_t* WT, int Kpad, int Npad, float* scr, int item, int lane) {
    const int nblk = Npad / 64, kb = item / nblk, nb = item % nblk, k0 = 64 * kb, n0 = 64 * nb;
    const int n4 = n0 + (lane & 15) * 4;
    f32x4 v[16];
#pragma unroll
    for (int i = 0; i < 16; ++i) { const int k = k0 + 4 * i + (lane >> 4); v[i] = (k < K && n4 < N) ? *(const f32x4*)(W + (size_t)k * N + n4) : (f32x4){0.f, 0.f, 0.f, 0.f}; }
#pragma unroll
    for (int i = 0; i < 16; ++i) { float* d = scr + (4 * i + (lane >> 4)) * 65 + (lane & 15) * 4; d[0] = v[i][0]; d[1] = v[i][1]; d[2] = v[i][2]; d[3] = v[i][3]; }
    asm volatile("s_waitcnt lgkmcnt(0)" ::: "memory");
    const int c = lane & 7;
#pragma unroll
    for (int j = 0; j < 8; ++j) { const int nn = (lane >> 3) + 8 * j; const float* s = scr + (8 * c) * 65 + nn;
        u32x4 o; o.x = cvt_pk_bf16(s[0 * 65], s[1 * 65]); o.y = cvt_pk_bf16(s[2 * 65], s[3 * 65]); o.z = cvt_pk_bf16(s[4 * 65], s[5 * 65]); o.w = cvt_pk_bf16(s[6 * 65], s[7 * 65]);
        *(u32x4*)(WT + (size_t)(n0 + nn) * Kpad + k0 + 8 * c) = o; }
    asm volatile("s_waitcnt lgkmcnt(0)" ::: "memory");
}

struct P { const float* in[39]; float* out; unsigned char* ws; };

__device__ __forceinline__ void row_info(int row, int& t, int& len, int& b, bool& prompt) {
    if (row < MPROMPT) { prompt = true; b = row >> 13; t = row & 8191; len = 8192; }
    else { prompt = false; const int rr = row - MPROMPT; b = rr >> 6; t = rr & 63; len = 64; }
}

__device__ __forceinline__ const float* ldp(const unsigned long long* tab, int i) {
    const unsigned long long v = tab[i];
    const unsigned lo = __builtin_amdgcn_readfirstlane((unsigned)v), hi = __builtin_amdgcn_readfirstlane((unsigned)(v >> 32));
    const __attribute__((address_space(1))) float* g = (const __attribute__((address_space(1))) float*)(((unsigned long long)hi << 32) | lo);
    return (const float*)g;
}
__device__ __forceinline__ void fast_grid_barrier(unsigned* bar, unsigned long long* tab) {
    asm volatile("s_waitcnt vmcnt(0)" ::: "memory");
    __syncthreads();
    if (threadIdx.x == 0) {
        const unsigned G = gridDim.x, grp = blockIdx.x & 7u;
        const unsigned epoch = (unsigned)tab[41] + 1u; tab[41] = epoch;
        const unsigned ngrp = (G - grp + 7u) >> 3, ntop = G < 8u ? G : 8u;
        __builtin_amdgcn_fence(__ATOMIC_RELEASE, "agent");
        asm volatile("s_waitcnt vmcnt(0)" ::: "memory");
        const unsigned old = __hip_atomic_fetch_add(&bar[64u * (1u + grp)], 1u, __ATOMIC_RELAXED, __HIP_MEMORY_SCOPE_AGENT);
        if (old + 1u == epoch * ngrp) (void)__hip_atomic_fetch_add(&bar[0], 1u, __ATOMIC_RELAXED, __HIP_MEMORY_SCOPE_AGENT);
        while (__hip_atomic_load(&bar[0], __ATOMIC_RELAXED, __HIP_MEMORY_SCOPE_AGENT) < epoch * ntop) __builtin_amdgcn_s_sleep(1);
        __builtin_amdgcn_fence(__ATOMIC_ACQUIRE, "agent");
        asm volatile("s_waitcnt vmcnt(0)" ::: "memory");
    }
    __syncthreads();
}
#define IN(k) ldp(tab, (k))
#define OUTP ((float*)ldp(tab, 39))
#define BASES float* X = (float*)ldp(tab, 39); unsigned char* ws_ = (unsigned char*)ldp(tab, 40); bf16_t* WT = (bf16_t*)(ws_ + WS_WT); unsigned char* RA = ws_ + WS_A; unsigned char* RB = ws_ + WS_B; \
    bf16_t* VFIRST = (bf16_t*)(ws_ + WS_VF); LAS unsigned char* ldsl = (LAS unsigned char*)lds; (void)X; (void)WT; (void)RA; (void)RB; (void)VFIRST; (void)ldsl;
#define RWKV_PTRS bf16_t* HB = (bf16_t*)RA; bf16_t* Rb = (bf16_t*)RB; bf16_t* Kb = Rb + ACT; bf16_t* Vb = (jl == 0) ? VFIRST : Kb + ACT; bf16_t* Lb = (bf16_t*)(RB + 204 * MiB); \
    float* DD = (float*)(RB + 240 * MiB); bf16_t* AA = (bf16_t*)RA; bf16_t* VG = AA + ACT; bf16_t* GG = VG + ACT; bf16_t* Y = GG + ACT; \
    bf16_t* W1 = WT + jl * RW_SZ; bf16_t* W2 = W1 + (size_t)7168 * 2048; bf16_t* WO = W2 + (size_t)8192 * 256; \
    (void)HB; (void)Rb; (void)Kb; (void)Vb; (void)Lb; (void)DD; (void)AA; (void)VG; (void)GG; (void)Y; (void)W1; (void)W2; (void)WO;
#define GLA_PTRS bf16_t* H = (bf16_t*)RB; float* LR = (float*)(RB + 68 * MiB); float* O = (float*)(RB + 70 * MiB); bf16_t* Y = (bf16_t*)(RB + 206 * MiB); \
    bf16_t* PROJ = (bf16_t*)RA; bf16_t* QE = (bf16_t*)(RA + 204 * MiB); bf16_t* KDT = (bf16_t*)(RA + 238 * MiB); bf16_t* VT = (bf16_t*)(RA + 272 * MiB); \
    bf16_t* SC = (bf16_t*)(RA + 340 * MiB); float* EL = (float*)(RA + 349 * MiB); bf16_t* GI = WT + GW_OFF + jl * GW_SZ; bf16_t* GO = GI + (size_t)6400 * 2048; \
    (void)H; (void)LR; (void)O; (void)Y; (void)PROJ; (void)QE; (void)KDT; (void)VT; (void)SC; (void)EL; (void)GI; (void)GO;
#define FFN_PTRS bf16_t* H = (bf16_t*)RB; bf16_t* HID = (bf16_t*)(RB + 68 * MiB); bf16_t* U = (bf16_t*)RA; bf16_t* WU = WT + FW_OFF + layer * FW_SZ; bf16_t* WD = WU + (size_t)F2 * 2048; \
    (void)H; (void)HID; (void)U; (void)WU; (void)WD;

__global__ void __launch_bounds__(512, 2) fwd_kernel(P p) {
    extern __shared__ __attribute__((aligned(16))) unsigned char lds[];
    cg::grid_group grid = cg::this_grid();
    const int G = gridDim.x, NGW = G * 8, NT = G * 512;
#define PHASE_IDS int tid = threadIdx.x; asm volatile("" : "+v"(tid)); const int lane = tid & 63; const int wave = __builtin_amdgcn_readfirstlane(tid >> 6); const int gw = blockIdx.x * 8 + wave; const int gtid = blockIdx.x * 512 + tid; (void)lane; (void)gw; (void)gtid;
    unsigned long long* tab = (unsigned long long*)(lds + LDS_BYTES - 512);
    if (threadIdx.x == 0) {
#pragma unroll
        for (int i = 0; i < 39; ++i) tab[i] = (unsigned long long)p.in[i];
        tab[39] = (unsigned long long)p.out; tab[40] = (unsigned long long)p.ws; tab[41] = 0ull;
    }
    __syncthreads();

    {
        PHASE_IDS BASES
        float* scr = (float*)(lds + wave * 16896);
#define TR(src, K, N, dst, Kpad, Npad) do { const int _ni = ((Kpad) / 64) * ((Npad) / 64); for (int it = cgw_; it < _ni; it += cngw_) tr_item((src), (K), (N), (dst), (Kpad), (Npad), scr, it, lane); } while (0)
#define CONVERT_WEIGHTS(JLO, JHI, ILO, IHI, GWV, NGWV) do { const int cgw_ = (GWV), cngw_ = (NGWV); \
        _Pragma("unroll 1") for (int j = (JLO); j < (JHI); ++j) { \
            bf16_t* W1 = WT + j * RW_SZ; bf16_t* W2 = W1 + (size_t)7168 * 2048; bf16_t* WO = W2 + (size_t)8192 * 256; \
            TR(IN(24) + (size_t)j * DM * DM, 2048, 2048, W1, 2048, 2048); \
            TR(IN(25) + (size_t)j * DM * DM, 2048, 2048, W1 + (size_t)2048 * 2048, 2048, 2048); \
            TR(IN(26) + (size_t)j * DM * DM, 2048, 2048, W1 + (size_t)4096 * 2048, 2048, 2048); \
            TR(IN(11) + (size_t)j * DM * 96, 2048, 96, W1 + (size_t)6144 * 2048, 2048, 256); \
            TR(IN(14) + (size_t)j * DM * 96, 2048, 96, W1 + (size_t)6400 * 2048, 2048, 256); \
            TR(IN(19) + (size_t)j * DM * 256, 2048, 256, W1 + (size_t)6656 * 2048, 2048, 256); \
            if (j >= 1) TR(IN(17) + (size_t)(j - 1) * DM * 64, 2048, 64, W1 + (size_t)6912 * 2048, 2048, 256); \
            TR(IN(12) + (size_t)j * 96 * DM, 96, 2048, W2, 256, 2048); \
            TR(IN(15) + (size_t)j * 96 * DM, 96, 2048, W2 + (size_t)2048 * 256, 256, 2048); \
            TR(IN(20) + (size_t)j * 256 * DM, 256, 2048, W2 + (size_t)4096 * 256, 256, 2048); \
            if (j >= 1) TR(IN(18) + (size_t)(j - 1) * 64 * DM, 64, 2048, W2 + (size_t)6144 * 256, 256, 2048); \
            TR(IN(27) + (size_t)j * DM * DM, 2048, 2048, WO, 2048, 2048); \
            bf16_t* GI = WT + GW_OFF + j * GW_SZ; bf16_t* GO = GI + (size_t)6400 * 2048; \
            TR(IN(30) + (size_t)j * DM * 6160, 2048, 6160, GI, 2048, 6400); \
            TR(IN(34) + (size_t)j * DM * DM, 2048, 2048, GO, 2048, 2048); \
        } \
        _Pragma("unroll 1") for (int i = (ILO); i < (IHI); ++i) { \
            bf16_t* WU = WT + FW_OFF + i * FW_SZ; bf16_t* WD = WU + (size_t)F2 * 2048; \
            TR(IN(35) + (size_t)i * DM * F2, 2048, F2, WU, 2048, F2); \
            TR(IN(38) + (size_t)i * FH * DM, FH, 2048, WD, FH, 2048); \
        } } while (0)
        if (G >= 256) CONVERT_WEIGHTS(0, 1, 0, 2, gw, NGW); else CONVERT_WEIGHTS(0, 2, 0, 4, gw, NGW);
        const f32x4* xp = (const f32x4*)IN(0); const f32x4* xs = (const f32x4*)IN(1); f32x4* xo = (f32x4*)X;
        const int NP4 = MPROMPT * DM / 4, NA4 = MROWS * DM / 4;
#pragma unroll 4
        for (int i = gtid; i < NA4; i += NT) xo[i] = i < NP4 ? xp[i] : xs[i - NP4];
    }
    grid.sync();

#pragma clang loop unroll(full)
    for (int layer = 0; layer < 4; ++layer) {
        const int jl = layer >> 1;
        if ((layer & 1) == 0) {
            {
                PHASE_IDS BASES RWKV_PTRS
                const float* gmix = IN(6) + (size_t)layer * DM;
                const float* mix = IN(9) + (size_t)jl * 6 * DM;
                const float* sst = IN(2) + (size_t)jl * 16 * DM;
                float* mixS = (float*)lds; float* gS = mixS + 6 * DM;
                for (int i = tid; i < 6 * DM / 4; i += 512) *(f32x4*)(mixS + i * 4) = *(const f32x4*)(mix + i * 4);
                for (int i = tid; i < DM / 4; i += 512) *(f32x4*)(gS + i * 4) = *(const f32x4*)(gmix + i * 4);
                __syncthreads();
                for (int row = gw; row < MROWS; row += NGW) {
                    int t, len, b; bool prompt; row_info(row, t, len, b, prompt);
                    const f32x4* xr = (const f32x4*)(X + (size_t)row * DM) + lane;
                    f32x4 x[8]; float ss = 0.f;
#pragma unroll
                    for (int q = 0; q < 8; ++q) { x[q] = xr[64 * q]; ss += x[q][0] * x[q][0] + x[q][1] * x[q][1] + x[q][2] * x[q][2] + x[q][3] * x[q][3]; }
                    const float rs = rsqrtf(wave_sum(ss, lane) * (1.f / DM) + 1e-6f);
                    f32x4 hp[8];
                    if (t > 0) {
                        const f32x4* xq = (const f32x4*)(X + (size_t)(row - 1) * DM) + lane; float s2 = 0.f;
#pragma unroll
                        for (int q = 0; q < 8; ++q) { hp[q] = xq[64 * q]; s2 += hp[q][0] * hp[q][0] + hp[q][1] * hp[q][1] + hp[q][2] * hp[q][2] + hp[q][3] * hp[q][3]; }
                        const float rp = rsqrtf(wave_sum(s2, lane) * (1.f / DM) + 1e-6f);
#pragma unroll
                        for (int q = 0; q < 8; ++q) { const f32x4 gg = *((const f32x4*)gS + lane + 64 * q); hp[q] = hp[q] * rp * gg; }
                    } else if (!prompt) {
#pragma unroll
                        for (int q = 0; q < 8; ++q) hp[q] = *((const f32x4*)(sst + (size_t)b * DM) + lane + 64 * q);
                    } else {
#pragma unroll
                        for (int q = 0; q < 8; ++q) hp[q] = (f32x4){0.f, 0.f, 0.f, 0.f};
                    }
                    const bool lastrow = (t == len - 1);
                    float* shout = OUTP + (prompt ? O_PSHIFT + ((size_t)jl * 2 + b) * DM : O_SSHIFT + ((size_t)jl * 16 + b) * DM);
#pragma unroll
                    for (int q = 0; q < 8; ++q) {
                        const f32x4 gg = *((const f32x4*)gS + lane + 64 * q);
                        const f32x4 h = x[q] * rs * gg; const f32x4 dlt = hp[q] - h;
                        if (lastrow) *((f32x4*)shout + lane + 64 * q) = h;
#pragma unroll
                        for (int m = 0; m < 6; ++m) {
                            const f32x4 mx = *((const f32x4*)(mixS + m * DM) + lane + 64 * q);
                            const f32x4 o = h + dlt * mx;
                            u32x2 w; w.x = cvt_pk_bf16(o[0], o[1]); w.y = cvt_pk_bf16(o[2], o[3]);
                            *((u32x2*)(HB + (size_t)m * ACT + (size_t)row * DM) + lane + 64 * q) = w;
                        }
                    }
                }
            }
            fast_grid_barrier((unsigned*)ldp(tab, 40), tab);
            {
                BASES RWKV_PTRS
                pg8::Gemm g{HB, W1, MROWS, jl == 0 ? 6912 : 7168, 2048, 1, ACT * 2};
                pg8::StaticOrder S; S.init(g.M, g.N, G, (int)blockIdx.x, g.K, 1);
                pg8::Epi<FR1> E{FR1{Rb, Kb, Vb, Lb}};
                pg8::gemm_phase(ldsl, g, S, E);
            }
            fast_grid_barrier((unsigned*)ldp(tab, 40), tab);
            {
                BASES RWKV_PTRS
                pg8::Gemm g{Lb, W2, MROWS, jl == 0 ? 6144 : 8192, 256, 2, (size_t)MROWS * 256 * 2};
                pg8::StaticOrder S; S.init(g.M, g.N, G, (int)blockIdx.x, g.K, 1);
                pg8::Epi<FR2> E{FR2{DD, AA, GG, VG, IN(10) + (size_t)jl * DM, IN(13) + (size_t)jl * DM, IN(16) + (size_t)(jl > 0 ? jl - 1 : 0) * DM}};
                pg8::gemm_phase(ldsl, g, S, E);
            }
            fast_grid_barrier((unsigned*)ldp(tab, 40), tab);
            {
                PHASE_IDS BASES RWKV_PTRS
                float* Obuf = (float*)(RA + 272 * MiB); float* RK = (float*)(RB + 204 * MiB); float* DTg = (float*)(RB + 208 * MiB);
                const float* k_k = IN(21) + (size_t)jl * DM; const float* k_a = IN(22) + (size_t)jl * DM; const float* r_k = IN(23) + (size_t)jl * DM;
                const int l32 = lane & 31, hl = lane >> 5;
#define S1_BAR do { asm volatile("s_waitcnt lgkmcnt(0)" ::: "memory"); __builtin_amdgcn_s_barrier(); asm volatile("" ::: "memory"); } while (0)
                const int st = tid >> 3, c0 = (tid & 7) * 8;
                u32x4 pr_, pk_, pv_, pa_, pvf_ = (u32x4){0u, 0u, 0u, 0u}, pvg_ = (u32x4){0u, 0u, 0u, 0u}; f32x4 pd0_, pd1_;
#define S1_FETCH(it) do { const size_t _off = (size_t)(((it) >> 5) * 64 + st) * DM + ((it) & 31) * 64 + c0; \
                    pr_ = *(const u32x4*)(Rb + _off); pk_ = *(const u32x4*)(Kb + _off); pv_ = *(const u32x4*)(Vb + _off); pa_ = *(const u32x4*)(AA + _off); \
                    pd0_ = *(const f32x4*)(DD + _off); pd1_ = *(const f32x4*)(DD + _off + 4); \
                    if (jl > 0) { pvf_ = *(const u32x4*)(VFIRST + _off); pvg_ = *(const u32x4*)(VG + _off); } } while (0)
#pragma unroll 1
                for (int item = blockIdx.x; item < 8704; item += G) {
                    LAS unsigned char* ldsv = (LAS unsigned char*)lds; asm volatile("" : "+v"(ldsv));
                    LAS bf16_t* AH = (LAS bf16_t*)(ldsv + 0); LAS bf16_t* RH = (LAS bf16_t*)(ldsv + 9216); LAS bf16_t* BH = (LAS bf16_t*)(ldsv + 18432); LAS bf16_t* KH = (LAS bf16_t*)(ldsv + 27648);
                    LAS bf16_t* BHT = (LAS bf16_t*)(ldsv + 36864); LAS bf16_t* KHT = (LAS bf16_t*)(ldsv + 46080); LAS bf16_t* VTs = (LAS bf16_t*)(ldsv + 55296); LAS bf16_t* XT = (LAS bf16_t*)(ldsv + 64512);
                    LAS float* AAB = (LAS float*)(ldsv + 82944); LAS bf16_t* AAK = (LAS bf16_t*)(ldsv + 99328); LAS bf16_t* ARB = (LAS bf16_t*)(ldsv + 108544); LAS bf16_t* ARK = (LAS bf16_t*)(ldsv + 117760);
                    LAS float* LB = (LAS float*)(ldsv + 126976); LAS float* DTS = (LAS float*)(ldsv + 143360);
                    (void)RH; (void)KH; (void)KHT;
                    const int chunk = item >> 5, h = item & 31, r0 = chunk * 64;
                    const int col = h * 64 + c0;
                    S1_FETCH(item);
                    float r[8], kk[8], bb[8], km[8], ld[8];
                    {
                        float k[8], v[8], a[8];
                        unpack8(pr_, r); unpack8(pk_, k); unpack8(pv_, v); unpack8(pa_, a);
                        const f32x4 d0 = pd0_, d1 = pd1_;
                        ld[0] = d0[0]; ld[1] = d0[1]; ld[2] = d0[2]; ld[3] = d0[3]; ld[4] = d1[0]; ld[5] = d1[1]; ld[6] = d1[2]; ld[7] = d1[3];
                        if (jl > 0) { float vf[8], vg[8]; unpack8(pvf_, vf); unpack8(pvg_, vg);
#pragma unroll
                            for (int i = 0; i < 8; ++i) v[i] = v[i] + (vf[i] - v[i]) * vg[i]; }
                        float ss = 0.f;
#pragma unroll
                        for (int i = 0; i < 8; ++i) { kk[i] = k[i] * k_k[col + i]; ss += kk[i] * kk[i]; }
                        ss = sum8(ss, lane);
                        const float inv = 1.f / fmaxf(sqrtf(ss), 1e-12f);
                        float rk = 0.f;
#pragma unroll
                        for (int i = 0; i < 8; ++i) { kk[i] *= inv; bb[i] = kk[i] * a[i]; km[i] = k[i] * (1.f + (a[i] - 1.f) * k_a[col + i]); rk += r[i] * km[i] * r_k[col + i]; }
                        rk = sum8(rk, lane);
                        if ((tid & 7) == 0) RK[(size_t)(r0 + st) * 32 + h] = rk;
                        *(LAS f32x4*)(LB + st * 64 + c0) = d0; *(LAS f32x4*)(LB + st * 64 + c0 + 4) = d1;
#pragma unroll
                        for (int i = 0; i < 8; i += 2) { const unsigned pk = cvt_pk_bf16(v[i], v[i + 1]); VTs[(c0 + i) * 72 + st] = (bf16_t)(pk & 0xffffu); VTs[(c0 + i + 1) * 72 + st] = (bf16_t)(pk >> 16); }
                    }
                    S1_BAR;
                    {
                        const int cc_ = tid & 63, tq_ = tid >> 6; float pf[8]; float run = 0.f;
#pragma unroll
                        for (int j = 0; j < 8; ++j) { run += LB[(8 * tq_ + j) * 64 + cc_]; pf[j] = run; }
                        AAB[tq_ * 64 + cc_] = run;
                        S1_BAR;
                        float ofs = 0.f;
#pragma unroll
                        for (int g = 0; g < 7; ++g) ofs += (g < tq_) ? AAB[g * 64 + cc_] : 0.f;
#pragma unroll
                        for (int j = 0; j < 8; ++j) LB[(8 * tq_ + j) * 64 + cc_] = pf[j] + ofs;
                    }
                    S1_BAR;
                    {
                        float ah[8], bh[8], kh[8], rh[8];
#pragma unroll
                        for (int i = 0; i < 8; ++i) { const float Lt = LB[st * 64 + c0 + i]; const float e3 = __expf(Lt), e2 = __expf(-Lt), e1 = __expf(Lt - ld[i]);
                            ah[i] = -kk[i] * e1; bh[i] = bb[i] * e2; kh[i] = km[i] * e2; rh[i] = r[i] * e3;
                            if (st == 63) { DTS[c0 + i] = e3; DTg[(size_t)item * 64 + c0 + i] = e3; } }
                        *(LAS u32x4*)(AH + st * 72 + c0) = pack8(ah); *(LAS u32x4*)(RH + st * 72 + c0) = pack8(rh);
                        *(LAS u32x4*)(BH + st * 72 + c0) = pack8(bh); *(LAS u32x4*)(KH + st * 72 + c0) = pack8(kh);
#pragma unroll
                        for (int i = 0; i < 8; i += 2) { const unsigned p1 = cvt_pk_bf16(bh[i], bh[i + 1]), p2 = cvt_pk_bf16(kh[i], kh[i + 1]);
                            BHT[(c0 + i) * 72 + st] = (bf16_t)(p1 & 0xffffu); BHT[(c0 + i + 1) * 72 + st] = (bf16_t)(p1 >> 16);
                            KHT[(c0 + i) * 72 + st] = (bf16_t)(p2 & 0xffffu); KHT[(c0 + i + 1) * 72 + st] = (bf16_t)(p2 >> 16); }
                    }
                    S1_BAR;
                    {
                        const int mi = wave & 3, rowsel = mi >> 1, tt = mi & 1;
#pragma unroll
                        for (int nn = 0; nn < 2; ++nn) {
                            const int colsel = wave >> 2, stl = nn; const int ni = 2 * colsel + nn;
                            f32x16 acc;
#pragma unroll
                            for (int i = 0; i < 16; ++i) acc[i] = 0.f;
                            if (stl <= tt) {
#pragma unroll
                                for (int ks = 0; ks < 4; ++ks) {
                                    const bf16x8 a = *(const LAS bf16x8*)(AH + (mi * 32 + l32) * 72 + ks * 16 + hl * 8);
                                    const bf16x8 b = *(const LAS bf16x8*)(BH + (ni * 32 + l32) * 72 + ks * 16 + hl * 8);
                                    acc = __builtin_amdgcn_mfma_f32_32x32x16_bf16(a, b, acc, 0, 0, 0);
                                }
                            }
#pragma unroll
                            for (int i = 0; i < 16; ++i) {
                                const int t = tt * 32 + crow(i, hl), s = stl * 32 + l32;
                                const bool keep = rowsel ? (s <= t) : (s < t);
                                const float val = keep ? acc[i] : 0.f;
                                if (rowsel == 0 && colsel == 0) AAB[t * 64 + s] = val;
                                else { LAS bf16_t* dst = (rowsel == 0) ? AAK : (colsel == 0 ? ARB : ARK); dst[t * 72 + s] = (bf16_t)(cvt_pk_bf16(val, 0.f) & 0xffffu); }
                            }
                        }
                    }
                    S1_BAR;
                    if (wave < 4) {
                        const int mt = wave >> 1, nt = wave & 1;
                        f32x16 acc;
#pragma unroll
                        for (int i = 0; i < 16; ++i) acc[i] = 0.f;
#pragma unroll
                        for (int ks = 0; ks < 4; ++ks) {
                            const bf16x8 a = *(const LAS bf16x8*)(AAK + (mt * 32 + l32) * 72 + ks * 16 + hl * 8);
                            const bf16x8 b = *(const LAS bf16x8*)(VTs + (nt * 32 + l32) * 72 + ks * 16 + hl * 8);
                            acc = __builtin_amdgcn_mfma_f32_32x32x16_bf16(a, b, acc, 0, 0, 0);
                        }
#pragma unroll
                        for (int i = 0; i < 16; ++i) LB[(mt * 32 + crow(i, hl)) * 64 + nt * 32 + l32] = acc[i];
                    }
                    S1_BAR;
                    {
                        const int colx = tid >> 2, par = tid & 3;
                        float Xp[4][4];
#pragma unroll
                        for (int i = 0; i < 4; ++i) { Xp[i][0] = 0.f; Xp[i][1] = 0.f; Xp[i][2] = 0.f; Xp[i][3] = 0.f; }
#pragma clang loop unroll(full)
                        for (int t = 0; t < 64; ++t) {
                            const float va_ = bf2f(AH[t * 72 + (colx & 63)]), vb_ = LB[t * 64 + (colx & 63)];
                            float a0 = par ? 0.f : ((colx < 64) ? va_ : vb_);
                            float a1 = 0.f, a2 = 0.f, a3 = 0.f;
#pragma clang loop unroll(full)
                            for (int i = 0; 16 * i < t; ++i) { const f32x4 w = *(const LAS f32x4*)(AAB + t * 64 + 16 * i + 4 * par);
                                a0 += w[0] * Xp[i][0]; a1 += w[1] * Xp[i][1]; a2 += w[2] * Xp[i][2]; a3 += w[3] * Xp[i][3]; }
                            float val = (a0 + a1) + (a2 + a3);
                            val += __builtin_bit_cast(float, __builtin_amdgcn_update_dpp(0, __builtin_bit_cast(int, val), 0xB1, 0xf, 0xf, false));
                            val += __builtin_bit_cast(float, __builtin_amdgcn_update_dpp(0, __builtin_bit_cast(int, val), 0x4E, 0xf, 0xf, false));
                            Xp[t >> 4][t & 3] = (par == ((t >> 2) & 3)) ? val : Xp[t >> 4][t & 3];
                            asm volatile("" : "+v"(Xp[t >> 4][t & 3]));
                        }
#pragma unroll
                        for (int i = 0; i < 4; ++i) { u32x2 w; w.x = cvt_pk_bf16(Xp[i][0], Xp[i][1]); w.y = cvt_pk_bf16(Xp[i][2], Xp[i][3]);
                            *(LAS u32x2*)(XT + colx * 72 + 16 * i + 4 * par) = w; }
                    }
                    S1_BAR;
                    {
                        const int kind = wave >> 2, mt = (wave & 3) >> 1, nt = wave & 1;
                        {
                            const LAS bf16_t* Ap = (kind == 0 ? ARB : BHT) + (mt * 32 + l32) * 72; const LAS bf16_t* Bp = XT + (nt * 32 + l32) * 72;
                            f32x16 acc;
#pragma unroll
                            for (int i = 0; i < 16; ++i) acc[i] = 0.f;
#pragma unroll
                            for (int ks = 0; ks < 4; ++ks) acc = __builtin_amdgcn_mfma_f32_32x32x16_bf16(*(const LAS bf16x8*)(Ap + ks * 16 + hl * 8), *(const LAS bf16x8*)(Bp + ks * 16 + hl * 8), acc, 0, 0, 0);
                            bf16_t* dstb = (kind == 0) ? Rb : Kb;
#pragma unroll
                            for (int i = 0; i < 16; ++i) { const int rr = mt * 32 + crow(i, hl), cc = nt * 32 + l32;
                                float val = acc[i];
                                if (kind == 0) val += bf2f(RH[rr * 72 + cc]); else val *= DTS[rr];
                                dstb[(size_t)(r0 + rr) * DM + h * 64 + cc] = (bf16_t)(cvt_pk_bf16(val, 0.f) & 0xffffu); }
                        }
                        {
                            const LAS bf16_t* A1 = (kind == 0 ? ARB : BHT) + (mt * 32 + l32) * 72; const LAS bf16_t* A2 = (kind == 0 ? ARK : KHT) + (mt * 32 + l32) * 72;
                            const LAS bf16_t* B1 = XT + (64 + nt * 32 + l32) * 72; const LAS bf16_t* B2 = VTs + (nt * 32 + l32) * 72;
                            f32x16 acc;
#pragma unroll
                            for (int i = 0; i < 16; ++i) acc[i] = 0.f;
#pragma unroll
                            for (int ks = 0; ks < 4; ++ks) acc = __builtin_amdgcn_mfma_f32_32x32x16_bf16(*(const LAS bf16x8*)(A1 + ks * 16 + hl * 8), *(const LAS bf16x8*)(B1 + ks * 16 + hl * 8), acc, 0, 0, 0);
#pragma unroll
                            for (int ks = 0; ks < 4; ++ks) acc = __builtin_amdgcn_mfma_f32_32x32x16_bf16(*(const LAS bf16x8*)(A2 + ks * 16 + hl * 8), *(const LAS bf16x8*)(B2 + ks * 16 + hl * 8), acc, 0, 0, 0);
                            float* dstf = (kind == 0) ? Obuf : DD;
#pragma unroll
                            for (int i = 0; i < 16; ++i) { const int rr = mt * 32 + crow(i, hl), cc = nt * 32 + l32;
                                float val = acc[i]; if (kind == 1) val *= DTS[rr];
                                dstf[(size_t)(r0 + rr) * DM + h * 64 + cc] = val; }
                        }
                    }
                    S1_BAR;
                }
            }
            fast_grid_barrier((unsigned*)ldp(tab, 40), tab);
#undef S1_BAR
#undef S1_FETCH
            {
                PHASE_IDS BASES RWKV_PTRS
                const float* DTg = (const float*)(RB + 208 * MiB);
                const int l32 = lane & 31, hl = lane >> 5;
                const int q = wave * G + blockIdx.x;
                if (q < 1152) {
                    const bool prompt = q < 128; int b, h, vh, chunk0, nch;
                    if (prompt) { const int chain = q & 63; b = chain >> 5; h = chain & 31; vh = q >> 6; chunk0 = b * 128; nch = 128; }
                    else { const int sq = q - 128; const int chain = sq >> 1; b = chain >> 5; h = chain & 31; vh = sq & 1; chunk0 = 256 + b; nch = 1; }
                    const int colb = h * 64, vcol = colb + 32 * vh + l32;
                    f32x16 S0, S1;
                    if (prompt) {
#pragma unroll
                        for (int i = 0; i < 16; ++i) { S0[i] = 0.f; S1[i] = 0.f; }
                    } else {
                        const float* s0 = IN(3) + ((((size_t)jl * 16 + b) * 32 + h) * 64 + (32 * vh + l32)) * 64;
#pragma unroll
                        for (int i = 0; i < 16; ++i) { S0[i] = s0[crow(i, hl)]; S1[i] = s0[32 + crow(i, hl)]; }
                    }
                    bf16x8 gf[2][2][2]; f32x16 n0, n1; f32x4 dt_[2][4];
#define S2_COMPUTE(cc) do { const int _r0 = (chunk0 + (cc)) * 64; \
                        u32x4 w00, w01, w10, w11; \
                        w00.x = cvt_pk_bf16(S0[0], S0[1]); w00.y = cvt_pk_bf16(S0[2], S0[3]); w00.z = cvt_pk_bf16(S0[4], S0[5]); w00.w = cvt_pk_bf16(S0[6], S0[7]); \
                        w01.x = cvt_pk_bf16(S0[8], S0[9]); w01.y = cvt_pk_bf16(S0[10], S0[11]); w01.z = cvt_pk_bf16(S0[12], S0[13]); w01.w = cvt_pk_bf16(S0[14], S0[15]); \
                        w10.x = cvt_pk_bf16(S1[0], S1[1]); w10.y = cvt_pk_bf16(S1[2], S1[3]); w10.z = cvt_pk_bf16(S1[4], S1[5]); w10.w = cvt_pk_bf16(S1[6], S1[7]); \
                        w11.x = cvt_pk_bf16(S1[8], S1[9]); w11.y = cvt_pk_bf16(S1[10], S1[11]); w11.z = cvt_pk_bf16(S1[12], S1[13]); w11.w = cvt_pk_bf16(S1[14], S1[15]); \
                        const bf16x8 sb00 = __builtin_bit_cast(bf16x8, w00), sb01 = __builtin_bit_cast(bf16x8, w01), sb10 = __builtin_bit_cast(bf16x8, w10), sb11 = __builtin_bit_cast(bf16x8, w11); \
                        n0 = __builtin_amdgcn_mfma_f32_32x32x16_bf16(gf[0][0][0], sb00, n0, 0, 0, 0); n1 = __builtin_amdgcn_mfma_f32_32x32x16_bf16(gf[1][0][0], sb00, n1, 0, 0, 0); \
                        n0 = __builtin_amdgcn_mfma_f32_32x32x16_bf16(gf[0][0][1], sb01, n0, 0, 0, 0); n1 = __builtin_amdgcn_mfma_f32_32x32x16_bf16(gf[1][0][1], sb01, n1, 0, 0, 0); \
                        n0 = __builtin_amdgcn_mfma_f32_32x32x16_bf16(gf[0][1][0], sb10, n0, 0, 0, 0); n1 = __builtin_amdgcn_mfma_f32_32x32x16_bf16(gf[1][1][0], sb10, n1, 0, 0, 0); \
                        n0 = __builtin_amdgcn_mfma_f32_32x32x16_bf16(gf[0][1][1], sb11, n0, 0, 0, 0); n1 = __builtin_amdgcn_mfma_f32_32x32x16_bf16(gf[1][1][1], sb11, n1, 0, 0, 0); \
                        { unsigned char* _sp = (unsigned char*)DD + ((size_t)(_r0 + l32) * DM + colb + 32 * vh) * 4 + 8 * hl; \
                          *(u32x2*)(_sp + 0) = (u32x2){w00.x, w00.y}; *(u32x2*)(_sp + 16) = (u32x2){w00.z, w00.w}; *(u32x2*)(_sp + 32) = (u32x2){w01.x, w01.y}; *(u32x2*)(_sp + 48) = (u32x2){w01.z, w01.w}; \
                          *(u32x2*)(_sp + 64) = (u32x2){w10.x, w10.y}; *(u32x2*)(_sp + 80) = (u32x2){w10.z, w10.w}; *(u32x2*)(_sp + 96) = (u32x2){w11.x, w11.y}; *(u32x2*)(_sp + 112) = (u32x2){w11.z, w11.w}; } \
                        _Pragma("unroll") for (int i = 0; i < 16; ++i) { S0[i] = S0[i] * dt_[0][i >> 2][i & 3] + n0[i]; S1[i] = S1[i] * dt_[1][i >> 2][i & 3] + n1[i]; } \
                    } while (0)
                    if (prompt) {
                        LAS float* dtl = (LAS float*)((LAS unsigned char*)lds);
                        LAS unsigned char* ring = (LAS unsigned char*)lds + 32768;
                        for (int i = lane; i < 128 * 16; i += 64) *(LAS f32x4*)(dtl + i * 4) = *(const f32x4*)(DTg + ((size_t)(chunk0 + (i >> 4)) * 32 + h) * 64 + (i & 15) * 4);
#define S2_DMA(cc) do { const int _r0 = (chunk0 + (cc)) * 64; LAS unsigned char* _s = ring + ((cc) & 3) * 16384; \
                            _Pragma("unroll") for (int j = 0; j < 8; ++j) { const int _row = 8 * j + (lane >> 3); const int _p = (lane & 7) ^ (_row & 7); \
                                __builtin_amdgcn_global_load_lds((const unsigned*)(Kb + (size_t)(_r0 + _row) * DM + colb + _p * 8), (LAS unsigned*)(_s + j * 1024), 16, 0, 0); } \
                            _Pragma("unroll") for (int j = 0; j < 8; ++j) { const int _row = 8 * j + (lane >> 3); \
                                __builtin_amdgcn_global_load_lds((const unsigned*)(DD + (size_t)(_r0 + _row) * DM + colb + 32 * vh + (lane & 7) * 4), (LAS unsigned*)(_s + 8192 + j * 1024), 16, 0, 0); } \
                        } while (0)
                        S2_DMA(0); S2_DMA(1);
#pragma unroll 1
                        for (int c = 0; c < 128; ++c) {
                            if (c + 2 < 128) { S2_DMA(c + 2); asm volatile("s_waitcnt vmcnt(32)" ::: "memory"); }
                            else if (c + 1 < 128) asm volatile("s_waitcnt vmcnt(16)" ::: "memory");
                            else asm volatile("s_waitcnt vmcnt(0)" ::: "memory");
                            LAS unsigned char* sl = ring + (c & 3) * 16384;
#pragma unroll
                            for (int mt = 0; mt < 2; ++mt)
#pragma unroll
                                for (int kt = 0; kt < 2; ++kt)
#pragma unroll
                                    for (int s2 = 0; s2 < 2; ++s2) {
                                        const int row = 32 * mt + l32, p = 4 * kt + 2 * s2;
                                        const u32x2 lo = *(const LAS u32x2*)(sl + row * 128 + ((p ^ (row & 7)) * 16) + 8 * hl);
                                        const u32x2 hi = *(const LAS u32x2*)(sl + row * 128 + (((p + 1) ^ (row & 7)) * 16) + 8 * hl);
                                        gf[mt][kt][s2] = __builtin_bit_cast(bf16x8, (u32x4){lo.x, lo.y, hi.x, hi.y});
                                    }
#pragma unroll
                            for (int i = 0; i < 16; ++i) { n0[i] = *(const LAS float*)(sl + 8192 + crow(i, hl) * 128 + l32 * 4); n1[i] = *(const LAS float*)(sl + 8192 + (32 + crow(i, hl)) * 128 + l32 * 4); }
#pragma unroll
                            for (int mt = 0; mt < 2; ++mt)
#pragma unroll
                                for (int g = 0; g < 4; ++g) dt_[mt][g] = *(const LAS f32x4*)(dtl + c * 64 + 32 * mt + 8 * g + 4 * hl);
                            S2_COMPUTE(c);
                        }
#undef S2_DMA
                    } else {
                        const int _r0 = chunk0 * 64; const size_t _item = (size_t)chunk0 * 32 + h;
#pragma unroll
                        for (int mt = 0; mt < 2; ++mt)
#pragma unroll
                            for (int kt = 0; kt < 2; ++kt)
#pragma unroll
                                for (int s2 = 0; s2 < 2; ++s2) {
                                    const size_t _o = (size_t)(_r0 + 32 * mt + l32) * DM + colb + 32 * kt + 16 * s2 + 4 * hl;
                                    const u32x2 _lo = *(const u32x2*)(Kb + _o), _hi = *(const u32x2*)(Kb + _o + 8); gf[mt][kt][s2] = __builtin_bit_cast(bf16x8, (u32x4){_lo.x, _lo.y, _hi.x, _hi.y}); }
#pragma unroll
                        for (int i = 0; i < 16; ++i) { n0[i] = DD[(size_t)(_r0 + crow(i, hl)) * DM + vcol]; n1[i] = DD[(size_t)(_r0 + 32 + crow(i, hl)) * DM + vcol]; }
#pragma unroll
                        for (int mt = 0; mt < 2; ++mt)
#pragma unroll
                            for (int g = 0; g < 4; ++g) dt_[mt][g] = *(const f32x4*)(DTg + _item * 64 + 32 * mt + 8 * g + 4 * hl);
                        S2_COMPUTE(0);
                    }
#undef S2_COMPUTE
                    float* so_ = OUTP + (prompt ? O_PWKV + ((((size_t)jl * 2 + b) * 32 + h) * 64 + (32 * vh + l32)) * 64
                                                : O_SWKV + ((((size_t)jl * 16 + b) * 32 + h) * 64 + (32 * vh + l32)) * 64);
#pragma unroll
                    for (int i = 0; i < 16; ++i) { so_[crow(i, hl)] = S0[i]; so_[32 + crow(i, hl)] = S1[i]; }
                }
            }
            fast_grid_barrier((unsigned*)ldp(tab, 40), tab);
            {
                PHASE_IDS BASES RWKV_PTRS
                const float* Obuf = (const float*)(RA + 272 * MiB); const float* RK = (const float*)(RB + 204 * MiB);
                const float* lnw_g = IN(28) + (size_t)jl * DM; const float* lnb_g = IN(29) + (size_t)jl * DM;
                float* lnw = (float*)(lds + 40960); float* lnb = lnw + DM;
                for (int i = tid; i < DM / 4; i += 512) { *(f32x4*)(lnw + i * 4) = *(const f32x4*)(lnw_g + i * 4); *(f32x4*)(lnb + i * 4) = *(const f32x4*)(lnb_g + i * 4); }
                __syncthreads();
                const int l32 = lane & 31, hl = lane >> 5;
#pragma unroll 1
                for (int item = blockIdx.x; item < 8704; item += G) {
                    LAS unsigned char* ldsv = (LAS unsigned char*)lds; asm volatile("" : "+v"(ldsv));
                    LAS bf16_t* R2s = (LAS bf16_t*)(ldsv + 0); LAS bf16_t* STs = (LAS bf16_t*)(ldsv + 9216); LAS float* Os = (LAS float*)(ldsv + 18432);
                    const int chunk = item >> 5, h = item & 31, r0 = chunk * 64;
                    {
                        const int rr = tid >> 3, pc = tid & 7;
                        *(LAS u32x4*)(R2s + rr * 72 + pc * 8) = *(const u32x4*)(Rb + (size_t)(r0 + rr) * DM + h * 64 + pc * 8);
                        const unsigned char* sp = (const unsigned char*)DD + ((size_t)(r0 + (rr & 31)) * DM + h * 64 + 32 * (rr >> 5)) * 4 + pc * 16;
                        *(LAS u32x4*)(STs + rr * 72 + pc * 8) = *(const u32x4*)sp;
                    }
                    __syncthreads();
                    if (wave < 4) {
                        const int tt = wave >> 1, vt = wave & 1;
                        f32x16 acc;
#pragma unroll
                        for (int i = 0; i < 16; ++i) acc[i] = Obuf[(size_t)(r0 + 32 * tt + crow(i, hl)) * DM + h * 64 + 32 * vt + l32];
#pragma unroll
                        for (int ks = 0; ks < 4; ++ks) acc = __builtin_amdgcn_mfma_f32_32x32x16_bf16(*(const LAS bf16x8*)(R2s + (32 * tt + l32) * 72 + ks * 16 + hl * 8), *(const LAS bf16x8*)(STs + (32 * vt + l32) * 72 + ks * 16 + hl * 8), acc, 0, 0, 0);
#pragma unroll
                        for (int i = 0; i < 16; ++i) Os[(32 * tt + crow(i, hl)) * 68 + 32 * vt + l32] = acc[i];
                    }
                    __syncthreads();
                    {
                        const int st = tid >> 3, c0 = (tid & 7) * 8, col = h * 64 + c0; const size_t off = (size_t)(r0 + st) * DM + col;
                        const f32x4 o0 = *(const LAS f32x4*)(Os + st * 68 + c0), o1 = *(const LAS f32x4*)(Os + st * 68 + c0 + 4);
                        float o[8] = {o0[0], o0[1], o0[2], o0[3], o1[0], o1[1], o1[2], o1[3]};
                        float s = 0.f;
#pragma unroll
                        for (int i = 0; i < 8; ++i) s += o[i];
                        const float mu = sum8(s, lane) * (1.f / 64.f); float q = 0.f;
#pragma unroll
                        for (int i = 0; i < 8; ++i) { o[i] -= mu; q += o[i] * o[i]; }
                        const float rstd = rsqrtf(sum8(q, lane) * (1.f / 64.f) + 64e-5f);
                        float v[8], g8[8]; unpack8(*(const u32x4*)(Vb + off), v); unpack8(*(const u32x4*)(GG + off), g8);
                        if (jl > 0) { float vf[8], vg[8]; unpack8(*(const u32x4*)(VFIRST + off), vf); unpack8(*(const u32x4*)(VG + off), vg);
#pragma unroll
                            for (int i = 0; i < 8; ++i) v[i] = v[i] + (vf[i] - v[i]) * vg[i]; }
                        const float rk = RK[(size_t)(r0 + st) * 32 + h];
                        float y[8];
#pragma unroll
                        for (int i = 0; i < 8; ++i) y[i] = (o[i] * rstd * lnw[col + i] + lnb[col + i] + rk * v[i]) * g8[i];
                        *(u32x4*)(Y + off) = pack8(y);
                    }
                    __syncthreads();
                }
            }
            fast_grid_barrier((unsigned*)ldp(tab, 40), tab);
            {
                BASES RWKV_PTRS
                pg8::Gemm g{Y, WO, MROWS, 2048, 2048, 0, 0};
                pg8::StaticOrder S; S.init(g.M, g.N, G, (int)blockIdx.x, g.K, 4);
                pg8::Epi<FRes> E{FRes{X, (float*)(RA + 272 * MiB)}};
                pg8::gemm_phase(ldsl, g, S, E);
                fast_grid_barrier((unsigned*)ldp(tab, 40), tab);
                {
                    PHASE_IDS
                    const float* PART = (const float*)(RA + 272 * MiB); const int ntail = S.nwg - S.nFull;
                    if (S.S > 1) for (int idx = gtid; idx < ntail * 16384; idx += NT) {
                        const int tl = idx >> 14, r = (idx >> 6) & 255, c4 = idx & 63; int pm, pn; S.tile_pmpn(S.nFull + tl, pm, pn);
                        f32x4* xp = (f32x4*)(X + (size_t)(pm * 256 + r) * DM + pn * 256 + c4 * 4); f32x4 acc = *xp;
#pragma unroll
                        for (int part = 0; part < 4; ++part) acc += *(const f32x4*)(PART + (size_t)(part * 32 + tl) * 65536 + r * 256 + c4 * 4);
                        *xp = acc; }
                }
            }
            fast_grid_barrier((unsigned*)ldp(tab, 40), tab);
        } else {
            { PHASE_IDS BASES GLA_PTRS
            const float* gmix = IN(6) + (size_t)layer * DM;
            f32x4 ggr[8];
#pragma unroll
            for (int q = 0; q < 8; ++q) ggr[q] = *((const f32x4*)gmix + lane + 64 * q);
            for (int row = gw; row < MROWS; row += NGW) {
                const f32x4* xr = (const f32x4*)(X + (size_t)row * DM) + lane; f32x4 x[8]; float ss = 0.f;
#pragma unroll
                for (int q = 0; q < 8; ++q) { x[q] = xr[64 * q]; ss += x[q][0] * x[q][0] + x[q][1] * x[q][1] + x[q][2] * x[q][2] + x[q][3] * x[q][3]; }
                const float rs = rsqrtf(wave_sum(ss, lane) * (1.f / DM) + 1e-6f);
#pragma unroll
                for (int q = 0; q < 8; ++q) { const f32x4 gg = ggr[q]; const f32x4 h = x[q] * rs * gg;
                    u32x2 w; w.x = cvt_pk_bf16(h[0], h[1]); w.y = cvt_pk_bf16(h[2], h[3]); *((u32x2*)(H + (size_t)row * DM) + lane + 64 * q) = w; }
            } }
            fast_grid_barrier((unsigned*)ldp(tab, 40), tab);
            {
                BASES GLA_PTRS
                pg8::Gemm g{H, GI, MROWS, 6400, 2048, 0, 0};
                pg8::StaticOrder S; S.init(g.M, g.N, G, (int)blockIdx.x, g.K, 1);
                pg8::Epi<FG1> E{FG1{PROJ, LR}};
                pg8::gemm_phase(ldsl, g, S, E);
            }
            fast_grid_barrier((unsigned*)ldp(tab, 40), tab);
            {
                PHASE_IDS BASES GLA_PTRS
                float* lrS = (float*)lds;
                float* w2S = (float*)(lds + 4096);
                float* totS = (float*)(lds + 20480);
                bf16_t* qeS = (bf16_t*)(lds + 22528);
                bf16_t* keS = (bf16_t*)(lds + 22528 + 33792);
                bf16_t* vS = qeS;
                const float* gw2 = IN(31) + (size_t)jl * 16 * 1024; const float* gkb = IN(32) + (size_t)jl * 1024;
#pragma unroll 1
                for (int it = blockIdx.x; it < 1088; it += G) {
                    const int c = it >> 2, h = it & 3, r0 = c * 64; const size_t base = (size_t)it;
                    if (tid < 256) *(f32x4*)(lrS + tid * 4) = *(const f32x4*)(LR + (size_t)r0 * 16 + tid * 4);
                    for (int q = tid; q < 1024; q += 512) { const int r = q >> 6, cc = (q & 63) * 4; *(f32x4*)(w2S + r * 256 + cc) = *(const f32x4*)(gw2 + (size_t)r * 1024 + h * 256 + cc); }
                    for (int q = tid; q < 2048; q += 512) { const int t = q >> 5, cc = (q & 31) * 8; const bf16_t* src = PROJ + (size_t)(r0 + t) * 6144 + h * 256 + cc;
                        *(u32x4*)(qeS + t * 264 + cc) = *(const u32x4*)src; *(u32x4*)(keS + t * 264 + cc) = *(const u32x4*)(src + 1024); }
                    __syncthreads();
                    const int d = tid & 255, half = tid >> 8;
                    float cumv[32];
                    {
                        float w[16];
#pragma unroll
                        for (int r = 0; r < 16; ++r) w[r] = w2S[r * 256 + d];
                        const float bb = gkb[h * 256 + d]; float run = 0.f;
#pragma unroll
                        for (int tt = 0; tt < 32; ++tt) {
                            const float* lp = lrS + (half * 32 + tt) * 16; float z = bb;
#pragma unroll
                            for (int r = 0; r < 16; ++r) z += lp[r] * w[r];
                            const float g = (fminf(z, 0.f) - log1pf(__expf(-fabsf(z)))) * 0.0625f;
                            run += g; cumv[tt] = run;
                        }
                        totS[half * 256 + d] = run;
                    }
                    __syncthreads();
                    {
                        const float t0 = totS[d], t1 = totS[256 + d]; const float last = t0 + t1, offc = half ? t0 : 0.f;
                        if (half == 0) EL[base * 256 + d] = __expf(last);
                        unsigned kdp[16];
#pragma unroll
                        for (int tt = 0; tt < 32; tt += 2) {
                            float kd2[2];
#pragma unroll
                            for (int e = 0; e < 2; ++e) {
                                const int t = half * 32 + tt + e; const float cum = cumv[tt + e] + offc;
                                const float q = bf2f(qeS[t * 264 + d]), k = bf2f(keS[t * 264 + d]);
                                const float qe = q * __expf(cum), ke = k * __expf(-cum); kd2[e] = k * __expf(last - cum);
                                const unsigned pq = cvt_pk_bf16(qe, ke);
                                qeS[t * 264 + d] = (bf16_t)(pq & 0xffffu); keS[t * 264 + d] = (bf16_t)(pq >> 16);
                            }
                            kdp[tt >> 1] = cvt_pk_bf16(kd2[0], kd2[1]);
                        }
                        u32x4* kdst = (u32x4*)(KDT + (base * 256 + d) * 64 + half * 32);
                        kdst[0] = (u32x4){kdp[0], kdp[1], kdp[2], kdp[3]}; kdst[1] = (u32x4){kdp[4], kdp[5], kdp[6], kdp[7]};
                        kdst[2] = (u32x4){kdp[8], kdp[9], kdp[10], kdp[11]}; kdst[3] = (u32x4){kdp[12], kdp[13], kdp[14], kdp[15]};
                    }
                    __syncthreads();
                    for (int q = tid; q < 2048; q += 512) { const int t = q >> 5, sl = (q >> 2) & 7, pc = q & 3;
                        *(u32x4*)(QE + ((base * 8 + sl) * 64 + t) * 32 + pc * 8) = *(const u32x4*)(qeS + t * 264 + sl * 32 + pc * 8); }
                    if (wave < 4) {
                        const int mi = wave >> 1, ni = wave & 1, l32 = lane & 31, hl = lane >> 5;
                        f32x16 cacc;
#pragma unroll
                        for (int i = 0; i < 16; ++i) cacc[i] = 0.f;
#pragma unroll
                        for (int kk = 0; kk < 16; ++kk) {
                            const bf16x8 a = *(const bf16x8*)(qeS + (mi * 32 + l32) * 264 + kk * 16 + hl * 8);
                            const bf16x8 b = *(const bf16x8*)(keS + (ni * 32 + l32) * 264 + kk * 16 + hl * 8);
                            cacc = __builtin_amdgcn_mfma_f32_32x32x16_bf16(a, b, cacc, 0, 0, 0);
                        }
#pragma unroll
                        for (int i = 0; i < 16; ++i) { const int ii = mi * 32 + crow(i, hl), jj = ni * 32 + l32;
                            const float v = (jj <= ii) ? cacc[i] : 0.f; SC[base * 4096 + ii * 64 + jj] = (bf16_t)(cvt_pk_bf16(v, 0.f) & 0xffffu); }
                    }
                    __syncthreads();
                    for (int q = tid; q < 4096; q += 512) { const int t = q >> 6, cc = (q & 63) * 8;
                        *(u32x4*)(vS + t * 520 + cc) = *(const u32x4*)(PROJ + (size_t)(r0 + t) * 6144 + 2048 + h * 512 + cc); }
                    __syncthreads();
                    {
                        const int dv = tid; u32x4* vdst = (u32x4*)(VT + (base * 512 + dv) * 64);
#pragma unroll
                        for (int q = 0; q < 8; ++q) {
                            unsigned w[4];
#pragma unroll
                            for (int e = 0; e < 4; ++e) { const unsigned lo = vS[(q * 8 + 2 * e) * 520 + dv], hi = vS[(q * 8 + 2 * e + 1) * 520 + dv]; w[e] = lo | (hi << 16); }
                            vdst[q] = (u32x4){w[0], w[1], w[2], w[3]};
                        }
                    }
                    __syncthreads();
                }
            }
            fast_grid_barrier((unsigned*)ldp(tab, 40), tab);
            {
                PHASE_IDS BASES GLA_PTRS
                float* red = (float*)lds;
                const int l32 = lane & 31, hl = lane >> 5;
#pragma unroll 1
                for (int u = blockIdx.x; u < 1152; u += G) {
                    const bool prompt = u < 128; int b, h, s, cg0, nch, row0;
                    if (prompt) { const int pair = u & 7; b = pair >> 2; h = pair & 3; s = u >> 3; cg0 = b * 128; nch = 128; row0 = b * 8192; }
                    else { const int su = u - 128; b = su >> 6; h = (su >> 4) & 3; s = su & 15; cg0 = 256 + b; nch = 1; row0 = MPROMPT + b * 64; }
                    f32x16 S;
                    if (prompt) {
#pragma unroll
                        for (int i = 0; i < 16; ++i) S[i] = 0.f;
                    } else {
                        const float* s0 = IN(4) + ((((size_t)jl * 16 + b) * 4 + h) * 256) * 512;
#pragma unroll
                        for (int i = 0; i < 16; ++i) S[i] = s0[(size_t)(32 * wave + crow(i, hl)) * 512 + 32 * s + l32];
                    }
                    const int mtw = wave & 1, ksw = wave >> 1;
                    bf16x8 ka[4], vb[4], qf[2][2], scf; f32x4 el[4];
#define GL_LD_Q(cc) do { const size_t _base = (size_t)(cg0 + (cc)) * 4 + h; const int _r0 = row0 + (cc) * 64; const bf16_t* _sc = SC + _base * 4096; \
                        _Pragma("unroll") for (int mt = 0; mt < 2; ++mt) _Pragma("unroll") for (int s2 = 0; s2 < 2; ++s2) { const bf16_t* _pq = QE + ((_base * 8 + wave) * 64 + mt * 32 + l32) * 32 + 16 * s2 + 4 * hl; \
                            const u32x2 _lo = *(const u32x2*)_pq, _hi = *(const u32x2*)(_pq + 8); qf[mt][s2] = __builtin_bit_cast(bf16x8, (u32x4){_lo.x, _lo.y, _hi.x, _hi.y}); } \
                        scf = *(const bf16x8*)(_sc + (mtw * 32 + l32) * 64 + 16 * ksw + 8 * hl); } while (0)
#define GL_LD_E(cc) do { const size_t _base = (size_t)(cg0 + (cc)) * 4 + h; \
                        _Pragma("unroll") for (int g = 0; g < 4; ++g) el[g] = *(const f32x4*)(EL + _base * 256 + 32 * wave + 8 * g + 4 * hl); } while (0)
#define GL_LD_K(cc) do { const size_t _base = (size_t)(cg0 + (cc)) * 4 + h; const bf16_t* _kdt = KDT + _base * 256 * 64; const bf16_t* _vt = VT + _base * 512 * 64; \
                        _Pragma("unroll") for (int ks = 0; ks < 4; ++ks) { ka[ks] = *(const bf16x8*)(_kdt + (32 * wave + l32) * 64 + 16 * ks + 8 * hl); vb[ks] = *(const bf16x8*)(_vt + (32 * s + l32) * 64 + 16 * ks + 8 * hl); } } while (0)
                    GL_LD_Q(0); GL_LD_E(0); GL_LD_K(0);
                    f32x4 osum = (f32x4){0.f, 0.f, 0.f, 0.f}; float* optr = nullptr;
#pragma unroll 1
                    for (int c = 0; c < nch; ++c) {
                        const int r0 = row0 + c * 64; const int cn = (c + 1 < nch) ? c + 1 : c;
                        asm volatile("" : "+v"(scf), "+v"(vb[3]));
                        if (c > 0) *(f32x4*)optr = osum;
                        u32x4 sp0, sp1;
                        sp0.x = cvt_pk_bf16(S[0], S[1]); sp0.y = cvt_pk_bf16(S[2], S[3]); sp0.z = cvt_pk_bf16(S[4], S[5]); sp0.w = cvt_pk_bf16(S[6], S[7]);
                        sp1.x = cvt_pk_bf16(S[8], S[9]); sp1.y = cvt_pk_bf16(S[10], S[11]); sp1.z = cvt_pk_bf16(S[12], S[13]); sp1.w = cvt_pk_bf16(S[14], S[15]);
                        const bf16x8 sb0 = __builtin_bit_cast(bf16x8, sp0), sb1 = __builtin_bit_cast(bf16x8, sp1);
                        const bf16x8 vbw = ksw == 0 ? vb[0] : ksw == 1 ? vb[1] : ksw == 2 ? vb[2] : vb[3];
#pragma unroll
                        for (int i = 0; i < 16; ++i) S[i] *= el[i >> 2][i & 3];
#pragma unroll
                        for (int ks = 0; ks < 4; ++ks) S = __builtin_amdgcn_mfma_f32_32x32x16_bf16(ka[ks], vb[ks], S, 0, 0, 0);
                        GL_LD_E(cn); GL_LD_K(cn);
                        f32x16 oo0, oo1;
#pragma unroll
                        for (int i = 0; i < 16; ++i) { oo0[i] = 0.f; oo1[i] = 0.f; }
                        oo0 = __builtin_amdgcn_mfma_f32_32x32x16_bf16(qf[0][0], sb0, oo0, 0, 0, 0); oo0 = __builtin_amdgcn_mfma_f32_32x32x16_bf16(qf[0][1], sb1, oo0, 0, 0, 0);
                        oo1 = __builtin_amdgcn_mfma_f32_32x32x16_bf16(qf[1][0], sb0, oo1, 0, 0, 0); oo1 = __builtin_amdgcn_mfma_f32_32x32x16_bf16(qf[1][1], sb1, oo1, 0, 0, 0);
                        if (mtw == 0) oo0 = __builtin_amdgcn_mfma_f32_32x32x16_bf16(scf, vbw, oo0, 0, 0, 0); else oo1 = __builtin_amdgcn_mfma_f32_32x32x16_bf16(scf, vbw, oo1, 0, 0, 0);
                        GL_LD_Q(cn);
#pragma unroll
                        for (int q = 0; q < 16; ++q) { red[(wave * 32 + q) * 64 + lane] = oo0[q]; red[(wave * 32 + 16 + q) * 64 + lane] = oo1[q]; }
                        asm volatile("s_waitcnt lgkmcnt(0)" ::: "memory"); __builtin_amdgcn_s_barrier(); asm volatile("" ::: "memory");
                        { const int q = tid >> 4, lg = tid & 15; f32x4 sum = (f32x4){0.f, 0.f, 0.f, 0.f};
#pragma unroll
                          for (int w = 0; w < 8; ++w) sum += *(const f32x4*)(red + (w * 32 + q) * 64 + 4 * lg);
                          const int mt = q >> 4, reg = q & 15, L = 4 * lg; const int i = mt * 32 + crow(reg, L >> 5), dv = L & 31;
                          osum = sum; optr = O + (size_t)(r0 + i) * DM + h * 512 + 32 * s + dv; }
                        asm volatile("s_waitcnt lgkmcnt(0)" ::: "memory"); __builtin_amdgcn_s_barrier(); asm volatile("" ::: "memory");
                    }
                    *(f32x4*)optr = osum;
#undef GL_LD_Q
#undef GL_LD_E
#undef GL_LD_K
                    float* dst = OUTP + (prompt ? O_PGLA + ((((size_t)jl * 2 + b) * 4 + h) * 256) * 512 : O_SGLA + ((((size_t)jl * 16 + b) * 4 + h) * 256) * 512);
#pragma unroll
                    for (int i = 0; i < 16; ++i) dst[(size_t)(32 * wave + crow(i, hl)) * 512 + 32 * s + l32] = S[i];
                }
                if (layer == 1 && G >= 256 && (int)blockIdx.x >= 128) {
                    float* scr = (float*)(lds + wave * 16896);
                    CONVERT_WEIGHTS(1, 2, 2, 4, ((int)blockIdx.x - 128) * 8 + wave, (G - 128) * 8);
                }
            }
            fast_grid_barrier((unsigned*)ldp(tab, 40), tab);
            {
                PHASE_IDS BASES GLA_PTRS
                const float* hn = IN(33) + (size_t)jl * 512;
                const f32x4 n0 = *(const f32x4*)(hn + lane * 8), n1 = *(const f32x4*)(hn + lane * 8 + 4);
                for (int row = gw; row < MROWS; row += NGW) {
#pragma unroll
                    for (int h = 0; h < 4; ++h) {
                        const float* op = O + (size_t)row * DM + h * 512 + lane * 8;
                        const f32x4 a = *(const f32x4*)op, b = *(const f32x4*)(op + 4);
                        float ss = a[0] * a[0] + a[1] * a[1] + a[2] * a[2] + a[3] * a[3] + b[0] * b[0] + b[1] * b[1] + b[2] * b[2] + b[3] * b[3];
                        const float rs = rsqrtf(wave_sum(ss, lane) * (1.f / 512.f) + 1e-5f);
                        float gt[8]; unpack8(*(const u32x4*)(PROJ + (size_t)row * 6144 + 4096 + h * 512 + lane * 8), gt);
                        float y[8];
#pragma unroll
                        for (int i = 0; i < 4; ++i) { y[i] = a[i] * rs * n0[i] * (gt[i] * sigmoidf_(gt[i])); y[4 + i] = b[i] * rs * n1[i] * (gt[4 + i] * sigmoidf_(gt[4 + i])); }
                        *(u32x4*)(Y + (size_t)row * DM + h * 512 + lane * 8) = pack8(y);
                    }
                }
            }
            fast_grid_barrier((unsigned*)ldp(tab, 40), tab);
            {
                BASES GLA_PTRS
                pg8::Gemm g{Y, GO, MROWS, 2048, 2048, 0, 0};
                pg8::StaticOrder S; S.init(g.M, g.N, G, (int)blockIdx.x, g.K, 4);
                pg8::Epi<FRes> E{FRes{X, (float*)(RA + 272 * MiB)}};
                pg8::gemm_phase(ldsl, g, S, E);
                fast_grid_barrier((unsigned*)ldp(tab, 40), tab);
                {
                    PHASE_IDS
                    const float* PART = (const float*)(RA + 272 * MiB); const int ntail = S.nwg - S.nFull;
                    if (S.S > 1) for (int idx = gtid; idx < ntail * 16384; idx += NT) {
                        const int tl = idx >> 14, r = (idx >> 6) & 255, c4 = idx & 63; int pm, pn; S.tile_pmpn(S.nFull + tl, pm, pn);
                        f32x4* xp = (f32x4*)(X + (size_t)(pm * 256 + r) * DM + pn * 256 + c4 * 4); f32x4 acc = *xp;
#pragma unroll
                        for (int part = 0; part < 4; ++part) acc += *(const f32x4*)(PART + (size_t)(part * 32 + tl) * 65536 + r * 256 + c4 * 4);
                        *xp = acc; }
                }
            }
            fast_grid_barrier((unsigned*)ldp(tab, 40), tab);
        }
        {
            { PHASE_IDS BASES FFN_PTRS
            const float* gf = IN(7) + (size_t)layer * DM;
            f32x4 ggr[8];
#pragma unroll
            for (int q = 0; q < 8; ++q) ggr[q] = *((const f32x4*)gf + lane + 64 * q);
            for (int row = gw; row < MROWS; row += NGW) {
                const f32x4* xr = (const f32x4*)(X + (size_t)row * DM) + lane; f32x4 x[8]; float ss = 0.f;
#pragma unroll
                for (int q = 0; q < 8; ++q) { x[q] = xr[64 * q]; ss += x[q][0] * x[q][0] + x[q][1] * x[q][1] + x[q][2] * x[q][2] + x[q][3] * x[q][3]; }
                const float rs = rsqrtf(wave_sum(ss, lane) * (1.f / DM) + 1e-6f);
#pragma unroll
                for (int q = 0; q < 8; ++q) { const f32x4 gg = ggr[q]; const f32x4 h = x[q] * rs * gg;
                    u32x2 w; w.x = cvt_pk_bf16(h[0], h[1]); w.y = cvt_pk_bf16(h[2], h[3]); *((u32x2*)(H + (size_t)row * DM) + lane + 64 * q) = w; }
            } }
            fast_grid_barrier((unsigned*)ldp(tab, 40), tab);
            {
                BASES FFN_PTRS
                pg8::Gemm g{H, WU, MROWS, F2, 2048, 0, 0};
                pg8::StaticOrder S; S.init(g.M, g.N, G, (int)blockIdx.x, g.K, 1);
                pg8::Epi<FUp> E{FUp{U, OUTP + O_PCONV + (size_t)layer * 2 * 2 * F2, OUTP + O_SCONV + (size_t)layer * 16 * 2 * F2}};
                pg8::gemm_phase(ldsl, g, S, E);
            }
            fast_grid_barrier((unsigned*)ldp(tab, 40), tab);
            {
                PHASE_IDS BASES FFN_PTRS
                const float* cw = IN(36) + (size_t)layer * 3 * F2; const float* cb = IN(37) + (size_t)layer * F2;
                const float* cst = IN(5) + (size_t)layer * 16 * 2 * F2;
#pragma unroll 1
                for (int it = gtid; it < 544 * 704; it += NT) {
                    const int rc = it / 704, c8 = it - rc * 704, col = c8 * 8, r0 = rc * 32;
                    int t0, len, b; bool prompt; row_info(r0, t0, len, b, prompt);
                    float wv[3][8], wg[3][8], bv[8], bg[8];
#pragma unroll
                    for (int k = 0; k < 3; ++k) { const f32x4 a = *(const f32x4*)(cw + (size_t)k * F2 + col), a2 = *(const f32x4*)(cw + (size_t)k * F2 + col + 4);
                        const f32x4 g = *(const f32x4*)(cw + (size_t)k * F2 + FH + col), g2 = *(const f32x4*)(cw + (size_t)k * F2 + FH + col + 4);
#pragma unroll
                        for (int i = 0; i < 4; ++i) { wv[k][i] = a[i]; wv[k][4 + i] = a2[i]; wg[k][i] = g[i]; wg[k][4 + i] = g2[i]; } }
                    { const f32x4 a = *(const f32x4*)(cb + col), a2 = *(const f32x4*)(cb + col + 4), g = *(const f32x4*)(cb + FH + col), g2 = *(const f32x4*)(cb + FH + col + 4);
#pragma unroll
                      for (int i = 0; i < 4; ++i) { bv[i] = a[i]; bv[4 + i] = a2[i]; bg[i] = g[i]; bg[4 + i] = g2[i]; } }
                    float v2[8], v1[8], g2_[8], g1_[8];
                    if (t0 > 0) {
                        unpack8(*(const u32x4*)(U + (size_t)(r0 - 2) * F2 + col), v2); unpack8(*(const u32x4*)(U + (size_t)(r0 - 1) * F2 + col), v1);
                        unpack8(*(const u32x4*)(U + (size_t)(r0 - 2) * F2 + FH + col), g2_); unpack8(*(const u32x4*)(U + (size_t)(r0 - 1) * F2 + FH + col), g1_);
                    } else if (!prompt) {
                        const float* s0 = cst + ((size_t)b * 2) * F2 + col; const float* s1 = s0 + F2;
#pragma unroll
                        for (int i = 0; i < 8; ++i) { v2[i] = s0[i]; v1[i] = s1[i]; g2_[i] = s0[FH + i]; g1_[i] = s1[FH + i]; }
                    } else {
#pragma unroll
                        for (int i = 0; i < 8; ++i) { v2[i] = 0.f; v1[i] = 0.f; g2_[i] = 0.f; g1_[i] = 0.f; }
                    }
#pragma unroll 1
                    for (int rb = 0; rb < 32; rb += 8) {
                      u32x4 uv_[8], ug_[8];
#pragma unroll
                      for (int j = 0; j < 8; ++j) { uv_[j] = *(const u32x4*)(U + (size_t)(r0 + rb + j) * F2 + col); ug_[j] = *(const u32x4*)(U + (size_t)(r0 + rb + j) * F2 + FH + col); }
#pragma unroll
                      for (int j = 0; j < 8; ++j) {
                        const int r = rb + j;
                        float v0[8], g0[8];
                        unpack8(uv_[j], v0); unpack8(ug_[j], g0);
                        float y[8];
#pragma unroll
                        for (int i = 0; i < 8; ++i) {
                            const float cv = bv[i] + wv[0][i] * v2[i] + wv[1][i] * v1[i] + wv[2][i] * v0[i];
                            const float cg_ = bg[i] + wg[0][i] * g2_[i] + wg[1][i] * g1_[i] + wg[2][i] * g0[i];
                            y[i] = cg_ * sigmoidf_(cg_) * cv;
                            v2[i] = v1[i]; v1[i] = v0[i]; g2_[i] = g1_[i]; g1_[i] = g0[i];
                        }
                        *(u32x4*)(HID + (size_t)(r0 + r) * FH + col) = pack8(y);
                      }
                    }
                }
            }
            fast_grid_barrier((unsigned*)ldp(tab, 40), tab);
            {
                BASES FFN_PTRS
                pg8::Gemm g{HID, WD, MROWS, 2048, FH, 0, 0};
                pg8::StaticOrder S; S.init(g.M, g.N, G, (int)blockIdx.x, g.K, 4);
                pg8::Epi<FRes> E{FRes{X, (float*)(RA + 272 * MiB)}};
                pg8::gemm_phase(ldsl, g, S, E);
                fast_grid_barrier((unsigned*)ldp(tab, 40), tab);
                {
                    PHASE_IDS
                    const float* PART = (const float*)(RA + 272 * MiB); const int ntail = S.nwg - S.nFull;
                    if (S.S > 1) for (int idx = gtid; idx < ntail * 16384; idx += NT) {
                        const int tl = idx >> 14, r = (idx >> 6) & 255, c4 = idx & 63; int pm, pn; S.tile_pmpn(S.nFull + tl, pm, pn);
                        f32x4* xp = (f32x4*)(X + (size_t)(pm * 256 + r) * DM + pn * 256 + c4 * 4); f32x4 acc = *xp;
#pragma unroll
                        for (int part = 0; part < 4; ++part) acc += *(const f32x4*)(PART + (size_t)(part * 32 + tl) * 65536 + r * 256 + c4 * 4);
                        *xp = acc; }
                }
            }
            fast_grid_barrier((unsigned*)ldp(tab, 40), tab);
        }
    }
    {
        PHASE_IDS BASES
        const float* gn = IN(8);
        f32x4 ggr[8];
#pragma unroll
        for (int q = 0; q < 8; ++q) ggr[q] = *((const f32x4*)gn + lane + 64 * q);
        for (int row = gw; row < MROWS; row += NGW) {
            f32x4* xr = (f32x4*)(X + (size_t)row * DM) + lane; f32x4 x[8]; float ss = 0.f;
#pragma unroll
            for (int q = 0; q < 8; ++q) { x[q] = xr[64 * q]; ss += x[q][0] * x[q][0] + x[q][1] * x[q][1] + x[q][2] * x[q][2] + x[q][3] * x[q][3]; }
            const float rs = rsqrtf(wave_sum(ss, lane) * (1.f / DM) + 1e-6f);
#pragma unroll
            for (int q = 0; q < 8; ++q) { const f32x4 gg = ggr[q]; xr[64 * q] = x[q] * rs * gg; }
        }
    }
}

#undef TR
#undef CONVERT_WEIGHTS
extern "C" void kernel_launch(void* const* d_in, const int* in_sizes, int n_in, void* d_out, int out_size, void* d_ws, size_t ws_size, hipStream_t stream) {
    static int grid = 0;
    if (grid == 0) {
        if (n_in != 39 || (size_t)out_size != O_TOTAL || ws_size < WS_END) {
            fprintf(stderr, "kernel_launch: unexpected shapes: n_in %d out %d ws %zu (need %zu)\n", n_in, out_size, ws_size, (size_t)WS_END); grid = -1; return; }
        int dev = 0, cus = 0, per_cu = 0;
        (void)hipGetDevice(&dev);
        (void)hipDeviceGetAttribute(&cus, hipDeviceAttributeMultiprocessorCount, dev);
        if (hipFuncSetAttribute((const void*)fwd_kernel, hipFuncAttributeMaxDynamicSharedMemorySize, LDS_BYTES) != hipSuccess) { fprintf(stderr, "kernel_launch: hipFuncSetAttribute failed\n"); grid = -1; return; }
        if (hipOccupancyMaxActiveBlocksPerMultiprocessor(&per_cu, (const void*)fwd_kernel, 512, LDS_BYTES) != hipSuccess || per_cu < 1) { fprintf(stderr, "kernel_launch: occupancy query says %d\n", per_cu); per_cu = 1; }
        (void)hipGetLastError();
        grid = cus * 1;
        if (grid <= 0) grid = 256;
    }
    if (grid < 0) return;
    P prm{};
    for (int i = 0; i < 39; ++i) prm.in[i] = (const float*)d_in[i];
    prm.out = (float*)d_out; prm.ws = (unsigned char*)d_ws;
    (void)hipMemsetAsync(d_ws, 0, 4096, stream);
    void* args[] = {&prm};
    hipError_t e = hipLaunchCooperativeKernel((const void*)fwd_kernel, dim3(grid), dim3(512), args, LDS_BYTES, stream);
    if (e != hipSuccess) fprintf(stderr, "cooperative launch failed: %s (grid %d)\n", hipGetErrorString(e), grid);
}
```

```cpp
#include <hip/hip_runtime.h>
#include <hip/hip_cooperative_groups.h>
#include <cstdio>
#include <cstdint>
namespace cg = cooperative_groups;

#define LAS __attribute__((address_space(3)))
typedef unsigned short bf16_t;
typedef short bf16x8 __attribute__((ext_vector_type(8)));
typedef float f32x4 __attribute__((ext_vector_type(4)));
typedef float f32x16 __attribute__((ext_vector_type(16)));
typedef unsigned u32x4 __attribute__((ext_vector_type(4)));
typedef unsigned u32x2 __attribute__((ext_vector_type(2)));

constexpr int DM = 2048, MROWS = 17408, MPROMPT = 16384;
constexpr int FH = 5632, F2 = 11264;
constexpr int LDS_BYTES = 147456;
constexpr size_t MiB = 1u << 20;
constexpr size_t WS_WT = 1 * MiB;
constexpr size_t WS_A = 411 * MiB;
constexpr size_t WS_B = 819 * MiB;
constexpr size_t WS_VF = 1227 * MiB;
constexpr size_t WS_END = 1295 * MiB;
constexpr size_t ACT = (size_t)MROWS * DM;
constexpr size_t RW_SZ = (size_t)7168 * 2048 + (size_t)8192 * 256 + (size_t)2048 * 2048;
constexpr size_t GW_SZ = (size_t)6400 * 2048 + (size_t)2048 * 2048;
constexpr size_t FW_SZ = (size_t)11264 * 2048 + (size_t)2048 * 5632;
constexpr size_t GW_OFF = 2 * RW_SZ, FW_OFF = GW_OFF + 2 * GW_SZ;
constexpr size_t O_PSHIFT = 35651584, O_PWKV = 35659776, O_PGLA = 36184064, O_PCONV = 38281216;
constexpr size_t O_SSHIFT = 38461440, O_SWKV = 38526976, O_SGLA = 42721280, O_SCONV = 59498496, O_TOTAL = 60940288;

__device__ __forceinline__ unsigned cvt_pk_bf16(float lo, float hi) { unsigned r; asm volatile("v_cvt_pk_bf16_f32 %0, %1, %2" : "=v"(r) : "v"(lo), "v"(hi)); return r; }
__device__ __forceinline__ float bf2f(bf16_t b) { return __builtin_bit_cast(float, (unsigned)b << 16); }
__device__ __forceinline__ float bflo(unsigned u) { return __builtin_bit_cast(float, u << 16); }
__device__ __forceinline__ float bfhi(unsigned u) { return __builtin_bit_cast(float, u & 0xffff0000u); }
__device__ __forceinline__ void unpack8(u32x4 w, float (&f)[8]) {
    f[0] = bflo(w.x); f[1] = bfhi(w.x); f[2] = bflo(w.y); f[3] = bfhi(w.y); f[4] = bflo(w.z); f[5] = bfhi(w.z); f[6] = bflo(w.w); f[7] = bfhi(w.w);
}
__device__ __forceinline__ u32x4 pack8(const float (&f)[8]) {
    u32x4 w; w.x = cvt_pk_bf16(f[0], f[1]); w.y = cvt_pk_bf16(f[2], f[3]); w.z = cvt_pk_bf16(f[4], f[5]); w.w = cvt_pk_bf16(f[6], f[7]); return w;
}
__device__ __forceinline__ float sigmoidf_(float x) { return 1.f / (1.f + __expf(-x)); }
__device__ __forceinline__ float shx(float v, int lane, int o) { return __builtin_bit_cast(float, __builtin_amdgcn_ds_bpermute((lane ^ o) << 2, __builtin_bit_cast(int, v))); }
__device__ __forceinline__ float wave_sum(float v, int lane) {
#pragma unroll
    for (int o = 1; o < 64; o <<= 1) v += shx(v, lane, o);
    return v;
}
__device__ __forceinline__ float sum8(float v, int lane) { v += shx(v, lane, 1); v += shx(v, lane, 2); v += shx(v, lane, 4); return v; }
__device__ __forceinline__ int crow(int reg, int h) { return (reg & 3) + 8 * (reg >> 2) + 4 * h; }

namespace pg8 {
constexpr int BM = 256, BK = 64, HALF = 128, HTB = HALF * BK * 2, STAGE_BYTES = 8 * HTB, NXCD = 8, WGM = 8;
__host__ __device__ __forceinline__ int lds_byte(int r, int c) { const int st = (r >> 4) * 2 + (c >> 5), rr = r & 15, cc = c & 31, ob = rr * 64 + cc * 2; return st * 1024 + (ob ^ (((ob >> 9) & 1) << 5)); }
__host__ __device__ __forceinline__ void stage_rc(int b, int& R, int& C) { const int st = b / 1024, sb = b % 1024, swz = sb ^ (((sb >> 9) & 1) << 5); R = (st >> 1) * 16 + swz / 64; C = (st & 1) * 32 + (swz % 64) / 2; }
__host__ __device__ __forceinline__ int perm32(int rho) { const int n = rho >> 4, i = rho & 15; return 8 * (i >> 2) + 4 * n + (i & 3); }

struct Unit { int pm, pn, kofs, knt, split; };
struct Gemm { const bf16_t* A; const bf16_t* Bt; int M, N, K; int mode; size_t astride; };
__device__ __forceinline__ const char* a_of(const Gemm& g, int pn) {
    int s = 0;
    if (g.mode == 1) s = pn < 8 ? 0 : pn < 16 ? 2 : pn < 24 ? 3 : pn == 24 ? 1 : pn == 25 ? 4 : pn == 26 ? 5 : 3;
    else if (g.mode == 2) s = pn >> 3;
    return (const char*)g.A + (size_t)s * g.astride;
}
struct StaticOrder {
    int nM, nN, nwg, G, c, nFull, S, ntK, total;
    __device__ __forceinline__ void init(int M, int N, int G_, int c_, int K = 0, int S_ = 1) { nM = M / BM; nN = N / BM; nwg = nM * nN; G = G_; c = c_; ntK = K / BK;
        nFull = (nwg / G) * G; S = S_; if (S_ <= 1 || nFull == nwg) { S = 1; nFull = nwg; } total = nFull + (nwg - nFull) * S; }
    __device__ __forceinline__ bool next(int i, Unit& u) const {
        const long L = (long)i * G + c; if (L >= total) return false;
        int wgid;
        if (L < nFull) { wgid = (int)L; u.kofs = 0; u.knt = ntK; u.split = 0; }
        else { const int j = (int)L - nFull; wgid = nFull + j / S; const int part = j % S; u.knt = ntK / S; u.kofs = part * u.knt * BK; u.split = 1 + part * 32 + j / S; }
        tile_pmpn(wgid, u.pm, u.pn); return true;
    }
    __device__ __forceinline__ void tile_pmpn(int wgid, int& pm, int& pn) const {
        { const int q = nwg / NXCD, r = nwg % NXCD, xcd = wgid % NXCD, off = wgid / NXCD; wgid = (xcd < r ? xcd * (q + 1) : r * (q + 1) + (xcd - r) * q) + off; }
        const int nig = WGM * nN, gid = wgid / nig, fm = gid * WGM, gsz = (nM - fm) < WGM ? (nM - fm) : WGM;
        pm = fm + ((wgid % nig) % gsz); pn = (wgid % nig) / gsz;
    }
};

template <class F> struct Epi {
    static constexpr bool PERM = true;
    F f;
    __device__ __forceinline__ void operator()(const f32x4 (&acc)[2][2][4][2], const Unit& u, int wr, int wc, int fr, int fq) const {
        { int t_ = threadIdx.x; asm volatile("" : "+v"(t_)); const int l_ = t_ & 63, w_ = __builtin_amdgcn_readfirstlane(t_ >> 6); fr = l_ & 15; fq = l_ >> 4; wr = w_ >> 2; wc = w_ & 3; }
        const int row0 = u.pm * BM + wr * 64 + fr, col0 = u.pn * BM + wc * 32 + 8 * fq;
#pragma unroll
        for (int ai = 0; ai < 2; ++ai)
#pragma unroll
            for (int m = 0; m < 4; ++m)
#pragma unroll
                for (int bj = 0; bj < 2; ++bj) f(row0 + ai * HALF + m * 16, col0 + bj * HALF, acc[ai][bj][m][0], acc[ai][bj][m][1], u.split);
    }
};

template <class EpiT>
__device__ __forceinline__ void gemm_phase(LAS unsigned char* lds, const Gemm g, const StaticOrder& S, const EpiT& E) {
    int tid = threadIdx.x; asm volatile("" : "+v"(tid));
    const int wid = __builtin_amdgcn_readfirstlane(tid >> 6), lane = tid & 63, wr = wid >> 2, wc = wid & 3, fr = lane & 15, fq = lane >> 4;
    const int K = g.K;
    unsigned voffA[2], voffB[2];
#pragma unroll
    for (int i = 0; i < 2; ++i) { int R, C; stage_rc(tid * 16 + i * 8192, R, C); const int Rb = EpiT::PERM ? ((R & ~31) + perm32(R & 31)) : R;
        voffA[i] = (unsigned)(R * K + C) * 2u; voffB[i] = (unsigned)(Rb * K + C) * 2u; }
    const size_t kstep = (size_t)(BK * 2);
    const size_t hstep = (size_t)HALF * K * 2;
    const size_t tstep = 2 * hstep;
    const unsigned ldsw = (unsigned)wid * 1024u;
    const int aoff = lds_byte(wr * 64 + fr, fq * 8), boff = lds_byte(wc * 32 + fr, fq * 8);
#define PG8_SA(b, h) (((b) * 2 + (h)) * HTB)
#define PG8_SB(b, h) ((4 + (b) * 2 + (h)) * HTB)
#define PG8_STAGE(bufoff, gbase, voff) do { _Pragma("unroll") for (int _i = 0; _i < 2; ++_i) \
        __builtin_amdgcn_global_load_lds((const unsigned*)((const char*)(gbase) + (voff)[_i]), (LAS unsigned*)(lds + (bufoff) + ldsw + _i * 8192), 16, 0, 0); } while (0)
#define PG8_LDA(dst, b, h) do { _Pragma("unroll") for (int m = 0; m < 4; ++m) _Pragma("unroll") for (int k = 0; k < 2; ++k) dst[m][k] = *(const LAS bf16x8*)(lds + PG8_SA(b, h) + aoff + m * 2048 + k * 1024); } while (0)
#define PG8_LDB(dst, b, h) do { _Pragma("unroll") for (int n = 0; n < 2; ++n) _Pragma("unroll") for (int k = 0; k < 2; ++k) dst[n][k] = *(const LAS bf16x8*)(lds + PG8_SB(b, h) + boff + n * 2048 + k * 1024); } while (0)
#define PG8_MMA(ai, bj, At, Bt) do { __builtin_amdgcn_s_setprio(1); _Pragma("unroll") for (int m = 0; m < 4; ++m) _Pragma("unroll") for (int n = 0; n < 2; ++n) _Pragma("unroll") for (int k = 0; k < 2; ++k) \
        acc[ai][bj][m][n] = __builtin_amdgcn_mfma_f32_16x16x32_bf16(Bt[n][k], At[m][k], acc[ai][bj][m][n], 0, 0, 0); __builtin_amdgcn_s_setprio(0); } while (0)
#define PG8_WAIT_V(n) asm volatile("s_waitcnt vmcnt(" #n ")" ::: "memory")
#define PG8_WAIT_L(n) asm volatile("s_waitcnt lgkmcnt(" #n ")" ::: "memory")
#define PG8_BAR __builtin_amdgcn_s_barrier()
#define PG8_SCHED __builtin_amdgcn_sched_barrier(0)
    Unit cur, nxt; int ui = 0;
    if (!S.next(0, cur)) return;
    f32x4 acc[2][2][4][2];
#pragma unroll
    for (int a = 0; a < 2; ++a)
#pragma unroll
        for (int b = 0; b < 2; ++b)
#pragma unroll
            for (int m = 0; m < 4; ++m)
#pragma unroll
                for (int n = 0; n < 2; ++n) acc[a][b][m][n] = (f32x4){0.f, 0.f, 0.f, 0.f};
    bf16x8 At[4][2], B0[2][2], B1[2][2];
    const char* cA = a_of(g, cur.pn) + (size_t)cur.pm * tstep + (size_t)cur.kofs * 2; const char* cB = (const char*)g.Bt + (size_t)cur.pn * tstep + (size_t)cur.kofs * 2;
    PG8_STAGE(PG8_SB(0, 0), cB, voffB); PG8_STAGE(PG8_SB(0, 1), cB + hstep, voffB); PG8_STAGE(PG8_SA(0, 0), cA, voffA); PG8_STAGE(PG8_SA(0, 1), cA + hstep, voffA);
    if (wr == 1) PG8_BAR;
    PG8_WAIT_V(2); PG8_BAR;
    PG8_STAGE(PG8_SB(1, 0), cB + kstep, voffB); PG8_STAGE(PG8_SA(1, 0), cA + kstep, voffA); PG8_STAGE(PG8_SB(1, 1), cB + hstep + kstep, voffB);
    PG8_WAIT_V(6); PG8_BAR;
    for (;;) {
        const bool has_next = S.next(ui + 1, nxt);
        const char* nA = has_next ? a_of(g, nxt.pn) + (size_t)nxt.pm * tstep + (size_t)nxt.kofs * 2 : cA; const char* nB = has_next ? (const char*)g.Bt + (size_t)nxt.pn * tstep + (size_t)nxt.kofs * 2 : cB;
        const int nt = cur.knt;
        for (int t = 0; t < nt; t += 2) {
            const bool last = (t == nt - 2);
            const char* a1 = cA + (size_t)(t + 1) * kstep;
            const char* a2 = last ? nA : cA + (size_t)(t + 2) * kstep; const char* b2 = last ? nB : cB + (size_t)(t + 2) * kstep;
            const char* a3 = a2 + kstep; const char* b3 = b2 + kstep;
            PG8_LDB(B0, 0, 0); PG8_LDB(B1, 0, 1); PG8_SCHED; PG8_LDA(At, 0, 0); PG8_STAGE(PG8_SA(1, 1), a1 + hstep, voffA);
            PG8_WAIT_V(8); PG8_WAIT_L(0); PG8_BAR; PG8_MMA(0, 0, At, B0); PG8_MMA(0, 1, At, B1); PG8_BAR; PG8_SCHED;
            PG8_LDA(At, 0, 1); PG8_STAGE(PG8_SB(0, 0), b2, voffB); PG8_STAGE(PG8_SB(0, 1), b2 + hstep, voffB); PG8_STAGE(PG8_SA(0, 0), a2, voffA);
            PG8_WAIT_V(8); PG8_WAIT_L(0); PG8_BAR; PG8_MMA(1, 0, At, B0); PG8_MMA(1, 1, At, B1); PG8_BAR; PG8_SCHED;
            PG8_LDB(B0, 1, 0); PG8_LDB(B1, 1, 1); PG8_SCHED; PG8_LDA(At, 1, 0); PG8_STAGE(PG8_SA(0, 1), a2 + hstep, voffA);
            PG8_WAIT_V(8); PG8_WAIT_L(0); PG8_BAR; PG8_MMA(0, 0, At, B0); PG8_MMA(0, 1, At, B1); PG8_BAR; PG8_SCHED;
            PG8_LDA(At, 1, 1); PG8_STAGE(PG8_SB(1, 0), b3, voffB); PG8_STAGE(PG8_SB(1, 1), b3 + hstep, voffB); PG8_STAGE(PG8_SA(1, 0), a3, voffA);
            PG8_WAIT_V(8); PG8_WAIT_L(0); PG8_BAR; PG8_MMA(1, 0, At, B0); PG8_MMA(1, 1, At, B1); PG8_BAR; PG8_SCHED;
        }
        if (wr == 0) PG8_BAR;
        E(acc, cur, wr, wc, fr, fq);
        if (!has_next) break;
#pragma unroll
        for (int a = 0; a < 2; ++a)
#pragma unroll
            for (int b = 0; b < 2; ++b)
#pragma unroll
                for (int m = 0; m < 4; ++m)
#pragma unroll
                    for (int n = 0; n < 2; ++n) acc[a][b][m][n] = (f32x4){0.f, 0.f, 0.f, 0.f};
        cur = nxt; cA = nA; cB = nB; ++ui;
        if (wr == 1) PG8_BAR;
    }
    PG8_WAIT_V(0);
    PG8_BAR;
#undef PG8_SA
#undef PG8_SB
#undef PG8_STAGE
#undef PG8_LDA
#undef PG8_LDB
#undef PG8_MMA
#undef PG8_WAIT_V
#undef PG8_WAIT_L
#undef PG8_BAR
#undef PG8_SCHED
}
}

__device__ __forceinline__ void store8bf(bf16_t* p, f32x4 a, f32x4 b) {
    u32x4 w; w.x = cvt_pk_bf16(a[0], a[1]); w.y = cvt_pk_bf16(a[2], a[3]); w.z = cvt_pk_bf16(b[0], b[1]); w.w = cvt_pk_bf16(b[2], b[3]);
    *(u32x4*)p = w;
}
struct FRes { float* X; float* PART;
    __device__ __forceinline__ void operator()(int row, int col, f32x4 a, f32x4 b, int split) const {
        float* p = X + (size_t)row * DM + col;
        if (split) { float* q = PART + (size_t)(split - 1) * 65536 + (row & 255) * 256 + (col & 255); *(f32x4*)q = a; *(f32x4*)(q + 4) = b; }
        else { f32x4 x0 = *(f32x4*)p, x1 = *(f32x4*)(p + 4); *(f32x4*)p = x0 + a; *(f32x4*)(p + 4) = x1 + b; } } };
struct FR1 { bf16_t *R, *K, *V, *L;
    __device__ __forceinline__ void operator()(int row, int col, f32x4 a, f32x4 b, int) const {
        if (col < 6144) { const int g = col >> 11; const size_t o = (size_t)row * DM + (col & 2047); if (g == 0) store8bf(R + o, a, b); else if (g == 1) store8bf(K + o, a, b); else store8bf(V + o, a, b); }
        else { const int t = (col - 6144) >> 8, c = col & 255;
            if (t == 0) { for (int i = 0; i < 4; ++i) { a[i] = 1.f - 2.f / (1.f + __expf(2.f * a[i])); b[i] = 1.f - 2.f / (1.f + __expf(2.f * b[i])); } }
            else if (t == 2) { for (int i = 0; i < 4; ++i) { a[i] = sigmoidf_(a[i]); b[i] = sigmoidf_(b[i]); } }
            store8bf(L + (size_t)t * MROWS * 256 + (size_t)row * 256 + c, a, b); } } };
__device__ __forceinline__ float decay_of(float z) { return -0.60653065971f / (1.f + __expf(-z)); }
struct FR2 { float* DD; bf16_t *AA, *GG, *VG; const float *w0, *a0, *v0;
    __device__ __forceinline__ void operator()(int row, int col, f32x4 a, f32x4 b, int) const {
        const int g = col >> 11, c = col & 2047; const size_t off = (size_t)row * DM + c;
        if (g == 0) { f32x4 z0 = *(const f32x4*)(w0 + c), z1 = *(const f32x4*)(w0 + c + 4); a += z0; b += z1;
            for (int i = 0; i < 4; ++i) { a[i] = decay_of(a[i]); b[i] = decay_of(b[i]); }
            *(f32x4*)(DD + off) = a; *(f32x4*)(DD + off + 4) = b; }
        else if (g == 1) { f32x4 z0 = *(const f32x4*)(a0 + c), z1 = *(const f32x4*)(a0 + c + 4); a += z0; b += z1;
            for (int i = 0; i < 4; ++i) { a[i] = sigmoidf_(a[i]); b[i] = sigmoidf_(b[i]); } store8bf(AA + off, a, b); }
        else if (g == 2) { store8bf(GG + off, a, b); }
        else { f32x4 z0 = *(const f32x4*)(v0 + c), z1 = *(const f32x4*)(v0 + c + 4); a += z0; b += z1;
            for (int i = 0; i < 4; ++i) { a[i] = sigmoidf_(a[i]); b[i] = sigmoidf_(b[i]); } store8bf(VG + off, a, b); } } };
struct FG1 { bf16_t* PROJ; float* LR;
    __device__ __forceinline__ void operator()(int row, int col, f32x4 a, f32x4 b, int) const {
        if (col < 6144) { if (col < 1024) { a *= 0.0625f; b *= 0.0625f; } store8bf(PROJ + (size_t)row * 6144 + col, a, b); }
        else if (col < 6160) { float* p = LR + (size_t)row * 16 + (col - 6144); *(f32x4*)p = a; *(f32x4*)(p + 4) = b; } } };
struct FUp { bf16_t* U; float* pconv; float* sconv;
    __device__ __forceinline__ void operator()(int row, int col, f32x4 a, f32x4 b, int) const {
        store8bf(U + (size_t)row * F2 + col, a, b);
        if (row < MPROMPT) { const int t = row & 8191; if (t >= 8190) { float* p = pconv + ((size_t)((row >> 13) * 2 + (t - 8190))) * F2 + col; *(f32x4*)p = a; *(f32x4*)(p + 4) = b; } }
        else { const int rr = row - MPROMPT, t = rr & 63; if (t >= 62) { float* p = sconv + ((size_t)((rr >> 6) * 2 + (t - 62))) * F2 + col; *(f32x4*)p = a; *(f32x4*)(p + 4) = b; } } } };

__device__ __forceinline__ void tr_item(const float* W, int K, int N, bf16_t* WT, int Kpad, int Npad, float* scr, int item, int lane) {
    const int nblk = Npad / 64, kb = item / nblk, nb = item % nblk, k0 = 64 * kb, n0 = 64 * nb;
    const int n4 = n0 + (lane & 15) * 4;
    f32x4 v[16];
#pragma unroll
    for (int i = 0; i < 16; ++i) { const int k = k0 + 4 * i + (lane >> 4); v[i] = (k < K && n4 < N) ? *(const f32x4*)(W + (size_t)k * N + n4) : (f32x4){0.f, 0.f, 0.f, 0.f}; }
#pragma unroll
    for (int i = 0; i < 16; ++i) { float* d = scr + (4 * i + (lane >> 4)) * 65 + (lane & 15) * 4; d[0] = v[i][0]; d[1] = v[i][1]; d[2] = v[i][2]; d[3] = v[i][3]; }
    asm volatile("s_waitcnt lgkmcnt(0)" ::: "memory");
    const int c = lane & 7;
#pragma unroll
    for (int j = 0; j < 8; ++j) { const int nn = (lane >> 3) + 8 * j; const float* s = scr + (8 * c) * 65 + nn;
        u32x4 o; o.x = cvt_pk_bf16(s[0 * 65], s[1 * 65]); o.y = cvt_pk_bf16(s[2 * 65], s[3 * 65]); o.z = cvt_pk_bf16(s[4 * 65], s[5 * 65]); o.w = cvt_pk_bf16(s[6 * 65], s[7 * 65]);
        *(u32x4*)(WT + (size_t)(n0 + nn) * Kpad + k0 + 8 * c) = o; }
    asm volatile("s_waitcnt lgkmcnt(0)" ::: "memory");
}

struct P { const float* in[39]; float* out; unsigned char* ws; };

__device__ __forceinline__ void row_info(int row, int& t, int& len, int& b, bool& prompt) {
    if (row < MPROMPT) { prompt = true; b = row >> 13; t = row & 8191; len = 8192; }
    else { prompt = false; const int rr = row - MPROMPT; b = rr >> 6; t = rr & 63; len = 64; }
}

__device__ __forceinline__ const float* ldp(const unsigned long long* tab, int i) {
    const unsigned long long v = tab[i];
    const unsigned lo = __builtin_amdgcn_readfirstlane((unsigned)v), hi = __builtin_amdgcn_readfirstlane((unsigned)(v >> 32));
    const __attribute__((address_space(1))) float* g = (const __attribute__((address_space(1))) float*)(((unsigned long long)hi << 32) | lo);
    return (const float*)g;
}
__device__ __forceinline__ void fast_grid_barrier(unsigned* bar, unsigned long long* tab) {
    asm volatile("s_waitcnt vmcnt(0)" ::: "memory");
    __syncthreads();
    if (threadIdx.x == 0) {
        const unsigned G = gridDim.x, grp = blockIdx.x & 7u;
        const unsigned epoch = (unsigned)tab[41] + 1u; tab[41] = epoch;
        const unsigned ngrp = (G - grp + 7u) >> 3, ntop = G < 8u ? G : 8u;
        __builtin_amdgcn_fence(__ATOMIC_RELEASE, "agent");
        asm volatile("s_waitcnt vmcnt(0)" ::: "memory");
        const unsigned old = __hip_atomic_fetch_add(&bar[64u * (1u + grp)], 1u, __ATOMIC_RELAXED, __HIP_MEMORY_SCOPE_AGENT);
        if (old + 1u == epoch * ngrp) (void)__hip_atomic_fetch_add(&bar[0], 1u, __ATOMIC_RELAXED, __HIP_MEMORY_SCOPE_AGENT);
        while (__hip_atomic_load(&bar[0], __ATOMIC_RELAXED, __HIP_MEMORY_SCOPE_AGENT) < epoch * ntop) __builtin_amdgcn_s_sleep(1);
        __builtin_amdgcn_fence(__ATOMIC_ACQUIRE, "agent");
        asm volatile("s_waitcnt vmcnt(0)" ::: "memory");
    }
    __syncthreads();
}
#define IN(k) ldp(tab, (k))
#define OUTP ((float*)ldp(tab, 39))
#define BASES float* X = (float*)ldp(tab, 39); unsigned char* ws_ = (unsigned char*)ldp(tab, 40); bf16_t* WT = (bf16_t*)(ws_ + WS_WT); unsigned char* RA = ws_ + WS_A; unsigned char* RB = ws_ + WS_B; \
    bf16_t* VFIRST = (bf16_t*)(ws_ + WS_VF); LAS unsigned char* ldsl = (LAS unsigned char*)lds; (void)X; (void)WT; (void)RA; (void)RB; (void)VFIRST; (void)ldsl;
#define RWKV_PTRS bf16_t* HB = (bf16_t*)RA; bf16_t* Rb = (bf16_t*)RB; bf16_t* Kb = Rb + ACT; bf16_t* Vb = (jl == 0) ? VFIRST : Kb + ACT; bf16_t* Lb = (bf16_t*)(RB + 204 * MiB); \
    float* DD = (float*)(RB + 240 * MiB); bf16_t* AA = (bf16_t*)RA; bf16_t* VG = AA + ACT; bf16_t* GG = VG + ACT; bf16_t* Y = GG + ACT; \
    bf16_t* W1 = WT + jl * RW_SZ; bf16_t* W2 = W1 + (size_t)7168 * 2048; bf16_t* WO = W2 + (size_t)8192 * 256; \
    (void)HB; (void)Rb; (void)Kb; (void)Vb; (void)Lb; (void)DD; (void)AA; (void)VG; (void)GG; (void)Y; (void)W1; (void)W2; (void)WO;
#define GLA_PTRS bf16_t* H = (bf16_t*)RB; float* LR = (float*)(RB + 68 * MiB); float* O = (float*)(RB + 70 * MiB); bf16_t* Y = (bf16_t*)(RB + 206 * MiB); \
    bf16_t* PROJ = (bf16_t*)RA; bf16_t* QE = (bf16_t*)(RA + 204 * MiB); bf16_t* KDT = (bf16_t*)(RA + 238 * MiB); bf16_t* VT = (bf16_t*)(RA + 272 * MiB); \
    bf16_t* SC = (bf16_t*)(RA + 340 * MiB); float* EL = (float*)(RA + 349 * MiB); bf16_t* GI = WT + GW_OFF + jl * GW_SZ; bf16_t* GO = GI + (size_t)6400 * 2048; \
    (void)H; (void)LR; (void)O; (void)Y; (void)PROJ; (void)QE; (void)KDT; (void)VT; (void)SC; (void)EL; (void)GI; (void)GO;
#define FFN_PTRS bf16_t* H = (bf16_t*)RB; bf16_t* HID = (bf16_t*)(RB + 68 * MiB); bf16_t* U = (bf16_t*)RA; bf16_t* WU = WT + FW_OFF + layer * FW_SZ; bf16_t* WD = WU + (size_t)F2 * 2048; \
    (void)H; (void)HID; (void)U; (void)WU; (void)WD;

__global__ void __launch_bounds__(512, 2) fwd_kernel(P p) {
    extern __shared__ __attribute__((aligned(16))) unsigned char lds[];
    cg::grid_group grid = cg::this_grid();
    const int G = gridDim.x, NGW = G * 8, NT = G * 512;
#define PHASE_IDS int tid = threadIdx.x; asm volatile("" : "+v"(tid)); const int lane = tid & 63; const int wave = __builtin_amdgcn_readfirstlane(tid >> 6); const int gw = blockIdx.x * 8 + wave; const int gtid = blockIdx.x * 512 + tid; (void)lane; (void)gw; (void)gtid;
    unsigned long long* tab = (unsigned long long*)(lds + LDS_BYTES - 512);
    if (threadIdx.x == 0) {
#pragma unroll
        for (int i = 0; i < 39; ++i) tab[i] = (unsigned long long)p.in[i];
        tab[39] = (unsigned long long)p.out; tab[40] = (unsigned long long)p.ws; tab[41] = 0ull;
    }
    __syncthreads();

    {
        PHASE_IDS BASES
        if (blockIdx.x == 0) { for (int i = tid; i < 1024; i += 512) ((unsigned*)ws_)[i] = 0u; }
        float* scr = (float*)(lds + wave * 16896);
#define TR(src, K, N, dst, Kpad, Npad) do { const int _ni = ((Kpad) / 64) * ((Npad) / 64); for (int it = cgw_; it < _ni; it += cngw_) tr_item((src), (K), (N), (dst), (Kpad), (Npad), scr, it, lane); } while (0)
#define CONVERT_WEIGHTS(JLO, JHI, ILO, IHI, GWV, NGWV) do { const int cgw_ = (GWV), cngw_ = (NGWV); \
        _Pragma("unroll 1") for (int j = (JLO); j < (JHI); ++j) { \
            bf16_t* W1 = WT + j * RW_SZ; bf16_t* W2 = W1 + (size_t)7168 * 2048; bf16_t* WO = W2 + (size_t)8192 * 256; \
            TR(IN(24) + (size_t)j * DM * DM, 2048, 2048, W1, 2048, 2048); \
            TR(IN(25) + (size_t)j * DM * DM, 2048, 2048, W1 + (size_t)2048 * 2048, 2048, 2048); \
            TR(IN(26) + (size_t)j * DM * DM, 2048, 2048, W1 + (size_t)4096 * 2048, 2048, 2048); \
            TR(IN(11) + (size_t)j * DM * 96, 2048, 96, W1 + (size_t)6144 * 2048, 2048, 256); \
            TR(IN(14) + (size_t)j * DM * 96, 2048, 96, W1 + (size_t)6400 * 2048, 2048, 256); \
            TR(IN(19) + (size_t)j * DM * 256, 2048, 256, W1 + (size_t)6656 * 2048, 2048, 256); \
            if (j >= 1) TR(IN(17) + (size_t)(j - 1) * DM * 64, 2048, 64, W1 + (size_t)6912 * 2048, 2048, 256); \
            TR(IN(12) + (size_t)j * 96 * DM, 96, 2048, W2, 256, 2048); \
            TR(IN(15) + (size_t)j * 96 * DM, 96, 2048, W2 + (size_t)2048 * 256, 256, 2048); \
            TR(IN(20) + (size_t)j * 256 * DM, 256, 2048, W2 + (size_t)4096 * 256, 256, 2048); \
            if (j >= 1) TR(IN(18) + (size_t)(j - 1) * 64 * DM, 64, 2048, W2 + (size_t)6144 * 256, 256, 2048); \
            TR(IN(27) + (size_t)j * DM * DM, 2048, 2048, WO, 2048, 2048); \
            bf16_t* GI = WT + GW_OFF + j * GW_SZ; bf16_t* GO = GI + (size_t)6400 * 2048; \
            TR(IN(30) + (size_t)j * DM * 6160, 2048, 6160, GI, 2048, 6400); \
            TR(IN(34) + (size_t)j * DM * DM, 2048, 2048, GO, 2048, 2048); \
        } \
        _Pragma("unroll 1") for (int i = (ILO); i < (IHI); ++i) { \
            bf16_t* WU = WT + FW_OFF + i * FW_SZ; bf16_t* WD = WU + (size_t)F2 * 2048; \
            TR(IN(35) + (size_t)i * DM * F2, 2048, F2, WU, 2048, F2); \
            TR(IN(38) + (size_t)i * FH * DM, FH, 2048, WD, FH, 2048); \
        } } while (0)
        if (G >= 256) CONVERT_WEIGHTS(0, 1, 0, 2, gw, NGW); else CONVERT_WEIGHTS(0, 2, 0, 4, gw, NGW);
        const f32x4* xp = (const f32x4*)IN(0); const f32x4* xs = (const f32x4*)IN(1); f32x4* xo = (f32x4*)X;
        const int NP4 = MPROMPT * DM / 4, NA4 = MROWS * DM / 4;
#pragma unroll 4
        for (int i = gtid; i < NA4; i += NT) xo[i] = i < NP4 ? xp[i] : xs[i - NP4];
    }
    grid.sync();

#pragma clang loop unroll(full)
    for (int layer = 0; layer < 4; ++layer) {
        const int jl = layer >> 1;
        if ((layer & 1) == 0) {
            {
                PHASE_IDS BASES RWKV_PTRS
                const float* gmix = IN(6) + (size_t)layer * DM;
                const float* mix = IN(9) + (size_t)jl * 6 * DM;
                const float* sst = IN(2) + (size_t)jl * 16 * DM;
                float* mixS = (float*)lds; float* gS = mixS + 6 * DM;
                for (int i = tid; i < 6 * DM / 4; i += 512) *(f32x4*)(mixS + i * 4) = *(const f32x4*)(mix + i * 4);
                for (int i = tid; i < DM / 4; i += 512) *(f32x4*)(gS + i * 4) = *(const f32x4*)(gmix + i * 4);
                __syncthreads();
                for (int row = gw; row < MROWS; row += NGW) {
                    int t, len, b; bool prompt; row_info(row, t, len, b, prompt);
                    const f32x4* xr = (const f32x4*)(X + (size_t)row * DM) + lane;
                    f32x4 x[8]; float ss = 0.f;
#pragma unroll
                    for (int q = 0; q < 8; ++q) { x[q] = xr[64 * q]; ss += x[q][0] * x[q][0] + x[q][1] * x[q][1] + x[q][2] * x[q][2] + x[q][3] * x[q][3]; }
                    const float rs = rsqrtf(wave_sum(ss, lane) * (1.f / DM) + 1e-6f);
                    f32x4 hp[8];
                    if (t > 0) {
                        const f32x4* xq = (const f32x4*)(X + (size_t)(row - 1) * DM) + lane; float s2 = 0.f;
#pragma unroll
                        for (int q = 0; q < 8; ++q) { hp[q] = xq[64 * q]; s2 += hp[q][0] * hp[q][0] + hp[q][1] * hp[q][1] + hp[q][2] * hp[q][2] + hp[q][3] * hp[q][3]; }
                        const float rp = rsqrtf(wave_sum(s2, lane) * (1.f / DM) + 1e-6f);
#pragma unroll
                        for (int q = 0; q < 8; ++q) { const f32x4 gg = *((const f32x4*)gS + lane + 64 * q); hp[q] = hp[q] * rp * gg; }
                    } else if (!prompt) {
#pragma unroll
                        for (int q = 0; q < 8; ++q) hp[q] = *((const f32x4*)(sst + (size_t)b * DM) + lane + 64 * q);
                    } else {
#pragma unroll
                        for (int q = 0; q < 8; ++q) hp[q] = (f32x4){0.f, 0.f, 0.f, 0.f};
                    }
                    const bool lastrow = (t == len - 1);
                    float* shout = OUTP + (prompt ? O_PSHIFT + ((size_t)jl * 2 + b) * DM : O_SSHIFT + ((size_t)jl * 16 + b) * DM);
#pragma unroll
                    for (int q = 0; q < 8; ++q) {
                        const f32x4 gg = *((const f32x4*)gS + lane + 64 * q);
                        const f32x4 h = x[q] * rs * gg; const f32x4 dlt = hp[q] - h;
                        if (lastrow) *((f32x4*)shout + lane + 64 * q) = h;
#pragma unroll
                        for (int m = 0; m < 6; ++m) {
                            const f32x4 mx = *((const f32x4*)(mixS + m * DM) + lane + 64 * q);
                            const f32x4 o = h + dlt * mx;
                            u32x2 w; w.x = cvt_pk_bf16(o[0], o[1]); w.y = cvt_pk_bf16(o[2], o[3]);
                            *((u32x2*)(HB + (size_t)m * ACT + (size_t)row * DM) + lane + 64 * q) = w;
                        }
                    }
                }
            }
            fast_grid_barrier((unsigned*)ldp(tab, 40), tab);
            {
                BASES RWKV_PTRS
                pg8::Gemm g{HB, W1, MROWS, jl == 0 ? 6912 : 7168, 2048, 1, ACT * 2};
                pg8::StaticOrder S; S.init(g.M, g.N, G, (int)blockIdx.x, g.K, 1);
                pg8::Epi<FR1> E{FR1{Rb, Kb, Vb, Lb}};
                pg8::gemm_phase(ldsl, g, S, E);
            }
            fast_grid_barrier((unsigned*)ldp(tab, 40), tab);
            {
                BASES RWKV_PTRS
                pg8::Gemm g{Lb, W2, MROWS, jl == 0 ? 6144 : 8192, 256, 2, (size_t)MROWS * 256 * 2};
                pg8::StaticOrder S; S.init(g.M, g.N, G, (int)blockIdx.x, g.K, 1);
                pg8::Epi<FR2> E{FR2{DD, AA, GG, VG, IN(10) + (size_t)jl * DM, IN(13) + (size_t)jl * DM, IN(16) + (size_t)(jl > 0 ? jl - 1 : 0) * DM}};
                pg8::gemm_phase(ldsl, g, S, E);
            }
            fast_grid_barrier((unsigned*)ldp(tab, 40), tab);
            {
                PHASE_IDS BASES RWKV_PTRS
                float* Obuf = (float*)(RA + 272 * MiB); float* RK = (float*)(RB + 204 * MiB); float* DTg = (float*)(RB + 208 * MiB);
                const float* k_k = IN(21) + (size_t)jl * DM; const float* k_a = IN(22) + (size_t)jl * DM; const float* r_k = IN(23) + (size_t)jl * DM;
                const int l32 = lane & 31, hl = lane >> 5;
#define S1_BAR do { asm volatile("s_waitcnt lgkmcnt(0)" ::: "memory"); __builtin_amdgcn_s_barrier(); asm volatile("" ::: "memory"); } while (0)
                const int st = tid >> 3, c0 = (tid & 7) * 8;
                u32x4 pr_, pk_, pv_, pa_, pvf_ = (u32x4){0u, 0u, 0u, 0u}, pvg_ = (u32x4){0u, 0u, 0u, 0u}; f32x4 pd0_, pd1_;
#define S1_FETCH(it) do { const size_t _off = (size_t)(((it) >> 5) * 64 + st) * DM + ((it) & 31) * 64 + c0; \
                    pr_ = *(const u32x4*)(Rb + _off); pk_ = *(const u32x4*)(Kb + _off); pv_ = *(const u32x4*)(Vb + _off); pa_ = *(const u32x4*)(AA + _off); \
                    pd0_ = *(const f32x4*)(DD + _off); pd1_ = *(const f32x4*)(DD + _off + 4); \
                    if (jl > 0) { pvf_ = *(const u32x4*)(VFIRST + _off); pvg_ = *(const u32x4*)(VG + _off); } } while (0)
#pragma unroll 1
                for (int item = blockIdx.x; item < 8704; item += G) {
                    LAS unsigned char* ldsv = (LAS unsigned char*)lds; asm volatile("" : "+v"(ldsv));
                    LAS bf16_t* AH = (LAS bf16_t*)(ldsv + 0); LAS bf16_t* RH = (LAS bf16_t*)(ldsv + 9216); LAS bf16_t* BH = (LAS bf16_t*)(ldsv + 18432); LAS bf16_t* KH = (LAS bf16_t*)(ldsv + 27648);
                    LAS bf16_t* BHT = (LAS bf16_t*)(ldsv + 36864); LAS bf16_t* KHT = (LAS bf16_t*)(ldsv + 46080); LAS bf16_t* VTs = (LAS bf16_t*)(ldsv + 55296); LAS bf16_t* XT = (LAS bf16_t*)(ldsv + 64512);
                    LAS float* AAB = (LAS float*)(ldsv + 82944); LAS bf16_t* AAK = (LAS bf16_t*)(ldsv + 99328); LAS bf16_t* ARB = (LAS bf16_t*)(ldsv + 108544); LAS bf16_t* ARK = (LAS bf16_t*)(ldsv + 117760);
                    LAS float* LB = (LAS float*)(ldsv + 126976); LAS float* DTS = (LAS float*)(ldsv + 143360);
                    (void)RH; (void)KH; (void)KHT;
                    const int chunk = item >> 5, h = item & 31, r0 = chunk * 64;
                    const int col = h * 64 + c0;
                    S1_FETCH(item);
                    float r[8], kk[8], bb[8], km[8], ld[8];
                    {
                        float k[8], v[8], a[8];
                        unpack8(pr_, r); unpack8(pk_, k); unpack8(pv_, v); unpack8(pa_, a);
                        const f32x4 d0 = pd0_, d1 = pd1_;
                        ld[0] = d0[0]; ld[1] = d0[1]; ld[2] = d0[2]; ld[3] = d0[3]; ld[4] = d1[0]; ld[5] = d1[1]; ld[6] = d1[2]; ld[7] = d1[3];
                        if (jl > 0) { float vf[8], vg[8]; unpack8(pvf_, vf); unpack8(pvg_, vg);
#pragma unroll
                            for (int i = 0; i < 8; ++i) v[i] = v[i] + (vf[i] - v[i]) * vg[i]; }
                        float ss = 0.f;
#pragma unroll
                        for (int i = 0; i < 8; ++i) { kk[i] = k[i] * k_k[col + i]; ss += kk[i] * kk[i]; }
                        ss = sum8(ss, lane);
                        const float inv = 1.f / fmaxf(sqrtf(ss), 1e-12f);
                        float rk = 0.f;
#pragma unroll
                        for (int i = 0; i < 8; ++i) { kk[i] *= inv; bb[i] = kk[i] * a[i]; km[i] = k[i] * (1.f + (a[i] - 1.f) * k_a[col + i]); rk += r[i] * km[i] * r_k[col + i]; }
                        rk = sum8(rk, lane);
                        if ((tid & 7) == 0) RK[(size_t)(r0 + st) * 32 + h] = rk;
                        *(LAS f32x4*)(LB + st * 64 + c0) = d0; *(LAS f32x4*)(LB + st * 64 + c0 + 4) = d1;
#pragma unroll
                        for (int i = 0; i < 8; i += 2) { const unsigned pk = cvt_pk_bf16(v[i], v[i + 1]); VTs[(c0 + i) * 72 + st] = (bf16_t)(pk & 0xffffu); VTs[(c0 + i + 1) * 72 + st] = (bf16_t)(pk >> 16); }
                    }
                    S1_BAR;
                    {
                        const int cc_ = tid & 63, tq_ = tid >> 6; float pf[8]; float run = 0.f;
#pragma unroll
                        for (int j = 0; j < 8; ++j) { run += LB[(8 * tq_ + j) * 64 + cc_]; pf[j] = run; }
                        AAB[tq_ * 64 + cc_] = run;
                        S1_BAR;
                        float ofs = 0.f;
#pragma unroll
                        for (int g = 0; g < 7; ++g) ofs += (g < tq_) ? AAB[g * 64 + cc_] : 0.f;
#pragma unroll
                        for (int j = 0; j < 8; ++j) LB[(8 * tq_ + j) * 64 + cc_] = pf[j] + ofs;
                    }
                    S1_BAR;
                    {
                        float ah[8], bh[8], kh[8], rh[8];
#pragma unroll
                        for (int i = 0; i < 8; ++i) { const float Lt = LB[st * 64 + c0 + i]; const float e3 = __expf(Lt), e2 = __expf(-Lt), e1 = __expf(Lt - ld[i]);
                            ah[i] = -kk[i] * e1; bh[i] = bb[i] * e2; kh[i] = km[i] * e2; rh[i] = r[i] * e3;
                            if (st == 63) { DTS[c0 + i] = e3; DTg[(size_t)item * 64 + c0 + i] = e3; } }
                        *(LAS u32x4*)(AH + st * 72 + c0) = pack8(ah); *(LAS u32x4*)(RH + st * 72 + c0) = pack8(rh);
                        *(LAS u32x4*)(BH + st * 72 + c0) = pack8(bh); *(LAS u32x4*)(KH + st * 72 + c0) = pack8(kh);
#pragma unroll
                        for (int i = 0; i < 8; i += 2) { const unsigned p1 = cvt_pk_bf16(bh[i], bh[i + 1]), p2 = cvt_pk_bf16(kh[i], kh[i + 1]);
                            BHT[(c0 + i) * 72 + st] = (bf16_t)(p1 & 0xffffu); BHT[(c0 + i + 1) * 72 + st] = (bf16_t)(p1 >> 16);
                            KHT[(c0 + i) * 72 + st] = (bf16_t)(p2 & 0xffffu); KHT[(c0 + i + 1) * 72 + st] = (bf16_t)(p2 >> 16); }
                    }
                    S1_BAR;
                    {
                        const int mi = wave & 3, rowsel = mi >> 1, tt = mi & 1;
#pragma unroll
                        for (int nn = 0; nn < 2; ++nn) {
                            const int colsel = wave >> 2, stl = nn; const int ni = 2 * colsel + nn;
                            f32x16 acc;
#pragma unroll
                            for (int i = 0; i < 16; ++i) acc[i] = 0.f;
                            if (stl <= tt) {
#pragma unroll
                                for (int ks = 0; ks < 4; ++ks) {
                                    const bf16x8 a = *(const LAS bf16x8*)(AH + (mi * 32 + l32) * 72 + ks * 16 + hl * 8);
                                    const bf16x8 b = *(const LAS bf16x8*)(BH + (ni * 32 + l32) * 72 + ks * 16 + hl * 8);
                                    acc = __builtin_amdgcn_mfma_f32_32x32x16_bf16(a, b, acc, 0, 0, 0);
                                }
                            }
#pragma unroll
                            for (int i = 0; i < 16; ++i) {
                                const int t = tt * 32 + crow(i, hl), s = stl * 32 + l32;
                                const bool keep = rowsel ? (s <= t) : (s < t);
                                const float val = keep ? acc[i] : 0.f;
                                if (rowsel == 0 && colsel == 0) AAB[t * 64 + s] = val;
                                else { LAS bf16_t* dst = (rowsel == 0) ? AAK : (colsel == 0 ? ARB : ARK); dst[t * 72 + s] = (bf16_t)(cvt_pk_bf16(val, 0.f) & 0xffffu); }
                            }
                        }
                    }
                    S1_BAR;
                    if (wave < 4) {
                        const int mt = wave >> 1, nt = wave & 1;
                        f32x16 acc;
#pragma unroll
                        for (int i = 0; i < 16; ++i) acc[i] = 0.f;
#pragma unroll
                        for (int ks = 0; ks < 4; ++ks) {
                            const bf16x8 a = *(const LAS bf16x8*)(AAK + (mt * 32 + l32) * 72 + ks * 16 + hl * 8);
                            const bf16x8 b = *(const LAS bf16x8*)(VTs + (nt * 32 + l32) * 72 + ks * 16 + hl * 8);
                            acc = __builtin_amdgcn_mfma_f32_32x32x16_bf16(a, b, acc, 0, 0, 0);
                        }
#pragma unroll
                        for (int i = 0; i < 16; ++i) LB[(mt * 32 + crow(i, hl)) * 64 + nt * 32 + l32] = acc[i];
                    }
                    S1_BAR;
                    {
                        const int colx = tid >> 2, par = tid & 3;
                        float Xp[4][4];
#pragma unroll
                        for (int i = 0; i < 4; ++i) { Xp[i][0] = 0.f; Xp[i][1] = 0.f; Xp[i][2] = 0.f; Xp[i][3] = 0.f; }
#pragma clang loop unroll(full)
                        for (int t = 0; t < 64; ++t) {
                            const float va_ = bf2f(AH[t * 72 + (colx & 63)]), vb_ = LB[t * 64 + (colx & 63)];
                            float a0 = par ? 0.f : ((colx < 64) ? va_ : vb_);
                            float a1 = 0.f, a2 = 0.f, a3 = 0.f;
#pragma clang loop unroll(full)
                            for (int i = 0; 16 * i < t; ++i) { const f32x4 w = *(const LAS f32x4*)(AAB + t * 64 + 16 * i + 4 * par);
                                a0 += w[0] * Xp[i][0]; a1 += w[1] * Xp[i][1]; a2 += w[2] * Xp[i][2]; a3 += w[3] * Xp[i][3]; }
                            float val = (a0 + a1) + (a2 + a3);
                            val += __builtin_bit_cast(float, __builtin_amdgcn_update_dpp(0, __builtin_bit_cast(int, val), 0xB1, 0xf, 0xf, false));
                            val += __builtin_bit_cast(float, __builtin_amdgcn_update_dpp(0, __builtin_bit_cast(int, val), 0x4E, 0xf, 0xf, false));
                            Xp[t >> 4][t & 3] = (par == ((t >> 2) & 3)) ? val : Xp[t >> 4][t & 3];
                            asm volatile("" : "+v"(Xp[t >> 4][t & 3]));
                        }
#pragma unroll
                        for (int i = 0; i < 4; ++i) { u32x2 w; w.x = cvt_pk_bf16(Xp[i][0], Xp[i][1]); w.y = cvt_pk_bf16(Xp[i][2], Xp[i][3]);
                            *(LAS u32x2*)(XT + colx * 72 + 16 * i + 4 * par) = w; }
                    }
                    S1_BAR;
                    {
                        const int kind = wave >> 2, mt = (wave & 3) >> 1, nt = wave & 1;
                        {
                            const LAS bf16_t* Ap = (kind == 0 ? ARB : BHT) + (mt * 32 + l32) * 72; const LAS bf16_t* Bp = XT + (nt * 32 + l32) * 72;
                            f32x16 acc;
#pragma unroll
                            for (int i = 0; i < 16; ++i) acc[i] = 0.f;
#pragma unroll
                            for (int ks = 0; ks < 4; ++ks) acc = __builtin_amdgcn_mfma_f32_32x32x16_bf16(*(const LAS bf16x8*)(Ap + ks * 16 + hl * 8), *(const LAS bf16x8*)(Bp + ks * 16 + hl * 8), acc, 0, 0, 0);
                            bf16_t* dstb = (kind == 0) ? Rb : Kb;
#pragma unroll
                            for (int i = 0; i < 16; ++i) { const int rr = mt * 32 + crow(i, hl), cc = nt * 32 + l32;
                                float val = acc[i];
                                if (kind == 0) val += bf2f(RH[rr * 72 + cc]); else val *= DTS[rr];
                                dstb[(size_t)(r0 + rr) * DM + h * 64 + cc] = (bf16_t)(cvt_pk_bf16(val, 0.f) & 0xffffu); }
                        }
                        {
                            const LAS bf16_t* A1 = (kind == 0 ? ARB : BHT) + (mt * 32 + l32) * 72; const LAS bf16_t* A2 = (kind == 0 ? ARK : KHT) + (mt * 32 + l32) * 72;
                            const LAS bf16_t* B1 = XT + (64 + nt * 32 + l32) * 72; const LAS bf16_t* B2 = VTs + (nt * 32 + l32) * 72;
                            f32x16 acc;
#pragma unroll
                            for (int i = 0; i < 16; ++i) acc[i] = 0.f;
#pragma unroll
                            for (int ks = 0; ks < 4; ++ks) acc = __builtin_amdgcn_mfma_f32_32x32x16_bf16(*(const LAS bf16x8*)(A1 + ks * 16 + hl * 8), *(const LAS bf16x8*)(B1 + ks * 16 + hl * 8), acc, 0, 0, 0);
#pragma unroll
                            for (int ks = 0; ks < 4; ++ks) acc = __builtin_amdgcn_mfma_f32_32x32x16_bf16(*(const LAS bf16x8*)(A2 + ks * 16 + hl * 8), *(const LAS bf16x8*)(B2 + ks * 16 + hl * 8), acc, 0, 0, 0);
                            float* dstf = (kind == 0) ? Obuf : DD;
#pragma unroll
                            for (int i = 0; i < 16; ++i) { const int rr = mt * 32 + crow(i, hl), cc = nt * 32 + l32;
                                float val = acc[i]; if (kind == 1) val *= DTS[rr];
                                dstf[(size_t)(r0 + rr) * DM + h * 64 + cc] = val; }
                        }
                    }
                    S1_BAR;
                }
            }
            fast_grid_barrier((unsigned*)ldp(tab, 40), tab);
#undef S1_BAR
#undef S1_FETCH
            {
                PHASE_IDS BASES RWKV_PTRS
                const float* DTg = (const float*)(RB + 208 * MiB);
                const int l32 = lane & 31, hl = lane >> 5;
                const int q = wave * G + blockIdx.x;
                if (q < 1152) {
                    const bool prompt = q < 128; int b, h, vh, chunk0, nch;
                    if (prompt) { const int chain = q & 63; b = chain >> 5; h = chain & 31; vh = q >> 6; chunk0 = b * 128; nch = 128; }
                    else { const int sq = q - 128; const int chain = sq >> 1; b = chain >> 5; h = chain & 31; vh = sq & 1; chunk0 = 256 + b; nch = 1; }
                    const int colb = h * 64, vcol = colb + 32 * vh + l32;
                    f32x16 S0, S1;
                    if (prompt) {
#pragma unroll
                        for (int i = 0; i < 16; ++i) { S0[i] = 0.f; S1[i] = 0.f; }
                    } else {
                        const float* s0 = IN(3) + ((((size_t)jl * 16 + b) * 32 + h) * 64 + (32 * vh + l32)) * 64;
#pragma unroll
                        for (int i = 0; i < 16; ++i) { S0[i] = s0[crow(i, hl)]; S1[i] = s0[32 + crow(i, hl)]; }
                    }
                    bf16x8 gf[2][2][2]; f32x16 n0, n1; f32x4 dt_[2][4];
#define S2_COMPUTE(cc) do { const int _r0 = (chunk0 + (cc)) * 64; \
                        u32x4 w00, w01, w10, w11; \
                        w00.x = cvt_pk_bf16(S0[0], S0[1]); w00.y = cvt_pk_bf16(S0[2], S0[3]); w00.z = cvt_pk_bf16(S0[4], S0[5]); w00.w = cvt_pk_bf16(S0[6], S0[7]); \
                        w01.x = cvt_pk_bf16(S0[8], S0[9]); w01.y = cvt_pk_bf16(S0[10], S0[11]); w01.z = cvt_pk_bf16(S0[12], S0[13]); w01.w = cvt_pk_bf16(S0[14], S0[15]); \
                        w10.x = cvt_pk_bf16(S1[0], S1[1]); w10.y = cvt_pk_bf16(S1[2], S1[3]); w10.z = cvt_pk_bf16(S1[4], S1[5]); w10.w = cvt_pk_bf16(S1[6], S1[7]); \
                        w11.x = cvt_pk_bf16(S1[8], S1[9]); w11.y = cvt_pk_bf16(S1[10], S1[11]); w11.z = cvt_pk_bf16(S1[12], S1[13]); w11.w = cvt_pk_bf16(S1[14], S1[15]); \
                        const bf16x8 sb00 = __builtin_bit_cast(bf16x8, w00), sb01 = __builtin_bit_cast(bf16x8, w01), sb10 = __builtin_bit_cast(bf16x8, w10), sb11 = __builtin_bit_cast(bf16x8, w11); \
                        n0 = __builtin_amdgcn_mfma_f32_32x32x16_bf16(gf[0][0][0], sb00, n0, 0, 0, 0); n1 = __builtin_amdgcn_mfma_f32_32x32x16_bf16(gf[1][0][0], sb00, n1, 0, 0, 0); \
                        n0 = __builtin_amdgcn_mfma_f32_32x32x16_bf16(gf[0][0][1], sb01, n0, 0, 0, 0); n1 = __builtin_amdgcn_mfma_f32_32x32x16_bf16(gf[1][0][1], sb01, n1, 0, 0, 0); \
                        n0 = __builtin_amdgcn_mfma_f32_32x32x16_bf16(gf[0][1][0], sb10, n0, 0, 0, 0); n1 = __builtin_amdgcn_mfma_f32_32x32x16_bf16(gf[1][1][0], sb10, n1, 0, 0, 0); \
                        n0 = __builtin_amdgcn_mfma_f32_32x32x16_bf16(gf[0][1][1], sb11, n0, 0, 0, 0); n1 = __builtin_amdgcn_mfma_f32_32x32x16_bf16(gf[1][1][1], sb11, n1, 0, 0, 0); \
                        { unsigned char* _sp = (unsigned char*)DD + ((size_t)(_r0 + l32) * DM + colb + 32 * vh) * 4 + 8 * hl; \
                          *(u32x2*)(_sp + 0) = (u32x2){w00.x, w00.y}; *(u32x2*)(_sp + 16) = (u32x2){w00.z, w00.w}; *(u32x2*)(_sp + 32) = (u32x2){w01.x, w01.y}; *(u32x2*)(_sp + 48) = (u32x2){w01.z, w01.w}; \
                          *(u32x2*)(_sp + 64) = (u32x2){w10.x, w10.y}; *(u32x2*)(_sp + 80) = (u32x2){w10.z, w10.w}; *(u32x2*)(_sp + 96) = (u32x2){w11.x, w11.y}; *(u32x2*)(_sp + 112) = (u32x2){w11.z, w11.w}; } \
                        _Pragma("unroll") for (int i = 0; i < 16; ++i) { S0[i] = S0[i] * dt_[0][i >> 2][i & 3] + n0[i]; S1[i] = S1[i] * dt_[1][i >> 2][i & 3] + n1[i]; } \
                    } while (0)
                    if (prompt) {
                        LAS float* dtl = (LAS float*)((LAS unsigned char*)lds);
                        LAS unsigned char* ring = (LAS unsigned char*)lds + 32768;
                        for (int i = lane; i < 128 * 16; i += 64) *(LAS f32x4*)(dtl + i * 4) = *(const f32x4*)(DTg + ((size_t)(chunk0 + (i >> 4)) * 32 + h) * 64 + (i & 15) * 4);
#define S2_DMA(cc) do { const int _r0 = (chunk0 + (cc)) * 64; LAS unsigned char* _s = ring + ((cc) & 3) * 16384; \
                            _Pragma("unroll") for (int j = 0; j < 8; ++j) { const int _row = 8 * j + (lane >> 3); const int _p = (lane & 7) ^ (_row & 7); \
                                __builtin_amdgcn_global_load_lds((const unsigned*)(Kb + (size_t)(_r0 + _row) * DM + colb + _p * 8), (LAS unsigned*)(_s + j * 1024), 16, 0, 0); } \
                            _Pragma("unroll") for (int j = 0; j < 8; ++j) { const int _row = 8 * j + (lane >> 3); \
                                __builtin_amdgcn_global_load_lds((const unsigned*)(DD + (size_t)(_r0 + _row) * DM + colb + 32 * vh + (lane & 7) * 4), (LAS unsigned*)(_s + 8192 + j * 1024), 16, 0, 0); } \
                        } while (0)
                        S2_DMA(0); S2_DMA(1);
#pragma unroll 1
                        for (int c = 0; c < 128; ++c) {
                            if (c + 2 < 128) { S2_DMA(c + 2); asm volatile("s_waitcnt vmcnt(32)" ::: "memory"); }
                            else if (c + 1 < 128) asm volatile("s_waitcnt vmcnt(16)" ::: "memory");
                            else asm volatile("s_waitcnt vmcnt(0)" ::: "memory");
                            LAS unsigned char* sl = ring + (c & 3) * 16384;
#pragma unroll
                            for (int mt = 0; mt < 2; ++mt)
#pragma unroll
                                for (int kt = 0; kt < 2; ++kt)
#pragma unroll
                                    for (int s2 = 0; s2 < 2; ++s2) {
                                        const int row = 32 * mt + l32, p = 4 * kt + 2 * s2;
                                        const u32x2 lo = *(const LAS u32x2*)(sl + row * 128 + ((p ^ (row & 7)) * 16) + 8 * hl);
                                        const u32x2 hi = *(const LAS u32x2*)(sl + row * 128 + (((p + 1) ^ (row & 7)) * 16) + 8 * hl);
                                        gf[mt][kt][s2] = __builtin_bit_cast(bf16x8, (u32x4){lo.x, lo.y, hi.x, hi.y});
                                    }
#pragma unroll
                            for (int i = 0; i < 16; ++i) { n0[i] = *(const LAS float*)(sl + 8192 + crow(i, hl) * 128 + l32 * 4); n1[i] = *(const LAS float*)(sl + 8192 + (32 + crow(i, hl)) * 128 + l32 * 4); }
#pragma unroll
                            for (int mt = 0; mt < 2; ++mt)
#pragma unroll
                                for (int g = 0; g < 4; ++g) dt_[mt][g] = *(const LAS f32x4*)(dtl + c * 64 + 32 * mt + 8 * g + 4 * hl);
                            S2_COMPUTE(c);
                        }
#undef S2_DMA
                    } else {
                        const int _r0 = chunk0 * 64; const size_t _item = (size_t)chunk0 * 32 + h;
#pragma unroll
                        for (int mt = 0; mt < 2; ++mt)
#pragma unroll
                            for (int kt = 0; kt < 2; ++kt)
#pragma unroll
                                for (int s2 = 0; s2 < 2; ++s2) {
                                    const size_t _o = (size_t)(_r0 + 32 * mt + l32) * DM + colb + 32 * kt + 16 * s2 + 4 * hl;
                                    const u32x2 _lo = *(const u32x2*)(Kb + _o), _hi = *(const u32x2*)(Kb + _o + 8); gf[mt][kt][s2] = __builtin_bit_cast(bf16x8, (u32x4){_lo.x, _lo.y, _hi.x, _hi.y}); }
#pragma unroll
                        for (int i = 0; i < 16; ++i) { n0[i] = DD[(size_t)(_r0 + crow(i, hl)) * DM + vcol]; n1[i] = DD[(size_t)(_r0 + 32 + crow(i, hl)) * DM + vcol]; }
#pragma unroll
                        for (int mt = 0; mt < 2; ++mt)
#pragma unroll
                            for (int g = 0; g < 4; ++g) dt_[mt][g] = *(const f32x4*)(DTg + _item * 64 + 32 * mt + 8 * g + 4 * hl);
                        S2_COMPUTE(0);
                    }
#undef S2_COMPUTE
                    float* so_ = OUTP + (prompt ? O_PWKV + ((((size_t)jl * 2 + b) * 32 + h) * 64 + (32 * vh + l32)) * 64
                                                : O_SWKV + ((((size_t)jl * 16 + b) * 32 + h) * 64 + (32 * vh + l32)) * 64);
#pragma unroll
                    for (int i = 0; i < 16; ++i) { so_[crow(i, hl)] = S0[i]; so_[32 + crow(i, hl)] = S1[i]; }
                }
            }
            fast_grid_barrier((unsigned*)ldp(tab, 40), tab);
            {
                PHASE_IDS BASES RWKV_PTRS
                const float* Obuf = (const float*)(RA + 272 * MiB); const float* RK = (const float*)(RB + 204 * MiB);
                const float* lnw_g = IN(28) + (size_t)jl * DM; const float* lnb_g = IN(29) + (size_t)jl * DM;
                float* lnw = (float*)(lds + 40960); float* lnb = lnw + DM;
                for (int i = tid; i < DM / 4; i += 512) { *(f32x4*)(lnw + i * 4) = *(const f32x4*)(lnw_g + i * 4); *(f32x4*)(lnb + i * 4) = *(const f32x4*)(lnb_g + i * 4); }
                __syncthreads();
                const int l32 = lane & 31, hl = lane >> 5;
#pragma unroll 1
                for (int item = blockIdx.x; item < 8704; item += G) {
                    LAS unsigned char* ldsv = (LAS unsigned char*)lds; asm volatile("" : "+v"(ldsv));
                    LAS bf16_t* R2s = (LAS bf16_t*)(ldsv + 0); LAS bf16_t* STs = (LAS bf16_t*)(ldsv + 9216); LAS float* Os = (LAS float*)(ldsv + 18432);
                    const int chunk = item >> 5, h = item & 31, r0 = chunk * 64;
                    {
                        const int rr = tid >> 3, pc = tid & 7;
                        *(LAS u32x4*)(R2s + rr * 72 + pc * 8) = *(const u32x4*)(Rb + (size_t)(r0 + rr) * DM + h * 64 + pc * 8);
                        const unsigned char* sp = (const unsigned char*)DD + ((size_t)(r0 + (rr & 31)) * DM + h * 64 + 32 * (rr >> 5)) * 4 + pc * 16;
                        *(LAS u32x4*)(STs + rr * 72 + pc * 8) = *(const u32x4*)sp;
                    }
                    __syncthreads();
                    if (wave < 4) {
                        const int tt = wave >> 1, vt = wave & 1;
                        f32x16 acc;
#pragma unroll
                        for (int i = 0; i < 16; ++i) acc[i] = Obuf[(size_t)(r0 + 32 * tt + crow(i, hl)) * DM + h * 64 + 32 * vt + l32];
#pragma unroll
                        for (int ks = 0; ks < 4; ++ks) acc = __builtin_amdgcn_mfma_f32_32x32x16_bf16(*(const LAS bf16x8*)(R2s + (32 * tt + l32) * 72 + ks * 16 + hl * 8), *(const LAS bf16x8*)(STs + (32 * vt + l32) * 72 + ks * 16 + hl * 8), acc, 0, 0, 0);
#pragma unroll
                        for (int i = 0; i < 16; ++i) Os[(32 * tt + crow(i, hl)) * 68 + 32 * vt + l32] = acc[i];
                    }
                    __syncthreads();
                    {
                        const int st = tid >> 3, c0 = (tid & 7) * 8, col = h * 64 + c0; const size_t off = (size_t)(r0 + st) * DM + col;
                        const f32x4 o0 = *(const LAS f32x4*)(Os + st * 68 + c0), o1 = *(const LAS f32x4*)(Os + st * 68 + c0 + 4);
                        float o[8] = {o0[0], o0[1], o0[2], o0[3], o1[0], o1[1], o1[2], o1[3]};
                        float s = 0.f;
#pragma unroll
                        for (int i = 0; i < 8; ++i) s += o[i];
                        const float mu = sum8(s, lane) * (1.f / 64.f); float q = 0.f;
#pragma unroll
                        for (int i = 0; i < 8; ++i) { o[i] -= mu; q += o[i] * o[i]; }
                        const float rstd = rsqrtf(sum8(q, lane) * (1.f / 64.f) + 64e-5f);
                        float v[8], g8[8]; unpack8(*(const u32x4*)(Vb + off), v); unpack8(*(const u32x4*)(GG + off), g8);
                        if (jl > 0) { float vf[8], vg[8]; unpack8(*(const u32x4*)(VFIRST + off), vf); unpack8(*(const u32x4*)(VG + off), vg);
#pragma unroll
                            for (int i = 0; i < 8; ++i) v[i] = v[i] + (vf[i] - v[i]) * vg[i]; }
                        const float rk = RK[(size_t)(r0 + st) * 32 + h];
                        float y[8];
#pragma unroll
                        for (int i = 0; i < 8; ++i) y[i] = (o[i] * rstd * lnw[col + i] + lnb[col + i] + rk * v[i]) * g8[i];
                        *(u32x4*)(Y + off) = pack8(y);
                    }
                    __syncthreads();
                }
            }
            fast_grid_barrier((unsigned*)ldp(tab, 40), tab);
            {
                BASES RWKV_PTRS
                pg8::Gemm g{Y, WO, MROWS, 2048, 2048, 0, 0};
                pg8::StaticOrder S; S.init(g.M, g.N, G, (int)blockIdx.x, g.K, 4);
                pg8::Epi<FRes> E{FRes{X, (float*)(RA + 272 * MiB)}};
                pg8::gemm_phase(ldsl, g, S, E);
                fast_grid_barrier((unsigned*)ldp(tab, 40), tab);
                {
                    PHASE_IDS
                    const float* PART = (const float*)(RA + 272 * MiB); const int ntail = S.nwg - S.nFull;
                    if (S.S > 1) for (int idx = gtid; idx < ntail * 16384; idx += NT) {
                        const int tl = idx >> 14, r = (idx >> 6) & 255, c4 = idx & 63; int pm, pn; S.tile_pmpn(S.nFull + tl, pm, pn);
                        f32x4* xp = (f32x4*)(X + (size_t)(pm * 256 + r) * DM + pn * 256 + c4 * 4); f32x4 acc = *xp;
#pragma unroll
                        for (int part = 0; part < 4; ++part) acc += *(const f32x4*)(PART + (size_t)(part * 32 + tl) * 65536 + r * 256 + c4 * 4);
                        *xp = acc; }
                }
            }
            fast_grid_barrier((unsigned*)ldp(tab, 40), tab);
        } else {
            { PHASE_IDS BASES GLA_PTRS
            const float* gmix = IN(6) + (size_t)layer * DM;
            f32x4 ggr[8];
#pragma unroll
            for (int q = 0; q < 8; ++q) ggr[q] = *((const f32x4*)gmix + lane + 64 * q);
            for (int row = gw; row < MROWS; row += NGW) {
                const f32x4* xr = (const f32x4*)(X + (size_t)row * DM) + lane; f32x4 x[8]; float ss = 0.f;
#pragma unroll
                for (int q = 0; q < 8; ++q) { x[q] = xr[64 * q]; ss += x[q][0] * x[q][0] + x[q][1] * x[q][1] + x[q][2] * x[q][2] + x[q][3] * x[q][3]; }
                const float rs = rsqrtf(wave_sum(ss, lane) * (1.f / DM) + 1e-6f);
#pragma unroll
                for (int q = 0; q < 8; ++q) { const f32x4 gg = ggr[q]; const f32x4 h = x[q] * rs * gg;
                    u32x2 w; w.x = cvt_pk_bf16(h[0], h[1]); w.y = cvt_pk_bf16(h[2], h[3]); *((u32x2*)(H + (size_t)row * DM) + lane + 64 * q) = w; }
            } }
            fast_grid_barrier((unsigned*)ldp(tab, 40), tab);
            {
                BASES GLA_PTRS
                pg8::Gemm g{H, GI, MROWS, 6400, 2048, 0, 0};
                pg8::StaticOrder S; S.init(g.M, g.N, G, (int)blockIdx.x, g.K, 1);
                pg8::Epi<FG1> E{FG1{PROJ, LR}};
                pg8::gemm_phase(ldsl, g, S, E);
            }
            fast_grid_barrier((unsigned*)ldp(tab, 40), tab);
            {
                PHASE_IDS BASES GLA_PTRS
                float* lrS = (float*)lds;
                float* w2S = (float*)(lds + 4096);
                float* totS = (float*)(lds + 20480);
                bf16_t* qeS = (bf16_t*)(lds + 22528);
                bf16_t* keS = (bf16_t*)(lds + 22528 + 33792);
                bf16_t* vS = qeS;
                const float* gw2 = IN(31) + (size_t)jl * 16 * 1024; const float* gkb = IN(32) + (size_t)jl * 1024;
#pragma unroll 1
                for (int it = blockIdx.x; it < 1088; it += G) {
                    const int c = it >> 2, h = it & 3, r0 = c * 64; const size_t base = (size_t)it;
                    if (tid < 256) *(f32x4*)(lrS + tid * 4) = *(const f32x4*)(LR + (size_t)r0 * 16 + tid * 4);
                    for (int q = tid; q < 1024; q += 512) { const int r = q >> 6, cc = (q & 63) * 4; *(f32x4*)(w2S + r * 256 + cc) = *(const f32x4*)(gw2 + (size_t)r * 1024 + h * 256 + cc); }
                    for (int q = tid; q < 2048; q += 512) { const int t = q >> 5, cc = (q & 31) * 8; const bf16_t* src = PROJ + (size_t)(r0 + t) * 6144 + h * 256 + cc;
                        *(u32x4*)(qeS + t * 264 + cc) = *(const u32x4*)src; *(u32x4*)(keS + t * 264 + cc) = *(const u32x4*)(src + 1024); }
                    __syncthreads();
                    const int d = tid & 255, half = tid >> 8;
                    float cumv[32];
                    {
                        float w[16];
#pragma unroll
                        for (int r = 0; r < 16; ++r) w[r] = w2S[r * 256 + d];
                        const float bb = gkb[h * 256 + d]; float run = 0.f;
#pragma unroll
                        for (int tt = 0; tt < 32; ++tt) {
                            const float* lp = lrS + (half * 32 + tt) * 16; float z = bb;
#pragma unroll
                            for (int r = 0; r < 16; ++r) z += lp[r] * w[r];
                            const float g = (fminf(z, 0.f) - log1pf(__expf(-fabsf(z)))) * 0.0625f;
                            run += g; cumv[tt] = run;
                        }
                        totS[half * 256 + d] = run;
                    }
                    __syncthreads();
                    {
                        const float t0 = totS[d], t1 = totS[256 + d]; const float last = t0 + t1, offc = half ? t0 : 0.f;
                        if (half == 0) EL[base * 256 + d] = __expf(last);
                        unsigned kdp[16];
#pragma unroll
                        for (int tt = 0; tt < 32; tt += 2) {
                            float kd2[2];
#pragma unroll
                            for (int e = 0; e < 2; ++e) {
                                const int t = half * 32 + tt + e; const float cum = cumv[tt + e] + offc;
                                const float q = bf2f(qeS[t * 264 + d]), k = bf2f(keS[t * 264 + d]);
                                const float qe = q * __expf(cum), ke = k * __expf(-cum); kd2[e] = k * __expf(last - cum);
                                const unsigned pq = cvt_pk_bf16(qe, ke);
                                qeS[t * 264 + d] = (bf16_t)(pq & 0xffffu); keS[t * 264 + d] = (bf16_t)(pq >> 16);
                            }
                            kdp[tt >> 1] = cvt_pk_bf16(kd2[0], kd2[1]);
                        }
                        u32x4* kdst = (u32x4*)(KDT + (base * 256 + d) * 64 + half * 32);
                        kdst[0] = (u32x4){kdp[0], kdp[1], kdp[2], kdp[3]}; kdst[1] = (u32x4){kdp[4], kdp[5], kdp[6], kdp[7]};
                        kdst[2] = (u32x4){kdp[8], kdp[9], kdp[10], kdp[11]}; kdst[3] = (u32x4){kdp[12], kdp[13], kdp[14], kdp[15]};
                    }
                    __syncthreads();
                    for (int q = tid; q < 2048; q += 512) { const int t = q >> 5, sl = (q >> 2) & 7, pc = q & 3;
                        *(u32x4*)(QE + ((base * 8 + sl) * 64 + t) * 32 + pc * 8) = *(const u32x4*)(qeS + t * 264 + sl * 32 + pc * 8); }
                    if (wave < 4) {
                        const int mi = wave >> 1, ni = wave & 1, l32 = lane & 31, hl = lane >> 5;
                        f32x16 cacc;
#pragma unroll
                        for (int i = 0; i < 16; ++i) cacc[i] = 0.f;
#pragma unroll
                        for (int kk = 0; kk < 16; ++kk) {
                            const bf16x8 a = *(const bf16x8*)(qeS + (mi * 32 + l32) * 264 + kk * 16 + hl * 8);
                            const bf16x8 b = *(const bf16x8*)(keS + (ni * 32 + l32) * 264 + kk * 16 + hl * 8);
                            cacc = __builtin_amdgcn_mfma_f32_32x32x16_bf16(a, b, cacc, 0, 0, 0);
                        }
#pragma unroll
                        for (int i = 0; i < 16; ++i) { const int ii = mi * 32 + crow(i, hl), jj = ni * 32 + l32;
                            const float v = (jj <= ii) ? cacc[i] : 0.f; SC[base * 4096 + ii * 64 + jj] = (bf16_t)(cvt_pk_bf16(v, 0.f) & 0xffffu); }
                    }
                    __syncthreads();
                    for (int q = tid; q < 4096; q += 512) { const int t = q >> 6, cc = (q & 63) * 8;
                        *(u32x4*)(vS + t * 520 + cc) = *(const u32x4*)(PROJ + (size_t)(r0 + t) * 6144 + 2048 + h * 512 + cc); }
                    __syncthreads();
                    {
                        const int dv = tid; u32x4* vdst = (u32x4*)(VT + (base * 512 + dv) * 64);
#pragma unroll
                        for (int q = 0; q < 8; ++q) {
                            unsigned w[4];
#pragma unroll
                            for (int e = 0; e < 4; ++e) { const unsigned lo = vS[(q * 8 + 2 * e) * 520 + dv], hi = vS[(q * 8 + 2 * e + 1) * 520 + dv]; w[e] = lo | (hi << 16); }
                            vdst[q] = (u32x4){w[0], w[1], w[2], w[3]};
                        }
                    }
                    __syncthreads();
                }
            }
            fast_grid_barrier((unsigned*)ldp(tab, 40), tab);
            {
                PHASE_IDS BASES GLA_PTRS
                float* red = (float*)lds;
                const int l32 = lane & 31, hl = lane >> 5;
#pragma unroll 1
                for (int u = blockIdx.x; u < 1152; u += G) {
                    const bool prompt = u < 128; int b, h, s, cg0, nch, row0;
                    if (prompt) { const int pair = u & 7; b = pair >> 2; h = pair & 3; s = u >> 3; cg0 = b * 128; nch = 128; row0 = b * 8192; }
                    else { const int su = u - 128; b = su >> 6; h = (su >> 4) & 3; s = su & 15; cg0 = 256 + b; nch = 1; row0 = MPROMPT + b * 64; }
                    f32x16 S;
                    if (prompt) {
#pragma unroll
                        for (int i = 0; i < 16; ++i) S[i] = 0.f;
                    } else {
                        const float* s0 = IN(4) + ((((size_t)jl * 16 + b) * 4 + h) * 256) * 512;
#pragma unroll
                        for (int i = 0; i < 16; ++i) S[i] = s0[(size_t)(32 * wave + crow(i, hl)) * 512 + 32 * s + l32];
                    }
                    const int mtw = wave & 1, ksw = wave >> 1;
                    bf16x8 ka[4], vb[4], qf[2][2], scf; f32x4 el[4];
#define GL_LD_Q(cc) do { const size_t _base = (size_t)(cg0 + (cc)) * 4 + h; const int _r0 = row0 + (cc) * 64; const bf16_t* _sc = SC + _base * 4096; \
                        _Pragma("unroll") for (int mt = 0; mt < 2; ++mt) _Pragma("unroll") for (int s2 = 0; s2 < 2; ++s2) { const bf16_t* _pq = QE + ((_base * 8 + wave) * 64 + mt * 32 + l32) * 32 + 16 * s2 + 4 * hl; \
                            const u32x2 _lo = *(const u32x2*)_pq, _hi = *(const u32x2*)(_pq + 8); qf[mt][s2] = __builtin_bit_cast(bf16x8, (u32x4){_lo.x, _lo.y, _hi.x, _hi.y}); } \
                        scf = *(const bf16x8*)(_sc + (mtw * 32 + l32) * 64 + 16 * ksw + 8 * hl); } while (0)
#define GL_LD_E(cc) do { const size_t _base = (size_t)(cg0 + (cc)) * 4 + h; \
                        _Pragma("unroll") for (int g = 0; g < 4; ++g) el[g] = *(const f32x4*)(EL + _base * 256 + 32 * wave + 8 * g + 4 * hl); } while (0)
#define GL_LD_K(cc) do { const size_t _base = (size_t)(cg0 + (cc)) * 4 + h; const bf16_t* _kdt = KDT + _base * 256 * 64; const bf16_t* _vt = VT + _base * 512 * 64; \
                        _Pragma("unroll") for (int ks = 0; ks < 4; ++ks) { ka[ks] = *(const bf16x8*)(_kdt + (32 * wave + l32) * 64 + 16 * ks + 8 * hl); vb[ks] = *(const bf16x8*)(_vt + (32 * s + l32) * 64 + 16 * ks + 8 * hl); } } while (0)
                    GL_LD_Q(0); GL_LD_E(0); GL_LD_K(0);
                    f32x4 osum = (f32x4){0.f, 0.f, 0.f, 0.f}; float* optr = nullptr;
#pragma unroll 1
                    for (int c = 0; c < nch; ++c) {
                        const int r0 = row0 + c * 64; const int cn = (c + 1 < nch) ? c + 1 : c;
                        asm volatile("" : "+v"(scf), "+v"(vb[3]));
                        if (c > 0) *(f32x4*)optr = osum;
                        u32x4 sp0, sp1;
                        sp0.x = cvt_pk_bf16(S[0], S[1]); sp0.y = cvt_pk_bf16(S[2], S[3]); sp0.z = cvt_pk_bf16(S[4], S[5]); sp0.w = cvt_pk_bf16(S[6], S[7]);
                        sp1.x = cvt_pk_bf16(S[8], S[9]); sp1.y = cvt_pk_bf16(S[10], S[11]); sp1.z = cvt_pk_bf16(S[12], S[13]); sp1.w = cvt_pk_bf16(S[14], S[15]);
                        const bf16x8 sb0 = __builtin_bit_cast(bf16x8, sp0), sb1 = __builtin_bit_cast(bf16x8, sp1);
                        const bf16x8 vbw = ksw == 0 ? vb[0] : ksw == 1 ? vb[1] : ksw == 2 ? vb[2] : vb[3];
#pragma unroll
                        for (int i = 0; i < 16; ++i) S[i] *= el[i >> 2][i & 3];
#pragma unroll
                        for (int ks = 0; ks < 4; ++ks) S = __builtin_amdgcn_mfma_f32_32x32x16_bf16(ka[ks], vb[ks], S, 0, 0, 0);
                        GL_LD_E(cn); GL_LD_K(cn);
                        f32x16 oo0, oo1;
#pragma unroll
                        for (int i = 0; i < 16; ++i) { oo0[i] = 0.f; oo1[i] = 0.f; }
                        oo0 = __builtin_amdgcn_mfma_f32_32x32x16_bf16(qf[0][0], sb0, oo0, 0, 0, 0); oo0 = __builtin_amdgcn_mfma_f32_32x32x16_bf16(qf[0][1], sb1, oo0, 0, 0, 0);
                        oo1 = __builtin_amdgcn_mfma_f32_32x32x16_bf16(qf[1][0], sb0, oo1, 0, 0, 0); oo1 = __builtin_amdgcn_mfma_f32_32x32x16_bf16(qf[1][1], sb1, oo1, 0, 0, 0);
                        if (mtw == 0) oo0 = __builtin_amdgcn_mfma_f32_32x32x16_bf16(scf, vbw, oo0, 0, 0, 0); else oo1 = __builtin_amdgcn_mfma_f32_32x32x16_bf16(scf, vbw, oo1, 0, 0, 0);
                        GL_LD_Q(cn);
#pragma unroll
                        for (int q = 0; q < 16; ++q) { red[(wave * 32 + q) * 64 + lane] = oo0[q]; red[(wave * 32 + 16 + q) * 64 + lane] = oo1[q]; }
                        asm volatile("s_waitcnt lgkmcnt(0)" ::: "memory"); __builtin_amdgcn_s_barrier(); asm volatile("" ::: "memory");
                        { const int q = tid >> 4, lg = tid & 15; f32x4 sum = (f32x4){0.f, 0.f, 0.f, 0.f};
#pragma unroll
                          for (int w = 0; w < 8; ++w) sum += *(const f32x4*)(red + (w * 32 + q) * 64 + 4 * lg);
                          const int mt = q >> 4, reg = q & 15, L = 4 * lg; const int i = mt * 32 + crow(reg, L >> 5), dv = L & 31;
                          osum = sum; optr = O + (size_t)(r0 + i) * DM + h * 512 + 32 * s + dv; }
                        asm volatile("s_waitcnt lgkmcnt(0)" ::: "memory"); __builtin_amdgcn_s_barrier(); asm volatile("" ::: "memory");
                    }
                    *(f32x4*)optr = osum;
#undef GL_LD_Q
#undef GL_LD_E
#undef GL_LD_K
                    float* dst = OUTP + (prompt ? O_PGLA + ((((size_t)jl * 2 + b) * 4 + h) * 256) * 512 : O_SGLA + ((((size_t)jl * 16 + b) * 4 + h) * 256) * 512);
#pragma unroll
                    for (int i = 0; i < 16; ++i) dst[(size_t)(32 * wave + crow(i, hl)) * 512 + 32 * s + l32] = S[i];
                }
                if (layer == 1 && G >= 256 && (int)blockIdx.x >= 128) {
                    float* scr = (float*)(lds + wave * 16896);
                    CONVERT_WEIGHTS(1, 2, 2, 4, ((int)blockIdx.x - 128) * 8 + wave, (G - 128) * 8);
                }
            }
            fast_grid_barrier((unsigned*)ldp(tab, 40), tab);
            {
                PHASE_IDS BASES GLA_PTRS
                const float* hn = IN(33) + (size_t)jl * 512;
                const f32x4 n0 = *(const f32x4*)(hn + lane * 8), n1 = *(const f32x4*)(hn + lane * 8 + 4);
                for (int row = gw; row < MROWS; row += NGW) {
#pragma unroll
                    for (int h = 0; h < 4; ++h) {
                        const float* op = O + (size_t)row * DM + h * 512 + lane * 8;
                        const f32x4 a = *(const f32x4*)op, b = *(const f32x4*)(op + 4);
                        float ss = a[0] * a[0] + a[1] * a[1] + a[2] * a[2] + a[3] * a[3] + b[0] * b[0] + b[1] * b[1] + b[2] * b[2] + b[3] * b[3];
                        const float rs = rsqrtf(wave_sum(ss, lane) * (1.f / 512.f) + 1e-5f);
                        float gt[8]; unpack8(*(const u32x4*)(PROJ + (size_t)row * 6144 + 4096 + h * 512 + lane * 8), gt);
                        float y[8];
#pragma unroll
                        for (int i = 0; i < 4; ++i) { y[i] = a[i] * rs * n0[i] * (gt[i] * sigmoidf_(gt[i])); y[4 + i] = b[i] * rs * n1[i] * (gt[4 + i] * sigmoidf_(gt[4 + i])); }
                        *(u32x4*)(Y + (size_t)row * DM + h * 512 + lane * 8) = pack8(y);
                    }
                }
            }
            fast_grid_barrier((unsigned*)ldp(tab, 40), tab);
            {
                BASES GLA_PTRS
                pg8::Gemm g{Y, GO, MROWS, 2048, 2048, 0, 0};
                pg8::StaticOrder S; S.init(g.M, g.N, G, (int)blockIdx.x, g.K, 4);
                pg8::Epi<FRes> E{FRes{X, (float*)(RA + 272 * MiB)}};
                pg8::gemm_phase(ldsl, g, S, E);
                fast_grid_barrier((unsigned*)ldp(tab, 40), tab);
                {
                    PHASE_IDS
                    const float* PART = (const float*)(RA + 272 * MiB); const int ntail = S.nwg - S.nFull;
                    if (S.S > 1) for (int idx = gtid; idx < ntail * 16384; idx += NT) {
                        const int tl = idx >> 14, r = (idx >> 6) & 255, c4 = idx & 63; int pm, pn; S.tile_pmpn(S.nFull + tl, pm, pn);
                        f32x4* xp = (f32x4*)(X + (size_t)(pm * 256 + r) * DM + pn * 256 + c4 * 4); f32x4 acc = *xp;
#pragma unroll
                        for (int part = 0; part < 4; ++part) acc += *(const f32x4*)(PART + (size_t)(part * 32 + tl) * 65536 + r * 256 + c4 * 4);
                        *xp = acc; }
                }
            }
            fast_grid_barrier((unsigned*)ldp(tab, 40), tab);
        }
        {
            { PHASE_IDS BASES FFN_PTRS
            const float* gf = IN(7) + (size_t)layer * DM;
            f32x4 ggr[8];
#pragma unroll
            for (int q = 0; q < 8; ++q) ggr[q] = *((const f32x4*)gf + lane + 64 * q);
            for (int row = gw; row < MROWS; row += NGW) {
                const f32x4* xr = (const f32x4*)(X + (size_t)row * DM) + lane; f32x4 x[8]; float ss = 0.f;
#pragma unroll
                for (int q = 0; q < 8; ++q) { x[q] = xr[64 * q]; ss += x[q][0] * x[q][0] + x[q][1] * x[q][1] + x[q][2] * x[q][2] + x[q][3] * x[q][3]; }
                const float rs = rsqrtf(wave_sum(ss, lane) * (1.f / DM) + 1e-6f);
#pragma unroll
                for (int q = 0; q < 8; ++q) { const f32x4 gg = ggr[q]; const f32x4 h = x[q] * rs * gg;
                    u32x2 w; w.x = cvt_pk_bf16(h[0], h[1]); w.y = cvt_pk_bf16(h[2], h[3]); *((u32x2*)(H + (size_t)row * DM) + lane + 64 * q) = w; }
            } }
            fast_grid_barrier((unsigned*)ldp(tab, 40), tab);
            {
                BASES FFN_PTRS
                pg8::Gemm g{H, WU, MROWS, F2, 2048, 0, 0};
                pg8::StaticOrder S; S.init(g.M, g.N, G, (int)blockIdx.x, g.K, 1);
                pg8::Epi<FUp> E{FUp{U, OUTP + O_PCONV + (size_t)layer * 2 * 2 * F2, OUTP + O_SCONV + (size_t)layer * 16 * 2 * F2}};
                pg8::gemm_phase(ldsl, g, S, E);
            }
            fast_grid_barrier((unsigned*)ldp(tab, 40), tab);
            {
                PHASE_IDS BASES FFN_PTRS
                const float* cw = IN(36) + (size_t)layer * 3 * F2; const float* cb = IN(37) + (size_t)layer * F2;
                const float* cst = IN(5) + (size_t)layer * 16 * 2 * F2;
#pragma unroll 1
                for (int it = gtid; it < 544 * 704; it += NT) {
                    const int rc = it / 704, c8 = it - rc * 704, col = c8 * 8, r0 = rc * 32;
                    int t0, len, b; bool prompt; row_info(r0, t0, len, b, prompt);
                    float wv[3][8], wg[3][8], bv[8], bg[8];
#pragma unroll
                    for (int k = 0; k < 3; ++k) { const f32x4 a = *(const f32x4*)(cw + (size_t)k * F2 + col), a2 = *(const f32x4*)(cw + (size_t)k * F2 + col + 4);
                        const f32x4 g = *(const f32x4*)(cw + (size_t)k * F2 + FH + col), g2 = *(const f32x4*)(cw + (size_t)k * F2 + FH + col + 4);
#pragma unroll
                        for (int i = 0; i < 4; ++i) { wv[k][i] = a[i]; wv[k][4 + i] = a2[i]; wg[k][i] = g[i]; wg[k][4 + i] = g2[i]; } }
                    { const f32x4 a = *(const f32x4*)(cb + col), a2 = *(const f32x4*)(cb + col + 4), g = *(const f32x4*)(cb + FH + col), g2 = *(const f32x4*)(cb + FH + col + 4);
#pragma unroll
                      for (int i = 0; i < 4; ++i) { bv[i] = a[i]; bv[4 + i] = a2[i]; bg[i] = g[i]; bg[4 + i] = g2[i]; } }
                    float v2[8], v1[8], g2_[8], g1_[8];
                    if (t0 > 0) {
                        unpack8(*(const u32x4*)(U + (size_t)(r0 - 2) * F2 + col), v2); unpack8(*(const u32x4*)(U + (size_t)(r0 - 1) * F2 + col), v1);
                        unpack8(*(const u32x4*)(U + (size_t)(r0 - 2) * F2 + FH + col), g2_); unpack8(*(const u32x4*)(U + (size_t)(r0 - 1) * F2 + FH + col), g1_);
                    } else if (!prompt) {
                        const float* s0 = cst + ((size_t)b * 2) * F2 + col; const float* s1 = s0 + F2;
#pragma unroll
                        for (int i = 0; i < 8; ++i) { v2[i] = s0[i]; v1[i] = s1[i]; g2_[i] = s0[FH + i]; g1_[i] = s1[FH + i]; }
                    } else {
#pragma unroll
                        for (int i = 0; i < 8; ++i) { v2[i] = 0.f; v1[i] = 0.f; g2_[i] = 0.f; g1_[i] = 0.f; }
                    }
#pragma unroll 1
                    for (int rb = 0; rb < 32; rb += 8) {
                      u32x4 uv_[8], ug_[8];
#pragma unroll
                      for (int j = 0; j < 8; ++j) { uv_[j] = *(const u32x4*)(U + (size_t)(r0 + rb + j) * F2 + col); ug_[j] = *(const u32x4*)(U + (size_t)(r0 + rb + j) * F2 + FH + col); }
#pragma unroll
                      for (int j = 0; j < 8; ++j) {
                        const int r = rb + j;
                        float v0[8], g0[8];
                        unpack8(uv_[j], v0); unpack8(ug_[j], g0);
                        float y[8];
#pragma unroll
                        for (int i = 0; i < 8; ++i) {
                            const float cv = bv[i] + wv[0][i] * v2[i] + wv[1][i] * v1[i] + wv[2][i] * v0[i];
                            const float cg_ = bg[i] + wg[0][i] * g2_[i] + wg[1][i] * g1_[i] + wg[2][i] * g0[i];
                            y[i] = cg_ * sigmoidf_(cg_) * cv;
                            v2[i] = v1[i]; v1[i] = v0[i]; g2_[i] = g1_[i]; g1_[i] = g0[i];
                        }
                        *(u32x4*)(HID + (size_t)(r0 + r) * FH + col) = pack8(y);
                      }
                    }
                }
            }
            fast_grid_barrier((unsigned*)ldp(tab, 40), tab);
            {
                BASES FFN_PTRS
                pg8::Gemm g{HID, WD, MROWS, 2048, FH, 0, 0};
                pg8::StaticOrder S; S.init(g.M, g.N, G, (int)blockIdx.x, g.K, 4);
                pg8::Epi<FRes> E{FRes{X, (float*)(RA + 272 * MiB)}};
                pg8::gemm_phase(ldsl, g, S, E);
                fast_grid_barrier((unsigned*)ldp(tab, 40), tab);
                {
                    PHASE_IDS
                    const float* PART = (const float*)(RA + 272 * MiB); const int ntail = S.nwg - S.nFull;
                    if (S.S > 1) for (int idx = gtid; idx < ntail * 16384; idx += NT) {
                        const int tl = idx >> 14, r = (idx >> 6) & 255, c4 = idx & 63; int pm, pn; S.tile_pmpn(S.nFull + tl, pm, pn);
                        f32x4* xp = (f32x4*)(X + (size_t)(pm * 256 + r) * DM + pn * 256 + c4 * 4); f32x4 acc = *xp;
#pragma unroll
                        for (int part = 0; part < 4; ++part) acc += *(const f32x4*)(PART + (size_t)(part * 32 + tl) * 65536 + r * 256 + c4 * 4);
                        *xp = acc; }
                }
            }
            fast_grid_barrier((unsigned*)ldp(tab, 40), tab);
        }
    }
    {
        PHASE_IDS BASES
        const float* gn = IN(8);
        f32x4 ggr[8];
#pragma unroll
        for (int q = 0; q < 8; ++q) ggr[q] = *((const f32x4*)gn + lane + 64 * q);
        for (int row = gw; row < MROWS; row += NGW) {
            f32x4* xr = (f32x4*)(X + (size_t)row * DM) + lane; f32x4 x[8]; float ss = 0.f;
#pragma unroll
            for (int q = 0; q < 8; ++q) { x[q] = xr[64 * q]; ss += x[q][0] * x[q][0] + x[q][1] * x[q][1] + x[q][2] * x[q][2] + x[q][3] * x[q][3]; }
            const float rs = rsqrtf(wave_sum(ss, lane) * (1.f / DM) + 1e-6f);
#pragma unroll
            for (int q = 0; q < 8; ++q) { const f32x4 gg = ggr[q]; xr[64 * q] = x[q] * rs * gg; }
        }
    }
}

#undef TR
#undef CONVERT_WEIGHTS
extern "C" void kernel_launch(void* const* d_in, const int* in_sizes, int n_in, void* d_out, int out_size, void* d_ws, size_t ws_size, hipStream_t stream) {
    static int grid = 0;
    if (grid == 0) {
        if (n_in != 39 || (size_t)out_size != O_TOTAL || ws_size < WS_END) {
            fprintf(stderr, "kernel_launch: unexpected shapes: n_in %d out %d ws %zu (need %zu)\n", n_in, out_size, ws_size, (size_t)WS_END); grid = -1; return; }
        int dev = 0, cus = 0, per_cu = 0;
        (void)hipGetDevice(&dev);
        (void)hipDeviceGetAttribute(&cus, hipDeviceAttributeMultiprocessorCount, dev);
        if (hipFuncSetAttribute((const void*)fwd_kernel, hipFuncAttributeMaxDynamicSharedMemorySize, LDS_BYTES) != hipSuccess) { fprintf(stderr, "kernel_launch: hipFuncSetAttribute failed\n"); grid = -1; return; }
        if (hipOccupancyMaxActiveBlocksPerMultiprocessor(&per_cu, (const void*)fwd_kernel, 512, LDS_BYTES) != hipSuccess || per_cu < 1) { fprintf(stderr, "kernel_launch: occupancy query says %d\n", per_cu); per_cu = 1; }
        (void)hipGetLastError();
        grid = cus * 1;
        if (grid <= 0) grid = 256;
    }
    if (grid < 0) return;
    P prm{};
    for (int i = 0; i < 39; ++i) prm.in[i] = (const float*)d_in[i];
    prm.out = (float*)d_out; prm.ws = (unsigned char*)d_ws;
    void* args[] = {&prm};
    hipError_t e = hipLaunchCooperativeKernel((const void*)fwd_kernel, dim3(grid), dim3(512), args, LDS_BYTES, stream);
    if (e != hipSuccess) fprintf(stderr, "cooperative launch failed: %s (grid %d)\n", hipGetErrorString(e), grid);
}
```

```cpp
#include <hip/hip_runtime.h>
#include <hip/hip_cooperative_groups.h>
#include <cstdio>
#include <cstdint>
namespace cg = cooperative_groups;

#define LAS __attribute__((address_space(3)))
typedef unsigned short bf16_t;
typedef short bf16x8 __attribute__((ext_vector_type(8)));
typedef float f32x4 __attribute__((ext_vector_type(4)));
typedef float f32x16 __attribute__((ext_vector_type(16)));
typedef unsigned u32x4 __attribute__((ext_vector_type(4)));
typedef unsigned u32x2 __attribute__((ext_vector_type(2)));

constexpr int DM = 2048, MROWS = 17408, MPROMPT = 16384;
constexpr int FH = 5632, F2 = 11264;
constexpr int LDS_BYTES = 147456;
constexpr size_t MiB = 1u << 20;
constexpr size_t WS_WT = 1 * MiB;
constexpr size_t WS_A = 411 * MiB;
constexpr size_t WS_B = 819 * MiB;
constexpr size_t WS_VF = 1227 * MiB;
constexpr size_t WS_END = 1295 * MiB;
constexpr size_t ACT = (size_t)MROWS * DM;
constexpr size_t RW_SZ = (size_t)7168 * 2048 + (size_t)8192 * 256 + (size_t)2048 * 2048;
constexpr size_t GW_SZ = (size_t)6400 * 2048 + (size_t)2048 * 2048;
constexpr size_t FW_SZ = (size_t)11264 * 2048 + (size_t)2048 * 5632;
constexpr size_t GW_OFF = 2 * RW_SZ, FW_OFF = GW_OFF + 2 * GW_SZ;
constexpr size_t O_PSHIFT = 35651584, O_PWKV = 35659776, O_PGLA = 36184064, O_PCONV = 38281216;
constexpr size_t O_SSHIFT = 38461440, O_SWKV = 38526976, O_SGLA = 42721280, O_SCONV = 59498496, O_TOTAL = 60940288;

__device__ __forceinline__ unsigned cvt_pk_bf16(float lo, float hi) { unsigned r; asm volatile("v_cvt_pk_bf16_f32 %0, %1, %2" : "=v"(r) : "v"(lo), "v"(hi)); return r; }
__device__ __forceinline__ float bf2f(bf16_t b) { return __builtin_bit_cast(float, (unsigned)b << 16); }
__device__ __forceinline__ float bflo(unsigned u) { return __builtin_bit_cast(float, u << 16); }
__device__ __forceinline__ float bfhi(unsigned u) { return __builtin_bit_cast(float, u & 0xffff0000u); }
__device__ __forceinline__ void unpack8(u32x4 w, float (&f)[8]) {
    f[0] = bflo(w.x); f[1] = bfhi(w.x); f[2] = bflo(w.y); f[3] = bfhi(w.y); f[4] = bflo(w.z); f[5] = bfhi(w.z); f[6] = bflo(w.w); f[7] = bfhi(w.w);
}
__device__ __forceinline__ u32x4 pack8(const float (&f)[8]) {
    u32x4 w; w.x = cvt_pk_bf16(f[0], f[1]); w.y = cvt_pk_bf16(f[2], f[3]); w.z = cvt_pk_bf16(f[4], f[5]); w.w = cvt_pk_bf16(f[6], f[7]); return w;
}
__device__ __forceinline__ float sigmoidf_(float x) { return 1.f / (1.f + __expf(-x)); }
__device__ __forceinline__ float shx(float v, int lane, int o) { return __builtin_bit_cast(float, __builtin_amdgcn_ds_bpermute((lane ^ o) << 2, __builtin_bit_cast(int, v))); }
__device__ __forceinline__ float wave_sum(float v, int lane) {
#pragma unroll
    for (int o = 1; o < 64; o <<= 1) v += shx(v, lane, o);
    return v;
}
__device__ __forceinline__ float sum8(float v, int lane) { v += shx(v, lane, 1); v += shx(v, lane, 2); v += shx(v, lane, 4); return v; }
__device__ __forceinline__ int crow(int reg, int h) { return (reg & 3) + 8 * (reg >> 2) + 4 * h; }

namespace pg8 {
constexpr int BM = 256, BK = 64, HALF = 128, HTB = HALF * BK * 2, STAGE_BYTES = 8 * HTB, NXCD = 8, WGM = 8;
__host__ __device__ __forceinline__ int lds_byte(int r, int c) { const int st = (r >> 4) * 2 + (c >> 5), rr = r & 15, cc = c & 31, ob = rr * 64 + cc * 2; return st * 1024 + (ob ^ (((ob >> 9) & 1) << 5)); }
__host__ __device__ __forceinline__ void stage_rc(int b, int& R, int& C) { const int st = b / 1024, sb = b % 1024, swz = sb ^ (((sb >> 9) & 1) << 5); R = (st >> 1) * 16 + swz / 64; C = (st & 1) * 32 + (swz % 64) / 2; }
__host__ __device__ __forceinline__ int perm32(int rho) { const int n = rho >> 4, i = rho & 15; return 8 * (i >> 2) + 4 * n + (i & 3); }

struct Unit { int pm, pn, kofs, knt, split; };
struct Gemm { const bf16_t* A; const bf16_t* Bt; int M, N, K; int mode; size_t astride; };
__device__ __forceinline__ const char* a_of(const Gemm& g, int pn) {
    int s = 0;
    if (g.mode == 1) s = pn < 8 ? 0 : pn < 16 ? 2 : pn < 24 ? 3 : pn == 24 ? 1 : pn == 25 ? 4 : pn == 26 ? 5 : 3;
    else if (g.mode == 2) s = pn >> 3;
    return (const char*)g.A + (size_t)s * g.astride;
}
struct StaticOrder {
    int nM, nN, nwg, G, c, nFull, S, ntK, total;
    __device__ __forceinline__ void init(int M, int N, int G_, int c_, int K = 0, int S_ = 1) { nM = M / BM; nN = N / BM; nwg = nM * nN; G = G_; c = c_; ntK = K / BK;
        nFull = (nwg / G) * G; S = S_; if (S_ <= 1 || nFull == nwg) { S = 1; nFull = nwg; } total = nFull + (nwg - nFull) * S; }
    __device__ __forceinline__ bool next(int i, Unit& u) const {
        const long L = (long)i * G + c; if (L >= total) return false;
        int wgid;
        if (L < nFull) { wgid = (int)L; u.kofs = 0; u.knt = ntK; u.split = 0; }
        else { const int j = (int)L - nFull; wgid = nFull + j / S; const int part = j % S; u.knt = ntK / S; u.kofs = part * u.knt * BK; u.split = 1 + part * 32 + j / S; }
        tile_pmpn(wgid, u.pm, u.pn); return true;
    }
    __device__ __forceinline__ void tile_pmpn(int wgid, int& pm, int& pn) const {
        { const int q = nwg / NXCD, r = nwg % NXCD, xcd = wgid % NXCD, off = wgid / NXCD; wgid = (xcd < r ? xcd * (q + 1) : r * (q + 1) + (xcd - r) * q) + off; }
        const int nig = WGM * nN, gid = wgid / nig, fm = gid * WGM, gsz = (nM - fm) < WGM ? (nM - fm) : WGM;
        pm = fm + ((wgid % nig) % gsz); pn = (wgid % nig) / gsz;
    }
};

template <class F> struct Epi {
    static constexpr bool PERM = true;
    F f;
    __device__ __forceinline__ void operator()(const f32x4 (&acc)[2][2][4][2], const Unit& u, int wr, int wc, int fr, int fq) const {
        { int t_ = threadIdx.x; asm volatile("" : "+v"(t_)); const int l_ = t_ & 63, w_ = __builtin_amdgcn_readfirstlane(t_ >> 6); fr = l_ & 15; fq = l_ >> 4; wr = w_ >> 2; wc = w_ & 3; }
        const int row0 = u.pm * BM + wr * 64 + fr, col0 = u.pn * BM + wc * 32 + 8 * fq;
#pragma unroll
        for (int ai = 0; ai < 2; ++ai)
#pragma unroll
            for (int m = 0; m < 4; ++m)
#pragma unroll
                for (int bj = 0; bj < 2; ++bj) f(row0 + ai * HALF + m * 16, col0 + bj * HALF, acc[ai][bj][m][0], acc[ai][bj][m][1], u.split);
    }
};

template <class EpiT>
__device__ __forceinline__ void gemm_phase(LAS unsigned char* lds, const Gemm g, const StaticOrder& S, const EpiT& E) {
    int tid = threadIdx.x; asm volatile("" : "+v"(tid));
    const int wid = __builtin_amdgcn_readfirstlane(tid >> 6), lane = tid & 63, wr = wid >> 2, wc = wid & 3, fr = lane & 15, fq = lane >> 4;
    const int K = g.K;
    unsigned voffA[2], voffB[2];
#pragma unroll
    for (int i = 0; i < 2; ++i) { int R, C; stage_rc(tid * 16 + i * 8192, R, C); const int Rb = EpiT::PERM ? ((R & ~31) + perm32(R & 31)) : R;
        voffA[i] = (unsigned)(R * K + C) * 2u; voffB[i] = (unsigned)(Rb * K + C) * 2u; }
    const size_t kstep = (size_t)(BK * 2);
    const size_t hstep = (size_t)HALF * K * 2;
    const size_t tstep = 2 * hstep;
    const unsigned ldsw = (unsigned)wid * 1024u;
    const int aoff = lds_byte(wr * 64 + fr, fq * 8), boff = lds_byte(wc * 32 + fr, fq * 8);
#define PG8_SA(b, h) (((b) * 2 + (h)) * HTB)
#define PG8_SB(b, h) ((4 + (b) * 2 + (h)) * HTB)
#define PG8_STAGE(bufoff, gbase, voff) do { _Pragma("unroll") for (int _i = 0; _i < 2; ++_i) \
        __builtin_amdgcn_global_load_lds((const unsigned*)((const char*)(gbase) + (voff)[_i]), (LAS unsigned*)(lds + (bufoff) + ldsw + _i * 8192), 16, 0, 0); } while (0)
#define PG8_LDA(dst, b, h) do { _Pragma("unroll") for (int m = 0; m < 4; ++m) _Pragma("unroll") for (int k = 0; k < 2; ++k) dst[m][k] = *(const LAS bf16x8*)(lds + PG8_SA(b, h) + aoff + m * 2048 + k * 1024); } while (0)
#define PG8_LDB(dst, b, h) do { _Pragma("unroll") for (int n = 0; n < 2; ++n) _Pragma("unroll") for (int k = 0; k < 2; ++k) dst[n][k] = *(const LAS bf16x8*)(lds + PG8_SB(b, h) + boff + n * 2048 + k * 1024); } while (0)
#define PG8_MMA(ai, bj, At, Bt) do { __builtin_amdgcn_s_setprio(1); _Pragma("unroll") for (int m = 0; m < 4; ++m) _Pragma("unroll") for (int n = 0; n < 2; ++n) _Pragma("unroll") for (int k = 0; k < 2; ++k) \
        acc[ai][bj][m][n] = __builtin_amdgcn_mfma_f32_16x16x32_bf16(Bt[n][k], At[m][k], acc[ai][bj][m][n], 0, 0, 0); __builtin_amdgcn_s_setprio(0); } while (0)
#define PG8_WAIT_V(n) asm volatile("s_waitcnt vmcnt(" #n ")" ::: "memory")
#define PG8_WAIT_L(n) asm volatile("s_waitcnt lgkmcnt(" #n ")" ::: "memory")
#define PG8_BAR __builtin_amdgcn_s_barrier()
#define PG8_SCHED __builtin_amdgcn_sched_barrier(0)
    Unit cur, nxt; int ui = 0;
    if (!S.next(0, cur)) return;
    f32x4 acc[2][2][4][2];
#pragma unroll
    for (int a = 0; a < 2; ++a)
#pragma unroll
        for (int b = 0; b < 2; ++b)
#pragma unroll
            for (int m = 0; m < 4; ++m)
#pragma unroll
                for (int n = 0; n < 2; ++n) acc[a][b][m][n] = (f32x4){0.f, 0.f, 0.f, 0.f};
    bf16x8 At[4][2], B0[2][2], B1[2][2];
    const char* cA = a_of(g, cur.pn) + (size_t)cur.pm * tstep + (size_t)cur.kofs * 2; const char* cB = (const char*)g.Bt + (size_t)cur.pn * tstep + (size_t)cur.kofs * 2;
    PG8_STAGE(PG8_SB(0, 0), cB, voffB); PG8_STAGE(PG8_SB(0, 1), cB + hstep, voffB); PG8_STAGE(PG8_SA(0, 0), cA, voffA); PG8_STAGE(PG8_SA(0, 1), cA + hstep, voffA);
    if (wr == 1) PG8_BAR;
    PG8_WAIT_V(2); PG8_BAR;
    PG8_STAGE(PG8_SB(1, 0), cB + kstep, voffB); PG8_STAGE(PG8_SA(1, 0), cA + kstep, voffA); PG8_STAGE(PG8_SB(1, 1), cB + hstep + kstep, voffB);
    PG8_WAIT_V(6); PG8_BAR;
    for (;;) {
        const bool has_next = S.next(ui + 1, nxt);
        const char* nA = has_next ? a_of(g, nxt.pn) + (size_t)nxt.pm * tstep + (size_t)nxt.kofs * 2 : cA; const char* nB = has_next ? (const char*)g.Bt + (size_t)nxt.pn * tstep + (size_t)nxt.kofs * 2 : cB;
        const int nt = cur.knt;
        for (int t = 0; t < nt; t += 2) {
            const bool last = (t == nt - 2);
            const char* a1 = cA + (size_t)(t + 1) * kstep;
            const char* a2 = last ? nA : cA + (size_t)(t + 2) * kstep; const char* b2 = last ? nB : cB + (size_t)(t + 2) * kstep;
            const char* a3 = a2 + kstep; const char* b3 = b2 + kstep;
            PG8_LDB(B0, 0, 0); PG8_LDB(B1, 0, 1); PG8_SCHED; PG8_LDA(At, 0, 0); PG8_STAGE(PG8_SA(1, 1), a1 + hstep, voffA);
            PG8_WAIT_V(8); PG8_WAIT_L(0); PG8_BAR; PG8_MMA(0, 0, At, B0); PG8_MMA(0, 1, At, B1); PG8_BAR; PG8_SCHED;
            PG8_LDA(At, 0, 1); PG8_STAGE(PG8_SB(0, 0), b2, voffB); PG8_STAGE(PG8_SB(0, 1), b2 + hstep, voffB); PG8_STAGE(PG8_SA(0, 0), a2, voffA);
            PG8_WAIT_V(8); PG8_WAIT_L(0); PG8_BAR; PG8_MMA(1, 0, At, B0); PG8_MMA(1, 1, At, B1); PG8_BAR; PG8_SCHED;
            PG8_LDB(B0, 1, 0); PG8_LDB(B1, 1, 1); PG8_SCHED; PG8_LDA(At, 1, 0); PG8_STAGE(PG8_SA(0, 1), a2 + hstep, voffA);
            PG8_WAIT_V(8); PG8_WAIT_L(0); PG8_BAR; PG8_MMA(0, 0, At, B0); PG8_MMA(0, 1, At, B1); PG8_BAR; PG8_SCHED;
            PG8_LDA(At, 1, 1); PG8_STAGE(PG8_SB(1, 0), b3, voffB); PG8_STAGE(PG8_SB(1, 1), b3 + hstep, voffB); PG8_STAGE(PG8_SA(1, 0), a3, voffA);
            PG8_WAIT_V(8); PG8_WAIT_L(0); PG8_BAR; PG8_MMA(1, 0, At, B0); PG8_MMA(1, 1, At, B1); PG8_BAR; PG8_SCHED;
        }
        if (wr == 0) PG8_BAR;
        E(acc, cur, wr, wc, fr, fq);
        if (!has_next) break;
#pragma unroll
        for (int a = 0; a < 2; ++a)
#pragma unroll
            for (int b = 0; b < 2; ++b)
#pragma unroll
                for (int m = 0; m < 4; ++m)
#pragma unroll
                    for (int n = 0; n < 2; ++n) acc[a][b][m][n] = (f32x4){0.f, 0.f, 0.f, 0.f};
        cur = nxt; cA = nA; cB = nB; ++ui;
        if (wr == 1) PG8_BAR;
    }
    PG8_WAIT_V(0);
    PG8_BAR;
#undef PG8_SA
#undef PG8_SB
#undef PG8_STAGE
#undef PG8_LDA
#undef PG8_LDB
#undef PG8_MMA
#undef PG8_WAIT_V
#undef PG8_WAIT_L
#undef PG8_BAR
#undef PG8_SCHED
}
}

__device__ __forceinline__ void store8bf(bf16_t* p, f32x4 a, f32x4 b) {
    u32x4 w; w.x = cvt_pk_bf16(a[0], a[1]); w.y = cvt_pk_bf16(a[2], a[3]); w.z = cvt_pk_bf16(b[0], b[1]); w.w = cvt_pk_bf16(b[2], b[3]);
    *(u32x4*)p = w;
}
struct FRes { float* X; float* PART;
    __device__ __forceinline__ void operator()(int row, int col, f32x4 a, f32x4 b, int split) const {
        float* p = X + (size_t)row * DM + col;
        if (split) { float* q = PART + (size_t)(split - 1) * 65536 + (row & 255) * 256 + (col & 255); *(f32x4*)q = a; *(f32x4*)(q + 4) = b; }
        else { f32x4 x0 = *(f32x4*)p, x1 = *(f32x4*)(p + 4); *(f32x4*)p = x0 + a; *(f32x4*)(p + 4) = x1 + b; } } };
struct FR1 { bf16_t *R, *K, *V, *L;
    __device__ __forceinline__ void operator()(int row, int col, f32x4 a, f32x4 b, int) const {
        if (col < 6144) { const int g = col >> 11; const size_t o = (size_t)row * DM + (col & 2047); if (g == 0) store8bf(R + o, a, b); else if (g == 1) store8bf(K + o, a, b); else store8bf(V + o, a, b); }
        else { const int t = (col - 6144) >> 8, c = col & 255;
            if (t == 0) { for (int i = 0; i < 4; ++i) { a[i] = 1.f - 2.f / (1.f + __expf(2.f * a[i])); b[i] = 1.f - 2.f / (1.f + __expf(2.f * b[i])); } }
            else if (t == 2) { for (int i = 0; i < 4; ++i) { a[i] = sigmoidf_(a[i]); b[i] = sigmoidf_(b[i]); } }
            store8bf(L + (size_t)t * MROWS * 256 + (size_t)row * 256 + c, a, b); } } };
__device__ __forceinline__ float decay_of(float z) { return -0.60653065971f / (1.f + __expf(-z)); }
struct FR2 { float* DD; bf16_t *AA, *GG, *VG; const float *w0, *a0, *v0;
    __device__ __forceinline__ void operator()(int row, int col, f32x4 a, f32x4 b, int) const {
        const int g = col >> 11, c = col & 2047; const size_t off = (size_t)row * DM + c;
        if (g == 0) { f32x4 z0 = *(const f32x4*)(w0 + c), z1 = *(const f32x4*)(w0 + c + 4); a += z0; b += z1;
            for (int i = 0; i < 4; ++i) { a[i] = decay_of(a[i]); b[i] = decay_of(b[i]); }
            *(f32x4*)(DD + off) = a; *(f32x4*)(DD + off + 4) = b; }
        else if (g == 1) { f32x4 z0 = *(const f32x4*)(a0 + c), z1 = *(const f32x4*)(a0 + c + 4); a += z0; b += z1;
            for (int i = 0; i < 4; ++i) { a[i] = sigmoidf_(a[i]); b[i] = sigmoidf_(b[i]); } store8bf(AA + off, a, b); }
        else if (g == 2) { store8bf(GG + off, a, b); }
        else { f32x4 z0 = *(const f32x4*)(v0 + c), z1 = *(const f32x4*)(v0 + c + 4); a += z0; b += z1;
            for (int i = 0; i < 4; ++i) { a[i] = sigmoidf_(a[i]); b[i] = sigmoidf_(b[i]); } store8bf(VG + off, a, b); } } };
struct FG1 { bf16_t* PROJ; float* LR;
    __device__ __forceinline__ void operator()(int row, int col, f32x4 a, f32x4 b, int) const {
        if (col < 6144) { if (col < 1024) { a *= 0.0625f; b *= 0.0625f; } store8bf(PROJ + (size_t)row * 6144 + col, a, b); }
        else if (col < 6160) { float* p = LR + (size_t)row * 16 + (col - 6144); *(f32x4*)p = a; *(f32x4*)(p + 4) = b; } } };
struct FUp { bf16_t* U; float* pconv; float* sconv;
    __device__ __forceinline__ void operator()(int row, int col, f32x4 a, f32x4 b, int) const {
        store8bf(U + (size_t)row * F2 + col, a, b);
        if (row < MPROMPT) { const int t = row & 8191; if (t >= 8190) { float* p = pconv + ((size_t)((row >> 13) * 2 + (t - 8190))) * F2 + col; *(f32x4*)p = a; *(f32x4*)(p + 4) = b; } }
        else { const int rr = row - MPROMPT, t = rr & 63; if (t >= 62) { float* p = sconv + ((size_t)((rr >> 6) * 2 + (t - 62))) * F2 + col; *(f32x4*)p = a; *(f32x4*)(p + 4) = b; } } } };

__device__ __forceinline__ void tr_item(const float* W, int K, int N, bf16_t* WT, int Kpad, int Npad, float* scr, int item, int lane) {
    const int nblk = Npad / 64, kb = item / nblk, nb = item % nblk, k0 = 64 * kb, n0 = 64 * nb;
    const int n4 = n0 + (lane & 15) * 4;
    f32x4 v[16];
#pragma unroll
    for (int i = 0; i < 16; ++i) { const int k = k0 + 4 * i + (lane >> 4); v[i] = (k < K && n4 < N) ? *(const f32x4*)(W + (size_t)k * N + n4) : (f32x4){0.f, 0.f, 0.f, 0.f}; }
#pragma unroll
    for (int i = 0; i < 16; ++i) { float* d = scr + (4 * i + (lane >> 4)) * 65 + (lane & 15) * 4; d[0] = v[i][0]; d[1] = v[i][1]; d[2] = v[i][2]; d[3] = v[i][3]; }
    asm volatile("s_waitcnt lgkmcnt(0)" ::: "memory");
    const int c = lane & 7;
#pragma unroll
    for (int j = 0; j < 8; ++j) { const int nn = (lane >> 3) + 8 * j; const float* s = scr + (8 * c) * 65 + nn;
        u32x4 o; o.x = cvt_pk_bf16(s[0 * 65], s[1 * 65]); o.y = cvt_pk_bf16(s[2 * 65], s[3 * 65]); o.z = cvt_pk_bf16(s[4 * 65], s[5 * 65]); o.w = cvt_pk_bf16(s[6 * 65], s[7 * 65]);
        *(u32x4*)(WT + (size_t)(n0 + nn) * Kpad + k0 + 8 * c) = o; }
    asm volatile("s_waitcnt lgkmcnt(0)" ::: "memory");
}

struct P { const float* in[39]; float* out; unsigned char* ws; };

__device__ __forceinline__ void row_info(int row, int& t, int& len, int& b, bool& prompt) {
    if (row < MPROMPT) { prompt = true; b = row >> 13; t = row & 8191; len = 8192; }
    else { prompt = false; const int rr = row - MPROMPT; b = rr >> 6; t = rr & 63; len = 64; }
}

__device__ __forceinline__ const float* ldp(const unsigned long long* tab, int i) {
    const unsigned long long v = tab[i];
    const unsigned lo = __builtin_amdgcn_readfirstlane((unsigned)v), hi = __builtin_amdgcn_readfirstlane((unsigned)(v >> 32));
    const __attribute__((address_space(1))) float* g = (const __attribute__((address_space(1))) float*)(((unsigned long long)hi << 32) | lo);
    return (const float*)g;
}
__device__ __forceinline__ void fast_grid_barrier(unsigned* bar, unsigned long long* tab) {
    asm volatile("s_waitcnt vmcnt(0)" ::: "memory");
    __syncthreads();
    if (threadIdx.x == 0) {
        const unsigned G = gridDim.x, grp = blockIdx.x & 7u;
        const unsigned epoch = (unsigned)tab[41] + 1u; tab[41] = epoch;
        const unsigned ngrp = (G - grp + 7u) >> 3, ntop = G < 8u ? G : 8u;
        __builtin_amdgcn_fence(__ATOMIC_RELEASE, "agent");
        asm volatile("s_waitcnt vmcnt(0)" ::: "memory");
        const unsigned old = __hip_atomic_fetch_add(&bar[64u * (1u + grp)], 1u, __ATOMIC_RELAXED, __HIP_MEMORY_SCOPE_AGENT);
        if (old + 1u == epoch * ngrp) (void)__hip_atomic_fetch_add(&bar[0], 1u, __ATOMIC_RELAXED, __HIP_MEMORY_SCOPE_AGENT);
        while (__hip_atomic_load(&bar[0], __ATOMIC_RELAXED, __HIP_MEMORY_SCOPE_AGENT) < epoch * ntop) __builtin_amdgcn_s_sleep(1);
        __builtin_amdgcn_fence(__ATOMIC_ACQUIRE, "agent");
        asm volatile("s_waitcnt vmcnt(0)" ::: "memory");
    }
    __syncthreads();
}
#define IN(k) ldp(tab, (k))
#define OUTP ((float*)ldp(tab, 39))
#define BASES float* X = (float*)ldp(tab, 39); unsigned char* ws_ = (unsigned char*)ldp(tab, 40); bf16_t* WT = (bf16_t*)(ws_ + WS_WT); unsigned char* RA = ws_ + WS_A; unsigned char* RB = ws_ + WS_B; \
    bf16_t* VFIRST = (bf16_t*)(ws_ + WS_VF); LAS unsigned char* ldsl = (LAS unsigned char*)lds; (void)X; (void)WT; (void)RA; (void)RB; (void)VFIRST; (void)ldsl;
#define RWKV_PTRS bf16_t* HB = (bf16_t*)RA; bf16_t* Rb = (bf16_t*)RB; bf16_t* Kb = Rb + ACT; bf16_t* Vb = (jl == 0) ? VFIRST : Kb + ACT; bf16_t* Lb = (bf16_t*)(RB + 204 * MiB); \
    float* DD = (float*)(RB + 240 * MiB); bf16_t* AA = (bf16_t*)RA; bf16_t* VG = AA + ACT; bf16_t* GG = VG + ACT; bf16_t* Y = GG + ACT; \
    bf16_t* W1 = WT + jl * RW_SZ; bf16_t* W2 = W1 + (size_t)7168 * 2048; bf16_t* WO = W2 + (size_t)8192 * 256; \
    (void)HB; (void)Rb; (void)Kb; (void)Vb; (void)Lb; (void)DD; (void)AA; (void)VG; (void)GG; (void)Y; (void)W1; (void)W2; (void)WO;
#define GLA_PTRS bf16_t* H = (bf16_t*)RB; float* LR = (float*)(RB + 68 * MiB); float* O = (float*)(RB + 70 * MiB); bf16_t* Y = (bf16_t*)(RB + 206 * MiB); \
    bf16_t* PROJ = (bf16_t*)RA; bf16_t* QE = (bf16_t*)(RA + 204 * MiB); bf16_t* KDT = (bf16_t*)(RA + 238 * MiB); bf16_t* VT = (bf16_t*)(RA + 272 * MiB); \
    bf16_t* SC = (bf16_t*)(RA + 340 * MiB); float* EL = (float*)(RA + 349 * MiB); bf16_t* GI = WT + GW_OFF + jl * GW_SZ; bf16_t* GO = GI + (size_t)6400 * 2048; \
    (void)H; (void)LR; (void)O; (void)Y; (void)PROJ; (void)QE; (void)KDT; (void)VT; (void)SC; (void)EL; (void)GI; (void)GO;
#define FFN_PTRS bf16_t* H = (bf16_t*)RB; bf16_t* HID = (bf16_t*)(RB + 68 * MiB); bf16_t* U = (bf16_t*)RA; bf16_t* WU = WT + FW_OFF + layer * FW_SZ; bf16_t* WD = WU + (size_t)F2 * 2048; \
    (void)H; (void)HID; (void)U; (void)WU; (void)WD;

__global__ void __launch_bounds__(512, 2) fwd_kernel(P p) {
    extern __shared__ __attribute__((aligned(16))) unsigned char lds[];
    cg::grid_group grid = cg::this_grid();
    const int G = gridDim.x, NGW = G * 8, NT = G * 512;
#define PHASE_IDS int tid = threadIdx.x; asm volatile("" : "+v"(tid)); const int lane = tid & 63; const int wave = __builtin_amdgcn_readfirstlane(tid >> 6); const int gw = blockIdx.x * 8 + wave; const int gtid = blockIdx.x * 512 + tid; (void)lane; (void)gw; (void)gtid;
    unsigned long long* tab = (unsigned long long*)(lds + LDS_BYTES - 512);
    if (threadIdx.x == 0) {
#pragma unroll
        for (int i = 0; i < 39; ++i) tab[i] = (unsigned long long)p.in[i];
        tab[39] = (unsigned long long)p.out; tab[40] = (unsigned long long)p.ws; tab[41] = 0ull;
    }
    __syncthreads();

    {
        PHASE_IDS BASES
        if (blockIdx.x == 0) { for (int i = tid; i < 1024; i += 512) ((unsigned*)ws_)[i] = 0u; }
        float* scr = (float*)(lds + wave * 16896);
#define TR(src, K, N, dst, Kpad, Npad) do { const int _ni = ((Kpad) / 64) * ((Npad) / 64); for (int it = cgw_; it < _ni; it += cngw_) tr_item((src), (K), (N), (dst), (Kpad), (Npad), scr, it, lane); } while (0)
#define CONVERT_WEIGHTS(JLO, JHI, ILO, IHI, GWV, NGWV) do { const int cgw_ = (GWV), cngw_ = (NGWV); \
        _Pragma("unroll 1") for (int j = (JLO); j < (JHI); ++j) { \
            bf16_t* W1 = WT + j * RW_SZ; bf16_t* W2 = W1 + (size_t)7168 * 2048; bf16_t* WO = W2 + (size_t)8192 * 256; \
            TR(IN(24) + (size_t)j * DM * DM, 2048, 2048, W1, 2048, 2048); \
            TR(IN(25) + (size_t)j * DM * DM, 2048, 2048, W1 + (size_t)2048 * 2048, 2048, 2048); \
            TR(IN(26) + (size_t)j * DM * DM, 2048, 2048, W1 + (size_t)4096 * 2048, 2048, 2048); \
            TR(IN(11) + (size_t)j * DM * 96, 2048, 96, W1 + (size_t)6144 * 2048, 2048, 256); \
            TR(IN(14) + (size_t)j * DM * 96, 2048, 96, W1 + (size_t)6400 * 2048, 2048, 256); \
            TR(IN(19) + (size_t)j * DM * 256, 2048, 256, W1 + (size_t)6656 * 2048, 2048, 256); \
            if (j >= 1) TR(IN(17) + (size_t)(j - 1) * DM * 64, 2048, 64, W1 + (size_t)6912 * 2048, 2048, 256); \
            TR(IN(12) + (size_t)j * 96 * DM, 96, 2048, W2, 256, 2048); \
            TR(IN(15) + (size_t)j * 96 * DM, 96, 2048, W2 + (size_t)2048 * 256, 256, 2048); \
            TR(IN(20) + (size_t)j * 256 * DM, 256, 2048, W2 + (size_t)4096 * 256, 256, 2048); \
            if (j >= 1) TR(IN(18) + (size_t)(j - 1) * 64 * DM, 64, 2048, W2 + (size_t)6144 * 256, 256, 2048); \
            TR(IN(27) + (size_t)j * DM * DM, 2048, 2048, WO, 2048, 2048); \
            bf16_t* GI = WT + GW_OFF + j * GW_SZ; bf16_t* GO = GI + (size_t)6400 * 2048; \
            TR(IN(30) + (size_t)j * DM * 6160, 2048, 6160, GI, 2048, 6400); \
            TR(IN(34) + (size_t)j * DM * DM, 2048, 2048, GO, 2048, 2048); \
        } \
        _Pragma("unroll 1") for (int i = (ILO); i < (IHI); ++i) { \
            bf16_t* WU = WT + FW_OFF + i * FW_SZ; bf16_t* WD = WU + (size_t)F2 * 2048; \
            TR(IN(35) + (size_t)i * DM * F2, 2048, F2, WU, 2048, F2); \
            TR(IN(38) + (size_t)i * FH * DM, FH, 2048, WD, FH, 2048); \
        } } while (0)
        if (G >= 256) CONVERT_WEIGHTS(0, 1, 0, 2, gw, NGW); else CONVERT_WEIGHTS(0, 2, 0, 4, gw, NGW);
        const f32x4* xp = (const f32x4*)IN(0); const f32x4* xs = (const f32x4*)IN(1); f32x4* xo = (f32x4*)X;
        const int NP4 = MPROMPT * DM / 4, NA4 = MROWS * DM / 4;
#pragma unroll 4
        for (int i = gtid; i < NA4; i += NT) xo[i] = i < NP4 ? xp[i] : xs[i - NP4];
    }
    grid.sync();

#pragma clang loop unroll(full)
    for (int layer = 0; layer < 4; ++layer) {
        const int jl = layer >> 1;
        if ((layer & 1) == 0) {
            {
                PHASE_IDS BASES RWKV_PTRS
                const float* gmix = IN(6) + (size_t)layer * DM;
                const float* mix = IN(9) + (size_t)jl * 6 * DM;
                const float* sst = IN(2) + (size_t)jl * 16 * DM;
                float* mixS = (float*)lds; float* gS = mixS + 6 * DM;
                for (int i = tid; i < 6 * DM / 4; i += 512) *(f32x4*)(mixS + i * 4) = *(const f32x4*)(mix + i * 4);
                for (int i = tid; i < DM / 4; i += 512) *(f32x4*)(gS + i * 4) = *(const f32x4*)(gmix + i * 4);
                __syncthreads();
                for (int row = gw; row < MROWS; row += NGW) {
                    int t, len, b; bool prompt; row_info(row, t, len, b, prompt);
                    const f32x4* xr = (const f32x4*)(X + (size_t)row * DM) + lane;
                    f32x4 x[8]; float ss = 0.f;
#pragma unroll
                    for (int q = 0; q < 8; ++q) { x[q] = xr[64 * q]; ss += x[q][0] * x[q][0] + x[q][1] * x[q][1] + x[q][2] * x[q][2] + x[q][3] * x[q][3]; }
                    const float rs = rsqrtf(wave_sum(ss, lane) * (1.f / DM) + 1e-6f);
                    f32x4 hp[8];
                    if (t > 0) {
                        const f32x4* xq = (const f32x4*)(X + (size_t)(row - 1) * DM) + lane; float s2 = 0.f;
#pragma unroll
                        for (int q = 0; q < 8; ++q) { hp[q] = xq[64 * q]; s2 += hp[q][0] * hp[q][0] + hp[q][1] * hp[q][1] + hp[q][2] * hp[q][2] + hp[q][3] * hp[q][3]; }
                        const float rp = rsqrtf(wave_sum(s2, lane) * (1.f / DM) + 1e-6f);
#pragma unroll
                        for (int q = 0; q < 8; ++q) { const f32x4 gg = *((const f32x4*)gS + lane + 64 * q); hp[q] = hp[q] * rp * gg; }
                    } else if (!prompt) {
#pragma unroll
                        for (int q = 0; q < 8; ++q) hp[q] = *((const f32x4*)(sst + (size_t)b * DM) + lane + 64 * q);
                    } else {
#pragma unroll
                        for (int q = 0; q < 8; ++q) hp[q] = (f32x4){0.f, 0.f, 0.f, 0.f};
                    }
                    const bool lastrow = (t == len - 1);
                    float* shout = OUTP + (prompt ? O_PSHIFT + ((size_t)jl * 2 + b) * DM : O_SSHIFT + ((size_t)jl * 16 + b) * DM);
#pragma unroll
                    for (int q = 0; q < 8; ++q) {
                        const f32x4 gg = *((const f32x4*)gS + lane + 64 * q);
                        const f32x4 h = x[q] * rs * gg; const f32x4 dlt = hp[q] - h;
                        if (lastrow) *((f32x4*)shout + lane + 64 * q) = h;
#pragma unroll
                        for (int m = 0; m < 6; ++m) {
                            const f32x4 mx = *((const f32x4*)(mixS + m * DM) + lane + 64 * q);
                            const f32x4 o = h + dlt * mx;
                            u32x2 w; w.x = cvt_pk_bf16(o[0], o[1]); w.y = cvt_pk_bf16(o[2], o[3]);
                            *((u32x2*)(HB + (size_t)m * ACT + (size_t)row * DM) + lane + 64 * q) = w;
                        }
                    }
                }
            }
            fast_grid_barrier((unsigned*)ldp(tab, 40), tab);
            {
                BASES RWKV_PTRS
                pg8::Gemm g{HB, W1, MROWS, jl == 0 ? 6912 : 7168, 2048, 1, ACT * 2};
                pg8::StaticOrder S; S.init(g.M, g.N, G, (int)blockIdx.x, g.K, 1);
                pg8::Epi<FR1> E{FR1{Rb, Kb, Vb, Lb}};
                pg8::gemm_phase(ldsl, g, S, E);
            }
            fast_grid_barrier((unsigned*)ldp(tab, 40), tab);
            {
                BASES RWKV_PTRS
                pg8::Gemm g{Lb, W2, MROWS, jl == 0 ? 6144 : 8192, 256, 2, (size_t)MROWS * 256 * 2};
                pg8::StaticOrder S; S.init(g.M, g.N, G, (int)blockIdx.x, g.K, 1);
                pg8::Epi<FR2> E{FR2{DD, AA, GG, VG, IN(10) + (size_t)jl * DM, IN(13) + (size_t)jl * DM, IN(16) + (size_t)(jl > 0 ? jl - 1 : 0) * DM}};
                pg8::gemm_phase(ldsl, g, S, E);
            }
            fast_grid_barrier((unsigned*)ldp(tab, 40), tab);
            {
                PHASE_IDS BASES RWKV_PTRS
                float* Obuf = (float*)(RA + 272 * MiB); float* RK = (float*)(RB + 204 * MiB); float* DTg = (float*)(RB + 208 * MiB);
                const float* k_k = IN(21) + (size_t)jl * DM; const float* k_a = IN(22) + (size_t)jl * DM; const float* r_k = IN(23) + (size_t)jl * DM;
                const int l32 = lane & 31, hl = lane >> 5;
#define S1_BAR do { asm volatile("s_waitcnt lgkmcnt(0)" ::: "memory"); __builtin_amdgcn_s_barrier(); asm volatile("" ::: "memory"); } while (0)
                const int st = tid >> 3, c0 = (tid & 7) * 8;
                u32x4 pr_, pk_, pv_, pa_, pvf_ = (u32x4){0u, 0u, 0u, 0u}, pvg_ = (u32x4){0u, 0u, 0u, 0u}; f32x4 pd0_, pd1_;
#define S1_FETCH(it) do { const size_t _off = (size_t)(((it) >> 5) * 64 + st) * DM + ((it) & 31) * 64 + c0; \
                    pr_ = *(const u32x4*)(Rb + _off); pk_ = *(const u32x4*)(Kb + _off); pv_ = *(const u32x4*)(Vb + _off); pa_ = *(const u32x4*)(AA + _off); \
                    pd0_ = *(const f32x4*)(DD + _off); pd1_ = *(const f32x4*)(DD + _off + 4); \
                    if (jl > 0) { pvf_ = *(const u32x4*)(VFIRST + _off); pvg_ = *(const u32x4*)(VG + _off); } } while (0)
                if ((int)blockIdx.x < 8704) S1_FETCH((int)blockIdx.x);
#pragma unroll 1
                for (int item = blockIdx.x; item < 8704; item += G) {
                    LAS unsigned char* ldsv = (LAS unsigned char*)lds; asm volatile("" : "+v"(ldsv));
                    LAS bf16_t* AH = (LAS bf16_t*)(ldsv + 0); LAS bf16_t* RH = (LAS bf16_t*)(ldsv + 9216); LAS bf16_t* BH = (LAS bf16_t*)(ldsv + 18432); LAS bf16_t* KH = (LAS bf16_t*)(ldsv + 27648);
                    LAS bf16_t* BHT = (LAS bf16_t*)(ldsv + 36864); LAS bf16_t* KHT = (LAS bf16_t*)(ldsv + 46080); LAS bf16_t* VTs = (LAS bf16_t*)(ldsv + 55296); LAS bf16_t* XT = (LAS bf16_t*)(ldsv + 64512);
                    LAS float* AAB = (LAS float*)(ldsv + 82944); LAS bf16_t* AAK = (LAS bf16_t*)(ldsv + 99328); LAS bf16_t* ARB = (LAS bf16_t*)(ldsv + 108544); LAS bf16_t* ARK = (LAS bf16_t*)(ldsv + 117760);
                    LAS float* LB = (LAS float*)(ldsv + 126976); LAS float* DTS = (LAS float*)(ldsv + 143360);
                    (void)RH; (void)KH; (void)KHT;
                    const int chunk = item >> 5, h = item & 31, r0 = chunk * 64;
                    const int col = h * 64 + c0;
                    float r[8], kk[8], bb[8], km[8], ld[8];
                    {
                        float k[8], v[8], a[8];
                        unpack8(pr_, r); unpack8(pk_, k); unpack8(pv_, v); unpack8(pa_, a);
                        const f32x4 d0 = pd0_, d1 = pd1_;
                        ld[0] = d0[0]; ld[1] = d0[1]; ld[2] = d0[2]; ld[3] = d0[3]; ld[4] = d1[0]; ld[5] = d1[1]; ld[6] = d1[2]; ld[7] = d1[3];
                        if (jl > 0) { float vf[8], vg[8]; unpack8(pvf_, vf); unpack8(pvg_, vg);
#pragma unroll
                            for (int i = 0; i < 8; ++i) v[i] = v[i] + (vf[i] - v[i]) * vg[i]; }
                        float ss = 0.f;
#pragma unroll
                        for (int i = 0; i < 8; ++i) { kk[i] = k[i] * k_k[col + i]; ss += kk[i] * kk[i]; }
                        ss = sum8(ss, lane);
                        const float inv = 1.f / fmaxf(sqrtf(ss), 1e-12f);
                        float rk = 0.f;
#pragma unroll
                        for (int i = 0; i < 8; ++i) { kk[i] *= inv; bb[i] = kk[i] * a[i]; km[i] = k[i] * (1.f + (a[i] - 1.f) * k_a[col + i]); rk += r[i] * km[i] * r_k[col + i]; }
                        rk = sum8(rk, lane);
                        if ((tid & 7) == 0) RK[(size_t)(r0 + st) * 32 + h] = rk;
                        *(LAS f32x4*)(LB + st * 64 + c0) = d0; *(LAS f32x4*)(LB + st * 64 + c0 + 4) = d1;
#pragma unroll
                        for (int i = 0; i < 8; i += 2) { const unsigned pk = cvt_pk_bf16(v[i], v[i + 1]); VTs[(c0 + i) * 72 + st] = (bf16_t)(pk & 0xffffu); VTs[(c0 + i + 1) * 72 + st] = (bf16_t)(pk >> 16); }
                    }
                    S1_BAR;
                    {
                        const int cc_ = tid & 63, tq_ = tid >> 6; float pf[8]; float run = 0.f;
#pragma unroll
                        for (int j = 0; j < 8; ++j) { run += LB[(8 * tq_ + j) * 64 + cc_]; pf[j] = run; }
                        AAB[tq_ * 64 + cc_] = run;
                        S1_BAR;
                        float ofs = 0.f;
#pragma unroll
                        for (int g = 0; g < 7; ++g) ofs += (g < tq_) ? AAB[g * 64 + cc_] : 0.f;
#pragma unroll
                        for (int j = 0; j < 8; ++j) LB[(8 * tq_ + j) * 64 + cc_] = pf[j] + ofs;
                    }
                    S1_BAR;
                    {
                        float ah[8], bh[8], kh[8], rh[8];
#pragma unroll
                        for (int i = 0; i < 8; ++i) { const float Lt = LB[st * 64 + c0 + i]; const float e3 = __expf(Lt), e2 = __expf(-Lt), e1 = __expf(Lt - ld[i]);
                            ah[i] = -kk[i] * e1; bh[i] = bb[i] * e2; kh[i] = km[i] * e2; rh[i] = r[i] * e3;
                            if (st == 63) { DTS[c0 + i] = e3; DTg[(size_t)item * 64 + c0 + i] = e3; } }
                        *(LAS u32x4*)(AH + st * 72 + c0) = pack8(ah); *(LAS u32x4*)(RH + st * 72 + c0) = pack8(rh);
                        *(LAS u32x4*)(BH + st * 72 + c0) = pack8(bh); *(LAS u32x4*)(KH + st * 72 + c0) = pack8(kh);
#pragma unroll
                        for (int i = 0; i < 8; i += 2) { const unsigned p1 = cvt_pk_bf16(bh[i], bh[i + 1]), p2 = cvt_pk_bf16(kh[i], kh[i + 1]);
                            BHT[(c0 + i) * 72 + st] = (bf16_t)(p1 & 0xffffu); BHT[(c0 + i + 1) * 72 + st] = (bf16_t)(p1 >> 16);
                            KHT[(c0 + i) * 72 + st] = (bf16_t)(p2 & 0xffffu); KHT[(c0 + i + 1) * 72 + st] = (bf16_t)(p2 >> 16); }
                    }
                    S1_BAR;
                    {
                        const int mi = wave & 3, rowsel = mi >> 1, tt = mi & 1;
#pragma unroll
                        for (int nn = 0; nn < 2; ++nn) {
                            const int colsel = wave >> 2, stl = nn; const int ni = 2 * colsel + nn;
                            f32x16 acc;
#pragma unroll
                            for (int i = 0; i < 16; ++i) acc[i] = 0.f;
                            if (stl <= tt) {
#pragma unroll
                                for (int ks = 0; ks < 4; ++ks) {
                                    const bf16x8 a = *(const LAS bf16x8*)(AH + (mi * 32 + l32) * 72 + ks * 16 + hl * 8);
                                    const bf16x8 b = *(const LAS bf16x8*)(BH + (ni * 32 + l32) * 72 + ks * 16 + hl * 8);
                                    acc = __builtin_amdgcn_mfma_f32_32x32x16_bf16(a, b, acc, 0, 0, 0);
                                }
                            }
#pragma unroll
                            for (int i = 0; i < 16; ++i) {
                                const int t = tt * 32 + crow(i, hl), s = stl * 32 + l32;
                                const bool keep = rowsel ? (s <= t) : (s < t);
                                const float val = keep ? acc[i] : 0.f;
                                if (rowsel == 0 && colsel == 0) AAB[t * 64 + s] = val;
                                else { LAS bf16_t* dst = (rowsel == 0) ? AAK : (colsel == 0 ? ARB : ARK); dst[t * 72 + s] = (bf16_t)(cvt_pk_bf16(val, 0.f) & 0xffffu); }
                            }
                        }
                    }
                    S1_BAR;
                    if (wave < 4) {
                        const int mt = wave >> 1, nt = wave & 1;
                        f32x16 acc;
#pragma unroll
                        for (int i = 0; i < 16; ++i) acc[i] = 0.f;
#pragma unroll
                        for (int ks = 0; ks < 4; ++ks) {
                            const bf16x8 a = *(const LAS bf16x8*)(AAK + (mt * 32 + l32) * 72 + ks * 16 + hl * 8);
                            const bf16x8 b = *(const LAS bf16x8*)(VTs + (nt * 32 + l32) * 72 + ks * 16 + hl * 8);
                            acc = __builtin_amdgcn_mfma_f32_32x32x16_bf16(a, b, acc, 0, 0, 0);
                        }
#pragma unroll
                        for (int i = 0; i < 16; ++i) LB[(mt * 32 + crow(i, hl)) * 64 + nt * 32 + l32] = acc[i];
                    }
                    S1_BAR;
                    {
                        const int colx = tid >> 2, par = tid & 3;
                        float Xp[4][4];
#pragma unroll
                        for (int i = 0; i < 4; ++i) { Xp[i][0] = 0.f; Xp[i][1] = 0.f; Xp[i][2] = 0.f; Xp[i][3] = 0.f; }
#pragma clang loop unroll(full)
                        for (int t = 0; t < 64; ++t) {
                            const float va_ = bf2f(AH[t * 72 + (colx & 63)]), vb_ = LB[t * 64 + (colx & 63)];
                            float a0 = par ? 0.f : ((colx < 64) ? va_ : vb_);
                            float a1 = 0.f, a2 = 0.f, a3 = 0.f;
#pragma clang loop unroll(full)
                            for (int i = 0; 16 * i < t; ++i) { const f32x4 w = *(const LAS f32x4*)(AAB + t * 64 + 16 * i + 4 * par);
                                a0 += w[0] * Xp[i][0]; a1 += w[1] * Xp[i][1]; a2 += w[2] * Xp[i][2]; a3 += w[3] * Xp[i][3]; }
                            float val = (a0 + a1) + (a2 + a3);
                            val += __builtin_bit_cast(float, __builtin_amdgcn_update_dpp(0, __builtin_bit_cast(int, val), 0xB1, 0xf, 0xf, false));
                            val += __builtin_bit_cast(float, __builtin_amdgcn_update_dpp(0, __builtin_bit_cast(int, val), 0x4E, 0xf, 0xf, false));
                            Xp[t >> 4][t & 3] = (par == ((t >> 2) & 3)) ? val : Xp[t >> 4][t & 3];
                            asm volatile("" : "+v"(Xp[t >> 4][t & 3]));
                        }
#pragma unroll
                        for (int i = 0; i < 4; ++i) { u32x2 w; w.x = cvt_pk_bf16(Xp[i][0], Xp[i][1]); w.y = cvt_pk_bf16(Xp[i][2], Xp[i][3]);
                            *(LAS u32x2*)(XT + colx * 72 + 16 * i + 4 * par) = w; }
                    }
                    S1_BAR;
                    if (item + G < 8704) S1_FETCH(item + G);
                    {
                        const int kind = wave >> 2, mt = (wave & 3) >> 1, nt = wave & 1;
                        {
                            const LAS bf16_t* Ap = (kind == 0 ? ARB : BHT) + (mt * 32 + l32) * 72; const LAS bf16_t* Bp = XT + (nt * 32 + l32) * 72;
                            f32x16 acc;
#pragma unroll
                            for (int i = 0; i < 16; ++i) acc[i] = 0.f;
#pragma unroll
                            for (int ks = 0; ks < 4; ++ks) acc = __builtin_amdgcn_mfma_f32_32x32x16_bf16(*(const LAS bf16x8*)(Ap + ks * 16 + hl * 8), *(const LAS bf16x8*)(Bp + ks * 16 + hl * 8), acc, 0, 0, 0);
                            bf16_t* dstb = (kind == 0) ? Rb : Kb;
#pragma unroll
                            for (int i = 0; i < 16; ++i) { const int rr = mt * 32 + crow(i, hl), cc = nt * 32 + l32;
                                float val = acc[i];
                                if (kind == 0) val += bf2f(RH[rr * 72 + cc]); else val *= DTS[rr];
                                dstb[(size_t)(r0 + rr) * DM + h * 64 + cc] = (bf16_t)(cvt_pk_bf16(val, 0.f) & 0xffffu); }
                        }
                        {
                            const LAS bf16_t* A1 = (kind == 0 ? ARB : BHT) + (mt * 32 + l32) * 72; const LAS bf16_t* A2 = (kind == 0 ? ARK : KHT) + (mt * 32 + l32) * 72;
                            const LAS bf16_t* B1 = XT + (64 + nt * 32 + l32) * 72; const LAS bf16_t* B2 = VTs + (nt * 32 + l32) * 72;
                            f32x16 acc;
#pragma unroll
                            for (int i = 0; i < 16; ++i) acc[i] = 0.f;
#pragma unroll
                            for (int ks = 0; ks < 4; ++ks) acc = __builtin_amdgcn_mfma_f32_32x32x16_bf16(*(const LAS bf16x8*)(A1 + ks * 16 + hl * 8), *(const LAS bf16x8*)(B1 + ks * 16 + hl * 8), acc, 0, 0, 0);
#pragma unroll
                            for (int ks = 0; ks < 4; ++ks) acc = __builtin_amdgcn_mfma_f32_32x32x16_bf16(*(const LAS bf16x8*)(A2 + ks * 16 + hl * 8), *(const LAS bf16x8*)(B2 + ks * 16 + hl * 8), acc, 0, 0, 0);
                            float* dstf = (kind == 0) ? Obuf : DD;
#pragma unroll
                            for (int i = 0; i < 16; ++i) { const int rr = mt * 32 + crow(i, hl), cc = nt * 32 + l32;
                                float val = acc[i]; if (kind == 1) val *= DTS[rr];
                                dstf[(size_t)(r0 + rr) * DM + h * 64 + cc] = val; }
                        }
                    }
                    S1_BAR;
                }
            }
            fast_grid_barrier((unsigned*)ldp(tab, 40), tab);
#undef S1_BAR
#undef S1_FETCH
            {
                PHASE_IDS BASES RWKV_PTRS
                const float* DTg = (const float*)(RB + 208 * MiB);
                const int l32 = lane & 31, hl = lane >> 5;
                const int q = wave * G + blockIdx.x;
                if (q < 1152) {
                    const bool prompt = q < 128; int b, h, vh, chunk0, nch;
                    if (prompt) { const int chain = q & 63; b = chain >> 5; h = chain & 31; vh = q >> 6; chunk0 = b * 128; nch = 128; }
                    else { const int sq = q - 128; const int chain = sq >> 1; b = chain >> 5; h = chain & 31; vh = sq & 1; chunk0 = 256 + b; nch = 1; }
                    const int colb = h * 64, vcol = colb + 32 * vh + l32;
                    f32x16 S0, S1;
                    if (prompt) {
#pragma unroll
                        for (int i = 0; i < 16; ++i) { S0[i] = 0.f; S1[i] = 0.f; }
                    } else {
                        const float* s0 = IN(3) + ((((size_t)jl * 16 + b) * 32 + h) * 64 + (32 * vh + l32)) * 64;
#pragma unroll
                        for (int i = 0; i < 16; ++i) { S0[i] = s0[crow(i, hl)]; S1[i] = s0[32 + crow(i, hl)]; }
                    }
                    bf16x8 gf[2][2][2]; f32x16 n0, n1; f32x4 dt_[2][4];
#define S2_COMPUTE(cc) do { const int _r0 = (chunk0 + (cc)) * 64; \
                        u32x4 w00, w01, w10, w11; \
                        w00.x = cvt_pk_bf16(S0[0], S0[1]); w00.y = cvt_pk_bf16(S0[2], S0[3]); w00.z = cvt_pk_bf16(S0[4], S0[5]); w00.w = cvt_pk_bf16(S0[6], S0[7]); \
                        w01.x = cvt_pk_bf16(S0[8], S0[9]); w01.y = cvt_pk_bf16(S0[10], S0[11]); w01.z = cvt_pk_bf16(S0[12], S0[13]); w01.w = cvt_pk_bf16(S0[14], S0[15]); \
                        w10.x = cvt_pk_bf16(S1[0], S1[1]); w10.y = cvt_pk_bf16(S1[2], S1[3]); w10.z = cvt_pk_bf16(S1[4], S1[5]); w10.w = cvt_pk_bf16(S1[6], S1[7]); \
                        w11.x = cvt_pk_bf16(S1[8], S1[9]); w11.y = cvt_pk_bf16(S1[10], S1[11]); w11.z = cvt_pk_bf16(S1[12], S1[13]); w11.w = cvt_pk_bf16(S1[14], S1[15]); \
                        const bf16x8 sb00 = __builtin_bit_cast(bf16x8, w00), sb01 = __builtin_bit_cast(bf16x8, w01), sb10 = __builtin_bit_cast(bf16x8, w10), sb11 = __builtin_bit_cast(bf16x8, w11); \
                        n0 = __builtin_amdgcn_mfma_f32_32x32x16_bf16(gf[0][0][0], sb00, n0, 0, 0, 0); n1 = __builtin_amdgcn_mfma_f32_32x32x16_bf16(gf[1][0][0], sb00, n1, 0, 0, 0); \
                        n0 = __builtin_amdgcn_mfma_f32_32x32x16_bf16(gf[0][0][1], sb01, n0, 0, 0, 0); n1 = __builtin_amdgcn_mfma_f32_32x32x16_bf16(gf[1][0][1], sb01, n1, 0, 0, 0); \
                        n0 = __builtin_amdgcn_mfma_f32_32x32x16_bf16(gf[0][1][0], sb10, n0, 0, 0, 0); n1 = __builtin_amdgcn_mfma_f32_32x32x16_bf16(gf[1][1][0], sb10, n1, 0, 0, 0); \
                        n0 = __builtin_amdgcn_mfma_f32_32x32x16_bf16(gf[0][1][1], sb11, n0, 0, 0, 0); n1 = __builtin_amdgcn_mfma_f32_32x32x16_bf16(gf[1][1][1], sb11, n1, 0, 0, 0); \
                        { unsigned char* _sp = (unsigned char*)DD + ((size_t)(_r0 + l32) * DM + colb + 32 * vh) * 4 + 8 * hl; \
                          *(u32x2*)(_sp + 0) = (u32x2){w00.x, w00.y}; *(u32x2*)(_sp + 16) = (u32x2){w00.z, w00.w}; *(u32x2*)(_sp + 32) = (u32x2){w01.x, w01.y}; *(u32x2*)(_sp + 48) = (u32x2){w01.z, w01.w}; \
                          *(u32x2*)(_sp + 64) = (u32x2){w10.x, w10.y}; *(u32x2*)(_sp + 80) = (u32x2){w10.z, w10.w}; *(u32x2*)(_sp + 96) = (u32x2){w11.x, w11.y}; *(u32x2*)(_sp + 112) = (u32x2){w11.z, w11.w}; } \
                        _Pragma("unroll") for (int i = 0; i < 16; ++i) { S0[i] = S0[i] * dt_[0][i >> 2][i & 3] + n0[i]; S1[i] = S1[i] * dt_[1][i >> 2][i & 3] + n1[i]; } \
                    } while (0)
                    if (prompt) {
                        LAS float* dtl = (LAS float*)((LAS unsigned char*)lds);
                        LAS unsigned char* ring = (LAS unsigned char*)lds + 32768;
                        for (int i = lane; i < 128 * 16; i += 64) *(LAS f32x4*)(dtl + i * 4) = *(const f32x4*)(DTg + ((size_t)(chunk0 + (i >> 4)) * 32 + h) * 64 + (i & 15) * 4);
#define S2_DMA(cc) do { const int _r0 = (chunk0 + (cc)) * 64; LAS unsigned char* _s = ring + ((cc) & 3) * 16384; \
                            _Pragma("unroll") for (int j = 0; j < 8; ++j) { const int _row = 8 * j + (lane >> 3); const int _p = (lane & 7) ^ (_row & 7); \
                                __builtin_amdgcn_global_load_lds((const unsigned*)(Kb + (size_t)(_r0 + _row) * DM + colb + _p * 8), (LAS unsigned*)(_s + j * 1024), 16, 0, 0); } \
                            _Pragma("unroll") for (int j = 0; j < 8; ++j) { const int _row = 8 * j + (lane >> 3); \
                                __builtin_amdgcn_global_load_lds((const unsigned*)(DD + (size_t)(_r0 + _row) * DM + colb + 32 * vh + (lane & 7) * 4), (LAS unsigned*)(_s + 8192 + j * 1024), 16, 0, 0); } \
                        } while (0)
                        S2_DMA(0); S2_DMA(1);
#pragma unroll 1
                        for (int c = 0; c < 128; ++c) {
                            if (c + 2 < 128) { S2_DMA(c + 2); asm volatile("s_waitcnt vmcnt(32)" ::: "memory"); }
                            else if (c + 1 < 128) asm volatile("s_waitcnt vmcnt(16)" ::: "memory");
                            else asm volatile("s_waitcnt vmcnt(0)" ::: "memory");
                            LAS unsigned char* sl = ring + (c & 3) * 16384;
#pragma unroll
                            for (int mt = 0; mt < 2; ++mt)
#pragma unroll
                                for (int kt = 0; kt < 2; ++kt)
#pragma unroll
                                    for (int s2 = 0; s2 < 2; ++s2) {
                                        const int row = 32 * mt + l32, p = 4 * kt + 2 * s2;
                                        const u32x2 lo = *(const LAS u32x2*)(sl + row * 128 + ((p ^ (row & 7)) * 16) + 8 * hl);
                                        const u32x2 hi = *(const LAS u32x2*)(sl + row * 128 + (((p + 1) ^ (row & 7)) * 16) + 8 * hl);
                                        gf[mt][kt][s2] = __builtin_bit_cast(bf16x8, (u32x4){lo.x, lo.y, hi.x, hi.y});
                                    }
#pragma unroll
                            for (int i = 0; i < 16; ++i) { n0[i] = *(const LAS float*)(sl + 8192 + crow(i, hl) * 128 + l32 * 4); n1[i] = *(const LAS float*)(sl + 8192 + (32 + crow(i, hl)) * 128 + l32 * 4); }
#pragma unroll
                            for (int mt = 0; mt < 2; ++mt)
#pragma unroll
                                for (int g = 0; g < 4; ++g) dt_[mt][g] = *(const LAS f32x4*)(dtl + c * 64 + 32 * mt + 8 * g + 4 * hl);
                            S2_COMPUTE(c);
                        }
#undef S2_DMA
                    } else {
                        const int _r0 = chunk0 * 64; const size_t _item = (size_t)chunk0 * 32 + h;
#pragma unroll
                        for (int mt = 0; mt < 2; ++mt)
#pragma unroll
                            for (int kt = 0; kt < 2; ++kt)
#pragma unroll
                                for (int s2 = 0; s2 < 2; ++s2) {
                                    const size_t _o = (size_t)(_r0 + 32 * mt + l32) * DM + colb + 32 * kt + 16 * s2 + 4 * hl;
                                    const u32x2 _lo = *(const u32x2*)(Kb + _o), _hi = *(const u32x2*)(Kb + _o + 8); gf[mt][kt][s2] = __builtin_bit_cast(bf16x8, (u32x4){_lo.x, _lo.y, _hi.x, _hi.y}); }
#pragma unroll
                        for (int i = 0; i < 16; ++i) { n0[i] = DD[(size_t)(_r0 + crow(i, hl)) * DM + vcol]; n1[i] = DD[(size_t)(_r0 + 32 + crow(i, hl)) * DM + vcol]; }
#pragma unroll
                        for (int mt = 0; mt < 2; ++mt)
#pragma unroll
                            for (int g = 0; g < 4; ++g) dt_[mt][g] = *(const f32x4*)(DTg + _item * 64 + 32 * mt + 8 * g + 4 * hl);
                        S2_COMPUTE(0);
                    }
#undef S2_COMPUTE
                    float* so_ = OUTP + (prompt ? O_PWKV + ((((size_t)jl * 2 + b) * 32 + h) * 64 + (32 * vh + l32)) * 64
                                                : O_SWKV + ((((size_t)jl * 16 + b) * 32 + h) * 64 + (32 * vh + l32)) * 64);
#pragma unroll
                    for (int i = 0; i < 16; ++i) { so_[crow(i, hl)] = S0[i]; so_[32 + crow(i, hl)] = S1[i]; }
                }
            }
            fast_grid_barrier((unsigned*)ldp(tab, 40), tab);
            {
                PHASE_IDS BASES RWKV_PTRS
                const float* Obuf = (const float*)(RA + 272 * MiB); const float* RK = (const float*)(RB + 204 * MiB);
                const float* lnw_g = IN(28) + (size_t)jl * DM; const float* lnb_g = IN(29) + (size_t)jl * DM;
                float* lnw = (float*)(lds + 40960); float* lnb = lnw + DM;
                for (int i = tid; i < DM / 4; i += 512) { *(f32x4*)(lnw + i * 4) = *(const f32x4*)(lnw_g + i * 4); *(f32x4*)(lnb + i * 4) = *(const f32x4*)(lnb_g + i * 4); }
                __syncthreads();
                const int l32 = lane & 31, hl = lane >> 5;
#pragma unroll 1
                for (int item = blockIdx.x; item < 8704; item += G) {
                    LAS unsigned char* ldsv = (LAS unsigned char*)lds; asm volatile("" : "+v"(ldsv));
                    LAS bf16_t* R2s = (LAS bf16_t*)(ldsv + 0); LAS bf16_t* STs = (LAS bf16_t*)(ldsv + 9216); LAS float* Os = (LAS float*)(ldsv + 18432);
                    const int chunk = item >> 5, h = item & 31, r0 = chunk * 64;
                    {
                        const int rr = tid >> 3, pc = tid & 7;
                        *(LAS u32x4*)(R2s + rr * 72 + pc * 8) = *(const u32x4*)(Rb + (size_t)(r0 + rr) * DM + h * 64 + pc * 8);
                        const unsigned char* sp = (const unsigned char*)DD + ((size_t)(r0 + (rr & 31)) * DM + h * 64 + 32 * (rr >> 5)) * 4 + pc * 16;
                        *(LAS u32x4*)(STs + rr * 72 + pc * 8) = *(const u32x4*)sp;
                    }
                    __syncthreads();
                    if (wave < 4) {
                        const int tt = wave >> 1, vt = wave & 1;
                        f32x16 acc;
#pragma unroll
                        for (int i = 0; i < 16; ++i) acc[i] = Obuf[(size_t)(r0 + 32 * tt + crow(i, hl)) * DM + h * 64 + 32 * vt + l32];
#pragma unroll
                        for (int ks = 0; ks < 4; ++ks) acc = __builtin_amdgcn_mfma_f32_32x32x16_bf16(*(const LAS bf16x8*)(R2s + (32 * tt + l32) * 72 + ks * 16 + hl * 8), *(const LAS bf16x8*)(STs + (32 * vt + l32) * 72 + ks * 16 + hl * 8), acc, 0, 0, 0);
#pragma unroll
                        for (int i = 0; i < 16; ++i) Os[(32 * tt + crow(i, hl)) * 68 + 32 * vt + l32] = acc[i];
                    }
                    __syncthreads();
                    {
                        const int st = tid >> 3, c0 = (tid & 7) * 8, col = h * 64 + c0; const size_t off = (size_t)(r0 + st) * DM + col;
                        const f32x4 o0 = *(const LAS f32x4*)(Os + st * 68 + c0), o1 = *(const LAS f32x4*)(Os + st * 68 + c0 + 4);
                        float o[8] = {o0[0], o0[1], o0[2], o0[3], o1[0], o1[1], o1[2], o1[3]};
                        float s = 0.f;
#pragma unroll
                        for (int i = 0; i < 8; ++i) s += o[i];
                        const float mu = sum8(s, lane) * (1.f / 64.f); float q = 0.f;
#pragma unroll
                        for (int i = 0; i < 8; ++i) { o[i] -= mu; q += o[i] * o[i]; }
                        const float rstd = rsqrtf(sum8(q, lane) * (1.f / 64.f) + 64e-5f);
                        float v[8], g8[8]; unpack8(*(const u32x4*)(Vb + off), v); unpack8(*(const u32x4*)(GG + off), g8);
                        if (jl > 0) { float vf[8], vg[8]; unpack8(*(const u32x4*)(VFIRST + off), vf); unpack8(*(const u32x4*)(VG + off), vg);
#pragma unroll
                            for (int i = 0; i < 8; ++i) v[i] = v[i] + (vf[i] - v[i]) * vg[i]; }
                        const float rk = RK[(size_t)(r0 + st) * 32 + h];
                        float y[8];
#pragma unroll
                        for (int i = 0; i < 8; ++i) y[i] = (o[i] * rstd * lnw[col + i] + lnb[col + i] + rk * v[i]) * g8[i];
                        *(u32x4*)(Y + off) = pack8(y);
                    }
                    __syncthreads();
                }
            }
            fast_grid_barrier((unsigned*)ldp(tab, 40), tab);
            {
                BASES RWKV_PTRS
                pg8::Gemm g{Y, WO, MROWS, 2048, 2048, 0, 0};
                pg8::StaticOrder S; S.init(g.M, g.N, G, (int)blockIdx.x, g.K, 4);
                pg8::Epi<FRes> E{FRes{X, (float*)(RA + 272 * MiB)}};
                pg8::gemm_phase(ldsl, g, S, E);
                fast_grid_barrier((unsigned*)ldp(tab, 40), tab);
                {
                    PHASE_IDS
                    const float* PART = (const float*)(RA + 272 * MiB); const int ntail = S.nwg - S.nFull;
                    if (S.S > 1) for (int idx = gtid; idx < ntail * 16384; idx += NT) {
                        const int tl = idx >> 14, r = (idx >> 6) & 255, c4 = idx & 63; int pm, pn; S.tile_pmpn(S.nFull + tl, pm, pn);
                        f32x4* xp = (f32x4*)(X + (size_t)(pm * 256 + r) * DM + pn * 256 + c4 * 4); f32x4 acc = *xp;
#pragma unroll
                        for (int part = 0; part < 4; ++part) acc += *(const f32x4*)(PART + (size_t)(part * 32 + tl) * 65536 + r * 256 + c4 * 4);
                        *xp = acc; }
                }
            }
            fast_grid_barrier((unsigned*)ldp(tab, 40), tab);
        } else {
            { PHASE_IDS BASES GLA_PTRS
            const float* gmix = IN(6) + (size_t)layer * DM;
            f32x4 ggr[8];
#pragma unroll
            for (int q = 0; q < 8; ++q) ggr[q] = *((const f32x4*)gmix + lane + 64 * q);
            for (int row = gw; row < MROWS; row += NGW) {
                const f32x4* xr = (const f32x4*)(X + (size_t)row * DM) + lane; f32x4 x[8]; float ss = 0.f;
#pragma unroll
                for (int q = 0; q < 8; ++q) { x[q] = xr[64 * q]; ss += x[q][0] * x[q][0] + x[q][1] * x[q][1] + x[q][2] * x[q][2] + x[q][3] * x[q][3]; }
                const float rs = rsqrtf(wave_sum(ss, lane) * (1.f / DM) + 1e-6f);
#pragma unroll
                for (int q = 0; q < 8; ++q) { const f32x4 gg = ggr[q]; const f32x4 h = x[q] * rs * gg;
                    u32x2 w; w.x = cvt_pk_bf16(h[0], h[1]); w.y = cvt_pk_bf16(h[2], h[3]); *((u32x2*)(H + (size_t)row * DM) + lane + 64 * q) = w; }
            } }
            fast_grid_barrier((unsigned*)ldp(tab, 40), tab);
            {
                BASES GLA_PTRS
                pg8::Gemm g{H, GI, MROWS, 6400, 2048, 0, 0};
                pg8::StaticOrder S; S.init(g.M, g.N, G, (int)blockIdx.x, g.K, 1);
                pg8::Epi<FG1> E{FG1{PROJ, LR}};
                pg8::gemm_phase(ldsl, g, S, E);
            }
            fast_grid_barrier((unsigned*)ldp(tab, 40), tab);
            {
                PHASE_IDS BASES GLA_PTRS
                float* lrS = (float*)lds;
                float* w2S = (float*)(lds + 4096);
                float* totS = (float*)(lds + 20480);
                bf16_t* qeS = (bf16_t*)(lds + 22528);
                bf16_t* keS = (bf16_t*)(lds + 22528 + 33792);
                bf16_t* vS = qeS;
                const float* gw2 = IN(31) + (size_t)jl * 16 * 1024; const float* gkb = IN(32) + (size_t)jl * 1024;
#pragma unroll 1
                for (int it = blockIdx.x; it < 1088; it += G) {
                    const int c = it >> 2, h = it & 3, r0 = c * 64; const size_t base = (size_t)it;
                    if (tid < 256) *(f32x4*)(lrS + tid * 4) = *(const f32x4*)(LR + (size_t)r0 * 16 + tid * 4);
                    for (int q = tid; q < 1024; q += 512) { const int r = q >> 6, cc = (q & 63) * 4; *(f32x4*)(w2S + r * 256 + cc) = *(const f32x4*)(gw2 + (size_t)r * 1024 + h * 256 + cc); }
                    for (int q = tid; q < 2048; q += 512) { const int t = q >> 5, cc = (q & 31) * 8; const bf16_t* src = PROJ + (size_t)(r0 + t) * 6144 + h * 256 + cc;
                        *(u32x4*)(qeS + t * 264 + cc) = *(const u32x4*)src; *(u32x4*)(keS + t * 264 + cc) = *(const u32x4*)(src + 1024); }
                    __syncthreads();
                    const int d = tid & 255, half = tid >> 8;
                    float cumv[32];
                    {
                        float w[16];
#pragma unroll
                        for (int r = 0; r < 16; ++r) w[r] = w2S[r * 256 + d];
                        const float bb = gkb[h * 256 + d]; float run = 0.f;
#pragma unroll
                        for (int tt = 0; tt < 32; ++tt) {
                            const float* lp = lrS + (half * 32 + tt) * 16; float z = bb;
#pragma unroll
                            for (int r = 0; r < 16; ++r) z += lp[r] * w[r];
                            const float g = (fminf(z, 0.f) - log1pf(__expf(-fabsf(z)))) * 0.0625f;
                            run += g; cumv[tt] = run;
                        }
                        totS[half * 256 + d] = run;
                    }
                    __syncthreads();
                    {
                        const float t0 = totS[d], t1 = totS[256 + d]; const float last = t0 + t1, offc = half ? t0 : 0.f;
                        if (half == 0) EL[base * 256 + d] = __expf(last);
                        unsigned kdp[16];
#pragma unroll
                        for (int tt = 0; tt < 32; tt += 2) {
                            float kd2[2];
#pragma unroll
                            for (int e = 0; e < 2; ++e) {
                                const int t = half * 32 + tt + e; const float cum = cumv[tt + e] + offc;
                                const float q = bf2f(qeS[t * 264 + d]), k = bf2f(keS[t * 264 + d]);
                                const float qe = q * __expf(cum), ke = k * __expf(-cum); kd2[e] = k * __expf(last - cum);
                                const unsigned pq = cvt_pk_bf16(qe, ke);
                                qeS[t * 264 + d] = (bf16_t)(pq & 0xffffu); keS[t * 264 + d] = (bf16_t)(pq >> 16);
                            }
                            kdp[tt >> 1] = cvt_pk_bf16(kd2[0], kd2[1]);
                        }
                        u32x4* kdst = (u32x4*)(KDT + (base * 256 + d) * 64 + half * 32);
                        kdst[0] = (u32x4){kdp[0], kdp[1], kdp[2], kdp[3]}; kdst[1] = (u32x4){kdp[4], kdp[5], kdp[6], kdp[7]};
                        kdst[2] = (u32x4){kdp[8], kdp[9], kdp[10], kdp[11]}; kdst[3] = (u32x4){kdp[12], kdp[13], kdp[14], kdp[15]};
                    }
                    __syncthreads();
                    for (int q = tid; q < 2048; q += 512) { const int t = q >> 5, sl = (q >> 2) & 7, pc = q & 3;
                        *(u32x4*)(QE + ((base * 8 + sl) * 64 + t) * 32 + pc * 8) = *(const u32x4*)(qeS + t * 264 + sl * 32 + pc * 8); }
                    if (wave < 4) {
                        const int mi = wave >> 1, ni = wave & 1, l32 = lane & 31, hl = lane >> 5;
                        f32x16 cacc;
#pragma unroll
                        for (int i = 0; i < 16; ++i) cacc[i] = 0.f;
#pragma unroll
                        for (int kk = 0; kk < 16; ++kk) {
                            const bf16x8 a = *(const bf16x8*)(qeS + (mi * 32 + l32) * 264 + kk * 16 + hl * 8);
                            const bf16x8 b = *(const bf16x8*)(keS + (ni * 32 + l32) * 264 + kk * 16 + hl * 8);
                            cacc = __builtin_amdgcn_mfma_f32_32x32x16_bf16(a, b, cacc, 0, 0, 0);
                        }
#pragma unroll
                        for (int i = 0; i < 16; ++i) { const int ii = mi * 32 + crow(i, hl), jj = ni * 32 + l32;
                            const float v = (jj <= ii) ? cacc[i] : 0.f; SC[base * 4096 + ii * 64 + jj] = (bf16_t)(cvt_pk_bf16(v, 0.f) & 0xffffu); }
                    }
                    __syncthreads();
                    for (int q = tid; q < 4096; q += 512) { const int t = q >> 6, cc = (q & 63) * 8;
                        *(u32x4*)(vS + t * 520 + cc) = *(const u32x4*)(PROJ + (size_t)(r0 + t) * 6144 + 2048 + h * 512 + cc); }
                    __syncthreads();
                    {
                        const int dv = tid; u32x4* vdst = (u32x4*)(VT + (base * 512 + dv) * 64);
#pragma unroll
                        for (int q = 0; q < 8; ++q) {
                            unsigned w[4];
#pragma unroll
                            for (int e = 0; e < 4; ++e) { const unsigned lo = vS[(q * 8 + 2 * e) * 520 + dv], hi = vS[(q * 8 + 2 * e + 1) * 520 + dv]; w[e] = lo | (hi << 16); }
                            vdst[q] = (u32x4){w[0], w[1], w[2], w[3]};
                        }
                    }
                    __syncthreads();
                }
            }
            fast_grid_barrier((unsigned*)ldp(tab, 40), tab);
            {
                PHASE_IDS BASES GLA_PTRS
                float* red = (float*)lds;
                const int l32 = lane & 31, hl = lane >> 5;
#pragma unroll 1
                for (int u = blockIdx.x; u < 1152; u += G) {
                    const bool prompt = u < 128; int b, h, s, cg0, nch, row0;
                    if (prompt) { const int pair = u & 7; b = pair >> 2; h = pair & 3; s = u >> 3; cg0 = b * 128; nch = 128; row0 = b * 8192; }
                    else { const int su = u - 128; b = su >> 6; h = (su >> 4) & 3; s = su & 15; cg0 = 256 + b; nch = 1; row0 = MPROMPT + b * 64; }
                    f32x16 S;
                    if (prompt) {
#pragma unroll
                        for (int i = 0; i < 16; ++i) S[i] = 0.f;
                    } else {
                        const float* s0 = IN(4) + ((((size_t)jl * 16 + b) * 4 + h) * 256) * 512;
#pragma unroll
                        for (int i = 0; i < 16; ++i) S[i] = s0[(size_t)(32 * wave + crow(i, hl)) * 512 + 32 * s + l32];
                    }
                    const int mtw = wave & 1, ksw = wave >> 1;
                    bf16x8 ka[4], vb[4], qf[2][2], scf; f32x4 el[4];
#define GL_LD_Q(cc) do { const size_t _base = (size_t)(cg0 + (cc)) * 4 + h; const int _r0 = row0 + (cc) * 64; const bf16_t* _sc = SC + _base * 4096; \
                        _Pragma("unroll") for (int mt = 0; mt < 2; ++mt) _Pragma("unroll") for (int s2 = 0; s2 < 2; ++s2) { const bf16_t* _pq = QE + ((_base * 8 + wave) * 64 + mt * 32 + l32) * 32 + 16 * s2 + 4 * hl; \
                            const u32x2 _lo = *(const u32x2*)_pq, _hi = *(const u32x2*)(_pq + 8); qf[mt][s2] = __builtin_bit_cast(bf16x8, (u32x4){_lo.x, _lo.y, _hi.x, _hi.y}); } \
                        scf = *(const bf16x8*)(_sc + (mtw * 32 + l32) * 64 + 16 * ksw + 8 * hl); } while (0)
#define GL_LD_E(cc) do { const size_t _base = (size_t)(cg0 + (cc)) * 4 + h; \
                        _Pragma("unroll") for (int g = 0; g < 4; ++g) el[g] = *(const f32x4*)(EL + _base * 256 + 32 * wave + 8 * g + 4 * hl); } while (0)
#define GL_LD_K(cc) do { const size_t _base = (size_t)(cg0 + (cc)) * 4 + h; const bf16_t* _kdt = KDT + _base * 256 * 64; const bf16_t* _vt = VT + _base * 512 * 64; \
                        _Pragma("unroll") for (int ks = 0; ks < 4; ++ks) { ka[ks] = *(const bf16x8*)(_kdt + (32 * wave + l32) * 64 + 16 * ks + 8 * hl); vb[ks] = *(const bf16x8*)(_vt + (32 * s + l32) * 64 + 16 * ks + 8 * hl); } } while (0)
                    GL_LD_Q(0); GL_LD_E(0); GL_LD_K(0);
                    f32x4 osum = (f32x4){0.f, 0.f, 0.f, 0.f}; float* optr = nullptr;
#pragma unroll 1
                    for (int c = 0; c < nch; ++c) {
                        const int r0 = row0 + c * 64; const int cn = (c + 1 < nch) ? c + 1 : c;
                        asm volatile("" : "+v"(scf), "+v"(vb[3]));
                        if (c > 0) *(f32x4*)optr = osum;
                        u32x4 sp0, sp1;
                        sp0.x = cvt_pk_bf16(S[0], S[1]); sp0.y = cvt_pk_bf16(S[2], S[3]); sp0.z = cvt_pk_bf16(S[4], S[5]); sp0.w = cvt_pk_bf16(S[6], S[7]);
                        sp1.x = cvt_pk_bf16(S[8], S[9]); sp1.y = cvt_pk_bf16(S[10], S[11]); sp1.z = cvt_pk_bf16(S[12], S[13]); sp1.w = cvt_pk_bf16(S[14], S[15]);
                        const bf16x8 sb0 = __builtin_bit_cast(bf16x8, sp0), sb1 = __builtin_bit_cast(bf16x8, sp1);
                        const bf16x8 vbw = ksw == 0 ? vb[0] : ksw == 1 ? vb[1] : ksw == 2 ? vb[2] : vb[3];
#pragma unroll
                        for (int i = 0; i < 16; ++i) S[i] *= el[i >> 2][i & 3];
#pragma unroll
                        for (int ks = 0; ks < 4; ++ks) S = __builtin_amdgcn_mfma_f32_32x32x16_bf16(ka[ks], vb[ks], S, 0, 0, 0);
                        GL_LD_E(cn); GL_LD_K(cn);
                        f32x16 oo0, oo1;
#pragma unroll
                        for (int i = 0; i < 16; ++i) { oo0[i] = 0.f; oo1[i] = 0.f; }
                        oo0 = __builtin_amdgcn_mfma_f32_32x32x16_bf16(qf[0][0], sb0, oo0, 0, 0, 0); oo0 = __builtin_amdgcn_mfma_f32_32x32x16_bf16(qf[0][1], sb1, oo0, 0, 0, 0);
                        oo1 = __builtin_amdgcn_mfma_f32_32x32x16_bf16(qf[1][0], sb0, oo1, 0, 0, 0); oo1 = __builtin_amdgcn_mfma_f32_32x32x16_bf16(qf[1][1], sb1, oo1, 0, 0, 0);
                        if (mtw == 0) oo0 = __builtin_amdgcn_mfma_f32_32x32x16_bf16(scf, vbw, oo0, 0, 0, 0); else oo1 = __builtin_amdgcn_mfma_f32_32x32x16_bf16(scf, vbw, oo1, 0, 0, 0);
                        GL_LD_Q(cn);
#pragma unroll
                        for (int q = 0; q < 16; ++q) { red[(wave * 32 + q) * 64 + lane] = oo0[q]; red[(wave * 32 + 16 + q) * 64 + lane] = oo1[q]; }
                        asm volatile("s_waitcnt lgkmcnt(0)" ::: "memory"); __builtin_amdgcn_s_barrier(); asm volatile("" ::: "memory");
                        { const int q = tid >> 4, lg = tid & 15; f32x4 sum = (f32x4){0.f, 0.f, 0.f, 0.f};
#pragma unroll
                          for (int w = 0; w < 8; ++w) sum += *(const f32x4*)(red + (w * 32 + q) * 64 + 4 * lg);
                          const int mt = q >> 4, reg = q & 15, L = 4 * lg; const int i = mt * 32 + crow(reg, L >> 5), dv = L & 31;
                          osum = sum; optr = O + (size_t)(r0 + i) * DM + h * 512 + 32 * s + dv; }
                        asm volatile("s_waitcnt lgkmcnt(0)" ::: "memory"); __builtin_amdgcn_s_barrier(); asm volatile("" ::: "memory");
                    }
                    *(f32x4*)optr = osum;
#undef GL_LD_Q
#undef GL_LD_E
#undef GL_LD_K
                    float* dst = OUTP + (prompt ? O_PGLA + ((((size_t)jl * 2 + b) * 4 + h) * 256) * 512 : O_SGLA + ((((size_t)jl * 16 + b) * 4 + h) * 256) * 512);
#pragma unroll
                    for (int i = 0; i < 16; ++i) dst[(size_t)(32 * wave + crow(i, hl)) * 512 + 32 * s + l32] = S[i];
                }
                if (layer == 1 && G >= 256 && (int)blockIdx.x >= 128) {
                    float* scr = (float*)(lds + wave * 16896);
                    CONVERT_WEIGHTS(1, 2, 2, 4, ((int)blockIdx.x - 128) * 8 + wave, (G - 128) * 8);
                }
            }
            fast_grid_barrier((unsigned*)ldp(tab, 40), tab);
            {
                PHASE_IDS BASES GLA_PTRS
                const float* hn = IN(33) + (size_t)jl * 512;
                const f32x4 n0 = *(const f32x4*)(hn + lane * 8), n1 = *(const f32x4*)(hn + lane * 8 + 4);
                for (int row = gw; row < MROWS; row += NGW) {
#pragma unroll
                    for (int h = 0; h < 4; ++h) {
                        const float* op = O + (size_t)row * DM + h * 512 + lane * 8;
                        const f32x4 a = *(const f32x4*)op, b = *(const f32x4*)(op + 4);
                        float ss = a[0] * a[0] + a[1] * a[1] + a[2] * a[2] + a[3] * a[3] + b[0] * b[0] + b[1] * b[1] + b[2] * b[2] + b[3] * b[3];
                        const float rs = rsqrtf(wave_sum(ss, lane) * (1.f / 512.f) + 1e-5f);
                        float gt[8]; unpack8(*(const u32x4*)(PROJ + (size_t)row * 6144 + 4096 + h * 512 + lane * 8), gt);
                        float y[8];
#pragma unroll
                        for (int i = 0; i < 4; ++i) { y[i] = a[i] * rs * n0[i] * (gt[i] * sigmoidf_(gt[i])); y[4 + i] = b[i] * rs * n1[i] * (gt[4 + i] * sigmoidf_(gt[4 + i])); }
                        *(u32x4*)(Y + (size_t)row * DM + h * 512 + lane * 8) = pack8(y);
                    }
                }
            }
            fast_grid_barrier((unsigned*)ldp(tab, 40), tab);
            {
                BASES GLA_PTRS
                pg8::Gemm g{Y, GO, MROWS, 2048, 2048, 0, 0};
                pg8::StaticOrder S; S.init(g.M, g.N, G, (int)blockIdx.x, g.K, 4);
                pg8::Epi<FRes> E{FRes{X, (float*)(RA + 272 * MiB)}};
                pg8::gemm_phase(ldsl, g, S, E);
                fast_grid_barrier((unsigned*)ldp(tab, 40), tab);
                {
                    PHASE_IDS
                    const float* PART = (const float*)(RA + 272 * MiB); const int ntail = S.nwg - S.nFull;
                    if (S.S > 1) for (int idx = gtid; idx < ntail * 16384; idx += NT) {
                        const int tl = idx >> 14, r = (idx >> 6) & 255, c4 = idx & 63; int pm, pn; S.tile_pmpn(S.nFull + tl, pm, pn);
                        f32x4* xp = (f32x4*)(X + (size_t)(pm * 256 + r) * DM + pn * 256 + c4 * 4); f32x4 acc = *xp;
#pragma unroll
                        for (int part = 0; part < 4; ++part) acc += *(const f32x4*)(PART + (size_t)(part * 32 + tl) * 65536 + r * 256 + c4 * 4);
                        *xp = acc; }
                }
            }
            fast_grid_barrier((unsigned*)ldp(tab, 40), tab);
        }
        {
            { PHASE_IDS BASES FFN_PTRS
            const float* gf = IN(7) + (size_t)layer * DM;
            f32x4 ggr[8];
#pragma unroll
            for (int q = 0; q < 8; ++q) ggr[q] = *((const f32x4*)gf + lane + 64 * q);
            for (int row = gw; row < MROWS; row += NGW) {
                const f32x4* xr = (const f32x4*)(X + (size_t)row * DM) + lane; f32x4 x[8]; float ss = 0.f;
#pragma unroll
                for (int q = 0; q < 8; ++q) { x[q] = xr[64 * q]; ss += x[q][0] * x[q][0] + x[q][1] * x[q][1] + x[q][2] * x[q][2] + x[q][3] * x[q][3]; }
                const float rs = rsqrtf(wave_sum(ss, lane) * (1.f / DM) + 1e-6f);
#pragma unroll
                for (int q = 0; q < 8; ++q) { const f32x4 gg = ggr[q]; const f32x4 h = x[q] * rs * gg;
                    u32x2 w; w.x = cvt_pk_bf16(h[0], h[1]); w.y = cvt_pk_bf16(h[2], h[3]); *((u32x2*)(H + (size_t)row * DM) + lane + 64 * q) = w; }
            } }
            fast_grid_barrier((unsigned*)ldp(tab, 40), tab);
            {
                BASES FFN_PTRS
                pg8::Gemm g{H, WU, MROWS, F2, 2048, 0, 0};
                pg8::StaticOrder S; S.init(g.M, g.N, G, (int)blockIdx.x, g.K, 1);
                pg8::Epi<FUp> E{FUp{U, OUTP + O_PCONV + (size_t)layer * 2 * 2 * F2, OUTP + O_SCONV + (size_t)layer * 16 * 2 * F2}};
                pg8::gemm_phase(ldsl, g, S, E);
            }
            fast_grid_barrier((unsigned*)ldp(tab, 40), tab);
            {
                PHASE_IDS BASES FFN_PTRS
                const float* cw = IN(36) + (size_t)layer * 3 * F2; const float* cb = IN(37) + (size_t)layer * F2;
                const float* cst = IN(5) + (size_t)layer * 16 * 2 * F2;
#pragma unroll 1
                for (int it = gtid; it < 544 * 704; it += NT) {
                    const int rc = it / 704, c8 = it - rc * 704, col = c8 * 8, r0 = rc * 32;
                    int t0, len, b; bool prompt; row_info(r0, t0, len, b, prompt);
                    float wv[3][8], wg[3][8], bv[8], bg[8];
#pragma unroll
                    for (int k = 0; k < 3; ++k) { const f32x4 a = *(const f32x4*)(cw + (size_t)k * F2 + col), a2 = *(const f32x4*)(cw + (size_t)k * F2 + col + 4);
                        const f32x4 g = *(const f32x4*)(cw + (size_t)k * F2 + FH + col), g2 = *(const f32x4*)(cw + (size_t)k * F2 + FH + col + 4);
#pragma unroll
                        for (int i = 0; i < 4; ++i) { wv[k][i] = a[i]; wv[k][4 + i] = a2[i]; wg[k][i] = g[i]; wg[k][4 + i] = g2[i]; } }
                    { const f32x4 a = *(const f32x4*)(cb + col), a2 = *(const f32x4*)(cb + col + 4), g = *(const f32x4*)(cb + FH + col), g2 = *(const f32x4*)(cb + FH + col + 4);
#pragma unroll
                      for (int i = 0; i < 4; ++i) { bv[i] = a[i]; bv[4 + i] = a2[i]; bg[i] = g[i]; bg[4 + i] = g2[i]; } }
                    float v2[8], v1[8], g2_[8], g1_[8];
                    if (t0 > 0) {
                        unpack8(*(const u32x4*)(U + (size_t)(r0 - 2) * F2 + col), v2); unpack8(*(const u32x4*)(U + (size_t)(r0 - 1) * F2 + col), v1);
                        unpack8(*(const u32x4*)(U + (size_t)(r0 - 2) * F2 + FH + col), g2_); unpack8(*(const u32x4*)(U + (size_t)(r0 - 1) * F2 + FH + col), g1_);
                    } else if (!prompt) {
                        const float* s0 = cst + ((size_t)b * 2) * F2 + col; const float* s1 = s0 + F2;
#pragma unroll
                        for (int i = 0; i < 8; ++i) { v2[i] = s0[i]; v1[i] = s1[i]; g2_[i] = s0[FH + i]; g1_[i] = s1[FH + i]; }
                    } else {
#pragma unroll
                        for (int i = 0; i < 8; ++i) { v2[i] = 0.f; v1[i] = 0.f; g2_[i] = 0.f; g1_[i] = 0.f; }
                    }
#pragma unroll 1
                    for (int rb = 0; rb < 32; rb += 8) {
                      u32x4 uv_[8], ug_[8];
#pragma unroll
                      for (int j = 0; j < 8; ++j) { uv_[j] = *(const u32x4*)(U + (size_t)(r0 + rb + j) * F2 + col); ug_[j] = *(const u32x4*)(U + (size_t)(r0 + rb + j) * F2 + FH + col); }
#pragma unroll
                      for (int j = 0; j < 8; ++j) {
                        const int r = rb + j;
                        float v0[8], g0[8];
                        unpack8(uv_[j], v0); unpack8(ug_[j], g0);
                        float y[8];
#pragma unroll
                        for (int i = 0; i < 8; ++i) {
                            const float cv = bv[i] + wv[0][i] * v2[i] + wv[1][i] * v1[i] + wv[2][i] * v0[i];
                            const float cg_ = bg[i] + wg[0][i] * g2_[i] + wg[1][i] * g1_[i] + wg[2][i] * g0[i];
                            y[i] = cg_ * sigmoidf_(cg_) * cv;
                            v2[i] = v1[i]; v1[i] = v0[i]; g2_[i] = g1_[i]; g1_[i] = g0[i];
                        }
                        *(u32x4*)(HID + (size_t)(r0 + r) * FH + col) = pack8(y);
                      }
                    }
                }
            }
            fast_grid_barrier((unsigned*)ldp(tab, 40), tab);
            {
                BASES FFN_PTRS
                pg8::Gemm g{HID, WD, MROWS, 2048, FH, 0, 0};
                pg8::StaticOrder S; S.init(g.M, g.N, G, (int)blockIdx.x, g.K, 4);
                pg8::Epi<FRes> E{FRes{X, (float*)(RA + 272 * MiB)}};
                pg8::gemm_phase(ldsl, g, S, E);
                fast_grid_barrier((unsigned*)ldp(tab, 40), tab);
                {
                    PHASE_IDS
                    const float* PART = (const float*)(RA + 272 * MiB); const int ntail = S.nwg - S.nFull;
                    if (S.S > 1) for (int idx = gtid; idx < ntail * 16384; idx += NT) {
                        const int tl = idx >> 14, r = (idx >> 6) & 255, c4 = idx & 63; int pm, pn; S.tile_pmpn(S.nFull + tl, pm, pn);
                        f32x4* xp = (f32x4*)(X + (size_t)(pm * 256 + r) * DM + pn * 256 + c4 * 4); f32x4 acc = *xp;
#pragma unroll
                        for (int part = 0; part < 4; ++part) acc += *(const f32x4*)(PART + (size_t)(part * 32 + tl) * 65536 + r * 256 + c4 * 4);
                        *xp = acc; }
                }
            }
            fast_grid_barrier((unsigned*)ldp(tab, 40), tab);
        }
    }
    {
        PHASE_IDS BASES
        const float* gn = IN(8);
        f32x4 ggr[8];
#pragma unroll
        for (int q = 0; q < 8; ++q) ggr[q] = *((const f32x4*)gn + lane + 64 * q);
        for (int row = gw; row < MROWS; row += NGW) {
            f32x4* xr = (f32x4*)(X + (size_t)row * DM) + lane; f32x4 x[8]; float ss = 0.f;
#pragma unroll
            for (int q = 0; q < 8; ++q) { x[q] = xr[64 * q]; ss += x[q][0] * x[q][0] + x[q][1] * x[q][1] + x[q][2] * x[q][2] + x[q][3] * x[q][3]; }
            const float rs = rsqrtf(wave_sum(ss, lane) * (1.f / DM) + 1e-6f);
#pragma unroll
            for (int q = 0; q < 8; ++q) { const f32x4 gg = ggr[q]; xr[64 * q] = x[q] * rs * gg; }
        }
    }
}

#undef TR
#undef CONVERT_WEIGHTS
extern "C" void kernel_launch(void* const* d_in, const int* in_sizes, int n_in, void* d_out, int out_size, void* d_ws, size_t ws_size, hipStream_t stream) {
    static int grid = 0;
    if (grid == 0) {
        if (n_in != 39 || (size_t)out_size != O_TOTAL || ws_size < WS_END) {
            fprintf(stderr, "kernel_launch: unexpected shapes: n_in %d out %d ws %zu (need %zu)\n", n_in, out_size, ws_size, (size_t)WS_END); grid = -1; return; }
        int dev = 0, cus = 0, per_cu = 0;
        (void)hipGetDevice(&dev);
        (void)hipDeviceGetAttribute(&cus, hipDeviceAttributeMultiprocessorCount, dev);
        if (hipFuncSetAttribute((const void*)fwd_kernel, hipFuncAttributeMaxDynamicSharedMemorySize, LDS_BYTES) != hipSuccess) { fprintf(stderr, "kernel_launch: hipFuncSetAttribute failed\n"); grid = -1; return; }
        if (hipOccupancyMaxActiveBlocksPerMultiprocessor(&per_cu, (const void*)fwd_kernel, 512, LDS_BYTES) != hipSuccess || per_cu < 1) { fprintf(stderr, "kernel_launch: occupancy query says %d\n", per_cu); per_cu = 1; }
        (void)hipGetLastError();
        grid = cus * 1;
        if (grid <= 0) grid = 256;
    }
    if (grid < 0) return;
    P prm{};
    for (int i = 0; i < 39; ++i) prm.in[i] = (const float*)d_in[i];
    prm.out = (float*)d_out; prm.ws = (unsigned char*)d_ws;
    void* args[] = {&prm};
    hipError_t e = hipLaunchCooperativeKernel((const void*)fwd_kernel, dim3(grid), dim3(512), args, LDS_BYTES, stream);
    if (e != hipSuccess) fprintf(stderr, "cooperative launch failed: %s (grid %d)\n", hipGetErrorString(e), grid);
}
```

```cpp
#include <hip/hip_runtime.h>
#include <hip/hip_cooperative_groups.h>
#include <cstdio>
#include <cstdint>
namespace cg = cooperative_groups;

#define LAS __attribute__((address_space(3)))
typedef unsigned short bf16_t;
typedef short bf16x8 __attribute__((ext_vector_type(8)));
typedef float f32x4 __attribute__((ext_vector_type(4)));
typedef float f32x16 __attribute__((ext_vector_type(16)));
typedef unsigned u32x4 __attribute__((ext_vector_type(4)));
typedef unsigned u32x2 __attribute__((ext_vector_type(2)));

constexpr int DM = 2048, MROWS = 17408, MPROMPT = 16384;
constexpr int FH = 5632, F2 = 11264;
constexpr int LDS_BYTES = 147456;
constexpr size_t MiB = 1u << 20;
constexpr size_t WS_WT = 1 * MiB;
constexpr size_t WS_A = 411 * MiB;
constexpr size_t WS_B = 819 * MiB;
constexpr size_t WS_VF = 1227 * MiB;
constexpr size_t WS_END = 1295 * MiB;
constexpr size_t ACT = (size_t)MROWS * DM;
constexpr size_t RW_SZ = (size_t)7168 * 2048 + (size_t)8192 * 256 + (size_t)2048 * 2048;
constexpr size_t GW_SZ = (size_t)6400 * 2048 + (size_t)2048 * 2048;
constexpr size_t FW_SZ = (size_t)11264 * 2048 + (size_t)2048 * 5632;
constexpr size_t GW_OFF = 2 * RW_SZ, FW_OFF = GW_OFF + 2 * GW_SZ;
constexpr size_t O_PSHIFT = 35651584, O_PWKV = 35659776, O_PGLA = 36184064, O_PCONV = 38281216;
constexpr size_t O_SSHIFT = 38461440, O_SWKV = 38526976, O_SGLA = 42721280, O_SCONV = 59498496, O_TOTAL = 60940288;

__device__ __forceinline__ unsigned cvt_pk_bf16(float lo, float hi) { unsigned r; asm volatile("v_cvt_pk_bf16_f32 %0, %1, %2" : "=v"(r) : "v"(lo), "v"(hi)); return r; }
__device__ __forceinline__ float bf2f(bf16_t b) { return __builtin_bit_cast(float, (unsigned)b << 16); }
__device__ __forceinline__ float bflo(unsigned u) { return __builtin_bit_cast(float, u << 16); }
__device__ __forceinline__ float bfhi(unsigned u) { return __builtin_bit_cast(float, u & 0xffff0000u); }
__device__ __forceinline__ void unpack8(u32x4 w, float (&f)[8]) {
    f[0] = bflo(w.x); f[1] = bfhi(w.x); f[2] = bflo(w.y); f[3] = bfhi(w.y); f[4] = bflo(w.z); f[5] = bfhi(w.z); f[6] = bflo(w.w); f[7] = bfhi(w.w);
}
__device__ __forceinline__ u32x4 pack8(const float (&f)[8]) {
    u32x4 w; w.x = cvt_pk_bf16(f[0], f[1]); w.y = cvt_pk_bf16(f[2], f[3]); w.z = cvt_pk_bf16(f[4], f[5]); w.w = cvt_pk_bf16(f[6], f[7]); return w;
}
__device__ __forceinline__ float sigmoidf_(float x) { return 1.f / (1.f + __expf(-x)); }
__device__ __forceinline__ float shx(float v, int lane, int o) { return __builtin_bit_cast(float, __builtin_amdgcn_ds_bpermute((lane ^ o) << 2, __builtin_bit_cast(int, v))); }
__device__ __forceinline__ float wave_sum(float v, int lane) {
#pragma unroll
    for (int o = 1; o < 64; o <<= 1) v += shx(v, lane, o);
    return v;
}
__device__ __forceinline__ float sum8(float v, int lane) { v += shx(v, lane, 1); v += shx(v, lane, 2); v += shx(v, lane, 4); return v; }
__device__ __forceinline__ int crow(int reg, int h) { return (reg & 3) + 8 * (reg >> 2) + 4 * h; }

namespace pg8 {
constexpr int BM = 256, BK = 64, HALF = 128, HTB = HALF * BK * 2, STAGE_BYTES = 8 * HTB, NXCD = 8, WGM = 8;
__host__ __device__ __forceinline__ int lds_byte(int r, int c) { const int st = (r >> 4) * 2 + (c >> 5), rr = r & 15, cc = c & 31, ob = rr * 64 + cc * 2; return st * 1024 + (ob ^ (((ob >> 9) & 1) << 5)); }
__host__ __device__ __forceinline__ void stage_rc(int b, int& R, int& C) { const int st = b / 1024, sb = b % 1024, swz = sb ^ (((sb >> 9) & 1) << 5); R = (st >> 1) * 16 + swz / 64; C = (st & 1) * 32 + (swz % 64) / 2; }
__host__ __device__ __forceinline__ int perm32(int rho) { const int n = rho >> 4, i = rho & 15; return 8 * (i >> 2) + 4 * n + (i & 3); }

struct Unit { int pm, pn, kofs, knt, split; };
struct Gemm { const bf16_t* A; const bf16_t* Bt; int M, N, K; int mode; size_t astride; };
__device__ __forceinline__ const char* a_of(const Gemm& g, int pn) {
    int s = 0;
    if (g.mode == 1) s = pn < 8 ? 0 : pn < 16 ? 2 : pn < 24 ? 3 : pn == 24 ? 1 : pn == 25 ? 4 : pn == 26 ? 5 : 3;
    else if (g.mode == 2) s = pn >> 3;
    return (const char*)g.A + (size_t)s * g.astride;
}
struct StaticOrder {
    int nM, nN, nwg, G, c, nFull, S, ntK, total;
    __device__ __forceinline__ void init(int M, int N, int G_, int c_, int K = 0, int S_ = 1) { nM = M / BM; nN = N / BM; nwg = nM * nN; G = G_; c = c_; ntK = K / BK;
        nFull = (nwg / G) * G; S = S_; if (S_ <= 1 || nFull == nwg) { S = 1; nFull = nwg; } total = nFull + (nwg - nFull) * S; }
    __device__ __forceinline__ bool next(int i, Unit& u) const {
        const long L = (long)i * G + c; if (L >= total) return false;
        int wgid;
        if (L < nFull) { wgid = (int)L; u.kofs = 0; u.knt = ntK; u.split = 0; }
        else { const int j = (int)L - nFull; wgid = nFull + j / S; const int part = j % S; u.knt = ntK / S; u.kofs = part * u.knt * BK; u.split = 1 + part * 32 + j / S; }
        tile_pmpn(wgid, u.pm, u.pn); return true;
    }
    __device__ __forceinline__ void tile_pmpn(int wgid, int& pm, int& pn) const {
        { const int q = nwg / NXCD, r = nwg % NXCD, xcd = wgid % NXCD, off = wgid / NXCD; wgid = (xcd < r ? xcd * (q + 1) : r * (q + 1) + (xcd - r) * q) + off; }
        const int nig = WGM * nN, gid = wgid / nig, fm = gid * WGM, gsz = (nM - fm) < WGM ? (nM - fm) : WGM;
        pm = fm + ((wgid % nig) % gsz); pn = (wgid % nig) / gsz;
    }
};

template <class F> struct Epi {
    static constexpr bool PERM = true;
    F f;
    __device__ __forceinline__ void operator()(const f32x4 (&acc)[2][2][4][2], const Unit& u, int wr, int wc, int fr, int fq) const {
        { int t_ = threadIdx.x; asm volatile("" : "+v"(t_)); const int l_ = t_ & 63, w_ = __builtin_amdgcn_readfirstlane(t_ >> 6); fr = l_ & 15; fq = l_ >> 4; wr = w_ >> 2; wc = w_ & 3; }
        const int row0 = u.pm * BM + wr * 64 + fr, col0 = u.pn * BM + wc * 32 + 8 * fq;
#pragma unroll
        for (int ai = 0; ai < 2; ++ai)
#pragma unroll
            for (int m = 0; m < 4; ++m)
#pragma unroll
                for (int bj = 0; bj < 2; ++bj) f(row0 + ai * HALF + m * 16, col0 + bj * HALF, acc[ai][bj][m][0], acc[ai][bj][m][1], u.split);
    }
};

template <class EpiT>
__device__ __forceinline__ void gemm_phase(LAS unsigned char* lds, const Gemm g, const StaticOrder& S, const EpiT& E) {
    int tid = threadIdx.x; asm volatile("" : "+v"(tid));
    const int wid = __builtin_amdgcn_readfirstlane(tid >> 6), lane = tid & 63, wr = wid >> 2, wc = wid & 3, fr = lane & 15, fq = lane >> 4;
    const int K = g.K;
    unsigned voffA[2], voffB[2];
#pragma unroll
    for (int i = 0; i < 2; ++i) { int R, C; stage_rc(tid * 16 + i * 8192, R, C); const int Rb = EpiT::PERM ? ((R & ~31) + perm32(R & 31)) : R;
        voffA[i] = (unsigned)(R * K + C) * 2u; voffB[i] = (unsigned)(Rb * K + C) * 2u; }
    const size_t kstep = (size_t)(BK * 2);
    const size_t hstep = (size_t)HALF * K * 2;
    const size_t tstep = 2 * hstep;
    const unsigned ldsw = (unsigned)wid * 1024u;
    const int aoff = lds_byte(wr * 64 + fr, fq * 8), boff = lds_byte(wc * 32 + fr, fq * 8);
#define PG8_SA(b, h) (((b) * 2 + (h)) * HTB)
#define PG8_SB(b, h) ((4 + (b) * 2 + (h)) * HTB)
#define PG8_STAGE(bufoff, gbase, voff) do { _Pragma("unroll") for (int _i = 0; _i < 2; ++_i) \
        __builtin_amdgcn_global_load_lds((const unsigned*)((const char*)(gbase) + (voff)[_i]), (LAS unsigned*)(lds + (bufoff) + ldsw + _i * 8192), 16, 0, 0); } while (0)
#define PG8_LDA(dst, b, h) do { _Pragma("unroll") for (int m = 0; m < 4; ++m) _Pragma("unroll") for (int k = 0; k < 2; ++k) dst[m][k] = *(const LAS bf16x8*)(lds + PG8_SA(b, h) + aoff + m * 2048 + k * 1024); } while (0)
#define PG8_LDB(dst, b, h) do { _Pragma("unroll") for (int n = 0; n < 2; ++n) _Pragma("unroll") for (int k = 0; k < 2; ++k) dst[n][k] = *(const LAS bf16x8*)(lds + PG8_SB(b, h) + boff + n * 2048 + k * 1024); } while (0)
#define PG8_MMA(ai, bj, At, Bt) do { __builtin_amdgcn_s_setprio(1); _Pragma("unroll") for (int m = 0; m < 4; ++m) _Pragma("unroll") for (int n = 0; n < 2; ++n) _Pragma("unroll") for (int k = 0; k < 2; ++k) \
        acc[ai][bj][m][n] = __builtin_amdgcn_mfma_f32_16x16x32_bf16(Bt[n][k], At[m][k], acc[ai][bj][m][n], 0, 0, 0); __builtin_amdgcn_s_setprio(0); } while (0)
#define PG8_WAIT_V(n) asm volatile("s_waitcnt vmcnt(" #n ")" ::: "memory")
#define PG8_WAIT_L(n) asm volatile("s_waitcnt lgkmcnt(" #n ")" ::: "memory")
#define PG8_BAR __builtin_amdgcn_s_barrier()
#define PG8_SCHED __builtin_amdgcn_sched_barrier(0)
    Unit cur, nxt; int ui = 0;
    if (!S.next(0, cur)) return;
    f32x4 acc[2][2][4][2];
#pragma unroll
    for (int a = 0; a < 2; ++a)
#pragma unroll
        for (int b = 0; b < 2; ++b)
#pragma unroll
            for (int m = 0; m < 4; ++m)
#pragma unroll
                for (int n = 0; n < 2; ++n) acc[a][b][m][n] = (f32x4){0.f, 0.f, 0.f, 0.f};
    bf16x8 At[4][2], B0[2][2], B1[2][2];
    const char* cA = a_of(g, cur.pn) + (size_t)cur.pm * tstep + (size_t)cur.kofs * 2; const char* cB = (const char*)g.Bt + (size_t)cur.pn * tstep + (size_t)cur.kofs * 2;
    PG8_STAGE(PG8_SB(0, 0), cB, voffB); PG8_STAGE(PG8_SB(0, 1), cB + hstep, voffB); PG8_STAGE(PG8_SA(0, 0), cA, voffA); PG8_STAGE(PG8_SA(0, 1), cA + hstep, voffA);
    if (wr == 1) PG8_BAR;
    PG8_WAIT_V(2); PG8_BAR;
    PG8_STAGE(PG8_SB(1, 0), cB + kstep, voffB); PG8_STAGE(PG8_SA(1, 0), cA + kstep, voffA); PG8_STAGE(PG8_SB(1, 1), cB + hstep + kstep, voffB);
    PG8_WAIT_V(6); PG8_BAR;
    for (;;) {
        const bool has_next = S.next(ui + 1, nxt);
        const char* nA = has_next ? a_of(g, nxt.pn) + (size_t)nxt.pm * tstep + (size_t)nxt.kofs * 2 : cA; const char* nB = has_next ? (const char*)g.Bt + (size_t)nxt.pn * tstep + (size_t)nxt.kofs * 2 : cB;
        const int nt = cur.knt;
        for (int t = 0; t < nt; t += 2) {
            const bool last = (t == nt - 2);
            const char* a1 = cA + (size_t)(t + 1) * kstep;
            const char* a2 = last ? nA : cA + (size_t)(t + 2) * kstep; const char* b2 = last ? nB : cB + (size_t)(t + 2) * kstep;
            const char* a3 = a2 + kstep; const char* b3 = b2 + kstep;
            PG8_LDB(B0, 0, 0); PG8_LDB(B1, 0, 1); PG8_SCHED; PG8_LDA(At, 0, 0); PG8_STAGE(PG8_SA(1, 1), a1 + hstep, voffA);
            PG8_WAIT_V(8); PG8_WAIT_L(0); PG8_BAR; PG8_MMA(0, 0, At, B0); PG8_MMA(0, 1, At, B1); PG8_BAR; PG8_SCHED;
            PG8_LDA(At, 0, 1); PG8_STAGE(PG8_SB(0, 0), b2, voffB); PG8_STAGE(PG8_SB(0, 1), b2 + hstep, voffB); PG8_STAGE(PG8_SA(0, 0), a2, voffA);
            PG8_WAIT_V(8); PG8_WAIT_L(0); PG8_BAR; PG8_MMA(1, 0, At, B0); PG8_MMA(1, 1, At, B1); PG8_BAR; PG8_SCHED;
            PG8_LDB(B0, 1, 0); PG8_LDB(B1, 1, 1); PG8_SCHED; PG8_LDA(At, 1, 0); PG8_STAGE(PG8_SA(0, 1), a2 + hstep, voffA);
            PG8_WAIT_V(8); PG8_WAIT_L(0); PG8_BAR; PG8_MMA(0, 0, At, B0); PG8_MMA(0, 1, At, B1); PG8_BAR; PG8_SCHED;
            PG8_LDA(At, 1, 1); PG8_STAGE(PG8_SB(1, 0), b3, voffB); PG8_STAGE(PG8_SB(1, 1), b3 + hstep, voffB); PG8_STAGE(PG8_SA(1, 0), a3, voffA);
            PG8_WAIT_V(8); PG8_WAIT_L(0); PG8_BAR; PG8_MMA(1, 0, At, B0); PG8_MMA(1, 1, At, B1); PG8_BAR; PG8_SCHED;
        }
        if (wr == 0) PG8_BAR;
        E(acc, cur, wr, wc, fr, fq);
        if (!has_next) break;
#pragma unroll
        for (int a = 0; a < 2; ++a)
#pragma unroll
            for (int b = 0; b < 2; ++b)
#pragma unroll
                for (int m = 0; m < 4; ++m)
#pragma unroll
                    for (int n = 0; n < 2; ++n) acc[a][b][m][n] = (f32x4){0.f, 0.f, 0.f, 0.f};
        cur = nxt; cA = nA; cB = nB; ++ui;
        if (wr == 1) PG8_BAR;
    }
    PG8_WAIT_V(0);
    PG8_BAR;
#undef PG8_SA
#undef PG8_SB
#undef PG8_STAGE
#undef PG8_LDA
#undef PG8_LDB
#undef PG8_MMA
#undef PG8_WAIT_V
#undef PG8_WAIT_L
#undef PG8_BAR
#undef PG8_SCHED
}
}

__device__ __forceinline__ void store8bf(bf16_t* p, f32x4 a, f32x4 b) {
    u32x4 w; w.x = cvt_pk_bf16(a[0], a[1]); w.y = cvt_pk_bf16(a[2], a[3]); w.z = cvt_pk_bf16(b[0], b[1]); w.w = cvt_pk_bf16(b[2], b[3]);
    *(u32x4*)p = w;
}
__device__ __forceinline__ const float* xin_row(const float* xp, const float* xs, int row) { return row < MPROMPT ? xp + (size_t)row * DM : xs + (size_t)(row - MPROMPT) * DM; }
struct FRes { float* X; float* PART; const float* xin_p; const float* xin_s;
    __device__ __forceinline__ void operator()(int row, int col, f32x4 a, f32x4 b, int split) const {
        float* p = X + (size_t)row * DM + col;
        if (split) { float* q = PART + (size_t)(split - 1) * 65536 + (row & 255) * 256 + (col & 255); *(f32x4*)q = a; *(f32x4*)(q + 4) = b; }
        else { const float* bp = xin_p ? xin_row(xin_p, xin_s, row) + col : p; f32x4 x0 = *(const f32x4*)bp, x1 = *(const f32x4*)(bp + 4); *(f32x4*)p = x0 + a; *(f32x4*)(p + 4) = x1 + b; } } };
struct FR1 { bf16_t *R, *K, *V, *L;
    __device__ __forceinline__ void operator()(int row, int col, f32x4 a, f32x4 b, int) const {
        if (col < 6144) { const int g = col >> 11; const size_t o = (size_t)row * DM + (col & 2047); if (g == 0) store8bf(R + o, a, b); else if (g == 1) store8bf(K + o, a, b); else store8bf(V + o, a, b); }
        else { const int t = (col - 6144) >> 8, c = col & 255;
            if (t == 0) { for (int i = 0; i < 4; ++i) { a[i] = 1.f - 2.f / (1.f + __expf(2.f * a[i])); b[i] = 1.f - 2.f / (1.f + __expf(2.f * b[i])); } }
            else if (t == 2) { for (int i = 0; i < 4; ++i) { a[i] = sigmoidf_(a[i]); b[i] = sigmoidf_(b[i]); } }
            store8bf(L + (size_t)t * MROWS * 256 + (size_t)row * 256 + c, a, b); } } };
__device__ __forceinline__ float decay_of(float z) { return -0.60653065971f / (1.f + __expf(-z)); }
struct FR2 { float* DD; bf16_t *AA, *GG, *VG; const float *w0, *a0, *v0;
    __device__ __forceinline__ void operator()(int row, int col, f32x4 a, f32x4 b, int) const {
        const int g = col >> 11, c = col & 2047; const size_t off = (size_t)row * DM + c;
        if (g == 0) { f32x4 z0 = *(const f32x4*)(w0 + c), z1 = *(const f32x4*)(w0 + c + 4); a += z0; b += z1;
            for (int i = 0; i < 4; ++i) { a[i] = decay_of(a[i]); b[i] = decay_of(b[i]); }
            *(f32x4*)(DD + off) = a; *(f32x4*)(DD + off + 4) = b; }
        else if (g == 1) { f32x4 z0 = *(const f32x4*)(a0 + c), z1 = *(const f32x4*)(a0 + c + 4); a += z0; b += z1;
            for (int i = 0; i < 4; ++i) { a[i] = sigmoidf_(a[i]); b[i] = sigmoidf_(b[i]); } store8bf(AA + off, a, b); }
        else if (g == 2) { store8bf(GG + off, a, b); }
        else { f32x4 z0 = *(const f32x4*)(v0 + c), z1 = *(const f32x4*)(v0 + c + 4); a += z0; b += z1;
            for (int i = 0; i < 4; ++i) { a[i] = sigmoidf_(a[i]); b[i] = sigmoidf_(b[i]); } store8bf(VG + off, a, b); } } };
struct FG1 { bf16_t* PROJ; float* LR;
    __device__ __forceinline__ void operator()(int row, int col, f32x4 a, f32x4 b, int) const {
        if (col < 6144) { if (col < 1024) { a *= 0.0625f; b *= 0.0625f; } store8bf(PROJ + (size_t)row * 6144 + col, a, b); }
        else if (col < 6160) { float* p = LR + (size_t)row * 16 + (col - 6144); *(f32x4*)p = a; *(f32x4*)(p + 4) = b; } } };
struct FUp { bf16_t* U; float* pconv; float* sconv;
    __device__ __forceinline__ void operator()(int row, int col, f32x4 a, f32x4 b, int) const {
        store8bf(U + (size_t)row * F2 + col, a, b);
        if (row < MPROMPT) { const int t = row & 8191; if (t >= 8190) { float* p = pconv + ((size_t)((row >> 13) * 2 + (t - 8190))) * F2 + col; *(f32x4*)p = a; *(f32x4*)(p + 4) = b; } }
        else { const int rr = row - MPROMPT, t = rr & 63; if (t >= 62) { float* p = sconv + ((size_t)((rr >> 6) * 2 + (t - 62))) * F2 + col; *(f32x4*)p = a; *(f32x4*)(p + 4) = b; } } } };

__device__ __forceinline__ void tr_item(const float* W, int K, int N, bf16_t* WT, int Kpad, int Npad, float* scr, int item, int lane) {
    const int nblk = Npad / 64, kb = item / nblk, nb = item % nblk, k0 = 64 * kb, n0 = 64 * nb;
    const int n4 = n0 + (lane & 15) * 4;
    f32x4 v[16];
#pragma unroll
    for (int i = 0; i < 16; ++i) { const int k = k0 + 4 * i + (lane >> 4); v[i] = (k < K && n4 < N) ? *(const f32x4*)(W + (size_t)k * N + n4) : (f32x4){0.f, 0.f, 0.f, 0.f}; }
#pragma unroll
    for (int i = 0; i < 16; ++i) { float* d = scr + (4 * i + (lane >> 4)) * 65 + (lane & 15) * 4; d[0] = v[i][0]; d[1] = v[i][1]; d[2] = v[i][2]; d[3] = v[i][3]; }
    asm volatile("s_waitcnt lgkmcnt(0)" ::: "memory");
    const int c = lane & 7;
#pragma unroll
    for (int j = 0; j < 8; ++j) { const int nn = (lane >> 3) + 8 * j; const float* s = scr + (8 * c) * 65 + nn;
        u32x4 o; o.x = cvt_pk_bf16(s[0 * 65], s[1 * 65]); o.y = cvt_pk_bf16(s[2 * 65], s[3 * 65]); o.z = cvt_pk_bf16(s[4 * 65], s[5 * 65]); o.w = cvt_pk_bf16(s[6 * 65], s[7 * 65]);
        *(u32x4*)(WT + (size_t)(n0 + nn) * Kpad + k0 + 8 * c) = o; }
    asm volatile("s_waitcnt lgkmcnt(0)" ::: "memory");
}

struct P { const float* in[39]; float* out; unsigned char* ws; };

__device__ __forceinline__ void row_info(int row, int& t, int& len, int& b, bool& prompt) {
    if (row < MPROMPT) { prompt = true; b = row >> 13; t = row & 8191; len = 8192; }
    else { prompt = false; const int rr = row - MPROMPT; b = rr >> 6; t = rr & 63; len = 64; }
}

__device__ __forceinline__ const float* ldp(const unsigned long long* tab, int i) {
    const unsigned long long v = tab[i];
    const unsigned lo = __builtin_amdgcn_readfirstlane((unsigned)v), hi = __builtin_amdgcn_readfirstlane((unsigned)(v >> 32));
    const __attribute__((address_space(1))) float* g = (const __attribute__((address_space(1))) float*)(((unsigned long long)hi << 32) | lo);
    return (const float*)g;
}
__device__ __forceinline__ void fast_grid_barrier(unsigned* bar, unsigned long long* tab) {
    asm volatile("s_waitcnt vmcnt(0)" ::: "memory");
    __syncthreads();
    if (threadIdx.x == 0) {
        const unsigned G = gridDim.x, grp = blockIdx.x & 7u;
        const unsigned epoch = (unsigned)tab[41] + 1u; tab[41] = epoch;
        const unsigned ngrp = (G - grp + 7u) >> 3, ntop = G < 8u ? G : 8u;
        __builtin_amdgcn_fence(__ATOMIC_RELEASE, "agent");
        asm volatile("s_waitcnt vmcnt(0)" ::: "memory");
        const unsigned old = __hip_atomic_fetch_add(&bar[64u * (1u + grp)], 1u, __ATOMIC_RELAXED, __HIP_MEMORY_SCOPE_AGENT);
        if (old + 1u == epoch * ngrp) (void)__hip_atomic_fetch_add(&bar[0], 1u, __ATOMIC_RELAXED, __HIP_MEMORY_SCOPE_AGENT);
        while (__hip_atomic_load(&bar[0], __ATOMIC_RELAXED, __HIP_MEMORY_SCOPE_AGENT) < epoch * ntop) __builtin_amdgcn_s_sleep(1);
        __builtin_amdgcn_fence(__ATOMIC_ACQUIRE, "agent");
        asm volatile("s_waitcnt vmcnt(0)" ::: "memory");
    }
    __syncthreads();
}
#define IN(k) ldp(tab, (k))
#define OUTP ((float*)ldp(tab, 39))
#define BASES float* X = (float*)ldp(tab, 39); unsigned char* ws_ = (unsigned char*)ldp(tab, 40); bf16_t* WT = (bf16_t*)(ws_ + WS_WT); unsigned char* RA = ws_ + WS_A; unsigned char* RB = ws_ + WS_B; \
    bf16_t* VFIRST = (bf16_t*)(ws_ + WS_VF); LAS unsigned char* ldsl = (LAS unsigned char*)lds; (void)X; (void)WT; (void)RA; (void)RB; (void)VFIRST; (void)ldsl;
#define RWKV_PTRS bf16_t* HB = (bf16_t*)RA; bf16_t* Rb = (bf16_t*)RB; bf16_t* Kb = Rb + ACT; bf16_t* Vb = (jl == 0) ? VFIRST : Kb + ACT; bf16_t* Lb = (bf16_t*)(RB + 204 * MiB); \
    float* DD = (float*)(RB + 240 * MiB); bf16_t* AA = (bf16_t*)RA; bf16_t* VG = AA + ACT; bf16_t* GG = VG + ACT; bf16_t* Y = GG + ACT; \
    bf16_t* W1 = WT + jl * RW_SZ; bf16_t* W2 = W1 + (size_t)7168 * 2048; bf16_t* WO = W2 + (size_t)8192 * 256; \
    (void)HB; (void)Rb; (void)Kb; (void)Vb; (void)Lb; (void)DD; (void)AA; (void)VG; (void)GG; (void)Y; (void)W1; (void)W2; (void)WO;
#define GLA_PTRS bf16_t* H = (bf16_t*)RB; float* LR = (float*)(RB + 68 * MiB); float* O = (float*)(RB + 70 * MiB); bf16_t* Y = (bf16_t*)(RB + 206 * MiB); \
    bf16_t* PROJ = (bf16_t*)RA; bf16_t* QE = (bf16_t*)(RA + 204 * MiB); bf16_t* KDT = (bf16_t*)(RA + 238 * MiB); bf16_t* VT = (bf16_t*)(RA + 272 * MiB); \
    bf16_t* SC = (bf16_t*)(RA + 340 * MiB); float* EL = (float*)(RA + 349 * MiB); bf16_t* GI = WT + GW_OFF + jl * GW_SZ; bf16_t* GO = GI + (size_t)6400 * 2048; \
    (void)H; (void)LR; (void)O; (void)Y; (void)PROJ; (void)QE; (void)KDT; (void)VT; (void)SC; (void)EL; (void)GI; (void)GO;
#define FFN_PTRS bf16_t* H = (bf16_t*)RB; bf16_t* HID = (bf16_t*)(RB + 68 * MiB); bf16_t* U = (bf16_t*)RA; bf16_t* WU = WT + FW_OFF + layer * FW_SZ; bf16_t* WD = WU + (size_t)F2 * 2048; \
    (void)H; (void)HID; (void)U; (void)WU; (void)WD;

__global__ void __launch_bounds__(512, 2) fwd_kernel(P p) {
    extern __shared__ __attribute__((aligned(16))) unsigned char lds[];
    cg::grid_group grid = cg::this_grid();
    const int G = gridDim.x, NGW = G * 8, NT = G * 512;
#define PHASE_IDS int tid = threadIdx.x; asm volatile("" : "+v"(tid)); const int lane = tid & 63; const int wave = __builtin_amdgcn_readfirstlane(tid >> 6); const int gw = blockIdx.x * 8 + wave; const int gtid = blockIdx.x * 512 + tid; (void)lane; (void)gw; (void)gtid;
    unsigned long long* tab = (unsigned long long*)(lds + LDS_BYTES - 512);
    if (threadIdx.x == 0) {
#pragma unroll
        for (int i = 0; i < 39; ++i) tab[i] = (unsigned long long)p.in[i];
        tab[39] = (unsigned long long)p.out; tab[40] = (unsigned long long)p.ws; tab[41] = 0ull;
    }
    __syncthreads();

    {
        PHASE_IDS BASES
        if (blockIdx.x == 0) { for (int i = tid; i < 1024; i += 512) ((unsigned*)ws_)[i] = 0u; }
        float* scr = (float*)(lds + wave * 16896);
#define TR(src, K, N, dst, Kpad, Npad) do { const int _ni = ((Kpad) / 64) * ((Npad) / 64); for (int it = cgw_; it < _ni; it += cngw_) tr_item((src), (K), (N), (dst), (Kpad), (Npad), scr, it, lane); } while (0)
#define CONVERT_WEIGHTS(JLO, JHI, ILO, IHI, GWV, NGWV) do { const int cgw_ = (GWV), cngw_ = (NGWV); \
        _Pragma("unroll 1") for (int j = (JLO); j < (JHI); ++j) { \
            bf16_t* W1 = WT + j * RW_SZ; bf16_t* W2 = W1 + (size_t)7168 * 2048; bf16_t* WO = W2 + (size_t)8192 * 256; \
            TR(IN(24) + (size_t)j * DM * DM, 2048, 2048, W1, 2048, 2048); \
            TR(IN(25) + (size_t)j * DM * DM, 2048, 2048, W1 + (size_t)2048 * 2048, 2048, 2048); \
            TR(IN(26) + (size_t)j * DM * DM, 2048, 2048, W1 + (size_t)4096 * 2048, 2048, 2048); \
            TR(IN(11) + (size_t)j * DM * 96, 2048, 96, W1 + (size_t)6144 * 2048, 2048, 256); \
            TR(IN(14) + (size_t)j * DM * 96, 2048, 96, W1 + (size_t)6400 * 2048, 2048, 256); \
            TR(IN(19) + (size_t)j * DM * 256, 2048, 256, W1 + (size_t)6656 * 2048, 2048, 256); \
            if (j >= 1) TR(IN(17) + (size_t)(j - 1) * DM * 64, 2048, 64, W1 + (size_t)6912 * 2048, 2048, 256); \
            TR(IN(12) + (size_t)j * 96 * DM, 96, 2048, W2, 256, 2048); \
            TR(IN(15) + (size_t)j * 96 * DM, 96, 2048, W2 + (size_t)2048 * 256, 256, 2048); \
            TR(IN(20) + (size_t)j * 256 * DM, 256, 2048, W2 + (size_t)4096 * 256, 256, 2048); \
            if (j >= 1) TR(IN(18) + (size_t)(j - 1) * 64 * DM, 64, 2048, W2 + (size_t)6144 * 256, 256, 2048); \
            TR(IN(27) + (size_t)j * DM * DM, 2048, 2048, WO, 2048, 2048); \
            bf16_t* GI = WT + GW_OFF + j * GW_SZ; bf16_t* GO = GI + (size_t)6400 * 2048; \
            TR(IN(30) + (size_t)j * DM * 6160, 2048, 6160, GI, 2048, 6400); \
            TR(IN(34) + (size_t)j * DM * DM, 2048, 2048, GO, 2048, 2048); \
        } \
        _Pragma("unroll 1") for (int i = (ILO); i < (IHI); ++i) { \
            bf16_t* WU = WT + FW_OFF + i * FW_SZ; bf16_t* WD = WU + (size_t)F2 * 2048; \
            TR(IN(35) + (size_t)i * DM * F2, 2048, F2, WU, 2048, F2); \
            TR(IN(38) + (size_t)i * FH * DM, FH, 2048, WD, FH, 2048); \
        } } while (0)
        if (G >= 256) CONVERT_WEIGHTS(0, 1, 0, 2, gw, NGW); else CONVERT_WEIGHTS(0, 2, 0, 4, gw, NGW);
    }
    grid.sync();

#pragma clang loop unroll(full)
    for (int layer = 0; layer < 4; ++layer) {
        const int jl = layer >> 1;
        if ((layer & 1) == 0) {
            {
                PHASE_IDS BASES RWKV_PTRS
                const float* gmix = IN(6) + (size_t)layer * DM;
                const float* mix = IN(9) + (size_t)jl * 6 * DM;
                const float* sst = IN(2) + (size_t)jl * 16 * DM;
                const float* xin0 = IN(0); const float* xin1 = IN(1);
                float* mixS = (float*)lds; float* gS = mixS + 6 * DM;
                for (int i = tid; i < 6 * DM / 4; i += 512) *(f32x4*)(mixS + i * 4) = *(const f32x4*)(mix + i * 4);
                for (int i = tid; i < DM / 4; i += 512) *(f32x4*)(gS + i * 4) = *(const f32x4*)(gmix + i * 4);
                __syncthreads();
                for (int row = gw; row < MROWS; row += NGW) {
                    int t, len, b; bool prompt; row_info(row, t, len, b, prompt);
                    const f32x4* xr = (const f32x4*)(layer == 0 ? xin_row(xin0, xin1, row) : X + (size_t)row * DM) + lane;
                    f32x4 x[8]; float ss = 0.f;
#pragma unroll
                    for (int q = 0; q < 8; ++q) { x[q] = xr[64 * q]; ss += x[q][0] * x[q][0] + x[q][1] * x[q][1] + x[q][2] * x[q][2] + x[q][3] * x[q][3]; }
                    const float rs = rsqrtf(wave_sum(ss, lane) * (1.f / DM) + 1e-6f);
                    f32x4 hp[8];
                    if (t > 0) {
                        const f32x4* xq = (const f32x4*)(layer == 0 ? xin_row(xin0, xin1, row - 1) : X + (size_t)(row - 1) * DM) + lane; float s2 = 0.f;
#pragma unroll
                        for (int q = 0; q < 8; ++q) { hp[q] = xq[64 * q]; s2 += hp[q][0] * hp[q][0] + hp[q][1] * hp[q][1] + hp[q][2] * hp[q][2] + hp[q][3] * hp[q][3]; }
                        const float rp = rsqrtf(wave_sum(s2, lane) * (1.f / DM) + 1e-6f);
#pragma unroll
                        for (int q = 0; q < 8; ++q) { const f32x4 gg = *((const f32x4*)gS + lane + 64 * q); hp[q] = hp[q] * rp * gg; }
                    } else if (!prompt) {
#pragma unroll
                        for (int q = 0; q < 8; ++q) hp[q] = *((const f32x4*)(sst + (size_t)b * DM) + lane + 64 * q);
                    } else {
#pragma unroll
                        for (int q = 0; q < 8; ++q) hp[q] = (f32x4){0.f, 0.f, 0.f, 0.f};
                    }
                    const bool lastrow = (t == len - 1);
                    float* shout = OUTP + (prompt ? O_PSHIFT + ((size_t)jl * 2 + b) * DM : O_SSHIFT + ((size_t)jl * 16 + b) * DM);
#pragma unroll
                    for (int q = 0; q < 8; ++q) {
                        const f32x4 gg = *((const f32x4*)gS + lane + 64 * q);
                        const f32x4 h = x[q] * rs * gg; const f32x4 dlt = hp[q] - h;
                        if (lastrow) *((f32x4*)shout + lane + 64 * q) = h;
#pragma unroll
                        for (int m = 0; m < 6; ++m) {
                            const f32x4 mx = *((const f32x4*)(mixS + m * DM) + lane + 64 * q);
                            const f32x4 o = h + dlt * mx;
                            u32x2 w; w.x = cvt_pk_bf16(o[0], o[1]); w.y = cvt_pk_bf16(o[2], o[3]);
                            *((u32x2*)(HB + (size_t)m * ACT + (size_t)row * DM) + lane + 64 * q) = w;
                        }
                    }
                }
            }
            fast_grid_barrier((unsigned*)ldp(tab, 40), tab);
            {
                BASES RWKV_PTRS
                pg8::Gemm g{HB, W1, MROWS, jl == 0 ? 6912 : 7168, 2048, 1, ACT * 2};
                pg8::StaticOrder S; S.init(g.M, g.N, G, (int)blockIdx.x, g.K, 1);
                pg8::Epi<FR1> E{FR1{Rb, Kb, Vb, Lb}};
                pg8::gemm_phase(ldsl, g, S, E);
            }
            fast_grid_barrier((unsigned*)ldp(tab, 40), tab);
            {
                BASES RWKV_PTRS
                pg8::Gemm g{Lb, W2, MROWS, jl == 0 ? 6144 : 8192, 256, 2, (size_t)MROWS * 256 * 2};
                pg8::StaticOrder S; S.init(g.M, g.N, G, (int)blockIdx.x, g.K, 1);
                pg8::Epi<FR2> E{FR2{DD, AA, GG, VG, IN(10) + (size_t)jl * DM, IN(13) + (size_t)jl * DM, IN(16) + (size_t)(jl > 0 ? jl - 1 : 0) * DM}};
                pg8::gemm_phase(ldsl, g, S, E);
            }
            fast_grid_barrier((unsigned*)ldp(tab, 40), tab);
            {
                PHASE_IDS BASES RWKV_PTRS
                float* Obuf = (float*)(RA + 272 * MiB); float* RK = (float*)(RB + 204 * MiB); float* DTg = (float*)(RB + 208 * MiB);
                const float* k_k = IN(21) + (size_t)jl * DM; const float* k_a = IN(22) + (size_t)jl * DM; const float* r_k = IN(23) + (size_t)jl * DM;
                const int l32 = lane & 31, hl = lane >> 5;
#define S1_BAR do { asm volatile("s_waitcnt lgkmcnt(0)" ::: "memory"); __builtin_amdgcn_s_barrier(); asm volatile("" ::: "memory"); } while (0)
                const int st = tid >> 3, c0 = (tid & 7) * 8;
                u32x4 pr_, pk_, pv_, pa_, pvf_ = (u32x4){0u, 0u, 0u, 0u}, pvg_ = (u32x4){0u, 0u, 0u, 0u}; f32x4 pd0_, pd1_;
#define S1_FETCH(it) do { const size_t _off = (size_t)(((it) >> 5) * 64 + st) * DM + ((it) & 31) * 64 + c0; \
                    pr_ = *(const u32x4*)(Rb + _off); pk_ = *(const u32x4*)(Kb + _off); pv_ = *(const u32x4*)(Vb + _off); pa_ = *(const u32x4*)(AA + _off); \
                    pd0_ = *(const f32x4*)(DD + _off); pd1_ = *(const f32x4*)(DD + _off + 4); \
                    if (jl > 0) { pvf_ = *(const u32x4*)(VFIRST + _off); pvg_ = *(const u32x4*)(VG + _off); } } while (0)
                if ((int)blockIdx.x < 8704) S1_FETCH((int)blockIdx.x);
#pragma unroll 1
                for (int item = blockIdx.x; item < 8704; item += G) {
                    LAS unsigned char* ldsv = (LAS unsigned char*)lds; asm volatile("" : "+v"(ldsv));
                    LAS bf16_t* AH = (LAS bf16_t*)(ldsv + 0); LAS bf16_t* RH = (LAS bf16_t*)(ldsv + 9216); LAS bf16_t* BH = (LAS bf16_t*)(ldsv + 18432); LAS bf16_t* KH = (LAS bf16_t*)(ldsv + 27648);
                    LAS bf16_t* BHT = (LAS bf16_t*)(ldsv + 36864); LAS bf16_t* KHT = (LAS bf16_t*)(ldsv + 46080); LAS bf16_t* VTs = (LAS bf16_t*)(ldsv + 55296); LAS bf16_t* XT = (LAS bf16_t*)(ldsv + 64512);
                    LAS float* AAB = (LAS float*)(ldsv + 82944); LAS bf16_t* AAK = (LAS bf16_t*)(ldsv + 99328); LAS bf16_t* ARB = (LAS bf16_t*)(ldsv + 108544); LAS bf16_t* ARK = (LAS bf16_t*)(ldsv + 117760);
                    LAS float* LB = (LAS float*)(ldsv + 126976); LAS float* DTS = (LAS float*)(ldsv + 143360);
                    (void)RH; (void)KH; (void)KHT;
                    const int chunk = item >> 5, h = item & 31, r0 = chunk * 64;
                    const int col = h * 64 + c0;
                    float r[8], kk[8], bb[8], km[8], ld[8];
                    {
                        float k[8], v[8], a[8];
                        unpack8(pr_, r); unpack8(pk_, k); unpack8(pv_, v); unpack8(pa_, a);
                        const f32x4 d0 = pd0_, d1 = pd1_;
                        ld[0] = d0[0]; ld[1] = d0[1]; ld[2] = d0[2]; ld[3] = d0[3]; ld[4] = d1[0]; ld[5] = d1[1]; ld[6] = d1[2]; ld[7] = d1[3];
                        if (jl > 0) { float vf[8], vg[8]; unpack8(pvf_, vf); unpack8(pvg_, vg);
#pragma unroll
                            for (int i = 0; i < 8; ++i) v[i] = v[i] + (vf[i] - v[i]) * vg[i]; }
                        float ss = 0.f;
#pragma unroll
                        for (int i = 0; i < 8; ++i) { kk[i] = k[i] * k_k[col + i]; ss += kk[i] * kk[i]; }
                        ss = sum8(ss, lane);
                        const float inv = 1.f / fmaxf(sqrtf(ss), 1e-12f);
                        float rk = 0.f;
#pragma unroll
                        for (int i = 0; i < 8; ++i) { kk[i] *= inv; bb[i] = kk[i] * a[i]; km[i] = k[i] * (1.f + (a[i] - 1.f) * k_a[col + i]); rk += r[i] * km[i] * r_k[col + i]; }
                        rk = sum8(rk, lane);
                        if ((tid & 7) == 0) RK[(size_t)(r0 + st) * 32 + h] = rk;
                        *(LAS f32x4*)(LB + st * 64 + c0) = d0; *(LAS f32x4*)(LB + st * 64 + c0 + 4) = d1;
#pragma unroll
                        for (int i = 0; i < 8; i += 2) { const unsigned pk = cvt_pk_bf16(v[i], v[i + 1]); VTs[(c0 + i) * 72 + st] = (bf16_t)(pk & 0xffffu); VTs[(c0 + i + 1) * 72 + st] = (bf16_t)(pk >> 16); }
                    }
                    S1_BAR;
                    {
                        const int cc_ = tid & 63, tq_ = tid >> 6; float pf[8]; float run = 0.f;
#pragma unroll
                        for (int j = 0; j < 8; ++j) { run += LB[(8 * tq_ + j) * 64 + cc_]; pf[j] = run; }
                        AAB[tq_ * 64 + cc_] = run;
                        S1_BAR;
                        float ofs = 0.f;
#pragma unroll
                        for (int g = 0; g < 7; ++g) ofs += (g < tq_) ? AAB[g * 64 + cc_] : 0.f;
#pragma unroll
                        for (int j = 0; j < 8; ++j) LB[(8 * tq_ + j) * 64 + cc_] = pf[j] + ofs;
                    }
                    S1_BAR;
                    {
                        float ah[8], bh[8], kh[8], rh[8];
#pragma unroll
                        for (int i = 0; i < 8; ++i) { const float Lt = LB[st * 64 + c0 + i]; const float e3 = __expf(Lt), e2 = __expf(-Lt), e1 = __expf(Lt - ld[i]);
                            ah[i] = -kk[i] * e1; bh[i] = bb[i] * e2; kh[i] = km[i] * e2; rh[i] = r[i] * e3;
                            if (st == 63) { DTS[c0 + i] = e3; DTg[(size_t)item * 64 + c0 + i] = e3; } }
                        *(LAS u32x4*)(AH + st * 72 + c0) = pack8(ah); *(LAS u32x4*)(RH + st * 72 + c0) = pack8(rh);
                        *(LAS u32x4*)(BH + st * 72 + c0) = pack8(bh); *(LAS u32x4*)(KH + st * 72 + c0) = pack8(kh);
#pragma unroll
                        for (int i = 0; i < 8; i += 2) { const unsigned p1 = cvt_pk_bf16(bh[i], bh[i + 1]), p2 = cvt_pk_bf16(kh[i], kh[i + 1]);
                            BHT[(c0 + i) * 72 + st] = (bf16_t)(p1 & 0xffffu); BHT[(c0 + i + 1) * 72 + st] = (bf16_t)(p1 >> 16);
                            KHT[(c0 + i) * 72 + st] = (bf16_t)(p2 & 0xffffu); KHT[(c0 + i + 1) * 72 + st] = (bf16_t)(p2 >> 16); }
                    }
                    S1_BAR;
                    {
                        const int mi = wave & 3, rowsel = mi >> 1, tt = mi & 1;
#pragma unroll
                        for (int nn = 0; nn < 2; ++nn) {
                            const int colsel = wave >> 2, stl = nn; const int ni = 2 * colsel + nn;
                            f32x16 acc;
#pragma unroll
                            for (int i = 0; i < 16; ++i) acc[i] = 0.f;
                            if (stl <= tt) {
#pragma unroll
                                for (int ks = 0; ks < 4; ++ks) {
                                    const bf16x8 a = *(const LAS bf16x8*)(AH + (mi * 32 + l32) * 72 + ks * 16 + hl * 8);
                                    const bf16x8 b = *(const LAS bf16x8*)(BH + (ni * 32 + l32) * 72 + ks * 16 + hl * 8);
                                    acc = __builtin_amdgcn_mfma_f32_32x32x16_bf16(a, b, acc, 0, 0, 0);
                                }
                            }
#pragma unroll
                            for (int i = 0; i < 16; ++i) {
                                const int t = tt * 32 + crow(i, hl), s = stl * 32 + l32;
                                const bool keep = rowsel ? (s <= t) : (s < t);
                                const float val = keep ? acc[i] : 0.f;
                                if (rowsel == 0 && colsel == 0) AAB[t * 64 + s] = val;
                                else { LAS bf16_t* dst = (rowsel == 0) ? AAK : (colsel == 0 ? ARB : ARK); dst[t * 72 + s] = (bf16_t)(cvt_pk_bf16(val, 0.f) & 0xffffu); }
                            }
                        }
                    }
                    S1_BAR;
                    if (wave < 4) {
                        const int mt = wave >> 1, nt = wave & 1;
                        f32x16 acc;
#pragma unroll
                        for (int i = 0; i < 16; ++i) acc[i] = 0.f;
#pragma unroll
                        for (int ks = 0; ks < 4; ++ks) {
                            const bf16x8 a = *(const LAS bf16x8*)(AAK + (mt * 32 + l32) * 72 + ks * 16 + hl * 8);
                            const bf16x8 b = *(const LAS bf16x8*)(VTs + (nt * 32 + l32) * 72 + ks * 16 + hl * 8);
                            acc = __builtin_amdgcn_mfma_f32_32x32x16_bf16(a, b, acc, 0, 0, 0);
                        }
#pragma unroll
                        for (int i = 0; i < 16; ++i) LB[(mt * 32 + crow(i, hl)) * 64 + nt * 32 + l32] = acc[i];
                    }
                    S1_BAR;
                    {
                        const int colx = tid >> 2, par = tid & 3;
                        float Xp[4][4];
#pragma unroll
                        for (int i = 0; i < 4; ++i) { Xp[i][0] = 0.f; Xp[i][1] = 0.f; Xp[i][2] = 0.f; Xp[i][3] = 0.f; }
#pragma clang loop unroll(full)
                        for (int t = 0; t < 64; ++t) {
                            const float va_ = bf2f(AH[t * 72 + (colx & 63)]), vb_ = LB[t * 64 + (colx & 63)];
                            float a0 = par ? 0.f : ((colx < 64) ? va_ : vb_);
                            float a1 = 0.f, a2 = 0.f, a3 = 0.f;
#pragma clang loop unroll(full)
                            for (int i = 0; 16 * i < t; ++i) { const f32x4 w = *(const LAS f32x4*)(AAB + t * 64 + 16 * i + 4 * par);
                                a0 += w[0] * Xp[i][0]; a1 += w[1] * Xp[i][1]; a2 += w[2] * Xp[i][2]; a3 += w[3] * Xp[i][3]; }
                            float val = (a0 + a1) + (a2 + a3);
                            val += __builtin_bit_cast(float, __builtin_amdgcn_update_dpp(0, __builtin_bit_cast(int, val), 0xB1, 0xf, 0xf, false));
                            val += __builtin_bit_cast(float, __builtin_amdgcn_update_dpp(0, __builtin_bit_cast(int, val), 0x4E, 0xf, 0xf, false));
                            Xp[t >> 4][t & 3] = (par == ((t >> 2) & 3)) ? val : Xp[t >> 4][t & 3];
                            asm volatile("" : "+v"(Xp[t >> 4][t & 3]));
                        }
#pragma unroll
                        for (int i = 0; i < 4; ++i) { u32x2 w; w.x = cvt_pk_bf16(Xp[i][0], Xp[i][1]); w.y = cvt_pk_bf16(Xp[i][2], Xp[i][3]);
                            *(LAS u32x2*)(XT + colx * 72 + 16 * i + 4 * par) = w; }
                    }
                    S1_BAR;
                    if (item + G < 8704) S1_FETCH(item + G);
                    {
                        const int kind = wave >> 2, mt = (wave & 3) >> 1, nt = wave & 1;
                        {
                            const LAS bf16_t* Ap = (kind == 0 ? ARB : BHT) + (mt * 32 + l32) * 72; const LAS bf16_t* Bp = XT + (nt * 32 + l32) * 72;
                            f32x16 acc;
#pragma unroll
                            for (int i = 0; i < 16; ++i) acc[i] = 0.f;
#pragma unroll
                            for (int ks = 0; ks < 4; ++ks) acc = __builtin_amdgcn_mfma_f32_32x32x16_bf16(*(const LAS bf16x8*)(Ap + ks * 16 + hl * 8), *(const LAS bf16x8*)(Bp + ks * 16 + hl * 8), acc, 0, 0, 0);
                            bf16_t* dstb = (kind == 0) ? Rb : Kb;
#pragma unroll
                            for (int i = 0; i < 16; ++i) { const int rr = mt * 32 + crow(i, hl), cc = nt * 32 + l32;
                                float val = acc[i];
                                if (kind == 0) val += bf2f(RH[rr * 72 + cc]); else val *= DTS[rr];
                                dstb[(size_t)(r0 + rr) * DM + h * 64 + cc] = (bf16_t)(cvt_pk_bf16(val, 0.f) & 0xffffu); }
                        }
                        {
                            const LAS bf16_t* A1 = (kind == 0 ? ARB : BHT) + (mt * 32 + l32) * 72; const LAS bf16_t* A2 = (kind == 0 ? ARK : KHT) + (mt * 32 + l32) * 72;
                            const LAS bf16_t* B1 = XT + (64 + nt * 32 + l32) * 72; const LAS bf16_t* B2 = VTs + (nt * 32 + l32) * 72;
                            f32x16 acc;
#pragma unroll
                            for (int i = 0; i < 16; ++i) acc[i] = 0.f;
#pragma unroll
                            for (int ks = 0; ks < 4; ++ks) acc = __builtin_amdgcn_mfma_f32_32x32x16_bf16(*(const LAS bf16x8*)(A1 + ks * 16 + hl * 8), *(const LAS bf16x8*)(B1 + ks * 16 + hl * 8), acc, 0, 0, 0);
#pragma unroll
                            for (int ks = 0; ks < 4; ++ks) acc = __builtin_amdgcn_mfma_f32_32x32x16_bf16(*(const LAS bf16x8*)(A2 + ks * 16 + hl * 8), *(const LAS bf16x8*)(B2 + ks * 16 + hl * 8), acc, 0, 0, 0);
                            float* dstf = (kind == 0) ? Obuf : DD;
#pragma unroll
                            for (int i = 0; i < 16; ++i) { const int rr = mt * 32 + crow(i, hl), cc = nt * 32 + l32;
                                float val = acc[i]; if (kind == 1) val *= DTS[rr];
                                dstf[(size_t)(r0 + rr) * DM + h * 64 + cc] = val; }
                        }
                    }
                    S1_BAR;
                }
            }
            fast_grid_barrier((unsigned*)ldp(tab, 40), tab);
#undef S1_BAR
#undef S1_FETCH
            {
                PHASE_IDS BASES RWKV_PTRS
                const float* DTg = (const float*)(RB + 208 * MiB);
                const int l32 = lane & 31, hl = lane >> 5;
                const int q = wave * G + blockIdx.x;
                if (q < 1152) {
                    const bool prompt = q < 128; int b, h, vh, chunk0, nch;
                    if (prompt) { const int chain = q & 63; b = chain >> 5; h = chain & 31; vh = q >> 6; chunk0 = b * 128; nch = 128; }
                    else { const int sq = q - 128; const int chain = sq >> 1; b = chain >> 5; h = chain & 31; vh = sq & 1; chunk0 = 256 + b; nch = 1; }
                    const int colb = h * 64, vcol = colb + 32 * vh + l32;
                    f32x16 S0, S1;
                    if (prompt) {
#pragma unroll
                        for (int i = 0; i < 16; ++i) { S0[i] = 0.f; S1[i] = 0.f; }
                    } else {
                        const float* s0 = IN(3) + ((((size_t)jl * 16 + b) * 32 + h) * 64 + (32 * vh + l32)) * 64;
#pragma unroll
                        for (int i = 0; i < 16; ++i) { S0[i] = s0[crow(i, hl)]; S1[i] = s0[32 + crow(i, hl)]; }
                    }
                    bf16x8 gf[2][2][2]; f32x16 n0, n1; f32x4 dt_[2][4];
#define S2_COMPUTE(cc) do { const int _r0 = (chunk0 + (cc)) * 64; \
                        u32x4 w00, w01, w10, w11; \
                        w00.x = cvt_pk_bf16(S0[0], S0[1]); w00.y = cvt_pk_bf16(S0[2], S0[3]); w00.z = cvt_pk_bf16(S0[4], S0[5]); w00.w = cvt_pk_bf16(S0[6], S0[7]); \
                        w01.x = cvt_pk_bf16(S0[8], S0[9]); w01.y = cvt_pk_bf16(S0[10], S0[11]); w01.z = cvt_pk_bf16(S0[12], S0[13]); w01.w = cvt_pk_bf16(S0[14], S0[15]); \
                        w10.x = cvt_pk_bf16(S1[0], S1[1]); w10.y = cvt_pk_bf16(S1[2], S1[3]); w10.z = cvt_pk_bf16(S1[4], S1[5]); w10.w = cvt_pk_bf16(S1[6], S1[7]); \
                        w11.x = cvt_pk_bf16(S1[8], S1[9]); w11.y = cvt_pk_bf16(S1[10], S1[11]); w11.z = cvt_pk_bf16(S1[12], S1[13]); w11.w = cvt_pk_bf16(S1[14], S1[15]); \
                        const bf16x8 sb00 = __builtin_bit_cast(bf16x8, w00), sb01 = __builtin_bit_cast(bf16x8, w01), sb10 = __builtin_bit_cast(bf16x8, w10), sb11 = __builtin_bit_cast(bf16x8, w11); \
                        n0 = __builtin_amdgcn_mfma_f32_32x32x16_bf16(gf[0][0][0], sb00, n0, 0, 0, 0); n1 = __builtin_amdgcn_mfma_f32_32x32x16_bf16(gf[1][0][0], sb00, n1, 0, 0, 0); \
                        n0 = __builtin_amdgcn_mfma_f32_32x32x16_bf16(gf[0][0][1], sb01, n0, 0, 0, 0); n1 = __builtin_amdgcn_mfma_f32_32x32x16_bf16(gf[1][0][1], sb01, n1, 0, 0, 0); \
                        n0 = __builtin_amdgcn_mfma_f32_32x32x16_bf16(gf[0][1][0], sb10, n0, 0, 0, 0); n1 = __builtin_amdgcn_mfma_f32_32x32x16_bf16(gf[1][1][0], sb10, n1, 0, 0, 0); \
                        n0 = __builtin_amdgcn_mfma_f32_32x32x16_bf16(gf[0][1][1], sb11, n0, 0, 0, 0); n1 = __builtin_amdgcn_mfma_f32_32x32x16_bf16(gf[1][1][1], sb11, n1, 0, 0, 0); \
                        { unsigned char* _sp = (unsigned char*)DD + ((size_t)(_r0 + l32) * DM + colb + 32 * vh) * 4 + 8 * hl; \
                          *(u32x2*)(_sp + 0) = (u32x2){w00.x, w00.y}; *(u32x2*)(_sp + 16) = (u32x2){w00.z, w00.w}; *(u32x2*)(_sp + 32) = (u32x2){w01.x, w01.y}; *(u32x2*)(_sp + 48) = (u32x2){w01.z, w01.w}; \
                          *(u32x2*)(_sp + 64) = (u32x2){w10.x, w10.y}; *(u32x2*)(_sp + 80) = (u32x2){w10.z, w10.w}; *(u32x2*)(_sp + 96) = (u32x2){w11.x, w11.y}; *(u32x2*)(_sp + 112) = (u32x2){w11.z, w11.w}; } \
                        _Pragma("unroll") for (int i = 0; i < 16; ++i) { S0[i] = S0[i] * dt_[0][i >> 2][i & 3] + n0[i]; S1[i] = S1[i] * dt_[1][i >> 2][i & 3] + n1[i]; } \
                    } while (0)
                    if (prompt) {
                        LAS float* dtl = (LAS float*)((LAS unsigned char*)lds);
                        LAS unsigned char* ring = (LAS unsigned char*)lds + 32768;
                        for (int i = lane; i < 128 * 16; i += 64) *(LAS f32x4*)(dtl + i * 4) = *(const f32x4*)(DTg + ((size_t)(chunk0 + (i >> 4)) * 32 + h) * 64 + (i & 15) * 4);
#define S2_DMA(cc) do { const int _r0 = (chunk0 + (cc)) * 64; LAS unsigned char* _s = ring + ((cc) & 3) * 16384; \
                            _Pragma("unroll") for (int j = 0; j < 8; ++j) { const int _row = 8 * j + (lane >> 3); const int _p = (lane & 7) ^ (_row & 7); \
                                __builtin_amdgcn_global_load_lds((const unsigned*)(Kb + (size_t)(_r0 + _row) * DM + colb + _p * 8), (LAS unsigned*)(_s + j * 1024), 16, 0, 0); } \
                            _Pragma("unroll") for (int j = 0; j < 8; ++j) { const int _row = 8 * j + (lane >> 3); \
                                __builtin_amdgcn_global_load_lds((const unsigned*)(DD + (size_t)(_r0 + _row) * DM + colb + 32 * vh + (lane & 7) * 4), (LAS unsigned*)(_s + 8192 + j * 1024), 16, 0, 0); } \
                        } while (0)
                        S2_DMA(0); S2_DMA(1);
#pragma unroll 1
                        for (int c = 0; c < 128; ++c) {
                            if (c + 2 < 128) { S2_DMA(c + 2); asm volatile("s_waitcnt vmcnt(32)" ::: "memory"); }
                            else if (c + 1 < 128) asm volatile("s_waitcnt vmcnt(16)" ::: "memory");
                            else asm volatile("s_waitcnt vmcnt(0)" ::: "memory");
                            LAS unsigned char* sl = ring + (c & 3) * 16384;
#pragma unroll
                            for (int mt = 0; mt < 2; ++mt)
#pragma unroll
                                for (int kt = 0; kt < 2; ++kt)
#pragma unroll
                                    for (int s2 = 0; s2 < 2; ++s2) {
                                        const int row = 32 * mt + l32, p = 4 * kt + 2 * s2;
                                        const u32x2 lo = *(const LAS u32x2*)(sl + row * 128 + ((p ^ (row & 7)) * 16) + 8 * hl);
                                        const u32x2 hi = *(const LAS u32x2*)(sl + row * 128 + (((p + 1) ^ (row & 7)) * 16) + 8 * hl);
                                        gf[mt][kt][s2] = __builtin_bit_cast(bf16x8, (u32x4){lo.x, lo.y, hi.x, hi.y});
                                    }
#pragma unroll
                            for (int i = 0; i < 16; ++i) { n0[i] = *(const LAS float*)(sl + 8192 + crow(i, hl) * 128 + l32 * 4); n1[i] = *(const LAS float*)(sl + 8192 + (32 + crow(i, hl)) * 128 + l32 * 4); }
#pragma unroll
                            for (int mt = 0; mt < 2; ++mt)
#pragma unroll
                                for (int g = 0; g < 4; ++g) dt_[mt][g] = *(const LAS f32x4*)(dtl + c * 64 + 32 * mt + 8 * g + 4 * hl);
                            S2_COMPUTE(c);
                        }
#undef S2_DMA
                    } else {
                        const int _r0 = chunk0 * 64; const size_t _item = (size_t)chunk0 * 32 + h;
#pragma unroll
                        for (int mt = 0; mt < 2; ++mt)
#pragma unroll
                            for (int kt = 0; kt < 2; ++kt)
#pragma unroll
                                for (int s2 = 0; s2 < 2; ++s2) {
                                    const size_t _o = (size_t)(_r0 + 32 * mt + l32) * DM + colb + 32 * kt + 16 * s2 + 4 * hl;
                                    const u32x2 _lo = *(const u32x2*)(Kb + _o), _hi = *(const u32x2*)(Kb + _o + 8); gf[mt][kt][s2] = __builtin_bit_cast(bf16x8, (u32x4){_lo.x, _lo.y, _hi.x, _hi.y}); }
#pragma unroll
                        for (int i = 0; i < 16; ++i) { n0[i] = DD[(size_t)(_r0 + crow(i, hl)) * DM + vcol]; n1[i] = DD[(size_t)(_r0 + 32 + crow(i, hl)) * DM + vcol]; }
#pragma unroll
                        for (int mt = 0; mt < 2; ++mt)
#pragma unroll
                            for (int g = 0; g < 4; ++g) dt_[mt][g] = *(const f32x4*)(DTg + _item * 64 + 32 * mt + 8 * g + 4 * hl);
                        S2_COMPUTE(0);
                    }
#undef S2_COMPUTE
                    float* so_ = OUTP + (prompt ? O_PWKV + ((((size_t)jl * 2 + b) * 32 + h) * 64 + (32 * vh + l32)) * 64
                                                : O_SWKV + ((((size_t)jl * 16 + b) * 32 + h) * 64 + (32 * vh + l32)) * 64);
#pragma unroll
                    for (int i = 0; i < 16; ++i) { so_[crow(i, hl)] = S0[i]; so_[32 + crow(i, hl)] = S1[i]; }
                }
            }
            fast_grid_barrier((unsigned*)ldp(tab, 40), tab);
            {
                PHASE_IDS BASES RWKV_PTRS
                const float* Obuf = (const float*)(RA + 272 * MiB); const float* RK = (const float*)(RB + 204 * MiB);
                const float* lnw_g = IN(28) + (size_t)jl * DM; const float* lnb_g = IN(29) + (size_t)jl * DM;
                float* lnw = (float*)(lds + 40960); float* lnb = lnw + DM;
                for (int i = tid; i < DM / 4; i += 512) { *(f32x4*)(lnw + i * 4) = *(const f32x4*)(lnw_g + i * 4); *(f32x4*)(lnb + i * 4) = *(const f32x4*)(lnb_g + i * 4); }
                __syncthreads();
                const int l32 = lane & 31, hl = lane >> 5;
#pragma unroll 1
                for (int item = blockIdx.x; item < 8704; item += G) {
                    LAS unsigned char* ldsv = (LAS unsigned char*)lds; asm volatile("" : "+v"(ldsv));
                    LAS bf16_t* R2s = (LAS bf16_t*)(ldsv + 0); LAS bf16_t* STs = (LAS bf16_t*)(ldsv + 9216); LAS float* Os = (LAS float*)(ldsv + 18432);
                    const int chunk = item >> 5, h = item & 31, r0 = chunk * 64;
                    {
                        const int rr = tid >> 3, pc = tid & 7;
                        *(LAS u32x4*)(R2s + rr * 72 + pc * 8) = *(const u32x4*)(Rb + (size_t)(r0 + rr) * DM + h * 64 + pc * 8);
                        const unsigned char* sp = (const unsigned char*)DD + ((size_t)(r0 + (rr & 31)) * DM + h * 64 + 32 * (rr >> 5)) * 4 + pc * 16;
                        *(LAS u32x4*)(STs + rr * 72 + pc * 8) = *(const u32x4*)sp;
                    }
                    __syncthreads();
                    if (wave < 4) {
                        const int tt = wave >> 1, vt = wave & 1;
                        f32x16 acc;
#pragma unroll
                        for (int i = 0; i < 16; ++i) acc[i] = Obuf[(size_t)(r0 + 32 * tt + crow(i, hl)) * DM + h * 64 + 32 * vt + l32];
#pragma unroll
                        for (int ks = 0; ks < 4; ++ks) acc = __builtin_amdgcn_mfma_f32_32x32x16_bf16(*(const LAS bf16x8*)(R2s + (32 * tt + l32) * 72 + ks * 16 + hl * 8), *(const LAS bf16x8*)(STs + (32 * vt + l32) * 72 + ks * 16 + hl * 8), acc, 0, 0, 0);
#pragma unroll
                        for (int i = 0; i < 16; ++i) Os[(32 * tt + crow(i, hl)) * 68 + 32 * vt + l32] = acc[i];
                    }
                    __syncthreads();
                    {
                        const int st = tid >> 3, c0 = (tid & 7) * 8, col = h * 64 + c0; const size_t off = (size_t)(r0 + st) * DM + col;
                        const f32x4 o0 = *(const LAS f32x4*)(Os + st * 68 + c0), o1 = *(const LAS f32x4*)(Os + st * 68 + c0 + 4);
                        float o[8] = {o0[0], o0[1], o0[2], o0[3], o1[0], o1[1], o1[2], o1[3]};
                        float s = 0.f;
#pragma unroll
                        for (int i = 0; i < 8; ++i) s += o[i];
                        const float mu = sum8(s, lane) * (1.f / 64.f); float q = 0.f;
#pragma unroll
                        for (int i = 0; i < 8; ++i) { o[i] -= mu; q += o[i] * o[i]; }
                        const float rstd = rsqrtf(sum8(q, lane) * (1.f / 64.f) + 64e-5f);
                        float v[8], g8[8]; unpack8(*(const u32x4*)(Vb + off), v); unpack8(*(const u32x4*)(GG + off), g8);
                        if (jl > 0) { float vf[8], vg[8]; unpack8(*(const u32x4*)(VFIRST + off), vf); unpack8(*(const u32x4*)(VG + off), vg);
#pragma unroll
                            for (int i = 0; i < 8; ++i) v[i] = v[i] + (vf[i] - v[i]) * vg[i]; }
                        const float rk = RK[(size_t)(r0 + st) * 32 + h];
                        float y[8];
#pragma unroll
                        for (int i = 0; i < 8; ++i) y[i] = (o[i] * rstd * lnw[col + i] + lnb[col + i] + rk * v[i]) * g8[i];
                        *(u32x4*)(Y + off) = pack8(y);
                    }
                    __syncthreads();
                }
            }
            fast_grid_barrier((unsigned*)ldp(tab, 40), tab);
            {
                BASES RWKV_PTRS
                pg8::Gemm g{Y, WO, MROWS, 2048, 2048, 0, 0};
                pg8::StaticOrder S; S.init(g.M, g.N, G, (int)blockIdx.x, g.K, 4);
                pg8::Epi<FRes> E{FRes{X, (float*)(RA + 272 * MiB), layer == 0 ? IN(0) : (const float*)nullptr, IN(1)}};
                pg8::gemm_phase(ldsl, g, S, E);
                fast_grid_barrier((unsigned*)ldp(tab, 40), tab);
                {
                    PHASE_IDS
                    const float* PART = (const float*)(RA + 272 * MiB); const int ntail = S.nwg - S.nFull;
                    if (S.S > 1) for (int idx = gtid; idx < ntail * 16384; idx += NT) {
                        const int tl = idx >> 14, r = (idx >> 6) & 255, c4 = idx & 63; int pm, pn; S.tile_pmpn(S.nFull + tl, pm, pn);
                        f32x4* xp = (f32x4*)(X + (size_t)(pm * 256 + r) * DM + pn * 256 + c4 * 4); f32x4 acc = (layer == 0) ? *(const f32x4*)(xin_row(E.f.xin_p, E.f.xin_s, pm * 256 + r) + pn * 256 + c4 * 4) : *xp;
#pragma unroll
                        for (int part = 0; part < 4; ++part) acc += *(const f32x4*)(PART + (size_t)(part * 32 + tl) * 65536 + r * 256 + c4 * 4);
                        *xp = acc; }
                }
            }
            fast_grid_barrier((unsigned*)ldp(tab, 40), tab);
        } else {
            { PHASE_IDS BASES GLA_PTRS
            const float* gmix = IN(6) + (size_t)layer * DM;
            f32x4 ggr[8];
#pragma unroll
            for (int q = 0; q < 8; ++q) ggr[q] = *((const f32x4*)gmix + lane + 64 * q);
            for (int row = gw; row < MROWS; row += NGW) {
                const f32x4* xr = (const f32x4*)(X + (size_t)row * DM) + lane; f32x4 x[8]; float ss = 0.f;
#pragma unroll
                for (int q = 0; q < 8; ++q) { x[q] = xr[64 * q]; ss += x[q][0] * x[q][0] + x[q][1] * x[q][1] + x[q][2] * x[q][2] + x[q][3] * x[q][3]; }
                const float rs = rsqrtf(wave_sum(ss, lane) * (1.f / DM) + 1e-6f);
#pragma unroll
                for (int q = 0; q < 8; ++q) { const f32x4 gg = ggr[q]; const f32x4 h = x[q] * rs * gg;
                    u32x2 w; w.x = cvt_pk_bf16(h[0], h[1]); w.y = cvt_pk_bf16(h[2], h[3]); *((u32x2*)(H + (size_t)row * DM) + lane + 64 * q) = w; }
            } }
            fast_grid_barrier((unsigned*)ldp(tab, 40), tab);
            {
                BASES GLA_PTRS
                pg8::Gemm g{H, GI, MROWS, 6400, 2048, 0, 0};
                pg8::StaticOrder S; S.init(g.M, g.N, G, (int)blockIdx.x, g.K, 1);
                pg8::Epi<FG1> E{FG1{PROJ, LR}};
                pg8::gemm_phase(ldsl, g, S, E);
            }
            fast_grid_barrier((unsigned*)ldp(tab, 40), tab);
            {
                PHASE_IDS BASES GLA_PTRS
                float* lrS = (float*)lds;
                float* w2S = (float*)(lds + 4096);
                float* totS = (float*)(lds + 20480);
                bf16_t* qeS = (bf16_t*)(lds + 22528);
                bf16_t* keS = (bf16_t*)(lds + 22528 + 33792);
                bf16_t* vS = qeS;
                const float* gw2 = IN(31) + (size_t)jl * 16 * 1024; const float* gkb = IN(32) + (size_t)jl * 1024;
#pragma unroll 1
                for (int it = blockIdx.x; it < 1088; it += G) {
                    const int c = it >> 2, h = it & 3, r0 = c * 64; const size_t base = (size_t)it;
                    if (tid < 256) *(f32x4*)(lrS + tid * 4) = *(const f32x4*)(LR + (size_t)r0 * 16 + tid * 4);
                    for (int q = tid; q < 1024; q += 512) { const int r = q >> 6, cc = (q & 63) * 4; *(f32x4*)(w2S + r * 256 + cc) = *(const f32x4*)(gw2 + (size_t)r * 1024 + h * 256 + cc); }
                    for (int q = tid; q < 2048; q += 512) { const int t = q >> 5, cc = (q & 31) * 8; const bf16_t* src = PROJ + (size_t)(r0 + t) * 6144 + h * 256 + cc;
                        *(u32x4*)(qeS + t * 264 + cc) = *(const u32x4*)src; *(u32x4*)(keS + t * 264 + cc) = *(const u32x4*)(src + 1024); }
                    __syncthreads();
                    const int d = tid & 255, half = tid >> 8;
                    float cumv[32];
                    {
                        float w[16];
#pragma unroll
                        for (int r = 0; r < 16; ++r) w[r] = w2S[r * 256 + d];
                        const float bb = gkb[h * 256 + d]; float run = 0.f;
#pragma unroll
                        for (int tt = 0; tt < 32; ++tt) {
                            const float* lp = lrS + (half * 32 + tt) * 16; float z = bb;
#pragma unroll
                            for (int r = 0; r < 16; ++r) z += lp[r] * w[r];
                            const float g = (fminf(z, 0.f) - log1pf(__expf(-fabsf(z)))) * 0.0625f;
                            run += g; cumv[tt] = run;
                        }
                        totS[half * 256 + d] = run;
                    }
                    __syncthreads();
                    {
                        const float t0 = totS[d], t1 = totS[256 + d]; const float last = t0 + t1, offc = half ? t0 : 0.f;
                        if (half == 0) EL[base * 256 + d] = __expf(last);
                        unsigned kdp[16];
#pragma unroll
                        for (int tt = 0; tt < 32; tt += 2) {
                            float kd2[2];
#pragma unroll
                            for (int e = 0; e < 2; ++e) {
                                const int t = half * 32 + tt + e; const float cum = cumv[tt + e] + offc;
                                const float q = bf2f(qeS[t * 264 + d]), k = bf2f(keS[t * 264 + d]);
                                const float qe = q * __expf(cum), ke = k * __expf(-cum); kd2[e] = k * __expf(last - cum);
                                const unsigned pq = cvt_pk_bf16(qe, ke);
                                qeS[t * 264 + d] = (bf16_t)(pq & 0xffffu); keS[t * 264 + d] = (bf16_t)(pq >> 16);
                            }
                            kdp[tt >> 1] = cvt_pk_bf16(kd2[0], kd2[1]);
                        }
                        u32x4* kdst = (u32x4*)(KDT + (base * 256 + d) * 64 + half * 32);
                        kdst[0] = (u32x4){kdp[0], kdp[1], kdp[2], kdp[3]}; kdst[1] = (u32x4){kdp[4], kdp[5], kdp[6], kdp[7]};
                        kdst[2] = (u32x4){kdp[8], kdp[9], kdp[10], kdp[11]}; kdst[3] = (u32x4){kdp[12], kdp[13], kdp[14], kdp[15]};
                    }
                    __syncthreads();
                    for (int q = tid; q < 2048; q += 512) { const int t = q >> 5, sl = (q >> 2) & 7, pc = q & 3;
                        *(u32x4*)(QE + ((base * 8 + sl) * 64 + t) * 32 + pc * 8) = *(const u32x4*)(qeS + t * 264 + sl * 32 + pc * 8); }
                    if (wave < 4) {
                        const int mi = wave >> 1, ni = wave & 1, l32 = lane & 31, hl = lane >> 5;
                        f32x16 cacc;
#pragma unroll
                        for (int i = 0; i < 16; ++i) cacc[i] = 0.f;
#pragma unroll
                        for (int kk = 0; kk < 16; ++kk) {
                            const bf16x8 a = *(const bf16x8*)(qeS + (mi * 32 + l32) * 264 + kk * 16 + hl * 8);
                            const bf16x8 b = *(const bf16x8*)(keS + (ni * 32 + l32) * 264 + kk * 16 + hl * 8);
                            cacc = __builtin_amdgcn_mfma_f32_32x32x16_bf16(a, b, cacc, 0, 0, 0);
                        }
#pragma unroll
                        for (int i = 0; i < 16; ++i) { const int ii = mi * 32 + crow(i, hl), jj = ni * 32 + l32;
                            const float v = (jj <= ii) ? cacc[i] : 0.f; SC[base * 4096 + ii * 64 + jj] = (bf16_t)(cvt_pk_bf16(v, 0.f) & 0xffffu); }
                    }
                    __syncthreads();
                    for (int q = tid; q < 4096; q += 512) { const int t = q >> 6, cc = (q & 63) * 8;
                        *(u32x4*)(vS + t * 520 + cc) = *(const u32x4*)(PROJ + (size_t)(r0 + t) * 6144 + 2048 + h * 512 + cc); }
                    __syncthreads();
                    {
                        const int dv = tid; u32x4* vdst = (u32x4*)(VT + (base * 512 + dv) * 64);
#pragma unroll
                        for (int q = 0; q < 8; ++q) {
                            unsigned w[4];
#pragma unroll
                            for (int e = 0; e < 4; ++e) { const unsigned lo = vS[(q * 8 + 2 * e) * 520 + dv], hi = vS[(q * 8 + 2 * e + 1) * 520 + dv]; w[e] = lo | (hi << 16); }
                            vdst[q] = (u32x4){w[0], w[1], w[2], w[3]};
                        }
                    }
                    __syncthreads();
                }
            }
            fast_grid_barrier((unsigned*)ldp(tab, 40), tab);
            {
                PHASE_IDS BASES GLA_PTRS
                float* red = (float*)lds;
                const int l32 = lane & 31, hl = lane >> 5;
#pragma unroll 1
                for (int u = blockIdx.x; u < 1152; u += G) {
                    const bool prompt = u < 128; int b, h, s, cg0, nch, row0;
                    if (prompt) { const int pair = u & 7; b = pair >> 2; h = pair & 3; s = u >> 3; cg0 = b * 128; nch = 128; row0 = b * 8192; }
                    else { const int su = u - 128; b = su >> 6; h = (su >> 4) & 3; s = su & 15; cg0 = 256 + b; nch = 1; row0 = MPROMPT + b * 64; }
                    f32x16 S;
                    if (prompt) {
#pragma unroll
                        for (int i = 0; i < 16; ++i) S[i] = 0.f;
                    } else {
                        const float* s0 = IN(4) + ((((size_t)jl * 16 + b) * 4 + h) * 256) * 512;
#pragma unroll
                        for (int i = 0; i < 16; ++i) S[i] = s0[(size_t)(32 * wave + crow(i, hl)) * 512 + 32 * s + l32];
                    }
                    const int mtw = wave & 1, ksw = wave >> 1;
                    bf16x8 ka[4], vb[4], qf[2][2], scf; f32x4 el[4];
#define GL_LD_Q(cc) do { const size_t _base = (size_t)(cg0 + (cc)) * 4 + h; const int _r0 = row0 + (cc) * 64; const bf16_t* _sc = SC + _base * 4096; \
                        _Pragma("unroll") for (int mt = 0; mt < 2; ++mt) _Pragma("unroll") for (int s2 = 0; s2 < 2; ++s2) { const bf16_t* _pq = QE + ((_base * 8 + wave) * 64 + mt * 32 + l32) * 32 + 16 * s2 + 4 * hl; \
                            const u32x2 _lo = *(const u32x2*)_pq, _hi = *(const u32x2*)(_pq + 8); qf[mt][s2] = __builtin_bit_cast(bf16x8, (u32x4){_lo.x, _lo.y, _hi.x, _hi.y}); } \
                        scf = *(const bf16x8*)(_sc + (mtw * 32 + l32) * 64 + 16 * ksw + 8 * hl); } while (0)
#define GL_LD_E(cc) do { const size_t _base = (size_t)(cg0 + (cc)) * 4 + h; \
                        _Pragma("unroll") for (int g = 0; g < 4; ++g) el[g] = *(const f32x4*)(EL + _base * 256 + 32 * wave + 8 * g + 4 * hl); } while (0)
#define GL_LD_K(cc) do { const size_t _base = (size_t)(cg0 + (cc)) * 4 + h; const bf16_t* _kdt = KDT + _base * 256 * 64; const bf16_t* _vt = VT + _base * 512 * 64; \
                        _Pragma("unroll") for (int ks = 0; ks < 4; ++ks) { ka[ks] = *(const bf16x8*)(_kdt + (32 * wave + l32) * 64 + 16 * ks + 8 * hl); vb[ks] = *(const bf16x8*)(_vt + (32 * s + l32) * 64 + 16 * ks + 8 * hl); } } while (0)
                    GL_LD_Q(0); GL_LD_E(0); GL_LD_K(0);
                    f32x4 osum = (f32x4){0.f, 0.f, 0.f, 0.f}; float* optr = nullptr;
#pragma unroll 1
                    for (int c = 0; c < nch; ++c) {
                        const int r0 = row0 + c * 64; const int cn = (c + 1 < nch) ? c + 1 : c;
                        asm volatile("" : "+v"(scf), "+v"(vb[3]));
                        if (c > 0) *(f32x4*)optr = osum;
                        u32x4 sp0, sp1;
                        sp0.x = cvt_pk_bf16(S[0], S[1]); sp0.y = cvt_pk_bf16(S[2], S[3]); sp0.z = cvt_pk_bf16(S[4], S[5]); sp0.w = cvt_pk_bf16(S[6], S[7]);
                        sp1.x = cvt_pk_bf16(S[8], S[9]); sp1.y = cvt_pk_bf16(S[10], S[11]); sp1.z = cvt_pk_bf16(S[12], S[13]); sp1.w = cvt_pk_bf16(S[14], S[15]);
                        const bf16x8 sb0 = __builtin_bit_cast(bf16x8, sp0), sb1 = __builtin_bit_cast(bf16x8, sp1);
                        const bf16x8 vbw = ksw == 0 ? vb[0] : ksw == 1 ? vb[1] : ksw == 2 ? vb[2] : vb[3];
#pragma unroll
                        for (int i = 0; i < 16; ++i) S[i] *= el[i >> 2][i & 3];
#pragma unroll
                        for (int ks = 0; ks < 4; ++ks) S = __builtin_amdgcn_mfma_f32_32x32x16_bf16(ka[ks], vb[ks], S, 0, 0, 0);
                        GL_LD_E(cn); GL_LD_K(cn);
                        f32x16 oo0, oo1;
#pragma unroll
                        for (int i = 0; i < 16; ++i) { oo0[i] = 0.f; oo1[i] = 0.f; }
                        oo0 = __builtin_amdgcn_mfma_f32_32x32x16_bf16(qf[0][0], sb0, oo0, 0, 0, 0); oo0 = __builtin_amdgcn_mfma_f32_32x32x16_bf16(qf[0][1], sb1, oo0, 0, 0, 0);
                        oo1 = __builtin_amdgcn_mfma_f32_32x32x16_bf16(qf[1][0], sb0, oo1, 0, 0, 0); oo1 = __builtin_amdgcn_mfma_f32_32x32x16_bf16(qf[1][1], sb1, oo1, 0, 0, 0);
                        if (mtw == 0) oo0 = __builtin_amdgcn_mfma_f32_32x32x16_bf16(scf, vbw, oo0, 0, 0, 0); else oo1 = __builtin_amdgcn_mfma_f32_32x32x16_bf16(scf, vbw, oo1, 0, 0, 0);
                        GL_LD_Q(cn);
#pragma unroll
                        for (int q = 0; q < 16; ++q) { red[(wave * 32 + q) * 64 + lane] = oo0[q]; red[(wave * 32 + 16 + q) * 64 + lane] = oo1[q]; }
                        asm volatile("s_waitcnt lgkmcnt(0)" ::: "memory"); __builtin_amdgcn_s_barrier(); asm volatile("" ::: "memory");
                        { const int q = tid >> 4, lg = tid & 15; f32x4 sum = (f32x4){0.f, 0.f, 0.f, 0.f};
#pragma unroll
                          for (int w = 0; w < 8; ++w) sum += *(const f32x4*)(red + (w * 32 + q) * 64 + 4 * lg);
                          const int mt = q >> 4, reg = q & 15, L = 4 * lg; const int i = mt * 32 + crow(reg, L >> 5), dv = L & 31;
                          osum = sum; optr = O + (size_t)(r0 + i) * DM + h * 512 + 32 * s + dv; }
                        asm volatile("s_waitcnt lgkmcnt(0)" ::: "memory"); __builtin_amdgcn_s_barrier(); asm volatile("" ::: "memory");
                    }
                    *(f32x4*)optr = osum;
#undef GL_LD_Q
#undef GL_LD_E
#undef GL_LD_K
                    float* dst = OUTP + (prompt ? O_PGLA + ((((size_t)jl * 2 + b) * 4 + h) * 256) * 512 : O_SGLA + ((((size_t)jl * 16 + b) * 4 + h) * 256) * 512);
#pragma unroll
                    for (int i = 0; i < 16; ++i) dst[(size_t)(32 * wave + crow(i, hl)) * 512 + 32 * s + l32] = S[i];
                }
                if (layer == 1 && G >= 256 && (int)blockIdx.x >= 128) {
                    float* scr = (float*)(lds + wave * 16896);
                    CONVERT_WEIGHTS(1, 2, 2, 4, ((int)blockIdx.x - 128) * 8 + wave, (G - 128) * 8);
                }
            }
            fast_grid_barrier((unsigned*)ldp(tab, 40), tab);
            {
                PHASE_IDS BASES GLA_PTRS
                const float* hn = IN(33) + (size_t)jl * 512;
                const f32x4 n0 = *(const f32x4*)(hn + lane * 8), n1 = *(const f32x4*)(hn + lane * 8 + 4);
                for (int row = gw; row < MROWS; row += NGW) {
#pragma unroll
                    for (int h = 0; h < 4; ++h) {
                        const float* op = O + (size_t)row * DM + h * 512 + lane * 8;
                        const f32x4 a = *(const f32x4*)op, b = *(const f32x4*)(op + 4);
                        float ss = a[0] * a[0] + a[1] * a[1] + a[2] * a[2] + a[3] * a[3] + b[0] * b[0] + b[1] * b[1] + b[2] * b[2] + b[3] * b[3];
                        const float rs = rsqrtf(wave_sum(ss, lane) * (1.f / 512.f) + 1e-5f);
                        float gt[8]; unpack8(*(const u32x4*)(PROJ + (size_t)row * 6144 + 4096 + h * 512 + lane * 8), gt);
                        float y[8];
#pragma unroll
                        for (int i = 0; i < 4; ++i) { y[i] = a[i] * rs * n0[i] * (gt[i] * sigmoidf_(gt[i])); y[4 + i] = b[i] * rs * n1[i] * (gt[4 + i] * sigmoidf_(gt[4 + i])); }
                        *(u32x4*)(Y + (size_t)row * DM + h * 512 + lane * 8) = pack8(y);
                    }
                }
            }
            fast_grid_barrier((unsigned*)ldp(tab, 40), tab);
            {
                BASES GLA_PTRS
                pg8::Gemm g{Y, GO, MROWS, 2048, 2048, 0, 0};
                pg8::StaticOrder S; S.init(g.M, g.N, G, (int)blockIdx.x, g.K, 4);
                pg8::Epi<FRes> E{FRes{X, (float*)(RA + 272 * MiB), nullptr, nullptr}};
                pg8::gemm_phase(ldsl, g, S, E);
                fast_grid_barrier((unsigned*)ldp(tab, 40), tab);
                {
                    PHASE_IDS
                    const float* PART = (const float*)(RA + 272 * MiB); const int ntail = S.nwg - S.nFull;
                    if (S.S > 1) for (int idx = gtid; idx < ntail * 16384; idx += NT) {
                        const int tl = idx >> 14, r = (idx >> 6) & 255, c4 = idx & 63; int pm, pn; S.tile_pmpn(S.nFull + tl, pm, pn);
                        f32x4* xp = (f32x4*)(X + (size_t)(pm * 256 + r) * DM + pn * 256 + c4 * 4); f32x4 acc = *xp;
#pragma unroll
                        for (int part = 0; part < 4; ++part) acc += *(const f32x4*)(PART + (size_t)(part * 32 + tl) * 65536 + r * 256 + c4 * 4);
                        *xp = acc; }
                }
            }
            fast_grid_barrier((unsigned*)ldp(tab, 40), tab);
        }
        {
            { PHASE_IDS BASES FFN_PTRS
            const float* gf = IN(7) + (size_t)layer * DM;
            f32x4 ggr[8];
#pragma unroll
            for (int q = 0; q < 8; ++q) ggr[q] = *((const f32x4*)gf + lane + 64 * q);
            for (int row = gw; row < MROWS; row += NGW) {
                const f32x4* xr = (const f32x4*)(X + (size_t)row * DM) + lane; f32x4 x[8]; float ss = 0.f;
#pragma unroll
                for (int q = 0; q < 8; ++q) { x[q] = xr[64 * q]; ss += x[q][0] * x[q][0] + x[q][1] * x[q][1] + x[q][2] * x[q][2] + x[q][3] * x[q][3]; }
                const float rs = rsqrtf(wave_sum(ss, lane) * (1.f / DM) + 1e-6f);
#pragma unroll
                for (int q = 0; q < 8; ++q) { const f32x4 gg = ggr[q]; const f32x4 h = x[q] * rs * gg;
                    u32x2 w; w.x = cvt_pk_bf16(h[0], h[1]); w.y = cvt_pk_bf16(h[2], h[3]); *((u32x2*)(H + (size_t)row * DM) + lane + 64 * q) = w; }
            } }
            fast_grid_barrier((unsigned*)ldp(tab, 40), tab);
            {
                BASES FFN_PTRS
                pg8::Gemm g{H, WU, MROWS, F2, 2048, 0, 0};
                pg8::StaticOrder S; S.init(g.M, g.N, G, (int)blockIdx.x, g.K, 1);
                pg8::Epi<FUp> E{FUp{U, OUTP + O_PCONV + (size_t)layer * 2 * 2 * F2, OUTP + O_SCONV + (size_t)layer * 16 * 2 * F2}};
                pg8::gemm_phase(ldsl, g, S, E);
            }
            fast_grid_barrier((unsigned*)ldp(tab, 40), tab);
            {
                PHASE_IDS BASES FFN_PTRS
                const float* cw = IN(36) + (size_t)layer * 3 * F2; const float* cb = IN(37) + (size_t)layer * F2;
                const float* cst = IN(5) + (size_t)layer * 16 * 2 * F2;
#pragma unroll 1
                for (int it = gtid; it < 544 * 704; it += NT) {
                    const int rc = it / 704, c8 = it - rc * 704, col = c8 * 8, r0 = rc * 32;
                    int t0, len, b; bool prompt; row_info(r0, t0, len, b, prompt);
                    float wv[3][8], wg[3][8], bv[8], bg[8];
#pragma unroll
                    for (int k = 0; k < 3; ++k) { const f32x4 a = *(const f32x4*)(cw + (size_t)k * F2 + col), a2 = *(const f32x4*)(cw + (size_t)k * F2 + col + 4);
                        const f32x4 g = *(const f32x4*)(cw + (size_t)k * F2 + FH + col), g2 = *(const f32x4*)(cw + (size_t)k * F2 + FH + col + 4);
#pragma unroll
                        for (int i = 0; i < 4; ++i) { wv[k][i] = a[i]; wv[k][4 + i] = a2[i]; wg[k][i] = g[i]; wg[k][4 + i] = g2[i]; } }
                    { const f32x4 a = *(const f32x4*)(cb + col), a2 = *(const f32x4*)(cb + col + 4), g = *(const f32x4*)(cb + FH + col), g2 = *(const f32x4*)(cb + FH + col + 4);
#pragma unroll
                      for (int i = 0; i < 4; ++i) { bv[i] = a[i]; bv[4 + i] = a2[i]; bg[i] = g[i]; bg[4 + i] = g2[i]; } }
                    float v2[8], v1[8], g2_[8], g1_[8];
                    if (t0 > 0) {
                        unpack8(*(const u32x4*)(U + (size_t)(r0 - 2) * F2 + col), v2); unpack8(*(const u32x4*)(U + (size_t)(r0 - 1) * F2 + col), v1);
                        unpack8(*(const u32x4*)(U + (size_t)(r0 - 2) * F2 + FH + col), g2_); unpack8(*(const u32x4*)(U + (size_t)(r0 - 1) * F2 + FH + col), g1_);
                    } else if (!prompt) {
                        const float* s0 = cst + ((size_t)b * 2) * F2 + col; const float* s1 = s0 + F2;
#pragma unroll
                        for (int i = 0; i < 8; ++i) { v2[i] = s0[i]; v1[i] = s1[i]; g2_[i] = s0[FH + i]; g1_[i] = s1[FH + i]; }
                    } else {
#pragma unroll
                        for (int i = 0; i < 8; ++i) { v2[i] = 0.f; v1[i] = 0.f; g2_[i] = 0.f; g1_[i] = 0.f; }
                    }
#pragma unroll 1
                    for (int rb = 0; rb < 32; rb += 8) {
                      u32x4 uv_[8], ug_[8];
#pragma unroll
                      for (int j = 0; j < 8; ++j) { uv_[j] = *(const u32x4*)(U + (size_t)(r0 + rb + j) * F2 + col); ug_[j] = *(const u32x4*)(U + (size_t)(r0 + rb + j) * F2 + FH + col); }
#pragma unroll
                      for (int j = 0; j < 8; ++j) {
                        const int r = rb + j;
                        float v0[8], g0[8];
                        unpack8(uv_[j], v0); unpack8(ug_[j], g0);
                        float y[8];
#pragma unroll
                        for (int i = 0; i < 8; ++i) {
                            const float cv = bv[i] + wv[0][i] * v2[i] + wv[1][i] * v1[i] + wv[2][i] * v0[i];
                            const float cg_ = bg[i] + wg[0][i] * g2_[i] + wg[1][i] * g1_[i] + wg[2][i] * g0[i];
                            y[i] = cg_ * sigmoidf_(cg_) * cv;
                            v2[i] = v1[i]; v1[i] = v0[i]; g2_[i] = g1_[i]; g1_[i] = g0[i];
                        }
                        *(u32x4*)(HID + (size_t)(r0 + r) * FH + col) = pack8(y);
                      }
                    }
                }
            }
            fast_grid_barrier((unsigned*)ldp(tab, 40), tab);
            {
                BASES FFN_PTRS
                pg8::Gemm g{HID, WD, MROWS, 2048, FH, 0, 0};
                pg8::StaticOrder S; S.init(g.M, g.N, G, (int)blockIdx.x, g.K, 4);
                pg8::Epi<FRes> E{FRes{X, (float*)(RA + 272 * MiB), nullptr, nullptr}};
                pg8::gemm_phase(ldsl, g, S, E);
                fast_grid_barrier((unsigned*)ldp(tab, 40), tab);
                {
                    PHASE_IDS
                    const float* PART = (const float*)(RA + 272 * MiB); const int ntail = S.nwg - S.nFull;
                    if (S.S > 1) for (int idx = gtid; idx < ntail * 16384; idx += NT) {
                        const int tl = idx >> 14, r = (idx >> 6) & 255, c4 = idx & 63; int pm, pn; S.tile_pmpn(S.nFull + tl, pm, pn);
                        f32x4* xp = (f32x4*)(X + (size_t)(pm * 256 + r) * DM + pn * 256 + c4 * 4); f32x4 acc = *xp;
#pragma unroll
                        for (int part = 0; part < 4; ++part) acc += *(const f32x4*)(PART + (size_t)(part * 32 + tl) * 65536 + r * 256 + c4 * 4);
                        *xp = acc; }
                }
            }
            fast_grid_barrier((unsigned*)ldp(tab, 40), tab);
        }
    }
    {
        PHASE_IDS BASES
        const float* gn = IN(8);
        f32x4 ggr[8];
#pragma unroll
        for (int q = 0; q < 8; ++q) ggr[q] = *((const f32x4*)gn + lane + 64 * q);
        for (int row = gw; row < MROWS; row += NGW) {
            f32x4* xr = (f32x4*)(X + (size_t)row * DM) + lane; f32x4 x[8]; float ss = 0.f;
#pragma unroll
            for (int q = 0; q < 8; ++q) { x[q] = xr[64 * q]; ss += x[q][0] * x[q][0] + x[q][1] * x[q][1] + x[q][2] * x[q][2] + x[q][3] * x[q][3]; }
            const float rs = rsqrtf(wave_sum(ss, lane) * (1.f / DM) + 1e-6f);
#pragma unroll
            for (int q = 0; q < 8; ++q) { const f32x4 gg = ggr[q]; xr[64 * q] = x[q] * rs * gg; }
        }
    }
}

#undef TR
#undef CONVERT_WEIGHTS
extern "C" void kernel_launch(void* const* d_in, const int* in_sizes, int n_in, void* d_out, int out_size, void* d_ws, size_t ws_size, hipStream_t stream) {
    static int grid = 0;
    if (grid == 0) {
        if (n_in != 39 || (size_t)out_size != O_TOTAL || ws_size < WS_END) {
            fprintf(stderr, "kernel_launch: unexpected shapes: n_in %d out %d ws %zu (need %zu)\n", n_in, out_size, ws_size, (size_t)WS_END); grid = -1; return; }
        int dev = 0, cus = 0, per_cu = 0;
        (void)hipGetDevice(&dev);
        (void)hipDeviceGetAttribute(&cus, hipDeviceAttributeMultiprocessorCount, dev);
        if (hipFuncSetAttribute((const void*)fwd_kernel, hipFuncAttributeMaxDynamicSharedMemorySize, LDS_BYTES) != hipSuccess) { fprintf(stderr, "kernel_launch: hipFuncSetAttribute failed\n"); grid = -1; return; }
        if (hipOccupancyMaxActiveBlocksPerMultiprocessor(&per_cu, (const void*)fwd_kernel, 512, LDS_BYTES) != hipSuccess || per_cu < 1) { fprintf(stderr, "kernel_launch: occupancy query says %d\n", per_cu); per_cu = 1; }
        (void)hipGetLastError();
        grid = cus * 1;
        if (grid <= 0) grid = 256;
    }
    if (grid < 0) return;
    P prm{};
    for (int i = 0; i < 39; ++i) prm.in[i] = (const float*)d_in[i];
    prm.out = (float*)d_out; prm.ws = (unsigned char*)d_ws;
    void* args[] = {&prm};
    hipError_t e = hipLaunchCooperativeKernel((const void*)fwd_kernel, dim3(grid), dim3(512), args, LDS_BYTES, stream);
    if (e != hipSuccess) fprintf(stderr, "cooperative launch failed: %s (grid %d)\n", hipGetErrorString(e), grid);
}
```

```cpp
#include <hip/hip_runtime.h>
#include <hip/hip_cooperative_groups.h>
#include <cstdio>
#include <cstdint>
namespace cg = cooperative_groups;

#define LAS __attribute__((address_space(3)))
typedef unsigned short bf16_t;
typedef short bf16x8 __attribute__((ext_vector_type(8)));
typedef float f32x4 __attribute__((ext_vector_type(4)));
typedef float f32x16 __attribute__((ext_vector_type(16)));
typedef unsigned u32x4 __attribute__((ext_vector_type(4)));
typedef unsigned u32x2 __attribute__((ext_vector_type(2)));

constexpr int DM = 2048, MROWS = 17408, MPROMPT = 16384;
constexpr int FH = 5632, F2 = 11264;
constexpr int LDS_BYTES = 147456;
constexpr size_t MiB = 1u << 20;
constexpr size_t WS_WT = 1 * MiB;
constexpr size_t WS_A = 411 * MiB;
constexpr size_t WS_B = 819 * MiB;
constexpr size_t WS_VF = 1227 * MiB;
constexpr size_t WS_END = 1295 * MiB;
constexpr size_t ACT = (size_t)MROWS * DM;
constexpr size_t RW_SZ = (size_t)7168 * 2048 + (size_t)8192 * 256 + (size_t)2048 * 2048;
constexpr size_t GW_SZ = (size_t)6400 * 2048 + (size_t)2048 * 2048;
constexpr size_t FW_SZ = (size_t)11264 * 2048 + (size_t)2048 * 5632;
constexpr size_t GW_OFF = 2 * RW_SZ, FW_OFF = GW_OFF + 2 * GW_SZ;
constexpr size_t O_PSHIFT = 35651584, O_PWKV = 35659776, O_PGLA = 36184064, O_PCONV = 38281216;
constexpr size_t O_SSHIFT = 38461440, O_SWKV = 38526976, O_SGLA = 42721280, O_SCONV = 59498496, O_TOTAL = 60940288;

__device__ __forceinline__ unsigned cvt_pk_bf16(float lo, float hi) { unsigned r; asm volatile("v_cvt_pk_bf16_f32 %0, %1, %2" : "=v"(r) : "v"(lo), "v"(hi)); return r; }
__device__ __forceinline__ float bf2f(bf16_t b) { return __builtin_bit_cast(float, (unsigned)b << 16); }
__device__ __forceinline__ float bflo(unsigned u) { return __builtin_bit_cast(float, u << 16); }
__device__ __forceinline__ float bfhi(unsigned u) { return __builtin_bit_cast(float, u & 0xffff0000u); }
__device__ __forceinline__ void unpack8(u32x4 w, float (&f)[8]) {
    f[0] = bflo(w.x); f[1] = bfhi(w.x); f[2] = bflo(w.y); f[3] = bfhi(w.y); f[4] = bflo(w.z); f[5] = bfhi(w.z); f[6] = bflo(w.w); f[7] = bfhi(w.w);
}
__device__ __forceinline__ u32x4 pack8(const float (&f)[8]) {
    u32x4 w; w.x = cvt_pk_bf16(f[0], f[1]); w.y = cvt_pk_bf16(f[2], f[3]); w.z = cvt_pk_bf16(f[4], f[5]); w.w = cvt_pk_bf16(f[6], f[7]); return w;
}
__device__ __forceinline__ float sigmoidf_(float x) { return 1.f / (1.f + __expf(-x)); }
__device__ __forceinline__ float shx(float v, int lane, int o) { return __builtin_bit_cast(float, __builtin_amdgcn_ds_bpermute((lane ^ o) << 2, __builtin_bit_cast(int, v))); }
__device__ __forceinline__ float wave_sum(float v, int lane) {
#pragma unroll
    for (int o = 1; o < 64; o <<= 1) v += shx(v, lane, o);
    return v;
}
__device__ __forceinline__ float sum8(float v, int lane) { v += shx(v, lane, 1); v += shx(v, lane, 2); v += shx(v, lane, 4); return v; }
__device__ __forceinline__ int crow(int reg, int h) { return (reg & 3) + 8 * (reg >> 2) + 4 * h; }

namespace pg8 {
constexpr int BM = 256, BK = 64, HALF = 128, HTB = HALF * BK * 2, STAGE_BYTES = 8 * HTB, NXCD = 8, WGM = 8;
__host__ __device__ __forceinline__ int lds_byte(int r, int c) { const int st = (r >> 4) * 2 + (c >> 5), rr = r & 15, cc = c & 31, ob = rr * 64 + cc * 2; return st * 1024 + (ob ^ (((ob >> 9) & 1) << 5)); }
__host__ __device__ __forceinline__ void stage_rc(int b, int& R, int& C) { const int st = b / 1024, sb = b % 1024, swz = sb ^ (((sb >> 9) & 1) << 5); R = (st >> 1) * 16 + swz / 64; C = (st & 1) * 32 + (swz % 64) / 2; }
__host__ __device__ __forceinline__ int perm32(int rho) { const int n = rho >> 4, i = rho & 15; return 8 * (i >> 2) + 4 * n + (i & 3); }

struct Unit { int pm, pn, kofs, knt, split; };
struct Gemm { const bf16_t* A; const bf16_t* Bt; int M, N, K; int mode; size_t astride; };
__device__ __forceinline__ const char* a_of(const Gemm& g, int pn) {
    int s = 0;
    if (g.mode == 1) s = pn < 8 ? 0 : pn < 16 ? 2 : pn < 24 ? 3 : pn == 24 ? 1 : pn == 25 ? 4 : pn == 26 ? 5 : 3;
    else if (g.mode == 2) s = pn >> 3;
    return (const char*)g.A + (size_t)s * g.astride;
}
struct StaticOrder {
    int nM, nN, nwg, G, c, nFull, S, ntK, total;
    __device__ __forceinline__ void init(int M, int N, int G_, int c_, int K = 0, int S_ = 1) { nM = M / BM; nN = N / BM; nwg = nM * nN; G = G_; c = c_; ntK = K / BK;
        nFull = (nwg / G) * G; S = S_; if (S_ <= 1 || nFull == nwg) { S = 1; nFull = nwg; } total = nFull + (nwg - nFull) * S; }
    __device__ __forceinline__ bool next(int i, Unit& u) const {
        const long L = (long)i * G + c; if (L >= total) return false;
        int wgid;
        if (L < nFull) { wgid = (int)L; u.kofs = 0; u.knt = ntK; u.split = 0; }
        else { const int j = (int)L - nFull; wgid = nFull + j / S; const int part = j % S; u.knt = ntK / S; u.kofs = part * u.knt * BK; u.split = 1 + part * 32 + j / S; }
        tile_pmpn(wgid, u.pm, u.pn); return true;
    }
    __device__ __forceinline__ void tile_pmpn(int wgid, int& pm, int& pn) const {
        { const int q = nwg / NXCD, r = nwg % NXCD, xcd = wgid % NXCD, off = wgid / NXCD; wgid = (xcd < r ? xcd * (q + 1) : r * (q + 1) + (xcd - r) * q) + off; }
        const int nig = WGM * nN, gid = wgid / nig, fm = gid * WGM, gsz = (nM - fm) < WGM ? (nM - fm) : WGM;
        pm = fm + ((wgid % nig) % gsz); pn = (wgid % nig) / gsz;
    }
};

template <class F> struct Epi {
    static constexpr bool PERM = true;
    F f;
    __device__ __forceinline__ void operator()(const f32x4 (&acc)[2][2][4][2], const Unit& u, int wr, int wc, int fr, int fq) const {
        { int t_ = threadIdx.x; asm volatile("" : "+v"(t_)); const int l_ = t_ & 63, w_ = __builtin_amdgcn_readfirstlane(t_ >> 6); fr = l_ & 15; fq = l_ >> 4; wr = w_ >> 2; wc = w_ & 3; }
        const int row0 = u.pm * BM + wr * 64 + fr, col0 = u.pn * BM + wc * 32 + 8 * fq;
#pragma unroll
        for (int ai = 0; ai < 2; ++ai)
#pragma unroll
            for (int m = 0; m < 4; ++m)
#pragma unroll
                for (int bj = 0; bj < 2; ++bj) f(row0 + ai * HALF + m * 16, col0 + bj * HALF, acc[ai][bj][m][0], acc[ai][bj][m][1], u.split);
    }
};

template <class EpiT>
__device__ __forceinline__ void gemm_phase(LAS unsigned char* lds, const Gemm g, const StaticOrder& S, const EpiT& E) {
    int tid = threadIdx.x; asm volatile("" : "+v"(tid));
    const int wid = __builtin_amdgcn_readfirstlane(tid >> 6), lane = tid & 63, wr = wid >> 2, wc = wid & 3, fr = lane & 15, fq = lane >> 4;
    const int K = g.K;
    unsigned voffA[2], voffB[2];
#pragma unroll
    for (int i = 0; i < 2; ++i) { int R, C; stage_rc(tid * 16 + i * 8192, R, C); const int Rb = EpiT::PERM ? ((R & ~31) + perm32(R & 31)) : R;
        voffA[i] = (unsigned)(R * K + C) * 2u; voffB[i] = (unsigned)(Rb * K + C) * 2u; }
    const size_t kstep = (size_t)(BK * 2);
    const size_t hstep = (size_t)HALF * K * 2;
    const size_t tstep = 2 * hstep;
    const unsigned ldsw = (unsigned)wid * 1024u;
    const int aoff = lds_byte(wr * 64 + fr, fq * 8), boff = lds_byte(wc * 32 + fr, fq * 8);
#define PG8_SA(b, h) (((b) * 2 + (h)) * HTB)
#define PG8_SB(b, h) ((4 + (b) * 2 + (h)) * HTB)
#define PG8_STAGE(bufoff, gbase, voff) do { _Pragma("unroll") for (int _i = 0; _i < 2; ++_i) \
        __builtin_amdgcn_global_load_lds((const unsigned*)((const char*)(gbase) + (voff)[_i]), (LAS unsigned*)(lds + (bufoff) + ldsw + _i * 8192), 16, 0, 0); } while (0)
#define PG8_LDA(dst, b, h) do { _Pragma("unroll") for (int m = 0; m < 4; ++m) _Pragma("unroll") for (int k = 0; k < 2; ++k) dst[m][k] = *(const LAS bf16x8*)(lds + PG8_SA(b, h) + aoff + m * 2048 + k * 1024); } while (0)
#define PG8_LDB(dst, b, h) do { _Pragma("unroll") for (int n = 0; n < 2; ++n) _Pragma("unroll") for (int k = 0; k < 2; ++k) dst[n][k] = *(const LAS bf16x8*)(lds + PG8_SB(b, h) + boff + n * 2048 + k * 1024); } while (0)
#define PG8_MMA(ai, bj, At, Bt) do { __builtin_amdgcn_s_setprio(1); _Pragma("unroll") for (int m = 0; m < 4; ++m) _Pragma("unroll") for (int n = 0; n < 2; ++n) _Pragma("unroll") for (int k = 0; k < 2; ++k) \
        acc[ai][bj][m][n] = __builtin_amdgcn_mfma_f32_16x16x32_bf16(Bt[n][k], At[m][k], acc[ai][bj][m][n], 0, 0, 0); __builtin_amdgcn_s_setprio(0); } while (0)
#define PG8_WAIT_V(n) asm volatile("s_waitcnt vmcnt(" #n ")" ::: "memory")
#define PG8_WAIT_L(n) asm volatile("s_waitcnt lgkmcnt(" #n ")" ::: "memory")
#define PG8_BAR __builtin_amdgcn_s_barrier()
#define PG8_SCHED __builtin_amdgcn_sched_barrier(0)
    Unit cur, nxt; int ui = 0;
    if (!S.next(0, cur)) return;
    f32x4 acc[2][2][4][2];
#pragma unroll
    for (int a = 0; a < 2; ++a)
#pragma unroll
        for (int b = 0; b < 2; ++b)
#pragma unroll
            for (int m = 0; m < 4; ++m)
#pragma unroll
                for (int n = 0; n < 2; ++n) acc[a][b][m][n] = (f32x4){0.f, 0.f, 0.f, 0.f};
    bf16x8 At[4][2], B0[2][2], B1[2][2];
    const char* cA = a_of(g, cur.pn) + (size_t)cur.pm * tstep + (size_t)cur.kofs * 2; const char* cB = (const char*)g.Bt + (size_t)cur.pn * tstep + (size_t)cur.kofs * 2;
    PG8_STAGE(PG8_SB(0, 0), cB, voffB); PG8_STAGE(PG8_SB(0, 1), cB + hstep, voffB); PG8_STAGE(PG8_SA(0, 0), cA, voffA); PG8_STAGE(PG8_SA(0, 1), cA + hstep, voffA);
    if (wr == 1) PG8_BAR;
    PG8_WAIT_V(2); PG8_BAR;
    PG8_STAGE(PG8_SB(1, 0), cB + kstep, voffB); PG8_STAGE(PG8_SA(1, 0), cA + kstep, voffA); PG8_STAGE(PG8_SB(1, 1), cB + hstep + kstep, voffB);
    PG8_WAIT_V(6); PG8_BAR;
    for (;;) {
        const bool has_next = S.next(ui + 1, nxt);
        const char* nA = has_next ? a_of(g, nxt.pn) + (size_t)nxt.pm * tstep + (size_t)nxt.kofs * 2 : cA; const char* nB = has_next ? (const char*)g.Bt + (size_t)nxt.pn * tstep + (size_t)nxt.kofs * 2 : cB;
        const int nt = cur.knt;
        for (int t = 0; t < nt; t += 2) {
            const bool last = (t == nt - 2);
            const char* a1 = cA + (size_t)(t + 1) * kstep;
            const char* a2 = last ? nA : cA + (size_t)(t + 2) * kstep; const char* b2 = last ? nB : cB + (size_t)(t + 2) * kstep;
            const char* a3 = a2 + kstep; const char* b3 = b2 + kstep;
            PG8_LDB(B0, 0, 0); PG8_LDB(B1, 0, 1); PG8_SCHED; PG8_LDA(At, 0, 0); PG8_STAGE(PG8_SA(1, 1), a1 + hstep, voffA);
            PG8_WAIT_V(8); PG8_WAIT_L(0); PG8_BAR; PG8_MMA(0, 0, At, B0); PG8_MMA(0, 1, At, B1); PG8_BAR; PG8_SCHED;
            PG8_LDA(At, 0, 1); PG8_STAGE(PG8_SB(0, 0), b2, voffB); PG8_STAGE(PG8_SB(0, 1), b2 + hstep, voffB); PG8_STAGE(PG8_SA(0, 0), a2, voffA);
            PG8_WAIT_V(8); PG8_WAIT_L(0); PG8_BAR; PG8_MMA(1, 0, At, B0); PG8_MMA(1, 1, At, B1); PG8_BAR; PG8_SCHED;
            PG8_LDB(B0, 1, 0); PG8_LDB(B1, 1, 1); PG8_SCHED; PG8_LDA(At, 1, 0); PG8_STAGE(PG8_SA(0, 1), a2 + hstep, voffA);
            PG8_WAIT_V(8); PG8_WAIT_L(0); PG8_BAR; PG8_MMA(0, 0, At, B0); PG8_MMA(0, 1, At, B1); PG8_BAR; PG8_SCHED;
            PG8_LDA(At, 1, 1); PG8_STAGE(PG8_SB(1, 0), b3, voffB); PG8_STAGE(PG8_SB(1, 1), b3 + hstep, voffB); PG8_STAGE(PG8_SA(1, 0), a3, voffA);
            PG8_WAIT_V(8); PG8_WAIT_L(0); PG8_BAR; PG8_MMA(1, 0, At, B0); PG8_MMA(1, 1, At, B1); PG8_BAR; PG8_SCHED;
        }
        if (wr == 0) PG8_BAR;
        E(acc, cur, wr, wc, fr, fq);
        if (!has_next) break;
#pragma unroll
        for (int a = 0; a < 2; ++a)
#pragma unroll
            for (int b = 0; b < 2; ++b)
#pragma unroll
                for (int m = 0; m < 4; ++m)
#pragma unroll
                    for (int n = 0; n < 2; ++n) acc[a][b][m][n] = (f32x4){0.f, 0.f, 0.f, 0.f};
        cur = nxt; cA = nA; cB = nB; ++ui;
        if (wr == 1) PG8_BAR;
    }
    PG8_WAIT_V(0);
    PG8_BAR;
#undef PG8_SA
#undef PG8_SB
#undef PG8_STAGE
#undef PG8_LDA
#undef PG8_LDB
#undef PG8_MMA
#undef PG8_WAIT_V
#undef PG8_WAIT_L
#undef PG8_BAR
#undef PG8_SCHED
}
}

__device__ __forceinline__ void store8bf(bf16_t* p, f32x4 a, f32x4 b) {
    u32x4 w; w.x = cvt_pk_bf16(a[0], a[1]); w.y = cvt_pk_bf16(a[2], a[3]); w.z = cvt_pk_bf16(b[0], b[1]); w.w = cvt_pk_bf16(b[2], b[3]);
    *(u32x4*)p = w;
}
__device__ __forceinline__ const float* xin_row(const float* xp, const float* xs, int row) { return row < MPROMPT ? xp + (size_t)row * DM : xs + (size_t)(row - MPROMPT) * DM; }
struct FRes { float* X; float* PART; const float* xin_p; const float* xin_s;
    __device__ __forceinline__ void operator()(int row, int col, f32x4 a, f32x4 b, int split) const {
        float* p = X + (size_t)row * DM + col;
        if (split) { float* q = PART + (size_t)(split - 1) * 65536 + (row & 255) * 256 + (col & 255); *(f32x4*)q = a; *(f32x4*)(q + 4) = b; }
        else { const float* bp = xin_p ? xin_row(xin_p, xin_s, row) + col : p; f32x4 x0 = *(const f32x4*)bp, x1 = *(const f32x4*)(bp + 4); *(f32x4*)p = x0 + a; *(f32x4*)(p + 4) = x1 + b; } } };
struct FR1 { bf16_t *R, *K, *V, *L;
    __device__ __forceinline__ void operator()(int row, int col, f32x4 a, f32x4 b, int) const {
        if (col < 6144) { const int g = col >> 11; const size_t o = (size_t)row * DM + (col & 2047); if (g == 0) store8bf(R + o, a, b); else if (g == 1) store8bf(K + o, a, b); else store8bf(V + o, a, b); }
        else { const int t = (col - 6144) >> 8, c = col & 255;
            if (t == 0) { for (int i = 0; i < 4; ++i) { a[i] = 1.f - 2.f / (1.f + __expf(2.f * a[i])); b[i] = 1.f - 2.f / (1.f + __expf(2.f * b[i])); } }
            else if (t == 2) { for (int i = 0; i < 4; ++i) { a[i] = sigmoidf_(a[i]); b[i] = sigmoidf_(b[i]); } }
            store8bf(L + (size_t)t * MROWS * 256 + (size_t)row * 256 + c, a, b); } } };
__device__ __forceinline__ float decay_of(float z) { return -0.60653065971f / (1.f + __expf(-z)); }
struct FR2 { float* DD; bf16_t *AA, *GG, *VG; const float *w0, *a0, *v0;
    __device__ __forceinline__ void operator()(int row, int col, f32x4 a, f32x4 b, int) const {
        const int g = col >> 11, c = col & 2047; const size_t off = (size_t)row * DM + c;
        if (g == 0) { f32x4 z0 = *(const f32x4*)(w0 + c), z1 = *(const f32x4*)(w0 + c + 4); a += z0; b += z1;
            for (int i = 0; i < 4; ++i) { a[i] = decay_of(a[i]); b[i] = decay_of(b[i]); }
            *(f32x4*)(DD + off) = a; *(f32x4*)(DD + off + 4) = b; }
        else if (g == 1) { f32x4 z0 = *(const f32x4*)(a0 + c), z1 = *(const f32x4*)(a0 + c + 4); a += z0; b += z1;
            for (int i = 0; i < 4; ++i) { a[i] = sigmoidf_(a[i]); b[i] = sigmoidf_(b[i]); } store8bf(AA + off, a, b); }
        else if (g == 2) { store8bf(GG + off, a, b); }
        else { f32x4 z0 = *(const f32x4*)(v0 + c), z1 = *(const f32x4*)(v0 + c + 4); a += z0; b += z1;
            for (int i = 0; i < 4; ++i) { a[i] = sigmoidf_(a[i]); b[i] = sigmoidf_(b[i]); } store8bf(VG + off, a, b); } } };
struct FG1 { bf16_t* PROJ; float* LR;
    __device__ __forceinline__ void operator()(int row, int col, f32x4 a, f32x4 b, int) const {
        if (col < 6144) { if (col < 1024) { a *= 0.0625f; b *= 0.0625f; } store8bf(PROJ + (size_t)row * 6144 + col, a, b); }
        else if (col < 6160) { float* p = LR + (size_t)row * 16 + (col - 6144); *(f32x4*)p = a; *(f32x4*)(p + 4) = b; } } };
struct FUp { bf16_t* U; float* pconv; float* sconv;
    __device__ __forceinline__ void operator()(int row, int col, f32x4 a, f32x4 b, int) const {
        store8bf(U + (size_t)row * F2 + col, a, b);
        if (row < MPROMPT) { const int t = row & 8191; if (t >= 8190) { float* p = pconv + ((size_t)((row >> 13) * 2 + (t - 8190))) * F2 + col; *(f32x4*)p = a; *(f32x4*)(p + 4) = b; } }
        else { const int rr = row - MPROMPT, t = rr & 63; if (t >= 62) { float* p = sconv + ((size_t)((rr >> 6) * 2 + (t - 62))) * F2 + col; *(f32x4*)p = a; *(f32x4*)(p + 4) = b; } } } };

__device__ __forceinline__ void tr_item(const float* W, int K, int N, bf16_t* WT, int Kpad, int Npad, float* scr, int item, int lane) {
    const int nblk = Npad / 64, kb = item / nblk, nb = item % nblk, k0 = 64 * kb, n0 = 64 * nb;
    const int n4 = n0 + (lane & 15) * 4;
    f32x4 v[16];
#pragma unroll
    for (int i = 0; i < 16; ++i) { const int k = k0 + 4 * i + (lane >> 4); v[i] = (k < K && n4 < N) ? *(const f32x4*)(W + (size_t)k * N + n4) : (f32x4){0.f, 0.f, 0.f, 0.f}; }
#pragma unroll
    for (int i = 0; i < 16; ++i) { float* d = scr + (4 * i + (lane >> 4)) * 65 + (lane & 15) * 4; d[0] = v[i][0]; d[1] = v[i][1]; d[2] = v[i][2]; d[3] = v[i][3]; }
    asm volatile("s_waitcnt lgkmcnt(0)" ::: "memory");
    const int c = lane & 7;
#pragma unroll
    for (int j = 0; j < 8; ++j) { const int nn = (lane >> 3) + 8 * j; const float* s = scr + (8 * c) * 65 + nn;
        u32x4 o; o.x = cvt_pk_bf16(s[0 * 65], s[1 * 65]); o.y = cvt_pk_bf16(s[2 * 65], s[3 * 65]); o.z = cvt_pk_bf16(s[4 * 65], s[5 * 65]); o.w = cvt_pk_bf16(s[6 * 65], s[7 * 65]);
        *(u32x4*)(WT + (size_t)(n0 + nn) * Kpad + k0 + 8 * c) = o; }
    asm volatile("s_waitcnt lgkmcnt(0)" ::: "memory");
}

struct P { const float* in[39]; float* out; unsigned char* ws; };

__device__ __forceinline__ void row_info(int row, int& t, int& len, int& b, bool& prompt) {
    if (row < MPROMPT) { prompt = true; b = row >> 13; t = row & 8191; len = 8192; }
    else { prompt = false; const int rr = row - MPROMPT; b = rr >> 6; t = rr & 63; len = 64; }
}

__device__ __forceinline__ const float* ldp(const unsigned long long* tab, int i) {
    const unsigned long long v = tab[i];
    const unsigned lo = __builtin_amdgcn_readfirstlane((unsigned)v), hi = __builtin_amdgcn_readfirstlane((unsigned)(v >> 32));
    const __attribute__((address_space(1))) float* g = (const __attribute__((address_space(1))) float*)(((unsigned long long)hi << 32) | lo);
    return (const float*)g;
}
__device__ __forceinline__ void fast_grid_barrier(unsigned* bar, unsigned long long* tab) {
    asm volatile("s_waitcnt vmcnt(0)" ::: "memory");
    __syncthreads();
    if (threadIdx.x == 0) {
        const unsigned G = gridDim.x, grp = blockIdx.x & 7u;
        const unsigned epoch = (unsigned)tab[41] + 1u; tab[41] = epoch;
        const unsigned ngrp = (G - grp + 7u) >> 3, ntop = G < 8u ? G : 8u;
        __builtin_amdgcn_fence(__ATOMIC_RELEASE, "agent");
        asm volatile("s_waitcnt vmcnt(0)" ::: "memory");
        const unsigned old = __hip_atomic_fetch_add(&bar[64u * (1u + grp)], 1u, __ATOMIC_RELAXED, __HIP_MEMORY_SCOPE_AGENT);
        if (old + 1u == epoch * ngrp) (void)__hip_atomic_fetch_add(&bar[0], 1u, __ATOMIC_RELAXED, __HIP_MEMORY_SCOPE_AGENT);
        while (__hip_atomic_load(&bar[0], __ATOMIC_RELAXED, __HIP_MEMORY_SCOPE_AGENT) < epoch * ntop) __builtin_amdgcn_s_sleep(1);
        __builtin_amdgcn_fence(__ATOMIC_ACQUIRE, "agent");
        asm volatile("s_waitcnt vmcnt(0)" ::: "memory");
    }
    __syncthreads();
}
#define IN(k) ldp(tab, (k))
#define OUTP ((float*)ldp(tab, 39))
#define BASES float* X = (float*)ldp(tab, 39); unsigned char* ws_ = (unsigned char*)ldp(tab, 40); bf16_t* WT = (bf16_t*)(ws_ + WS_WT); unsigned char* RA = ws_ + WS_A; unsigned char* RB = ws_ + WS_B; \
    bf16_t* VFIRST = (bf16_t*)(ws_ + WS_VF); LAS unsigned char* ldsl = (LAS unsigned char*)lds; (void)X; (void)WT; (void)RA; (void)RB; (void)VFIRST; (void)ldsl;
#define RWKV_PTRS bf16_t* HB = (bf16_t*)RA; bf16_t* Rb = (bf16_t*)RB; bf16_t* Kb = Rb + ACT; bf16_t* Vb = (jl == 0) ? VFIRST : Kb + ACT; bf16_t* Lb = (bf16_t*)(RB + 204 * MiB); \
    float* DD = (float*)(RB + 240 * MiB); bf16_t* AA = (bf16_t*)RA; bf16_t* VG = AA + ACT; bf16_t* GG = VG + ACT; bf16_t* Y = GG + ACT; \
    bf16_t* W1 = WT + jl * RW_SZ; bf16_t* W2 = W1 + (size_t)7168 * 2048; bf16_t* WO = W2 + (size_t)8192 * 256; \
    (void)HB; (void)Rb; (void)Kb; (void)Vb; (void)Lb; (void)DD; (void)AA; (void)VG; (void)GG; (void)Y; (void)W1; (void)W2; (void)WO;
#define GLA_PTRS bf16_t* H = (bf16_t*)RB; float* LR = (float*)(RB + 68 * MiB); float* O = (float*)(RB + 70 * MiB); bf16_t* Y = (bf16_t*)(RB + 206 * MiB); \
    bf16_t* PROJ = (bf16_t*)RA; bf16_t* QE = (bf16_t*)(RA + 204 * MiB); bf16_t* KDT = (bf16_t*)(RA + 238 * MiB); bf16_t* VT = (bf16_t*)(RA + 272 * MiB); \
    bf16_t* SC = (bf16_t*)(RA + 340 * MiB); float* EL = (float*)(RA + 349 * MiB); bf16_t* GI = WT + GW_OFF + jl * GW_SZ; bf16_t* GO = GI + (size_t)6400 * 2048; \
    (void)H; (void)LR; (void)O; (void)Y; (void)PROJ; (void)QE; (void)KDT; (void)VT; (void)SC; (void)EL; (void)GI; (void)GO;
#define FFN_PTRS bf16_t* H = (bf16_t*)RB; bf16_t* HID = (bf16_t*)(RB + 68 * MiB); bf16_t* U = (bf16_t*)RA; bf16_t* WU = WT + FW_OFF + layer * FW_SZ; bf16_t* WD = WU + (size_t)F2 * 2048; \
    (void)H; (void)HID; (void)U; (void)WU; (void)WD;

__global__ void __launch_bounds__(512, 2) fwd_kernel(P p) {
    extern __shared__ __attribute__((aligned(16))) unsigned char lds[];
    cg::grid_group grid = cg::this_grid();
    const int G = gridDim.x, NGW = G * 8, NT = G * 512;
#define PHASE_IDS int tid = threadIdx.x; asm volatile("" : "+v"(tid)); const int lane = tid & 63; const int wave = __builtin_amdgcn_readfirstlane(tid >> 6); const int gw = blockIdx.x * 8 + wave; const int gtid = blockIdx.x * 512 + tid; (void)lane; (void)gw; (void)gtid;
    unsigned long long* tab = (unsigned long long*)(lds + LDS_BYTES - 512);
    if (threadIdx.x == 0) {
#pragma unroll
        for (int i = 0; i < 39; ++i) tab[i] = (unsigned long long)p.in[i];
        tab[39] = (unsigned long long)p.out; tab[40] = (unsigned long long)p.ws; tab[41] = 0ull;
    }
    __syncthreads();

    {
        PHASE_IDS BASES
        if (blockIdx.x == 0) { for (int i = tid; i < 1024; i += 512) ((unsigned*)ws_)[i] = 0u; }
        float* scr = (float*)(lds + wave * 16896);
#define TR(src, K, N, dst, Kpad, Npad) do { const int _ni = ((Kpad) / 64) * ((Npad) / 64); for (int it = cgw_; it < _ni; it += cngw_) tr_item((src), (K), (N), (dst), (Kpad), (Npad), scr, it, lane); } while (0)
#define CONVERT_WEIGHTS(JLO, JHI, ILO, IHI, GWV, NGWV) do { const int cgw_ = (GWV), cngw_ = (NGWV); \
        _Pragma("unroll 1") for (int j = (JLO); j < (JHI); ++j) { \
            bf16_t* W1 = WT + j * RW_SZ; bf16_t* W2 = W1 + (size_t)7168 * 2048; bf16_t* WO = W2 + (size_t)8192 * 256; \
            TR(IN(24) + (size_t)j * DM * DM, 2048, 2048, W1, 2048, 2048); \
            TR(IN(25) + (size_t)j * DM * DM, 2048, 2048, W1 + (size_t)2048 * 2048, 2048, 2048); \
            TR(IN(26) + (size_t)j * DM * DM, 2048, 2048, W1 + (size_t)4096 * 2048, 2048, 2048); \
            TR(IN(11) + (size_t)j * DM * 96, 2048, 96, W1 + (size_t)6144 * 2048, 2048, 256); \
            TR(IN(14) + (size_t)j * DM * 96, 2048, 96, W1 + (size_t)6400 * 2048, 2048, 256); \
            TR(IN(19) + (size_t)j * DM * 256, 2048, 256, W1 + (size_t)6656 * 2048, 2048, 256); \
            if (j >= 1) TR(IN(17) + (size_t)(j - 1) * DM * 64, 2048, 64, W1 + (size_t)6912 * 2048, 2048, 256); \
            TR(IN(12) + (size_t)j * 96 * DM, 96, 2048, W2, 256, 2048); \
            TR(IN(15) + (size_t)j * 96 * DM, 96, 2048, W2 + (size_t)2048 * 256, 256, 2048); \
            TR(IN(20) + (size_t)j * 256 * DM, 256, 2048, W2 + (size_t)4096 * 256, 256, 2048); \
            if (j >= 1) TR(IN(18) + (size_t)(j - 1) * 64 * DM, 64, 2048, W2 + (size_t)6144 * 256, 256, 2048); \
            TR(IN(27) + (size_t)j * DM * DM, 2048, 2048, WO, 2048, 2048); \
            bf16_t* GI = WT + GW_OFF + j * GW_SZ; bf16_t* GO = GI + (size_t)6400 * 2048; \
            TR(IN(30) + (size_t)j * DM * 6160, 2048, 6160, GI, 2048, 6400); \
            TR(IN(34) + (size_t)j * DM * DM, 2048, 2048, GO, 2048, 2048); \
        } \
        _Pragma("unroll 1") for (int i = (ILO); i < (IHI); ++i) { \
            bf16_t* WU = WT + FW_OFF + i * FW_SZ; bf16_t* WD = WU + (size_t)F2 * 2048; \
            TR(IN(35) + (size_t)i * DM * F2, 2048, F2, WU, 2048, F2); \
            TR(IN(38) + (size_t)i * FH * DM, FH, 2048, WD, FH, 2048); \
        } } while (0)
        if (G >= 256) CONVERT_WEIGHTS(0, 1, 0, 2, gw, NGW); else CONVERT_WEIGHTS(0, 2, 0, 4, gw, NGW);
    }
    grid.sync();

#pragma clang loop unroll(full)
    for (int layer = 0; layer < 4; ++layer) {
        const int jl = layer >> 1;
        if ((layer & 1) == 0) {
            {
                PHASE_IDS BASES RWKV_PTRS
                const float* gmix = IN(6) + (size_t)layer * DM;
                const float* mix = IN(9) + (size_t)jl * 6 * DM;
                const float* sst = IN(2) + (size_t)jl * 16 * DM;
                const float* xin0 = IN(0); const float* xin1 = IN(1);
                float* mixS = (float*)lds; float* gS = mixS + 6 * DM;
                for (int i = tid; i < 6 * DM / 4; i += 512) *(f32x4*)(mixS + i * 4) = *(const f32x4*)(mix + i * 4);
                for (int i = tid; i < DM / 4; i += 512) *(f32x4*)(gS + i * 4) = *(const f32x4*)(gmix + i * 4);
                __syncthreads();
                for (int row = gw; row < MROWS; row += NGW) {
                    int t, len, b; bool prompt; row_info(row, t, len, b, prompt);
                    const f32x4* xr = (const f32x4*)(layer == 0 ? xin_row(xin0, xin1, row) : X + (size_t)row * DM) + lane;
                    f32x4 x[8]; float ss = 0.f;
#pragma unroll
                    for (int q = 0; q < 8; ++q) { x[q] = xr[64 * q]; ss += x[q][0] * x[q][0] + x[q][1] * x[q][1] + x[q][2] * x[q][2] + x[q][3] * x[q][3]; }
                    const float rs = rsqrtf(wave_sum(ss, lane) * (1.f / DM) + 1e-6f);
                    f32x4 hp[8];
                    if (t > 0) {
                        const f32x4* xq = (const f32x4*)(layer == 0 ? xin_row(xin0, xin1, row - 1) : X + (size_t)(row - 1) * DM) + lane; float s2 = 0.f;
#pragma unroll
                        for (int q = 0; q < 8; ++q) { hp[q] = xq[64 * q]; s2 += hp[q][0] * hp[q][0] + hp[q][1] * hp[q][1] + hp[q][2] * hp[q][2] + hp[q][3] * hp[q][3]; }
                        const float rp = rsqrtf(wave_sum(s2, lane) * (1.f / DM) + 1e-6f);
#pragma unroll
                        for (int q = 0; q < 8; ++q) { const f32x4 gg = *((const f32x4*)gS + lane + 64 * q); hp[q] = hp[q] * rp * gg; }
                    } else if (!prompt) {
#pragma unroll
                        for (int q = 0; q < 8; ++q) hp[q] = *((const f32x4*)(sst + (size_t)b * DM) + lane + 64 * q);
                    } else {
#pragma unroll
                        for (int q = 0; q < 8; ++q) hp[q] = (f32x4){0.f, 0.f, 0.f, 0.f};
                    }
                    const bool lastrow = (t == len - 1);
                    float* shout = OUTP + (prompt ? O_PSHIFT + ((size_t)jl * 2 + b) * DM : O_SSHIFT + ((size_t)jl * 16 + b) * DM);
#pragma unroll
                    for (int q = 0; q < 8; ++q) {
                        const f32x4 gg = *((const f32x4*)gS + lane + 64 * q);
                        const f32x4 h = x[q] * rs * gg; const f32x4 dlt = hp[q] - h;
                        if (lastrow) *((f32x4*)shout + lane + 64 * q) = h;
#pragma unroll
                        for (int m = 0; m < 6; ++m) {
                            const f32x4 mx = *((const f32x4*)(mixS + m * DM) + lane + 64 * q);
                            const f32x4 o = h + dlt * mx;
                            u32x2 w; w.x = cvt_pk_bf16(o[0], o[1]); w.y = cvt_pk_bf16(o[2], o[3]);
                            *((u32x2*)(HB + (size_t)m * ACT + (size_t)row * DM) + lane + 64 * q) = w;
                        }
                    }
                }
            }
            fast_grid_barrier((unsigned*)ldp(tab, 40), tab);
            {
                BASES RWKV_PTRS
                pg8::Gemm g{HB, W1, MROWS, jl == 0 ? 6912 : 7168, 2048, 1, ACT * 2};
                pg8::StaticOrder S; S.init(g.M, g.N, G, (int)blockIdx.x, g.K, 1);
                pg8::Epi<FR1> E{FR1{Rb, Kb, Vb, Lb}};
                pg8::gemm_phase(ldsl, g, S, E);
            }
            fast_grid_barrier((unsigned*)ldp(tab, 40), tab);
            {
                BASES RWKV_PTRS
                pg8::Gemm g{Lb, W2, MROWS, jl == 0 ? 6144 : 8192, 256, 2, (size_t)MROWS * 256 * 2};
                pg8::StaticOrder S; S.init(g.M, g.N, G, (int)blockIdx.x, g.K, 1);
                pg8::Epi<FR2> E{FR2{DD, AA, GG, VG, IN(10) + (size_t)jl * DM, IN(13) + (size_t)jl * DM, IN(16) + (size_t)(jl > 0 ? jl - 1 : 0) * DM}};
                pg8::gemm_phase(ldsl, g, S, E);
            }
            fast_grid_barrier((unsigned*)ldp(tab, 40), tab);
            {
                PHASE_IDS BASES RWKV_PTRS
                float* Obuf = (float*)(RA + 272 * MiB); float* RK = (float*)(RB + 204 * MiB); float* DTg = (float*)(RB + 208 * MiB);
                const float* k_k = IN(21) + (size_t)jl * DM; const float* k_a = IN(22) + (size_t)jl * DM; const float* r_k = IN(23) + (size_t)jl * DM;
                const int l32 = lane & 31, hl = lane >> 5;
#define S1_BAR do { asm volatile("s_waitcnt lgkmcnt(0)" ::: "memory"); __builtin_amdgcn_s_barrier(); asm volatile("" ::: "memory"); } while (0)
                const int st = tid >> 3, c0 = (tid & 7) * 8;
                u32x4 pr_, pk_, pv_, pa_, pvf_ = (u32x4){0u, 0u, 0u, 0u}, pvg_ = (u32x4){0u, 0u, 0u, 0u}; f32x4 pd0_, pd1_;
#define S1_FETCH(it) do { const size_t _off = (size_t)(((it) >> 5) * 64 + st) * DM + ((it) & 31) * 64 + c0; \
                    pr_ = *(const u32x4*)(Rb + _off); pk_ = *(const u32x4*)(Kb + _off); pv_ = *(const u32x4*)(Vb + _off); pa_ = *(const u32x4*)(AA + _off); \
                    pd0_ = *(const f32x4*)(DD + _off); pd1_ = *(const f32x4*)(DD + _off + 4); \
                    if (jl > 0) { pvf_ = *(const u32x4*)(VFIRST + _off); pvg_ = *(const u32x4*)(VG + _off); } } while (0)
                if ((int)blockIdx.x < 8704) S1_FETCH((int)blockIdx.x);
#pragma unroll 1
                for (int item = blockIdx.x; item < 8704; item += G) {
                    LAS unsigned char* ldsv = (LAS unsigned char*)lds; asm volatile("" : "+v"(ldsv));
                    LAS bf16_t* AH = (LAS bf16_t*)(ldsv + 0); LAS bf16_t* RH = (LAS bf16_t*)(ldsv + 9216); LAS bf16_t* BH = (LAS bf16_t*)(ldsv + 18432); LAS bf16_t* KH = (LAS bf16_t*)(ldsv + 27648);
                    LAS bf16_t* BHT = (LAS bf16_t*)(ldsv + 36864); LAS bf16_t* KHT = (LAS bf16_t*)(ldsv + 46080); LAS bf16_t* VTs = (LAS bf16_t*)(ldsv + 55296); LAS bf16_t* XT = (LAS bf16_t*)(ldsv + 64512);
                    LAS float* AAB = (LAS float*)(ldsv + 82944); LAS bf16_t* AAK = (LAS bf16_t*)(ldsv + 99328); LAS bf16_t* ARB = (LAS bf16_t*)(ldsv + 108544); LAS bf16_t* ARK = (LAS bf16_t*)(ldsv + 117760);
                    LAS float* LB = (LAS float*)(ldsv + 126976); LAS float* DTS = (LAS float*)(ldsv + 143360);
                    (void)RH; (void)KH; (void)KHT;
                    const int chunk = item >> 5, h = item & 31, r0 = chunk * 64;
                    const int col = h * 64 + c0;
                    float r[8], kk[8], bb[8], km[8], ld[8];
                    {
                        float k[8], v[8], a[8];
                        unpack8(pr_, r); unpack8(pk_, k); unpack8(pv_, v); unpack8(pa_, a);
                        const f32x4 d0 = pd0_, d1 = pd1_;
                        ld[0] = d0[0]; ld[1] = d0[1]; ld[2] = d0[2]; ld[3] = d0[3]; ld[4] = d1[0]; ld[5] = d1[1]; ld[6] = d1[2]; ld[7] = d1[3];
                        if (jl > 0) { float vf[8], vg[8]; unpack8(pvf_, vf); unpack8(pvg_, vg);
#pragma unroll
                            for (int i = 0; i < 8; ++i) v[i] = v[i] + (vf[i] - v[i]) * vg[i]; }
                        float ss = 0.f;
#pragma unroll
                        for (int i = 0; i < 8; ++i) { kk[i] = k[i] * k_k[col + i]; ss += kk[i] * kk[i]; }
                        ss = sum8(ss, lane);
                        const float inv = 1.f / fmaxf(sqrtf(ss), 1e-12f);
                        float rk = 0.f;
#pragma unroll
                        for (int i = 0; i < 8; ++i) { kk[i] *= inv; bb[i] = kk[i] * a[i]; km[i] = k[i] * (1.f + (a[i] - 1.f) * k_a[col + i]); rk += r[i] * km[i] * r_k[col + i]; }
                        rk = sum8(rk, lane);
                        if ((tid & 7) == 0) RK[(size_t)(r0 + st) * 32 + h] = rk;
                        *(LAS f32x4*)(LB + st * 64 + c0) = d0; *(LAS f32x4*)(LB + st * 64 + c0 + 4) = d1;
#pragma unroll
                        for (int i = 0; i < 8; i += 2) { const unsigned pk = cvt_pk_bf16(v[i], v[i + 1]); VTs[(c0 + i) * 72 + st] = (bf16_t)(pk & 0xffffu); VTs[(c0 + i + 1) * 72 + st] = (bf16_t)(pk >> 16); }
                    }
                    S1_BAR;
                    {
                        const int cc_ = tid & 63, tq_ = tid >> 6; float pf[8]; float run = 0.f;
#pragma unroll
                        for (int j = 0; j < 8; ++j) { run += LB[(8 * tq_ + j) * 64 + cc_]; pf[j] = run; }
                        AAB[tq_ * 64 + cc_] = run;
                        S1_BAR;
                        float ofs = 0.f;
#pragma unroll
                        for (int g = 0; g < 7; ++g) ofs += (g < tq_) ? AAB[g * 64 + cc_] : 0.f;
#pragma unroll
                        for (int j = 0; j < 8; ++j) LB[(8 * tq_ + j) * 64 + cc_] = pf[j] + ofs;
                    }
                    S1_BAR;
                    {
                        float ah[8], bh[8], kh[8], rh[8];
#pragma unroll
                        for (int i = 0; i < 8; ++i) { const float Lt = LB[st * 64 + c0 + i]; const float e3 = __expf(Lt), e2 = __expf(-Lt), e1 = __expf(Lt - ld[i]);
                            ah[i] = -kk[i] * e1; bh[i] = bb[i] * e2; kh[i] = km[i] * e2; rh[i] = r[i] * e3;
                            if (st == 63) { DTS[c0 + i] = e3; DTg[(size_t)item * 64 + c0 + i] = e3; } }
                        *(LAS u32x4*)(AH + st * 72 + c0) = pack8(ah); *(LAS u32x4*)(RH + st * 72 + c0) = pack8(rh);
                        *(LAS u32x4*)(BH + st * 72 + c0) = pack8(bh); *(LAS u32x4*)(KH + st * 72 + c0) = pack8(kh);
#pragma unroll
                        for (int i = 0; i < 8; i += 2) { const unsigned p1 = cvt_pk_bf16(bh[i], bh[i + 1]), p2 = cvt_pk_bf16(kh[i], kh[i + 1]);
                            BHT[(c0 + i) * 72 + st] = (bf16_t)(p1 & 0xffffu); BHT[(c0 + i + 1) * 72 + st] = (bf16_t)(p1 >> 16);
                            KHT[(c0 + i) * 72 + st] = (bf16_t)(p2 & 0xffffu); KHT[(c0 + i + 1) * 72 + st] = (bf16_t)(p2 >> 16); }
                    }
                    S1_BAR;
                    {
                        const int mi = wave & 3, rowsel = mi >> 1, tt = mi & 1;
#pragma unroll
                        for (int nn = 0; nn < 2; ++nn) {
                            const int colsel = wave >> 2, stl = nn; const int ni = 2 * colsel + nn;
                            f32x16 acc;
#pragma unroll
                            for (int i = 0; i < 16; ++i) acc[i] = 0.f;
                            if (stl <= tt) {
#pragma unroll
                                for (int ks = 0; ks < 4; ++ks) {
                                    const bf16x8 a = *(const LAS bf16x8*)(AH + (mi * 32 + l32) * 72 + ks * 16 + hl * 8);
                                    const bf16x8 b = *(const LAS bf16x8*)(BH + (ni * 32 + l32) * 72 + ks * 16 + hl * 8);
                                    acc = __builtin_amdgcn_mfma_f32_32x32x16_bf16(a, b, acc, 0, 0, 0);
                                }
                            }
#pragma unroll
                            for (int i = 0; i < 16; ++i) {
                                const int t = tt * 32 + crow(i, hl), s = stl * 32 + l32;
                                const bool keep = rowsel ? (s <= t) : (s < t);
                                const float val = keep ? acc[i] : 0.f;
                                if (rowsel == 0 && colsel == 0) AAB[t * 64 + s] = val;
                                else { LAS bf16_t* dst = (rowsel == 0) ? AAK : (colsel == 0 ? ARB : ARK); dst[t * 72 + s] = (bf16_t)(cvt_pk_bf16(val, 0.f) & 0xffffu); }
                            }
                        }
                    }
                    S1_BAR;
                    if (wave < 4) {
                        const int mt = wave >> 1, nt = wave & 1;
                        f32x16 acc;
#pragma unroll
                        for (int i = 0; i < 16; ++i) acc[i] = 0.f;
#pragma unroll
                        for (int ks = 0; ks < 4; ++ks) {
                            const bf16x8 a = *(const LAS bf16x8*)(AAK + (mt * 32 + l32) * 72 + ks * 16 + hl * 8);
                            const bf16x8 b = *(const LAS bf16x8*)(VTs + (nt * 32 + l32) * 72 + ks * 16 + hl * 8);
                            acc = __builtin_amdgcn_mfma_f32_32x32x16_bf16(a, b, acc, 0, 0, 0);
                        }
#pragma unroll
                        for (int i = 0; i < 16; ++i) LB[(mt * 32 + crow(i, hl)) * 64 + nt * 32 + l32] = acc[i];
                    }
                    S1_BAR;
                    {
                        const int colx = tid >> 2, par = tid & 3;
                        float Xp[4][4];
#pragma unroll
                        for (int i = 0; i < 4; ++i) { Xp[i][0] = 0.f; Xp[i][1] = 0.f; Xp[i][2] = 0.f; Xp[i][3] = 0.f; }
#pragma clang loop unroll(full)
                        for (int t = 0; t < 64; ++t) {
                            const float va_ = bf2f(AH[t * 72 + (colx & 63)]), vb_ = LB[t * 64 + (colx & 63)];
                            float a0 = par ? 0.f : ((colx < 64) ? va_ : vb_);
                            float a1 = 0.f, a2 = 0.f, a3 = 0.f;
#pragma clang loop unroll(full)
                            for (int i = 0; 16 * i < t; ++i) { const f32x4 w = *(const LAS f32x4*)(AAB + t * 64 + 16 * i + 4 * par);
                                a0 += w[0] * Xp[i][0]; a1 += w[1] * Xp[i][1]; a2 += w[2] * Xp[i][2]; a3 += w[3] * Xp[i][3]; }
                            float val = (a0 + a1) + (a2 + a3);
                            val += __builtin_bit_cast(float, __builtin_amdgcn_update_dpp(0, __builtin_bit_cast(int, val), 0xB1, 0xf, 0xf, false));
                            val += __builtin_bit_cast(float, __builtin_amdgcn_update_dpp(0, __builtin_bit_cast(int, val), 0x4E, 0xf, 0xf, false));
                            Xp[t >> 4][t & 3] = (par == ((t >> 2) & 3)) ? val : Xp[t >> 4][t & 3];
                            asm volatile("" : "+v"(Xp[t >> 4][t & 3]));
                        }
#pragma unroll
                        for (int i = 0; i < 4; ++i) { u32x2 w; w.x = cvt_pk_bf16(Xp[i][0], Xp[i][1]); w.y = cvt_pk_bf16(Xp[i][2], Xp[i][3]);
                            *(LAS u32x2*)(XT + colx * 72 + 16 * i + 4 * par) = w; }
                    }
                    S1_BAR;
                    if (item + G < 8704) S1_FETCH(item + G);
                    {
                        const int kind = wave >> 2, mt = (wave & 3) >> 1, nt = wave & 1;
                        {
                            const LAS bf16_t* Ap = (kind == 0 ? ARB : BHT) + (mt * 32 + l32) * 72; const LAS bf16_t* Bp = XT + (nt * 32 + l32) * 72;
                            f32x16 acc;
#pragma unroll
                            for (int i = 0; i < 16; ++i) acc[i] = 0.f;
#pragma unroll
                            for (int ks = 0; ks < 4; ++ks) acc = __builtin_amdgcn_mfma_f32_32x32x16_bf16(*(const LAS bf16x8*)(Ap + ks * 16 + hl * 8), *(const LAS bf16x8*)(Bp + ks * 16 + hl * 8), acc, 0, 0, 0);
                            bf16_t* dstb = (kind == 0) ? Rb : Kb;
#pragma unroll
                            for (int i = 0; i < 16; ++i) { const int rr = mt * 32 + crow(i, hl), cc = nt * 32 + l32;
                                float val = acc[i];
                                if (kind == 0) val += bf2f(RH[rr * 72 + cc]); else val *= DTS[rr];
                                dstb[(size_t)(r0 + rr) * DM + h * 64 + cc] = (bf16_t)(cvt_pk_bf16(val, 0.f) & 0xffffu); }
                        }
                        {
                            const LAS bf16_t* A1 = (kind == 0 ? ARB : BHT) + (mt * 32 + l32) * 72; const LAS bf16_t* A2 = (kind == 0 ? ARK : KHT) + (mt * 32 + l32) * 72;
                            const LAS bf16_t* B1 = XT + (64 + nt * 32 + l32) * 72; const LAS bf16_t* B2 = VTs + (nt * 32 + l32) * 72;
                            f32x16 acc;
#pragma unroll
                            for (int i = 0; i < 16; ++i) acc[i] = 0.f;
#pragma unroll
                            for (int ks = 0; ks < 4; ++ks) acc = __builtin_amdgcn_mfma_f32_32x32x16_bf16(*(const LAS bf16x8*)(A1 + ks * 16 + hl * 8), *(const LAS bf16x8*)(B1 + ks * 16 + hl * 8), acc, 0, 0, 0);
#pragma unroll
                            for (int ks = 0; ks < 4; ++ks) acc = __builtin_amdgcn_mfma_f32_32x32x16_bf16(*(const LAS bf16x8*)(A2 + ks * 16 + hl * 8), *(const LAS bf16x8*)(B2 + ks * 16 + hl * 8), acc, 0, 0, 0);
                            float* dstf = (kind == 0) ? Obuf : DD;
#pragma unroll
                            for (int i = 0; i < 16; ++i) { const int rr = mt * 32 + crow(i, hl), cc = nt * 32 + l32;
                                float val = acc[i]; if (kind == 1) val *= DTS[rr];
                                dstf[(size_t)(r0 + rr) * DM + h * 64 + cc] = val; }
                        }
                    }
                    S1_BAR;
                }
            }
            fast_grid_barrier((unsigned*)ldp(tab, 40), tab);
#undef S1_BAR
#undef S1_FETCH
            {
                PHASE_IDS BASES RWKV_PTRS
                const float* DTg = (const float*)(RB + 208 * MiB);
                const int l32 = lane & 31, hl = lane >> 5;
                const int q = wave * G + blockIdx.x;
                if (q < 1152) {
                    const bool prompt = q < 128; int b, h, vh, chunk0, nch;
                    if (prompt) { const int chain = q & 63; b = chain >> 5; h = chain & 31; vh = q >> 6; chunk0 = b * 128; nch = 128; }
                    else { const int sq = q - 128; const int chain = sq >> 1; b = chain >> 5; h = chain & 31; vh = sq & 1; chunk0 = 256 + b; nch = 1; }
                    const int colb = h * 64, vcol = colb + 32 * vh + l32;
                    f32x16 S0, S1;
                    if (prompt) {
#pragma unroll
                        for (int i = 0; i < 16; ++i) { S0[i] = 0.f; S1[i] = 0.f; }
                    } else {
                        const float* s0 = IN(3) + ((((size_t)jl * 16 + b) * 32 + h) * 64 + (32 * vh + l32)) * 64;
#pragma unroll
                        for (int i = 0; i < 16; ++i) { S0[i] = s0[crow(i, hl)]; S1[i] = s0[32 + crow(i, hl)]; }
                    }
                    bf16x8 gf[2][2][2]; f32x16 n0, n1; f32x4 dt_[2][4];
#define S2_COMPUTE(cc) do { const int _r0 = (chunk0 + (cc)) * 64; \
                        u32x4 w00, w01, w10, w11; \
                        w00.x = cvt_pk_bf16(S0[0], S0[1]); w00.y = cvt_pk_bf16(S0[2], S0[3]); w00.z = cvt_pk_bf16(S0[4], S0[5]); w00.w = cvt_pk_bf16(S0[6], S0[7]); \
                        w01.x = cvt_pk_bf16(S0[8], S0[9]); w01.y = cvt_pk_bf16(S0[10], S0[11]); w01.z = cvt_pk_bf16(S0[12], S0[13]); w01.w = cvt_pk_bf16(S0[14], S0[15]); \
                        w10.x = cvt_pk_bf16(S1[0], S1[1]); w10.y = cvt_pk_bf16(S1[2], S1[3]); w10.z = cvt_pk_bf16(S1[4], S1[5]); w10.w = cvt_pk_bf16(S1[6], S1[7]); \
                        w11.x = cvt_pk_bf16(S1[8], S1[9]); w11.y = cvt_pk_bf16(S1[10], S1[11]); w11.z = cvt_pk_bf16(S1[12], S1[13]); w11.w = cvt_pk_bf16(S1[14], S1[15]); \
                        const bf16x8 sb00 = __builtin_bit_cast(bf16x8, w00), sb01 = __builtin_bit_cast(bf16x8, w01), sb10 = __builtin_bit_cast(bf16x8, w10), sb11 = __builtin_bit_cast(bf16x8, w11); \
                        n0 = __builtin_amdgcn_mfma_f32_32x32x16_bf16(gf[0][0][0], sb00, n0, 0, 0, 0); n1 = __builtin_amdgcn_mfma_f32_32x32x16_bf16(gf[1][0][0], sb00, n1, 0, 0, 0); \
                        n0 = __builtin_amdgcn_mfma_f32_32x32x16_bf16(gf[0][0][1], sb01, n0, 0, 0, 0); n1 = __builtin_amdgcn_mfma_f32_32x32x16_bf16(gf[1][0][1], sb01, n1, 0, 0, 0); \
                        n0 = __builtin_amdgcn_mfma_f32_32x32x16_bf16(gf[0][1][0], sb10, n0, 0, 0, 0); n1 = __builtin_amdgcn_mfma_f32_32x32x16_bf16(gf[1][1][0], sb10, n1, 0, 0, 0); \
                        n0 = __builtin_amdgcn_mfma_f32_32x32x16_bf16(gf[0][1][1], sb11, n0, 0, 0, 0); n1 = __builtin_amdgcn_mfma_f32_32x32x16_bf16(gf[1][1][1], sb11, n1, 0, 0, 0); \
                        { unsigned char* _sp = (unsigned char*)DD + ((size_t)(_r0 + l32) * DM + colb + 32 * vh) * 4 + 8 * hl; \
                          *(u32x2*)(_sp + 0) = (u32x2){w00.x, w00.y}; *(u32x2*)(_sp + 16) = (u32x2){w00.z, w00.w}; *(u32x2*)(_sp + 32) = (u32x2){w01.x, w01.y}; *(u32x2*)(_sp + 48) = (u32x2){w01.z, w01.w}; \
                          *(u32x2*)(_sp + 64) = (u32x2){w10.x, w10.y}; *(u32x2*)(_sp + 80) = (u32x2){w10.z, w10.w}; *(u32x2*)(_sp + 96) = (u32x2){w11.x, w11.y}; *(u32x2*)(_sp + 112) = (u32x2){w11.z, w11.w}; } \
                        _Pragma("unroll") for (int i = 0; i < 16; ++i) { S0[i] = S0[i] * dt_[0][i >> 2][i & 3] + n0[i]; S1[i] = S1[i] * dt_[1][i >> 2][i & 3] + n1[i]; } \
                    } while (0)
                    if (prompt) {
                        LAS float* dtl = (LAS float*)((LAS unsigned char*)lds);
                        LAS unsigned char* ring = (LAS unsigned char*)lds + 32768;
                        for (int i = lane; i < 128 * 16; i += 64) *(LAS f32x4*)(dtl + i * 4) = *(const f32x4*)(DTg + ((size_t)(chunk0 + (i >> 4)) * 32 + h) * 64 + (i & 15) * 4);
#define S2_DMA(cc) do { const int _r0 = (chunk0 + (cc)) * 64; LAS unsigned char* _s = ring + ((cc) & 3) * 16384; \
                            _Pragma("unroll") for (int j = 0; j < 8; ++j) { const int _row = 8 * j + (lane >> 3); const int _p = (lane & 7) ^ (_row & 7); \
                                __builtin_amdgcn_global_load_lds((const unsigned*)(Kb + (size_t)(_r0 + _row) * DM + colb + _p * 8), (LAS unsigned*)(_s + j * 1024), 16, 0, 0); } \
                            _Pragma("unroll") for (int j = 0; j < 8; ++j) { const int _row = 8 * j + (lane >> 3); \
                                __builtin_amdgcn_global_load_lds((const unsigned*)(DD + (size_t)(_r0 + _row) * DM + colb + 32 * vh + (lane & 7) * 4), (LAS unsigned*)(_s + 8192 + j * 1024), 16, 0, 0); } \
                        } while (0)
                        S2_DMA(0); S2_DMA(1);
#pragma unroll 1
                        for (int c = 0; c < 128; ++c) {
                            if (c + 2 < 128) { S2_DMA(c + 2); asm volatile("s_waitcnt vmcnt(32)" ::: "memory"); }
                            else if (c + 1 < 128) asm volatile("s_waitcnt vmcnt(16)" ::: "memory");
                            else asm volatile("s_waitcnt vmcnt(0)" ::: "memory");
                            LAS unsigned char* sl = ring + (c & 3) * 16384;
#pragma unroll
                            for (int mt = 0; mt < 2; ++mt)
#pragma unroll
                                for (int kt = 0; kt < 2; ++kt)
#pragma unroll
                                    for (int s2 = 0; s2 < 2; ++s2) {
                                        const int row = 32 * mt + l32, p = 4 * kt + 2 * s2;
                                        const u32x2 lo = *(const LAS u32x2*)(sl + row * 128 + ((p ^ (row & 7)) * 16) + 8 * hl);
                                        const u32x2 hi = *(const LAS u32x2*)(sl + row * 128 + (((p + 1) ^ (row & 7)) * 16) + 8 * hl);
                                        gf[mt][kt][s2] = __builtin_bit_cast(bf16x8, (u32x4){lo.x, lo.y, hi.x, hi.y});
                                    }
#pragma unroll
                            for (int i = 0; i < 16; ++i) { n0[i] = *(const LAS float*)(sl + 8192 + crow(i, hl) * 128 + l32 * 4); n1[i] = *(const LAS float*)(sl + 8192 + (32 + crow(i, hl)) * 128 + l32 * 4); }
#pragma unroll
                            for (int mt = 0; mt < 2; ++mt)
#pragma unroll
                                for (int g = 0; g < 4; ++g) dt_[mt][g] = *(const LAS f32x4*)(dtl + c * 64 + 32 * mt + 8 * g + 4 * hl);
                            S2_COMPUTE(c);
                        }
#undef S2_DMA
                    } else {
                        const int _r0 = chunk0 * 64; const size_t _item = (size_t)chunk0 * 32 + h;
#pragma unroll
                        for (int mt = 0; mt < 2; ++mt)
#pragma unroll
                            for (int kt = 0; kt < 2; ++kt)
#pragma unroll
                                for (int s2 = 0; s2 < 2; ++s2) {
                                    const size_t _o = (size_t)(_r0 + 32 * mt + l32) * DM + colb + 32 * kt + 16 * s2 + 4 * hl;
                                    const u32x2 _lo = *(const u32x2*)(Kb + _o), _hi = *(const u32x2*)(Kb + _o + 8); gf[mt][kt][s2] = __builtin_bit_cast(bf16x8, (u32x4){_lo.x, _lo.y, _hi.x, _hi.y}); }
#pragma unroll
                        for (int i = 0; i < 16; ++i) { n0[i] = DD[(size_t)(_r0 + crow(i, hl)) * DM + vcol]; n1[i] = DD[(size_t)(_r0 + 32 + crow(i, hl)) * DM + vcol]; }
#pragma unroll
                        for (int mt = 0; mt < 2; ++mt)
#pragma unroll
                            for (int g = 0; g < 4; ++g) dt_[mt][g] = *(const f32x4*)(DTg + _item * 64 + 32 * mt + 8 * g + 4 * hl);
                        S2_COMPUTE(0);
                    }
#undef S2_COMPUTE
                    float* so_ = OUTP + (prompt ? O_PWKV + ((((size_t)jl * 2 + b) * 32 + h) * 64 + (32 * vh + l32)) * 64
                                                : O_SWKV + ((((size_t)jl * 16 + b) * 32 + h) * 64 + (32 * vh + l32)) * 64);
#pragma unroll
                    for (int i = 0; i < 16; ++i) { so_[crow(i, hl)] = S0[i]; so_[32 + crow(i, hl)] = S1[i]; }
                }
            }
            fast_grid_barrier((unsigned*)ldp(tab, 40), tab);
            {
                PHASE_IDS BASES RWKV_PTRS
                const float* Obuf = (const float*)(RA + 272 * MiB); const float* RK = (const float*)(RB + 204 * MiB);
                const float* lnw_g = IN(28) + (size_t)jl * DM; const float* lnb_g = IN(29) + (size_t)jl * DM;
                float* lnw = (float*)(lds + 40960); float* lnb = lnw + DM;
                for (int i = tid; i < DM / 4; i += 512) { *(f32x4*)(lnw + i * 4) = *(const f32x4*)(lnw_g + i * 4); *(f32x4*)(lnb + i * 4) = *(const f32x4*)(lnb_g + i * 4); }
                __syncthreads();
                const int l32 = lane & 31, hl = lane >> 5;
#pragma unroll 1
                for (int item = blockIdx.x; item < 8704; item += G) {
                    LAS unsigned char* ldsv = (LAS unsigned char*)lds; asm volatile("" : "+v"(ldsv));
                    LAS bf16_t* R2s = (LAS bf16_t*)(ldsv + 0); LAS bf16_t* STs = (LAS bf16_t*)(ldsv + 9216); LAS float* Os = (LAS float*)(ldsv + 18432);
                    const int chunk = item >> 5, h = item & 31, r0 = chunk * 64;
                    {
                        const int rr = tid >> 3, pc = tid & 7;
                        *(LAS u32x4*)(R2s + rr * 72 + pc * 8) = *(const u32x4*)(Rb + (size_t)(r0 + rr) * DM + h * 64 + pc * 8);
                        const unsigned char* sp = (const unsigned char*)DD + ((size_t)(r0 + (rr & 31)) * DM + h * 64 + 32 * (rr >> 5)) * 4 + pc * 16;
                        *(LAS u32x4*)(STs + rr * 72 + pc * 8) = *(const u32x4*)sp;
                    }
                    __syncthreads();
                    if (wave < 4) {
                        const int tt = wave >> 1, vt = wave & 1;
                        f32x16 acc;
#pragma unroll
                        for (int i = 0; i < 16; ++i) acc[i] = Obuf[(size_t)(r0 + 32 * tt + crow(i, hl)) * DM + h * 64 + 32 * vt + l32];
#pragma unroll
                        for (int ks = 0; ks < 4; ++ks) acc = __builtin_amdgcn_mfma_f32_32x32x16_bf16(*(const LAS bf16x8*)(R2s + (32 * tt + l32) * 72 + ks * 16 + hl * 8), *(const LAS bf16x8*)(STs + (32 * vt + l32) * 72 + ks * 16 + hl * 8), acc, 0, 0, 0);
#pragma unroll
                        for (int i = 0; i < 16; ++i) Os[(32 * tt + crow(i, hl)) * 68 + 32 * vt + l32] = acc[i];
                    }
                    __syncthreads();
                    {
                        const int st = tid >> 3, c0 = (tid & 7) * 8, col = h * 64 + c0; const size_t off = (size_t)(r0 + st) * DM + col;
                        const f32x4 o0 = *(const LAS f32x4*)(Os + st * 68 + c0), o1 = *(const LAS f32x4*)(Os + st * 68 + c0 + 4);
                        float o[8] = {o0[0], o0[1], o0[2], o0[3], o1[0], o1[1], o1[2], o1[3]};
                        float s = 0.f;
#pragma unroll
                        for (int i = 0; i < 8; ++i) s += o[i];
                        const float mu = sum8(s, lane) * (1.f / 64.f); float q = 0.f;
#pragma unroll
                        for (int i = 0; i < 8; ++i) { o[i] -= mu; q += o[i] * o[i]; }
                        const float rstd = rsqrtf(sum8(q, lane) * (1.f / 64.f) + 64e-5f);
                        float v[8], g8[8]; unpack8(*(const u32x4*)(Vb + off), v); unpack8(*(const u32x4*)(GG + off), g8);
                        if (jl > 0) { float vf[8], vg[8]; unpack8(*(const u32x4*)(VFIRST + off), vf); unpack8(*(const u32x4*)(VG + off), vg);
#pragma unroll
                            for (int i = 0; i < 8; ++i) v[i] = v[i] + (vf[i] - v[i]) * vg[i]; }
                        const float rk = RK[(size_t)(r0 + st) * 32 + h];
                        float y[8];
#pragma unroll
                        for (int i = 0; i < 8; ++i) y[i] = (o[i] * rstd * lnw[col + i] + lnb[col + i] + rk * v[i]) * g8[i];
                        *(u32x4*)(Y + off) = pack8(y);
                    }
                    __syncthreads();
                }
            }
            fast_grid_barrier((unsigned*)ldp(tab, 40), tab);
            {
                BASES RWKV_PTRS
                pg8::Gemm g{Y, WO, MROWS, 2048, 2048, 0, 0};
                pg8::StaticOrder S; S.init(g.M, g.N, G, (int)blockIdx.x, g.K, 4);
                pg8::Epi<FRes> E{FRes{X, (float*)(RA + 272 * MiB), layer == 0 ? IN(0) : (const float*)nullptr, IN(1)}};
                pg8::gemm_phase(ldsl, g, S, E);
                fast_grid_barrier((unsigned*)ldp(tab, 40), tab);
                {
                    PHASE_IDS
                    const float* PART = (const float*)(RA + 272 * MiB); const int ntail = S.nwg - S.nFull;
                    if (S.S > 1) for (int idx = gtid; idx < ntail * 16384; idx += NT) {
                        const int tl = idx >> 14, r = (idx >> 6) & 255, c4 = idx & 63; int pm, pn; S.tile_pmpn(S.nFull + tl, pm, pn);
                        f32x4* xp = (f32x4*)(X + (size_t)(pm * 256 + r) * DM + pn * 256 + c4 * 4); f32x4 acc = (layer == 0) ? *(const f32x4*)(xin_row(E.f.xin_p, E.f.xin_s, pm * 256 + r) + pn * 256 + c4 * 4) : *xp;
#pragma unroll
                        for (int part = 0; part < 4; ++part) acc += *(const f32x4*)(PART + (size_t)(part * 32 + tl) * 65536 + r * 256 + c4 * 4);
                        *xp = acc; }
                }
            }
            fast_grid_barrier((unsigned*)ldp(tab, 40), tab);
        } else {
            { PHASE_IDS BASES GLA_PTRS
            const float* gmix = IN(6) + (size_t)layer * DM;
            f32x4 ggr[8];
#pragma unroll
            for (int q = 0; q < 8; ++q) ggr[q] = *((const f32x4*)gmix + lane + 64 * q);
            for (int row = gw; row < MROWS; row += NGW) {
                const f32x4* xr = (const f32x4*)(X + (size_t)row * DM) + lane; f32x4 x[8]; float ss = 0.f;
#pragma unroll
                for (int q = 0; q < 8; ++q) { x[q] = xr[64 * q]; ss += x[q][0] * x[q][0] + x[q][1] * x[q][1] + x[q][2] * x[q][2] + x[q][3] * x[q][3]; }
                const float rs = rsqrtf(wave_sum(ss, lane) * (1.f / DM) + 1e-6f);
#pragma unroll
                for (int q = 0; q < 8; ++q) { const f32x4 gg = ggr[q]; const f32x4 h = x[q] * rs * gg;
                    u32x2 w; w.x = cvt_pk_bf16(h[0], h[1]); w.y = cvt_pk_bf16(h[2], h[3]); *((u32x2*)(H + (size_t)row * DM) + lane + 64 * q) = w; }
            } }
            fast_grid_barrier((unsigned*)ldp(tab, 40), tab);
            {
                BASES GLA_PTRS
                pg8::Gemm g{H, GI, MROWS, 6400, 2048, 0, 0};
                pg8::StaticOrder S; S.init(g.M, g.N, G, (int)blockIdx.x, g.K, 1);
                pg8::Epi<FG1> E{FG1{PROJ, LR}};
                pg8::gemm_phase(ldsl, g, S, E);
            }
            fast_grid_barrier((unsigned*)ldp(tab, 40), tab);
            {
                PHASE_IDS BASES GLA_PTRS
                float* lrS = (float*)lds;
                float* w2S = (float*)(lds + 4096);
                float* totS = (float*)(lds + 20480);
                bf16_t* qeS = (bf16_t*)(lds + 22528);
                bf16_t* keS = (bf16_t*)(lds + 22528 + 33792);
                bf16_t* vS = qeS;
                const float* gw2 = IN(31) + (size_t)jl * 16 * 1024; const float* gkb = IN(32) + (size_t)jl * 1024;
#pragma unroll 1
                for (int it = blockIdx.x; it < 1088; it += G) {
                    const int c = it >> 2, h = it & 3, r0 = c * 64; const size_t base = (size_t)it;
                    if (tid < 256) *(f32x4*)(lrS + tid * 4) = *(const f32x4*)(LR + (size_t)r0 * 16 + tid * 4);
                    for (int q = tid; q < 1024; q += 512) { const int r = q >> 6, cc = (q & 63) * 4; *(f32x4*)(w2S + r * 256 + cc) = *(const f32x4*)(gw2 + (size_t)r * 1024 + h * 256 + cc); }
                    for (int q = tid; q < 2048; q += 512) { const int t = q >> 5, cc = (q & 31) * 8; const bf16_t* src = PROJ + (size_t)(r0 + t) * 6144 + h * 256 + cc;
                        *(u32x4*)(qeS + t * 264 + cc) = *(const u32x4*)src; *(u32x4*)(keS + t * 264 + cc) = *(const u32x4*)(src + 1024); }
                    __syncthreads();
                    const int d = tid & 255, half = tid >> 8;
                    float cumv[32];
                    {
                        float w[16];
#pragma unroll
                        for (int r = 0; r < 16; ++r) w[r] = w2S[r * 256 + d];
                        const float bb = gkb[h * 256 + d]; float run = 0.f;
#pragma unroll
                        for (int tt = 0; tt < 32; ++tt) {
                            const float* lp = lrS + (half * 32 + tt) * 16; float z = bb;
#pragma unroll
                            for (int r = 0; r < 16; ++r) z += lp[r] * w[r];
                            const float g = (fminf(z, 0.f) - log1pf(__expf(-fabsf(z)))) * 0.0625f;
                            run += g; cumv[tt] = run;
                        }
                        totS[half * 256 + d] = run;
                    }
                    __syncthreads();
                    {
                        const float t0 = totS[d], t1 = totS[256 + d]; const float last = t0 + t1, offc = half ? t0 : 0.f;
                        if (half == 0) EL[base * 256 + d] = __expf(last);
                        unsigned kdp[16];
#pragma unroll
                        for (int tt = 0; tt < 32; tt += 2) {
                            float kd2[2];
#pragma unroll
                            for (int e = 0; e < 2; ++e) {
                                const int t = half * 32 + tt + e; const float cum = cumv[tt + e] + offc;
                                const float q = bf2f(qeS[t * 264 + d]), k = bf2f(keS[t * 264 + d]);
                                const float qe = q * __expf(cum), ke = k * __expf(-cum); kd2[e] = k * __expf(last - cum);
                                const unsigned pq = cvt_pk_bf16(qe, ke);
                                qeS[t * 264 + d] = (bf16_t)(pq & 0xffffu); keS[t * 264 + d] = (bf16_t)(pq >> 16);
                            }
                            kdp[tt >> 1] = cvt_pk_bf16(kd2[0], kd2[1]);
                        }
                        u32x4* kdst = (u32x4*)(KDT + (base * 256 + d) * 64 + half * 32);
                        kdst[0] = (u32x4){kdp[0], kdp[1], kdp[2], kdp[3]}; kdst[1] = (u32x4){kdp[4], kdp[5], kdp[6], kdp[7]};
                        kdst[2] = (u32x4){kdp[8], kdp[9], kdp[10], kdp[11]}; kdst[3] = (u32x4){kdp[12], kdp[13], kdp[14], kdp[15]};
                    }
                    __syncthreads();
                    for (int q = tid; q < 2048; q += 512) { const int t = q >> 5, sl = (q >> 2) & 7, pc = q & 3;
                        *(u32x4*)(QE + ((base * 8 + sl) * 64 + t) * 32 + pc * 8) = *(const u32x4*)(qeS + t * 264 + sl * 32 + pc * 8); }
                    if (wave < 4) {
                        const int mi = wave >> 1, ni = wave & 1, l32 = lane & 31, hl = lane >> 5;
                        f32x16 cacc;
#pragma unroll
                        for (int i = 0; i < 16; ++i) cacc[i] = 0.f;
#pragma unroll
                        for (int kk = 0; kk < 16; ++kk) {
                            const bf16x8 a = *(const bf16x8*)(qeS + (mi * 32 + l32) * 264 + kk * 16 + hl * 8);
                            const bf16x8 b = *(const bf16x8*)(keS + (ni * 32 + l32) * 264 + kk * 16 + hl * 8);
                            cacc = __builtin_amdgcn_mfma_f32_32x32x16_bf16(a, b, cacc, 0, 0, 0);
                        }
#pragma unroll
                        for (int i = 0; i < 16; ++i) { const int ii = mi * 32 + crow(i, hl), jj = ni * 32 + l32;
                            const float v = (jj <= ii) ? cacc[i] : 0.f; SC[base * 4096 + ii * 64 + jj] = (bf16_t)(cvt_pk_bf16(v, 0.f) & 0xffffu); }
                    }
                    __syncthreads();
                    for (int q = tid; q < 4096; q += 512) { const int t = q >> 6, cc = (q & 63) * 8;
                        *(u32x4*)(vS + t * 520 + cc) = *(const u32x4*)(PROJ + (size_t)(r0 + t) * 6144 + 2048 + h * 512 + cc); }
                    __syncthreads();
                    {
                        const int dv = tid; u32x4* vdst = (u32x4*)(VT + (base * 512 + dv) * 64);
#pragma unroll
                        for (int q = 0; q < 8; ++q) {
                            unsigned w[4];
#pragma unroll
                            for (int e = 0; e < 4; ++e) { const unsigned lo = vS[(q * 8 + 2 * e) * 520 + dv], hi = vS[(q * 8 + 2 * e + 1) * 520 + dv]; w[e] = lo | (hi << 16); }
                            vdst[q] = (u32x4){w[0], w[1], w[2], w[3]};
                        }
                    }
                    __syncthreads();
                }
            }
            fast_grid_barrier((unsigned*)ldp(tab, 40), tab);
            {
                PHASE_IDS BASES GLA_PTRS
                float* red = (float*)lds;
                const int l32 = lane & 31, hl = lane >> 5;
                int u0_ = (int)blockIdx.x, ustr_ = G;
                if (G >= 256) { if ((int)blockIdx.x < 128) ustr_ = 1 << 30; else { u0_ = (int)blockIdx.x; ustr_ = G - 128; } }
#pragma unroll 1
                for (int u = u0_; u < 1152; u += ustr_) {
                    const bool prompt = u < 128; int b, h, s, cg0, nch, row0;
                    if (prompt) { const int pair = u & 7; b = pair >> 2; h = pair & 3; s = u >> 3; cg0 = b * 128; nch = 128; row0 = b * 8192; }
                    else { const int su = u - 128; b = su >> 6; h = (su >> 4) & 3; s = su & 15; cg0 = 256 + b; nch = 1; row0 = MPROMPT + b * 64; }
                    f32x16 S;
                    if (prompt) {
#pragma unroll
                        for (int i = 0; i < 16; ++i) S[i] = 0.f;
                    } else {
                        const float* s0 = IN(4) + ((((size_t)jl * 16 + b) * 4 + h) * 256) * 512;
#pragma unroll
                        for (int i = 0; i < 16; ++i) S[i] = s0[(size_t)(32 * wave + crow(i, hl)) * 512 + 32 * s + l32];
                    }
                    const int mtw = wave & 1, ksw = wave >> 1;
                    bf16x8 ka[4], vb[4], qf[2][2], scf; f32x4 el[4];
#define GL_LD_Q(cc) do { const size_t _base = (size_t)(cg0 + (cc)) * 4 + h; const int _r0 = row0 + (cc) * 64; const bf16_t* _sc = SC + _base * 4096; \
                        _Pragma("unroll") for (int mt = 0; mt < 2; ++mt) _Pragma("unroll") for (int s2 = 0; s2 < 2; ++s2) { const bf16_t* _pq = QE + ((_base * 8 + wave) * 64 + mt * 32 + l32) * 32 + 16 * s2 + 4 * hl; \
                            const u32x2 _lo = *(const u32x2*)_pq, _hi = *(const u32x2*)(_pq + 8); qf[mt][s2] = __builtin_bit_cast(bf16x8, (u32x4){_lo.x, _lo.y, _hi.x, _hi.y}); } \
                        scf = *(const bf16x8*)(_sc + (mtw * 32 + l32) * 64 + 16 * ksw + 8 * hl); } while (0)
#define GL_LD_E(cc) do { const size_t _base = (size_t)(cg0 + (cc)) * 4 + h; \
                        _Pragma("unroll") for (int g = 0; g < 4; ++g) el[g] = *(const f32x4*)(EL + _base * 256 + 32 * wave + 8 * g + 4 * hl); } while (0)
#define GL_LD_K(cc) do { const size_t _base = (size_t)(cg0 + (cc)) * 4 + h; const bf16_t* _kdt = KDT + _base * 256 * 64; const bf16_t* _vt = VT + _base * 512 * 64; \
                        _Pragma("unroll") for (int ks = 0; ks < 4; ++ks) { ka[ks] = *(const bf16x8*)(_kdt + (32 * wave + l32) * 64 + 16 * ks + 8 * hl); vb[ks] = *(const bf16x8*)(_vt + (32 * s + l32) * 64 + 16 * ks + 8 * hl); } } while (0)
                    GL_LD_Q(0); GL_LD_E(0); GL_LD_K(0);
                    f32x4 osum = (f32x4){0.f, 0.f, 0.f, 0.f}; float* optr = nullptr;
#pragma unroll 1
                    for (int c = 0; c < nch; ++c) {
                        const int r0 = row0 + c * 64; const int cn = (c + 1 < nch) ? c + 1 : c;
                        asm volatile("" : "+v"(scf), "+v"(vb[3]));
                        if (c > 0) *(f32x4*)optr = osum;
                        u32x4 sp0, sp1;
                        sp0.x = cvt_pk_bf16(S[0], S[1]); sp0.y = cvt_pk_bf16(S[2], S[3]); sp0.z = cvt_pk_bf16(S[4], S[5]); sp0.w = cvt_pk_bf16(S[6], S[7]);
                        sp1.x = cvt_pk_bf16(S[8], S[9]); sp1.y = cvt_pk_bf16(S[10], S[11]); sp1.z = cvt_pk_bf16(S[12], S[13]); sp1.w = cvt_pk_bf16(S[14], S[15]);
                        const bf16x8 sb0 = __builtin_bit_cast(bf16x8, sp0), sb1 = __builtin_bit_cast(bf16x8, sp1);
                        const bf16x8 vbw = ksw == 0 ? vb[0] : ksw == 1 ? vb[1] : ksw == 2 ? vb[2] : vb[3];
#pragma unroll
                        for (int i = 0; i < 16; ++i) S[i] *= el[i >> 2][i & 3];
#pragma unroll
                        for (int ks = 0; ks < 4; ++ks) S = __builtin_amdgcn_mfma_f32_32x32x16_bf16(ka[ks], vb[ks], S, 0, 0, 0);
                        GL_LD_E(cn); GL_LD_K(cn);
                        f32x16 oo0, oo1;
#pragma unroll
                        for (int i = 0; i < 16; ++i) { oo0[i] = 0.f; oo1[i] = 0.f; }
                        oo0 = __builtin_amdgcn_mfma_f32_32x32x16_bf16(qf[0][0], sb0, oo0, 0, 0, 0); oo0 = __builtin_amdgcn_mfma_f32_32x32x16_bf16(qf[0][1], sb1, oo0, 0, 0, 0);
                        oo1 = __builtin_amdgcn_mfma_f32_32x32x16_bf16(qf[1][0], sb0, oo1, 0, 0, 0); oo1 = __builtin_amdgcn_mfma_f32_32x32x16_bf16(qf[1][1], sb1, oo1, 0, 0, 0);
                        if (mtw == 0) oo0 = __builtin_amdgcn_mfma_f32_32x32x16_bf16(scf, vbw, oo0, 0, 0, 0); else oo1 = __builtin_amdgcn_mfma_f32_32x32x16_bf16(scf, vbw, oo1, 0, 0, 0);
                        GL_LD_Q(cn);
#pragma unroll
                        for (int q = 0; q < 16; ++q) { red[(wave * 32 + q) * 64 + lane] = oo0[q]; red[(wave * 32 + 16 + q) * 64 + lane] = oo1[q]; }
                        asm volatile("s_waitcnt lgkmcnt(0)" ::: "memory"); __builtin_amdgcn_s_barrier(); asm volatile("" ::: "memory");
                        { const int q = tid >> 4, lg = tid & 15; f32x4 sum = (f32x4){0.f, 0.f, 0.f, 0.f};
#pragma unroll
                          for (int w = 0; w < 8; ++w) sum += *(const f32x4*)(red + (w * 32 + q) * 64 + 4 * lg);
                          const int mt = q >> 4, reg = q & 15, L = 4 * lg; const int i = mt * 32 + crow(reg, L >> 5), dv = L & 31;
                          osum = sum; optr = O + (size_t)(r0 + i) * DM + h * 512 + 32 * s + dv; }
                        asm volatile("s_waitcnt lgkmcnt(0)" ::: "memory"); __builtin_amdgcn_s_barrier(); asm volatile("" ::: "memory");
                    }
                    *(f32x4*)optr = osum;
#undef GL_LD_Q
#undef GL_LD_E
#undef GL_LD_K
                    float* dst = OUTP + (prompt ? O_PGLA + ((((size_t)jl * 2 + b) * 4 + h) * 256) * 512 : O_SGLA + ((((size_t)jl * 16 + b) * 4 + h) * 256) * 512);
#pragma unroll
                    for (int i = 0; i < 16; ++i) dst[(size_t)(32 * wave + crow(i, hl)) * 512 + 32 * s + l32] = S[i];
                }
                if (layer == 1 && G >= 256 && (int)blockIdx.x >= 128) {
                    float* scr = (float*)(lds + wave * 16896);
                    CONVERT_WEIGHTS(1, 2, 2, 4, ((int)blockIdx.x - 128) * 8 + wave, (G - 128) * 8);
                }
            }
            fast_grid_barrier((unsigned*)ldp(tab, 40), tab);
            {
                PHASE_IDS BASES GLA_PTRS
                const float* hn = IN(33) + (size_t)jl * 512;
                const f32x4 n0 = *(const f32x4*)(hn + lane * 8), n1 = *(const f32x4*)(hn + lane * 8 + 4);
                for (int row = gw; row < MROWS; row += NGW) {
#pragma unroll
                    for (int h = 0; h < 4; ++h) {
                        const float* op = O + (size_t)row * DM + h * 512 + lane * 8;
                        const f32x4 a = *(const f32x4*)op, b = *(const f32x4*)(op + 4);
                        float ss = a[0] * a[0] + a[1] * a[1] + a[2] * a[2] + a[3] * a[3] + b[0] * b[0] + b[1] * b[1] + b[2] * b[2] + b[3] * b[3];
                        const float rs = rsqrtf(wave_sum(ss, lane) * (1.f / 512.f) + 1e-5f);
                        float gt[8]; unpack8(*(const u32x4*)(PROJ + (size_t)row * 6144 + 4096 + h * 512 + lane * 8), gt);
                        float y[8];
#pragma unroll
                        for (int i = 0; i < 4; ++i) { y[i] = a[i] * rs * n0[i] * (gt[i] * sigmoidf_(gt[i])); y[4 + i] = b[i] * rs * n1[i] * (gt[4 + i] * sigmoidf_(gt[4 + i])); }
                        *(u32x4*)(Y + (size_t)row * DM + h * 512 + lane * 8) = pack8(y);
                    }
                }
            }
            fast_grid_barrier((unsigned*)ldp(tab, 40), tab);
            {
                BASES GLA_PTRS
                pg8::Gemm g{Y, GO, MROWS, 2048, 2048, 0, 0};
                pg8::StaticOrder S; S.init(g.M, g.N, G, (int)blockIdx.x, g.K, 4);
                pg8::Epi<FRes> E{FRes{X, (float*)(RA + 272 * MiB), nullptr, nullptr}};
                pg8::gemm_phase(ldsl, g, S, E);
                fast_grid_barrier((unsigned*)ldp(tab, 40), tab);
                {
                    PHASE_IDS
                    const float* PART = (const float*)(RA + 272 * MiB); const int ntail = S.nwg - S.nFull;
                    if (S.S > 1) for (int idx = gtid; idx < ntail * 16384; idx += NT) {
                        const int tl = idx >> 14, r = (idx >> 6) & 255, c4 = idx & 63; int pm, pn; S.tile_pmpn(S.nFull + tl, pm, pn);
                        f32x4* xp = (f32x4*)(X + (size_t)(pm * 256 + r) * DM + pn * 256 + c4 * 4); f32x4 acc = *xp;
#pragma unroll
                        for (int part = 0; part < 4; ++part) acc += *(const f32x4*)(PART + (size_t)(part * 32 + tl) * 65536 + r * 256 + c4 * 4);
                        *xp = acc; }
                }
            }
            fast_grid_barrier((unsigned*)ldp(tab, 40), tab);
        }
        {
            { PHASE_IDS BASES FFN_PTRS
            const float* gf = IN(7) + (size_t)layer * DM;
            f32x4 ggr[8];
#pragma unroll
            for (int q = 0; q < 8; ++q) ggr[q] = *((const f32x4*)gf + lane + 64 * q);
            for (int row = gw; row < MROWS; row += NGW) {
                const f32x4* xr = (const f32x4*)(X + (size_t)row * DM) + lane; f32x4 x[8]; float ss = 0.f;
#pragma unroll
                for (int q = 0; q < 8; ++q) { x[q] = xr[64 * q]; ss += x[q][0] * x[q][0] + x[q][1] * x[q][1] + x[q][2] * x[q][2] + x[q][3] * x[q][3]; }
                const float rs = rsqrtf(wave_sum(ss, lane) * (1.f / DM) + 1e-6f);
#pragma unroll
                for (int q = 0; q < 8; ++q) { const f32x4 gg = ggr[q]; const f32x4 h = x[q] * rs * gg;
                    u32x2 w; w.x = cvt_pk_bf16(h[0], h[1]); w.y = cvt_pk_bf16(h[2], h[3]); *((u32x2*)(H + (size_t)row * DM) + lane + 64 * q) = w; }
            } }
            fast_grid_barrier((unsigned*)ldp(tab, 40), tab);
            {
                BASES FFN_PTRS
                pg8::Gemm g{H, WU, MROWS, F2, 2048, 0, 0};
                pg8::StaticOrder S; S.init(g.M, g.N, G, (int)blockIdx.x, g.K, 1);
                pg8::Epi<FUp> E{FUp{U, OUTP + O_PCONV + (size_t)layer * 2 * 2 * F2, OUTP + O_SCONV + (size_t)layer * 16 * 2 * F2}};
                pg8::gemm_phase(ldsl, g, S, E);
            }
            fast_grid_barrier((unsigned*)ldp(tab, 40), tab);
            {
                PHASE_IDS BASES FFN_PTRS
                const float* cw = IN(36) + (size_t)layer * 3 * F2; const float* cb = IN(37) + (size_t)layer * F2;
                const float* cst = IN(5) + (size_t)layer * 16 * 2 * F2;
#pragma unroll 1
                for (int it = gtid; it < 544 * 704; it += NT) {
                    const int rc = it / 704, c8 = it - rc * 704, col = c8 * 8, r0 = rc * 32;
                    int t0, len, b; bool prompt; row_info(r0, t0, len, b, prompt);
                    float wv[3][8], wg[3][8], bv[8], bg[8];
#pragma unroll
                    for (int k = 0; k < 3; ++k) { const f32x4 a = *(const f32x4*)(cw + (size_t)k * F2 + col), a2 = *(const f32x4*)(cw + (size_t)k * F2 + col + 4);
                        const f32x4 g = *(const f32x4*)(cw + (size_t)k * F2 + FH + col), g2 = *(const f32x4*)(cw + (size_t)k * F2 + FH + col + 4);
#pragma unroll
                        for (int i = 0; i < 4; ++i) { wv[k][i] = a[i]; wv[k][4 + i] = a2[i]; wg[k][i] = g[i]; wg[k][4 + i] = g2[i]; } }
                    { const f32x4 a = *(const f32x4*)(cb + col), a2 = *(const f32x4*)(cb + col + 4), g = *(const f32x4*)(cb + FH + col), g2 = *(const f32x4*)(cb + FH + col + 4);
#pragma unroll
                      for (int i = 0; i < 4; ++i) { bv[i] = a[i]; bv[4 + i] = a2[i]; bg[i] = g[i]; bg[4 + i] = g2[i]; } }
                    float v2[8], v1[8], g2_[8], g1_[8];
                    if (t0 > 0) {
                        unpack8(*(const u32x4*)(U + (size_t)(r0 - 2) * F2 + col), v2); unpack8(*(const u32x4*)(U + (size_t)(r0 - 1) * F2 + col), v1);
                        unpack8(*(const u32x4*)(U + (size_t)(r0 - 2) * F2 + FH + col), g2_); unpack8(*(const u32x4*)(U + (size_t)(r0 - 1) * F2 + FH + col), g1_);
                    } else if (!prompt) {
                        const float* s0 = cst + ((size_t)b * 2) * F2 + col; const float* s1 = s0 + F2;
#pragma unroll
                        for (int i = 0; i < 8; ++i) { v2[i] = s0[i]; v1[i] = s1[i]; g2_[i] = s0[FH + i]; g1_[i] = s1[FH + i]; }
                    } else {
#pragma unroll
                        for (int i = 0; i < 8; ++i) { v2[i] = 0.f; v1[i] = 0.f; g2_[i] = 0.f; g1_[i] = 0.f; }
                    }
#pragma unroll 1
                    for (int rb = 0; rb < 32; rb += 8) {
                      u32x4 uv_[8], ug_[8];
#pragma unroll
                      for (int j = 0; j < 8; ++j) { uv_[j] = *(const u32x4*)(U + (size_t)(r0 + rb + j) * F2 + col); ug_[j] = *(const u32x4*)(U + (size_t)(r0 + rb + j) * F2 + FH + col); }
#pragma unroll
                      for (int j = 0; j < 8; ++j) {
                        const int r = rb + j;
                        float v0[8], g0[8];
                        unpack8(uv_[j], v0); unpack8(ug_[j], g0);
                        float y[8];
#pragma unroll
                        for (int i = 0; i < 8; ++i) {
                            const float cv = bv[i] + wv[0][i] * v2[i] + wv[1][i] * v1[i] + wv[2][i] * v0[i];
                            const float cg_ = bg[i] + wg[0][i] * g2_[i] + wg[1][i] * g1_[i] + wg[2][i] * g0[i];
                            y[i] = cg_ * sigmoidf_(cg_) * cv;
                            v2[i] = v1[i]; v1[i] = v0[i]; g2_[i] = g1_[i]; g1_[i] = g0[i];
                        }
                        *(u32x4*)(HID + (size_t)(r0 + r) * FH + col) = pack8(y);
                      }
                    }
                }
            }
            fast_grid_barrier((unsigned*)ldp(tab, 40), tab);
            {
                BASES FFN_PTRS
                pg8::Gemm g{HID, WD, MROWS, 2048, FH, 0, 0};
                pg8::StaticOrder S; S.init(g.M, g.N, G, (int)blockIdx.x, g.K, 4);
                pg8::Epi<FRes> E{FRes{X, (float*)(RA + 272 * MiB), nullptr, nullptr}};
                pg8::gemm_phase(ldsl, g, S, E);
                fast_grid_barrier((unsigned*)ldp(tab, 40), tab);
                {
                    PHASE_IDS
                    const float* PART = (const float*)(RA + 272 * MiB); const int ntail = S.nwg - S.nFull;
                    if (S.S > 1) for (int idx = gtid; idx < ntail * 16384; idx += NT) {
                        const int tl = idx >> 14, r = (idx >> 6) & 255, c4 = idx & 63; int pm, pn; S.tile_pmpn(S.nFull + tl, pm, pn);
                        f32x4* xp = (f32x4*)(X + (size_t)(pm * 256 + r) * DM + pn * 256 + c4 * 4); f32x4 acc = *xp;
#pragma unroll
                        for (int part = 0; part < 4; ++part) acc += *(const f32x4*)(PART + (size_t)(part * 32 + tl) * 65536 + r * 256 + c4 * 4);
                        *xp = acc; }
                }
            }
            fast_grid_barrier((unsigned*)ldp(tab, 40), tab);
        }
    }
    {
        PHASE_IDS BASES
        const float* gn = IN(8);
        f32x4 ggr[8];
#pragma unroll
        for (int q = 0; q < 8; ++q) ggr[q] = *((const f32x4*)gn + lane + 64 * q);
        for (int row = gw; row < MROWS; row += NGW) {
            f32x4* xr = (f32x4*)(X + (size_t)row * DM) + lane; f32x4 x[8]; float ss = 0.f;
#pragma unroll
            for (int q = 0; q < 8; ++q) { x[q] = xr[64 * q]; ss += x[q][0] * x[q][0] + x[q][1] * x[q][1] + x[q][2] * x[q][2] + x[q][3] * x[q][3]; }
            const float rs = rsqrtf(wave_sum(ss, lane) * (1.f / DM) + 1e-6f);
#pragma unroll
            for (int q = 0; q < 8; ++q) { const f32x4 gg = ggr[q]; xr[64 * q] = x[q] * rs * gg; }
        }
    }
}

#undef TR
#undef CONVERT_WEIGHTS
extern "C" void kernel_launch(void* const* d_in, const int* in_sizes, int n_in, void* d_out, int out_size, void* d_ws, size_t ws_size, hipStream_t stream) {
    static int grid = 0;
    if (grid == 0) {
        if (n_in != 39 || (size_t)out_size != O_TOTAL || ws_size < WS_END) {
            fprintf(stderr, "kernel_launch: unexpected shapes: n_in %d out %d ws %zu (need %zu)\n", n_in, out_size, ws_size, (size_t)WS_END); grid = -1; return; }
        int dev = 0, cus = 0, per_cu = 0;
        (void)hipGetDevice(&dev);
        (void)hipDeviceGetAttribute(&cus, hipDeviceAttributeMultiprocessorCount, dev);
        if (hipFuncSetAttribute((const void*)fwd_kernel, hipFuncAttributeMaxDynamicSharedMemorySize, LDS_BYTES) != hipSuccess) { fprintf(stderr, "kernel_launch: hipFuncSetAttribute failed\n"); grid = -1; return; }
        if (hipOccupancyMaxActiveBlocksPerMultiprocessor(&per_cu, (const void*)fwd_kernel, 512, LDS_BYTES) != hipSuccess || per_cu < 1) { fprintf(stderr, "kernel_launch: occupancy query says %d\n", per_cu); per_cu = 1; }
        (void)hipGetLastError();
        grid = cus * 1;
        if (grid <= 0) grid = 256;
    }
    if (grid < 0) return;
    P prm{};
    for (int i = 0; i < 39; ++i) prm.in[i] = (const float*)d_in[i];
    prm.out = (float*)d_out; prm.ws = (unsigned char*)d_ws;
    void* args[] = {&prm};
    hipError_t e = hipLaunchCooperativeKernel((const void*)fwd_kernel, dim3(grid), dim3(512), args, LDS_BYTES, stream);
    if (e != hipSuccess) fprintf(stderr, "cooperative launch failed: %s (grid %d)\n", hipGetErrorString(e), grid);
}
```

```cpp
#include <hip/hip_runtime.h>
#include <hip/hip_cooperative_groups.h>
#include <cstdio>
#include <cstdint>
namespace cg = cooperative_groups;

#define LAS __attribute__((address_space(3)))
typedef unsigned short bf16_t;
typedef short bf16x8 __attribute__((ext_vector_type(8)));
typedef float f32x4 __attribute__((ext_vector_type(4)));
typedef float f32x16 __attribute__((ext_vector_type(16)));
typedef unsigned u32x4 __attribute__((ext_vector_type(4)));
typedef unsigned u32x2 __attribute__((ext_vector_type(2)));

constexpr int DM = 2048, MROWS = 17408, MPROMPT = 16384;
constexpr int FH = 5632, F2 = 11264;
constexpr int LDS_BYTES = 147456;
constexpr size_t MiB = 1u << 20;
constexpr size_t WS_WT = 1 * MiB;
constexpr size_t WS_A = 411 * MiB;
constexpr size_t WS_B = 819 * MiB;
constexpr size_t WS_VF = 1227 * MiB;
constexpr size_t WS_END = 1295 * MiB;
constexpr size_t ACT = (size_t)MROWS * DM;
constexpr size_t RW_SZ = (size_t)7168 * 2048 + (size_t)8192 * 256 + (size_t)2048 * 2048;
constexpr size_t GW_SZ = (size_t)6400 * 2048 + (size_t)2048 * 2048;
constexpr size_t FW_SZ = (size_t)11264 * 2048 + (size_t)2048 * 5632;
constexpr size_t GW_OFF = 2 * RW_SZ, FW_OFF = GW_OFF + 2 * GW_SZ;
constexpr size_t O_PSHIFT = 35651584, O_PWKV = 35659776, O_PGLA = 36184064, O_PCONV = 38281216;
constexpr size_t O_SSHIFT = 38461440, O_SWKV = 38526976, O_SGLA = 42721280, O_SCONV = 59498496, O_TOTAL = 60940288;

__device__ __forceinline__ unsigned cvt_pk_bf16(float lo, float hi) { unsigned r; asm volatile("v_cvt_pk_bf16_f32 %0, %1, %2" : "=v"(r) : "v"(lo), "v"(hi)); return r; }
__device__ __forceinline__ float bf2f(bf16_t b) { return __builtin_bit_cast(float, (unsigned)b << 16); }
__device__ __forceinline__ float bflo(unsigned u) { return __builtin_bit_cast(float, u << 16); }
__device__ __forceinline__ float bfhi(unsigned u) { return __builtin_bit_cast(float, u & 0xffff0000u); }
__device__ __forceinline__ void unpack8(u32x4 w, float (&f)[8]) {
    f[0] = bflo(w.x); f[1] = bfhi(w.x); f[2] = bflo(w.y); f[3] = bfhi(w.y); f[4] = bflo(w.z); f[5] = bfhi(w.z); f[6] = bflo(w.w); f[7] = bfhi(w.w);
}
__device__ __forceinline__ u32x4 pack8(const float (&f)[8]) {
    u32x4 w; w.x = cvt_pk_bf16(f[0], f[1]); w.y = cvt_pk_bf16(f[2], f[3]); w.z = cvt_pk_bf16(f[4], f[5]); w.w = cvt_pk_bf16(f[6], f[7]); return w;
}
__device__ __forceinline__ float sigmoidf_(float x) { return 1.f / (1.f + __expf(-x)); }
__device__ __forceinline__ float shx(float v, int lane, int o) { return __builtin_bit_cast(float, __builtin_amdgcn_ds_bpermute((lane ^ o) << 2, __builtin_bit_cast(int, v))); }
__device__ __forceinline__ float wave_sum(float v, int lane) {
#pragma unroll
    for (int o = 1; o < 64; o <<= 1) v += shx(v, lane, o);
    return v;
}
__device__ __forceinline__ float sum8(float v, int lane) { v += shx(v, lane, 1); v += shx(v, lane, 2); v += shx(v, lane, 4); return v; }
__device__ __forceinline__ int crow(int reg, int h) { return (reg & 3) + 8 * (reg >> 2) + 4 * h; }

namespace pg8 {
constexpr int BM = 256, BK = 64, HALF = 128, HTB = HALF * BK * 2, STAGE_BYTES = 8 * HTB, NXCD = 8, WGM = 8;
__host__ __device__ __forceinline__ int lds_byte(int r, int c) { const int st = (r >> 4) * 2 + (c >> 5), rr = r & 15, cc = c & 31, ob = rr * 64 + cc * 2; return st * 1024 + (ob ^ (((ob >> 9) & 1) << 5)); }
__host__ __device__ __forceinline__ void stage_rc(int b, int& R, int& C) { const int st = b / 1024, sb = b % 1024, swz = sb ^ (((sb >> 9) & 1) << 5); R = (st >> 1) * 16 + swz / 64; C = (st & 1) * 32 + (swz % 64) / 2; }
__host__ __device__ __forceinline__ int perm32(int rho) { const int n = rho >> 4, i = rho & 15; return 8 * (i >> 2) + 4 * n + (i & 3); }

struct Unit { int pm, pn, kofs, knt, split; };
struct Gemm { const bf16_t* A; const bf16_t* Bt; int M, N, K; int mode; size_t astride; };
__device__ __forceinline__ const char* a_of(const Gemm& g, int pn) {
    int s = 0;
    if (g.mode == 1) s = pn < 8 ? 0 : pn < 16 ? 2 : pn < 24 ? 3 : pn == 24 ? 1 : pn == 25 ? 4 : pn == 26 ? 5 : 3;
    else if (g.mode == 2) s = pn >> 3;
    return (const char*)g.A + (size_t)s * g.astride;
}
struct StaticOrder {
    int nM, nN, nwg, G, c, nFull, S, ntK, total;
    __device__ __forceinline__ void init(int M, int N, int G_, int c_, int K = 0, int S_ = 1) { nM = M / BM; nN = N / BM; nwg = nM * nN; G = G_; c = c_; ntK = K / BK;
        nFull = (nwg / G) * G; S = S_; if (S_ <= 1 || nFull == nwg) { S = 1; nFull = nwg; } total = nFull + (nwg - nFull) * S; }
    __device__ __forceinline__ bool next(int i, Unit& u) const {
        const long L = (long)i * G + c; if (L >= total) return false;
        int wgid;
        if (L < nFull) { wgid = (int)L; u.kofs = 0; u.knt = ntK; u.split = 0; }
        else { const int j = (int)L - nFull; wgid = nFull + j / S; const int part = j % S; u.knt = ntK / S; u.kofs = part * u.knt * BK; u.split = 1 + part * 32 + j / S; }
        tile_pmpn(wgid, u.pm, u.pn); return true;
    }
    __device__ __forceinline__ void tile_pmpn(int wgid, int& pm, int& pn) const {
        { const int q = nwg / NXCD, r = nwg % NXCD, xcd = wgid % NXCD, off = wgid / NXCD; wgid = (xcd < r ? xcd * (q + 1) : r * (q + 1) + (xcd - r) * q) + off; }
        const int nig = WGM * nN, gid = wgid / nig, fm = gid * WGM, gsz = (nM - fm) < WGM ? (nM - fm) : WGM;
        pm = fm + ((wgid % nig) % gsz); pn = (wgid % nig) / gsz;
    }
};

template <class F> struct Epi {
    static constexpr bool PERM = true;
    F f;
    __device__ __forceinline__ void operator()(const f32x4 (&acc)[2][2][4][2], const Unit& u, int wr, int wc, int fr, int fq) const {
        { int t_ = threadIdx.x; asm volatile("" : "+v"(t_)); const int l_ = t_ & 63, w_ = __builtin_amdgcn_readfirstlane(t_ >> 6); fr = l_ & 15; fq = l_ >> 4; wr = w_ >> 2; wc = w_ & 3; }
        const int row0 = u.pm * BM + wr * 64 + fr, col0 = u.pn * BM + wc * 32 + 8 * fq;
#pragma unroll
        for (int ai = 0; ai < 2; ++ai)
#pragma unroll
            for (int m = 0; m < 4; ++m)
#pragma unroll
                for (int bj = 0; bj < 2; ++bj) f(row0 + ai * HALF + m * 16, col0 + bj * HALF, acc[ai][bj][m][0], acc[ai][bj][m][1], u.split);
    }
};

template <class EpiT>
__device__ __forceinline__ void gemm_phase(LAS unsigned char* lds, const Gemm g, const StaticOrder& S, const EpiT& E) {
    int tid = threadIdx.x; asm volatile("" : "+v"(tid));
    const int wid = __builtin_amdgcn_readfirstlane(tid >> 6), lane = tid & 63, wr = wid >> 2, wc = wid & 3, fr = lane & 15, fq = lane >> 4;
    const int K = g.K;
    unsigned voffA[2], voffB[2];
#pragma unroll
    for (int i = 0; i < 2; ++i) { int R, C; stage_rc(tid * 16 + i * 8192, R, C); const int Rb = EpiT::PERM ? ((R & ~31) + perm32(R & 31)) : R;
        voffA[i] = (unsigned)(R * K + C) * 2u; voffB[i] = (unsigned)(Rb * K + C) * 2u; }
    const size_t kstep = (size_t)(BK * 2);
    const size_t hstep = (size_t)HALF * K * 2;
    const size_t tstep = 2 * hstep;
    const unsigned ldsw = (unsigned)wid * 1024u;
    const int aoff = lds_byte(wr * 64 + fr, fq * 8), boff = lds_byte(wc * 32 + fr, fq * 8);
#define PG8_SA(b, h) (((b) * 2 + (h)) * HTB)
#define PG8_SB(b, h) ((4 + (b) * 2 + (h)) * HTB)
#define PG8_STAGE(bufoff, gbase, voff) do { _Pragma("unroll") for (int _i = 0; _i < 2; ++_i) \
        __builtin_amdgcn_global_load_lds((const unsigned*)((const char*)(gbase) + (voff)[_i]), (LAS unsigned*)(lds + (bufoff) + ldsw + _i * 8192), 16, 0, 0); } while (0)
#define PG8_LDA(dst, b, h) do { _Pragma("unroll") for (int m = 0; m < 4; ++m) _Pragma("unroll") for (int k = 0; k < 2; ++k) dst[m][k] = *(const LAS bf16x8*)(lds + PG8_SA(b, h) + aoff + m * 2048 + k * 1024); } while (0)
#define PG8_LDB(dst, b, h) do { _Pragma("unroll") for (int n = 0; n < 2; ++n) _Pragma("unroll") for (int k = 0; k < 2; ++k) dst[n][k] = *(const LAS bf16x8*)(lds + PG8_SB(b, h) + boff + n * 2048 + k * 1024); } while (0)
#define PG8_MMA(ai, bj, At, Bt) do { __builtin_amdgcn_s_setprio(1); _Pragma("unroll") for (int m = 0; m < 4; ++m) _Pragma("unroll") for (int n = 0; n < 2; ++n) _Pragma("unroll") for (int k = 0; k < 2; ++k) \
        acc[ai][bj][m][n] = __builtin_amdgcn_mfma_f32_16x16x32_bf16(Bt[n][k], At[m][k], acc[ai][bj][m][n], 0, 0, 0); __builtin_amdgcn_s_setprio(0); } while (0)
#define PG8_WAIT_V(n) asm volatile("s_waitcnt vmcnt(" #n ")" ::: "memory")
#define PG8_WAIT_L(n) asm volatile("s_waitcnt lgkmcnt(" #n ")" ::: "memory")
#define PG8_BAR __builtin_amdgcn_s_barrier()
#define PG8_SCHED __builtin_amdgcn_sched_barrier(0)
    Unit cur, nxt; int ui = 0;
    if (!S.next(0, cur)) return;
    f32x4 acc[2][2][4][2];
#pragma unroll
    for (int a = 0; a < 2; ++a)
#pragma unroll
        for (int b = 0; b < 2; ++b)
#pragma unroll
            for (int m = 0; m < 4; ++m)
#pragma unroll
                for (int n = 0; n < 2; ++n) acc[a][b][m][n] = (f32x4){0.f, 0.f, 0.f, 0.f};
    bf16x8 At[4][2], B0[2][2], B1[2][2];
    const char* cA = a_of(g, cur.pn) + (size_t)cur.pm * tstep + (size_t)cur.kofs * 2; const char* cB = (const char*)g.Bt + (size_t)cur.pn * tstep + (size_t)cur.kofs * 2;
    PG8_STAGE(PG8_SB(0, 0), cB, voffB); PG8_STAGE(PG8_SB(0, 1), cB + hstep, voffB); PG8_STAGE(PG8_SA(0, 0), cA, voffA); PG8_STAGE(PG8_SA(0, 1), cA + hstep, voffA);
    if (wr == 1) PG8_BAR;
    PG8_WAIT_V(2); PG8_BAR;
    PG8_STAGE(PG8_SB(1, 0), cB + kstep, voffB); PG8_STAGE(PG8_SA(1, 0), cA + kstep, voffA); PG8_STAGE(PG8_SB(1, 1), cB + hstep + kstep, voffB);
    PG8_WAIT_V(6); PG8_BAR;
    for (;;) {
        const bool has_next = S.next(ui + 1, nxt);
        const char* nA = has_next ? a_of(g, nxt.pn) + (size_t)nxt.pm * tstep + (size_t)nxt.kofs * 2 : cA; const char* nB = has_next ? (const char*)g.Bt + (size_t)nxt.pn * tstep + (size_t)nxt.kofs * 2 : cB;
        const int nt = cur.knt;
        for (int t = 0; t < nt; t += 2) {
            const bool last = (t == nt - 2);
            const char* a1 = cA + (size_t)(t + 1) * kstep;
            const char* a2 = last ? nA : cA + (size_t)(t + 2) * kstep; const char* b2 = last ? nB : cB + (size_t)(t + 2) * kstep;
            const char* a3 = a2 + kstep; const char* b3 = b2 + kstep;
            PG8_LDB(B0, 0, 0); PG8_LDB(B1, 0, 1); PG8_SCHED; PG8_LDA(At, 0, 0); PG8_STAGE(PG8_SA(1, 1), a1 + hstep, voffA);
            PG8_WAIT_V(8); PG8_WAIT_L(0); PG8_BAR; PG8_MMA(0, 0, At, B0); PG8_MMA(0, 1, At, B1); PG8_BAR; PG8_SCHED;
            PG8_LDA(At, 0, 1); PG8_STAGE(PG8_SB(0, 0), b2, voffB); PG8_STAGE(PG8_SB(0, 1), b2 + hstep, voffB); PG8_STAGE(PG8_SA(0, 0), a2, voffA);
            PG8_WAIT_V(8); PG8_WAIT_L(0); PG8_BAR; PG8_MMA(1, 0, At, B0); PG8_MMA(1, 1, At, B1); PG8_BAR; PG8_SCHED;
            PG8_LDB(B0, 1, 0); PG8_LDB(B1, 1, 1); PG8_SCHED; PG8_LDA(At, 1, 0); PG8_STAGE(PG8_SA(0, 1), a2 + hstep, voffA);
            PG8_WAIT_V(8); PG8_WAIT_L(0); PG8_BAR; PG8_MMA(0, 0, At, B0); PG8_MMA(0, 1, At, B1); PG8_BAR; PG8_SCHED;
            PG8_LDA(At, 1, 1); PG8_STAGE(PG8_SB(1, 0), b3, voffB); PG8_STAGE(PG8_SB(1, 1), b3 + hstep, voffB); PG8_STAGE(PG8_SA(1, 0), a3, voffA);
            PG8_WAIT_V(8); PG8_WAIT_L(0); PG8_BAR; PG8_MMA(1, 0, At, B0); PG8_MMA(1, 1, At, B1); PG8_BAR; PG8_SCHED;
        }
        if (wr == 0) PG8_BAR;
        E(acc, cur, wr, wc, fr, fq);
        if (!has_next) break;
#pragma unroll
        for (int a = 0; a < 2; ++a)
#pragma unroll
            for (int b = 0; b < 2; ++b)
#pragma unroll
                for (int m = 0; m < 4; ++m)
#pragma unroll
                    for (int n = 0; n < 2; ++n) acc[a][b][m][n] = (f32x4){0.f, 0.f, 0.f, 0.f};
        cur = nxt; cA = nA; cB = nB; ++ui;
        if (wr == 1) PG8_BAR;
    }
    PG8_WAIT_V(0);
    PG8_BAR;
#undef PG8_SA
#undef PG8_SB
#undef PG8_STAGE
#undef PG8_LDA
#undef PG8_LDB
#undef PG8_MMA
#undef PG8_WAIT_V
#undef PG8_WAIT_L
#undef PG8_BAR
#undef PG8_SCHED
}
}

__device__ __forceinline__ void store8bf(bf16_t* p, f32x4 a, f32x4 b) {
    u32x4 w; w.x = cvt_pk_bf16(a[0], a[1]); w.y = cvt_pk_bf16(a[2], a[3]); w.z = cvt_pk_bf16(b[0], b[1]); w.w = cvt_pk_bf16(b[2], b[3]);
    *(u32x4*)p = w;
}
__device__ __forceinline__ const float* xin_row(const float* xp, const float* xs, int row) { return row < MPROMPT ? xp + (size_t)row * DM : xs + (size_t)(row - MPROMPT) * DM; }
struct FRes { float* X; float* PART; const float* xin_p; const float* xin_s;
    __device__ __forceinline__ void operator()(int row, int col, f32x4 a, f32x4 b, int split) const {
        float* p = X + (size_t)row * DM + col;
        if (split) { float* q = PART + (size_t)(split - 1) * 65536 + (row & 255) * 256 + (col & 255); *(f32x4*)q = a; *(f32x4*)(q + 4) = b; }
        else { const float* bp = xin_p ? xin_row(xin_p, xin_s, row) + col : p; f32x4 x0 = *(const f32x4*)bp, x1 = *(const f32x4*)(bp + 4); *(f32x4*)p = x0 + a; *(f32x4*)(p + 4) = x1 + b; } } };
struct FR1 { bf16_t *R, *K, *V, *L;
    __device__ __forceinline__ void operator()(int row, int col, f32x4 a, f32x4 b, int) const {
        if (col < 6144) { const int g = col >> 11; const size_t o = (size_t)row * DM + (col & 2047); if (g == 0) store8bf(R + o, a, b); else if (g == 1) store8bf(K + o, a, b); else store8bf(V + o, a, b); }
        else { const int t = (col - 6144) >> 8, c = col & 255;
            if (t == 0) { for (int i = 0; i < 4; ++i) { a[i] = 1.f - 2.f / (1.f + __expf(2.f * a[i])); b[i] = 1.f - 2.f / (1.f + __expf(2.f * b[i])); } }
            else if (t == 2) { for (int i = 0; i < 4; ++i) { a[i] = sigmoidf_(a[i]); b[i] = sigmoidf_(b[i]); } }
            store8bf(L + (size_t)t * MROWS * 256 + (size_t)row * 256 + c, a, b); } } };
__device__ __forceinline__ float decay_of(float z) { return -0.60653065971f / (1.f + __expf(-z)); }
struct FR2 { float* DD; bf16_t *AA, *GG, *VG; const float *w0, *a0, *v0;
    __device__ __forceinline__ void operator()(int row, int col, f32x4 a, f32x4 b, int) const {
        const int g = col >> 11, c = col & 2047; const size_t off = (size_t)row * DM + c;
        if (g == 0) { f32x4 z0 = *(const f32x4*)(w0 + c), z1 = *(const f32x4*)(w0 + c + 4); a += z0; b += z1;
            for (int i = 0; i < 4; ++i) { a[i] = decay_of(a[i]); b[i] = decay_of(b[i]); }
            *(f32x4*)(DD + off) = a; *(f32x4*)(DD + off + 4) = b; }
        else if (g == 1) { f32x4 z0 = *(const f32x4*)(a0 + c), z1 = *(const f32x4*)(a0 + c + 4); a += z0; b += z1;
            for (int i = 0; i < 4; ++i) { a[i] = sigmoidf_(a[i]); b[i] = sigmoidf_(b[i]); } store8bf(AA + off, a, b); }
        else if (g == 2) { store8bf(GG + off, a, b); }
        else { f32x4 z0 = *(const f32x4*)(v0 + c), z1 = *(const f32x4*)(v0 + c + 4); a += z0; b += z1;
            for (int i = 0; i < 4; ++i) { a[i] = sigmoidf_(a[i]); b[i] = sigmoidf_(b[i]); } store8bf(VG + off, a, b); } } };
struct FG1 { bf16_t* PROJ; float* LR;
    __device__ __forceinline__ void operator()(int row, int col, f32x4 a, f32x4 b, int) const {
        if (col < 6144) { if (col < 1024) { a *= 0.0625f; b *= 0.0625f; } store8bf(PROJ + (size_t)row * 6144 + col, a, b); }
        else if (col < 6160) { float* p = LR + (size_t)row * 16 + (col - 6144); *(f32x4*)p = a; *(f32x4*)(p + 4) = b; } } };
struct FUp { bf16_t* U; float* pconv; float* sconv;
    __device__ __forceinline__ void operator()(int row, int col, f32x4 a, f32x4 b, int) const {
        store8bf(U + (size_t)row * F2 + col, a, b);
        if (row < MPROMPT) { const int t = row & 8191; if (t >= 8190) { float* p = pconv + ((size_t)((row >> 13) * 2 + (t - 8190))) * F2 + col; *(f32x4*)p = a; *(f32x4*)(p + 4) = b; } }
        else { const int rr = row - MPROMPT, t = rr & 63; if (t >= 62) { float* p = sconv + ((size_t)((rr >> 6) * 2 + (t - 62))) * F2 + col; *(f32x4*)p = a; *(f32x4*)(p + 4) = b; } } } };

__device__ __forceinline__ void tr_item(const float* W, int K, int N, bf16_t* WT, int Kpad, int Npad, float* scr, int item, int lane) {
    const int nblk = Npad / 64, kb = item / nblk, nb = item % nblk, k0 = 64 * kb, n0 = 64 * nb;
    const int n4 = n0 + (lane & 15) * 4;
    f32x4 v[16];
#pragma unroll
    for (int i = 0; i < 16; ++i) { const int k = k0 + 4 * i + (lane >> 4); v[i] = (k < K && n4 < N) ? *(const f32x4*)(W + (size_t)k * N + n4) : (f32x4){0.f, 0.f, 0.f, 0.f}; }
#pragma unroll
    for (int i = 0; i < 16; ++i) { float* d = scr + (4 * i + (lane >> 4)) * 65 + (lane & 15) * 4; d[0] = v[i][0]; d[1] = v[i][1]; d[2] = v[i][2]; d[3] = v[i][3]; }
    asm volatile("s_waitcnt lgkmcnt(0)" ::: "memory");
    const int c = lane & 7;
#pragma unroll
    for (int j = 0; j < 8; ++j) { const int nn = (lane >> 3) + 8 * j; const float* s = scr + (8 * c) * 65 + nn;
        u32x4 o; o.x = cvt_pk_bf16(s[0 * 65], s[1 * 65]); o.y = cvt_pk_bf16(s[2 * 65], s[3 * 65]); o.z = cvt_pk_bf16(s[4 * 65], s[5 * 65]); o.w = cvt_pk_bf16(s[6 * 65], s[7 * 65]);
        *(u32x4*)(WT + (size_t)(n0 + nn) * Kpad + k0 + 8 * c) = o; }
    asm volatile("s_waitcnt lgkmcnt(0)" ::: "memory");
}

struct P { const float* in[39]; float* out; unsigned char* ws; };

__device__ __forceinline__ void row_info(int row, int& t, int& len, int& b, bool& prompt) {
    if (row < MPROMPT) { prompt = true; b = row >> 13; t = row & 8191; len = 8192; }
    else { prompt = false; const int rr = row - MPROMPT; b = rr >> 6; t = rr & 63; len = 64; }
}

__device__ __forceinline__ const float* ldp(const unsigned long long* tab, int i) {
    const unsigned long long v = tab[i];
    const unsigned lo = __builtin_amdgcn_readfirstlane((unsigned)v), hi = __builtin_amdgcn_readfirstlane((unsigned)(v >> 32));
    const __attribute__((address_space(1))) float* g = (const __attribute__((address_space(1))) float*)(((unsigned long long)hi << 32) | lo);
    return (const float*)g;
}
__device__ __forceinline__ void fast_grid_barrier(unsigned* bar, unsigned long long* tab) {
    asm volatile("s_waitcnt vmcnt(0)" ::: "memory");
    __syncthreads();
    if (threadIdx.x == 0) {
        const unsigned G = gridDim.x, grp = blockIdx.x & 7u;
        const unsigned epoch = (unsigned)tab[41] + 1u; tab[41] = epoch;
        const unsigned ngrp = (G - grp + 7u) >> 3, ntop = G < 8u ? G : 8u;
        __builtin_amdgcn_fence(__ATOMIC_RELEASE, "agent");
        asm volatile("s_waitcnt vmcnt(0)" ::: "memory");
        const unsigned old = __hip_atomic_fetch_add(&bar[64u * (1u + grp)], 1u, __ATOMIC_RELAXED, __HIP_MEMORY_SCOPE_AGENT);
        if (old + 1u == epoch * ngrp) (void)__hip_atomic_fetch_add(&bar[0], 1u, __ATOMIC_RELAXED, __HIP_MEMORY_SCOPE_AGENT);
        while (__hip_atomic_load(&bar[0], __ATOMIC_RELAXED, __HIP_MEMORY_SCOPE_AGENT) < epoch * ntop) __builtin_amdgcn_s_sleep(1);
        __builtin_amdgcn_fence(__ATOMIC_ACQUIRE, "agent");
        asm volatile("s_waitcnt vmcnt(0)" ::: "memory");
    }
    __syncthreads();
}
#define IN(k) ldp(tab, (k))
#define OUTP ((float*)ldp(tab, 39))
#define BASES float* X = (float*)ldp(tab, 39); unsigned char* ws_ = (unsigned char*)ldp(tab, 40); bf16_t* WT = (bf16_t*)(ws_ + WS_WT); unsigned char* RA = ws_ + WS_A; unsigned char* RB = ws_ + WS_B; \
    bf16_t* VFIRST = (bf16_t*)(ws_ + WS_VF); LAS unsigned char* ldsl = (LAS unsigned char*)lds; (void)X; (void)WT; (void)RA; (void)RB; (void)VFIRST; (void)ldsl;
#define RWKV_PTRS bf16_t* HB = (bf16_t*)RA; bf16_t* Rb = (bf16_t*)RB; bf16_t* Kb = Rb + ACT; bf16_t* Vb = (jl == 0) ? VFIRST : Kb + ACT; bf16_t* Lb = (bf16_t*)(RB + 204 * MiB); \
    float* DD = (float*)(RB + 240 * MiB); bf16_t* AA = (bf16_t*)RA; bf16_t* VG = AA + ACT; bf16_t* GG = VG + ACT; bf16_t* Y = GG + ACT; \
    bf16_t* W1 = WT + jl * RW_SZ; bf16_t* W2 = W1 + (size_t)7168 * 2048; bf16_t* WO = W2 + (size_t)8192 * 256; \
    (void)HB; (void)Rb; (void)Kb; (void)Vb; (void)Lb; (void)DD; (void)AA; (void)VG; (void)GG; (void)Y; (void)W1; (void)W2; (void)WO;
#define GLA_PTRS bf16_t* H = (bf16_t*)RB; float* LR = (float*)(RB + 68 * MiB); float* O = (float*)(RB + 70 * MiB); bf16_t* Y = (bf16_t*)(RB + 206 * MiB); \
    bf16_t* PROJ = (bf16_t*)RA; bf16_t* QE = (bf16_t*)(RA + 204 * MiB); bf16_t* KDT = (bf16_t*)(RA + 238 * MiB); bf16_t* VT = (bf16_t*)(RA + 272 * MiB); \
    bf16_t* SC = (bf16_t*)(RA + 340 * MiB); float* EL = (float*)(RA + 349 * MiB); bf16_t* GI = WT + GW_OFF + jl * GW_SZ; bf16_t* GO = GI + (size_t)6400 * 2048; \
    (void)H; (void)LR; (void)O; (void)Y; (void)PROJ; (void)QE; (void)KDT; (void)VT; (void)SC; (void)EL; (void)GI; (void)GO;
#define FFN_PTRS bf16_t* H = (bf16_t*)RB; bf16_t* HID = (bf16_t*)(RB + 68 * MiB); bf16_t* U = (bf16_t*)RA; bf16_t* WU = WT + FW_OFF + layer * FW_SZ; bf16_t* WD = WU + (size_t)F2 * 2048; \
    (void)H; (void)HID; (void)U; (void)WU; (void)WD;

__global__ void __launch_bounds__(512, 2) fwd_kernel(P p) {
    extern __shared__ __attribute__((aligned(16))) unsigned char lds[];
    cg::grid_group grid = cg::this_grid();
    const int G = gridDim.x, NGW = G * 8, NT = G * 512;
#define PHASE_IDS int tid = threadIdx.x; asm volatile("" : "+v"(tid)); const int lane = tid & 63; const int wave = __builtin_amdgcn_readfirstlane(tid >> 6); const int gw = blockIdx.x * 8 + wave; const int gtid = blockIdx.x * 512 + tid; (void)lane; (void)gw; (void)gtid;
    unsigned long long* tab = (unsigned long long*)(lds + LDS_BYTES - 512);
    if (threadIdx.x == 0) {
#pragma unroll
        for (int i = 0; i < 39; ++i) tab[i] = (unsigned long long)p.in[i];
        tab[39] = (unsigned long long)p.out; tab[40] = (unsigned long long)p.ws; tab[41] = 0ull;
    }
    __syncthreads();

    {
        PHASE_IDS BASES
        if (blockIdx.x == 0) { for (int i = tid; i < 1024; i += 512) ((unsigned*)ws_)[i] = 0u; }
        float* scr = (float*)(lds + wave * 16896);
#define TR(src, K, N, dst, Kpad, Npad) do { const int _ni = ((Kpad) / 64) * ((Npad) / 64); for (int it = cgw_; it < _ni; it += cngw_) tr_item((src), (K), (N), (dst), (Kpad), (Npad), scr, it, lane); } while (0)
#define CONVERT_WEIGHTS(JLO, JHI, ILO, IHI, GWV, NGWV) do { const int cgw_ = (GWV), cngw_ = (NGWV); \
        _Pragma("unroll 1") for (int j = (JLO); j < (JHI); ++j) { \
            bf16_t* W1 = WT + j * RW_SZ; bf16_t* W2 = W1 + (size_t)7168 * 2048; bf16_t* WO = W2 + (size_t)8192 * 256; \
            TR(IN(24) + (size_t)j * DM * DM, 2048, 2048, W1, 2048, 2048); \
            TR(IN(25) + (size_t)j * DM * DM, 2048, 2048, W1 + (size_t)2048 * 2048, 2048, 2048); \
            TR(IN(26) + (size_t)j * DM * DM, 2048, 2048, W1 + (size_t)4096 * 2048, 2048, 2048); \
            TR(IN(11) + (size_t)j * DM * 96, 2048, 96, W1 + (size_t)6144 * 2048, 2048, 256); \
            TR(IN(14) + (size_t)j * DM * 96, 2048, 96, W1 + (size_t)6400 * 2048, 2048, 256); \
            TR(IN(19) + (size_t)j * DM * 256, 2048, 256, W1 + (size_t)6656 * 2048, 2048, 256); \
            if (j >= 1) TR(IN(17) + (size_t)(j - 1) * DM * 64, 2048, 64, W1 + (size_t)6912 * 2048, 2048, 256); \
            TR(IN(12) + (size_t)j * 96 * DM, 96, 2048, W2, 256, 2048); \
            TR(IN(15) + (size_t)j * 96 * DM, 96, 2048, W2 + (size_t)2048 * 256, 256, 2048); \
            TR(IN(20) + (size_t)j * 256 * DM, 256, 2048, W2 + (size_t)4096 * 256, 256, 2048); \
            if (j >= 1) TR(IN(18) + (size_t)(j - 1) * 64 * DM, 64, 2048, W2 + (size_t)6144 * 256, 256, 2048); \
            TR(IN(27) + (size_t)j * DM * DM, 2048, 2048, WO, 2048, 2048); \
            bf16_t* GI = WT + GW_OFF + j * GW_SZ; bf16_t* GO = GI + (size_t)6400 * 2048; \
            TR(IN(30) + (size_t)j * DM * 6160, 2048, 6160, GI, 2048, 6400); \
            TR(IN(34) + (size_t)j * DM * DM, 2048, 2048, GO, 2048, 2048); \
        } \
        _Pragma("unroll 1") for (int i = (ILO); i < (IHI); ++i) { \
            bf16_t* WU = WT + FW_OFF + i * FW_SZ; bf16_t* WD = WU + (size_t)F2 * 2048; \
            TR(IN(35) + (size_t)i * DM * F2, 2048, F2, WU, 2048, F2); \
            TR(IN(38) + (size_t)i * FH * DM, FH, 2048, WD, FH, 2048); \
        } } while (0)
        if (G >= 256) CONVERT_WEIGHTS(0, 1, 0, 2, gw, NGW); else CONVERT_WEIGHTS(0, 2, 0, 4, gw, NGW);
    }
    grid.sync();

#pragma clang loop unroll(full)
    for (int layer = 0; layer < 4; ++layer) {
        const int jl = layer >> 1;
        if ((layer & 1) == 0) {
            {
                PHASE_IDS BASES RWKV_PTRS
                const float* gmix = IN(6) + (size_t)layer * DM;
                const float* mix = IN(9) + (size_t)jl * 6 * DM;
                const float* sst = IN(2) + (size_t)jl * 16 * DM;
                const float* xin0 = IN(0); const float* xin1 = IN(1);
                float* mixS = (float*)lds; float* gS = mixS + 6 * DM;
                for (int i = tid; i < 6 * DM / 4; i += 512) *(f32x4*)(mixS + i * 4) = *(const f32x4*)(mix + i * 4);
                for (int i = tid; i < DM / 4; i += 512) *(f32x4*)(gS + i * 4) = *(const f32x4*)(gmix + i * 4);
                __syncthreads();
                for (int row = gw; row < MROWS; row += NGW) {
                    int t, len, b; bool prompt; row_info(row, t, len, b, prompt);
                    const f32x4* xr = (const f32x4*)(layer == 0 ? xin_row(xin0, xin1, row) : X + (size_t)row * DM) + lane;
                    f32x4 x[8]; float ss = 0.f;
#pragma unroll
                    for (int q = 0; q < 8; ++q) { x[q] = xr[64 * q]; ss += x[q][0] * x[q][0] + x[q][1] * x[q][1] + x[q][2] * x[q][2] + x[q][3] * x[q][3]; }
                    const float rs = rsqrtf(wave_sum(ss, lane) * (1.f / DM) + 1e-6f);
                    f32x4 hp[8];
                    if (t > 0) {
                        const f32x4* xq = (const f32x4*)(layer == 0 ? xin_row(xin0, xin1, row - 1) : X + (size_t)(row - 1) * DM) + lane; float s2 = 0.f;
#pragma unroll
                        for (int q = 0; q < 8; ++q) { hp[q] = xq[64 * q]; s2 += hp[q][0] * hp[q][0] + hp[q][1] * hp[q][1] + hp[q][2] * hp[q][2] + hp[q][3] * hp[q][3]; }
                        const float rp = rsqrtf(wave_sum(s2, lane) * (1.f / DM) + 1e-6f);
#pragma unroll
                        for (int q = 0; q < 8; ++q) { const f32x4 gg = *((const f32x4*)gS + lane + 64 * q); hp[q] = hp[q] * rp * gg; }
                    } else if (!prompt) {
#pragma unroll
                        for (int q = 0; q < 8; ++q) hp[q] = *((const f32x4*)(sst + (size_t)b * DM) + lane + 64 * q);
                    } else {
#pragma unroll
                        for (int q = 0; q < 8; ++q) hp[q] = (f32x4){0.f, 0.f, 0.f, 0.f};
                    }
                    const bool lastrow = (t == len - 1);
                    float* shout = OUTP + (prompt ? O_PSHIFT + ((size_t)jl * 2 + b) * DM : O_SSHIFT + ((size_t)jl * 16 + b) * DM);
#pragma unroll
                    for (int q = 0; q < 8; ++q) {
                        const f32x4 gg = *((const f32x4*)gS + lane + 64 * q);
                        const f32x4 h = x[q] * rs * gg; const f32x4 dlt = hp[q] - h;
                        if (lastrow) *((f32x4*)shout + lane + 64 * q) = h;
#pragma unroll
                        for (int m = 0; m < 6; ++m) {
                            const f32x4 mx = *((const f32x4*)(mixS + m * DM) + lane + 64 * q);
                            const f32x4 o = h + dlt * mx;
                            u32x2 w; w.x = cvt_pk_bf16(o[0], o[1]); w.y = cvt_pk_bf16(o[2], o[3]);
                            *((u32x2*)(HB + (size_t)m * ACT + (size_t)row * DM) + lane + 64 * q) = w;
                        }
                    }
                }
            }
            fast_grid_barrier((unsigned*)ldp(tab, 40), tab);
            {
                BASES RWKV_PTRS
                pg8::Gemm g{HB, W1, MROWS, jl == 0 ? 6912 : 7168, 2048, 1, ACT * 2};
                pg8::StaticOrder S; S.init(g.M, g.N, G, (int)blockIdx.x, g.K, 1);
                pg8::Epi<FR1> E{FR1{Rb, Kb, Vb, Lb}};
                pg8::gemm_phase(ldsl, g, S, E);
            }
            fast_grid_barrier((unsigned*)ldp(tab, 40), tab);
            {
                BASES RWKV_PTRS
                pg8::Gemm g{Lb, W2, MROWS, jl == 0 ? 6144 : 8192, 256, 2, (size_t)MROWS * 256 * 2};
                pg8::StaticOrder S; S.init(g.M, g.N, G, (int)blockIdx.x, g.K, 1);
                pg8::Epi<FR2> E{FR2{DD, AA, GG, VG, IN(10) + (size_t)jl * DM, IN(13) + (size_t)jl * DM, IN(16) + (size_t)(jl > 0 ? jl - 1 : 0) * DM}};
                pg8::gemm_phase(ldsl, g, S, E);
            }
            fast_grid_barrier((unsigned*)ldp(tab, 40), tab);
            {
                PHASE_IDS BASES RWKV_PTRS
                float* Obuf = (float*)(RA + 272 * MiB); float* RK = (float*)(RB + 204 * MiB); float* DTg = (float*)(RB + 208 * MiB);
                const float* k_k = IN(21) + (size_t)jl * DM; const float* k_a = IN(22) + (size_t)jl * DM; const float* r_k = IN(23) + (size_t)jl * DM;
                const int l32 = lane & 31, hl = lane >> 5;
#define S1_BAR do { asm volatile("s_waitcnt lgkmcnt(0)" ::: "memory"); __builtin_amdgcn_s_barrier(); asm volatile("" ::: "memory"); } while (0)
                const int st = tid >> 3, c0 = (tid & 7) * 8;
                u32x4 pr_, pk_, pv_, pa_, pvf_ = (u32x4){0u, 0u, 0u, 0u}, pvg_ = (u32x4){0u, 0u, 0u, 0u}; f32x4 pd0_, pd1_;
#define S1_FETCH(it) do { const size_t _off = (size_t)(((it) >> 5) * 64 + st) * DM + ((it) & 31) * 64 + c0; \
                    pr_ = *(const u32x4*)(Rb + _off); pk_ = *(const u32x4*)(Kb + _off); pv_ = *(const u32x4*)(Vb + _off); pa_ = *(const u32x4*)(AA + _off); \
                    pd0_ = *(const f32x4*)(DD + _off); pd1_ = *(const f32x4*)(DD + _off + 4); \
                    if (jl > 0) { pvf_ = *(const u32x4*)(VFIRST + _off); pvg_ = *(const u32x4*)(VG + _off); } } while (0)
                if ((int)blockIdx.x < 8704) S1_FETCH((int)blockIdx.x);
#pragma unroll 1
                for (int item = blockIdx.x; item < 8704; item += G) {
                    LAS unsigned char* ldsv = (LAS unsigned char*)lds; asm volatile("" : "+v"(ldsv));
                    LAS bf16_t* AH = (LAS bf16_t*)(ldsv + 0); LAS bf16_t* RH = (LAS bf16_t*)(ldsv + 9216); LAS bf16_t* BH = (LAS bf16_t*)(ldsv + 18432); LAS bf16_t* KH = (LAS bf16_t*)(ldsv + 27648);
                    LAS bf16_t* BHT = (LAS bf16_t*)(ldsv + 36864); LAS bf16_t* KHT = (LAS bf16_t*)(ldsv + 46080); LAS bf16_t* VTs = (LAS bf16_t*)(ldsv + 55296); LAS bf16_t* XT = (LAS bf16_t*)(ldsv + 64512);
                    LAS float* AAB = (LAS float*)(ldsv + 82944); LAS bf16_t* AAK = (LAS bf16_t*)(ldsv + 99328); LAS bf16_t* ARB = (LAS bf16_t*)(ldsv + 108544); LAS bf16_t* ARK = (LAS bf16_t*)(ldsv + 117760);
                    LAS float* LB = (LAS float*)(ldsv + 126976); LAS float* DTS = (LAS float*)(ldsv + 143360);
                    (void)RH; (void)KH; (void)KHT;
                    const int chunk = item >> 5, h = item & 31, r0 = chunk * 64;
                    const int col = h * 64 + c0;
                    float r[8], kk[8], bb[8], km[8], ld[8];
                    {
                        float k[8], v[8], a[8];
                        unpack8(pr_, r); unpack8(pk_, k); unpack8(pv_, v); unpack8(pa_, a);
                        const f32x4 d0 = pd0_, d1 = pd1_;
                        ld[0] = d0[0]; ld[1] = d0[1]; ld[2] = d0[2]; ld[3] = d0[3]; ld[4] = d1[0]; ld[5] = d1[1]; ld[6] = d1[2]; ld[7] = d1[3];
                        if (jl > 0) { float vf[8], vg[8]; unpack8(pvf_, vf); unpack8(pvg_, vg);
#pragma unroll
                            for (int i = 0; i < 8; ++i) v[i] = v[i] + (vf[i] - v[i]) * vg[i]; }
                        float ss = 0.f;
#pragma unroll
                        for (int i = 0; i < 8; ++i) { kk[i] = k[i] * k_k[col + i]; ss += kk[i] * kk[i]; }
                        ss = sum8(ss, lane);
                        const float inv = 1.f / fmaxf(sqrtf(ss), 1e-12f);
                        float rk = 0.f;
#pragma unroll
                        for (int i = 0; i < 8; ++i) { kk[i] *= inv; bb[i] = kk[i] * a[i]; km[i] = k[i] * (1.f + (a[i] - 1.f) * k_a[col + i]); rk += r[i] * km[i] * r_k[col + i]; }
                        rk = sum8(rk, lane);
                        if ((tid & 7) == 0) RK[(size_t)(r0 + st) * 32 + h] = rk;
                        *(LAS f32x4*)(LB + st * 64 + c0) = d0; *(LAS f32x4*)(LB + st * 64 + c0 + 4) = d1;
#pragma unroll
                        for (int i = 0; i < 8; i += 2) { const unsigned pk = cvt_pk_bf16(v[i], v[i + 1]); VTs[(c0 + i) * 72 + st] = (bf16_t)(pk & 0xffffu); VTs[(c0 + i + 1) * 72 + st] = (bf16_t)(pk >> 16); }
                    }
                    S1_BAR;
                    {
                        const int cc_ = tid & 63, tq_ = tid >> 6; float pf[8]; float run = 0.f;
#pragma unroll
                        for (int j = 0; j < 8; ++j) { run += LB[(8 * tq_ + j) * 64 + cc_]; pf[j] = run; }
                        AAB[tq_ * 64 + cc_] = run;
                        S1_BAR;
                        float ofs = 0.f;
#pragma unroll
                        for (int g = 0; g < 7; ++g) ofs += (g < tq_) ? AAB[g * 64 + cc_] : 0.f;
#pragma unroll
                        for (int j = 0; j < 8; ++j) LB[(8 * tq_ + j) * 64 + cc_] = pf[j] + ofs;
                    }
                    S1_BAR;
                    {
                        float ah[8], bh[8], kh[8], rh[8];
#pragma unroll
                        for (int i = 0; i < 8; ++i) { const float Lt = LB[st * 64 + c0 + i]; const float e3 = __expf(Lt), e2 = __expf(-Lt), e1 = __expf(Lt - ld[i]);
                            ah[i] = -kk[i] * e1; bh[i] = bb[i] * e2; kh[i] = km[i] * e2; rh[i] = r[i] * e3;
                            if (st == 63) { DTS[c0 + i] = e3; DTg[(size_t)item * 64 + c0 + i] = e3; } }
                        *(LAS u32x4*)(AH + st * 72 + c0) = pack8(ah); *(LAS u32x4*)(RH + st * 72 + c0) = pack8(rh);
                        *(LAS u32x4*)(BH + st * 72 + c0) = pack8(bh); *(LAS u32x4*)(KH + st * 72 + c0) = pack8(kh);
#pragma unroll
                        for (int i = 0; i < 8; i += 2) { const unsigned p1 = cvt_pk_bf16(bh[i], bh[i + 1]), p2 = cvt_pk_bf16(kh[i], kh[i + 1]);
                            BHT[(c0 + i) * 72 + st] = (bf16_t)(p1 & 0xffffu); BHT[(c0 + i + 1) * 72 + st] = (bf16_t)(p1 >> 16);
                            KHT[(c0 + i) * 72 + st] = (bf16_t)(p2 & 0xffffu); KHT[(c0 + i + 1) * 72 + st] = (bf16_t)(p2 >> 16); }
                    }
                    S1_BAR;
                    {
                        const int mi = wave & 3, rowsel = mi >> 1, tt = mi & 1;
#pragma unroll
                        for (int nn = 0; nn < 2; ++nn) {
                            const int colsel = wave >> 2, stl = nn; const int ni = 2 * colsel + nn;
                            f32x16 acc;
#pragma unroll
                            for (int i = 0; i < 16; ++i) acc[i] = 0.f;
                            if (stl <= tt) {
#pragma unroll
                                for (int ks = 0; ks < 4; ++ks) {
                                    const bf16x8 a = *(const LAS bf16x8*)(AH + (mi * 32 + l32) * 72 + ks * 16 + hl * 8);
                                    const bf16x8 b = *(const LAS bf16x8*)(BH + (ni * 32 + l32) * 72 + ks * 16 + hl * 8);
                                    acc = __builtin_amdgcn_mfma_f32_32x32x16_bf16(a, b, acc, 0, 0, 0);
                                }
                            }
#pragma unroll
                            for (int i = 0; i < 16; ++i) {
                                const int t = tt * 32 + crow(i, hl), s = stl * 32 + l32;
                                const bool keep = rowsel ? (s <= t) : (s < t);
                                const float val = keep ? acc[i] : 0.f;
                                if (rowsel == 0 && colsel == 0) AAB[t * 64 + s] = val;
                                else { LAS bf16_t* dst = (rowsel == 0) ? AAK : (colsel == 0 ? ARB : ARK); dst[t * 72 + s] = (bf16_t)(cvt_pk_bf16(val, 0.f) & 0xffffu); }
                            }
                        }
                    }
                    S1_BAR;
                    if (wave < 4) {
                        const int mt = wave >> 1, nt = wave & 1;
                        f32x16 acc;
#pragma unroll
                        for (int i = 0; i < 16; ++i) acc[i] = 0.f;
#pragma unroll
                        for (int ks = 0; ks < 4; ++ks) {
                            const bf16x8 a = *(const LAS bf16x8*)(AAK + (mt * 32 + l32) * 72 + ks * 16 + hl * 8);
                            const bf16x8 b = *(const LAS bf16x8*)(VTs + (nt * 32 + l32) * 72 + ks * 16 + hl * 8);
                            acc = __builtin_amdgcn_mfma_f32_32x32x16_bf16(a, b, acc, 0, 0, 0);
                        }
#pragma unroll
                        for (int i = 0; i < 16; ++i) LB[(mt * 32 + crow(i, hl)) * 64 + nt * 32 + l32] = acc[i];
                    }
                    S1_BAR;
                    {
                        const int colx = tid >> 2, par = tid & 3;
                        float Xp[4][4];
#pragma unroll
                        for (int i = 0; i < 4; ++i) { Xp[i][0] = 0.f; Xp[i][1] = 0.f; Xp[i][2] = 0.f; Xp[i][3] = 0.f; }
#pragma clang loop unroll(full)
                        for (int t = 0; t < 64; ++t) {
                            const float va_ = bf2f(AH[t * 72 + (colx & 63)]), vb_ = LB[t * 64 + (colx & 63)];
                            float a0 = par ? 0.f : ((colx < 64) ? va_ : vb_);
                            float a1 = 0.f, a2 = 0.f, a3 = 0.f;
#pragma clang loop unroll(full)
                            for (int i = 0; 16 * i < t; ++i) { const f32x4 w = *(const LAS f32x4*)(AAB + t * 64 + 16 * i + 4 * par);
                                a0 += w[0] * Xp[i][0]; a1 += w[1] * Xp[i][1]; a2 += w[2] * Xp[i][2]; a3 += w[3] * Xp[i][3]; }
                            float val = (a0 + a1) + (a2 + a3);
                            val += __builtin_bit_cast(float, __builtin_amdgcn_update_dpp(0, __builtin_bit_cast(int, val), 0xB1, 0xf, 0xf, false));
                            val += __builtin_bit_cast(float, __builtin_amdgcn_update_dpp(0, __builtin_bit_cast(int, val), 0x4E, 0xf, 0xf, false));
                            Xp[t >> 4][t & 3] = (par == ((t >> 2) & 3)) ? val : Xp[t >> 4][t & 3];
                            asm volatile("" : "+v"(Xp[t >> 4][t & 3]));
                        }
#pragma unroll
                        for (int i = 0; i < 4; ++i) { u32x2 w; w.x = cvt_pk_bf16(Xp[i][0], Xp[i][1]); w.y = cvt_pk_bf16(Xp[i][2], Xp[i][3]);
                            *(LAS u32x2*)(XT + colx * 72 + 16 * i + 4 * par) = w; }
                    }
                    S1_BAR;
                    if (item + G < 8704) S1_FETCH(item + G);
                    {
                        const int kind = wave >> 2, mt = (wave & 3) >> 1, nt = wave & 1;
                        {
                            const LAS bf16_t* Ap = (kind == 0 ? ARB : BHT) + (mt * 32 + l32) * 72; const LAS bf16_t* Bp = XT + (nt * 32 + l32) * 72;
                            f32x16 acc;
#pragma unroll
                            for (int i = 0; i < 16; ++i) acc[i] = 0.f;
#pragma unroll
                            for (int ks = 0; ks < 4; ++ks) acc = __builtin_amdgcn_mfma_f32_32x32x16_bf16(*(const LAS bf16x8*)(Ap + ks * 16 + hl * 8), *(const LAS bf16x8*)(Bp + ks * 16 + hl * 8), acc, 0, 0, 0);
                            bf16_t* dstb = (kind == 0) ? Rb : Kb;
#pragma unroll
                            for (int i = 0; i < 16; ++i) { const int rr = mt * 32 + crow(i, hl), cc = nt * 32 + l32;
                                float val = acc[i];
                                if (kind == 0) val += bf2f(RH[rr * 72 + cc]); else val *= DTS[rr];
                                dstb[(size_t)(r0 + rr) * DM + h * 64 + cc] = (bf16_t)(cvt_pk_bf16(val, 0.f) & 0xffffu); }
                        }
                        {
                            const LAS bf16_t* A1 = (kind == 0 ? ARB : BHT) + (mt * 32 + l32) * 72; const LAS bf16_t* A2 = (kind == 0 ? ARK : KHT) + (mt * 32 + l32) * 72;
                            const LAS bf16_t* B1 = XT + (64 + nt * 32 + l32) * 72; const LAS bf16_t* B2 = VTs + (nt * 32 + l32) * 72;
                            f32x16 acc;
#pragma unroll
                            for (int i = 0; i < 16; ++i) acc[i] = 0.f;
#pragma unroll
                            for (int ks = 0; ks < 4; ++ks) acc = __builtin_amdgcn_mfma_f32_32x32x16_bf16(*(const LAS bf16x8*)(A1 + ks * 16 + hl * 8), *(const LAS bf16x8*)(B1 + ks * 16 + hl * 8), acc, 0, 0, 0);
#pragma unroll
                            for (int ks = 0; ks < 4; ++ks) acc = __builtin_amdgcn_mfma_f32_32x32x16_bf16(*(const LAS bf16x8*)(A2 + ks * 16 + hl * 8), *(const LAS bf16x8*)(B2 + ks * 16 + hl * 8), acc, 0, 0, 0);
                            float* dstf = (kind == 0) ? Obuf : DD;
#pragma unroll
                            for (int i = 0; i < 16; ++i) { const int rr = mt * 32 + crow(i, hl), cc = nt * 32 + l32;
                                float val = acc[i]; if (kind == 1) val *= DTS[rr];
                                dstf[(size_t)(r0 + rr) * DM + h * 64 + cc] = val; }
                        }
                    }
                    S1_BAR;
                }
            }
            fast_grid_barrier((unsigned*)ldp(tab, 40), tab);
#undef S1_BAR
#undef S1_FETCH
            {
                PHASE_IDS BASES RWKV_PTRS
                const float* DTg = (const float*)(RB + 208 * MiB);
                const int l32 = lane & 31, hl = lane >> 5;
                int q = wave * G + blockIdx.x;
                if (G >= 256) {
                    if ((int)blockIdx.x < 128) q = (wave == 0) ? (int)blockIdx.x : 1 << 20;
                    else q = 128 + wave * 128 + ((int)blockIdx.x - 128);
                    if ((int)blockIdx.x >= 256) q = 1 << 20;
                }
                if (q < 1152) {
                    const bool prompt = q < 128; int b, h, vh, chunk0, nch;
                    if (prompt) { const int chain = q & 63; b = chain >> 5; h = chain & 31; vh = q >> 6; chunk0 = b * 128; nch = 128; }
                    else { const int sq = q - 128; const int chain = sq >> 1; b = chain >> 5; h = chain & 31; vh = sq & 1; chunk0 = 256 + b; nch = 1; }
                    const int colb = h * 64, vcol = colb + 32 * vh + l32;
                    f32x16 S0, S1;
                    if (prompt) {
#pragma unroll
                        for (int i = 0; i < 16; ++i) { S0[i] = 0.f; S1[i] = 0.f; }
                    } else {
                        const float* s0 = IN(3) + ((((size_t)jl * 16 + b) * 32 + h) * 64 + (32 * vh + l32)) * 64;
#pragma unroll
                        for (int i = 0; i < 16; ++i) { S0[i] = s0[crow(i, hl)]; S1[i] = s0[32 + crow(i, hl)]; }
                    }
                    bf16x8 gf[2][2][2]; f32x16 n0, n1; f32x4 dt_[2][4];
#define S2_COMPUTE(cc) do { const int _r0 = (chunk0 + (cc)) * 64; \
                        u32x4 w00, w01, w10, w11; \
                        w00.x = cvt_pk_bf16(S0[0], S0[1]); w00.y = cvt_pk_bf16(S0[2], S0[3]); w00.z = cvt_pk_bf16(S0[4], S0[5]); w00.w = cvt_pk_bf16(S0[6], S0[7]); \
                        w01.x = cvt_pk_bf16(S0[8], S0[9]); w01.y = cvt_pk_bf16(S0[10], S0[11]); w01.z = cvt_pk_bf16(S0[12], S0[13]); w01.w = cvt_pk_bf16(S0[14], S0[15]); \
                        w10.x = cvt_pk_bf16(S1[0], S1[1]); w10.y = cvt_pk_bf16(S1[2], S1[3]); w10.z = cvt_pk_bf16(S1[4], S1[5]); w10.w = cvt_pk_bf16(S1[6], S1[7]); \
                        w11.x = cvt_pk_bf16(S1[8], S1[9]); w11.y = cvt_pk_bf16(S1[10], S1[11]); w11.z = cvt_pk_bf16(S1[12], S1[13]); w11.w = cvt_pk_bf16(S1[14], S1[15]); \
                        const bf16x8 sb00 = __builtin_bit_cast(bf16x8, w00), sb01 = __builtin_bit_cast(bf16x8, w01), sb10 = __builtin_bit_cast(bf16x8, w10), sb11 = __builtin_bit_cast(bf16x8, w11); \
                        n0 = __builtin_amdgcn_mfma_f32_32x32x16_bf16(gf[0][0][0], sb00, n0, 0, 0, 0); n1 = __builtin_amdgcn_mfma_f32_32x32x16_bf16(gf[1][0][0], sb00, n1, 0, 0, 0); \
                        n0 = __builtin_amdgcn_mfma_f32_32x32x16_bf16(gf[0][0][1], sb01, n0, 0, 0, 0); n1 = __builtin_amdgcn_mfma_f32_32x32x16_bf16(gf[1][0][1], sb01, n1, 0, 0, 0); \
                        n0 = __builtin_amdgcn_mfma_f32_32x32x16_bf16(gf[0][1][0], sb10, n0, 0, 0, 0); n1 = __builtin_amdgcn_mfma_f32_32x32x16_bf16(gf[1][1][0], sb10, n1, 0, 0, 0); \
                        n0 = __builtin_amdgcn_mfma_f32_32x32x16_bf16(gf[0][1][1], sb11, n0, 0, 0, 0); n1 = __builtin_amdgcn_mfma_f32_32x32x16_bf16(gf[1][1][1], sb11, n1, 0, 0, 0); \
                        { unsigned char* _sp = (unsigned char*)DD + ((size_t)(_r0 + l32) * DM + colb + 32 * vh) * 4 + 8 * hl; \
                          *(u32x2*)(_sp + 0) = (u32x2){w00.x, w00.y}; *(u32x2*)(_sp + 16) = (u32x2){w00.z, w00.w}; *(u32x2*)(_sp + 32) = (u32x2){w01.x, w01.y}; *(u32x2*)(_sp + 48) = (u32x2){w01.z, w01.w}; \
                          *(u32x2*)(_sp + 64) = (u32x2){w10.x, w10.y}; *(u32x2*)(_sp + 80) = (u32x2){w10.z, w10.w}; *(u32x2*)(_sp + 96) = (u32x2){w11.x, w11.y}; *(u32x2*)(_sp + 112) = (u32x2){w11.z, w11.w}; } \
                        _Pragma("unroll") for (int i = 0; i < 16; ++i) { S0[i] = S0[i] * dt_[0][i >> 2][i & 3] + n0[i]; S1[i] = S1[i] * dt_[1][i >> 2][i & 3] + n1[i]; } \
                    } while (0)
                    if (prompt) {
                        LAS float* dtl = (LAS float*)((LAS unsigned char*)lds);
                        LAS unsigned char* ring = (LAS unsigned char*)lds + 32768;
                        for (int i = lane; i < 128 * 16; i += 64) *(LAS f32x4*)(dtl + i * 4) = *(const f32x4*)(DTg + ((size_t)(chunk0 + (i >> 4)) * 32 + h) * 64 + (i & 15) * 4);
#define S2_DMA(cc) do { const int _r0 = (chunk0 + (cc)) * 64; LAS unsigned char* _s = ring + ((cc) & 3) * 16384; \
                            _Pragma("unroll") for (int j = 0; j < 8; ++j) { const int _row = 8 * j + (lane >> 3); const int _p = (lane & 7) ^ (_row & 7); \
                                __builtin_amdgcn_global_load_lds((const unsigned*)(Kb + (size_t)(_r0 + _row) * DM + colb + _p * 8), (LAS unsigned*)(_s + j * 1024), 16, 0, 0); } \
                            _Pragma("unroll") for (int j = 0; j < 8; ++j) { const int _row = 8 * j + (lane >> 3); \
                                __builtin_amdgcn_global_load_lds((const unsigned*)(DD + (size_t)(_r0 + _row) * DM + colb + 32 * vh + (lane & 7) * 4), (LAS unsigned*)(_s + 8192 + j * 1024), 16, 0, 0); } \
                        } while (0)
                        S2_DMA(0); S2_DMA(1);
#pragma unroll 1
                        for (int c = 0; c < 128; ++c) {
                            if (c + 2 < 128) { S2_DMA(c + 2); asm volatile("s_waitcnt vmcnt(32)" ::: "memory"); }
                            else if (c + 1 < 128) asm volatile("s_waitcnt vmcnt(16)" ::: "memory");
                            else asm volatile("s_waitcnt vmcnt(0)" ::: "memory");
                            LAS unsigned char* sl = ring + (c & 3) * 16384;
#pragma unroll
                            for (int mt = 0; mt < 2; ++mt)
#pragma unroll
                                for (int kt = 0; kt < 2; ++kt)
#pragma unroll
                                    for (int s2 = 0; s2 < 2; ++s2) {
                                        const int row = 32 * mt + l32, p = 4 * kt + 2 * s2;
                                        const u32x2 lo = *(const LAS u32x2*)(sl + row * 128 + ((p ^ (row & 7)) * 16) + 8 * hl);
                                        const u32x2 hi = *(const LAS u32x2*)(sl + row * 128 + (((p + 1) ^ (row & 7)) * 16) + 8 * hl);
                                        gf[mt][kt][s2] = __builtin_bit_cast(bf16x8, (u32x4){lo.x, lo.y, hi.x, hi.y});
                                    }
#pragma unroll
                            for (int i = 0; i < 16; ++i) { n0[i] = *(const LAS float*)(sl + 8192 + crow(i, hl) * 128 + l32 * 4); n1[i] = *(const LAS float*)(sl + 8192 + (32 + crow(i, hl)) * 128 + l32 * 4); }
#pragma unroll
                            for (int mt = 0; mt < 2; ++mt)
#pragma unroll
                                for (int g = 0; g < 4; ++g) dt_[mt][g] = *(const LAS f32x4*)(dtl + c * 64 + 32 * mt + 8 * g + 4 * hl);
                            S2_COMPUTE(c);
                        }
#undef S2_DMA
                    } else {
                        const int _r0 = chunk0 * 64; const size_t _item = (size_t)chunk0 * 32 + h;
#pragma unroll
                        for (int mt = 0; mt < 2; ++mt)
#pragma unroll
                            for (int kt = 0; kt < 2; ++kt)
#pragma unroll
                                for (int s2 = 0; s2 < 2; ++s2) {
                                    const size_t _o = (size_t)(_r0 + 32 * mt + l32) * DM + colb + 32 * kt + 16 * s2 + 4 * hl;
                                    const u32x2 _lo = *(const u32x2*)(Kb + _o), _hi = *(const u32x2*)(Kb + _o + 8); gf[mt][kt][s2] = __builtin_bit_cast(bf16x8, (u32x4){_lo.x, _lo.y, _hi.x, _hi.y}); }
#pragma unroll
                        for (int i = 0; i < 16; ++i) { n0[i] = DD[(size_t)(_r0 + crow(i, hl)) * DM + vcol]; n1[i] = DD[(size_t)(_r0 + 32 + crow(i, hl)) * DM + vcol]; }
#pragma unroll
                        for (int mt = 0; mt < 2; ++mt)
#pragma unroll
                            for (int g = 0; g < 4; ++g) dt_[mt][g] = *(const f32x4*)(DTg + _item * 64 + 32 * mt + 8 * g + 4 * hl);
                        S2_COMPUTE(0);
                    }
#undef S2_COMPUTE
                    float* so_ = OUTP + (prompt ? O_PWKV + ((((size_t)jl * 2 + b) * 32 + h) * 64 + (32 * vh + l32)) * 64
                                                : O_SWKV + ((((size_t)jl * 16 + b) * 32 + h) * 64 + (32 * vh + l32)) * 64);
#pragma unroll
                    for (int i = 0; i < 16; ++i) { so_[crow(i, hl)] = S0[i]; so_[32 + crow(i, hl)] = S1[i]; }
                }
            }
            fast_grid_barrier((unsigned*)ldp(tab, 40), tab);
            {
                PHASE_IDS BASES RWKV_PTRS
                const float* Obuf = (const float*)(RA + 272 * MiB); const float* RK = (const float*)(RB + 204 * MiB);
                const float* lnw_g = IN(28) + (size_t)jl * DM; const float* lnb_g = IN(29) + (size_t)jl * DM;
                float* lnw = (float*)(lds + 40960); float* lnb = lnw + DM;
                for (int i = tid; i < DM / 4; i += 512) { *(f32x4*)(lnw + i * 4) = *(const f32x4*)(lnw_g + i * 4); *(f32x4*)(lnb + i * 4) = *(const f32x4*)(lnb_g + i * 4); }
                __syncthreads();
                const int l32 = lane & 31, hl = lane >> 5;
#pragma unroll 1
                for (int item = blockIdx.x; item < 8704; item += G) {
                    LAS unsigned char* ldsv = (LAS unsigned char*)lds; asm volatile("" : "+v"(ldsv));
                    LAS bf16_t* R2s = (LAS bf16_t*)(ldsv + 0); LAS bf16_t* STs = (LAS bf16_t*)(ldsv + 9216); LAS float* Os = (LAS float*)(ldsv + 18432);
                    const int chunk = item >> 5, h = item & 31, r0 = chunk * 64;
                    {
                        const int rr = tid >> 3, pc = tid & 7;
                        *(LAS u32x4*)(R2s + rr * 72 + pc * 8) = *(const u32x4*)(Rb + (size_t)(r0 + rr) * DM + h * 64 + pc * 8);
                        const unsigned char* sp = (const unsigned char*)DD + ((size_t)(r0 + (rr & 31)) * DM + h * 64 + 32 * (rr >> 5)) * 4 + pc * 16;
                        *(LAS u32x4*)(STs + rr * 72 + pc * 8) = *(const u32x4*)sp;
                    }
                    __syncthreads();
                    if (wave < 4) {
                        const int tt = wave >> 1, vt = wave & 1;
                        f32x16 acc;
#pragma unroll
                        for (int i = 0; i < 16; ++i) acc[i] = Obuf[(size_t)(r0 + 32 * tt + crow(i, hl)) * DM + h * 64 + 32 * vt + l32];
#pragma unroll
                        for (int ks = 0; ks < 4; ++ks) acc = __builtin_amdgcn_mfma_f32_32x32x16_bf16(*(const LAS bf16x8*)(R2s + (32 * tt + l32) * 72 + ks * 16 + hl * 8), *(const LAS bf16x8*)(STs + (32 * vt + l32) * 72 + ks * 16 + hl * 8), acc, 0, 0, 0);
#pragma unroll
                        for (int i = 0; i < 16; ++i) Os[(32 * tt + crow(i, hl)) * 68 + 32 * vt + l32] = acc[i];
                    }
                    __syncthreads();
                    {
                        const int st = tid >> 3, c0 = (tid & 7) * 8, col = h * 64 + c0; const size_t off = (size_t)(r0 + st) * DM + col;
                        const f32x4 o0 = *(const LAS f32x4*)(Os + st * 68 + c0), o1 = *(const LAS f32x4*)(Os + st * 68 + c0 + 4);
                        float o[8] = {o0[0], o0[1], o0[2], o0[3], o1[0], o1[1], o1[2], o1[3]};
                        float s = 0.f;
#pragma unroll
                        for (int i = 0; i < 8; ++i) s += o[i];
                        const float mu = sum8(s, lane) * (1.f / 64.f); float q = 0.f;
#pragma unroll
                        for (int i = 0; i < 8; ++i) { o[i] -= mu; q += o[i] * o[i]; }
                        const float rstd = rsqrtf(sum8(q, lane) * (1.f / 64.f) + 64e-5f);
                        float v[8], g8[8]; unpack8(*(const u32x4*)(Vb + off), v); unpack8(*(const u32x4*)(GG + off), g8);
                        if (jl > 0) { float vf[8], vg[8]; unpack8(*(const u32x4*)(VFIRST + off), vf); unpack8(*(const u32x4*)(VG + off), vg);
#pragma unroll
                            for (int i = 0; i < 8; ++i) v[i] = v[i] + (vf[i] - v[i]) * vg[i]; }
                        const float rk = RK[(size_t)(r0 + st) * 32 + h];
                        float y[8];
#pragma unroll
                        for (int i = 0; i < 8; ++i) y[i] = (o[i] * rstd * lnw[col + i] + lnb[col + i] + rk * v[i]) * g8[i];
                        *(u32x4*)(Y + off) = pack8(y);
                    }
                    __syncthreads();
                }
            }
            fast_grid_barrier((unsigned*)ldp(tab, 40), tab);
            {
                BASES RWKV_PTRS
                pg8::Gemm g{Y, WO, MROWS, 2048, 2048, 0, 0};
                pg8::StaticOrder S; S.init(g.M, g.N, G, (int)blockIdx.x, g.K, 4);
                pg8::Epi<FRes> E{FRes{X, (float*)(RA + 272 * MiB), layer == 0 ? IN(0) : (const float*)nullptr, IN(1)}};
                pg8::gemm_phase(ldsl, g, S, E);
                fast_grid_barrier((unsigned*)ldp(tab, 40), tab);
                {
                    PHASE_IDS
                    const float* PART = (const float*)(RA + 272 * MiB); const int ntail = S.nwg - S.nFull;
                    if (S.S > 1) for (int idx = gtid; idx < ntail * 16384; idx += NT) {
                        const int tl = idx >> 14, r = (idx >> 6) & 255, c4 = idx & 63; int pm, pn; S.tile_pmpn(S.nFull + tl, pm, pn);
                        f32x4* xp = (f32x4*)(X + (size_t)(pm * 256 + r) * DM + pn * 256 + c4 * 4); f32x4 acc = (layer == 0) ? *(const f32x4*)(xin_row(E.f.xin_p, E.f.xin_s, pm * 256 + r) + pn * 256 + c4 * 4) : *xp;
#pragma unroll
                        for (int part = 0; part < 4; ++part) acc += *(const f32x4*)(PART + (size_t)(part * 32 + tl) * 65536 + r * 256 + c4 * 4);
                        *xp = acc; }
                }
            }
            fast_grid_barrier((unsigned*)ldp(tab, 40), tab);
        } else {
            { PHASE_IDS BASES GLA_PTRS
            const float* gmix = IN(6) + (size_t)layer * DM;
            f32x4 ggr[8];
#pragma unroll
            for (int q = 0; q < 8; ++q) ggr[q] = *((const f32x4*)gmix + lane + 64 * q);
            for (int row = gw; row < MROWS; row += NGW) {
                const f32x4* xr = (const f32x4*)(X + (size_t)row * DM) + lane; f32x4 x[8]; float ss = 0.f;
#pragma unroll
                for (int q = 0; q < 8; ++q) { x[q] = xr[64 * q]; ss += x[q][0] * x[q][0] + x[q][1] * x[q][1] + x[q][2] * x[q][2] + x[q][3] * x[q][3]; }
                const float rs = rsqrtf(wave_sum(ss, lane) * (1.f / DM) + 1e-6f);
#pragma unroll
                for (int q = 0; q < 8; ++q) { const f32x4 gg = ggr[q]; const f32x4 h = x[q] * rs * gg;
                    u32x2 w; w.x = cvt_pk_bf16(h[0], h[1]); w.y = cvt_pk_bf16(h[2], h[3]); *((u32x2*)(H + (size_t)row * DM) + lane + 64 * q) = w; }
            } }
            fast_grid_barrier((unsigned*)ldp(tab, 40), tab);
            {
                BASES GLA_PTRS
                pg8::Gemm g{H, GI, MROWS, 6400, 2048, 0, 0};
                pg8::StaticOrder S; S.init(g.M, g.N, G, (int)blockIdx.x, g.K, 1);
                pg8::Epi<FG1> E{FG1{PROJ, LR}};
                pg8::gemm_phase(ldsl, g, S, E);
            }
            fast_grid_barrier((unsigned*)ldp(tab, 40), tab);
            {
                PHASE_IDS BASES GLA_PTRS
                float* lrS = (float*)lds;
                float* w2S = (float*)(lds + 4096);
                float* totS = (float*)(lds + 20480);
                bf16_t* qeS = (bf16_t*)(lds + 22528);
                bf16_t* keS = (bf16_t*)(lds + 22528 + 33792);
                bf16_t* vS = qeS;
                const float* gw2 = IN(31) + (size_t)jl * 16 * 1024; const float* gkb = IN(32) + (size_t)jl * 1024;
#pragma unroll 1
                for (int it = blockIdx.x; it < 1088; it += G) {
                    const int c = it >> 2, h = it & 3, r0 = c * 64; const size_t base = (size_t)it;
                    if (tid < 256) *(f32x4*)(lrS + tid * 4) = *(const f32x4*)(LR + (size_t)r0 * 16 + tid * 4);
                    for (int q = tid; q < 1024; q += 512) { const int r = q >> 6, cc = (q & 63) * 4; *(f32x4*)(w2S + r * 256 + cc) = *(const f32x4*)(gw2 + (size_t)r * 1024 + h * 256 + cc); }
                    for (int q = tid; q < 2048; q += 512) { const int t = q >> 5, cc = (q & 31) * 8; const bf16_t* src = PROJ + (size_t)(r0 + t) * 6144 + h * 256 + cc;
                        *(u32x4*)(qeS + t * 264 + cc) = *(const u32x4*)src; *(u32x4*)(keS + t * 264 + cc) = *(const u32x4*)(src + 1024); }
                    __syncthreads();
                    const int d = tid & 255, half = tid >> 8;
                    float cumv[32];
                    {
                        float w[16];
#pragma unroll
                        for (int r = 0; r < 16; ++r) w[r] = w2S[r * 256 + d];
                        const float bb = gkb[h * 256 + d]; float run = 0.f;
#pragma unroll
                        for (int tt = 0; tt < 32; ++tt) {
                            const float* lp = lrS + (half * 32 + tt) * 16; float z = bb;
#pragma unroll
                            for (int r = 0; r < 16; ++r) z += lp[r] * w[r];
                            const float g = (fminf(z, 0.f) - log1pf(__expf(-fabsf(z)))) * 0.0625f;
                            run += g; cumv[tt] = run;
                        }
                        totS[half * 256 + d] = run;
                    }
                    __syncthreads();
                    {
                        const float t0 = totS[d], t1 = totS[256 + d]; const float last = t0 + t1, offc = half ? t0 : 0.f;
                        if (half == 0) EL[base * 256 + d] = __expf(last);
                        unsigned kdp[16];
#pragma unroll
                        for (int tt = 0; tt < 32; tt += 2) {
                            float kd2[2];
#pragma unroll
                            for (int e = 0; e < 2; ++e) {
                                const int t = half * 32 + tt + e; const float cum = cumv[tt + e] + offc;
                                const float q = bf2f(qeS[t * 264 + d]), k = bf2f(keS[t * 264 + d]);
                                const float qe = q * __expf(cum), ke = k * __expf(-cum); kd2[e] = k * __expf(last - cum);
                                const unsigned pq = cvt_pk_bf16(qe, ke);
                                qeS[t * 264 + d] = (bf16_t)(pq & 0xffffu); keS[t * 264 + d] = (bf16_t)(pq >> 16);
                            }
                            kdp[tt >> 1] = cvt_pk_bf16(kd2[0], kd2[1]);
                        }
                        u32x4* kdst = (u32x4*)(KDT + (base * 256 + d) * 64 + half * 32);
                        kdst[0] = (u32x4){kdp[0], kdp[1], kdp[2], kdp[3]}; kdst[1] = (u32x4){kdp[4], kdp[5], kdp[6], kdp[7]};
                        kdst[2] = (u32x4){kdp[8], kdp[9], kdp[10], kdp[11]}; kdst[3] = (u32x4){kdp[12], kdp[13], kdp[14], kdp[15]};
                    }
                    __syncthreads();
                    for (int q = tid; q < 2048; q += 512) { const int t = q >> 5, sl = (q >> 2) & 7, pc = q & 3;
                        *(u32x4*)(QE + ((base * 8 + sl) * 64 + t) * 32 + pc * 8) = *(const u32x4*)(qeS + t * 264 + sl * 32 + pc * 8); }
                    if (wave < 4) {
                        const int mi = wave >> 1, ni = wave & 1, l32 = lane & 31, hl = lane >> 5;
                        f32x16 cacc;
#pragma unroll
                        for (int i = 0; i < 16; ++i) cacc[i] = 0.f;
#pragma unroll
                        for (int kk = 0; kk < 16; ++kk) {
                            const bf16x8 a = *(const bf16x8*)(qeS + (mi * 32 + l32) * 264 + kk * 16 + hl * 8);
                            const bf16x8 b = *(const bf16x8*)(keS + (ni * 32 + l32) * 264 + kk * 16 + hl * 8);
                            cacc = __builtin_amdgcn_mfma_f32_32x32x16_bf16(a, b, cacc, 0, 0, 0);
                        }
#pragma unroll
                        for (int i = 0; i < 16; ++i) { const int ii = mi * 32 + crow(i, hl), jj = ni * 32 + l32;
                            const float v = (jj <= ii) ? cacc[i] : 0.f; SC[base * 4096 + ii * 64 + jj] = (bf16_t)(cvt_pk_bf16(v, 0.f) & 0xffffu); }
                    }
                    __syncthreads();
                    for (int q = tid; q < 4096; q += 512) { const int t = q >> 6, cc = (q & 63) * 8;
                        *(u32x4*)(vS + t * 520 + cc) = *(const u32x4*)(PROJ + (size_t)(r0 + t) * 6144 + 2048 + h * 512 + cc); }
                    __syncthreads();
                    {
                        const int dv = tid; u32x4* vdst = (u32x4*)(VT + (base * 512 + dv) * 64);
#pragma unroll
                        for (int q = 0; q < 8; ++q) {
                            unsigned w[4];
#pragma unroll
                            for (int e = 0; e < 4; ++e) { const unsigned lo = vS[(q * 8 + 2 * e) * 520 + dv], hi = vS[(q * 8 + 2 * e + 1) * 520 + dv]; w[e] = lo | (hi << 16); }
                            vdst[q] = (u32x4){w[0], w[1], w[2], w[3]};
                        }
                    }
                    __syncthreads();
                }
            }
            fast_grid_barrier((unsigned*)ldp(tab, 40), tab);
            {
                PHASE_IDS BASES GLA_PTRS
                float* red = (float*)lds;
                const int l32 = lane & 31, hl = lane >> 5;
                int u0_ = (int)blockIdx.x, ustr_ = G;
                if (G >= 256) { if ((int)blockIdx.x < 128) ustr_ = 1 << 30; else { u0_ = (int)blockIdx.x; ustr_ = G - 128; } }
#pragma unroll 1
                for (int u = u0_; u < 1152; u += ustr_) {
                    const bool prompt = u < 128; int b, h, s, cg0, nch, row0;
                    if (prompt) { const int pair = u & 7; b = pair >> 2; h = pair & 3; s = u >> 3; cg0 = b * 128; nch = 128; row0 = b * 8192; }
                    else { const int su = u - 128; b = su >> 6; h = (su >> 4) & 3; s = su & 15; cg0 = 256 + b; nch = 1; row0 = MPROMPT + b * 64; }
                    f32x16 S;
                    if (prompt) {
#pragma unroll
                        for (int i = 0; i < 16; ++i) S[i] = 0.f;
                    } else {
                        const float* s0 = IN(4) + ((((size_t)jl * 16 + b) * 4 + h) * 256) * 512;
#pragma unroll
                        for (int i = 0; i < 16; ++i) S[i] = s0[(size_t)(32 * wave + crow(i, hl)) * 512 + 32 * s + l32];
                    }
                    const int mtw = wave & 1, ksw = wave >> 1;
                    bf16x8 ka[4], vb[4], qf[2][2], scf; f32x4 el[4];
#define GL_LD_Q(cc) do { const size_t _base = (size_t)(cg0 + (cc)) * 4 + h; const int _r0 = row0 + (cc) * 64; const bf16_t* _sc = SC + _base * 4096; \
                        _Pragma("unroll") for (int mt = 0; mt < 2; ++mt) _Pragma("unroll") for (int s2 = 0; s2 < 2; ++s2) { const bf16_t* _pq = QE + ((_base * 8 + wave) * 64 + mt * 32 + l32) * 32 + 16 * s2 + 4 * hl; \
                            const u32x2 _lo = *(const u32x2*)_pq, _hi = *(const u32x2*)(_pq + 8); qf[mt][s2] = __builtin_bit_cast(bf16x8, (u32x4){_lo.x, _lo.y, _hi.x, _hi.y}); } \
                        scf = *(const bf16x8*)(_sc + (mtw * 32 + l32) * 64 + 16 * ksw + 8 * hl); } while (0)
#define GL_LD_E(cc) do { const size_t _base = (size_t)(cg0 + (cc)) * 4 + h; \
                        _Pragma("unroll") for (int g = 0; g < 4; ++g) el[g] = *(const f32x4*)(EL + _base * 256 + 32 * wave + 8 * g + 4 * hl); } while (0)
#define GL_LD_K(cc) do { const size_t _base = (size_t)(cg0 + (cc)) * 4 + h; const bf16_t* _kdt = KDT + _base * 256 * 64; const bf16_t* _vt = VT + _base * 512 * 64; \
                        _Pragma("unroll") for (int ks = 0; ks < 4; ++ks) { ka[ks] = *(const bf16x8*)(_kdt + (32 * wave + l32) * 64 + 16 * ks + 8 * hl); vb[ks] = *(const bf16x8*)(_vt + (32 * s + l32) * 64 + 16 * ks + 8 * hl); } } while (0)
                    GL_LD_Q(0); GL_LD_E(0); GL_LD_K(0);
                    f32x4 osum = (f32x4){0.f, 0.f, 0.f, 0.f}; float* optr = nullptr;
#pragma unroll 1
                    for (int c = 0; c < nch; ++c) {
                        const int r0 = row0 + c * 64; const int cn = (c + 1 < nch) ? c + 1 : c;
                        asm volatile("" : "+v"(scf), "+v"(vb[3]));
                        if (c > 0) *(f32x4*)optr = osum;
                        u32x4 sp0, sp1;
                        sp0.x = cvt_pk_bf16(S[0], S[1]); sp0.y = cvt_pk_bf16(S[2], S[3]); sp0.z = cvt_pk_bf16(S[4], S[5]); sp0.w = cvt_pk_bf16(S[6], S[7]);
                        sp1.x = cvt_pk_bf16(S[8], S[9]); sp1.y = cvt_pk_bf16(S[10], S[11]); sp1.z = cvt_pk_bf16(S[12], S[13]); sp1.w = cvt_pk_bf16(S[14], S[15]);
                        const bf16x8 sb0 = __builtin_bit_cast(bf16x8, sp0), sb1 = __builtin_bit_cast(bf16x8, sp1);
                        const bf16x8 vbw = ksw == 0 ? vb[0] : ksw == 1 ? vb[1] : ksw == 2 ? vb[2] : vb[3];
#pragma unroll
                        for (int i = 0; i < 16; ++i) S[i] *= el[i >> 2][i & 3];
#pragma unroll
                        for (int ks = 0; ks < 4; ++ks) S = __builtin_amdgcn_mfma_f32_32x32x16_bf16(ka[ks], vb[ks], S, 0, 0, 0);
                        GL_LD_E(cn); GL_LD_K(cn);
                        f32x16 oo0, oo1;
#pragma unroll
                        for (int i = 0; i < 16; ++i) { oo0[i] = 0.f; oo1[i] = 0.f; }
                        oo0 = __builtin_amdgcn_mfma_f32_32x32x16_bf16(qf[0][0], sb0, oo0, 0, 0, 0); oo0 = __builtin_amdgcn_mfma_f32_32x32x16_bf16(qf[0][1], sb1, oo0, 0, 0, 0);
                        oo1 = __builtin_amdgcn_mfma_f32_32x32x16_bf16(qf[1][0], sb0, oo1, 0, 0, 0); oo1 = __builtin_amdgcn_mfma_f32_32x32x16_bf16(qf[1][1], sb1, oo1, 0, 0, 0);
                        if (mtw == 0) oo0 = __builtin_amdgcn_mfma_f32_32x32x16_bf16(scf, vbw, oo0, 0, 0, 0); else oo1 = __builtin_amdgcn_mfma_f32_32x32x16_bf16(scf, vbw, oo1, 0, 0, 0);
                        GL_LD_Q(cn);
#pragma unroll
                        for (int q = 0; q < 16; ++q) { red[(wave * 32 + q) * 64 + lane] = oo0[q]; red[(wave * 32 + 16 + q) * 64 + lane] = oo1[q]; }
                        asm volatile("s_waitcnt lgkmcnt(0)" ::: "memory"); __builtin_amdgcn_s_barrier(); asm volatile("" ::: "memory");
                        { const int q = tid >> 4, lg = tid & 15; f32x4 sum = (f32x4){0.f, 0.f, 0.f, 0.f};
#pragma unroll
                          for (int w = 0; w < 8; ++w) sum += *(const f32x4*)(red + (w * 32 + q) * 64 + 4 * lg);
                          const int mt = q >> 4, reg = q & 15, L = 4 * lg; const int i = mt * 32 + crow(reg, L >> 5), dv = L & 31;
                          osum = sum; optr = O + (size_t)(r0 + i) * DM + h * 512 + 32 * s + dv; }
                        asm volatile("s_waitcnt lgkmcnt(0)" ::: "memory"); __builtin_amdgcn_s_barrier(); asm volatile("" ::: "memory");
                    }
                    *(f32x4*)optr = osum;
#undef GL_LD_Q
#undef GL_LD_E
#undef GL_LD_K
                    float* dst = OUTP + (prompt ? O_PGLA + ((((size_t)jl * 2 + b) * 4 + h) * 256) * 512 : O_SGLA + ((((size_t)jl * 16 + b) * 4 + h) * 256) * 512);
#pragma unroll
                    for (int i = 0; i < 16; ++i) dst[(size_t)(32 * wave + crow(i, hl)) * 512 + 32 * s + l32] = S[i];
                }
                if (layer == 1 && G >= 256 && (int)blockIdx.x >= 128) {
                    float* scr = (float*)(lds + wave * 16896);
                    CONVERT_WEIGHTS(1, 2, 2, 4, ((int)blockIdx.x - 128) * 8 + wave, (G - 128) * 8);
                }
            }
            fast_grid_barrier((unsigned*)ldp(tab, 40), tab);
            {
                PHASE_IDS BASES GLA_PTRS
                const float* hn = IN(33) + (size_t)jl * 512;
                const f32x4 n0 = *(const f32x4*)(hn + lane * 8), n1 = *(const f32x4*)(hn + lane * 8 + 4);
                for (int row = gw; row < MROWS; row += NGW) {
#pragma unroll
                    for (int h = 0; h < 4; ++h) {
                        const float* op = O + (size_t)row * DM + h * 512 + lane * 8;
                        const f32x4 a = *(const f32x4*)op, b = *(const f32x4*)(op + 4);
                        float ss = a[0] * a[0] + a[1] * a[1] + a[2] * a[2] + a[3] * a[3] + b[0] * b[0] + b[1] * b[1] + b[2] * b[2] + b[3] * b[3];
                        const float rs = rsqrtf(wave_sum(ss, lane) * (1.f / 512.f) + 1e-5f);
                        float gt[8]; unpack8(*(const u32x4*)(PROJ + (size_t)row * 6144 + 4096 + h * 512 + lane * 8), gt);
                        float y[8];
#pragma unroll
                        for (int i = 0; i < 4; ++i) { y[i] = a[i] * rs * n0[i] * (gt[i] * sigmoidf_(gt[i])); y[4 + i] = b[i] * rs * n1[i] * (gt[4 + i] * sigmoidf_(gt[4 + i])); }
                        *(u32x4*)(Y + (size_t)row * DM + h * 512 + lane * 8) = pack8(y);
                    }
                }
            }
            fast_grid_barrier((unsigned*)ldp(tab, 40), tab);
            {
                BASES GLA_PTRS
                pg8::Gemm g{Y, GO, MROWS, 2048, 2048, 0, 0};
                pg8::StaticOrder S; S.init(g.M, g.N, G, (int)blockIdx.x, g.K, 4);
                pg8::Epi<FRes> E{FRes{X, (float*)(RA + 272 * MiB), nullptr, nullptr}};
                pg8::gemm_phase(ldsl, g, S, E);
                fast_grid_barrier((unsigned*)ldp(tab, 40), tab);
                {
                    PHASE_IDS
                    const float* PART = (const float*)(RA + 272 * MiB); const int ntail = S.nwg - S.nFull;
                    if (S.S > 1) for (int idx = gtid; idx < ntail * 16384; idx += NT) {
                        const int tl = idx >> 14, r = (idx >> 6) & 255, c4 = idx & 63; int pm, pn; S.tile_pmpn(S.nFull + tl, pm, pn);
                        f32x4* xp = (f32x4*)(X + (size_t)(pm * 256 + r) * DM + pn * 256 + c4 * 4); f32x4 acc = *xp;
#pragma unroll
                        for (int part = 0; part < 4; ++part) acc += *(const f32x4*)(PART + (size_t)(part * 32 + tl) * 65536 + r * 256 + c4 * 4);
                        *xp = acc; }
                }
            }
            fast_grid_barrier((unsigned*)ldp(tab, 40), tab);
        }
        {
            { PHASE_IDS BASES FFN_PTRS
            const float* gf = IN(7) + (size_t)layer * DM;
            f32x4 ggr[8];
#pragma unroll
            for (int q = 0; q < 8; ++q) ggr[q] = *((const f32x4*)gf + lane + 64 * q);
            for (int row = gw; row < MROWS; row += NGW) {
                const f32x4* xr = (const f32x4*)(X + (size_t)row * DM) + lane; f32x4 x[8]; float ss = 0.f;
#pragma unroll
                for (int q = 0; q < 8; ++q) { x[q] = xr[64 * q]; ss += x[q][0] * x[q][0] + x[q][1] * x[q][1] + x[q][2] * x[q][2] + x[q][3] * x[q][3]; }
                const float rs = rsqrtf(wave_sum(ss, lane) * (1.f / DM) + 1e-6f);
#pragma unroll
                for (int q = 0; q < 8; ++q) { const f32x4 gg = ggr[q]; const f32x4 h = x[q] * rs * gg;
                    u32x2 w; w.x = cvt_pk_bf16(h[0], h[1]); w.y = cvt_pk_bf16(h[2], h[3]); *((u32x2*)(H + (size_t)row * DM) + lane + 64 * q) = w; }
            } }
            fast_grid_barrier((unsigned*)ldp(tab, 40), tab);
            {
                BASES FFN_PTRS
                pg8::Gemm g{H, WU, MROWS, F2, 2048, 0, 0};
                pg8::StaticOrder S; S.init(g.M, g.N, G, (int)blockIdx.x, g.K, 1);
                pg8::Epi<FUp> E{FUp{U, OUTP + O_PCONV + (size_t)layer * 2 * 2 * F2, OUTP + O_SCONV + (size_t)layer * 16 * 2 * F2}};
                pg8::gemm_phase(ldsl, g, S, E);
            }
            fast_grid_barrier((unsigned*)ldp(tab, 40), tab);
            {
                PHASE_IDS BASES FFN_PTRS
                const float* cw = IN(36) + (size_t)layer * 3 * F2; const float* cb = IN(37) + (size_t)layer * F2;
                const float* cst = IN(5) + (size_t)layer * 16 * 2 * F2;
#pragma unroll 1
                for (int it = gtid; it < 544 * 704; it += NT) {
                    const int rc = it / 704, c8 = it - rc * 704, col = c8 * 8, r0 = rc * 32;
                    int t0, len, b; bool prompt; row_info(r0, t0, len, b, prompt);
                    float wv[3][8], wg[3][8], bv[8], bg[8];
#pragma unroll
                    for (int k = 0; k < 3; ++k) { const f32x4 a = *(const f32x4*)(cw + (size_t)k * F2 + col), a2 = *(const f32x4*)(cw + (size_t)k * F2 + col + 4);
                        const f32x4 g = *(const f32x4*)(cw + (size_t)k * F2 + FH + col), g2 = *(const f32x4*)(cw + (size_t)k * F2 + FH + col + 4);
#pragma unroll
                        for (int i = 0; i < 4; ++i) { wv[k][i] = a[i]; wv[k][4 + i] = a2[i]; wg[k][i] = g[i]; wg[k][4 + i] = g2[i]; } }
                    { const f32x4 a = *(const f32x4*)(cb + col), a2 = *(const f32x4*)(cb + col + 4), g = *(const f32x4*)(cb + FH + col), g2 = *(const f32x4*)(cb + FH + col + 4);
#pragma unroll
                      for (int i = 0; i < 4; ++i) { bv[i] = a[i]; bv[4 + i] = a2[i]; bg[i] = g[i]; bg[4 + i] = g2[i]; } }
                    float v2[8], v1[8], g2_[8], g1_[8];
                    if (t0 > 0) {
                        unpack8(*(const u32x4*)(U + (size_t)(r0 - 2) * F2 + col), v2); unpack8(*(const u32x4*)(U + (size_t)(r0 - 1) * F2 + col), v1);
                        unpack8(*(const u32x4*)(U + (size_t)(r0 - 2) * F2 + FH + col), g2_); unpack8(*(const u32x4*)(U + (size_t)(r0 - 1) * F2 + FH + col), g1_);
                    } else if (!prompt) {
                        const float* s0 = cst + ((size_t)b * 2) * F2 + col; const float* s1 = s0 + F2;
#pragma unroll
                        for (int i = 0; i < 8; ++i) { v2[i] = s0[i]; v1[i] = s1[i]; g2_[i] = s0[FH + i]; g1_[i] = s1[FH + i]; }
                    } else {
#pragma unroll
                        for (int i = 0; i < 8; ++i) { v2[i] = 0.f; v1[i] = 0.f; g2_[i] = 0.f; g1_[i] = 0.f; }
                    }
#pragma unroll 1
                    for (int rb = 0; rb < 32; rb += 8) {
                      u32x4 uv_[8], ug_[8];
#pragma unroll
                      for (int j = 0; j < 8; ++j) { uv_[j] = *(const u32x4*)(U + (size_t)(r0 + rb + j) * F2 + col); ug_[j] = *(const u32x4*)(U + (size_t)(r0 + rb + j) * F2 + FH + col); }
#pragma unroll
                      for (int j = 0; j < 8; ++j) {
                        const int r = rb + j;
                        float v0[8], g0[8];
                        unpack8(uv_[j], v0); unpack8(ug_[j], g0);
                        float y[8];
#pragma unroll
                        for (int i = 0; i < 8; ++i) {
                            const float cv = bv[i] + wv[0][i] * v2[i] + wv[1][i] * v1[i] + wv[2][i] * v0[i];
                            const float cg_ = bg[i] + wg[0][i] * g2_[i] + wg[1][i] * g1_[i] + wg[2][i] * g0[i];
                            y[i] = cg_ * sigmoidf_(cg_) * cv;
                            v2[i] = v1[i]; v1[i] = v0[i]; g2_[i] = g1_[i]; g1_[i] = g0[i];
                        }
                        *(u32x4*)(HID + (size_t)(r0 + r) * FH + col) = pack8(y);
                      }
                    }
                }
            }
            fast_grid_barrier((unsigned*)ldp(tab, 40), tab);
            {
                BASES FFN_PTRS
                pg8::Gemm g{HID, WD, MROWS, 2048, FH, 0, 0};
                pg8::StaticOrder S; S.init(g.M, g.N, G, (int)blockIdx.x, g.K, 4);
                pg8::Epi<FRes> E{FRes{X, (float*)(RA + 272 * MiB), nullptr, nullptr}};
                pg8::gemm_phase(ldsl, g, S, E);
                fast_grid_barrier((unsigned*)ldp(tab, 40), tab);
                {
                    PHASE_IDS
                    const float* PART = (const float*)(RA + 272 * MiB); const int ntail = S.nwg - S.nFull;
                    if (S.S > 1) for (int idx = gtid; idx < ntail * 16384; idx += NT) {
                        const int tl = idx >> 14, r = (idx >> 6) & 255, c4 = idx & 63; int pm, pn; S.tile_pmpn(S.nFull + tl, pm, pn);
                        f32x4* xp = (f32x4*)(X + (size_t)(pm * 256 + r) * DM + pn * 256 + c4 * 4); f32x4 acc = *xp;
#pragma unroll
                        for (int part = 0; part < 4; ++part) acc += *(const f32x4*)(PART + (size_t)(part * 32 + tl) * 65536 + r * 256 + c4 * 4);
                        *xp = acc; }
                }
            }
            fast_grid_barrier((unsigned*)ldp(tab, 40), tab);
        }
    }
    {
        PHASE_IDS BASES
        const float* gn = IN(8);
        f32x4 ggr[8];
#pragma unroll
        for (int q = 0; q < 8; ++q) ggr[q] = *((const f32x4*)gn + lane + 64 * q);
        for (int row = gw; row < MROWS; row += NGW) {
            f32x4* xr = (f32x4*)(X + (size_t)row * DM) + lane; f32x4 x[8]; float ss = 0.f;
#pragma unroll
            for (int q = 0; q < 8; ++q) { x[q] = xr[64 * q]; ss += x[q][0] * x[q][0] + x[q][1] * x[q][1] + x[q][2] * x[q][2] + x[q][3] * x[q][3]; }
            const float rs = rsqrtf(wave_sum(ss, lane) * (1.f / DM) + 1e-6f);
#pragma unroll
            for (int q = 0; q < 8; ++q) { const f32x4 gg = ggr[q]; xr[64 * q] = x[q] * rs * gg; }
        }
    }
}

#undef TR
#undef CONVERT_WEIGHTS
extern "C" void kernel_launch(void* const* d_in, const int* in_sizes, int n_in, void* d_out, int out_size, void* d_ws, size_t ws_size, hipStream_t stream) {
    static int grid = 0;
    if (grid == 0) {
        if (n_in != 39 || (size_t)out_size != O_TOTAL || ws_size < WS_END) {
            fprintf(stderr, "kernel_launch: unexpected shapes: n_in %d out %d ws %zu (need %zu)\n", n_in, out_size, ws_size, (size_t)WS_END); grid = -1; return; }
        int dev = 0, cus = 0, per_cu = 0;
        (void)hipGetDevice(&dev);
        (void)hipDeviceGetAttribute(&cus, hipDeviceAttributeMultiprocessorCount, dev);
        if (hipFuncSetAttribute((const void*)fwd_kernel, hipFuncAttributeMaxDynamicSharedMemorySize, LDS_BYTES) != hipSuccess) { fprintf(stderr, "kernel_launch: hipFuncSetAttribute failed\n"); grid = -1; return; }
        if (hipOccupancyMaxActiveBlocksPerMultiprocessor(&per_cu, (const void*)fwd_kernel, 512, LDS_BYTES) != hipSuccess || per_cu < 1) { fprintf(stderr, "kernel_launch: occupancy query says %d\n", per_cu); per_cu = 1; }
        (void)hipGetLastError();
        grid = cus * 1;
        if (grid <= 0) grid = 256;
    }
    if (grid < 0) return;
    P prm{};
    for (int i = 0; i < 39; ++i) prm.in[i] = (const float*)d_in[i];
    prm.out = (float*)d_out; prm.ws = (unsigned char*)d_ws;
    void* args[] = {&prm};
    hipError_t e = hipLaunchCooperativeKernel((const void*)fwd_kernel, dim3(grid), dim3(512), args, LDS_BYTES, stream);
    if (e != hipSuccess) fprintf(stderr, "cooperative launch failed: %s (grid %d)\n", hipGetErrorString(e), grid);
}
```
